# Optimizing an MI355X kernel written in HIP

```python
import math
import jax
import jax.numpy as jnp
from jax import lax
import numpy as np

D_MODEL = 1024
BATCH = 32
SEQ = 256
DEPTH = 4
DEC_BATCH = 8
DEC_SEQ = 2048
PAST_LEN = 512

GRID_W = 64
N_MIXERS = 3
LAYER_KIND = tuple(l % N_MIXERS for l in range(DEPTH))
LAYER_SLOT = tuple(LAYER_KIND[:l].count(LAYER_KIND[l]) for l in range(DEPTH))
N_DIFF = LAYER_KIND.count(0)
N_RET = LAYER_KIND.count(1)
N_HGRN = LAYER_KIND.count(2)

DA_HEADS = 8
DA_HEAD_DIM = 64
DA_V_DIM = 2 * DA_HEAD_DIM
DA_WIDTH = DA_HEADS * DA_V_DIM
DA_QK = 2 * DA_HEADS * DA_HEAD_DIM
DA_IN = 2 * DA_QK + 2 * DA_WIDTH
ROPE_BASE = 10000.0
Q_BLOCK = 128

RET_HEADS = 8
RET_DK = 128
RET_DV = 256
RET_WIDTH = RET_HEADS * RET_DV
RET_QK = RET_HEADS * RET_DK
RET_IN = 2 * RET_QK + 2 * RET_WIDTH

HG_HEADS = 8
HG_DK = 128
HG_DV = D_MODEL // HG_HEADS
HG_F = HG_HEADS * HG_DK
HG_WIDTH = HG_HEADS * HG_DV
HG_IN = 3 * HG_F + 2 * HG_WIDTH

CHUNK = 64
EPS = 1e-6

kernel_name = 'hybrid_diff_ret_hgrn2_prefix_denoise_step'


def rms_norm(x, gain=None):
    xf = x.astype(jnp.float32)
    y = xf * lax.rsqrt(jnp.mean(xf * xf, axis=-1, keepdims=True) + EPS)
    if gain is not None:
        y = y * gain.astype(jnp.float32)
    return y.astype(x.dtype)


def modulation(cvec, w, b):
    m = jax.nn.silu(cvec) @ w + b
    shift, scale, gate = jnp.split(m, 3, axis=-1)
    return shift[:, None, :], scale[:, None, :], gate[:, None, :]


def axial_rope(x):
    B, T, S, hd = x.shape
    rows = T // GRID_W
    row = jnp.repeat(jnp.arange(rows), GRID_W)
    col = jnp.broadcast_to(jnp.arange(GRID_W), (rows, GRID_W)).reshape(-1)
    n_pair = hd // 4
    inv = ROPE_BASE ** (-jnp.arange(n_pair, dtype=jnp.float32) / n_pair)
    ang = jnp.concatenate([row[:, None] * inv, col[:, None] * inv], axis=-1)
    cos = jnp.cos(ang)[None, :, None, :]
    sin = jnp.sin(ang)[None, :, None, :]
    xf = x.astype(jnp.float32).reshape(B, T, S, hd // 2, 2)
    x1, x2 = xf[..., 0], xf[..., 1]
    out = jnp.stack([x1 * cos - x2 * sin, x1 * sin + x2 * cos], axis=-1)
    return out.reshape(B, T, S, hd).astype(x.dtype)


def to_chunks(x):
    B, T = x.shape[:2]
    return jnp.moveaxis(x.reshape(B, T // CHUNK, CHUNK, *x.shape[2:]), 1, 0)


def from_chunks(x):
    n, B, C = x.shape[:3]
    return jnp.moveaxis(x, 0, 1).reshape(B, n * C, *x.shape[3:])


def diff_softmax_attend(q, k, v, lam):
    B, Tq, S, dh = q.shape
    H = S // 2
    nb = Tq // Q_BLOCK
    qb = jnp.moveaxis(q.reshape(B, nb, Q_BLOCK, S, dh), 1, 0)

    def block(qblk):
        s = jnp.einsum('bqsd,bksd->bsqk', qblk, k).astype(jnp.float32)
        p = jax.nn.softmax(s, axis=-1).reshape(B, H, 2, Q_BLOCK, -1)
        a = p[:, :, 0] - lam * p[:, :, 1]
        return jnp.einsum('bhqk,bkhe->bqhe', a.astype(v.dtype), v)

    o = lax.map(block, qb)
    return jnp.moveaxis(o, 0, 1).reshape(B, Tq, H, v.shape[-1])


def diff_attention(xn, w_in, w_out, lam_vec, sub_g, layer_idx, ctx_k=None, ctx_v=None):
    B, T, _ = xn.shape
    h = xn @ w_in
    q, k, v, g = jnp.split(h, [DA_QK, 2 * DA_QK, 2 * DA_QK + DA_WIDTH], axis=-1)
    q = q.reshape(B, T, 2 * DA_HEADS, DA_HEAD_DIM)
    k = k.reshape(B, T, 2 * DA_HEADS, DA_HEAD_DIM)
    v = v.reshape(B, T, DA_HEADS, DA_V_DIM)
    lam_init = 0.8 - 0.6 * math.exp(-0.3 * layer_idx)
    lf = lam_vec.astype(jnp.float32)
    lam = jnp.exp(jnp.sum(lf[0] * lf[1])) - jnp.exp(jnp.sum(lf[2] * lf[3])) + lam_init
    if ctx_k is None:
        keys, vals = k, v
    else:
        q = axial_rope(q)
        k = axial_rope(k)
        keys = jnp.concatenate([k, ctx_k.astype(k.dtype)], axis=1)
        vals = jnp.concatenate([v, ctx_v.astype(v.dtype)], axis=1)
    o = diff_softmax_attend(q * (DA_HEAD_DIM ** -0.5), keys, vals, lam)
    o = rms_norm(o, sub_g) * (1.0 - lam_init)
    y = (o.reshape(B, T, DA_WIDTH) * jax.nn.silu(g)) @ w_out
    return y, k, v


def retention_scan(q, k, v, log_g, s0):
    idx = jnp.arange(CHUNK, dtype=jnp.float32)
    diff = idx[:, None] - idx[None, :]
    causal = diff >= 0
    decay_mat = jnp.where(causal, jnp.exp(jnp.where(causal, diff, 0.0) * log_g[:, None, None]), 0.0)
    q_dec = jnp.exp((idx + 1.0)[:, None] * log_g[None, :])
    k_dec = jnp.exp((CHUNK - 1.0 - idx)[:, None] * log_g[None, :])
    chunk_dec = jnp.exp(CHUNK * log_g)[None, :, None, None]

    def step(S, inp):
        qc, kc, vc = inp
        sc = jnp.einsum('bthd,bshd->bhts', qc, kc) * decay_mat
        o = (jnp.einsum('bhts,bshe->bthe', sc, vc)
             + jnp.einsum('bthd,bhde->bthe', qc * q_dec[None, :, :, None], S))
        S = chunk_dec * S + jnp.einsum('bshd,bshe->bhde', kc * k_dec[None, :, :, None], vc)
        return S, o

    f32 = jnp.float32
    S, o = lax.scan(step, s0.astype(f32),
                    (to_chunks(q.astype(f32)), to_chunks(k.astype(f32)), to_chunks(v.astype(f32))))
    return from_chunks(o), S


def gla_scan(q, k, v, log_f, s0):
    idx = jnp.arange(CHUNK)
    causal = idx[:, None] >= idx[None, :]
    mid = CHUNK // 2

    def step(S, inp):
        qc, kc, vc, gc = inp
        b = lax.cumsum(gc, axis=1)
        ref = b[:, mid:mid + 1]
        sc = jnp.einsum('bthd,bshd->bhts', qc * jnp.exp(b - ref), kc * jnp.exp(ref - b))
        sc = jnp.where(causal, sc, 0.0)
        o = (jnp.einsum('bhts,bshe->bthe', sc, vc)
             + jnp.einsum('bthd,bhde->bthe', qc * jnp.exp(b), S))
        b_last = b[:, -1:]
        S = (jnp.exp(b_last[:, 0])[..., None] * S
             + jnp.einsum('bshd,bshe->bhde', kc * jnp.exp(b_last - b), vc))
        return S, o

    f32 = jnp.float32
    S, o = lax.scan(step, s0.astype(f32),
                    (to_chunks(q.astype(f32)), to_chunks(k.astype(f32)),
                     to_chunks(v.astype(f32)), to_chunks(log_f.astype(f32))))
    return from_chunks(o), S


def retention(xn, w_in, w_out, decay_param, s0=None):
    B, T, _ = xn.shape
    h = xn @ w_in
    q, k, v, g = jnp.split(h, [RET_QK, 2 * RET_QK, 2 * RET_QK + RET_WIDTH], axis=-1)
    q = q.reshape(B, T, RET_HEADS, RET_DK)
    k = k.reshape(B, T, RET_HEADS, RET_DK) * (RET_DK ** -0.5)
    v = v.reshape(B, T, RET_HEADS, RET_DV)
    log_g = jnp.log1p(-jnp.exp(decay_param.astype(jnp.float32)))
    if s0 is None:
        s0 = jnp.zeros((B, 2, RET_HEADS, RET_DK, RET_DV), jnp.float32)
    of, sf = retention_scan(q, k, v, log_g[0], s0[:, 0])
    ob, sb = retention_scan(q[:, ::-1], k[:, ::-1], v[:, ::-1], log_g[1], s0[:, 1])
    o = rms_norm(of + ob[:, ::-1]).astype(xn.dtype)
    y = (o.reshape(B, T, RET_WIDTH) * jax.nn.silu(g)) @ w_out
    return y, jnp.stack([sf, sb], axis=1)


def hgrn2(xn, w_in, w_out, lb_logits, norm_g, layer_idx, s0=None):
    B, T, _ = xn.shape
    h = xn @ w_in
    q, ff, fb, i, g = jnp.split(h, [HG_F, 2 * HG_F, 3 * HG_F, 3 * HG_F + HG_WIDTH], axis=-1)
    sm = jax.nn.softmax(lb_logits.astype(jnp.float32), axis=1)
    lb = lax.cumsum(sm, axis=1)[:, layer_idx] - sm[:, 0]

    def gates(fl, lbd):
        f = lbd + (1.0 - lbd) * jax.nn.sigmoid(fl.astype(jnp.float32))
        shp = (B, T, HG_HEADS, HG_DK)
        return jnp.log(f).reshape(shp), (1.0 - f).reshape(shp)

    q = jax.nn.silu(q).reshape(B, T, HG_HEADS, HG_DK)
    i = i.reshape(B, T, HG_HEADS, HG_DV)
    gf, kf = gates(ff, lb[0])
    gb, kb = gates(fb, lb[1])
    if s0 is None:
        s0 = jnp.zeros((B, 2, HG_HEADS, HG_DK, HG_DV), jnp.float32)
    of, sf = gla_scan(q, kf, i, gf, s0[:, 0])
    ob, sb = gla_scan(q[:, ::-1], kb[:, ::-1], i[:, ::-1], gb[:, ::-1], s0[:, 1])
    o = rms_norm(of + ob[:, ::-1], norm_g).astype(xn.dtype)
    y = (o.reshape(B, T, HG_WIDTH) * jax.nn.silu(g)) @ w_out
    return y, jnp.stack([sf, sb], axis=1)


def setup_inputs(seed: int = 0) -> dict:
    key = jax.random.key(seed)
    ks = jax.random.split(key, 24)
    f32 = jnp.float32
    D = D_MODEL

    def nrm(k, shape, s):
        return jax.random.normal(k, shape, f32) * s

    ret_base = jnp.asarray(np.log(2.0 ** (-5.0 - np.arange(RET_HEADS))), dtype=f32)
    return {
        'x_prompt': nrm(ks[0], (BATCH, SEQ, D), 1.0),
        'x_sample': nrm(ks[1], (DEC_BATCH, DEC_SEQ, D), 1.0),
        'cache_k': nrm(ks[2], (DEC_BATCH, N_DIFF, PAST_LEN, 2 * DA_HEADS, DA_HEAD_DIM), 1.0),
        'cache_v': nrm(ks[3], (DEC_BATCH, N_DIFF, PAST_LEN, DA_HEADS, DA_V_DIM), 1.0),
        'state_ret': nrm(ks[4], (DEC_BATCH, N_RET, 2, RET_HEADS, RET_DK, RET_DV), 0.5),
        'state_hgrn': nrm(ks[5], (DEC_BATCH, N_HGRN, 2, HG_HEADS, HG_DK, HG_DV), 0.5),
        'c': nrm(ks[6], (DEC_BATCH, D), 1.0),
        'c_ctx': nrm(ks[7], (D,), 1.0),
        'w_mod': nrm(ks[8], (DEPTH, D, 3 * D), 0.5 * D ** -0.5),
        'b_mod': nrm(ks[9], (DEPTH, 3 * D), 0.02),
        'g_pre': 1.0 + nrm(ks[10], (DEPTH, D), 0.05),
        'g_post': 1.0 + nrm(ks[11], (DEPTH, D), 0.05),
        'da_w_in': nrm(ks[12], (N_DIFF, D, DA_IN), D ** -0.5),
        'da_w_out': nrm(ks[13], (N_DIFF, DA_WIDTH, D), DA_WIDTH ** -0.5),
        'da_lambda': nrm(ks[14], (N_DIFF, 4, DA_HEAD_DIM), 0.1),
        'da_subln': 1.0 + nrm(ks[15], (N_DIFF, DA_V_DIM), 0.05),
        'ret_w_in': nrm(ks[16], (N_RET, D, RET_IN), D ** -0.5),
        'ret_w_out': nrm(ks[17], (N_RET, RET_WIDTH, D), RET_WIDTH ** -0.5),
        'ret_decay': ret_base + nrm(ks[18], (N_RET, 2, RET_HEADS), 0.05),
        'hg_w_in': nrm(ks[19], (N_HGRN, D, HG_IN), D ** -0.5),
        'hg_w_out': nrm(ks[20], (N_HGRN, HG_WIDTH, D), HG_WIDTH ** -0.5),
        'hg_lb': nrm(ks[21], (2, DEPTH, HG_F), 0.1),
        'hg_norm': 1.0 + nrm(ks[22], (N_HGRN, HG_DV), 0.05),
    }


def reference(x_prompt, x_sample, cache_k, cache_v, state_ret, state_hgrn, c, c_ctx,
              w_mod, b_mod, g_pre, g_post,
              da_w_in, da_w_out, da_lambda, da_subln,
              ret_w_in, ret_w_out, ret_decay,
              hg_w_in, hg_w_out, hg_lb, hg_norm):
    xp, xs = x_prompt, x_sample
    new_k, new_v, new_r, new_h = [], [], [], []
    for l in range(DEPTH):
        kind = LAYER_KIND[l]
        j = LAYER_SLOT[l]
        sh_p, sc_p, ga_p = modulation(c_ctx[None, :], w_mod[l], b_mod[l])
        sh_s, sc_s, ga_s = modulation(c, w_mod[l], b_mod[l])
        hp = rms_norm(xp, g_pre[l]) * (1.0 + sc_p) + sh_p
        hs = rms_norm(xs, g_pre[l]) * (1.0 + sc_s) + sh_s
        if kind == 0:
            yp, kp, vp = diff_attention(hp, da_w_in[j], da_w_out[j], da_lambda[j], da_subln[j], l)
            ys, _, _ = diff_attention(hs, da_w_in[j], da_w_out[j], da_lambda[j], da_subln[j], l,
                                      cache_k[:, j], cache_v[:, j])
            new_k.append(kp)
            new_v.append(vp)
        elif kind == 1:
            yp, sp = retention(hp, ret_w_in[j], ret_w_out[j], ret_decay[j])
            ys, _ = retention(hs, ret_w_in[j], ret_w_out[j], ret_decay[j], state_ret[:, j])
            new_r.append(sp)
        else:
            yp, sp = hgrn2(hp, hg_w_in[j], hg_w_out[j], hg_lb, hg_norm[j], l)
            ys, _ = hgrn2(hs, hg_w_in[j], hg_w_out[j], hg_lb, hg_norm[j], l, state_hgrn[:, j])
            new_h.append(sp)
        xp = xp + ga_p * rms_norm(yp, g_post[l])
        xs = xs + ga_s * rms_norm(ys, g_post[l])
    new_cache_k = jnp.stack(new_k, axis=1)
    new_cache_v = jnp.stack(new_v, axis=1)
    new_state_ret = jnp.stack(new_r, axis=1)
    new_state_hgrn = jnp.stack(new_h, axis=1)
    return (xp, xs, new_cache_k, new_cache_v, new_state_ret, new_state_hgrn)
```

```cpp
#include <hip/hip_runtime.h>
#include <hip/hip_cooperative_groups.h>
#include <cstdint>
#include <cstdio>
namespace cg = cooperative_groups;

#ifndef ONE_LAUNCH
#define ONE_LAUNCH 1
#endif

typedef unsigned short bf16_t;
typedef short bf16x8 __attribute__((ext_vector_type(8)));
typedef float f32x4 __attribute__((ext_vector_type(4)));

#define MIB ((size_t)1 << 20)
#define NPH 23
#define LDS_BYTES 74752

#define OFF_WIN  (288 * MIB)
#define OFF_WOUT (300 * MIB)
#define OFF_HP   (304 * MIB)
#define OFF_MISC (320 * MIB)
#define MISC_ROPE 524288
#define WS_NEED  (322 * MIB)
#define PLANE_E  ((size_t)25165824)
#define OUT_YP 0
#define OUT_YS 8388608
#define OUT_CK 25165824
#define OUT_CV 41943040
#define OUT_SR 58720256
#define OUT_SH 75497472

struct Params {
  const float* in[23];
  float* out;
  unsigned char* ws;
  int ph_lo, ph_hi;
};

struct LayerInfo { int kind, slot, IN, WIDTH; const float* w_in; const float* w_out; };

__device__ __forceinline__ LayerInfo layer_info(const Params& p, int l) {
  LayerInfo L;
  if (l == 0)      { L.kind = 0; L.slot = 0; L.IN = 4096; L.WIDTH = 1024; L.w_in = p.in[12]; L.w_out = p.in[13]; }
  else if (l == 1) { L.kind = 1; L.slot = 0; L.IN = 6144; L.WIDTH = 2048; L.w_in = p.in[16]; L.w_out = p.in[17]; }
  else if (l == 2) { L.kind = 2; L.slot = 0; L.IN = 5120; L.WIDTH = 1024; L.w_in = p.in[19]; L.w_out = p.in[20]; }
  else             { L.kind = 0; L.slot = 1; L.IN = 4096; L.WIDTH = 1024; L.w_in = p.in[12] + (size_t)1024 * 4096; L.w_out = p.in[13] + (size_t)1024 * 1024; }
  return L;
}
__device__ __forceinline__ bf16_t* hs_ptr(const Params& p, int l) {
  return l < 3 ? (bf16_t*)(p.out + OUT_SH) : (bf16_t*)(p.ws + 240 * MIB);
}

__device__ __forceinline__ bf16_t f2bf(float f) { unsigned u = __float_as_uint(f); u += 0x7fffu + ((u >> 16) & 1u); return (bf16_t)(u >> 16); }
__device__ __forceinline__ float bf2f(unsigned h) { return __uint_as_float(h << 16); }
__device__ __forceinline__ unsigned pack2(float a, float b) { return (unsigned)f2bf(a) | ((unsigned)f2bf(b) << 16); }
__device__ __forceinline__ float lo_f(unsigned w) { return __uint_as_float(w << 16); }
__device__ __forceinline__ float hi_f(unsigned w) { return __uint_as_float(w & 0xffff0000u); }
__device__ __forceinline__ float silu_f(float x) { return x / (1.f + __expf(-x)); }
__device__ __forceinline__ float wave_sum(float v) {
#pragma unroll
  for (int o = 32; o > 0; o >>= 1) v += __shfl_xor(v, o);
  return v;
}
#define MFMA(a, b, c) __builtin_amdgcn_mfma_f32_16x16x32_bf16((a), (b), (c), 0, 0, 0)

__device__ __forceinline__ void convT_tile(const float* __restrict__ src, int src_ld, bf16_t* __restrict__ dst, int dst_ld, unsigned char* lds) {
  float* t = (float*)lds;
  const int tid = threadIdx.x;
  const int kr = tid >> 4, nc = (tid & 15) * 4;
#pragma unroll
  for (int j = 0; j < 4; ++j) {
    const float4 v = *(const float4*)(src + (size_t)(kr + 16 * j) * src_ld + nc);
    float* tp = t + (kr + 16 * j) * 65 + nc;
    tp[0] = v.x; tp[1] = v.y; tp[2] = v.z; tp[3] = v.w;
  }
  __syncthreads();
  const int n = tid >> 2, kc = (tid & 3) * 16;
  unsigned w[8];
#pragma unroll
  for (int i = 0; i < 8; ++i) w[i] = pack2(t[(kc + 2 * i) * 65 + n], t[(kc + 2 * i + 1) * 65 + n]);
  uint4* d = (uint4*)(dst + (size_t)n * dst_ld + kc);
  d[0] = make_uint4(w[0], w[1], w[2], w[3]);
  d[1] = make_uint4(w[4], w[5], w[6], w[7]);
  __syncthreads();
}

__device__ __forceinline__ int conv_weights_count(const Params& p, int l) {
  const LayerInfo L = layer_info(p, l);
  return (L.IN / 64) * 16 + (L.WIDTH / 64) * 16;
}
__device__ __forceinline__ void conv_weights_item(const Params& p, int l, int it, unsigned char* lds) {
  const LayerInfo L = layer_info(p, l);
  const int nin = (L.IN / 64) * 16;
  if (it < nin) {
    const int kt = it & 15, nt = it >> 4;
    convT_tile(L.w_in + (size_t)(kt * 64) * L.IN + nt * 64, L.IN, (bf16_t*)(p.ws + OFF_WIN) + (size_t)(nt * 64) * 1024 + kt * 64, 1024, lds);
  } else {
    const int it2 = it - nin, nkt = L.WIDTH / 64;
    const int kt = it2 % nkt, nt = it2 / nkt;
    convT_tile(L.w_out + (size_t)(kt * 64) * 1024 + nt * 64, 1024, (bf16_t*)(p.ws + OFF_WOUT) + (size_t)(nt * 64) * L.WIDTH + kt * 64, L.WIDTH, lds);
  }
}

__device__ __forceinline__ void mod_item(const Params& p, int it, unsigned char* lds) {
  float* ssilu = (float*)lds;
  float* red = ssilu + 9 * 1024;
  const int tid = threadIdx.x;
  const int l = it / 48, col0 = (it % 48) * 64;
  for (int i = tid; i < 9 * 1024; i += 256) {
    const int v = i >> 10, k = i & 1023;
    const float x = (v == 0) ? p.in[7][k] : p.in[6][(v - 1) * 1024 + k];
    ssilu[i] = silu_f(x);
  }
  __syncthreads();
  const int col = tid & 63, kq = tid >> 6;
  const float* w = p.in[8] + (size_t)l * 1024 * 3072 + col0 + col;
  float acc[9];
#pragma unroll
  for (int v = 0; v < 9; ++v) acc[v] = 0.f;
  for (int k = kq * 256; k < kq * 256 + 256; ++k) {
    const float wv = w[(size_t)k * 3072];
#pragma unroll
    for (int v = 0; v < 9; ++v) acc[v] += ssilu[v * 1024 + k] * wv;
  }
#pragma unroll
  for (int v = 0; v < 9; ++v) red[(kq * 9 + v) * 64 + col] = acc[v];
  __syncthreads();
  float* mod = (float*)(p.ws + OFF_MISC);
  for (int i = tid; i < 9 * 64; i += 256) {
    const int v = i >> 6, cc = i & 63;
    const float s = red[(0 * 9 + v) * 64 + cc] + red[(1 * 9 + v) * 64 + cc] + red[(2 * 9 + v) * 64 + cc] + red[(3 * 9 + v) * 64 + cc];
    mod[(size_t)(l * 9 + v) * 3072 + col0 + cc] = s + p.in[9][l * 3072 + col0 + cc];
  }
  __syncthreads();
}

__device__ __forceinline__ void rope_item(const Params& p, int it) {
  const int idx = it * 256 + threadIdx.x;
  const int t = idx >> 5, pp = idx & 31;
  const int pos = pp < 16 ? (t >> 6) : (t & 63);
  const float inv = exp2f(-(float)(pp & 15) * (13.287712379549449f / 16.f));
  const float ang = (float)pos * inv;
  const double a = (double)ang;
  const double r = a - 6.283185307179586 * rint(a * 0.15915494309189535);
  const float rf = (float)r;
  float2* tab = (float2*)(p.ws + OFF_MISC + MISC_ROPE);
  tab[idx] = make_float2(__cosf(rf), __sinf(rf));
}

__device__ __forceinline__ void phase0(const Params& p, unsigned char* lds) {
  const int nw = conv_weights_count(p, 0);
  const int total = 192 + 256 + nw;
  for (int it = blockIdx.x; it < total; it += gridDim.x) {
    if (it < 192) mod_item(p, it, lds);
    else if (it < 448) rope_item(p, it - 192);
    else conv_weights_item(p, 0, it - 448, lds);
  }
}

__device__ __forceinline__ void post_phase(const Params& p, int lprev, int lnext, unsigned char* lds) {
  const int tid = threadIdx.x, lane = tid & 63, w = tid >> 6;
  const float* mod = (const float*)(p.ws + OFF_MISC);
  const float* Y = nullptr;
  if (lprev >= 0) {
    const int kind = layer_info(p, lprev).kind;
    Y = (const float*)(p.ws + (kind == 1 ? 96 * MIB : 0));
  }
  bf16_t* hp = (bf16_t*)(p.ws + OFF_HP);
  bf16_t* hs = lnext < 4 ? hs_ptr(p, lnext) : nullptr;
  for (int row = blockIdx.x * 4 + w; row < 24576; row += gridDim.x * 4) {
    const int mv = row < 8192 ? 0 : 1 + ((row - 8192) >> 11);
    const float* xs = (lprev <= 0) ? (row < 8192 ? p.in[0] + (size_t)row * 1024 : p.in[1] + (size_t)(row - 8192) * 1024) : p.out + (size_t)row * 1024;
    float4 x[4];
#pragma unroll
    for (int j = 0; j < 4; ++j) x[j] = *(const float4*)(xs + lane * 4 + 256 * j);
    if (lprev >= 0) {
      float4 y[4];
      float ss = 0.f;
#pragma unroll
      for (int j = 0; j < 4; ++j) { y[j] = *(const float4*)(Y + (size_t)row * 1024 + lane * 4 + 256 * j); ss += y[j].x * y[j].x + y[j].y * y[j].y + y[j].z * y[j].z + y[j].w * y[j].w; }
      ss = wave_sum(ss);
      const float rstd = rsqrtf(ss * (1.f / 1024.f) + 1e-6f);
      const float* ga = mod + (size_t)(lprev * 9 + mv) * 3072 + 2048;
      const float* gp = p.in[11] + lprev * 1024;
#pragma unroll
      for (int j = 0; j < 4; ++j) {
        const int c = lane * 4 + 256 * j;
        const float4 g4 = *(const float4*)(ga + c), p4 = *(const float4*)(gp + c);
        x[j].x += g4.x * (y[j].x * rstd * p4.x); x[j].y += g4.y * (y[j].y * rstd * p4.y);
        x[j].z += g4.z * (y[j].z * rstd * p4.z); x[j].w += g4.w * (y[j].w * rstd * p4.w);
        *(float4*)(p.out + (size_t)row * 1024 + c) = x[j];
      }
    }
    if (lnext < 4) {
      float ss = 0.f;
#pragma unroll
      for (int j = 0; j < 4; ++j) ss += x[j].x * x[j].x + x[j].y * x[j].y + x[j].z * x[j].z + x[j].w * x[j].w;
      ss = wave_sum(ss);
      const float rstd = rsqrtf(ss * (1.f / 1024.f) + 1e-6f);
      const float* sh = mod + (size_t)(lnext * 9 + mv) * 3072;
      const float* sc = sh + 1024;
      const float* gp = p.in[10] + lnext * 1024;
      bf16_t* hd = row < 8192 ? hp + (size_t)row * 1024 : hs + (size_t)(row - 8192) * 1024;
#pragma unroll
      for (int j = 0; j < 4; ++j) {
        const int c = lane * 4 + 256 * j;
        const float4 s4 = *(const float4*)(sh + c), c4 = *(const float4*)(sc + c), p4 = *(const float4*)(gp + c);
        const float h0 = x[j].x * rstd * p4.x * (1.f + c4.x) + s4.x, h1 = x[j].y * rstd * p4.y * (1.f + c4.y) + s4.y;
        const float h2 = x[j].z * rstd * p4.z * (1.f + c4.z) + s4.z, h3 = x[j].w * rstd * p4.w * (1.f + c4.w) + s4.w;
        *(uint2*)(hd + c) = make_uint2(pack2(h0, h1), pack2(h2, h3));
      }
    }
  }
  if (lprev >= 0 && lnext < 4) {
    const int nw = conv_weights_count(p, lnext);
    for (int it = blockIdx.x; it < nw; it += gridDim.x) conv_weights_item(p, lnext, it, lds);
  }
}

template <bool SWAP>
__device__ __forceinline__ void gemm_tile_compute(const bf16_t* __restrict__ Ag, const bf16_t* __restrict__ Bg, int K, unsigned char* lds, f32x4 (&acc)[4][4]) {
  const int tid = threadIdx.x, lane = tid & 63, wid = tid >> 6, wm = wid >> 1, wn = wid & 1;
  const int lr = lane & 15, lg = lane >> 4;
  const int srow = tid >> 3, schunk = tid & 7;
  uint4 ra[4], rb[4];
#pragma unroll
  for (int mi = 0; mi < 4; ++mi)
#pragma unroll
    for (int ni = 0; ni < 4; ++ni) acc[mi][ni] = (f32x4){0.f, 0.f, 0.f, 0.f};
  const bf16_t* ap = Ag + (size_t)srow * K + schunk * 8;
  const bf16_t* bp = Bg + (size_t)srow * K + schunk * 8;
  const size_t rstep = (size_t)32 * K;
#pragma unroll
  for (int j = 0; j < 4; ++j) { ra[j] = *(const uint4*)(ap + j * rstep); rb[j] = *(const uint4*)(bp + j * rstep); }
  unsigned char* sw = lds + srow * 144 + schunk * 16;
#pragma unroll
  for (int j = 0; j < 4; ++j) { *(uint4*)(sw + j * 32 * 144) = ra[j]; *(uint4*)(sw + 18432 + j * 32 * 144) = rb[j]; }
  __syncthreads();
  const int nk = K >> 6;
  const int aoff = (wm * 64 + lr) * 144 + lg * 16, boff = 18432 + (wn * 64 + lr) * 144 + lg * 16;
  for (int kt = 0; kt < nk; ++kt) {
    if (kt + 1 < nk) {
#pragma unroll
      for (int j = 0; j < 4; ++j) { ra[j] = *(const uint4*)(ap + (kt + 1) * 64 + j * rstep); rb[j] = *(const uint4*)(bp + (kt + 1) * 64 + j * rstep); }
    }
    const unsigned char* st = lds + (kt & 1) * 36864;
#pragma unroll
    for (int kk = 0; kk < 2; ++kk) {
      bf16x8 af[4], bfr[4];
#pragma unroll
      for (int mi = 0; mi < 4; ++mi) af[mi] = *(const bf16x8*)(st + aoff + mi * 16 * 144 + kk * 64);
#pragma unroll
      for (int ni = 0; ni < 4; ++ni) bfr[ni] = *(const bf16x8*)(st + boff + ni * 16 * 144 + kk * 64);
#pragma unroll
      for (int mi = 0; mi < 4; ++mi)
#pragma unroll
        for (int ni = 0; ni < 4; ++ni)
          acc[mi][ni] = SWAP ? MFMA(bfr[ni], af[mi], acc[mi][ni]) : MFMA(af[mi], bfr[ni], acc[mi][ni]);
    }
    if (kt + 1 < nk) {
      unsigned char* sw2 = sw + ((kt + 1) & 1) * 36864;
#pragma unroll
      for (int j = 0; j < 4; ++j) { *(uint4*)(sw2 + j * 32 * 144) = ra[j]; *(uint4*)(sw2 + 18432 + j * 32 * 144) = rb[j]; }
    }
    __syncthreads();
  }
}

enum { GM_IN_DA = 0, GM_IN_RET_QKV = 1, GM_IN_RET_G = 2, GM_IN_HG = 3, GM_OUT = 4 };

__device__ __forceinline__ void epi_swapped(const Params& p, int mode, int slot, int ykind, int m, int n, f32x4 v) {
  bf16_t* R0 = (bf16_t*)p.ws;
  if (mode == GM_OUT) {
    float* Y = (float*)(p.ws + (ykind == 1 ? 96 * MIB : 0));
    *(f32x4*)(Y + (size_t)m * 1024 + n) = v;
  } else if (mode == GM_IN_DA) {
    const bool smp = m >= 8192;
    const int ms = m - 8192;
    const int b = smp ? (ms >> 11) : (m >> 8), t = smp ? (ms & 2047) : (m & 255);
    if (n < 2048) {
      if (smp) {
        const float4 cs = *(const float4*)((const float*)(p.ws + OFF_MISC + MISC_ROPE) + (size_t)(t * 32 + ((n & 63) >> 1)) * 2);
        const float a0 = v[0] * cs.x - v[1] * cs.y, a1 = v[0] * cs.y + v[1] * cs.x;
        const float a2 = v[2] * cs.z - v[3] * cs.w, a3 = v[2] * cs.w + v[3] * cs.z;
        v = (f32x4){a0, a1, a2, a3};
      }
      if (n < 1024) {
        *(uint2*)(R0 + (size_t)m * 1024 + n) = make_uint2(pack2(v[0] * 0.125f, v[1] * 0.125f), pack2(v[2] * 0.125f, v[3] * 0.125f));
      } else {
        const int c = n - 1024;
        const uint2 pk = make_uint2(pack2(v[0], v[1]), pack2(v[2], v[3]));
        if (smp) {
          *(uint2*)(R0 + 64 * MIB / 2 + ((size_t)b * 2560 + t) * 1024 + c) = pk;
        } else {
          *(f32x4*)(p.out + OUT_CK + ((size_t)((b * 2 + slot) * 256 + t)) * 1024 + c) = v;
          *(uint2*)(R0 + 48 * MIB / 2 + (size_t)m * 1024 + c) = pk;
        }
      }
    } else {
      *(uint2*)(R0 + 160 * MIB / 2 + (size_t)m * 1024 + (n - 3072)) = make_uint2(pack2(silu_f(v[0]), silu_f(v[1])), pack2(silu_f(v[2]), silu_f(v[3])));
    }
  } else if (mode == GM_IN_RET_QKV) {
    if (n < 1024) *(uint2*)(R0 + (size_t)m * 1024 + n) = make_uint2(pack2(v[0], v[1]), pack2(v[2], v[3]));
    else if (n < 2048) { const float s = 0.08838834764831845f; *(uint2*)(R0 + PLANE_E + (size_t)m * 1024 + (n - 1024)) = make_uint2(pack2(v[0] * s, v[1] * s), pack2(v[2] * s, v[3] * s)); }
    else *(uint2*)(R0 + 2 * PLANE_E + (size_t)m * 2048 + (n - 2048)) = make_uint2(pack2(v[0], v[1]), pack2(v[2], v[3]));
  } else if (mode == GM_IN_RET_G) {
    *(uint2*)(R0 + (size_t)m * 2048 + n) = make_uint2(pack2(silu_f(v[0]), silu_f(v[1])), pack2(silu_f(v[2]), silu_f(v[3])));
  } else {
    if (n < 1024 || n >= 4096) v = (f32x4){silu_f(v[0]), silu_f(v[1]), silu_f(v[2]), silu_f(v[3])};
    *(uint2*)(R0 + (size_t)(n >> 10) * PLANE_E + (size_t)m * 1024 + (n & 1023)) = make_uint2(pack2(v[0], v[1]), pack2(v[2], v[3]));
  }
}

__device__ __forceinline__ void epi_da_v(const Params& p, int slot, int m, int n, f32x4 v) {
  bf16_t* R0 = (bf16_t*)p.ws;
  const int c = n - 2048, hh = c >> 7, e = c & 127;
  const uint2 pk = make_uint2(pack2(v[0], v[1]), pack2(v[2], v[3]));
  if (m >= 8192) {
    const int ms = m - 8192, b = ms >> 11, t = ms & 2047;
    *(uint2*)(R0 + 120 * MIB / 2 + ((size_t)((b * 8 + hh) * 128 + e)) * 2560 + t) = pk;
  } else {
    const int b = m >> 8, t = m & 255;
    float* o = p.out + OUT_CV + ((size_t)((b * 2 + slot) * 256 + t)) * 1024 + c;
    o[0] = v[0]; o[1024] = v[1]; o[2048] = v[2]; o[3072] = v[3];
    *(uint2*)(R0 + 104 * MIB / 2 + ((size_t)((b * 8 + hh) * 128 + e)) * 256 + t) = pk;
  }
}

__device__ __forceinline__ void gemm_phase(const Params& p, int l, int mode, unsigned char* lds) {
  const LayerInfo L = layer_info(p, l);
  bf16_t* R0 = (bf16_t*)p.ws;
  const bf16_t *Ap, *As, *Bt;
  int K, N;
  if (mode == GM_OUT) {
    K = L.WIDTH; N = 1024; Bt = (const bf16_t*)(p.ws + OFF_WOUT);
    const bf16_t* base = R0 + (L.kind == 0 ? 160 * MIB / 2 : (L.kind == 1 ? 4 * PLANE_E : 5 * PLANE_E));
    Ap = base; As = base + (size_t)8192 * K;
  } else {
    K = 1024; Ap = (const bf16_t*)(p.ws + OFF_HP); As = hs_ptr(p, l);
    Bt = (const bf16_t*)(p.ws + OFF_WIN) + (mode == GM_IN_RET_G ? (size_t)4096 * 1024 : 0);
    N = (mode == GM_IN_DA || mode == GM_IN_RET_QKV) ? 4096 : (mode == GM_IN_RET_G ? 2048 : 5120);
  }
  const int ntn = N >> 7, ntiles = 192 * ntn;
  const int extra = (mode == GM_IN_DA) ? 3072 : 0;
  const int tid = threadIdx.x, lane = tid & 63, wid = tid >> 6, wm = wid >> 1, wn = wid & 1, lr = lane & 15, lg = lane >> 4;
  for (int it = blockIdx.x; it < ntiles + extra; it += gridDim.x) {
    if (it < ntiles) {
      const int mt = it / ntn, nt = it - mt * ntn;
      const int m0 = mt * 128, n0 = nt * 128;
      const bf16_t* A = m0 < 8192 ? Ap + (size_t)m0 * K : As + (size_t)(m0 - 8192) * K;
      const bf16_t* B = Bt + (size_t)n0 * K;
      f32x4 acc[4][4];
      if (mode == GM_IN_DA && n0 >= 2048 && n0 < 3072) {
        gemm_tile_compute<false>(A, B, K, lds, acc);
#pragma unroll
        for (int mi = 0; mi < 4; ++mi)
#pragma unroll
          for (int ni = 0; ni < 4; ++ni)
            epi_da_v(p, L.slot, m0 + wm * 64 + mi * 16 + 4 * lg, n0 + wn * 64 + ni * 16 + lr, acc[mi][ni]);
      } else {
        gemm_tile_compute<true>(A, B, K, lds, acc);
#pragma unroll
        for (int mi = 0; mi < 4; ++mi)
#pragma unroll
          for (int ni = 0; ni < 4; ++ni)
            epi_swapped(p, mode, L.slot, L.kind, m0 + wm * 64 + mi * 16 + lr, n0 + wn * 64 + ni * 16 + 4 * lg, acc[mi][ni]);
      }
    } else {
      const int ci = it - ntiles;
      if (ci < 2048) {
        const int idx = (ci * 256 + tid) * 8;
        const int b = idx >> 19, rem = idx & 524287, tp = rem >> 10, c = rem & 1023;
        const float* src = p.in[2] + ((size_t)((b * 2 + L.slot) * 512 + tp)) * 1024 + c;
        const float4 u0 = *(const float4*)src, u1 = *(const float4*)(src + 4);
        *(uint4*)(R0 + 64 * MIB / 2 + ((size_t)b * 2560 + 2048 + tp) * 1024 + c) = make_uint4(pack2(u0.x, u0.y), pack2(u0.z, u0.w), pack2(u1.x, u1.y), pack2(u1.z, u1.w));
      } else {
        const int i2 = ci - 2048;
        const int b = i2 >> 7, hh = (i2 >> 4) & 7, tt = (i2 >> 1) & 7, et = i2 & 1;
        convT_tile(p.in[3] + ((size_t)((b * 2 + L.slot) * 512 + tt * 64)) * 1024 + hh * 128 + et * 64, 1024,
                   R0 + 120 * MIB / 2 + ((size_t)((b * 8 + hh) * 128 + et * 64)) * 2560 + 2048 + tt * 64, 2560, lds);
      }
    }
  }
}

__device__ __forceinline__ void attn_phase(const Params& p, int l, unsigned char* lds) {
  const int slot = l == 3 ? 1 : 0;
  const float lam_init = 0.8f - 0.6f * expf(-0.3f * (float)l);
  const int tid = threadIdx.x, lane = tid & 63, w = tid >> 6, lr = lane & 15, lg = lane >> 4;
  float lam;
  {
    const float* lf = p.in[14] + slot * 256;
    const float a = wave_sum(lf[lane] * lf[64 + lane]);
    const float b2 = wave_sum(lf[128 + lane] * lf[192 + lane]);
    lam = expf(a) - expf(b2) + lam_init;
  }
  bf16_t* R0 = (bf16_t*)p.ws;
  const float* subg = p.in[15] + slot * 128;
  for (int item = blockIdx.x; item < 3072; item += gridDim.x) {
    int grp, b, h, qt;
    if (item < 2048) { grp = 1; b = item >> 8; h = (item >> 5) & 7; qt = item & 31; }
    else { const int i2 = item - 2048; grp = 0; b = i2 >> 5; h = (i2 >> 2) & 7; qt = i2 & 3; }
    const int nkeys = grp ? 2560 : 256, ntile = nkeys >> 6;
    const int mq = (grp ? 8192 + b * 2048 : b * 256) + qt * 64 + w * 16 + lr;
    const bf16_t* Kg = grp ? R0 + 64 * MIB / 2 + (size_t)b * 2560 * 1024 + h * 128 : R0 + 48 * MIB / 2 + (size_t)b * 256 * 1024 + h * 128;
    const bf16_t* Vg = grp ? R0 + 120 * MIB / 2 + (size_t)(b * 8 + h) * 128 * 2560 : R0 + 104 * MIB / 2 + (size_t)(b * 8 + h) * 128 * 256;
    bf16x8 qf[2][2];
#pragma unroll
    for (int sub = 0; sub < 2; ++sub)
#pragma unroll
      for (int ks = 0; ks < 2; ++ks) qf[sub][ks] = *(const bf16x8*)(R0 + (size_t)mq * 1024 + h * 128 + sub * 64 + ks * 32 + lg * 8);
    const int krow = tid >> 4, kch = tid & 15;
    const int vrow = tid >> 3, vch = tid & 7;
    const bf16_t* kp = Kg + (size_t)krow * 1024 + kch * 8;
    const bf16_t* vp = Vg + (size_t)vrow * nkeys + vch * 8;
    unsigned char* ksw = lds + krow * 272 + kch * 16;
    unsigned char* vsw = lds + 17408 + vrow * 144 + vch * 16;
    uint4 rk[4], rv[4];
    float mx[2] = {-1e30f, -1e30f}, ls[2] = {0.f, 0.f};
#pragma unroll
    for (int j = 0; j < 4; ++j) rk[j] = *(const uint4*)(kp + (size_t)(16 * j) * 1024);
#pragma unroll
    for (int j = 0; j < 4; ++j) *(uint4*)(ksw + j * 16 * 272) = rk[j];
    __syncthreads();
    for (int kt = 0; kt < ntile; ++kt) {
      if (kt + 1 < ntile) {
#pragma unroll
        for (int j = 0; j < 4; ++j) rk[j] = *(const uint4*)(kp + (size_t)((kt + 1) * 64 + 16 * j) * 1024);
      }
      const unsigned char* ks_ = lds + (kt & 1) * 35840;
#pragma unroll
      for (int sub = 0; sub < 2; ++sub) {
        f32x4 s[4];
#pragma unroll
        for (int nt = 0; nt < 4; ++nt) {
          s[nt] = (f32x4){0.f, 0.f, 0.f, 0.f};
#pragma unroll
          for (int ks = 0; ks < 2; ++ks) {
            const bf16x8 kf = *(const bf16x8*)(ks_ + (16 * nt + lr) * 272 + sub * 128 + ks * 64 + lg * 16);
            s[nt] = MFMA(kf, qf[sub][ks], s[nt]);
          }
        }
        float tm = s[0][0];
#pragma unroll
        for (int nt = 0; nt < 4; ++nt)
#pragma unroll
          for (int r = 0; r < 4; ++r) tm = fmaxf(tm, s[nt][r]);
        tm = fmaxf(tm, __shfl_xor(tm, 16));
        tm = fmaxf(tm, __shfl_xor(tm, 32));
        const float mn = fmaxf(mx[sub], tm);
        float acc = 0.f;
#pragma unroll
        for (int nt = 0; nt < 4; ++nt)
#pragma unroll
          for (int r = 0; r < 4; ++r) acc += __expf(s[nt][r] - mn);
        ls[sub] = ls[sub] * __expf(mx[sub] - mn) + acc;
        mx[sub] = mn;
      }
      if (kt + 1 < ntile) {
        unsigned char* d = ksw + ((kt + 1) & 1) * 35840;
#pragma unroll
        for (int j = 0; j < 4; ++j) *(uint4*)(d + j * 16 * 272) = rk[j];
      }
      __syncthreads();
    }
    float il[2];
#pragma unroll
    for (int sub = 0; sub < 2; ++sub) {
      float t = ls[sub];
      t += __shfl_xor(t, 16);
      t += __shfl_xor(t, 32);
      il[sub] = 1.f / t;
    }
    const float c1 = il[0], c2 = lam * il[1];
    f32x4 o[8];
#pragma unroll
    for (int et = 0; et < 8; ++et) o[et] = (f32x4){0.f, 0.f, 0.f, 0.f};
#pragma unroll
    for (int j = 0; j < 4; ++j) { rk[j] = *(const uint4*)(kp + (size_t)(16 * j) * 1024); rv[j] = *(const uint4*)(vp + (size_t)(32 * j) * nkeys); }
#pragma unroll
    for (int j = 0; j < 4; ++j) { *(uint4*)(ksw + j * 16 * 272) = rk[j]; *(uint4*)(vsw + j * 32 * 144) = rv[j]; }
    __syncthreads();
    for (int kt = 0; kt < ntile; ++kt) {
      if (kt + 1 < ntile) {
#pragma unroll
        for (int j = 0; j < 4; ++j) { rk[j] = *(const uint4*)(kp + (size_t)((kt + 1) * 64 + 16 * j) * 1024); rv[j] = *(const uint4*)(vp + (size_t)(32 * j) * nkeys + (kt + 1) * 64); }
      }
      const unsigned char* ks_ = lds + (kt & 1) * 35840;
      const unsigned char* vs_ = ks_ + 17408;
#pragma unroll
      for (int k2 = 0; k2 < 2; ++k2) {
        f32x4 s[2][2];
#pragma unroll
        for (int sub = 0; sub < 2; ++sub)
#pragma unroll
          for (int nn = 0; nn < 2; ++nn) {
            s[sub][nn] = (f32x4){0.f, 0.f, 0.f, 0.f};
#pragma unroll
            for (int ks = 0; ks < 2; ++ks) {
              const bf16x8 kf = *(const bf16x8*)(ks_ + (16 * (2 * k2 + nn) + lr) * 272 + sub * 128 + ks * 64 + lg * 16);
              s[sub][nn] = MFMA(kf, qf[sub][ks], s[sub][nn]);
            }
          }
        unsigned pw[4];
#pragma unroll
        for (int nn = 0; nn < 2; ++nn) {
          float a[4];
#pragma unroll
          for (int r = 0; r < 4; ++r) a[r] = __expf(s[0][nn][r] - mx[0]) * c1 - __expf(s[1][nn][r] - mx[1]) * c2;
          pw[nn * 2] = pack2(a[0], a[1]);
          pw[nn * 2 + 1] = pack2(a[2], a[3]);
        }
        bf16x8 pf;
        {
          union { unsigned u[4]; bf16x8 v; } cv;
          cv.u[0] = pw[0]; cv.u[1] = pw[1]; cv.u[2] = pw[2]; cv.u[3] = pw[3];
          pf = cv.v;
        }
#pragma unroll
        for (int et = 0; et < 8; ++et) {
          const unsigned char* va = vs_ + (16 * et + lr) * 144 + (32 * k2 + 4 * lg) * 2;
          const uint2 lo = *(const uint2*)va, hi = *(const uint2*)(va + 32);
          union { unsigned u[4]; bf16x8 v; } cv;
          cv.u[0] = lo.x; cv.u[1] = lo.y; cv.u[2] = hi.x; cv.u[3] = hi.y;
          o[et] = MFMA(cv.v, pf, o[et]);
        }
      }
      if (kt + 1 < ntile) {
        unsigned char* dk = ksw + ((kt + 1) & 1) * 35840;
        unsigned char* dv = vsw + ((kt + 1) & 1) * 35840;
#pragma unroll
        for (int j = 0; j < 4; ++j) { *(uint4*)(dk + j * 16 * 272) = rk[j]; *(uint4*)(dv + j * 32 * 144) = rv[j]; }
      }
      __syncthreads();
    }
    float ss = 0.f;
#pragma unroll
    for (int et = 0; et < 8; ++et)
#pragma unroll
      for (int r = 0; r < 4; ++r) ss += o[et][r] * o[et][r];
    ss += __shfl_xor(ss, 16);
    ss += __shfl_xor(ss, 32);
    const float rs = rsqrtf(ss * (1.f / 128.f) + 1e-6f) * (1.f - lam_init);
    bf16_t* gp = R0 + 160 * MIB / 2 + (size_t)mq * 1024 + h * 128;
#pragma unroll
    for (int et = 0; et < 8; ++et) {
      const int e0 = 16 * et + 4 * lg;
      const uint2 g = *(const uint2*)(gp + e0);
      const float4 sg = *(const float4*)(subg + e0);
      const float v0 = o[et][0] * rs * sg.x * lo_f(g.x), v1 = o[et][1] * rs * sg.y * hi_f(g.x);
      const float v2 = o[et][2] * rs * sg.z * lo_f(g.y), v3 = o[et][3] * rs * sg.w * hi_f(g.y);
      *(uint2*)(gp + e0) = make_uint2(pack2(v0, v1), pack2(v2, v3));
    }
  }
}

template <int KIND, int DIR>
__device__ __forceinline__ void scan_item(const Params& p, int item, unsigned char* lds) {
  constexpr int DV = KIND == 1 ? 256 : 128, NSL = DV / 64, LDV = KIND == 1 ? 2048 : 1024;
  const int tid = threadIdx.x, lane = tid & 63, w = tid >> 6, lr = lane & 15, lg = lane >> 4;
  int grp, b, h, sl;
  {
    int it = item;
    if (it < 64 * NSL) grp = 1; else { grp = 0; it -= 64 * NSL; }
    sl = it % NSL; h = (it / NSL) & 7; b = it / (NSL * 8);
  }
  const int T = grp ? 2048 : 256, nch = T >> 6;
  const size_t mbase = grp ? (size_t)8192 + (size_t)b * 2048 : (size_t)b * 256;
  bf16_t* R0 = (bf16_t*)p.ws;
  const bf16_t* Qg = R0 + mbase * 1024 + h * 128;
  const bf16_t* Kg = R0 + (KIND == 1 ? PLANE_E : (DIR ? 2 * PLANE_E : PLANE_E)) + mbase * 1024 + h * 128;
  const bf16_t* Vg = R0 + (KIND == 1 ? 2 * PLANE_E : 3 * PLANE_E) + mbase * LDV + h * DV + sl * 64;
  bf16_t* Og = R0 + (KIND == 1 ? 4 * PLANE_E : 5 * PLANE_E) + mbase * LDV + h * DV + sl * 64;
  unsigned char* Qs = lds;
  unsigned char* X = lds + 17408;
  unsigned char* Vt = lds + 35840;
  unsigned char* StS = lds + 45056;
  unsigned char* Pm = lds + 62464;
  float* xch = (float*)(lds + 71680);
  float* blA = xch + 512;
  float* erA = xch + 640;
  const int dp = tid & 63, tq = tid >> 6, r0 = tq * 16, d0 = dp * 2;
  float cst0, cst1;
  if (KIND == 1) { cst0 = cst1 = log1pf(-expf(p.in[18][DIR * 8 + h])); }
  else {
    const float* lbp = p.in[21] + DIR * 4096 + h * 128 + d0;
    {
      const float x0 = lbp[0], x1 = lbp[1024], x2 = lbp[2048], x3 = lbp[3072];
      const float m = fmaxf(fmaxf(x0, x1), fmaxf(x2, x3));
      const float e0 = expf(x0 - m), e1 = expf(x1 - m), e2 = expf(x2 - m), e3 = expf(x3 - m);
      cst0 = (e1 + e2) / (e0 + e1 + e2 + e3);
    }
    {
      const float x0 = lbp[1], x1 = lbp[1025], x2 = lbp[2049], x3 = lbp[3073];
      const float m = fmaxf(fmaxf(x0, x1), fmaxf(x2, x3));
      const float e0 = expf(x0 - m), e1 = expf(x1 - m), e2 = expf(x2 - m), e3 = expf(x3 - m);
      cst1 = (e1 + e2) / (e0 + e1 + e2 + e3);
    }
  }
  f32x4 S[8];
  if (grp) {
    const float* s0 = (KIND == 1 ? p.in[4] : p.in[5]) + ((size_t)((b * 2 + DIR) * 8 + h) * 128) * DV + sl * 64 + 16 * w + lr + (size_t)(4 * lg) * DV;
    asm volatile("" : "+v"(s0));
#pragma unroll
    for (int dt = 0; dt < 8; ++dt)
#pragma unroll
      for (int r = 0; r < 4; ++r) S[dt][r] = s0[(16 * dt + r) * DV];
  } else {
#pragma unroll
    for (int dt = 0; dt < 8; ++dt) S[dt] = (f32x4){0.f, 0.f, 0.f, 0.f};
  }
  unsigned qv[16], kv[16], vv[8];
  const int ve2 = tid & 31, vq = tid >> 5;
  const int qoff = r0 * 512 + dp;
  const int voff = (8 * vq) * (LDV / 2) + ve2;
  const unsigned* Qg32 = (const unsigned*)Qg;
  const unsigned* Kg32 = (const unsigned*)Kg;
  const unsigned* Vg32 = (const unsigned*)Vg;
#define SCAN_ISSUE(c)                                                                                   \
  {                                                                                                     \
    const unsigned* q_ = Qg32 + (size_t)(c) * (64 * 512) + qoff;                                        \
    const unsigned* k_ = Kg32 + (size_t)(c) * (64 * 512) + qoff;                                        \
    const unsigned* v_ = Vg32 + (size_t)(c) * (64 * (LDV / 2)) + voff;                                  \
    asm volatile("" : "+v"(q_), "+v"(k_), "+v"(v_));                                                    \
    _Pragma("unroll") for (int i = 0; i < 16; ++i) { qv[i] = q_[i * 512]; kv[i] = k_[i * 512]; }        \
    _Pragma("unroll") for (int i = 0; i < 8; ++i) vv[i] = v_[i * (LDV / 2)];                            \
  }
  SCAN_ISSUE(DIR ? nch - 1 : 0);
  for (int ci = 0; ci < nch; ++ci) {
    const int c = DIR ? nch - 1 - ci : ci;
    float tot0 = 0.f, tot1 = 0.f;
    if (KIND == 1) { tot0 = tot1 = 16.f * cst0; }
    else {
#pragma unroll
      for (int i = 0; i < 16; ++i) {
        const float s0_ = 1.f / (1.f + __expf(-lo_f(kv[i]))), s1_ = 1.f / (1.f + __expf(-hi_f(kv[i])));
        tot0 += __logf(cst0 + (1.f - cst0) * s0_);
        tot1 += __logf(cst1 + (1.f - cst1) * s1_);
      }
    }
    *(float2*)(xch + tq * 128 + d0) = make_float2(tot0, tot1);
    __syncthreads();
    const float2 t0 = *(const float2*)(xch + d0), t1 = *(const float2*)(xch + 128 + d0), t2 = *(const float2*)(xch + 256 + d0), t3 = *(const float2*)(xch + 384 + d0);
    const float blast0 = (t0.x + t1.x) + (t2.x + t3.x), blast1 = (t0.y + t1.y) + (t2.y + t3.y);
    float ref0, ref1, run0, run1;
    if (DIR == 0) {
      ref0 = t0.x + t1.x; ref1 = t0.y + t1.y;
      run0 = (tq > 0 ? t0.x : 0.f) + (tq > 1 ? t1.x : 0.f) + (tq > 2 ? t2.x : 0.f);
      run1 = (tq > 0 ? t0.y : 0.f) + (tq > 1 ? t1.y : 0.f) + (tq > 2 ? t2.y : 0.f);
    } else {
      ref0 = t2.x + t3.x; ref1 = t2.y + t3.y;
      run0 = (tq < 3 ? t3.x : 0.f) + (tq < 2 ? t2.x : 0.f) + (tq < 1 ? t1.x : 0.f);
      run1 = (tq < 3 ? t3.y : 0.f) + (tq < 2 ? t2.y : 0.f) + (tq < 1 ? t1.y : 0.f);
    }
    unsigned ktp0[8], ktp1[8];
#pragma unroll
    for (int jj = 0; jj < 8; ++jj) {
      const int j = DIR ? 7 - jj : jj;
      float ka[2], kb[2];
#pragma unroll
      for (int hh = 0; hh < 2; ++hh) {
        const int i = 2 * j + (DIR ? 1 - hh : hh);
        float g0, g1, k0, k1;
        if (KIND == 1) { g0 = g1 = cst0; k0 = lo_f(kv[i]); k1 = hi_f(kv[i]); }
        else {
          const float s0_ = 1.f / (1.f + __expf(-lo_f(kv[i]))), s1_ = 1.f / (1.f + __expf(-hi_f(kv[i])));
          g0 = __logf(cst0 + (1.f - cst0) * s0_); g1 = __logf(cst1 + (1.f - cst1) * s1_);
          k0 = (1.f - cst0) * (1.f - s0_); k1 = (1.f - cst1) * (1.f - s1_);
        }
        run0 += g0; run1 += g1;
        *(unsigned*)(Qs + (r0 + i) * 272 + d0 * 2) = pack2(lo_f(qv[i]) * __expf(run0 - ref0), hi_f(qv[i]) * __expf(run1 - ref1));
        *(unsigned*)(X + (r0 + i) * 272 + d0 * 2) = pack2(k0 * __expf(ref0 - run0), k1 * __expf(ref1 - run1));
        ka[i & 1] = k0 * __expf(blast0 - run0);
        kb[i & 1] = k1 * __expf(blast1 - run1);
      }
      ktp0[j] = pack2(ka[0], ka[1]);
      ktp1[j] = pack2(kb[0], kb[1]);
    }
    if (tq == 0) { *(float2*)(blA + d0) = make_float2(__expf(blast0), __expf(blast1)); *(float2*)(erA + d0) = make_float2(__expf(ref0), __expf(ref1)); }
    {
      const unsigned a0 = (vv[0] & 0xffffu) | (vv[1] << 16), a1 = (vv[2] & 0xffffu) | (vv[3] << 16), a2 = (vv[4] & 0xffffu) | (vv[5] << 16), a3 = (vv[6] & 0xffffu) | (vv[7] << 16);
      const unsigned b0 = (vv[0] >> 16) | (vv[1] & 0xffff0000u), b1 = (vv[2] >> 16) | (vv[3] & 0xffff0000u), b2 = (vv[4] >> 16) | (vv[5] & 0xffff0000u), b3 = (vv[6] >> 16) | (vv[7] & 0xffff0000u);
      *(uint4*)(Vt + (2 * ve2) * 144 + vq * 16) = make_uint4(a0, a1, a2, a3);
      *(uint4*)(Vt + (2 * ve2 + 1) * 144 + vq * 16) = make_uint4(b0, b1, b2, b3);
    }
    if (ci + 1 < nch) { SCAN_ISSUE(DIR ? c - 1 : c + 1); }
    __syncthreads();
#pragma unroll
    for (int dt = 0; dt < 8; ++dt) {
      const float4 er4 = *(const float4*)(erA + 16 * dt + 4 * lg);
      *(uint2*)(StS + (16 * w + lr) * 272 + (16 * dt + 4 * lg) * 2) = make_uint2(pack2(S[dt][0] * er4.x, S[dt][1] * er4.y), pack2(S[dt][2] * er4.z, S[dt][3] * er4.w));
    }
    bf16x8 qf[4];
#pragma unroll
    for (int ks = 0; ks < 4; ++ks) qf[ks] = *(const bf16x8*)(Qs + (16 * w + lr) * 272 + ks * 64 + lg * 16);
    uint2 pv[4];
    {
      const int t = 16 * w + lr;
#pragma unroll
      for (int st = 0; st < 4; ++st) {
        f32x4 s = (f32x4){0.f, 0.f, 0.f, 0.f};
#pragma unroll
        for (int ks = 0; ks < 4; ++ks) {
          const bf16x8 kf = *(const bf16x8*)(X + (16 * st + lr) * 272 + ks * 64 + lg * 16);
          s = MFMA(kf, qf[ks], s);
        }
        float v[4];
#pragma unroll
        for (int r = 0; r < 4; ++r) {
          const int si = 16 * st + 4 * lg + r;
          const bool keep = DIR ? (t <= si) : (t >= si);
          v[r] = keep ? s[r] : 0.f;
        }
        pv[st] = make_uint2(pack2(v[0], v[1]), pack2(v[2], v[3]));
      }
    }
    __syncthreads();
#pragma unroll
    for (int st = 0; st < 4; ++st) *(uint2*)(Pm + (16 * w + lr) * 144 + (16 * st + 4 * lg) * 2) = pv[st];
    *(uint4*)(X + d0 * 144 + r0 * 2) = make_uint4(ktp0[0], ktp0[1], ktp0[2], ktp0[3]);
    *(uint4*)(X + d0 * 144 + r0 * 2 + 16) = make_uint4(ktp0[4], ktp0[5], ktp0[6], ktp0[7]);
    *(uint4*)(X + (d0 + 1) * 144 + r0 * 2) = make_uint4(ktp1[0], ktp1[1], ktp1[2], ktp1[3]);
    *(uint4*)(X + (d0 + 1) * 144 + r0 * 2 + 16) = make_uint4(ktp1[4], ktp1[5], ktp1[6], ktp1[7]);
    __syncthreads();
    {
      bf16x8 pf[2];
#pragma unroll
      for (int ks = 0; ks < 2; ++ks) pf[ks] = *(const bf16x8*)(Pm + (16 * w + lr) * 144 + ks * 64 + lg * 16);
#pragma unroll
      for (int et = 0; et < 4; ++et) {
        f32x4 o = (f32x4){0.f, 0.f, 0.f, 0.f};
#pragma unroll
        for (int ks = 0; ks < 2; ++ks) {
          const bf16x8 vf = *(const bf16x8*)(Vt + (16 * et + lr) * 144 + ks * 64 + lg * 16);
          o = MFMA(vf, pf[ks], o);
        }
#pragma unroll
        for (int ks = 0; ks < 4; ++ks) {
          const bf16x8 sf = *(const bf16x8*)(StS + (16 * et + lr) * 272 + ks * 64 + lg * 16);
          o = MFMA(sf, qf[ks], o);
        }
        bf16_t* op = Og + (size_t)(c * 64 + 16 * w + lr) * LDV + 16 * et + 4 * lg;
        if (DIR) {
          const uint2 old = *(const uint2*)op;
          o[0] += lo_f(old.x); o[1] += hi_f(old.x); o[2] += lo_f(old.y); o[3] += hi_f(old.y);
        }
        *(uint2*)op = make_uint2(pack2(o[0], o[1]), pack2(o[2], o[3]));
      }
    }
    {
      bf16x8 vtf[2];
#pragma unroll
      for (int ks = 0; ks < 2; ++ks) vtf[ks] = *(const bf16x8*)(Vt + (16 * w + lr) * 144 + ks * 64 + lg * 16);
#pragma unroll
      for (int dt = 0; dt < 8; ++dt) {
        const float4 bl4 = *(const float4*)(blA + 16 * dt + 4 * lg);
        S[dt][0] *= bl4.x; S[dt][1] *= bl4.y; S[dt][2] *= bl4.z; S[dt][3] *= bl4.w;
#pragma unroll
        for (int ks = 0; ks < 2; ++ks) {
          const bf16x8 kf = *(const bf16x8*)(X + (16 * dt + lr) * 144 + ks * 64 + lg * 16);
          S[dt] = MFMA(kf, vtf[ks], S[dt]);
        }
      }
    }
    __syncthreads();
  }
#undef SCAN_ISSUE
  if (!grp) {
    float* so = p.out + (KIND == 1 ? OUT_SR : OUT_SH) + ((size_t)((b * 2 + DIR) * 8 + h) * 128) * DV + sl * 64 + 16 * w + lr + (size_t)(4 * lg) * DV;
    asm volatile("" : "+v"(so));
#pragma unroll
    for (int dt = 0; dt < 8; ++dt)
#pragma unroll
      for (int r = 0; r < 4; ++r) so[(16 * dt + r) * DV] = S[dt][r];
  }
}

template <int KIND, int DIR>
__device__ __forceinline__ void scan_phase(const Params& p, unsigned char* lds) {
  constexpr int NSL = (KIND == 1 ? 256 : 128) / 64;
  const int ns = 64 * NSL, npr = 256 * NSL;
  const int G = gridDim.x, bid = blockIdx.x;
  int it, step, end = ns + npr;
  if (G > ns) {
    if (bid < ns) { it = bid; step = end; }
    else { it = ns + (bid - ns); step = G - ns; }
  } else { it = bid; step = G; }
  for (; it < end; it += step) scan_item<KIND, DIR>(p, it, lds);
}

template <int KIND>
__device__ __forceinline__ void normgate_phase(const Params& p) {
  const int tid = threadIdx.x, lane = tid & 63, w = tid >> 6;
  bf16_t* R0 = (bf16_t*)p.ws;
  for (int idx = blockIdx.x * 4 + w; idx < 24576 * 8; idx += gridDim.x * 4) {
    const int m = idx >> 3, hh = idx & 7;
    if (KIND == 1) {
      bf16_t* op = R0 + 4 * PLANE_E + (size_t)m * 2048 + hh * 256 + lane * 4;
      const uint2 ov = *(const uint2*)op;
      const uint2 gv = *(const uint2*)(R0 + (size_t)m * 2048 + hh * 256 + lane * 4);
      const float a0 = lo_f(ov.x), a1 = hi_f(ov.x), a2 = lo_f(ov.y), a3 = hi_f(ov.y);
      const float ss = wave_sum(a0 * a0 + a1 * a1 + a2 * a2 + a3 * a3);
      const float rs = rsqrtf(ss * (1.f / 256.f) + 1e-6f);
      *(uint2*)op = make_uint2(pack2(a0 * rs * lo_f(gv.x), a1 * rs * hi_f(gv.x)), pack2(a2 * rs * lo_f(gv.y), a3 * rs * hi_f(gv.y)));
    } else {
      bf16_t* op = R0 + 5 * PLANE_E + (size_t)m * 1024 + hh * 128 + lane * 2;
      const unsigned ov = *(const unsigned*)op;
      const unsigned gv = *(const unsigned*)(R0 + 4 * PLANE_E + (size_t)m * 1024 + hh * 128 + lane * 2);
      const float a0 = lo_f(ov), a1 = hi_f(ov);
      const float ss = wave_sum(a0 * a0 + a1 * a1);
      const float rs = rsqrtf(ss * (1.f / 128.f) + 1e-6f);
      const float2 gn = *(const float2*)(p.in[22] + lane * 2);
      *(unsigned*)op = pack2(a0 * rs * gn.x * lo_f(gv), a1 * rs * gn.y * hi_f(gv));
    }
  }
}

__device__ __forceinline__ void opaque_params(Params& q) {
  asm volatile("" : "+s"(q.out), "+s"(q.ws));
#pragma unroll
  for (int i = 0; i < 23; ++i) asm volatile("" : "+s"(q.in[i]));
}

#ifdef PH_ONLY
#define PHASE(n, call) if (n == PH_ONLY) { const Params& q = p; call; }
#else
#define PHASE(n, call) if (p.ph_lo <= n && n < p.ph_hi) { const Params& q = p; call; if (n + 1 < p.ph_hi) grid.sync(); }
#endif

__global__ void __launch_bounds__(256, 2) mega_fwd(Params p) {
  extern __shared__ __attribute__((aligned(16))) unsigned char lds[];
  cg::grid_group grid = cg::this_grid();
  PHASE(0, phase0(q, lds))
  PHASE(1, post_phase(q, -1, 0, lds))
  PHASE(2, gemm_phase(q, 0, GM_IN_DA, lds))
  PHASE(3, attn_phase(q, 0, lds))
  PHASE(4, gemm_phase(q, 0, GM_OUT, lds))
  PHASE(5, post_phase(q, 0, 1, lds))
  PHASE(6, gemm_phase(q, 1, GM_IN_RET_QKV, lds))
  PHASE(7, (scan_phase<1, 0>(q, lds)))
  PHASE(8, (scan_phase<1, 1>(q, lds)))
  PHASE(9, gemm_phase(q, 1, GM_IN_RET_G, lds))
  PHASE(10, normgate_phase<1>(q))
  PHASE(11, gemm_phase(q, 1, GM_OUT, lds))
  PHASE(12, post_phase(q, 1, 2, lds))
  PHASE(13, gemm_phase(q, 2, GM_IN_HG, lds))
  PHASE(14, (scan_phase<2, 0>(q, lds)))
  PHASE(15, (scan_phase<2, 1>(q, lds)))
  PHASE(16, normgate_phase<2>(q))
  PHASE(17, gemm_phase(q, 2, GM_OUT, lds))
  PHASE(18, post_phase(q, 2, 3, lds))
  PHASE(19, gemm_phase(q, 3, GM_IN_DA, lds))
  PHASE(20, attn_phase(q, 3, lds))
  PHASE(21, gemm_phase(q, 3, GM_OUT, lds))
  PHASE(22, post_phase(q, 3, 4, lds))
}

extern "C" void kernel_launch(void* const* d_in, const int* in_sizes, int n_in, void* d_out, int out_size, void* d_ws, size_t ws_size, hipStream_t stream) {
  static int grid_blocks = 0;
  if (grid_blocks == 0) {
    int dev = 0, cus = 0, per_cu = 0;
    hipGetDevice(&dev);
    hipDeviceGetAttribute(&cus, hipDeviceAttributeMultiprocessorCount, dev);
    hipFuncSetAttribute((const void*)mega_fwd, hipFuncAttributeMaxDynamicSharedMemorySize, LDS_BYTES);
    hipOccupancyMaxActiveBlocksPerMultiprocessor(&per_cu, (const void*)mega_fwd, 256, LDS_BYTES);
    if (per_cu < 1) per_cu = 1;
    if (per_cu > 2) per_cu = 2;
    if (cus < 1) cus = 256;
    grid_blocks = cus * per_cu;
    (void)hipGetLastError();
    if (n_in != 23 || ws_size < WS_NEED) { fprintf(stderr, "kernel_launch: unexpected n_in %d / ws_size %zu (need %zu)\n", n_in, ws_size, (size_t)WS_NEED); }
  }
  Params p{};
  for (int i = 0; i < 23; ++i) p.in[i] = (const float*)d_in[i];
  p.out = (float*)d_out;
  p.ws = (unsigned char*)d_ws;
#if ONE_LAUNCH
  p.ph_lo = 0; p.ph_hi = NPH;
  void* args[] = {&p};
  hipError_t e = hipLaunchCooperativeKernel((const void*)mega_fwd, dim3(grid_blocks), dim3(256), args, LDS_BYTES, stream);
  if (e != hipSuccess) fprintf(stderr, "cooperative launch failed: %s (grid %d)\n", hipGetErrorString(e), grid_blocks);
#else
  for (int ph = 0; ph < NPH; ++ph) {
    p.ph_lo = ph; p.ph_hi = ph + 1;
    hipLaunchKernelGGL(mega_fwd, dim3(grid_blocks), dim3(256), LDS_BYTES, stream, p);
  }
#endif
}
```

```cpp
#include <hip/hip_runtime.h>
#include <hip/hip_cooperative_groups.h>
#include <cstdint>
#include <cstdio>
namespace cg = cooperative_groups;

#ifndef ONE_LAUNCH
#define ONE_LAUNCH 1
#endif

typedef unsigned short bf16_t;
typedef short bf16x8 __attribute__((ext_vector_type(8)));
typedef float f32x4 __attribute__((ext_vector_type(4)));

#define MIB ((size_t)1 << 20)
#define NPH 23
#define LDS_BYTES 74752

#define OFF_WIN  (288 * MIB)
#define OFF_WOUT (300 * MIB)
#define OFF_HP   (304 * MIB)
#define OFF_MISC (320 * MIB)
#define MISC_ROPE 524288
#define WS_NEED  (322 * MIB)
#define PLANE_E  ((size_t)25165824)
#define OUT_YP 0
#define OUT_YS 8388608
#define OUT_CK 25165824
#define OUT_CV 41943040
#define OUT_SR 58720256
#define OUT_SH 75497472

struct Params {
  const float* in[23];
  float* out;
  unsigned char* ws;
  int ph_lo, ph_hi;
};

struct LayerInfo { int kind, slot, IN, WIDTH; const float* w_in; const float* w_out; };

__device__ __forceinline__ LayerInfo layer_info(const Params& p, int l) {
  LayerInfo L;
  if (l == 0)      { L.kind = 0; L.slot = 0; L.IN = 4096; L.WIDTH = 1024; L.w_in = p.in[12]; L.w_out = p.in[13]; }
  else if (l == 1) { L.kind = 1; L.slot = 0; L.IN = 6144; L.WIDTH = 2048; L.w_in = p.in[16]; L.w_out = p.in[17]; }
  else if (l == 2) { L.kind = 2; L.slot = 0; L.IN = 5120; L.WIDTH = 1024; L.w_in = p.in[19]; L.w_out = p.in[20]; }
  else             { L.kind = 0; L.slot = 1; L.IN = 4096; L.WIDTH = 1024; L.w_in = p.in[12] + (size_t)1024 * 4096; L.w_out = p.in[13] + (size_t)1024 * 1024; }
  return L;
}
__device__ __forceinline__ bf16_t* hs_ptr(const Params& p, int l) {
  return l < 3 ? (bf16_t*)(p.out + OUT_SH) : (bf16_t*)(p.ws + 240 * MIB);
}

typedef __bf16 nbf16x2 __attribute__((ext_vector_type(2)));
typedef float f32x2 __attribute__((ext_vector_type(2)));
__device__ __forceinline__ float bf2f(unsigned h) { return __uint_as_float(h << 16); }
__device__ __forceinline__ unsigned pack2(float a, float b) { const f32x2 f = {a, b}; return __builtin_bit_cast(unsigned, __builtin_convertvector(f, nbf16x2)); }
__device__ __forceinline__ float lo_f(unsigned w) { return __uint_as_float(w << 16); }
__device__ __forceinline__ float hi_f(unsigned w) { return __uint_as_float(w & 0xffff0000u); }
__device__ __forceinline__ float silu_f(float x) { return x / (1.f + __expf(-x)); }
__device__ __forceinline__ float wave_sum(float v) {
#pragma unroll
  for (int o = 32; o > 0; o >>= 1) v += __shfl_xor(v, o);
  return v;
}
#define MFMA(a, b, c) __builtin_amdgcn_mfma_f32_16x16x32_bf16((a), (b), (c), 0, 0, 0)

__device__ __forceinline__ void convT_tile(const float* __restrict__ src, int src_ld, bf16_t* __restrict__ dst, int dst_ld, unsigned char* lds) {
  float* t = (float*)lds;
  const int tid = threadIdx.x;
  const int kr = tid >> 4, nc = (tid & 15) * 4;
#pragma unroll
  for (int j = 0; j < 4; ++j) {
    const float4 v = *(const float4*)(src + (size_t)(kr + 16 * j) * src_ld + nc);
    float* tp = t + (kr + 16 * j) * 65 + nc;
    tp[0] = v.x; tp[1] = v.y; tp[2] = v.z; tp[3] = v.w;
  }
  __syncthreads();
  const int n = tid >> 2, kc = (tid & 3) * 16;
  unsigned w[8];
#pragma unroll
  for (int i = 0; i < 8; ++i) w[i] = pack2(t[(kc + 2 * i) * 65 + n], t[(kc + 2 * i + 1) * 65 + n]);
  uint4* d = (uint4*)(dst + (size_t)n * dst_ld + kc);
  d[0] = make_uint4(w[0], w[1], w[2], w[3]);
  d[1] = make_uint4(w[4], w[5], w[6], w[7]);
  __syncthreads();
}

__device__ __forceinline__ int conv_weights_count(const Params& p, int l) {
  const LayerInfo L = layer_info(p, l);
  return (L.IN / 64) * 16 + (L.WIDTH / 64) * 16;
}
__device__ __forceinline__ void conv_weights_item(const Params& p, int l, int it, unsigned char* lds) {
  const LayerInfo L = layer_info(p, l);
  const int nin = (L.IN / 64) * 16;
  if (it < nin) {
    const int kt = it & 15, nt = it >> 4;
    convT_tile(L.w_in + (size_t)(kt * 64) * L.IN + nt * 64, L.IN, (bf16_t*)(p.ws + OFF_WIN) + (size_t)(nt * 64) * 1024 + kt * 64, 1024, lds);
  } else {
    const int it2 = it - nin, nkt = L.WIDTH / 64;
    const int kt = it2 % nkt, nt = it2 / nkt;
    convT_tile(L.w_out + (size_t)(kt * 64) * 1024 + nt * 64, 1024, (bf16_t*)(p.ws + OFF_WOUT) + (size_t)(nt * 64) * L.WIDTH + kt * 64, L.WIDTH, lds);
  }
}

__device__ __forceinline__ void mod_item(const Params& p, int it, unsigned char* lds) {
  float* ssilu = (float*)lds;
  float* red = ssilu + 9 * 1024;
  const int tid = threadIdx.x;
  const int l = it / 48, col0 = (it % 48) * 64;
  for (int i = tid; i < 9 * 1024; i += 256) {
    const int v = i >> 10, k = i & 1023;
    const float x = (v == 0) ? p.in[7][k] : p.in[6][(v - 1) * 1024 + k];
    ssilu[i] = silu_f(x);
  }
  __syncthreads();
  const int col = tid & 63, kq = tid >> 6;
  const float* w = p.in[8] + (size_t)l * 1024 * 3072 + col0 + col;
  float acc[9];
#pragma unroll
  for (int v = 0; v < 9; ++v) acc[v] = 0.f;
  for (int k = kq * 256; k < kq * 256 + 256; ++k) {
    const float wv = w[(size_t)k * 3072];
#pragma unroll
    for (int v = 0; v < 9; ++v) acc[v] += ssilu[v * 1024 + k] * wv;
  }
#pragma unroll
  for (int v = 0; v < 9; ++v) red[(kq * 9 + v) * 64 + col] = acc[v];
  __syncthreads();
  float* mod = (float*)(p.ws + OFF_MISC);
  for (int i = tid; i < 9 * 64; i += 256) {
    const int v = i >> 6, cc = i & 63;
    const float s = red[(0 * 9 + v) * 64 + cc] + red[(1 * 9 + v) * 64 + cc] + red[(2 * 9 + v) * 64 + cc] + red[(3 * 9 + v) * 64 + cc];
    mod[(size_t)(l * 9 + v) * 3072 + col0 + cc] = s + p.in[9][l * 3072 + col0 + cc];
  }
  __syncthreads();
}

__device__ __forceinline__ void rope_item(const Params& p, int it) {
  const int idx = it * 256 + threadIdx.x;
  const int t = idx >> 5, pp = idx & 31;
  const int pos = pp < 16 ? (t >> 6) : (t & 63);
  const float inv = exp2f(-(float)(pp & 15) * (13.287712379549449f / 16.f));
  const float ang = (float)pos * inv;
  const double a = (double)ang;
  const double r = a - 6.283185307179586 * rint(a * 0.15915494309189535);
  const float rf = (float)r;
  float2* tab = (float2*)(p.ws + OFF_MISC + MISC_ROPE);
  tab[idx] = make_float2(__cosf(rf), __sinf(rf));
}

__device__ __forceinline__ void phase0(const Params& p, unsigned char* lds) {
  const int nw = conv_weights_count(p, 0);
  const int total = 192 + 256 + nw;
  for (int it = blockIdx.x; it < total; it += gridDim.x) {
    if (it < 192) mod_item(p, it, lds);
    else if (it < 448) rope_item(p, it - 192);
    else conv_weights_item(p, 0, it - 448, lds);
  }
}

__device__ __forceinline__ void post_phase(const Params& p, int lprev, int lnext, unsigned char* lds, const bool dry) {
  const int tid = threadIdx.x, lane = tid & 63, w = tid >> 6;
  const float* mod = (const float*)(p.ws + OFF_MISC);
  const float* Y = nullptr;
  if (lprev >= 0) {
    const int kind = layer_info(p, lprev).kind;
    Y = (const float*)(p.ws + (kind == 1 ? 96 * MIB : 0));
  }
  bf16_t* hp = (bf16_t*)(p.ws + OFF_HP);
  bf16_t* hs = lnext < 4 ? hs_ptr(p, lnext) : nullptr;
  for (int row = blockIdx.x * 4 + w; row < 24576; row += gridDim.x * 4) {
    const int mv = row < 8192 ? 0 : 1 + ((row - 8192) >> 11);
    const float* xs = (lprev <= 0) ? (row < 8192 ? p.in[0] + (size_t)row * 1024 : p.in[1] + (size_t)(row - 8192) * 1024) : p.out + (size_t)row * 1024;
    float4 x[4];
#pragma unroll
    for (int j = 0; j < 4; ++j) x[j] = *(const float4*)(xs + lane * 4 + 256 * j);
    if (lprev >= 0) {
      float4 y[4];
      float ss = 0.f;
#pragma unroll
      for (int j = 0; j < 4; ++j) { y[j] = *(const float4*)(Y + (size_t)row * 1024 + lane * 4 + 256 * j); ss += y[j].x * y[j].x + y[j].y * y[j].y + y[j].z * y[j].z + y[j].w * y[j].w; }
      ss = wave_sum(ss);
      const float rstd = rsqrtf(ss * (1.f / 1024.f) + 1e-6f);
      const float* ga = mod + (size_t)(lprev * 9 + mv) * 3072 + 2048;
      const float* gp = p.in[11] + lprev * 1024;
#pragma unroll
      for (int j = 0; j < 4; ++j) {
        const int c = lane * 4 + 256 * j;
        const float4 g4 = *(const float4*)(ga + c), p4 = *(const float4*)(gp + c);
        x[j].x += g4.x * (y[j].x * rstd * p4.x); x[j].y += g4.y * (y[j].y * rstd * p4.y);
        x[j].z += g4.z * (y[j].z * rstd * p4.z); x[j].w += g4.w * (y[j].w * rstd * p4.w);
        if (!dry) *(float4*)(p.out + (size_t)row * 1024 + c) = x[j];
      }
    }
    if (lnext < 4) {
      float ss = 0.f;
#pragma unroll
      for (int j = 0; j < 4; ++j) ss += x[j].x * x[j].x + x[j].y * x[j].y + x[j].z * x[j].z + x[j].w * x[j].w;
      ss = wave_sum(ss);
      const float rstd = rsqrtf(ss * (1.f / 1024.f) + 1e-6f);
      const float* sh = mod + (size_t)(lnext * 9 + mv) * 3072;
      const float* sc = sh + 1024;
      const float* gp = p.in[10] + lnext * 1024;
      bf16_t* hd = row < 8192 ? hp + (size_t)row * 1024 : hs + (size_t)(row - 8192) * 1024;
#pragma unroll
      for (int j = 0; j < 4; ++j) {
        const int c = lane * 4 + 256 * j;
        const float4 s4 = *(const float4*)(sh + c), c4 = *(const float4*)(sc + c), p4 = *(const float4*)(gp + c);
        const float h0 = x[j].x * rstd * p4.x * (1.f + c4.x) + s4.x, h1 = x[j].y * rstd * p4.y * (1.f + c4.y) + s4.y;
        const float h2 = x[j].z * rstd * p4.z * (1.f + c4.z) + s4.z, h3 = x[j].w * rstd * p4.w * (1.f + c4.w) + s4.w;
        *(uint2*)(hd + c) = make_uint2(pack2(h0, h1), pack2(h2, h3));
      }
    }
  }
  if (lprev >= 0 && lnext < 4) {
    const int nw = conv_weights_count(p, lnext);
    for (int it = blockIdx.x; it < nw; it += gridDim.x) conv_weights_item(p, lnext, it, lds);
  }
}

#define LAS __attribute__((address_space(3)))
template <bool SWAP>
__device__ __forceinline__ void gemm_tile_compute(const bf16_t* __restrict__ Ag, const bf16_t* __restrict__ Bg, int K, unsigned char* lds, f32x4 (&acc)[4][4]) {
  const int tid = threadIdx.x, lane = tid & 63, wid = __builtin_amdgcn_readfirstlane(tid >> 6), wm = wid >> 1, wn = wid & 1;
  const int lr = lane & 15, lg = lane >> 4;
  LAS unsigned char* l3 = (LAS unsigned char*)lds;
  int goff[4];
#pragma unroll
  for (int j = 0; j < 4; ++j) {
    const int row = wid * 32 + 8 * j + (lane >> 3);
    goff[j] = row * K + (((lane & 7) ^ ((row >> 1) & 7)) << 3);
  }
#pragma unroll
  for (int mi = 0; mi < 4; ++mi)
#pragma unroll
    for (int ni = 0; ni < 4; ++ni) acc[mi][ni] = (f32x4){0.f, 0.f, 0.f, 0.f};
#define GEMM_STAGE(s, k0)                                                                                                        \
  {                                                                                                                              \
    _Pragma("unroll") for (int j = 0; j < 4; ++j) {                                                                              \
      __builtin_amdgcn_global_load_lds((const unsigned*)(Ag + goff[j] + (k0)), (LAS unsigned*)(l3 + (s) * 32768 + (wid * 4 + j) * 1024), 16, 0, 0);          \
      __builtin_amdgcn_global_load_lds((const unsigned*)(Bg + goff[j] + (k0)), (LAS unsigned*)(l3 + (s) * 32768 + 16384 + (wid * 4 + j) * 1024), 16, 0, 0);  \
    }                                                                                                                            \
  }
  GEMM_STAGE(0, 0);
  asm volatile("s_waitcnt vmcnt(0)" ::: "memory");
  __syncthreads();
  const int nk = K >> 6;
  const int x0 = lg ^ ((lr >> 1) & 7);
  const int aoff0 = (wm * 64 + lr) * 128 + x0 * 16, aoff1 = (wm * 64 + lr) * 128 + (x0 ^ 4) * 16;
  const int boff0 = 16384 + (wn * 64 + lr) * 128 + x0 * 16, boff1 = 16384 + (wn * 64 + lr) * 128 + (x0 ^ 4) * 16;
  for (int kt = 0; kt < nk; ++kt) {
    if (kt + 1 < nk) GEMM_STAGE((kt + 1) & 1, (kt + 1) * 64);
    const unsigned char* st = lds + (kt & 1) * 32768;
#pragma unroll
    for (int kk = 0; kk < 2; ++kk) {
      bf16x8 af[4], bfr[4];
#pragma unroll
      for (int mi = 0; mi < 4; ++mi) af[mi] = *(const bf16x8*)(st + (kk ? aoff1 : aoff0) + mi * 2048);
#pragma unroll
      for (int ni = 0; ni < 4; ++ni) bfr[ni] = *(const bf16x8*)(st + (kk ? boff1 : boff0) + ni * 2048);
#pragma unroll
      for (int mi = 0; mi < 4; ++mi)
#pragma unroll
        for (int ni = 0; ni < 4; ++ni)
          acc[mi][ni] = SWAP ? MFMA(bfr[ni], af[mi], acc[mi][ni]) : MFMA(af[mi], bfr[ni], acc[mi][ni]);
    }
    asm volatile("s_waitcnt vmcnt(0)" ::: "memory");
    __syncthreads();
  }
#undef GEMM_STAGE
}

enum { GM_IN_DA = 0, GM_IN_RET_QKV = 1, GM_IN_RET_G = 2, GM_IN_HG = 3, GM_OUT = 4 };

__device__ __forceinline__ void epi_swapped(const Params& p, int mode, int slot, int ykind, int m, int n, f32x4 v) {
  bf16_t* R0 = (bf16_t*)p.ws;
  if (mode == GM_OUT) {
    float* Y = (float*)(p.ws + (ykind == 1 ? 96 * MIB : 0));
    *(f32x4*)(Y + (size_t)m * 1024 + n) = v;
  } else if (mode == GM_IN_DA) {
    const bool smp = m >= 8192;
    const int ms = m - 8192;
    const int b = smp ? (ms >> 11) : (m >> 8), t = smp ? (ms & 2047) : (m & 255);
    if (n < 2048) {
      if (smp) {
        const float4 cs = *(const float4*)((const float*)(p.ws + OFF_MISC + MISC_ROPE) + (size_t)(t * 32 + ((n & 63) >> 1)) * 2);
        const float a0 = v[0] * cs.x - v[1] * cs.y, a1 = v[0] * cs.y + v[1] * cs.x;
        const float a2 = v[2] * cs.z - v[3] * cs.w, a3 = v[2] * cs.w + v[3] * cs.z;
        v = (f32x4){a0, a1, a2, a3};
      }
      if (n < 1024) {
        *(uint2*)(R0 + (size_t)m * 1024 + n) = make_uint2(pack2(v[0] * 0.125f, v[1] * 0.125f), pack2(v[2] * 0.125f, v[3] * 0.125f));
      } else {
        const int c = n - 1024;
        const uint2 pk = make_uint2(pack2(v[0], v[1]), pack2(v[2], v[3]));
        if (smp) {
          *(uint2*)(R0 + 64 * MIB / 2 + ((size_t)b * 2560 + t) * 1024 + c) = pk;
        } else {
          *(f32x4*)(p.out + OUT_CK + ((size_t)((b * 2 + slot) * 256 + t)) * 1024 + c) = v;
          *(uint2*)(R0 + 48 * MIB / 2 + (size_t)m * 1024 + c) = pk;
        }
      }
    } else {
      *(uint2*)(R0 + 160 * MIB / 2 + (size_t)m * 1024 + (n - 3072)) = make_uint2(pack2(silu_f(v[0]), silu_f(v[1])), pack2(silu_f(v[2]), silu_f(v[3])));
    }
  } else if (mode == GM_IN_RET_QKV) {
    if (n < 1024) *(uint2*)(R0 + (size_t)m * 1024 + n) = make_uint2(pack2(v[0], v[1]), pack2(v[2], v[3]));
    else if (n < 2048) { const float s = 0.08838834764831845f; *(uint2*)(R0 + PLANE_E + (size_t)m * 1024 + (n - 1024)) = make_uint2(pack2(v[0] * s, v[1] * s), pack2(v[2] * s, v[3] * s)); }
    else *(uint2*)(R0 + 2 * PLANE_E + (size_t)m * 2048 + (n - 2048)) = make_uint2(pack2(v[0], v[1]), pack2(v[2], v[3]));
  } else if (mode == GM_IN_RET_G) {
    *(uint2*)(R0 + (size_t)m * 2048 + n) = make_uint2(pack2(silu_f(v[0]), silu_f(v[1])), pack2(silu_f(v[2]), silu_f(v[3])));
  } else {
    if (n < 1024 || n >= 4096) v = (f32x4){silu_f(v[0]), silu_f(v[1]), silu_f(v[2]), silu_f(v[3])};
    *(uint2*)(R0 + (size_t)(n >> 10) * PLANE_E + (size_t)m * 1024 + (n & 1023)) = make_uint2(pack2(v[0], v[1]), pack2(v[2], v[3]));
  }
}

__device__ __forceinline__ void epi_da_v(const Params& p, int slot, int m, int n, f32x4 v) {
  bf16_t* R0 = (bf16_t*)p.ws;
  const int c = n - 2048, hh = c >> 7, e = c & 127;
  const uint2 pk = make_uint2(pack2(v[0], v[1]), pack2(v[2], v[3]));
  if (m >= 8192) {
    const int ms = m - 8192, b = ms >> 11, t = ms & 2047;
    *(uint2*)(R0 + 120 * MIB / 2 + ((size_t)((b * 8 + hh) * 128 + e)) * 2560 + t) = pk;
  } else {
    const int b = m >> 8, t = m & 255;
    float* o = p.out + OUT_CV + ((size_t)((b * 2 + slot) * 256 + t)) * 1024 + c;
    o[0] = v[0]; o[1024] = v[1]; o[2048] = v[2]; o[3072] = v[3];
    *(uint2*)(R0 + 104 * MIB / 2 + ((size_t)((b * 8 + hh) * 128 + e)) * 256 + t) = pk;
  }
}

__device__ __forceinline__ void gemm_phase(const Params& p, int l, int mode, unsigned char* lds) {
  const LayerInfo L = layer_info(p, l);
  bf16_t* R0 = (bf16_t*)p.ws;
  const bf16_t *Ap, *As, *Bt;
  int K, N;
  if (mode == GM_OUT) {
    K = L.WIDTH; N = 1024; Bt = (const bf16_t*)(p.ws + OFF_WOUT);
    const bf16_t* base = R0 + (L.kind == 0 ? 160 * MIB / 2 : (L.kind == 1 ? 4 * PLANE_E : 5 * PLANE_E));
    Ap = base; As = base + (size_t)8192 * K;
  } else {
    K = 1024; Ap = (const bf16_t*)(p.ws + OFF_HP); As = hs_ptr(p, l);
    Bt = (const bf16_t*)(p.ws + OFF_WIN) + (mode == GM_IN_RET_G ? (size_t)4096 * 1024 : 0);
    N = (mode == GM_IN_DA || mode == GM_IN_RET_QKV) ? 4096 : (mode == GM_IN_RET_G ? 2048 : 5120);
  }
  const int ntn = N >> 7, ntiles = 192 * ntn;
  const int extra = (mode == GM_IN_DA) ? 3072 : 0;
  const int tid = threadIdx.x, lane = tid & 63, wid = tid >> 6, wm = wid >> 1, wn = wid & 1, lr = lane & 15, lg = lane >> 4;
  const int G = gridDim.x;
  const bool swz = (G & 7) == 0;
  const int nbx = G >> 3, xcd = blockIdx.x & 7, jx = blockIdx.x >> 3, snn = ntn >> 3;
  for (int it0 = blockIdx.x, rnd = 0; it0 < ntiles + extra; it0 += G, ++rnd) {
    int it = it0;
    if (swz && it0 < ntiles) {
      const int q = jx + nbx * rnd;
      const int st = xcd + 8 * (q >> 6), tin = q & 63;
      const int smt = st / snn, snt = st - smt * snn;
      it = (smt * 8 + (tin >> 3)) * ntn + snt * 8 + (tin & 7);
    }
    if (it < ntiles) {
      const int mt = it / ntn, nt = it - mt * ntn;
      const int m0 = mt * 128, n0 = nt * 128;
      const bf16_t* A = m0 < 8192 ? Ap + (size_t)m0 * K : As + (size_t)(m0 - 8192) * K;
      const bf16_t* B = Bt + (size_t)n0 * K;
      f32x4 acc[4][4];
      if (mode == GM_IN_DA && n0 >= 2048 && n0 < 3072) {
        gemm_tile_compute<false>(A, B, K, lds, acc);
#pragma unroll
        for (int mi = 0; mi < 4; ++mi)
#pragma unroll
          for (int ni = 0; ni < 4; ++ni)
            epi_da_v(p, L.slot, m0 + wm * 64 + mi * 16 + 4 * lg, n0 + wn * 64 + ni * 16 + lr, acc[mi][ni]);
      } else {
        gemm_tile_compute<true>(A, B, K, lds, acc);
#pragma unroll
        for (int mi = 0; mi < 4; ++mi)
#pragma unroll
          for (int ni = 0; ni < 4; ++ni)
            epi_swapped(p, mode, L.slot, L.kind, m0 + wm * 64 + mi * 16 + lr, n0 + wn * 64 + ni * 16 + 4 * lg, acc[mi][ni]);
      }
    } else {
      const int ci = it - ntiles;
      if (ci < 2048) {
        const int idx = (ci * 256 + tid) * 8;
        const int b = idx >> 19, rem = idx & 524287, tp = rem >> 10, c = rem & 1023;
        const float* src = p.in[2] + ((size_t)((b * 2 + L.slot) * 512 + tp)) * 1024 + c;
        const float4 u0 = *(const float4*)src, u1 = *(const float4*)(src + 4);
        *(uint4*)(R0 + 64 * MIB / 2 + ((size_t)b * 2560 + 2048 + tp) * 1024 + c) = make_uint4(pack2(u0.x, u0.y), pack2(u0.z, u0.w), pack2(u1.x, u1.y), pack2(u1.z, u1.w));
      } else {
        const int i2 = ci - 2048;
        const int b = i2 >> 7, hh = (i2 >> 4) & 7, tt = (i2 >> 1) & 7, et = i2 & 1;
        convT_tile(p.in[3] + ((size_t)((b * 2 + L.slot) * 512 + tt * 64)) * 1024 + hh * 128 + et * 64, 1024,
                   R0 + 120 * MIB / 2 + ((size_t)((b * 8 + hh) * 128 + et * 64)) * 2560 + 2048 + tt * 64, 2560, lds);
      }
    }
  }
}

__device__ __forceinline__ void attn_phase(const Params& p, int l, unsigned char* lds, const bool dry) {
  const int slot = l == 3 ? 1 : 0;
  const float lam_init = 0.8f - 0.6f * expf(-0.3f * (float)l);
  const int tid = threadIdx.x, lane = tid & 63, w = tid >> 6, lr = lane & 15, lg = lane >> 4;
  float lam;
  {
    const float* lf = p.in[14] + slot * 256;
    const float a = wave_sum(lf[lane] * lf[64 + lane]);
    const float b2 = wave_sum(lf[128 + lane] * lf[192 + lane]);
    lam = expf(a) - expf(b2) + lam_init;
  }
  bf16_t* R0 = (bf16_t*)p.ws;
  const float* subg = p.in[15] + slot * 128;
  for (int item = blockIdx.x; item < 3072; item += gridDim.x) {
    int grp, b, h, qt;
    if (item < 2048) { grp = 1; b = item >> 8; h = (item >> 5) & 7; qt = item & 31; }
    else { const int i2 = item - 2048; grp = 0; b = i2 >> 5; h = (i2 >> 2) & 7; qt = i2 & 3; }
    const int nkeys = grp ? 2560 : 256, ntile = nkeys >> 6;
    const int mq = (grp ? 8192 + b * 2048 : b * 256) + qt * 64 + w * 16 + lr;
    const bf16_t* Kg = grp ? R0 + 64 * MIB / 2 + (size_t)b * 2560 * 1024 + h * 128 : R0 + 48 * MIB / 2 + (size_t)b * 256 * 1024 + h * 128;
    const bf16_t* Vg = grp ? R0 + 120 * MIB / 2 + (size_t)(b * 8 + h) * 128 * 2560 : R0 + 104 * MIB / 2 + (size_t)(b * 8 + h) * 128 * 256;
    bf16x8 qf[2][2];
#pragma unroll
    for (int sub = 0; sub < 2; ++sub)
#pragma unroll
      for (int ks = 0; ks < 2; ++ks) qf[sub][ks] = *(const bf16x8*)(R0 + (size_t)mq * 1024 + h * 128 + sub * 64 + ks * 32 + lg * 8);
    LAS unsigned char* l3 = (LAS unsigned char*)lds;
    const int wu = __builtin_amdgcn_readfirstlane(w);
    int koff[4], voff[4];
#pragma unroll
    for (int j = 0; j < 4; ++j) {
      const int kr = (wu * 4 + j) * 4 + (lane >> 4);
      koff[j] = kr * 1024 + (((lane & 15) ^ (kr & 15)) << 3);
      const int er = (wu * 4 + j) * 8 + (lane >> 3);
      voff[j] = er * nkeys + (((lane & 7) ^ ((er >> 1) & 7)) << 3);
    }
#define ATT_STAGE_K(s, key0)                                                                                  \
  {                                                                                                           \
    _Pragma("unroll") for (int j = 0; j < 4; ++j)                                                             \
      __builtin_amdgcn_global_load_lds((const unsigned*)(Kg + (size_t)(key0) * 1024 + koff[j]), (LAS unsigned*)(l3 + (s) * 32768 + (wu * 4 + j) * 1024), 16, 0, 0); \
  }
#define ATT_STAGE_V(s, key0)                                                                                  \
  {                                                                                                           \
    _Pragma("unroll") for (int j = 0; j < 4; ++j)                                                             \
      __builtin_amdgcn_global_load_lds((const unsigned*)(Vg + (key0) + voff[j]), (LAS unsigned*)(l3 + (s) * 32768 + 16384 + (wu * 4 + j) * 1024), 16, 0, 0); \
  }
    const int xl = lg ^ lr;
    const int vsw = (lr >> 1) & 7;
    const int vlo = lr * 128 + ((((lg >> 1)) ^ vsw) << 4) + (lg & 1) * 8;
    float mx[2] = {-1e30f, -1e30f}, ls[2] = {0.f, 0.f};
    ATT_STAGE_K(0, 0);
    asm volatile("s_waitcnt vmcnt(0)" ::: "memory");
    __syncthreads();
    for (int kt = 0; kt < ntile; ++kt) {
      if (kt + 1 < ntile) ATT_STAGE_K((kt + 1) & 1, (kt + 1) * 64);
      const unsigned char* ks_ = lds + (kt & 1) * 32768;
#pragma unroll
      for (int sub = 0; sub < 2; ++sub) {
        f32x4 s[4];
#pragma unroll
        for (int nt = 0; nt < 4; ++nt) {
          s[nt] = (f32x4){0.f, 0.f, 0.f, 0.f};
#pragma unroll
          for (int ks = 0; ks < 2; ++ks) {
            const bf16x8 kf = *(const bf16x8*)(ks_ + (16 * nt + lr) * 256 + ((xl ^ (sub * 8 + ks * 4)) << 4));
            s[nt] = MFMA(kf, qf[sub][ks], s[nt]);
          }
        }
        float tm = s[0][0];
#pragma unroll
        for (int nt = 0; nt < 4; ++nt)
#pragma unroll
          for (int r = 0; r < 4; ++r) tm = fmaxf(tm, s[nt][r]);
        tm = fmaxf(tm, __shfl_xor(tm, 16));
        tm = fmaxf(tm, __shfl_xor(tm, 32));
        const float mn = fmaxf(mx[sub], tm);
        float acc = 0.f;
#pragma unroll
        for (int nt = 0; nt < 4; ++nt)
#pragma unroll
          for (int r = 0; r < 4; ++r) acc += __expf(s[nt][r] - mn);
        ls[sub] = ls[sub] * __expf(mx[sub] - mn) + acc;
        mx[sub] = mn;
      }
      asm volatile("s_waitcnt vmcnt(0)" ::: "memory");
      __syncthreads();
    }
    float il[2];
#pragma unroll
    for (int sub = 0; sub < 2; ++sub) {
      float t = ls[sub];
      t += __shfl_xor(t, 16);
      t += __shfl_xor(t, 32);
      il[sub] = 1.f / t;
    }
    const float c1 = il[0], c2 = lam * il[1];
    f32x4 o[8];
#pragma unroll
    for (int et = 0; et < 8; ++et) o[et] = (f32x4){0.f, 0.f, 0.f, 0.f};
    ATT_STAGE_K(0, 0);
    ATT_STAGE_V(0, 0);
    asm volatile("s_waitcnt vmcnt(0)" ::: "memory");
    __syncthreads();
    for (int kt = 0; kt < ntile; ++kt) {
      if (kt + 1 < ntile) { ATT_STAGE_K((kt + 1) & 1, (kt + 1) * 64); ATT_STAGE_V((kt + 1) & 1, (kt + 1) * 64); }
      const unsigned char* ks_ = lds + (kt & 1) * 32768;
      const unsigned char* vs_ = ks_ + 16384;
#pragma unroll
      for (int k2 = 0; k2 < 2; ++k2) {
        f32x4 s[2][2];
#pragma unroll
        for (int sub = 0; sub < 2; ++sub)
#pragma unroll
          for (int nn = 0; nn < 2; ++nn) {
            s[sub][nn] = (f32x4){0.f, 0.f, 0.f, 0.f};
#pragma unroll
            for (int ks = 0; ks < 2; ++ks) {
              const bf16x8 kf = *(const bf16x8*)(ks_ + (16 * (2 * k2 + nn) + lr) * 256 + ((xl ^ (sub * 8 + ks * 4)) << 4));
              s[sub][nn] = MFMA(kf, qf[sub][ks], s[sub][nn]);
            }
          }
        unsigned pw[4];
#pragma unroll
        for (int nn = 0; nn < 2; ++nn) {
          float a[4];
#pragma unroll
          for (int r = 0; r < 4; ++r) a[r] = __expf(s[0][nn][r] - mx[0]) * c1 - __expf(s[1][nn][r] - mx[1]) * c2;
          pw[nn * 2] = pack2(a[0], a[1]);
          pw[nn * 2 + 1] = pack2(a[2], a[3]);
        }
        bf16x8 pf;
        {
          union { unsigned u[4]; bf16x8 v; } cv;
          cv.u[0] = pw[0]; cv.u[1] = pw[1]; cv.u[2] = pw[2]; cv.u[3] = pw[3];
          pf = cv.v;
        }
#pragma unroll
        for (int et = 0; et < 8; ++et) {
          const unsigned char* va = vs_ + et * 2048 + (vlo ^ (k2 << 6));
          const uint2 lo = *(const uint2*)va, hi = *(const uint2*)(vs_ + et * 2048 + (vlo ^ (k2 << 6) ^ 32));
          union { unsigned u[4]; bf16x8 v; } cv;
          cv.u[0] = lo.x; cv.u[1] = lo.y; cv.u[2] = hi.x; cv.u[3] = hi.y;
          o[et] = MFMA(cv.v, pf, o[et]);
        }
      }
      asm volatile("s_waitcnt vmcnt(0)" ::: "memory");
      __syncthreads();
    }
#undef ATT_STAGE_K
#undef ATT_STAGE_V
    float ss = 0.f;
#pragma unroll
    for (int et = 0; et < 8; ++et)
#pragma unroll
      for (int r = 0; r < 4; ++r) ss += o[et][r] * o[et][r];
    ss += __shfl_xor(ss, 16);
    ss += __shfl_xor(ss, 32);
    const float rs = rsqrtf(ss * (1.f / 128.f) + 1e-6f) * (1.f - lam_init);
    bf16_t* gp = R0 + 160 * MIB / 2 + (size_t)mq * 1024 + h * 128;
#pragma unroll
    for (int et = 0; et < 8; ++et) {
      const int e0 = 16 * et + 4 * lg;
      const uint2 g = *(const uint2*)(gp + e0);
      const float4 sg = *(const float4*)(subg + e0);
      const float v0 = o[et][0] * rs * sg.x * lo_f(g.x), v1 = o[et][1] * rs * sg.y * hi_f(g.x);
      const float v2 = o[et][2] * rs * sg.z * lo_f(g.y), v3 = o[et][3] * rs * sg.w * hi_f(g.y);
      if (!dry) *(uint2*)(gp + e0) = make_uint2(pack2(v0, v1), pack2(v2, v3));
    }
  }
}

template <int KIND, int DIR>
__device__ __forceinline__ void scan_item(const Params& p, int item, unsigned char* lds, const bool dry) {
  constexpr int DV = KIND == 1 ? 256 : 128, NSL = DV / 64, LDV = KIND == 1 ? 2048 : 1024;
  const int tid = threadIdx.x, lane = tid & 63, w = tid >> 6, lr = lane & 15, lg = lane >> 4;
  int grp, b, h, sl;
  {
    int it = item;
    if (it < 64 * NSL) grp = 1; else { grp = 0; it -= 64 * NSL; }
    sl = it % NSL; h = (it / NSL) & 7; b = it / (NSL * 8);
  }
  const int T = grp ? 2048 : 256, nch = T >> 6;
  const size_t mbase = grp ? (size_t)8192 + (size_t)b * 2048 : (size_t)b * 256;
  bf16_t* R0 = (bf16_t*)p.ws;
  const bf16_t* Qg = R0 + mbase * 1024 + h * 128;
  const bf16_t* Kg = R0 + (KIND == 1 ? PLANE_E : (DIR ? 2 * PLANE_E : PLANE_E)) + mbase * 1024 + h * 128;
  const bf16_t* Vg = R0 + (KIND == 1 ? 2 * PLANE_E : 3 * PLANE_E) + mbase * LDV + h * DV + sl * 64;
  bf16_t* Og = R0 + (KIND == 1 ? 4 * PLANE_E : 5 * PLANE_E) + mbase * LDV + h * DV + sl * 64;
  unsigned char* Qs = lds;
  unsigned char* X = lds + 17408;
  unsigned char* Vt = lds + 35840;
  unsigned char* StS = lds + 45056;
  unsigned char* Pm = lds + 62464;
  float* xch = (float*)(lds + 71680);
  float* blA = xch + 512;
  float* erA = xch + 640;
  const int dp = tid & 63, tq = tid >> 6, r0 = tq * 16, d0 = dp * 2;
  float cst0, cst1;
  if (KIND == 1) { cst0 = cst1 = log1pf(-expf(p.in[18][DIR * 8 + h])); }
  else {
    const float* lbp = p.in[21] + DIR * 4096 + h * 128 + d0;
    {
      const float x0 = lbp[0], x1 = lbp[1024], x2 = lbp[2048], x3 = lbp[3072];
      const float m = fmaxf(fmaxf(x0, x1), fmaxf(x2, x3));
      const float e0 = expf(x0 - m), e1 = expf(x1 - m), e2 = expf(x2 - m), e3 = expf(x3 - m);
      cst0 = (e1 + e2) / (e0 + e1 + e2 + e3);
    }
    {
      const float x0 = lbp[1], x1 = lbp[1025], x2 = lbp[2049], x3 = lbp[3073];
      const float m = fmaxf(fmaxf(x0, x1), fmaxf(x2, x3));
      const float e0 = expf(x0 - m), e1 = expf(x1 - m), e2 = expf(x2 - m), e3 = expf(x3 - m);
      cst1 = (e1 + e2) / (e0 + e1 + e2 + e3);
    }
  }
  f32x4 S[8];
  if (grp) {
    const float* s0 = (KIND == 1 ? p.in[4] : p.in[5]) + ((size_t)((b * 2 + DIR) * 8 + h) * 128) * DV + sl * 64 + 16 * w + lr + (size_t)(4 * lg) * DV;
    asm volatile("" : "+v"(s0));
#pragma unroll
    for (int dt = 0; dt < 8; ++dt)
#pragma unroll
      for (int r = 0; r < 4; ++r) S[dt][r] = s0[(16 * dt + r) * DV];
  } else {
#pragma unroll
    for (int dt = 0; dt < 8; ++dt) S[dt] = (f32x4){0.f, 0.f, 0.f, 0.f};
  }
  unsigned qv[16], kv[16], vv[8];
  const int ve2 = tid & 31, vq = tid >> 5;
  const int qoff = r0 * 512 + dp;
  const int voff = (8 * vq) * (LDV / 2) + ve2;
  const unsigned* Qg32 = (const unsigned*)Qg;
  const unsigned* Kg32 = (const unsigned*)Kg;
  const unsigned* Vg32 = (const unsigned*)Vg;
#define SCAN_ISSUE(c)                                                                                   \
  {                                                                                                     \
    const unsigned* q_ = Qg32 + (size_t)(c) * (64 * 512) + qoff;                                        \
    const unsigned* k_ = Kg32 + (size_t)(c) * (64 * 512) + qoff;                                        \
    const unsigned* v_ = Vg32 + (size_t)(c) * (64 * (LDV / 2)) + voff;                                  \
    asm volatile("" : "+v"(q_), "+v"(k_), "+v"(v_));                                                    \
    _Pragma("unroll") for (int i = 0; i < 16; ++i) { qv[i] = q_[i * 512]; kv[i] = k_[i * 512]; }        \
    _Pragma("unroll") for (int i = 0; i < 8; ++i) vv[i] = v_[i * (LDV / 2)];                            \
  }
  SCAN_ISSUE(DIR ? nch - 1 : 0);
  for (int ci = 0; ci < nch; ++ci) {
    const int c = DIR ? nch - 1 - ci : ci;
    float tot0 = 0.f, tot1 = 0.f;
    if (KIND == 1) { tot0 = tot1 = 16.f * cst0; }
    else {
#pragma unroll
      for (int i = 0; i < 16; ++i) {
        const float s0_ = 1.f / (1.f + __expf(-lo_f(kv[i]))), s1_ = 1.f / (1.f + __expf(-hi_f(kv[i])));
        tot0 += __logf(cst0 + (1.f - cst0) * s0_);
        tot1 += __logf(cst1 + (1.f - cst1) * s1_);
      }
    }
    *(float2*)(xch + tq * 128 + d0) = make_float2(tot0, tot1);
    __syncthreads();
    const float2 t0 = *(const float2*)(xch + d0), t1 = *(const float2*)(xch + 128 + d0), t2 = *(const float2*)(xch + 256 + d0), t3 = *(const float2*)(xch + 384 + d0);
    const float blast0 = (t0.x + t1.x) + (t2.x + t3.x), blast1 = (t0.y + t1.y) + (t2.y + t3.y);
    float ref0, ref1, run0, run1;
    if (DIR == 0) {
      ref0 = t0.x + t1.x; ref1 = t0.y + t1.y;
      run0 = (tq > 0 ? t0.x : 0.f) + (tq > 1 ? t1.x : 0.f) + (tq > 2 ? t2.x : 0.f);
      run1 = (tq > 0 ? t0.y : 0.f) + (tq > 1 ? t1.y : 0.f) + (tq > 2 ? t2.y : 0.f);
    } else {
      ref0 = t2.x + t3.x; ref1 = t2.y + t3.y;
      run0 = (tq < 3 ? t3.x : 0.f) + (tq < 2 ? t2.x : 0.f) + (tq < 1 ? t1.x : 0.f);
      run1 = (tq < 3 ? t3.y : 0.f) + (tq < 2 ? t2.y : 0.f) + (tq < 1 ? t1.y : 0.f);
    }
    unsigned ktp0[8], ktp1[8];
#pragma unroll
    for (int jj = 0; jj < 8; ++jj) {
      const int j = DIR ? 7 - jj : jj;
      float ka[2], kb[2];
#pragma unroll
      for (int hh = 0; hh < 2; ++hh) {
        const int i = 2 * j + (DIR ? 1 - hh : hh);
        float g0, g1, k0, k1;
        if (KIND == 1) { g0 = g1 = cst0; k0 = lo_f(kv[i]); k1 = hi_f(kv[i]); }
        else {
          const float s0_ = 1.f / (1.f + __expf(-lo_f(kv[i]))), s1_ = 1.f / (1.f + __expf(-hi_f(kv[i])));
          g0 = __logf(cst0 + (1.f - cst0) * s0_); g1 = __logf(cst1 + (1.f - cst1) * s1_);
          k0 = (1.f - cst0) * (1.f - s0_); k1 = (1.f - cst1) * (1.f - s1_);
        }
        run0 += g0; run1 += g1;
        *(unsigned*)(Qs + (r0 + i) * 272 + d0 * 2) = pack2(lo_f(qv[i]) * __expf(run0 - ref0), hi_f(qv[i]) * __expf(run1 - ref1));
        *(unsigned*)(X + (r0 + i) * 272 + d0 * 2) = pack2(k0 * __expf(ref0 - run0), k1 * __expf(ref1 - run1));
        ka[i & 1] = k0 * __expf(blast0 - run0);
        kb[i & 1] = k1 * __expf(blast1 - run1);
      }
      ktp0[j] = pack2(ka[0], ka[1]);
      ktp1[j] = pack2(kb[0], kb[1]);
    }
    if (tq == 0) { *(float2*)(blA + d0) = make_float2(__expf(blast0), __expf(blast1)); *(float2*)(erA + d0) = make_float2(__expf(ref0), __expf(ref1)); }
    {
      const unsigned a0 = (vv[0] & 0xffffu) | (vv[1] << 16), a1 = (vv[2] & 0xffffu) | (vv[3] << 16), a2 = (vv[4] & 0xffffu) | (vv[5] << 16), a3 = (vv[6] & 0xffffu) | (vv[7] << 16);
      const unsigned b0 = (vv[0] >> 16) | (vv[1] & 0xffff0000u), b1 = (vv[2] >> 16) | (vv[3] & 0xffff0000u), b2 = (vv[4] >> 16) | (vv[5] & 0xffff0000u), b3 = (vv[6] >> 16) | (vv[7] & 0xffff0000u);
      *(uint4*)(Vt + (2 * ve2) * 144 + vq * 16) = make_uint4(a0, a1, a2, a3);
      *(uint4*)(Vt + (2 * ve2 + 1) * 144 + vq * 16) = make_uint4(b0, b1, b2, b3);
    }
    if (ci + 1 < nch) { SCAN_ISSUE(DIR ? c - 1 : c + 1); }
    __syncthreads();
#pragma unroll
    for (int dt = 0; dt < 8; ++dt) {
      const float4 er4 = *(const float4*)(erA + 16 * dt + 4 * lg);
      *(uint2*)(StS + (16 * w + lr) * 272 + (16 * dt + 4 * lg) * 2) = make_uint2(pack2(S[dt][0] * er4.x, S[dt][1] * er4.y), pack2(S[dt][2] * er4.z, S[dt][3] * er4.w));
    }
    bf16x8 qf[4];
#pragma unroll
    for (int ks = 0; ks < 4; ++ks) qf[ks] = *(const bf16x8*)(Qs + (16 * w + lr) * 272 + ks * 64 + lg * 16);
    uint2 pv[4];
    {
      const int t = 16 * w + lr;
#pragma unroll
      for (int st = 0; st < 4; ++st) {
        f32x4 s = (f32x4){0.f, 0.f, 0.f, 0.f};
#pragma unroll
        for (int ks = 0; ks < 4; ++ks) {
          const bf16x8 kf = *(const bf16x8*)(X + (16 * st + lr) * 272 + ks * 64 + lg * 16);
          s = MFMA(kf, qf[ks], s);
        }
        float v[4];
#pragma unroll
        for (int r = 0; r < 4; ++r) {
          const int si = 16 * st + 4 * lg + r;
          const bool keep = DIR ? (t <= si) : (t >= si);
          v[r] = keep ? s[r] : 0.f;
        }
        pv[st] = make_uint2(pack2(v[0], v[1]), pack2(v[2], v[3]));
      }
    }
    __syncthreads();
#pragma unroll
    for (int st = 0; st < 4; ++st) *(uint2*)(Pm + (16 * w + lr) * 144 + (16 * st + 4 * lg) * 2) = pv[st];
    *(uint4*)(X + d0 * 144 + r0 * 2) = make_uint4(ktp0[0], ktp0[1], ktp0[2], ktp0[3]);
    *(uint4*)(X + d0 * 144 + r0 * 2 + 16) = make_uint4(ktp0[4], ktp0[5], ktp0[6], ktp0[7]);
    *(uint4*)(X + (d0 + 1) * 144 + r0 * 2) = make_uint4(ktp1[0], ktp1[1], ktp1[2], ktp1[3]);
    *(uint4*)(X + (d0 + 1) * 144 + r0 * 2 + 16) = make_uint4(ktp1[4], ktp1[5], ktp1[6], ktp1[7]);
    __syncthreads();
    {
      bf16x8 pf[2];
#pragma unroll
      for (int ks = 0; ks < 2; ++ks) pf[ks] = *(const bf16x8*)(Pm + (16 * w + lr) * 144 + ks * 64 + lg * 16);
#pragma unroll
      for (int et = 0; et < 4; ++et) {
        f32x4 o = (f32x4){0.f, 0.f, 0.f, 0.f};
#pragma unroll
        for (int ks = 0; ks < 2; ++ks) {
          const bf16x8 vf = *(const bf16x8*)(Vt + (16 * et + lr) * 144 + ks * 64 + lg * 16);
          o = MFMA(vf, pf[ks], o);
        }
#pragma unroll
        for (int ks = 0; ks < 4; ++ks) {
          const bf16x8 sf = *(const bf16x8*)(StS + (16 * et + lr) * 272 + ks * 64 + lg * 16);
          o = MFMA(sf, qf[ks], o);
        }
        bf16_t* op = Og + (size_t)(c * 64 + 16 * w + lr) * LDV + 16 * et + 4 * lg;
        if (DIR) {
          const uint2 old = *(const uint2*)op;
          o[0] += lo_f(old.x); o[1] += hi_f(old.x); o[2] += lo_f(old.y); o[3] += hi_f(old.y);
        }
        if (!(DIR && dry)) *(uint2*)op = make_uint2(pack2(o[0], o[1]), pack2(o[2], o[3]));
      }
    }
    {
      bf16x8 vtf[2];
#pragma unroll
      for (int ks = 0; ks < 2; ++ks) vtf[ks] = *(const bf16x8*)(Vt + (16 * w + lr) * 144 + ks * 64 + lg * 16);
#pragma unroll
      for (int dt = 0; dt < 8; ++dt) {
        const float4 bl4 = *(const float4*)(blA + 16 * dt + 4 * lg);
        S[dt][0] *= bl4.x; S[dt][1] *= bl4.y; S[dt][2] *= bl4.z; S[dt][3] *= bl4.w;
#pragma unroll
        for (int ks = 0; ks < 2; ++ks) {
          const bf16x8 kf = *(const bf16x8*)(X + (16 * dt + lr) * 144 + ks * 64 + lg * 16);
          S[dt] = MFMA(kf, vtf[ks], S[dt]);
        }
      }
    }
    __syncthreads();
  }
#undef SCAN_ISSUE
  if (!grp) {
    float* so = p.out + (KIND == 1 ? OUT_SR : OUT_SH) + ((size_t)((b * 2 + DIR) * 8 + h) * 128) * DV + sl * 64 + 16 * w + lr + (size_t)(4 * lg) * DV;
    asm volatile("" : "+v"(so));
#pragma unroll
    for (int dt = 0; dt < 8; ++dt)
#pragma unroll
      for (int r = 0; r < 4; ++r) so[(16 * dt + r) * DV] = S[dt][r];
  }
}

template <int KIND, int DIR>
__device__ __forceinline__ void scan_phase(const Params& p, unsigned char* lds, const bool dry) {
  constexpr int NSL = (KIND == 1 ? 256 : 128) / 64;
  const int ns = 64 * NSL, npr = 256 * NSL;
  const int G = gridDim.x, bid = blockIdx.x;
  int it, step, end = ns + npr;
  if (G > ns) {
    if (bid < ns) { it = bid; step = end; }
    else { it = ns + (bid - ns); step = G - ns; }
  } else { it = bid; step = G; }
  for (; it < end; it += step) scan_item<KIND, DIR>(p, it, lds, dry);
}

template <int KIND>
__device__ __forceinline__ void normgate_phase(const Params& p, const bool dry) {
  const int tid = threadIdx.x, lane = tid & 63, w = tid >> 6;
  bf16_t* R0 = (bf16_t*)p.ws;
  for (int idx = blockIdx.x * 4 + w; idx < 24576 * 8; idx += gridDim.x * 4) {
    const int m = idx >> 3, hh = idx & 7;
    if (KIND == 1) {
      bf16_t* op = R0 + 4 * PLANE_E + (size_t)m * 2048 + hh * 256 + lane * 4;
      const uint2 ov = *(const uint2*)op;
      const uint2 gv = *(const uint2*)(R0 + (size_t)m * 2048 + hh * 256 + lane * 4);
      const float a0 = lo_f(ov.x), a1 = hi_f(ov.x), a2 = lo_f(ov.y), a3 = hi_f(ov.y);
      const float ss = wave_sum(a0 * a0 + a1 * a1 + a2 * a2 + a3 * a3);
      const float rs = rsqrtf(ss * (1.f / 256.f) + 1e-6f);
      if (!dry) *(uint2*)op = make_uint2(pack2(a0 * rs * lo_f(gv.x), a1 * rs * hi_f(gv.x)), pack2(a2 * rs * lo_f(gv.y), a3 * rs * hi_f(gv.y)));
    } else {
      bf16_t* op = R0 + 5 * PLANE_E + (size_t)m * 1024 + hh * 128 + lane * 2;
      const unsigned ov = *(const unsigned*)op;
      const unsigned gv = *(const unsigned*)(R0 + 4 * PLANE_E + (size_t)m * 1024 + hh * 128 + lane * 2);
      const float a0 = lo_f(ov), a1 = hi_f(ov);
      const float ss = wave_sum(a0 * a0 + a1 * a1);
      const float rs = rsqrtf(ss * (1.f / 128.f) + 1e-6f);
      const float2 gn = *(const float2*)(p.in[22] + lane * 2);
      if (!dry) *(unsigned*)op = pack2(a0 * rs * gn.x * lo_f(gv), a1 * rs * gn.y * hi_f(gv));
    }
  }
}

__device__ __forceinline__ void opaque_params(Params& q) {
  asm volatile("" : "+s"(q.out), "+s"(q.ws));
#pragma unroll
  for (int i = 0; i < 23; ++i) asm volatile("" : "+s"(q.in[i]));
}

#if defined(PH_ONLY)
#define PHASE(n, call) if (n == PH_ONLY) { const bool dry = false; call; }
#elif defined(REP_N)
#define PHASE(n, call) if (lo <= n && n < hi) { for (int rep = (n == REP_N ? 0 : 1); rep < 2; ++rep) { const bool dry = (rep == 0); call; if (!(fin && n + 1 == hi && rep == 1)) grid.sync(); } }
#else
#define PHASE(n, call) if (lo <= n && n < hi) { const bool dry = false; call; if (!(fin && n + 1 == hi)) grid.sync(); }
#endif

__device__ __forceinline__ void run_range(const Params& q, int lo, int hi, bool fin, cg::grid_group& grid, unsigned char* lds) {
  PHASE(0, phase0(q, lds))
  PHASE(1, post_phase(q, -1, 0, lds, dry))
  PHASE(2, gemm_phase(q, 0, GM_IN_DA, lds))
  PHASE(3, attn_phase(q, 0, lds, dry))
  PHASE(4, gemm_phase(q, 0, GM_OUT, lds))
  PHASE(5, post_phase(q, 0, 1, lds, dry))
  PHASE(6, gemm_phase(q, 1, GM_IN_RET_QKV, lds))
  PHASE(7, (scan_phase<1, 0>(q, lds, dry)))
  PHASE(8, (scan_phase<1, 1>(q, lds, dry)))
  PHASE(9, gemm_phase(q, 1, GM_IN_RET_G, lds))
  PHASE(10, normgate_phase<1>(q, dry))
  PHASE(11, gemm_phase(q, 1, GM_OUT, lds))
  PHASE(12, post_phase(q, 1, 2, lds, dry))
  PHASE(13, gemm_phase(q, 2, GM_IN_HG, lds))
  PHASE(14, (scan_phase<2, 0>(q, lds, dry)))
  PHASE(15, (scan_phase<2, 1>(q, lds, dry)))
  PHASE(16, normgate_phase<2>(q, dry))
  PHASE(17, gemm_phase(q, 2, GM_OUT, lds))
  PHASE(18, post_phase(q, 2, 3, lds, dry))
  PHASE(19, gemm_phase(q, 3, GM_IN_DA, lds))
  PHASE(20, attn_phase(q, 3, lds, dry))
  PHASE(21, gemm_phase(q, 3, GM_OUT, lds))
  PHASE(22, post_phase(q, 3, 4, lds, dry))
}

__global__ void __launch_bounds__(256, 2) mega_fwd(Params p) {
  extern __shared__ __attribute__((aligned(16))) unsigned char lds[];
  cg::grid_group grid = cg::this_grid();
#if 0
#else
  run_range(p, p.ph_lo, p.ph_hi, true, grid, lds);
#endif
}

extern "C" void kernel_launch(void* const* d_in, const int* in_sizes, int n_in, void* d_out, int out_size, void* d_ws, size_t ws_size, hipStream_t stream) {
  static int grid_blocks = 0;
  if (grid_blocks == 0) {
    int dev = 0, cus = 0, per_cu = 0;
    hipGetDevice(&dev);
    hipDeviceGetAttribute(&cus, hipDeviceAttributeMultiprocessorCount, dev);
    hipFuncSetAttribute((const void*)mega_fwd, hipFuncAttributeMaxDynamicSharedMemorySize, LDS_BYTES);
    hipOccupancyMaxActiveBlocksPerMultiprocessor(&per_cu, (const void*)mega_fwd, 256, LDS_BYTES);
    per_cu = 2;
    if (cus < 1) cus = 256;
    grid_blocks = cus * per_cu;
    (void)hipGetLastError();
    if (n_in != 23 || ws_size < WS_NEED) { fprintf(stderr, "kernel_launch: unexpected n_in %d / ws_size %zu (need %zu)\n", n_in, ws_size, (size_t)WS_NEED); }
  }
  Params p{};
  for (int i = 0; i < 23; ++i) p.in[i] = (const float*)d_in[i];
  p.out = (float*)d_out;
  p.ws = (unsigned char*)d_ws;
#if ONE_LAUNCH
  p.ph_lo = 0; p.ph_hi = NPH;
  void* args[] = {&p};
  hipError_t e = hipLaunchCooperativeKernel((const void*)mega_fwd, dim3(grid_blocks), dim3(256), args, LDS_BYTES, stream);
  if (e != hipSuccess) fprintf(stderr, "cooperative launch failed: %s (grid %d)\n", hipGetErrorString(e), grid_blocks);
#else
  for (int ph = 0; ph < NPH; ++ph) {
    p.ph_lo = ph; p.ph_hi = ph + 1;
    hipLaunchKernelGGL(mega_fwd, dim3(grid_blocks), dim3(256), LDS_BYTES, stream, p);
  }
#endif
}
```

```cpp
#include <hip/hip_runtime.h>
#include <hip/hip_cooperative_groups.h>
#include <cstdint>
#include <cstdio>
namespace cg = cooperative_groups;

#ifndef ONE_LAUNCH
#define ONE_LAUNCH 1
#endif

typedef unsigned short bf16_t;
typedef short bf16x8 __attribute__((ext_vector_type(8)));
typedef float f32x4 __attribute__((ext_vector_type(4)));

#define NTHR 512
#define HTID ((int)(threadIdx.x & 255))
#define HALFID ((int)(threadIdx.x >> 8))
#define VBID ((int)(blockIdx.x * 2 + (threadIdx.x >> 8)))
#define VGDIM ((int)(gridDim.x * 2))
#define HALF_LDS 74816
#define MIB ((size_t)1 << 20)
#define NPH 23
#define LDS_BYTES (2 * HALF_LDS)
#define LDS_SLOT 74752
#define MISC_CTR (MISC_ROPE + 524288)

#define OFF_WIN  (288 * MIB)
#define OFF_WOUT (300 * MIB)
#define OFF_HP   (304 * MIB)
#define OFF_MISC (320 * MIB)
#define MISC_ROPE 524288
#define WS_NEED  (322 * MIB)
#define PLANE_E  ((size_t)25165824)
#define OUT_YP 0
#define OUT_YS 8388608
#define OUT_CK 25165824
#define OUT_CV 41943040
#define OUT_SR 58720256
#define OUT_SH 75497472

struct Params {
  const float* in[23];
  float* out;
  unsigned char* ws;
  int ph_lo, ph_hi;
};

struct LayerInfo { int kind, slot, IN, WIDTH; const float* w_in; const float* w_out; };

__device__ __forceinline__ LayerInfo layer_info(const Params& p, int l) {
  LayerInfo L;
  if (l == 0)      { L.kind = 0; L.slot = 0; L.IN = 4096; L.WIDTH = 1024; L.w_in = p.in[12]; L.w_out = p.in[13]; }
  else if (l == 1) { L.kind = 1; L.slot = 0; L.IN = 6144; L.WIDTH = 2048; L.w_in = p.in[16]; L.w_out = p.in[17]; }
  else if (l == 2) { L.kind = 2; L.slot = 0; L.IN = 5120; L.WIDTH = 1024; L.w_in = p.in[19]; L.w_out = p.in[20]; }
  else             { L.kind = 0; L.slot = 1; L.IN = 4096; L.WIDTH = 1024; L.w_in = p.in[12] + (size_t)1024 * 4096; L.w_out = p.in[13] + (size_t)1024 * 1024; }
  return L;
}
__device__ __forceinline__ bf16_t* hs_ptr(const Params& p, int l) {
  return l < 3 ? (bf16_t*)(p.out + OUT_SH) : (bf16_t*)(p.ws + 240 * MIB);
}

typedef __bf16 nbf16x2 __attribute__((ext_vector_type(2)));
typedef float f32x2 __attribute__((ext_vector_type(2)));
__device__ __forceinline__ float bf2f(unsigned h) { return __uint_as_float(h << 16); }
__device__ __forceinline__ unsigned pack2(float a, float b) { const f32x2 f = {a, b}; return __builtin_bit_cast(unsigned, __builtin_convertvector(f, nbf16x2)); }
__device__ __forceinline__ float lo_f(unsigned w) { return __uint_as_float(w << 16); }
__device__ __forceinline__ float hi_f(unsigned w) { return __uint_as_float(w & 0xffff0000u); }
__device__ __forceinline__ float silu_f(float x) { return x / (1.f + __expf(-x)); }
__device__ __forceinline__ float wave_sum(float v) {
#pragma unroll
  for (int o = 32; o > 0; o >>= 1) v += __shfl_xor(v, o);
  return v;
}
#define QSCALE 0.18033688011112042f
#define SB __builtin_amdgcn_sched_barrier(0)
#define MFMA(a, b, c) __builtin_amdgcn_mfma_f32_16x16x32_bf16((a), (b), (c), 0, 0, 0)

__device__ __forceinline__ void convT_tile(const float* __restrict__ src, int src_ld, bf16_t* __restrict__ dst, int dst_ld, unsigned char* lds) {
  float* t = (float*)lds;
  const int tid = HTID;
  const int kr = tid >> 4, nc = (tid & 15) * 4;
#pragma unroll
  for (int j = 0; j < 4; ++j) {
    const float4 v = *(const float4*)(src + (size_t)(kr + 16 * j) * src_ld + nc);
    float* tp = t + (kr + 16 * j) * 65 + nc;
    tp[0] = v.x; tp[1] = v.y; tp[2] = v.z; tp[3] = v.w;
  }
  __syncthreads();
  const int n = tid >> 2, kc = (tid & 3) * 16;
  unsigned w[8];
#pragma unroll
  for (int i = 0; i < 8; ++i) w[i] = pack2(t[(kc + 2 * i) * 65 + n], t[(kc + 2 * i + 1) * 65 + n]);
  uint4* d = (uint4*)(dst + (size_t)n * dst_ld + kc);
  d[0] = make_uint4(w[0], w[1], w[2], w[3]);
  d[1] = make_uint4(w[4], w[5], w[6], w[7]);
  __syncthreads();
}

__device__ __forceinline__ int conv_weights_count(const Params& p, int l) {
  const LayerInfo L = layer_info(p, l);
  return (L.IN / 64) * 16 + (L.WIDTH / 64) * 16;
}
__device__ __forceinline__ void conv_weights_item(const Params& p, int l, int it, unsigned char* lds) {
  const LayerInfo L = layer_info(p, l);
  const int nin = (L.IN / 64) * 16;
  if (it < nin) {
    const int kt = it & 15, nt = it >> 4;
    convT_tile(L.w_in + (size_t)(kt * 64) * L.IN + nt * 64, L.IN, (bf16_t*)(p.ws + OFF_WIN) + (size_t)(nt * 64) * 1024 + kt * 64, 1024, lds);
  } else {
    const int it2 = it - nin, nkt = L.WIDTH / 64;
    const int kt = it2 % nkt, nt = it2 / nkt;
    convT_tile(L.w_out + (size_t)(kt * 64) * 1024 + nt * 64, 1024, (bf16_t*)(p.ws + OFF_WOUT) + (size_t)(nt * 64) * L.WIDTH + kt * 64, L.WIDTH, lds);
  }
}

__device__ __forceinline__ void mod_item(const Params& p, int it, unsigned char* lds) {
  float* ssilu = (float*)lds;
  float* red = ssilu + 9 * 1024;
  const int tid = HTID;
  const int l = it / 48, col0 = (it % 48) * 64;
  for (int i = tid; i < 9 * 1024; i += 256) {
    const int v = i >> 10, k = i & 1023;
    const float x = (v == 0) ? p.in[7][k] : p.in[6][(v - 1) * 1024 + k];
    ssilu[i] = silu_f(x);
  }
  __syncthreads();
  const int col = tid & 63, kq = tid >> 6;
  const float* w = p.in[8] + (size_t)l * 1024 * 3072 + col0 + col;
  float acc[9];
#pragma unroll
  for (int v = 0; v < 9; ++v) acc[v] = 0.f;
  for (int k = kq * 256; k < kq * 256 + 256; ++k) {
    const float wv = w[(size_t)k * 3072];
#pragma unroll
    for (int v = 0; v < 9; ++v) acc[v] += ssilu[v * 1024 + k] * wv;
  }
#pragma unroll
  for (int v = 0; v < 9; ++v) red[(kq * 9 + v) * 64 + col] = acc[v];
  __syncthreads();
  float* mod = (float*)(p.ws + OFF_MISC);
  for (int i = tid; i < 9 * 64; i += 256) {
    const int v = i >> 6, cc = i & 63;
    const float s = red[(0 * 9 + v) * 64 + cc] + red[(1 * 9 + v) * 64 + cc] + red[(2 * 9 + v) * 64 + cc] + red[(3 * 9 + v) * 64 + cc];
    mod[(size_t)(l * 9 + v) * 3072 + col0 + cc] = s + p.in[9][l * 3072 + col0 + cc];
  }
  __syncthreads();
}

__device__ __forceinline__ void rope_item(const Params& p, int it) {
  const int idx = it * 256 + HTID;
  const int t = idx >> 5, pp = idx & 31;
  const int pos = pp < 16 ? (t >> 6) : (t & 63);
  const float inv = exp2f(-(float)(pp & 15) * (13.287712379549449f / 16.f));
  const float ang = (float)pos * inv;
  const double a = (double)ang;
  const double r = a - 6.283185307179586 * rint(a * 0.15915494309189535);
  const float rf = (float)r;
  float2* tab = (float2*)(p.ws + OFF_MISC + MISC_ROPE);
  tab[idx] = make_float2(__cosf(rf), __sinf(rf));
}

__device__ __forceinline__ void phase0(const Params& p, unsigned char* lds) {
  const int nw = conv_weights_count(p, 0);
  const int total = 192 + 256 + nw;
  for (int it = VBID; it < total; it += VGDIM) {
    if (it < 192) mod_item(p, it, lds);
    else if (it < 448) rope_item(p, it - 192);
    else conv_weights_item(p, 0, it - 448, lds);
  }
}

__device__ __forceinline__ void post_phase(const Params& p, int lprev, int lnext, unsigned char* lds, const bool dry) {
  const int tid = HTID, lane = tid & 63, w = tid >> 6;
  const float* mod = (const float*)(p.ws + OFF_MISC);
  const float* Y = nullptr;
  if (lprev >= 0) {
    const int kind = layer_info(p, lprev).kind;
    Y = (const float*)(p.ws + (kind == 1 ? 96 * MIB : 0));
  }
  bf16_t* hp = (bf16_t*)(p.ws + OFF_HP);
  bf16_t* hs = lnext < 4 ? hs_ptr(p, lnext) : nullptr;
  for (int row = VBID * 4 + w; row < 24576; row += VGDIM * 4) {
    const int mv = row < 8192 ? 0 : 1 + ((row - 8192) >> 11);
    const float* xs = (lprev <= 0) ? (row < 8192 ? p.in[0] + (size_t)row * 1024 : p.in[1] + (size_t)(row - 8192) * 1024) : p.out + (size_t)row * 1024;
    float4 x[4];
#pragma unroll
    for (int j = 0; j < 4; ++j) x[j] = *(const float4*)(xs + lane * 4 + 256 * j);
    if (lprev >= 0) {
      float4 y[4];
      float ss = 0.f;
#pragma unroll
      for (int j = 0; j < 4; ++j) { y[j] = *(const float4*)(Y + (size_t)row * 1024 + lane * 4 + 256 * j); ss += y[j].x * y[j].x + y[j].y * y[j].y + y[j].z * y[j].z + y[j].w * y[j].w; }
      ss = wave_sum(ss);
      const float rstd = rsqrtf(ss * (1.f / 1024.f) + 1e-6f);
      const float* ga = mod + (size_t)(lprev * 9 + mv) * 3072 + 2048;
      const float* gp = p.in[11] + lprev * 1024;
#pragma unroll
      for (int j = 0; j < 4; ++j) {
        const int c = lane * 4 + 256 * j;
        const float4 g4 = *(const float4*)(ga + c), p4 = *(const float4*)(gp + c);
        x[j].x += g4.x * (y[j].x * rstd * p4.x); x[j].y += g4.y * (y[j].y * rstd * p4.y);
        x[j].z += g4.z * (y[j].z * rstd * p4.z); x[j].w += g4.w * (y[j].w * rstd * p4.w);
        if (!dry) *(float4*)(p.out + (size_t)row * 1024 + c) = x[j];
      }
    }
    if (lnext < 4) {
      float ss = 0.f;
#pragma unroll
      for (int j = 0; j < 4; ++j) ss += x[j].x * x[j].x + x[j].y * x[j].y + x[j].z * x[j].z + x[j].w * x[j].w;
      ss = wave_sum(ss);
      const float rstd = rsqrtf(ss * (1.f / 1024.f) + 1e-6f);
      const float* sh = mod + (size_t)(lnext * 9 + mv) * 3072;
      const float* sc = sh + 1024;
      const float* gp = p.in[10] + lnext * 1024;
      bf16_t* hd = row < 8192 ? hp + (size_t)row * 1024 : hs + (size_t)(row - 8192) * 1024;
#pragma unroll
      for (int j = 0; j < 4; ++j) {
        const int c = lane * 4 + 256 * j;
        const float4 s4 = *(const float4*)(sh + c), c4 = *(const float4*)(sc + c), p4 = *(const float4*)(gp + c);
        const float h0 = x[j].x * rstd * p4.x * (1.f + c4.x) + s4.x, h1 = x[j].y * rstd * p4.y * (1.f + c4.y) + s4.y;
        const float h2 = x[j].z * rstd * p4.z * (1.f + c4.z) + s4.z, h3 = x[j].w * rstd * p4.w * (1.f + c4.w) + s4.w;
        *(uint2*)(hd + c) = make_uint2(pack2(h0, h1), pack2(h2, h3));
      }
    }
  }
  if (lprev >= 0 && lnext < 4) {
    const int nw = conv_weights_count(p, lnext);
    for (int it = VBID; it < nw; it += VGDIM) conv_weights_item(p, lnext, it, lds);
  }
}


__device__ __forceinline__ unsigned xcc_id() { return (unsigned)__builtin_amdgcn_s_getreg((3 << 11) | 20) & 7u; }
__device__ __forceinline__ bool wq_next(unsigned* ctr, int nst, int mult, unsigned xcd, int& qstate, int& q, int& idx, unsigned char* lds) {
  volatile int* slot = (volatile int*)(lds + LDS_SLOT);
  __syncthreads();
  if (HTID == 0) {
    int qq = -1, ii = 0, st = qstate;
    while (st < 8) {
      const int cand = (int)((xcd + (unsigned)st) & 7u);
      const int got = (int)atomicAdd(ctr + cand, 1u);
      if (got < mult * ((nst - cand + 7) >> 3)) { qq = cand; ii = got; break; }
      ++st;
    }
    slot[0] = qq; slot[1] = ii; slot[2] = st;
  }
  __syncthreads();
  q = slot[0]; idx = slot[1]; qstate = slot[2];
  return q >= 0;
}

#define LAS __attribute__((address_space(3)))
template <bool SWAP>
__device__ __forceinline__ void gemm_tile_compute(const bf16_t* __restrict__ Ag, const bf16_t* __restrict__ Bg, int K, unsigned char* lds, f32x4 (&acc)[8][4]) {
  const int tid = threadIdx.x, lane = tid & 63, wid = __builtin_amdgcn_readfirstlane(tid >> 6), wm = wid >> 2, wn = wid & 3;
  const int lr = lane & 15, lg = lane >> 4;
  LAS unsigned char* l3 = (LAS unsigned char*)lds;
  const int prow = lane >> 3;
  const int pgo0 = prow * K + (((lane & 7) ^ ((prow >> 1) & 7)) << 3);
  const int pgo1 = prow * K + (((lane & 7) ^ ((4 + (prow >> 1)) & 7)) << 3);
  const bf16_t* asrc = Ag + (size_t)(wid * 32) * K;
  const bf16_t* bsrc = Bg + (size_t)(wid * 32) * K;
  const size_t pstep = (size_t)8 * K;
#pragma unroll
  for (int mi = 0; mi < 8; ++mi)
#pragma unroll
    for (int ni = 0; ni < 4; ++ni) acc[mi][ni] = (f32x4){0.f, 0.f, 0.f, 0.f};
#define GEMM_STAGE(s, k0)                                                                                                                  \
  {                                                                                                                                        \
    _Pragma("unroll") for (int j = 0; j < 4; ++j) {                                                                                        \
      __builtin_amdgcn_global_load_lds((const unsigned*)(asrc + j * pstep + ((j & 1) ? pgo1 : pgo0) + (k0)), (LAS unsigned*)(l3 + (s) * 65536 + (wid * 4 + j) * 1024), 16, 0, 0);          \
      __builtin_amdgcn_global_load_lds((const unsigned*)(bsrc + j * pstep + ((j & 1) ? pgo1 : pgo0) + (k0)), (LAS unsigned*)(l3 + (s) * 65536 + 32768 + (wid * 4 + j) * 1024), 16, 0, 0);  \
    }                                                                                                                                      \
  }
  const int nk = K >> 6;
  GEMM_STAGE(0, 0);
  asm volatile("s_waitcnt vmcnt(0)" ::: "memory");
  __syncthreads();
  const int x0 = lg ^ ((lr >> 1) & 7);
  const int aoff0 = (wm * 128 + lr) * 128 + x0 * 16, aoff1 = (wm * 128 + lr) * 128 + (x0 ^ 4) * 16;
  const int boff0 = 32768 + (wn * 64 + lr) * 128 + x0 * 16, boff1 = 32768 + (wn * 64 + lr) * 128 + (x0 ^ 4) * 16;
  for (int kt = 0; kt < nk; ++kt) {
    if (kt + 1 < nk) GEMM_STAGE((kt + 1) & 1, (kt + 1) * 64);
    const unsigned char* st = lds + (kt & 1) * 65536;
#pragma unroll
    for (int kk = 0; kk < 2; ++kk) {
      bf16x8 af[8], bfr[4];
#pragma unroll
      for (int ni = 0; ni < 4; ++ni) bfr[ni] = *(const bf16x8*)(st + (kk ? boff1 : boff0) + ni * 2048);
#pragma unroll
      for (int mi = 0; mi < 8; ++mi) af[mi] = *(const bf16x8*)(st + (kk ? aoff1 : aoff0) + mi * 2048);
#pragma unroll
      for (int mi = 0; mi < 8; ++mi)
#pragma unroll
        for (int ni = 0; ni < 4; ++ni)
          acc[mi][ni] = SWAP ? MFMA(bfr[ni], af[mi], acc[mi][ni]) : MFMA(af[mi], bfr[ni], acc[mi][ni]);
    }
    asm volatile("s_waitcnt vmcnt(0)" ::: "memory");
    __syncthreads();
  }
#undef GEMM_STAGE
}

enum { GM_IN_DA = 0, GM_IN_RET_QKV = 1, GM_IN_RET_G = 2, GM_IN_HG = 3, GM_OUT = 4 };

__device__ __forceinline__ void epi_swapped(const Params& p, int mode, int slot, int ykind, int m, int n, f32x4 v) {
  bf16_t* R0 = (bf16_t*)p.ws;
  if (mode == GM_OUT) {
    float* Y = (float*)(p.ws + (ykind == 1 ? 96 * MIB : 0));
    *(f32x4*)(Y + (size_t)m * 1024 + n) = v;
  } else if (mode == GM_IN_DA) {
    const bool smp = m >= 8192;
    const int ms = m - 8192;
    const int b = smp ? (ms >> 11) : (m >> 8), t = smp ? (ms & 2047) : (m & 255);
    if (n < 2048) {
      if (smp) {
        const float4 cs = *(const float4*)((const float*)(p.ws + OFF_MISC + MISC_ROPE) + (size_t)(t * 32 + ((n & 63) >> 1)) * 2);
        const float a0 = v[0] * cs.x - v[1] * cs.y, a1 = v[0] * cs.y + v[1] * cs.x;
        const float a2 = v[2] * cs.z - v[3] * cs.w, a3 = v[2] * cs.w + v[3] * cs.z;
        v = (f32x4){a0, a1, a2, a3};
      }
      if (n < 1024) {
        *(uint2*)(R0 + (size_t)m * 1024 + n) = make_uint2(pack2(v[0] * QSCALE, v[1] * QSCALE), pack2(v[2] * QSCALE, v[3] * QSCALE));
      } else {
        const int c = n - 1024;
        const uint2 pk = make_uint2(pack2(v[0], v[1]), pack2(v[2], v[3]));
        if (smp) {
          *(uint2*)(R0 + 64 * MIB / 2 + ((size_t)b * 2560 + t) * 1024 + c) = pk;
        } else {
          *(f32x4*)(p.out + OUT_CK + ((size_t)((b * 2 + slot) * 256 + t)) * 1024 + c) = v;
          *(uint2*)(R0 + 48 * MIB / 2 + (size_t)m * 1024 + c) = pk;
        }
      }
    } else {
      *(uint2*)(R0 + 160 * MIB / 2 + (size_t)m * 1024 + (n - 3072)) = make_uint2(pack2(silu_f(v[0]), silu_f(v[1])), pack2(silu_f(v[2]), silu_f(v[3])));
    }
  } else if (mode == GM_IN_RET_QKV) {
    if (n < 1024) *(uint2*)(R0 + (size_t)m * 1024 + n) = make_uint2(pack2(v[0], v[1]), pack2(v[2], v[3]));
    else if (n < 2048) { const float s = 0.08838834764831845f; *(uint2*)(R0 + PLANE_E + (size_t)m * 1024 + (n - 1024)) = make_uint2(pack2(v[0] * s, v[1] * s), pack2(v[2] * s, v[3] * s)); }
    else *(uint2*)(R0 + 2 * PLANE_E + (size_t)m * 2048 + (n - 2048)) = make_uint2(pack2(v[0], v[1]), pack2(v[2], v[3]));
  } else if (mode == GM_IN_RET_G) {
    *(uint2*)(R0 + (size_t)m * 2048 + n) = make_uint2(pack2(silu_f(v[0]), silu_f(v[1])), pack2(silu_f(v[2]), silu_f(v[3])));
  } else {
    if (n < 1024 || n >= 4096) v = (f32x4){silu_f(v[0]), silu_f(v[1]), silu_f(v[2]), silu_f(v[3])};
    *(uint2*)(R0 + (size_t)(n >> 10) * PLANE_E + (size_t)m * 1024 + (n & 1023)) = make_uint2(pack2(v[0], v[1]), pack2(v[2], v[3]));
  }
}

__device__ __forceinline__ void epi_da_v(const Params& p, int slot, int m, int n, f32x4 v) {
  bf16_t* R0 = (bf16_t*)p.ws;
  const int c = n - 2048, hh = c >> 7, e = c & 127;
  const uint2 pk = make_uint2(pack2(v[0], v[1]), pack2(v[2], v[3]));
  if (m >= 8192) {
    const int ms = m - 8192, b = ms >> 11, t = ms & 2047;
    *(uint2*)(R0 + 120 * MIB / 2 + ((size_t)((b * 8 + hh) * 128 + e)) * 2560 + t) = pk;
  } else {
    const int b = m >> 8, t = m & 255;
    float* o = p.out + OUT_CV + ((size_t)((b * 2 + slot) * 256 + t)) * 1024 + c;
    o[0] = v[0]; o[1024] = v[1]; o[2048] = v[2]; o[3072] = v[3];
    *(uint2*)(R0 + 104 * MIB / 2 + ((size_t)((b * 8 + hh) * 128 + e)) * 256 + t) = pk;
  }
}

__device__ __forceinline__ void gemm_phase(const Params& p, int l, int mode, unsigned char* lds, int phid) {
  const LayerInfo L = layer_info(p, l);
  bf16_t* R0 = (bf16_t*)p.ws;
  const bf16_t *Ap, *As, *Bt;
  int K, N;
  if (mode == GM_OUT) {
    K = L.WIDTH; N = 1024; Bt = (const bf16_t*)(p.ws + OFF_WOUT);
    const bf16_t* base = R0 + (L.kind == 0 ? 160 * MIB / 2 : (L.kind == 1 ? 4 * PLANE_E : 5 * PLANE_E));
    Ap = base; As = base + (size_t)8192 * K;
  } else {
    K = 1024; Ap = (const bf16_t*)(p.ws + OFF_HP); As = hs_ptr(p, l);
    Bt = (const bf16_t*)(p.ws + OFF_WIN) + (mode == GM_IN_RET_G ? (size_t)4096 * 1024 : 0);
    N = (mode == GM_IN_DA || mode == GM_IN_RET_QKV) ? 4096 : (mode == GM_IN_RET_G ? 2048 : 5120);
  }
  const int ntn = N >> 8, ntiles = 96 * ntn;
  const int extra = (mode == GM_IN_DA) ? 3072 : 0;
  const int tid = threadIdx.x, lane = tid & 63, wid = tid >> 6, wm = wid >> 2, wn = wid & 3, lr = lane & 15, lg = lane >> 4;
  const int G = gridDim.x;
  const bool swz = (G & 7) == 0;
  const int xcd = blockIdx.x & 7, snn = ntn >> 2, nst = 12 * snn;
  const int q0 = swz ? (int)(blockIdx.x >> 3) : (int)blockIdx.x, qstep = swz ? (G >> 3) : G;
  const int qlen = swz ? 32 * ((nst - xcd + 7) >> 3) : ntiles;
  for (int q = q0; q < qlen; q += qstep) {
    int it = q;
    if (swz) {
      const int st = xcd + 8 * (q >> 5), tin = q & 31;
      const int smt = st / snn, snt = st - smt * snn;
      it = (smt * 8 + (tin >> 2)) * ntn + snt * 4 + (tin & 3);
    }
    if (it < ntiles) {
      const int mt = it / ntn, nt = it - mt * ntn;
      const int m0 = mt * 256, n0 = nt * 256;
      const bf16_t* A = m0 < 8192 ? Ap + (size_t)m0 * K : As + (size_t)(m0 - 8192) * K;
      const bf16_t* B = Bt + (size_t)n0 * K;
      f32x4 acc[8][4];
      if (mode == GM_IN_DA && n0 >= 2048 && n0 < 3072) {
        gemm_tile_compute<false>(A, B, K, lds, acc);
#pragma unroll
        for (int mi = 0; mi < 8; ++mi)
#pragma unroll
          for (int ni = 0; ni < 4; ++ni)
            epi_da_v(p, L.slot, m0 + wm * 128 + mi * 16 + 4 * lg, n0 + wn * 64 + ni * 16 + lr, acc[mi][ni]);
      } else {
        gemm_tile_compute<true>(A, B, K, lds, acc);
#pragma unroll
        for (int mi = 0; mi < 8; ++mi)
#pragma unroll
          for (int ni = 0; ni < 4; ++ni)
            epi_swapped(p, mode, L.slot, L.kind, m0 + wm * 128 + mi * 16 + lr, n0 + wn * 64 + ni * 16 + 4 * lg, acc[mi][ni]);
      }
    }
  }
  for (int ci = VBID; ci < extra; ci += VGDIM) {
    {
      if (ci < 2048) {
        const int idx = (ci * 256 + HTID) * 8;
        const int b = idx >> 19, rem = idx & 524287, tp = rem >> 10, c = rem & 1023;
        const float* src = p.in[2] + ((size_t)((b * 2 + L.slot) * 512 + tp)) * 1024 + c;
        const float4 u0 = *(const float4*)src, u1 = *(const float4*)(src + 4);
        *(uint4*)(R0 + 64 * MIB / 2 + ((size_t)b * 2560 + 2048 + tp) * 1024 + c) = make_uint4(pack2(u0.x, u0.y), pack2(u0.z, u0.w), pack2(u1.x, u1.y), pack2(u1.z, u1.w));
      } else {
        const int i2 = ci - 2048;
        const int b = i2 >> 7, hh = (i2 >> 4) & 7, tt = (i2 >> 1) & 7, et = i2 & 1;
        convT_tile(p.in[3] + ((size_t)((b * 2 + L.slot) * 512 + tt * 64)) * 1024 + hh * 128 + et * 64, 1024,
                   R0 + 120 * MIB / 2 + ((size_t)((b * 8 + hh) * 128 + et * 64)) * 2560 + 2048 + tt * 64, 2560, lds + HALFID * HALF_LDS);
      }
    }
  }
}

__device__ __forceinline__ void attn_phase(const Params& p, int l, unsigned char* lds, const bool dry, int phid) {
  const int slot = l == 3 ? 1 : 0;
  const float lam_init = 0.8f - 0.6f * expf(-0.3f * (float)l);
  const int tid = threadIdx.x, lane = tid & 63, w = tid >> 6, lr = lane & 15, lg = lane >> 4;
  float lam;
  {
    const float* lf = p.in[14] + slot * 256;
    const float a = wave_sum(lf[lane] * lf[64 + lane]);
    const float b2 = wave_sum(lf[128 + lane] * lf[192 + lane]);
    lam = expf(a) - expf(b2) + lam_init;
  }
  bf16_t* R0 = (bf16_t*)p.ws;
  const float* subg = p.in[15] + slot * 128;
  for (int item = blockIdx.x; item < 1536; item += gridDim.x) {
    int grp, b, h, qt;
    if (item < 1024) { grp = 1; b = item >> 7; h = (item >> 4) & 7; qt = item & 15; }
    else { const int i2 = item - 1024; grp = 0; b = i2 >> 4; h = (i2 >> 1) & 7; qt = i2 & 1; }
    const int nkeys = grp ? 2560 : 256, ntile = nkeys >> 6;
    const int mq = (grp ? 8192 + b * 2048 : b * 256) + qt * 128 + w * 16 + lr;
    const bf16_t* Kg = grp ? R0 + 64 * MIB / 2 + (size_t)b * 2560 * 1024 + h * 128 : R0 + 48 * MIB / 2 + (size_t)b * 256 * 1024 + h * 128;
    const bf16_t* Vg = grp ? R0 + 120 * MIB / 2 + (size_t)(b * 8 + h) * 128 * 2560 : R0 + 104 * MIB / 2 + (size_t)(b * 8 + h) * 128 * 256;
    bf16x8 qf[2][2];
#pragma unroll
    for (int sub = 0; sub < 2; ++sub)
#pragma unroll
      for (int ks = 0; ks < 2; ++ks) qf[sub][ks] = *(const bf16x8*)(R0 + (size_t)mq * 1024 + h * 128 + sub * 64 + ks * 32 + lg * 8);
    LAS unsigned char* l3 = (LAS unsigned char*)lds;
    const int wu = __builtin_amdgcn_readfirstlane(w);
    int koff[2], voff[2];
#pragma unroll
    for (int j = 0; j < 2; ++j) {
      const int kr = (wu * 2 + j) * 4 + (lane >> 4);
      koff[j] = kr * 1024 + (((lane & 15) ^ (kr & 15)) << 3);
      const int er = (wu * 2 + j) * 8 + (lane >> 3);
      voff[j] = er * nkeys + (((lane & 7) ^ ((er >> 1) & 7)) << 3);
    }
#define ATT_STAGE_K(s, key0)                                                                                  \
  {                                                                                                           \
    _Pragma("unroll") for (int j = 0; j < 2; ++j)                                                             \
      __builtin_amdgcn_global_load_lds((const unsigned*)(Kg + (size_t)(key0) * 1024 + koff[j]), (LAS unsigned*)(l3 + (s) * 32768 + (wu * 2 + j) * 1024), 16, 0, 0); \
  }
#define ATT_STAGE_V(s, key0)                                                                                  \
  {                                                                                                           \
    _Pragma("unroll") for (int j = 0; j < 2; ++j)                                                             \
      __builtin_amdgcn_global_load_lds((const unsigned*)(Vg + (key0) + voff[j]), (LAS unsigned*)(l3 + (s) * 32768 + 16384 + (wu * 2 + j) * 1024), 16, 0, 0); \
  }
    const int xl = lg ^ lr;
    const int vsw = (lr >> 1) & 7;
    const int vlo = lr * 128 + ((((lg >> 1)) ^ vsw) << 4) + (lg & 1) * 8;
    float mx[2] = {-1e30f, -1e30f}, ls[2] = {0.f, 0.f};
    ATT_STAGE_K(0, 0);
    asm volatile("s_waitcnt vmcnt(0)" ::: "memory");
    __syncthreads();
    for (int kt = 0; kt < ntile; ++kt) {
      if (kt + 1 < ntile) ATT_STAGE_K((kt + 1) & 1, (kt + 1) * 64);
      const unsigned char* ks_ = lds + (kt & 1) * 32768 + lr * 256;
      bf16x8 kf0[8], kf1[8];
#pragma unroll
      for (int nt = 0; nt < 4; ++nt)
#pragma unroll
        for (int ks = 0; ks < 2; ++ks) kf0[nt * 2 + ks] = *(const bf16x8*)(ks_ + nt * 4096 + ((xl ^ (ks * 4)) << 4));
      SB;
#pragma unroll
      for (int nt = 0; nt < 4; ++nt)
#pragma unroll
        for (int ks = 0; ks < 2; ++ks) kf1[nt * 2 + ks] = *(const bf16x8*)(ks_ + nt * 4096 + ((xl ^ (8 + ks * 4)) << 4));
      f32x4 s0[4], s1[4];
#pragma unroll
      for (int nt = 0; nt < 4; ++nt) {
        s0[nt] = MFMA(kf0[nt * 2], qf[0][0], ((f32x4){0.f, 0.f, 0.f, 0.f}));
        s0[nt] = MFMA(kf0[nt * 2 + 1], qf[0][1], s0[nt]);
      }
      SB;
#pragma unroll
      for (int nt = 0; nt < 4; ++nt) {
        s1[nt] = MFMA(kf1[nt * 2], qf[1][0], ((f32x4){0.f, 0.f, 0.f, 0.f}));
        s1[nt] = MFMA(kf1[nt * 2 + 1], qf[1][1], s1[nt]);
      }
      SB;
#pragma unroll
      for (int sub = 0; sub < 2; ++sub) {
        float tm = sub ? s1[0][0] : s0[0][0];
#pragma unroll
        for (int nt = 0; nt < 4; ++nt)
#pragma unroll
          for (int r = 0; r < 4; ++r) tm = fmaxf(tm, sub ? s1[nt][r] : s0[nt][r]);
        tm = fmaxf(tm, __shfl_xor(tm, 16));
        tm = fmaxf(tm, __shfl_xor(tm, 32));
        const float mn = fmaxf(mx[sub], tm);
        float acc = 0.f;
#pragma unroll
        for (int nt = 0; nt < 4; ++nt)
#pragma unroll
          for (int r = 0; r < 4; ++r) acc += __builtin_amdgcn_exp2f((sub ? s1[nt][r] : s0[nt][r]) - mn);
        ls[sub] = ls[sub] * __builtin_amdgcn_exp2f(mx[sub] - mn) + acc;
        mx[sub] = mn;
      }
      asm volatile("s_waitcnt vmcnt(0)" ::: "memory");
      __syncthreads();
    }
    float mo[2];
#pragma unroll
    for (int sub = 0; sub < 2; ++sub) {
      float t = ls[sub];
      t += __shfl_xor(t, 16);
      t += __shfl_xor(t, 32);
      mo[sub] = mx[sub] + __log2f(t);
    }
    f32x4 o[8];
#pragma unroll
    for (int et = 0; et < 8; ++et) o[et] = (f32x4){0.f, 0.f, 0.f, 0.f};
    ATT_STAGE_K(0, 0);
    ATT_STAGE_V(0, 0);
    asm volatile("s_waitcnt vmcnt(0)" ::: "memory");
    __syncthreads();
    for (int kt = 0; kt < ntile; ++kt) {
      if (kt + 1 < ntile) { ATT_STAGE_K((kt + 1) & 1, (kt + 1) * 64); ATT_STAGE_V((kt + 1) & 1, (kt + 1) * 64); }
      const unsigned char* ks_ = lds + (kt & 1) * 32768 + lr * 256;
      const unsigned char* vs_ = lds + (kt & 1) * 32768 + 16384;
      bf16x8 kfr[8];
      uint2 vlo_[8], vhi_[8];
#define ATT_RD_K(k2)                                                                                                   \
  _Pragma("unroll") for (int sub = 0; sub < 2; ++sub) _Pragma("unroll") for (int nn = 0; nn < 2; ++nn)                  \
      _Pragma("unroll") for (int ks = 0; ks < 2; ++ks)                                                                  \
          kfr[sub * 4 + nn * 2 + ks] = *(const bf16x8*)(ks_ + (2 * (k2) + nn) * 4096 + ((xl ^ (sub * 8 + ks * 4)) << 4));
#define ATT_RD_V(k2)                                                                                                   \
  _Pragma("unroll") for (int et = 0; et < 8; ++et) {                                                                    \
    vlo_[et] = *(const uint2*)(vs_ + et * 2048 + (vlo ^ ((k2) << 6)));                                                  \
    vhi_[et] = *(const uint2*)(vs_ + et * 2048 + (vlo ^ ((k2) << 6) ^ 32));                                             \
  }
#define ATT_QK_SM_PV()                                                                                                 \
  {                                                                                                                    \
    f32x4 s[2][2];                                                                                                     \
    _Pragma("unroll") for (int sub = 0; sub < 2; ++sub) _Pragma("unroll") for (int nn = 0; nn < 2; ++nn) {              \
      s[sub][nn] = MFMA(kfr[sub * 4 + nn * 2], qf[sub][0], ((f32x4){0.f, 0.f, 0.f, 0.f}));                              \
      s[sub][nn] = MFMA(kfr[sub * 4 + nn * 2 + 1], qf[sub][1], s[sub][nn]);                                             \
    }                                                                                                                  \
    SB;                                                                                                                \
    unsigned pw[4];                                                                                                    \
    _Pragma("unroll") for (int nn = 0; nn < 2; ++nn) {                                                                  \
      float a[4];                                                                                                      \
      _Pragma("unroll") for (int r = 0; r < 4; ++r)                                                                     \
          a[r] = __builtin_amdgcn_exp2f(s[0][nn][r] - mo[0]) - lam * __builtin_amdgcn_exp2f(s[1][nn][r] - mo[1]);      \
      pw[nn * 2] = pack2(a[0], a[1]);                                                                                  \
      pw[nn * 2 + 1] = pack2(a[2], a[3]);                                                                              \
    }                                                                                                                  \
    union { unsigned u[4]; bf16x8 v; } cp;                                                                             \
    cp.u[0] = pw[0]; cp.u[1] = pw[1]; cp.u[2] = pw[2]; cp.u[3] = pw[3];                                                \
    SB;                                                                                                                \
    _Pragma("unroll") for (int et = 0; et < 8; ++et) {                                                                  \
      union { unsigned u[4]; bf16x8 v; } cv;                                                                           \
      cv.u[0] = vlo_[et].x; cv.u[1] = vlo_[et].y; cv.u[2] = vhi_[et].x; cv.u[3] = vhi_[et].y;                          \
      o[et] = MFMA(cv.v, cp.v, o[et]);                                                                                 \
    }                                                                                                                  \
  }
      ATT_RD_K(0)
      ATT_RD_V(0)
      SB;
      ATT_QK_SM_PV()
      SB;
      ATT_RD_K(1)
      ATT_RD_V(1)
      SB;
      ATT_QK_SM_PV()
#undef ATT_RD_K
#undef ATT_RD_V
#undef ATT_QK_SM_PV
      asm volatile("s_waitcnt vmcnt(0)" ::: "memory");
      __syncthreads();
    }
#undef ATT_STAGE_K
#undef ATT_STAGE_V
    float ss = 0.f;
#pragma unroll
    for (int et = 0; et < 8; ++et)
#pragma unroll
      for (int r = 0; r < 4; ++r) ss += o[et][r] * o[et][r];
    ss += __shfl_xor(ss, 16);
    ss += __shfl_xor(ss, 32);
    const float rs = rsqrtf(ss * (1.f / 128.f) + 1e-6f) * (1.f - lam_init);
    bf16_t* gp = R0 + 160 * MIB / 2 + (size_t)mq * 1024 + h * 128;
#pragma unroll
    for (int et = 0; et < 8; ++et) {
      const int e0 = 16 * et + 4 * lg;
      const uint2 g = *(const uint2*)(gp + e0);
      const float4 sg = *(const float4*)(subg + e0);
      const float v0 = o[et][0] * rs * sg.x * lo_f(g.x), v1 = o[et][1] * rs * sg.y * hi_f(g.x);
      const float v2 = o[et][2] * rs * sg.z * lo_f(g.y), v3 = o[et][3] * rs * sg.w * hi_f(g.y);
      if (!dry) *(uint2*)(gp + e0) = make_uint2(pack2(v0, v1), pack2(v2, v3));
    }
  }
}

template <int KIND, int DIR>
__device__ __forceinline__ void scan_item(const Params& p, int item, unsigned char* lds, const bool dry) {
  constexpr int DV = KIND == 1 ? 256 : 128, NSL = DV / 64, LDV = KIND == 1 ? 2048 : 1024;
  const int tid = HTID, lane = tid & 63, w = tid >> 6, lr = lane & 15, lg = lane >> 4;
  int grp, b, h, sl;
  {
    int it = item;
    if (it < 64 * NSL) grp = 1; else { grp = 0; it -= 64 * NSL; }
    sl = it % NSL; h = (it / NSL) & 7; b = it / (NSL * 8);
  }
  const int T = grp ? 2048 : 256, nch = T >> 6;
  const size_t mbase = grp ? (size_t)8192 + (size_t)b * 2048 : (size_t)b * 256;
  bf16_t* R0 = (bf16_t*)p.ws;
  const bf16_t* Qg = R0 + mbase * 1024 + h * 128;
  const bf16_t* Kg = R0 + (KIND == 1 ? PLANE_E : (DIR ? 2 * PLANE_E : PLANE_E)) + mbase * 1024 + h * 128;
  const bf16_t* Vg = R0 + (KIND == 1 ? 2 * PLANE_E : 3 * PLANE_E) + mbase * LDV + h * DV + sl * 64;
  bf16_t* Og = R0 + (KIND == 1 ? 4 * PLANE_E : 5 * PLANE_E) + mbase * LDV + h * DV + sl * 64;
  unsigned char* Qs = lds;
  unsigned char* X = lds + 17408;
  unsigned char* Vt = lds + 35840;
  unsigned char* StS = lds + 45056;
  unsigned char* Pm = lds + 62464;
  float* xch = (float*)(lds + 71680);
  float* blA = xch + 512;
  float* erA = xch + 640;
  const int dp = tid & 63, tq = tid >> 6, r0 = tq * 16, d0 = dp * 2;
  float cst0, cst1;
  if (KIND == 1) { cst0 = cst1 = log1pf(-expf(p.in[18][DIR * 8 + h])); }
  else {
    const float* lbp = p.in[21] + DIR * 4096 + h * 128 + d0;
    {
      const float x0 = lbp[0], x1 = lbp[1024], x2 = lbp[2048], x3 = lbp[3072];
      const float m = fmaxf(fmaxf(x0, x1), fmaxf(x2, x3));
      const float e0 = expf(x0 - m), e1 = expf(x1 - m), e2 = expf(x2 - m), e3 = expf(x3 - m);
      cst0 = (e1 + e2) / (e0 + e1 + e2 + e3);
    }
    {
      const float x0 = lbp[1], x1 = lbp[1025], x2 = lbp[2049], x3 = lbp[3073];
      const float m = fmaxf(fmaxf(x0, x1), fmaxf(x2, x3));
      const float e0 = expf(x0 - m), e1 = expf(x1 - m), e2 = expf(x2 - m), e3 = expf(x3 - m);
      cst1 = (e1 + e2) / (e0 + e1 + e2 + e3);
    }
  }
  f32x4 S[8];
  if (grp) {
    const float* s0 = (KIND == 1 ? p.in[4] : p.in[5]) + ((size_t)((b * 2 + DIR) * 8 + h) * 128) * DV + sl * 64 + 16 * w + lr + (size_t)(4 * lg) * DV;
    asm volatile("" : "+v"(s0));
#pragma unroll
    for (int dt = 0; dt < 8; ++dt)
#pragma unroll
      for (int r = 0; r < 4; ++r) S[dt][r] = s0[(16 * dt + r) * DV];
  } else {
#pragma unroll
    for (int dt = 0; dt < 8; ++dt) S[dt] = (f32x4){0.f, 0.f, 0.f, 0.f};
  }
  unsigned qv[16], kv[16], vv[8];
  const int ve2 = tid & 31, vq = tid >> 5;
  const int qoff = r0 * 512 + dp;
  const int voff = (8 * vq) * (LDV / 2) + ve2;
  const unsigned* Qg32 = (const unsigned*)Qg;
  const unsigned* Kg32 = (const unsigned*)Kg;
  const unsigned* Vg32 = (const unsigned*)Vg;
#define SCAN_ISSUE(c)                                                                                   \
  {                                                                                                     \
    const unsigned* q_ = Qg32 + (size_t)(c) * (64 * 512) + qoff;                                        \
    const unsigned* k_ = Kg32 + (size_t)(c) * (64 * 512) + qoff;                                        \
    const unsigned* v_ = Vg32 + (size_t)(c) * (64 * (LDV / 2)) + voff;                                  \
    asm volatile("" : "+v"(q_), "+v"(k_), "+v"(v_));                                                    \
    _Pragma("unroll") for (int i = 0; i < 16; ++i) { qv[i] = q_[i * 512]; kv[i] = k_[i * 512]; }        \
    _Pragma("unroll") for (int i = 0; i < 8; ++i) vv[i] = v_[i * (LDV / 2)];                            \
  }
  SCAN_ISSUE(DIR ? nch - 1 : 0);
  for (int ci = 0; ci < nch; ++ci) {
    const int c = DIR ? nch - 1 - ci : ci;
    float tot0 = 0.f, tot1 = 0.f;
    if (KIND == 1) { tot0 = tot1 = 16.f * cst0; }
    else {
#pragma unroll
      for (int i = 0; i < 16; ++i) {
        const float s0_ = 1.f / (1.f + __expf(-lo_f(kv[i]))), s1_ = 1.f / (1.f + __expf(-hi_f(kv[i])));
        tot0 += __logf(cst0 + (1.f - cst0) * s0_);
        tot1 += __logf(cst1 + (1.f - cst1) * s1_);
      }
    }
    *(float2*)(xch + tq * 128 + d0) = make_float2(tot0, tot1);
    __syncthreads();
    const float2 t0 = *(const float2*)(xch + d0), t1 = *(const float2*)(xch + 128 + d0), t2 = *(const float2*)(xch + 256 + d0), t3 = *(const float2*)(xch + 384 + d0);
    const float blast0 = (t0.x + t1.x) + (t2.x + t3.x), blast1 = (t0.y + t1.y) + (t2.y + t3.y);
    float ref0, ref1, run0, run1;
    if (DIR == 0) {
      ref0 = t0.x + t1.x; ref1 = t0.y + t1.y;
      run0 = (tq > 0 ? t0.x : 0.f) + (tq > 1 ? t1.x : 0.f) + (tq > 2 ? t2.x : 0.f);
      run1 = (tq > 0 ? t0.y : 0.f) + (tq > 1 ? t1.y : 0.f) + (tq > 2 ? t2.y : 0.f);
    } else {
      ref0 = t2.x + t3.x; ref1 = t2.y + t3.y;
      run0 = (tq < 3 ? t3.x : 0.f) + (tq < 2 ? t2.x : 0.f) + (tq < 1 ? t1.x : 0.f);
      run1 = (tq < 3 ? t3.y : 0.f) + (tq < 2 ? t2.y : 0.f) + (tq < 1 ? t1.y : 0.f);
    }
    unsigned ktp0[8], ktp1[8];
#pragma unroll
    for (int jj = 0; jj < 8; ++jj) {
      const int j = DIR ? 7 - jj : jj;
      float ka[2], kb[2];
#pragma unroll
      for (int hh = 0; hh < 2; ++hh) {
        const int i = 2 * j + (DIR ? 1 - hh : hh);
        float g0, g1, k0, k1;
        if (KIND == 1) { g0 = g1 = cst0; k0 = lo_f(kv[i]); k1 = hi_f(kv[i]); }
        else {
          const float s0_ = 1.f / (1.f + __expf(-lo_f(kv[i]))), s1_ = 1.f / (1.f + __expf(-hi_f(kv[i])));
          g0 = __logf(cst0 + (1.f - cst0) * s0_); g1 = __logf(cst1 + (1.f - cst1) * s1_);
          k0 = (1.f - cst0) * (1.f - s0_); k1 = (1.f - cst1) * (1.f - s1_);
        }
        run0 += g0; run1 += g1;
        *(unsigned*)(Qs + (r0 + i) * 272 + d0 * 2) = pack2(lo_f(qv[i]) * __expf(run0 - ref0), hi_f(qv[i]) * __expf(run1 - ref1));
        *(unsigned*)(X + (r0 + i) * 272 + d0 * 2) = pack2(k0 * __expf(ref0 - run0), k1 * __expf(ref1 - run1));
        ka[i & 1] = k0 * __expf(blast0 - run0);
        kb[i & 1] = k1 * __expf(blast1 - run1);
      }
      ktp0[j] = pack2(ka[0], ka[1]);
      ktp1[j] = pack2(kb[0], kb[1]);
    }
    if (tq == 0) { *(float2*)(blA + d0) = make_float2(__expf(blast0), __expf(blast1)); *(float2*)(erA + d0) = make_float2(__expf(ref0), __expf(ref1)); }
    {
      const unsigned a0 = (vv[0] & 0xffffu) | (vv[1] << 16), a1 = (vv[2] & 0xffffu) | (vv[3] << 16), a2 = (vv[4] & 0xffffu) | (vv[5] << 16), a3 = (vv[6] & 0xffffu) | (vv[7] << 16);
      const unsigned b0 = (vv[0] >> 16) | (vv[1] & 0xffff0000u), b1 = (vv[2] >> 16) | (vv[3] & 0xffff0000u), b2 = (vv[4] >> 16) | (vv[5] & 0xffff0000u), b3 = (vv[6] >> 16) | (vv[7] & 0xffff0000u);
      *(uint4*)(Vt + (2 * ve2) * 144 + vq * 16) = make_uint4(a0, a1, a2, a3);
      *(uint4*)(Vt + (2 * ve2 + 1) * 144 + vq * 16) = make_uint4(b0, b1, b2, b3);
    }
    if (ci + 1 < nch) { SCAN_ISSUE(DIR ? c - 1 : c + 1); }
    __syncthreads();
#pragma unroll
    for (int dt = 0; dt < 8; ++dt) {
      const float4 er4 = *(const float4*)(erA + 16 * dt + 4 * lg);
      *(uint2*)(StS + (16 * w + lr) * 272 + (16 * dt + 4 * lg) * 2) = make_uint2(pack2(S[dt][0] * er4.x, S[dt][1] * er4.y), pack2(S[dt][2] * er4.z, S[dt][3] * er4.w));
    }
    bf16x8 qf[4];
#pragma unroll
    for (int ks = 0; ks < 4; ++ks) qf[ks] = *(const bf16x8*)(Qs + (16 * w + lr) * 272 + ks * 64 + lg * 16);
    uint2 pv[4];
    {
      const int t = 16 * w + lr;
#pragma unroll
      for (int st = 0; st < 4; ++st) {
        f32x4 s = (f32x4){0.f, 0.f, 0.f, 0.f};
#pragma unroll
        for (int ks = 0; ks < 4; ++ks) {
          const bf16x8 kf = *(const bf16x8*)(X + (16 * st + lr) * 272 + ks * 64 + lg * 16);
          s = MFMA(kf, qf[ks], s);
        }
        float v[4];
#pragma unroll
        for (int r = 0; r < 4; ++r) {
          const int si = 16 * st + 4 * lg + r;
          const bool keep = DIR ? (t <= si) : (t >= si);
          v[r] = keep ? s[r] : 0.f;
        }
        pv[st] = make_uint2(pack2(v[0], v[1]), pack2(v[2], v[3]));
      }
    }
    __syncthreads();
#pragma unroll
    for (int st = 0; st < 4; ++st) *(uint2*)(Pm + (16 * w + lr) * 144 + (16 * st + 4 * lg) * 2) = pv[st];
    *(uint4*)(X + d0 * 144 + r0 * 2) = make_uint4(ktp0[0], ktp0[1], ktp0[2], ktp0[3]);
    *(uint4*)(X + d0 * 144 + r0 * 2 + 16) = make_uint4(ktp0[4], ktp0[5], ktp0[6], ktp0[7]);
    *(uint4*)(X + (d0 + 1) * 144 + r0 * 2) = make_uint4(ktp1[0], ktp1[1], ktp1[2], ktp1[3]);
    *(uint4*)(X + (d0 + 1) * 144 + r0 * 2 + 16) = make_uint4(ktp1[4], ktp1[5], ktp1[6], ktp1[7]);
    __syncthreads();
    {
      bf16x8 pf[2];
#pragma unroll
      for (int ks = 0; ks < 2; ++ks) pf[ks] = *(const bf16x8*)(Pm + (16 * w + lr) * 144 + ks * 64 + lg * 16);
#pragma unroll
      for (int et = 0; et < 4; ++et) {
        f32x4 o = (f32x4){0.f, 0.f, 0.f, 0.f};
#pragma unroll
        for (int ks = 0; ks < 2; ++ks) {
          const bf16x8 vf = *(const bf16x8*)(Vt + (16 * et + lr) * 144 + ks * 64 + lg * 16);
          o = MFMA(vf, pf[ks], o);
        }
#pragma unroll
        for (int ks = 0; ks < 4; ++ks) {
          const bf16x8 sf = *(const bf16x8*)(StS + (16 * et + lr) * 272 + ks * 64 + lg * 16);
          o = MFMA(sf, qf[ks], o);
        }
        bf16_t* op = Og + (size_t)(c * 64 + 16 * w + lr) * LDV + 16 * et + 4 * lg;
        if (DIR) {
          const uint2 old = *(const uint2*)op;
          o[0] += lo_f(old.x); o[1] += hi_f(old.x); o[2] += lo_f(old.y); o[3] += hi_f(old.y);
        }
        if (!(DIR && dry)) *(uint2*)op = make_uint2(pack2(o[0], o[1]), pack2(o[2], o[3]));
      }
    }
    {
      bf16x8 vtf[2];
#pragma unroll
      for (int ks = 0; ks < 2; ++ks) vtf[ks] = *(const bf16x8*)(Vt + (16 * w + lr) * 144 + ks * 64 + lg * 16);
#pragma unroll
      for (int dt = 0; dt < 8; ++dt) {
        const float4 bl4 = *(const float4*)(blA + 16 * dt + 4 * lg);
        S[dt][0] *= bl4.x; S[dt][1] *= bl4.y; S[dt][2] *= bl4.z; S[dt][3] *= bl4.w;
#pragma unroll
        for (int ks = 0; ks < 2; ++ks) {
          const bf16x8 kf = *(const bf16x8*)(X + (16 * dt + lr) * 144 + ks * 64 + lg * 16);
          S[dt] = MFMA(kf, vtf[ks], S[dt]);
        }
      }
    }
    __syncthreads();
  }
#undef SCAN_ISSUE
  if (!grp) {
    float* so = p.out + (KIND == 1 ? OUT_SR : OUT_SH) + ((size_t)((b * 2 + DIR) * 8 + h) * 128) * DV + sl * 64 + 16 * w + lr + (size_t)(4 * lg) * DV;
    asm volatile("" : "+v"(so));
#pragma unroll
    for (int dt = 0; dt < 8; ++dt)
#pragma unroll
      for (int r = 0; r < 4; ++r) so[(16 * dt + r) * DV] = S[dt][r];
  }
}

template <int KIND, int DIR>
__device__ __forceinline__ void scan_phase(const Params& p, unsigned char* lds, const bool dry) {
  constexpr int NSL = (KIND == 1 ? 256 : 128) / 64;
  const int ns = 64 * NSL, npr = 256 * NSL;
  const int G = VGDIM, bid = VBID;
  int it, step, end = ns + npr;
  if (G > ns) {
    if (bid < ns) { it = bid; step = end; }
    else { it = ns + (bid - ns); step = G - ns; }
  } else { it = bid; step = G; }
  for (; it < end; it += step) scan_item<KIND, DIR>(p, it, lds, dry);
}

template <int KIND>
__device__ __forceinline__ void normgate_phase(const Params& p, const bool dry) {
  const int tid = HTID, lane = tid & 63, w = tid >> 6;
  bf16_t* R0 = (bf16_t*)p.ws;
  for (int idx = VBID * 4 + w; idx < 24576 * 8; idx += VGDIM * 4) {
    const int m = idx >> 3, hh = idx & 7;
    if (KIND == 1) {
      bf16_t* op = R0 + 4 * PLANE_E + (size_t)m * 2048 + hh * 256 + lane * 4;
      const uint2 ov = *(const uint2*)op;
      const uint2 gv = *(const uint2*)(R0 + (size_t)m * 2048 + hh * 256 + lane * 4);
      const float a0 = lo_f(ov.x), a1 = hi_f(ov.x), a2 = lo_f(ov.y), a3 = hi_f(ov.y);
      const float ss = wave_sum(a0 * a0 + a1 * a1 + a2 * a2 + a3 * a3);
      const float rs = rsqrtf(ss * (1.f / 256.f) + 1e-6f);
      if (!dry) *(uint2*)op = make_uint2(pack2(a0 * rs * lo_f(gv.x), a1 * rs * hi_f(gv.x)), pack2(a2 * rs * lo_f(gv.y), a3 * rs * hi_f(gv.y)));
    } else {
      bf16_t* op = R0 + 5 * PLANE_E + (size_t)m * 1024 + hh * 128 + lane * 2;
      const unsigned ov = *(const unsigned*)op;
      const unsigned gv = *(const unsigned*)(R0 + 4 * PLANE_E + (size_t)m * 1024 + hh * 128 + lane * 2);
      const float a0 = lo_f(ov), a1 = hi_f(ov);
      const float ss = wave_sum(a0 * a0 + a1 * a1);
      const float rs = rsqrtf(ss * (1.f / 128.f) + 1e-6f);
      const float2 gn = *(const float2*)(p.in[22] + lane * 2);
      if (!dry) *(unsigned*)op = pack2(a0 * rs * gn.x * lo_f(gv), a1 * rs * gn.y * hi_f(gv));
    }
  }
}

__device__ __forceinline__ void opaque_params(Params& q) {
  asm volatile("" : "+s"(q.out), "+s"(q.ws));
#pragma unroll
  for (int i = 0; i < 23; ++i) asm volatile("" : "+s"(q.in[i]));
}

#if defined(PH_ONLY)
#define PHASE(n, call) if (n == PH_ONLY) { const bool dry = false; call; }
#elif defined(REP_N)
#define PHASE(n, call) if (lo <= n && n < hi) { for (int rep = (n == REP_N ? 0 : 1); rep < 2; ++rep) { const bool dry = (rep == 0); call; if (!(fin && n + 1 == hi && rep == 1)) grid.sync(); } }
#else
#define PHASE(n, call) if (lo <= n && n < hi) { const bool dry = false; call; if (!(fin && n + 1 == hi)) grid.sync(); }
#endif

__device__ __forceinline__ void run_range(const Params& q, int lo, int hi, bool fin, cg::grid_group& grid, unsigned char* lds) {
  unsigned char* ldh = lds + HALFID * HALF_LDS;
  PHASE(0, phase0(q, ldh))
  PHASE(1, post_phase(q, -1, 0, ldh, dry))
  PHASE(2, gemm_phase(q, 0, GM_IN_DA, lds, 2))
  PHASE(3, attn_phase(q, 0, lds, dry, 3))
  PHASE(4, gemm_phase(q, 0, GM_OUT, lds, 4))
  PHASE(5, post_phase(q, 0, 1, ldh, dry))
  PHASE(6, gemm_phase(q, 1, GM_IN_RET_QKV, lds, 6))
  PHASE(7, (scan_phase<1, 0>(q, ldh, dry)))
  PHASE(8, (scan_phase<1, 1>(q, ldh, dry)))
  PHASE(9, gemm_phase(q, 1, GM_IN_RET_G, lds, 9))
  PHASE(10, normgate_phase<1>(q, dry))
  PHASE(11, gemm_phase(q, 1, GM_OUT, lds, 11))
  PHASE(12, post_phase(q, 1, 2, ldh, dry))
  PHASE(13, gemm_phase(q, 2, GM_IN_HG, lds, 13))
  PHASE(14, (scan_phase<2, 0>(q, ldh, dry)))
  PHASE(15, (scan_phase<2, 1>(q, ldh, dry)))
  PHASE(16, normgate_phase<2>(q, dry))
  PHASE(17, gemm_phase(q, 2, GM_OUT, lds, 17))
  PHASE(18, post_phase(q, 2, 3, ldh, dry))
  PHASE(19, gemm_phase(q, 3, GM_IN_DA, lds, 19))
  PHASE(20, attn_phase(q, 3, lds, dry, 20))
  PHASE(21, gemm_phase(q, 3, GM_OUT, lds, 21))
  PHASE(22, post_phase(q, 3, 4, ldh, dry))
}

__global__ void __launch_bounds__(NTHR, 2) mega_fwd(Params p) {
  extern __shared__ __attribute__((aligned(16))) unsigned char lds[];
  cg::grid_group grid = cg::this_grid();
  run_range(p, p.ph_lo, p.ph_hi, true, grid, lds);
}

extern "C" void kernel_launch(void* const* d_in, const int* in_sizes, int n_in, void* d_out, int out_size, void* d_ws, size_t ws_size, hipStream_t stream) {
  static int grid_blocks = 0;
  if (grid_blocks == 0) {
    int dev = 0, cus = 0, per_cu = 0;
    hipGetDevice(&dev);
    hipDeviceGetAttribute(&cus, hipDeviceAttributeMultiprocessorCount, dev);
    hipFuncSetAttribute((const void*)mega_fwd, hipFuncAttributeMaxDynamicSharedMemorySize, LDS_BYTES);
    hipOccupancyMaxActiveBlocksPerMultiprocessor(&per_cu, (const void*)mega_fwd, NTHR, LDS_BYTES);
    if (per_cu < 1) per_cu = 1;
    if (per_cu > 1) per_cu = 1;
    if (cus < 1) cus = 256;
    grid_blocks = cus * per_cu;
    (void)hipGetLastError();
    if (n_in != 23 || ws_size < WS_NEED) { fprintf(stderr, "kernel_launch: unexpected n_in %d / ws_size %zu (need %zu)\n", n_in, ws_size, (size_t)WS_NEED); }
  }
  Params p{};
  for (int i = 0; i < 23; ++i) p.in[i] = (const float*)d_in[i];
  p.out = (float*)d_out;
  p.ws = (unsigned char*)d_ws;
#if ONE_LAUNCH
  p.ph_lo = 0; p.ph_hi = NPH;
  void* args[] = {&p};
  hipError_t e = hipLaunchCooperativeKernel((const void*)mega_fwd, dim3(grid_blocks), dim3(NTHR), args, LDS_BYTES, stream);
  if (e != hipSuccess) fprintf(stderr, "cooperative launch failed: %s (grid %d)\n", hipGetErrorString(e), grid_blocks);
#else
  for (int ph = 0; ph < NPH; ++ph) {
    p.ph_lo = ph; p.ph_hi = ph + 1;
    hipLaunchKernelGGL(mega_fwd, dim3(grid_blocks), dim3(NTHR), LDS_BYTES, stream, p);
  }
#endif
}
```

```cpp
#include <hip/hip_runtime.h>
#include <hip/hip_cooperative_groups.h>
#include <cstdint>
#include <cstdio>
namespace cg = cooperative_groups;

#ifndef ONE_LAUNCH
#define ONE_LAUNCH 1
#endif

typedef unsigned short bf16_t;
typedef short bf16x8 __attribute__((ext_vector_type(8)));
typedef float f32x4 __attribute__((ext_vector_type(4)));

#define NTHR 512
#define HTID ((int)(threadIdx.x & 255))
#define HALFID ((int)(threadIdx.x >> 8))
#define VBID ((int)(blockIdx.x * 2 + (threadIdx.x >> 8)))
#define VGDIM ((int)(gridDim.x * 2))
#define HALF_LDS 74816
#define MIB ((size_t)1 << 20)
#define NPH 23
#define LDS_BYTES (2 * HALF_LDS)
#define LDS_SLOT 74752
#define MISC_CTR (MISC_ROPE + 524288)

#define OFF_WIN  (288 * MIB)
#define OFF_WOUT (300 * MIB)
#define OFF_HP   (304 * MIB)
#define OFF_MISC (320 * MIB)
#define MISC_ROPE 524288
#define WS_NEED  (322 * MIB)
#define PLANE_E  ((size_t)25165824)
#define OUT_YP 0
#define OUT_YS 8388608
#define OUT_CK 25165824
#define OUT_CV 41943040
#define OUT_SR 58720256
#define OUT_SH 75497472

struct Params {
  const float* in[23];
  float* out;
  unsigned char* ws;
  int ph_lo, ph_hi;
};

struct LayerInfo { int kind, slot, IN, WIDTH; const float* w_in; const float* w_out; };

__device__ __forceinline__ LayerInfo layer_info(const Params& p, int l) {
  LayerInfo L;
  if (l == 0)      { L.kind = 0; L.slot = 0; L.IN = 4096; L.WIDTH = 1024; L.w_in = p.in[12]; L.w_out = p.in[13]; }
  else if (l == 1) { L.kind = 1; L.slot = 0; L.IN = 6144; L.WIDTH = 2048; L.w_in = p.in[16]; L.w_out = p.in[17]; }
  else if (l == 2) { L.kind = 2; L.slot = 0; L.IN = 5120; L.WIDTH = 1024; L.w_in = p.in[19]; L.w_out = p.in[20]; }
  else             { L.kind = 0; L.slot = 1; L.IN = 4096; L.WIDTH = 1024; L.w_in = p.in[12] + (size_t)1024 * 4096; L.w_out = p.in[13] + (size_t)1024 * 1024; }
  return L;
}
__device__ __forceinline__ bf16_t* hs_ptr(const Params& p, int l) {
  return l < 3 ? (bf16_t*)(p.out + OUT_SH) : (bf16_t*)(p.ws + 240 * MIB);
}

typedef __bf16 nbf16x2 __attribute__((ext_vector_type(2)));
typedef float f32x2 __attribute__((ext_vector_type(2)));
__device__ __forceinline__ float bf2f(unsigned h) { return __uint_as_float(h << 16); }
__device__ __forceinline__ unsigned pack2(float a, float b) { const f32x2 f = {a, b}; return __builtin_bit_cast(unsigned, __builtin_convertvector(f, nbf16x2)); }
__device__ __forceinline__ float lo_f(unsigned w) { return __uint_as_float(w << 16); }
__device__ __forceinline__ float hi_f(unsigned w) { return __uint_as_float(w & 0xffff0000u); }
__device__ __forceinline__ float silu_f(float x) { return x / (1.f + __expf(-x)); }
__device__ __forceinline__ float wave_sum(float v) {
#pragma unroll
  for (int o = 32; o > 0; o >>= 1) v += __shfl_xor(v, o);
  return v;
}
#define QSCALE 0.18033688011112042f
#define SB __builtin_amdgcn_sched_barrier(0)
#define MFMA(a, b, c) __builtin_amdgcn_mfma_f32_16x16x32_bf16((a), (b), (c), 0, 0, 0)

__device__ __forceinline__ void convT_tile(const float* __restrict__ src, int src_ld, bf16_t* __restrict__ dst, int dst_ld, unsigned char* lds) {
  float* t = (float*)lds;
  const int tid = HTID;
  const int kr = tid >> 4, nc = (tid & 15) * 4;
#pragma unroll
  for (int j = 0; j < 4; ++j) {
    const float4 v = *(const float4*)(src + (size_t)(kr + 16 * j) * src_ld + nc);
    float* tp = t + (kr + 16 * j) * 65 + nc;
    tp[0] = v.x; tp[1] = v.y; tp[2] = v.z; tp[3] = v.w;
  }
  __syncthreads();
  const int n = tid >> 2, kc = (tid & 3) * 16;
  unsigned w[8];
#pragma unroll
  for (int i = 0; i < 8; ++i) w[i] = pack2(t[(kc + 2 * i) * 65 + n], t[(kc + 2 * i + 1) * 65 + n]);
  uint4* d = (uint4*)(dst + (size_t)n * dst_ld + kc);
  d[0] = make_uint4(w[0], w[1], w[2], w[3]);
  d[1] = make_uint4(w[4], w[5], w[6], w[7]);
  __syncthreads();
}

__device__ __forceinline__ int conv_weights_count(const Params& p, int l) {
  const LayerInfo L = layer_info(p, l);
  return (L.IN / 64) * 16 + (L.WIDTH / 64) * 16;
}
__device__ __forceinline__ void conv_weights_item(const Params& p, int l, int it, unsigned char* lds) {
  const LayerInfo L = layer_info(p, l);
  const int nin = (L.IN / 64) * 16;
  if (it < nin) {
    const int kt = it & 15, nt = it >> 4;
    convT_tile(L.w_in + (size_t)(kt * 64) * L.IN + nt * 64, L.IN, (bf16_t*)(p.ws + OFF_WIN) + (size_t)(nt * 64) * 1024 + kt * 64, 1024, lds);
  } else {
    const int it2 = it - nin, nkt = L.WIDTH / 64;
    const int kt = it2 % nkt, nt = it2 / nkt;
    convT_tile(L.w_out + (size_t)(kt * 64) * 1024 + nt * 64, 1024, (bf16_t*)(p.ws + OFF_WOUT) + (size_t)(nt * 64) * L.WIDTH + kt * 64, L.WIDTH, lds);
  }
}

__device__ __forceinline__ void mod_item(const Params& p, int it, unsigned char* lds) {
  float* ssilu = (float*)lds;
  float* red = ssilu + 9 * 1024;
  const int tid = HTID;
  const int l = it / 48, col0 = (it % 48) * 64;
  for (int i = tid; i < 9 * 1024; i += 256) {
    const int v = i >> 10, k = i & 1023;
    const float x = (v == 0) ? p.in[7][k] : p.in[6][(v - 1) * 1024 + k];
    ssilu[i] = silu_f(x);
  }
  __syncthreads();
  const int col = tid & 63, kq = tid >> 6;
  const float* w = p.in[8] + (size_t)l * 1024 * 3072 + col0 + col;
  float acc[9];
#pragma unroll
  for (int v = 0; v < 9; ++v) acc[v] = 0.f;
  for (int k = kq * 256; k < kq * 256 + 256; ++k) {
    const float wv = w[(size_t)k * 3072];
#pragma unroll
    for (int v = 0; v < 9; ++v) acc[v] += ssilu[v * 1024 + k] * wv;
  }
#pragma unroll
  for (int v = 0; v < 9; ++v) red[(kq * 9 + v) * 64 + col] = acc[v];
  __syncthreads();
  float* mod = (float*)(p.ws + OFF_MISC);
  for (int i = tid; i < 9 * 64; i += 256) {
    const int v = i >> 6, cc = i & 63;
    const float s = red[(0 * 9 + v) * 64 + cc] + red[(1 * 9 + v) * 64 + cc] + red[(2 * 9 + v) * 64 + cc] + red[(3 * 9 + v) * 64 + cc];
    mod[(size_t)(l * 9 + v) * 3072 + col0 + cc] = s + p.in[9][l * 3072 + col0 + cc];
  }
  __syncthreads();
}

__device__ __forceinline__ void rope_item(const Params& p, int it) {
  const int idx = it * 256 + HTID;
  const int t = idx >> 5, pp = idx & 31;
  const int pos = pp < 16 ? (t >> 6) : (t & 63);
  const float inv = exp2f(-(float)(pp & 15) * (13.287712379549449f / 16.f));
  const float ang = (float)pos * inv;
  const double a = (double)ang;
  const double r = a - 6.283185307179586 * rint(a * 0.15915494309189535);
  const float rf = (float)r;
  float2* tab = (float2*)(p.ws + OFF_MISC + MISC_ROPE);
  tab[idx] = make_float2(__cosf(rf), __sinf(rf));
}

__device__ __forceinline__ void phase0(const Params& p, unsigned char* lds) {
  const int nw = conv_weights_count(p, 0);
  const int total = 192 + 256 + nw;
  for (int it = VBID; it < total; it += VGDIM) {
    if (it < 192) mod_item(p, it, lds);
    else if (it < 448) rope_item(p, it - 192);
    else conv_weights_item(p, 0, it - 448, lds);
  }
}

__device__ __forceinline__ void post_phase(const Params& p, int lprev, int lnext, unsigned char* lds, const bool dry) {
  const int tid = HTID, lane = tid & 63, w = tid >> 6;
  const float* mod = (const float*)(p.ws + OFF_MISC);
  const bf16_t* Y = nullptr;
  if (lprev >= 0) {
    const int kind = layer_info(p, lprev).kind;
    Y = (const bf16_t*)(p.ws + (kind == 1 ? 96 * MIB : 0));
  }
  bf16_t* hp = (bf16_t*)(p.ws + OFF_HP);
  bf16_t* hs = lnext < 4 ? hs_ptr(p, lnext) : nullptr;
  for (int row = VBID * 4 + w; row < 24576; row += VGDIM * 4) {
    const int mv = row < 8192 ? 0 : 1 + ((row - 8192) >> 11);
    const float* xs = (lprev <= 0) ? (row < 8192 ? p.in[0] + (size_t)row * 1024 : p.in[1] + (size_t)(row - 8192) * 1024) : p.out + (size_t)row * 1024;
    float4 x[4];
#pragma unroll
    for (int j = 0; j < 4; ++j) x[j] = *(const float4*)(xs + lane * 4 + 256 * j);
    if (lprev >= 0) {
      float4 y[4];
      float ss = 0.f;
#pragma unroll
      for (int j = 0; j < 4; ++j) { const uint2 yw = *(const uint2*)(Y + (size_t)row * 1024 + lane * 4 + 256 * j); y[j] = make_float4(lo_f(yw.x), hi_f(yw.x), lo_f(yw.y), hi_f(yw.y)); ss += y[j].x * y[j].x + y[j].y * y[j].y + y[j].z * y[j].z + y[j].w * y[j].w; }
      ss = wave_sum(ss);
      const float rstd = rsqrtf(ss * (1.f / 1024.f) + 1e-6f);
      const float* ga = mod + (size_t)(lprev * 9 + mv) * 3072 + 2048;
      const float* gp = p.in[11] + lprev * 1024;
#pragma unroll
      for (int j = 0; j < 4; ++j) {
        const int c = lane * 4 + 256 * j;
        const float4 g4 = *(const float4*)(ga + c), p4 = *(const float4*)(gp + c);
        x[j].x += g4.x * (y[j].x * rstd * p4.x); x[j].y += g4.y * (y[j].y * rstd * p4.y);
        x[j].z += g4.z * (y[j].z * rstd * p4.z); x[j].w += g4.w * (y[j].w * rstd * p4.w);
        if (!dry) *(float4*)(p.out + (size_t)row * 1024 + c) = x[j];
      }
    }
    if (lnext < 4) {
      float ss = 0.f;
#pragma unroll
      for (int j = 0; j < 4; ++j) ss += x[j].x * x[j].x + x[j].y * x[j].y + x[j].z * x[j].z + x[j].w * x[j].w;
      ss = wave_sum(ss);
      const float rstd = rsqrtf(ss * (1.f / 1024.f) + 1e-6f);
      const float* sh = mod + (size_t)(lnext * 9 + mv) * 3072;
      const float* sc = sh + 1024;
      const float* gp = p.in[10] + lnext * 1024;
      bf16_t* hd = row < 8192 ? hp + (size_t)row * 1024 : hs + (size_t)(row - 8192) * 1024;
#pragma unroll
      for (int j = 0; j < 4; ++j) {
        const int c = lane * 4 + 256 * j;
        const float4 s4 = *(const float4*)(sh + c), c4 = *(const float4*)(sc + c), p4 = *(const float4*)(gp + c);
        const float h0 = x[j].x * rstd * p4.x * (1.f + c4.x) + s4.x, h1 = x[j].y * rstd * p4.y * (1.f + c4.y) + s4.y;
        const float h2 = x[j].z * rstd * p4.z * (1.f + c4.z) + s4.z, h3 = x[j].w * rstd * p4.w * (1.f + c4.w) + s4.w;
        *(uint2*)(hd + c) = make_uint2(pack2(h0, h1), pack2(h2, h3));
      }
    }
  }
  if (lprev >= 0 && lnext < 4) {
    const int nw = conv_weights_count(p, lnext);
    for (int it = VBID; it < nw; it += VGDIM) conv_weights_item(p, lnext, it, lds);
  }
}


__device__ __forceinline__ unsigned xcc_id() { return (unsigned)__builtin_amdgcn_s_getreg((3 << 11) | 20) & 7u; }
__device__ __forceinline__ bool wq_next(unsigned* ctr, int nst, int mult, unsigned xcd, int& qstate, int& q, int& idx, unsigned char* lds) {
  volatile int* slot = (volatile int*)(lds + LDS_SLOT);
  __syncthreads();
  if (HTID == 0) {
    int qq = -1, ii = 0, st = qstate;
    while (st < 8) {
      const int cand = (int)((xcd + (unsigned)st) & 7u);
      const int got = (int)atomicAdd(ctr + cand, 1u);
      if (got < mult * ((nst - cand + 7) >> 3)) { qq = cand; ii = got; break; }
      ++st;
    }
    slot[0] = qq; slot[1] = ii; slot[2] = st;
  }
  __syncthreads();
  q = slot[0]; idx = slot[1]; qstate = slot[2];
  return q >= 0;
}

#define LAS __attribute__((address_space(3)))
template <bool SWAP>
__device__ __forceinline__ void gemm_tile_compute(const bf16_t* __restrict__ Ag, const bf16_t* __restrict__ Bg, int K, unsigned char* lds, f32x4 (&acc)[8][4]) {
  const int tid = threadIdx.x, lane = tid & 63, wid = __builtin_amdgcn_readfirstlane(tid >> 6), wm = wid >> 2, wn = wid & 3;
  const int lr = lane & 15, lg = lane >> 4;
  LAS unsigned char* l3 = (LAS unsigned char*)lds;
  const int prow = lane >> 3;
  const int pgo0 = prow * K + (((lane & 7) ^ ((prow >> 1) & 7)) << 3);
  const int pgo1 = prow * K + (((lane & 7) ^ ((4 + (prow >> 1)) & 7)) << 3);
  const bf16_t* asrc = Ag + (size_t)(wid * 32) * K;
  const bf16_t* bsrc = Bg + (size_t)(wid * 32) * K;
  const size_t pstep = (size_t)8 * K;
#pragma unroll
  for (int mi = 0; mi < 8; ++mi)
#pragma unroll
    for (int ni = 0; ni < 4; ++ni) acc[mi][ni] = (f32x4){0.f, 0.f, 0.f, 0.f};
#define GEMM_STAGE(s, k0)                                                                                                                  \
  {                                                                                                                                        \
    _Pragma("unroll") for (int j = 0; j < 4; ++j) {                                                                                        \
      __builtin_amdgcn_global_load_lds((const unsigned*)(asrc + j * pstep + ((j & 1) ? pgo1 : pgo0) + (k0)), (LAS unsigned*)(l3 + (s) * 65536 + (wid * 4 + j) * 1024), 16, 0, 0);          \
      __builtin_amdgcn_global_load_lds((const unsigned*)(bsrc + j * pstep + ((j & 1) ? pgo1 : pgo0) + (k0)), (LAS unsigned*)(l3 + (s) * 65536 + 32768 + (wid * 4 + j) * 1024), 16, 0, 0);  \
    }                                                                                                                                      \
  }
  const int nk = K >> 6;
  GEMM_STAGE(0, 0);
  asm volatile("s_waitcnt vmcnt(0)" ::: "memory");
  __syncthreads();
  const int x0 = lg ^ ((lr >> 1) & 7);
  const int aoff0 = (wm * 128 + lr) * 128 + x0 * 16, aoff1 = (wm * 128 + lr) * 128 + (x0 ^ 4) * 16;
  const int boff0 = 32768 + (wn * 64 + lr) * 128 + x0 * 16, boff1 = 32768 + (wn * 64 + lr) * 128 + (x0 ^ 4) * 16;
  for (int kt = 0; kt < nk; ++kt) {
    if (kt + 1 < nk) GEMM_STAGE((kt + 1) & 1, (kt + 1) * 64);
    const unsigned char* st = lds + (kt & 1) * 65536;
#pragma unroll
    for (int kk = 0; kk < 2; ++kk) {
      bf16x8 af[8], bfr[4];
#pragma unroll
      for (int ni = 0; ni < 4; ++ni) bfr[ni] = *(const bf16x8*)(st + (kk ? boff1 : boff0) + ni * 2048);
#pragma unroll
      for (int mi = 0; mi < 8; ++mi) af[mi] = *(const bf16x8*)(st + (kk ? aoff1 : aoff0) + mi * 2048);
#pragma unroll
      for (int mi = 0; mi < 8; ++mi)
#pragma unroll
        for (int ni = 0; ni < 4; ++ni)
          acc[mi][ni] = SWAP ? MFMA(bfr[ni], af[mi], acc[mi][ni]) : MFMA(af[mi], bfr[ni], acc[mi][ni]);
    }
    asm volatile("s_waitcnt vmcnt(0)" ::: "memory");
    __syncthreads();
  }
#undef GEMM_STAGE
}

enum { GM_IN_DA = 0, GM_IN_RET_QKV = 1, GM_IN_RET_G = 2, GM_IN_HG = 3, GM_OUT = 4 };

__device__ __forceinline__ void epi_swapped(const Params& p, int mode, int slot, int ykind, int m, int n, f32x4 v) {
  bf16_t* R0 = (bf16_t*)p.ws;
  if (mode == GM_OUT) {
    bf16_t* Y = (bf16_t*)(p.ws + (ykind == 1 ? 96 * MIB : 0));
    *(uint2*)(Y + (size_t)m * 1024 + n) = make_uint2(pack2(v[0], v[1]), pack2(v[2], v[3]));
  } else if (mode == GM_IN_DA) {
    const bool smp = m >= 8192;
    const int ms = m - 8192;
    const int b = smp ? (ms >> 11) : (m >> 8), t = smp ? (ms & 2047) : (m & 255);
    if (n < 2048) {
      if (smp) {
        const float4 cs = *(const float4*)((const float*)(p.ws + OFF_MISC + MISC_ROPE) + (size_t)(t * 32 + ((n & 63) >> 1)) * 2);
        const float a0 = v[0] * cs.x - v[1] * cs.y, a1 = v[0] * cs.y + v[1] * cs.x;
        const float a2 = v[2] * cs.z - v[3] * cs.w, a3 = v[2] * cs.w + v[3] * cs.z;
        v = (f32x4){a0, a1, a2, a3};
      }
      if (n < 1024) {
        *(uint2*)(R0 + (size_t)m * 1024 + n) = make_uint2(pack2(v[0] * QSCALE, v[1] * QSCALE), pack2(v[2] * QSCALE, v[3] * QSCALE));
      } else {
        const int c = n - 1024;
        const uint2 pk = make_uint2(pack2(v[0], v[1]), pack2(v[2], v[3]));
        if (smp) {
          *(uint2*)(R0 + 64 * MIB / 2 + ((size_t)b * 2560 + t) * 1024 + c) = pk;
        } else {
          *(f32x4*)(p.out + OUT_CK + ((size_t)((b * 2 + slot) * 256 + t)) * 1024 + c) = v;
          *(uint2*)(R0 + 48 * MIB / 2 + (size_t)m * 1024 + c) = pk;
        }
      }
    } else {
      *(uint2*)(R0 + 160 * MIB / 2 + (size_t)m * 1024 + (n - 3072)) = make_uint2(pack2(silu_f(v[0]), silu_f(v[1])), pack2(silu_f(v[2]), silu_f(v[3])));
    }
  } else if (mode == GM_IN_RET_QKV) {
    if (n < 1024) *(uint2*)(R0 + (size_t)m * 1024 + n) = make_uint2(pack2(v[0], v[1]), pack2(v[2], v[3]));
    else if (n < 2048) { const float s = 0.08838834764831845f; *(uint2*)(R0 + PLANE_E + (size_t)m * 1024 + (n - 1024)) = make_uint2(pack2(v[0] * s, v[1] * s), pack2(v[2] * s, v[3] * s)); }
    else *(uint2*)(R0 + 2 * PLANE_E + (size_t)m * 2048 + (n - 2048)) = make_uint2(pack2(v[0], v[1]), pack2(v[2], v[3]));
  } else if (mode == GM_IN_RET_G) {
    *(uint2*)(R0 + (size_t)m * 2048 + n) = make_uint2(pack2(silu_f(v[0]), silu_f(v[1])), pack2(silu_f(v[2]), silu_f(v[3])));
  } else {
    if (n < 1024 || n >= 4096) v = (f32x4){silu_f(v[0]), silu_f(v[1]), silu_f(v[2]), silu_f(v[3])};
    *(uint2*)(R0 + (size_t)(n >> 10) * PLANE_E + (size_t)m * 1024 + (n & 1023)) = make_uint2(pack2(v[0], v[1]), pack2(v[2], v[3]));
  }
}

__device__ __forceinline__ void epi_da_v(const Params& p, int slot, int m, int n, f32x4 v) {
  bf16_t* R0 = (bf16_t*)p.ws;
  const int c = n - 2048, hh = c >> 7, e = c & 127;
  const uint2 pk = make_uint2(pack2(v[0], v[1]), pack2(v[2], v[3]));
  if (m >= 8192) {
    const int ms = m - 8192, b = ms >> 11, t = ms & 2047;
    *(uint2*)(R0 + 120 * MIB / 2 + ((size_t)((b * 8 + hh) * 128 + e)) * 2560 + t) = pk;
  } else {
    const int b = m >> 8, t = m & 255;
    float* o = p.out + OUT_CV + ((size_t)((b * 2 + slot) * 256 + t)) * 1024 + c;
    o[0] = v[0]; o[1024] = v[1]; o[2048] = v[2]; o[3072] = v[3];
    *(uint2*)(R0 + 104 * MIB / 2 + ((size_t)((b * 8 + hh) * 128 + e)) * 256 + t) = pk;
  }
}

__device__ __forceinline__ void gemm_phase(const Params& p, int l, int mode, unsigned char* lds, int phid) {
  const LayerInfo L = layer_info(p, l);
  bf16_t* R0 = (bf16_t*)p.ws;
  const bf16_t *Ap, *As, *Bt;
  int K, N;
  if (mode == GM_OUT) {
    K = L.WIDTH; N = 1024; Bt = (const bf16_t*)(p.ws + OFF_WOUT);
    const bf16_t* base = R0 + (L.kind == 0 ? 160 * MIB / 2 : (L.kind == 1 ? 4 * PLANE_E : 5 * PLANE_E));
    Ap = base; As = base + (size_t)8192 * K;
  } else {
    K = 1024; Ap = (const bf16_t*)(p.ws + OFF_HP); As = hs_ptr(p, l);
    Bt = (const bf16_t*)(p.ws + OFF_WIN) + (mode == GM_IN_RET_G ? (size_t)4096 * 1024 : 0);
    N = (mode == GM_IN_DA || mode == GM_IN_RET_QKV) ? 4096 : (mode == GM_IN_RET_G ? 2048 : 5120);
  }
  const int ntn = N >> 8, ntiles = 96 * ntn;
  const int extra = (mode == GM_IN_DA) ? 3072 : 0;
  const int tid = threadIdx.x, lane = tid & 63, wid = tid >> 6, wm = wid >> 2, wn = wid & 3, lr = lane & 15, lg = lane >> 4;
  const int G = gridDim.x;
  const bool swz = (G & 7) == 0;
  const int xcd = blockIdx.x & 7, snn = ntn >> 2, nst = 12 * snn;
  const int q0 = swz ? (int)(blockIdx.x >> 3) : (int)blockIdx.x, qstep = swz ? (G >> 3) : G;
  const int qlen = swz ? 32 * ((nst - xcd + 7) >> 3) : ntiles;
  for (int q = q0; q < qlen; q += qstep) {
    int it = q;
    if (swz) {
      const int st = xcd + 8 * (q >> 5), tin = q & 31;
      const int smt = st / snn, snt = st - smt * snn;
      it = (smt * 8 + (tin >> 2)) * ntn + snt * 4 + (tin & 3);
    }
    if (it < ntiles) {
      const int mt = it / ntn, nt = it - mt * ntn;
      const int m0 = mt * 256, n0 = nt * 256;
      const bf16_t* A = m0 < 8192 ? Ap + (size_t)m0 * K : As + (size_t)(m0 - 8192) * K;
      const bf16_t* B = Bt + (size_t)n0 * K;
      f32x4 acc[8][4];
      if (mode == GM_IN_DA && n0 >= 2048 && n0 < 3072) {
        gemm_tile_compute<false>(A, B, K, lds, acc);
#pragma unroll
        for (int mi = 0; mi < 8; ++mi)
#pragma unroll
          for (int ni = 0; ni < 4; ++ni)
            epi_da_v(p, L.slot, m0 + wm * 128 + mi * 16 + 4 * lg, n0 + wn * 64 + ni * 16 + lr, acc[mi][ni]);
      } else {
        gemm_tile_compute<true>(A, B, K, lds, acc);
#pragma unroll
        for (int mi = 0; mi < 8; ++mi)
#pragma unroll
          for (int ni = 0; ni < 4; ++ni)
            epi_swapped(p, mode, L.slot, L.kind, m0 + wm * 128 + mi * 16 + lr, n0 + wn * 64 + ni * 16 + 4 * lg, acc[mi][ni]);
      }
    }
  }
  for (int ci = VBID; ci < extra; ci += VGDIM) {
    {
      if (ci < 2048) {
        const int idx = (ci * 256 + HTID) * 8;
        const int b = idx >> 19, rem = idx & 524287, tp = rem >> 10, c = rem & 1023;
        const float* src = p.in[2] + ((size_t)((b * 2 + L.slot) * 512 + tp)) * 1024 + c;
        const float4 u0 = *(const float4*)src, u1 = *(const float4*)(src + 4);
        *(uint4*)(R0 + 64 * MIB / 2 + ((size_t)b * 2560 + 2048 + tp) * 1024 + c) = make_uint4(pack2(u0.x, u0.y), pack2(u0.z, u0.w), pack2(u1.x, u1.y), pack2(u1.z, u1.w));
      } else {
        const int i2 = ci - 2048;
        const int b = i2 >> 7, hh = (i2 >> 4) & 7, tt = (i2 >> 1) & 7, et = i2 & 1;
        convT_tile(p.in[3] + ((size_t)((b * 2 + L.slot) * 512 + tt * 64)) * 1024 + hh * 128 + et * 64, 1024,
                   R0 + 120 * MIB / 2 + ((size_t)((b * 8 + hh) * 128 + et * 64)) * 2560 + 2048 + tt * 64, 2560, lds + HALFID * HALF_LDS);
      }
    }
  }
}

__device__ __forceinline__ void attn_phase(const Params& p, int l, unsigned char* lds, const bool dry, int phid) {
  const int slot = l == 3 ? 1 : 0;
  const float lam_init = 0.8f - 0.6f * expf(-0.3f * (float)l);
  const int tid = threadIdx.x, lane = tid & 63, w = tid >> 6, lr = lane & 15, lg = lane >> 4;
  float lam;
  {
    const float* lf = p.in[14] + slot * 256;
    const float a = wave_sum(lf[lane] * lf[64 + lane]);
    const float b2 = wave_sum(lf[128 + lane] * lf[192 + lane]);
    lam = expf(a) - expf(b2) + lam_init;
  }
  bf16_t* R0 = (bf16_t*)p.ws;
  const float* subg = p.in[15] + slot * 128;
  for (int item = blockIdx.x; item < 1536; item += gridDim.x) {
    int grp, b, h, qt;
    if (item < 1024) { grp = 1; b = item >> 7; h = (item >> 4) & 7; qt = item & 15; }
    else { const int i2 = item - 1024; grp = 0; b = i2 >> 4; h = (i2 >> 1) & 7; qt = i2 & 1; }
    const int nkeys = grp ? 2560 : 256, ntile = nkeys >> 6;
    const int mq = (grp ? 8192 + b * 2048 : b * 256) + qt * 128 + w * 16 + lr;
    const bf16_t* Kg = grp ? R0 + 64 * MIB / 2 + (size_t)b * 2560 * 1024 + h * 128 : R0 + 48 * MIB / 2 + (size_t)b * 256 * 1024 + h * 128;
    const bf16_t* Vg = grp ? R0 + 120 * MIB / 2 + (size_t)(b * 8 + h) * 128 * 2560 : R0 + 104 * MIB / 2 + (size_t)(b * 8 + h) * 128 * 256;
    bf16x8 qf[2][2];
#pragma unroll
    for (int sub = 0; sub < 2; ++sub)
#pragma unroll
      for (int ks = 0; ks < 2; ++ks) qf[sub][ks] = *(const bf16x8*)(R0 + (size_t)mq * 1024 + h * 128 + sub * 64 + ks * 32 + lg * 8);
    LAS unsigned char* l3 = (LAS unsigned char*)lds;
    const int wu = __builtin_amdgcn_readfirstlane(w);
    int koff[2], voff[2];
#pragma unroll
    for (int j = 0; j < 2; ++j) {
      const int kr = (wu * 2 + j) * 4 + (lane >> 4);
      koff[j] = kr * 1024 + (((lane & 15) ^ (kr & 15)) << 3);
      const int er = (wu * 2 + j) * 8 + (lane >> 3);
      voff[j] = er * nkeys + (((lane & 7) ^ ((er >> 1) & 7)) << 3);
    }
#define ATT_STAGE_K(s, key0)                                                                                  \
  {                                                                                                           \
    _Pragma("unroll") for (int j = 0; j < 2; ++j)                                                             \
      __builtin_amdgcn_global_load_lds((const unsigned*)(Kg + (size_t)(key0) * 1024 + koff[j]), (LAS unsigned*)(l3 + (s) * 32768 + (wu * 2 + j) * 1024), 16, 0, 0); \
  }
#define ATT_STAGE_V(s, key0)                                                                                  \
  {                                                                                                           \
    _Pragma("unroll") for (int j = 0; j < 2; ++j)                                                             \
      __builtin_amdgcn_global_load_lds((const unsigned*)(Vg + (key0) + voff[j]), (LAS unsigned*)(l3 + (s) * 32768 + 16384 + (wu * 2 + j) * 1024), 16, 0, 0); \
  }
    const int xl = lg ^ lr;
    const int vsw = (lr >> 1) & 7;
    const int vlo = lr * 128 + ((((lg >> 1)) ^ vsw) << 4) + (lg & 1) * 8;
    float mx[2] = {-1e30f, -1e30f}, ls[2] = {0.f, 0.f};
    f32x4 o0[8], o1[8];
#pragma unroll
    for (int et = 0; et < 8; ++et) { o0[et] = (f32x4){0.f, 0.f, 0.f, 0.f}; o1[et] = (f32x4){0.f, 0.f, 0.f, 0.f}; }
    ATT_STAGE_K(0, 0);
    ATT_STAGE_V(0, 0);
    asm volatile("s_waitcnt vmcnt(0)" ::: "memory");
    __syncthreads();
    for (int kt = 0; kt < ntile; ++kt) {
      if (kt + 1 < ntile) { ATT_STAGE_K((kt + 1) & 1, (kt + 1) * 64); ATT_STAGE_V((kt + 1) & 1, (kt + 1) * 64); }
      const unsigned char* ks_ = lds + (kt & 1) * 32768 + lr * 256;
      const unsigned char* vs_ = lds + (kt & 1) * 32768 + 16384;
#pragma unroll
      for (int k2 = 0; k2 < 2; ++k2) {
        bf16x8 kfr[8];
        uint2 vlo_[8], vhi_[8];
#pragma unroll
        for (int sub = 0; sub < 2; ++sub)
#pragma unroll
          for (int nn = 0; nn < 2; ++nn)
#pragma unroll
            for (int ks = 0; ks < 2; ++ks)
              kfr[sub * 4 + nn * 2 + ks] = *(const bf16x8*)(ks_ + (2 * k2 + nn) * 4096 + ((xl ^ (sub * 8 + ks * 4)) << 4));
#pragma unroll
        for (int et = 0; et < 8; ++et) {
          vlo_[et] = *(const uint2*)(vs_ + et * 2048 + (vlo ^ (k2 << 6)));
          vhi_[et] = *(const uint2*)(vs_ + et * 2048 + (vlo ^ (k2 << 6) ^ 32));
        }
        SB;
        f32x4 s[2][2];
#pragma unroll
        for (int sub = 0; sub < 2; ++sub)
#pragma unroll
          for (int nn = 0; nn < 2; ++nn) {
            s[sub][nn] = MFMA(kfr[sub * 4 + nn * 2], qf[sub][0], ((f32x4){0.f, 0.f, 0.f, 0.f}));
            s[sub][nn] = MFMA(kfr[sub * 4 + nn * 2 + 1], qf[sub][1], s[sub][nn]);
          }
        SB;
        bf16x8 pf[2];
        float tmx[2];
#pragma unroll
        for (int sub = 0; sub < 2; ++sub) {
          float tm = fmaxf(fmaxf(fmaxf(s[sub][0][0], s[sub][0][1]), fmaxf(s[sub][0][2], s[sub][0][3])), fmaxf(fmaxf(s[sub][1][0], s[sub][1][1]), fmaxf(s[sub][1][2], s[sub][1][3])));
          tm = fmaxf(tm, __shfl_xor(tm, 16));
          tm = fmaxf(tm, __shfl_xor(tm, 32));
          tmx[sub] = tm;
        }
        if (__any((tmx[0] > mx[0] + 8.f) || (tmx[1] > mx[1] + 8.f))) {
#pragma unroll
          for (int sub = 0; sub < 2; ++sub) {
            const float mn = (tmx[sub] > mx[sub] + 8.f) ? tmx[sub] : mx[sub];
            const float sc = __builtin_amdgcn_exp2f(mx[sub] - mn);
            mx[sub] = mn;
            ls[sub] *= sc;
#pragma unroll
            for (int et = 0; et < 8; ++et) {
              if (sub == 0) { o0[et][0] *= sc; o0[et][1] *= sc; o0[et][2] *= sc; o0[et][3] *= sc; }
              else { o1[et][0] *= sc; o1[et][1] *= sc; o1[et][2] *= sc; o1[et][3] *= sc; }
            }
          }
        }
#pragma unroll
        for (int sub = 0; sub < 2; ++sub) {
          unsigned pw[4];
          float acc = 0.f;
#pragma unroll
          for (int nn = 0; nn < 2; ++nn) {
            float a[4];
#pragma unroll
            for (int r = 0; r < 4; ++r) { a[r] = __builtin_amdgcn_exp2f(s[sub][nn][r] - mx[sub]); acc += a[r]; }
            pw[nn * 2] = pack2(a[0], a[1]);
            pw[nn * 2 + 1] = pack2(a[2], a[3]);
          }
          ls[sub] += acc;
          union { unsigned u[4]; bf16x8 v; } cp;
          cp.u[0] = pw[0]; cp.u[1] = pw[1]; cp.u[2] = pw[2]; cp.u[3] = pw[3];
          pf[sub] = cp.v;
        }
        SB;
#pragma unroll
        for (int et = 0; et < 8; ++et) {
          union { unsigned u[4]; bf16x8 v; } cv;
          cv.u[0] = vlo_[et].x; cv.u[1] = vlo_[et].y; cv.u[2] = vhi_[et].x; cv.u[3] = vhi_[et].y;
          o0[et] = MFMA(cv.v, pf[0], o0[et]);
          o1[et] = MFMA(cv.v, pf[1], o1[et]);
        }
        SB;
      }
      asm volatile("s_waitcnt vmcnt(0)" ::: "memory");
      __syncthreads();
    }
    f32x4 o[8];
    {
      float t0 = ls[0], t1 = ls[1];
      t0 += __shfl_xor(t0, 16); t0 += __shfl_xor(t0, 32);
      t1 += __shfl_xor(t1, 16); t1 += __shfl_xor(t1, 32);
      const float c1 = 1.f / t0, c2 = lam / t1;
#pragma unroll
      for (int et = 0; et < 8; ++et)
#pragma unroll
        for (int r = 0; r < 4; ++r) o[et][r] = o0[et][r] * c1 - o1[et][r] * c2;
    }
#undef ATT_STAGE_K
#undef ATT_STAGE_V
    float ss = 0.f;
#pragma unroll
    for (int et = 0; et < 8; ++et)
#pragma unroll
      for (int r = 0; r < 4; ++r) ss += o[et][r] * o[et][r];
    ss += __shfl_xor(ss, 16);
    ss += __shfl_xor(ss, 32);
    const float rs = rsqrtf(ss * (1.f / 128.f) + 1e-6f) * (1.f - lam_init);
    bf16_t* gp = R0 + 160 * MIB / 2 + (size_t)mq * 1024 + h * 128;
#pragma unroll
    for (int et = 0; et < 8; ++et) {
      const int e0 = 16 * et + 4 * lg;
      const uint2 g = *(const uint2*)(gp + e0);
      const float4 sg = *(const float4*)(subg + e0);
      const float v0 = o[et][0] * rs * sg.x * lo_f(g.x), v1 = o[et][1] * rs * sg.y * hi_f(g.x);
      const float v2 = o[et][2] * rs * sg.z * lo_f(g.y), v3 = o[et][3] * rs * sg.w * hi_f(g.y);
      if (!dry) *(uint2*)(gp + e0) = make_uint2(pack2(v0, v1), pack2(v2, v3));
    }
  }
}

template <int KIND, int DIR>
__device__ __forceinline__ void scan_item(const Params& p, int item, unsigned char* lds, const bool dry) {
  constexpr int DV = KIND == 1 ? 256 : 128, NSL = DV / 64, LDV = KIND == 1 ? 2048 : 1024;
  const int tid = HTID, lane = tid & 63, w = tid >> 6, lr = lane & 15, lg = lane >> 4;
  int grp, b, h, sl;
  {
    int it = item;
    if (it < 64 * NSL) grp = 1; else { grp = 0; it -= 64 * NSL; }
    sl = it % NSL; h = (it / NSL) & 7; b = it / (NSL * 8);
  }
  const int T = grp ? 2048 : 256, nch = T >> 6;
  const size_t mbase = grp ? (size_t)8192 + (size_t)b * 2048 : (size_t)b * 256;
  bf16_t* R0 = (bf16_t*)p.ws;
  const bf16_t* Qg = R0 + mbase * 1024 + h * 128;
  const bf16_t* Kg = R0 + (KIND == 1 ? PLANE_E : (DIR ? 2 * PLANE_E : PLANE_E)) + mbase * 1024 + h * 128;
  const bf16_t* Vg = R0 + (KIND == 1 ? 2 * PLANE_E : 3 * PLANE_E) + mbase * LDV + h * DV + sl * 64;
  bf16_t* Og = R0 + (KIND == 1 ? 4 * PLANE_E : 5 * PLANE_E) + mbase * LDV + h * DV + sl * 64;
  unsigned char* Qs = lds;
  unsigned char* X = lds + 17408;
  unsigned char* Vt = lds + 35840;
  unsigned char* StS = lds + 45056;
  unsigned char* Pm = lds + 62464;
  float* xch = (float*)(lds + 71680);
  float* blA = xch + 512;
  float* erA = xch + 640;
  const int dp = tid & 63, tq = tid >> 6, r0 = tq * 16, d0 = dp * 2;
  float cst0, cst1;
  if (KIND == 1) { cst0 = cst1 = log1pf(-expf(p.in[18][DIR * 8 + h])); }
  else {
    const float* lbp = p.in[21] + DIR * 4096 + h * 128 + d0;
    {
      const float x0 = lbp[0], x1 = lbp[1024], x2 = lbp[2048], x3 = lbp[3072];
      const float m = fmaxf(fmaxf(x0, x1), fmaxf(x2, x3));
      const float e0 = expf(x0 - m), e1 = expf(x1 - m), e2 = expf(x2 - m), e3 = expf(x3 - m);
      cst0 = (e1 + e2) / (e0 + e1 + e2 + e3);
    }
    {
      const float x0 = lbp[1], x1 = lbp[1025], x2 = lbp[2049], x3 = lbp[3073];
      const float m = fmaxf(fmaxf(x0, x1), fmaxf(x2, x3));
      const float e0 = expf(x0 - m), e1 = expf(x1 - m), e2 = expf(x2 - m), e3 = expf(x3 - m);
      cst1 = (e1 + e2) / (e0 + e1 + e2 + e3);
    }
  }
  f32x4 S[8];
  if (grp) {
    const float* s0 = (KIND == 1 ? p.in[4] : p.in[5]) + ((size_t)((b * 2 + DIR) * 8 + h) * 128) * DV + sl * 64 + 16 * w + lr + (size_t)(4 * lg) * DV;
    asm volatile("" : "+v"(s0));
#pragma unroll
    for (int dt = 0; dt < 8; ++dt)
#pragma unroll
      for (int r = 0; r < 4; ++r) S[dt][r] = s0[(16 * dt + r) * DV];
  } else {
#pragma unroll
    for (int dt = 0; dt < 8; ++dt) S[dt] = (f32x4){0.f, 0.f, 0.f, 0.f};
  }
  unsigned qv[16], kv[16], vv[8];
  const int ve2 = tid & 31, vq = tid >> 5;
  const int qoff = r0 * 512 + dp;
  const int voff = (8 * vq) * (LDV / 2) + ve2;
  const unsigned* Qg32 = (const unsigned*)Qg;
  const unsigned* Kg32 = (const unsigned*)Kg;
  const unsigned* Vg32 = (const unsigned*)Vg;
#define SCAN_ISSUE(c)                                                                                   \
  {                                                                                                     \
    const unsigned* q_ = Qg32 + (size_t)(c) * (64 * 512) + qoff;                                        \
    const unsigned* k_ = Kg32 + (size_t)(c) * (64 * 512) + qoff;                                        \
    const unsigned* v_ = Vg32 + (size_t)(c) * (64 * (LDV / 2)) + voff;                                  \
    asm volatile("" : "+v"(q_), "+v"(k_), "+v"(v_));                                                    \
    _Pragma("unroll") for (int i = 0; i < 16; ++i) { qv[i] = q_[i * 512]; kv[i] = k_[i * 512]; }        \
    _Pragma("unroll") for (int i = 0; i < 8; ++i) vv[i] = v_[i * (LDV / 2)];                            \
  }
  SCAN_ISSUE(DIR ? nch - 1 : 0);
  for (int ci = 0; ci < nch; ++ci) {
    const int c = DIR ? nch - 1 - ci : ci;
    float tot0 = 0.f, tot1 = 0.f;
    if (KIND == 1) { tot0 = tot1 = 16.f * cst0; }
    else {
#pragma unroll
      for (int i = 0; i < 16; ++i) {
        const float s0_ = 1.f / (1.f + __expf(-lo_f(kv[i]))), s1_ = 1.f / (1.f + __expf(-hi_f(kv[i])));
        tot0 += __logf(cst0 + (1.f - cst0) * s0_);
        tot1 += __logf(cst1 + (1.f - cst1) * s1_);
      }
    }
    *(float2*)(xch + tq * 128 + d0) = make_float2(tot0, tot1);
    __syncthreads();
    const float2 t0 = *(const float2*)(xch + d0), t1 = *(const float2*)(xch + 128 + d0), t2 = *(const float2*)(xch + 256 + d0), t3 = *(const float2*)(xch + 384 + d0);
    const float blast0 = (t0.x + t1.x) + (t2.x + t3.x), blast1 = (t0.y + t1.y) + (t2.y + t3.y);
    float ref0, ref1, run0, run1;
    if (DIR == 0) {
      ref0 = t0.x + t1.x; ref1 = t0.y + t1.y;
      run0 = (tq > 0 ? t0.x : 0.f) + (tq > 1 ? t1.x : 0.f) + (tq > 2 ? t2.x : 0.f);
      run1 = (tq > 0 ? t0.y : 0.f) + (tq > 1 ? t1.y : 0.f) + (tq > 2 ? t2.y : 0.f);
    } else {
      ref0 = t2.x + t3.x; ref1 = t2.y + t3.y;
      run0 = (tq < 3 ? t3.x : 0.f) + (tq < 2 ? t2.x : 0.f) + (tq < 1 ? t1.x : 0.f);
      run1 = (tq < 3 ? t3.y : 0.f) + (tq < 2 ? t2.y : 0.f) + (tq < 1 ? t1.y : 0.f);
    }
    unsigned ktp0[8], ktp1[8];
#pragma unroll
    for (int jj = 0; jj < 8; ++jj) {
      const int j = DIR ? 7 - jj : jj;
      float ka[2], kb[2];
#pragma unroll
      for (int hh = 0; hh < 2; ++hh) {
        const int i = 2 * j + (DIR ? 1 - hh : hh);
        float g0, g1, k0, k1;
        if (KIND == 1) { g0 = g1 = cst0; k0 = lo_f(kv[i]); k1 = hi_f(kv[i]); }
        else {
          const float s0_ = 1.f / (1.f + __expf(-lo_f(kv[i]))), s1_ = 1.f / (1.f + __expf(-hi_f(kv[i])));
          g0 = __logf(cst0 + (1.f - cst0) * s0_); g1 = __logf(cst1 + (1.f - cst1) * s1_);
          k0 = (1.f - cst0) * (1.f - s0_); k1 = (1.f - cst1) * (1.f - s1_);
        }
        run0 += g0; run1 += g1;
        *(unsigned*)(Qs + (r0 + i) * 272 + d0 * 2) = pack2(lo_f(qv[i]) * __expf(run0 - ref0), hi_f(qv[i]) * __expf(run1 - ref1));
        *(unsigned*)(X + (r0 + i) * 272 + d0 * 2) = pack2(k0 * __expf(ref0 - run0), k1 * __expf(ref1 - run1));
        ka[i & 1] = k0 * __expf(blast0 - run0);
        kb[i & 1] = k1 * __expf(blast1 - run1);
      }
      ktp0[j] = pack2(ka[0], ka[1]);
      ktp1[j] = pack2(kb[0], kb[1]);
    }
    if (tq == 0) { *(float2*)(blA + d0) = make_float2(__expf(blast0), __expf(blast1)); *(float2*)(erA + d0) = make_float2(__expf(ref0), __expf(ref1)); }
    {
      const unsigned a0 = (vv[0] & 0xffffu) | (vv[1] << 16), a1 = (vv[2] & 0xffffu) | (vv[3] << 16), a2 = (vv[4] & 0xffffu) | (vv[5] << 16), a3 = (vv[6] & 0xffffu) | (vv[7] << 16);
      const unsigned b0 = (vv[0] >> 16) | (vv[1] & 0xffff0000u), b1 = (vv[2] >> 16) | (vv[3] & 0xffff0000u), b2 = (vv[4] >> 16) | (vv[5] & 0xffff0000u), b3 = (vv[6] >> 16) | (vv[7] & 0xffff0000u);
      *(uint4*)(Vt + (2 * ve2) * 144 + vq * 16) = make_uint4(a0, a1, a2, a3);
      *(uint4*)(Vt + (2 * ve2 + 1) * 144 + vq * 16) = make_uint4(b0, b1, b2, b3);
    }
    if (ci + 1 < nch) { SCAN_ISSUE(DIR ? c - 1 : c + 1); }
    __syncthreads();
#pragma unroll
    for (int dt = 0; dt < 8; ++dt) {
      const float4 er4 = *(const float4*)(erA + 16 * dt + 4 * lg);
      *(uint2*)(StS + (16 * w + lr) * 272 + (16 * dt + 4 * lg) * 2) = make_uint2(pack2(S[dt][0] * er4.x, S[dt][1] * er4.y), pack2(S[dt][2] * er4.z, S[dt][3] * er4.w));
    }
    bf16x8 qf[4];
#pragma unroll
    for (int ks = 0; ks < 4; ++ks) qf[ks] = *(const bf16x8*)(Qs + (16 * w + lr) * 272 + ks * 64 + lg * 16);
    uint2 pv[4];
    {
      const int t = 16 * w + lr;
#pragma unroll
      for (int st = 0; st < 4; ++st) {
        f32x4 s = (f32x4){0.f, 0.f, 0.f, 0.f};
#pragma unroll
        for (int ks = 0; ks < 4; ++ks) {
          const bf16x8 kf = *(const bf16x8*)(X + (16 * st + lr) * 272 + ks * 64 + lg * 16);
          s = MFMA(kf, qf[ks], s);
        }
        float v[4];
#pragma unroll
        for (int r = 0; r < 4; ++r) {
          const int si = 16 * st + 4 * lg + r;
          const bool keep = DIR ? (t <= si) : (t >= si);
          v[r] = keep ? s[r] : 0.f;
        }
        pv[st] = make_uint2(pack2(v[0], v[1]), pack2(v[2], v[3]));
      }
    }
    __syncthreads();
#pragma unroll
    for (int st = 0; st < 4; ++st) *(uint2*)(Pm + (16 * w + lr) * 144 + (16 * st + 4 * lg) * 2) = pv[st];
    *(uint4*)(X + d0 * 144 + r0 * 2) = make_uint4(ktp0[0], ktp0[1], ktp0[2], ktp0[3]);
    *(uint4*)(X + d0 * 144 + r0 * 2 + 16) = make_uint4(ktp0[4], ktp0[5], ktp0[6], ktp0[7]);
    *(uint4*)(X + (d0 + 1) * 144 + r0 * 2) = make_uint4(ktp1[0], ktp1[1], ktp1[2], ktp1[3]);
    *(uint4*)(X + (d0 + 1) * 144 + r0 * 2 + 16) = make_uint4(ktp1[4], ktp1[5], ktp1[6], ktp1[7]);
    __syncthreads();
    {
      bf16x8 pf[2];
#pragma unroll
      for (int ks = 0; ks < 2; ++ks) pf[ks] = *(const bf16x8*)(Pm + (16 * w + lr) * 144 + ks * 64 + lg * 16);
#pragma unroll
      for (int et = 0; et < 4; ++et) {
        f32x4 o = (f32x4){0.f, 0.f, 0.f, 0.f};
#pragma unroll
        for (int ks = 0; ks < 2; ++ks) {
          const bf16x8 vf = *(const bf16x8*)(Vt + (16 * et + lr) * 144 + ks * 64 + lg * 16);
          o = MFMA(vf, pf[ks], o);
        }
#pragma unroll
        for (int ks = 0; ks < 4; ++ks) {
          const bf16x8 sf = *(const bf16x8*)(StS + (16 * et + lr) * 272 + ks * 64 + lg * 16);
          o = MFMA(sf, qf[ks], o);
        }
        bf16_t* op = Og + (size_t)(c * 64 + 16 * w + lr) * LDV + 16 * et + 4 * lg;
        if (DIR) {
          const uint2 old = *(const uint2*)op;
          o[0] += lo_f(old.x); o[1] += hi_f(old.x); o[2] += lo_f(old.y); o[3] += hi_f(old.y);
        }
        if (!(DIR && dry)) *(uint2*)op = make_uint2(pack2(o[0], o[1]), pack2(o[2], o[3]));
      }
    }
    {
      bf16x8 vtf[2];
#pragma unroll
      for (int ks = 0; ks < 2; ++ks) vtf[ks] = *(const bf16x8*)(Vt + (16 * w + lr) * 144 + ks * 64 + lg * 16);
#pragma unroll
      for (int dt = 0; dt < 8; ++dt) {
        const float4 bl4 = *(const float4*)(blA + 16 * dt + 4 * lg);
        S[dt][0] *= bl4.x; S[dt][1] *= bl4.y; S[dt][2] *= bl4.z; S[dt][3] *= bl4.w;
#pragma unroll
        for (int ks = 0; ks < 2; ++ks) {
          const bf16x8 kf = *(const bf16x8*)(X + (16 * dt + lr) * 144 + ks * 64 + lg * 16);
          S[dt] = MFMA(kf, vtf[ks], S[dt]);
        }
      }
    }
    __syncthreads();
  }
#undef SCAN_ISSUE
  if (!grp) {
    float* so = p.out + (KIND == 1 ? OUT_SR : OUT_SH) + ((size_t)((b * 2 + DIR) * 8 + h) * 128) * DV + sl * 64 + 16 * w + lr + (size_t)(4 * lg) * DV;
    asm volatile("" : "+v"(so));
#pragma unroll
    for (int dt = 0; dt < 8; ++dt)
#pragma unroll
      for (int r = 0; r < 4; ++r) so[(16 * dt + r) * DV] = S[dt][r];
  }
}

template <int KIND, int DIR>
__device__ __forceinline__ void scan_phase(const Params& p, unsigned char* lds, const bool dry) {
  constexpr int NSL = (KIND == 1 ? 256 : 128) / 64;
  const int ns = 64 * NSL, npr = 256 * NSL;
  const int G = VGDIM, bid = VBID;
  int it, step, end = ns + npr;
  if (G > ns) {
    if (bid < ns) { it = bid; step = end; }
    else { it = ns + (bid - ns); step = G - ns; }
  } else { it = bid; step = G; }
  for (; it < end; it += step) scan_item<KIND, DIR>(p, it, lds, dry);
}

template <int KIND>
__device__ __forceinline__ void normgate_phase(const Params& p, const bool dry) {
  const int tid = HTID, lane = tid & 63, w = tid >> 6;
  bf16_t* R0 = (bf16_t*)p.ws;
  for (int idx = VBID * 4 + w; idx < 24576 * 8; idx += VGDIM * 4) {
    const int m = idx >> 3, hh = idx & 7;
    if (KIND == 1) {
      bf16_t* op = R0 + 4 * PLANE_E + (size_t)m * 2048 + hh * 256 + lane * 4;
      const uint2 ov = *(const uint2*)op;
      const uint2 gv = *(const uint2*)(R0 + (size_t)m * 2048 + hh * 256 + lane * 4);
      const float a0 = lo_f(ov.x), a1 = hi_f(ov.x), a2 = lo_f(ov.y), a3 = hi_f(ov.y);
      const float ss = wave_sum(a0 * a0 + a1 * a1 + a2 * a2 + a3 * a3);
      const float rs = rsqrtf(ss * (1.f / 256.f) + 1e-6f);
      if (!dry) *(uint2*)op = make_uint2(pack2(a0 * rs * lo_f(gv.x), a1 * rs * hi_f(gv.x)), pack2(a2 * rs * lo_f(gv.y), a3 * rs * hi_f(gv.y)));
    } else {
      bf16_t* op = R0 + 5 * PLANE_E + (size_t)m * 1024 + hh * 128 + lane * 2;
      const unsigned ov = *(const unsigned*)op;
      const unsigned gv = *(const unsigned*)(R0 + 4 * PLANE_E + (size_t)m * 1024 + hh * 128 + lane * 2);
      const float a0 = lo_f(ov), a1 = hi_f(ov);
      const float ss = wave_sum(a0 * a0 + a1 * a1);
      const float rs = rsqrtf(ss * (1.f / 128.f) + 1e-6f);
      const float2 gn = *(const float2*)(p.in[22] + lane * 2);
      if (!dry) *(unsigned*)op = pack2(a0 * rs * gn.x * lo_f(gv), a1 * rs * gn.y * hi_f(gv));
    }
  }
}

__device__ __forceinline__ void opaque_params(Params& q) {
  asm volatile("" : "+s"(q.out), "+s"(q.ws));
#pragma unroll
  for (int i = 0; i < 23; ++i) asm volatile("" : "+s"(q.in[i]));
}

#if defined(PH_ONLY)
#define PHASE(n, call) if (n == PH_ONLY) { const bool dry = false; call; }
#elif defined(REP_N)
#define PHASE(n, call) if (lo <= n && n < hi) { for (int rep = (n == REP_N ? 0 : 1); rep < 2; ++rep) { const bool dry = (rep == 0); call; if (!(fin && n + 1 == hi && rep == 1)) grid.sync(); } }
#else
#define PHASE(n, call) if (lo <= n && n < hi) { const bool dry = false; call; if (!(fin && n + 1 == hi)) grid.sync(); }
#endif

__device__ __forceinline__ void run_range(const Params& q, int lo, int hi, bool fin, cg::grid_group& grid, unsigned char* lds) {
  unsigned char* ldh = lds + HALFID * HALF_LDS;
  PHASE(0, phase0(q, ldh))
  PHASE(1, post_phase(q, -1, 0, ldh, dry))
  PHASE(2, gemm_phase(q, 0, GM_IN_DA, lds, 2))
  PHASE(3, attn_phase(q, 0, lds, dry, 3))
  PHASE(4, gemm_phase(q, 0, GM_OUT, lds, 4))
  PHASE(5, post_phase(q, 0, 1, ldh, dry))
  PHASE(6, gemm_phase(q, 1, GM_IN_RET_QKV, lds, 6))
  PHASE(7, (scan_phase<1, 0>(q, ldh, dry)))
  PHASE(8, (scan_phase<1, 1>(q, ldh, dry)))
  PHASE(9, gemm_phase(q, 1, GM_IN_RET_G, lds, 9))
  PHASE(10, normgate_phase<1>(q, dry))
  PHASE(11, gemm_phase(q, 1, GM_OUT, lds, 11))
  PHASE(12, post_phase(q, 1, 2, ldh, dry))
  PHASE(13, gemm_phase(q, 2, GM_IN_HG, lds, 13))
  PHASE(14, (scan_phase<2, 0>(q, ldh, dry)))
  PHASE(15, (scan_phase<2, 1>(q, ldh, dry)))
  PHASE(16, normgate_phase<2>(q, dry))
  PHASE(17, gemm_phase(q, 2, GM_OUT, lds, 17))
  PHASE(18, post_phase(q, 2, 3, ldh, dry))
  PHASE(19, gemm_phase(q, 3, GM_IN_DA, lds, 19))
  PHASE(20, attn_phase(q, 3, lds, dry, 20))
  PHASE(21, gemm_phase(q, 3, GM_OUT, lds, 21))
  PHASE(22, post_phase(q, 3, 4, ldh, dry))
}

__global__ void __launch_bounds__(NTHR, 2) mega_fwd(Params p) {
  extern __shared__ __attribute__((aligned(16))) unsigned char lds[];
  cg::grid_group grid = cg::this_grid();
  run_range(p, p.ph_lo, p.ph_hi, true, grid, lds);
}

extern "C" void kernel_launch(void* const* d_in, const int* in_sizes, int n_in, void* d_out, int out_size, void* d_ws, size_t ws_size, hipStream_t stream) {
  static int grid_blocks = 0;
  if (grid_blocks == 0) {
    int dev = 0, cus = 0, per_cu = 0;
    hipGetDevice(&dev);
    hipDeviceGetAttribute(&cus, hipDeviceAttributeMultiprocessorCount, dev);
    hipFuncSetAttribute((const void*)mega_fwd, hipFuncAttributeMaxDynamicSharedMemorySize, LDS_BYTES);
    hipOccupancyMaxActiveBlocksPerMultiprocessor(&per_cu, (const void*)mega_fwd, NTHR, LDS_BYTES);
    if (per_cu < 1) per_cu = 1;
    if (per_cu > 1) per_cu = 1;
    if (cus < 1) cus = 256;
    grid_blocks = cus * per_cu;
    (void)hipGetLastError();
    if (n_in != 23 || ws_size < WS_NEED) { fprintf(stderr, "kernel_launch: unexpected n_in %d / ws_size %zu (need %zu)\n", n_in, ws_size, (size_t)WS_NEED); }
  }
  Params p{};
  for (int i = 0; i < 23; ++i) p.in[i] = (const float*)d_in[i];
  p.out = (float*)d_out;
  p.ws = (unsigned char*)d_ws;
#if ONE_LAUNCH
  p.ph_lo = 0; p.ph_hi = NPH;
  void* args[] = {&p};
  hipError_t e = hipLaunchCooperativeKernel((const void*)mega_fwd, dim3(grid_blocks), dim3(NTHR), args, LDS_BYTES, stream);
  if (e != hipSuccess) fprintf(stderr, "cooperative launch failed: %s (grid %d)\n", hipGetErrorString(e), grid_blocks);
#else
  for (int ph = 0; ph < NPH; ++ph) {
    p.ph_lo = ph; p.ph_hi = ph + 1;
    hipLaunchKernelGGL(mega_fwd, dim3(grid_blocks), dim3(NTHR), LDS_BYTES, stream, p);
  }
#endif
}
```

```cpp
#include <hip/hip_runtime.h>
#include <hip/hip_cooperative_groups.h>
#include <cstdint>
#include <cstdio>
namespace cg = cooperative_groups;

#ifndef ONE_LAUNCH
#define ONE_LAUNCH 1
#endif

typedef unsigned short bf16_t;
typedef short bf16x8 __attribute__((ext_vector_type(8)));
typedef float f32x4 __attribute__((ext_vector_type(4)));

#define NTHR 512
#define HTID ((int)(threadIdx.x & 255))
#define HALFID ((int)(threadIdx.x >> 8))
#define VBID ((int)(blockIdx.x * 2 + (threadIdx.x >> 8)))
#define VGDIM ((int)(gridDim.x * 2))
#define HALF_LDS 74816
#define MIB ((size_t)1 << 20)
#define NPH 23
#define LDS_BYTES (2 * HALF_LDS)
#define LDS_SLOT 74752
#define MISC_CTR (MISC_ROPE + 524288)

#define OFF_WIN  (288 * MIB)
#define OFF_WOUT (300 * MIB)
#define OFF_HP   (304 * MIB)
#define OFF_MISC (320 * MIB)
#define MISC_ROPE 524288
#define WS_NEED  (322 * MIB)
#define PLANE_E  ((size_t)25165824)
#define OUT_YP 0
#define OUT_YS 8388608
#define OUT_CK 25165824
#define OUT_CV 41943040
#define OUT_SR 58720256
#define OUT_SH 75497472

struct Params {
  const float* in[23];
  float* out;
  unsigned char* ws;
  int ph_lo, ph_hi;
};

struct LayerInfo { int kind, slot, IN, WIDTH; const float* w_in; const float* w_out; };

__device__ __forceinline__ LayerInfo layer_info(const Params& p, int l) {
  LayerInfo L;
  if (l == 0)      { L.kind = 0; L.slot = 0; L.IN = 4096; L.WIDTH = 1024; L.w_in = p.in[12]; L.w_out = p.in[13]; }
  else if (l == 1) { L.kind = 1; L.slot = 0; L.IN = 6144; L.WIDTH = 2048; L.w_in = p.in[16]; L.w_out = p.in[17]; }
  else if (l == 2) { L.kind = 2; L.slot = 0; L.IN = 5120; L.WIDTH = 1024; L.w_in = p.in[19]; L.w_out = p.in[20]; }
  else             { L.kind = 0; L.slot = 1; L.IN = 4096; L.WIDTH = 1024; L.w_in = p.in[12] + (size_t)1024 * 4096; L.w_out = p.in[13] + (size_t)1024 * 1024; }
  return L;
}
__device__ __forceinline__ bf16_t* hs_ptr(const Params& p, int l) {
  return l < 3 ? (bf16_t*)(p.out + OUT_SH) : (bf16_t*)(p.ws + 240 * MIB);
}

typedef __bf16 nbf16x2 __attribute__((ext_vector_type(2)));
typedef float f32x2 __attribute__((ext_vector_type(2)));
__device__ __forceinline__ float bf2f(unsigned h) { return __uint_as_float(h << 16); }
__device__ __forceinline__ unsigned pack2(float a, float b) { const f32x2 f = {a, b}; return __builtin_bit_cast(unsigned, __builtin_convertvector(f, nbf16x2)); }
__device__ __forceinline__ float lo_f(unsigned w) { return __uint_as_float(w << 16); }
__device__ __forceinline__ float hi_f(unsigned w) { return __uint_as_float(w & 0xffff0000u); }
__device__ __forceinline__ float silu_f(float x) { return x / (1.f + __expf(-x)); }
__device__ __forceinline__ float wave_sum(float v) {
#pragma unroll
  for (int o = 32; o > 0; o >>= 1) v += __shfl_xor(v, o);
  return v;
}
#define QSCALE 0.18033688011112042f
#define SB __builtin_amdgcn_sched_barrier(0)
#define MFMA(a, b, c) __builtin_amdgcn_mfma_f32_16x16x32_bf16((a), (b), (c), 0, 0, 0)

__device__ __forceinline__ void convT_tile(const float* __restrict__ src, int src_ld, bf16_t* __restrict__ dst, int dst_ld, unsigned char* lds) {
  float* t = (float*)lds;
  const int tid = HTID;
  const int kr = tid >> 4, nc = (tid & 15) * 4;
#pragma unroll
  for (int j = 0; j < 4; ++j) {
    const float4 v = *(const float4*)(src + (size_t)(kr + 16 * j) * src_ld + nc);
    float* tp = t + (kr + 16 * j) * 65 + nc;
    tp[0] = v.x; tp[1] = v.y; tp[2] = v.z; tp[3] = v.w;
  }
  __syncthreads();
  const int n = tid >> 2, kc = (tid & 3) * 16;
  unsigned w[8];
#pragma unroll
  for (int i = 0; i < 8; ++i) w[i] = pack2(t[(kc + 2 * i) * 65 + n], t[(kc + 2 * i + 1) * 65 + n]);
  uint4* d = (uint4*)(dst + (size_t)n * dst_ld + kc);
  d[0] = make_uint4(w[0], w[1], w[2], w[3]);
  d[1] = make_uint4(w[4], w[5], w[6], w[7]);
  __syncthreads();
}

__device__ __forceinline__ int conv_weights_count(const Params& p, int l) {
  const LayerInfo L = layer_info(p, l);
  return (L.IN / 64) * 16 + (L.WIDTH / 64) * 16;
}
__device__ __forceinline__ void conv_weights_item(const Params& p, int l, int it, unsigned char* lds) {
  const LayerInfo L = layer_info(p, l);
  const int nin = (L.IN / 64) * 16;
  if (it < nin) {
    const int kt = it & 15, nt = it >> 4;
    convT_tile(L.w_in + (size_t)(kt * 64) * L.IN + nt * 64, L.IN, (bf16_t*)(p.ws + OFF_WIN) + (size_t)(nt * 64) * 1024 + kt * 64, 1024, lds);
  } else {
    const int it2 = it - nin, nkt = L.WIDTH / 64;
    const int kt = it2 % nkt, nt = it2 / nkt;
    convT_tile(L.w_out + (size_t)(kt * 64) * 1024 + nt * 64, 1024, (bf16_t*)(p.ws + OFF_WOUT) + (size_t)(nt * 64) * L.WIDTH + kt * 64, L.WIDTH, lds);
  }
}

__device__ __forceinline__ void mod_item(const Params& p, int it, unsigned char* lds) {
  float* ssilu = (float*)lds;
  float* red = ssilu + 9 * 1024;
  const int tid = HTID;
  const int l = it / 48, col0 = (it % 48) * 64;
  for (int i = tid; i < 9 * 1024; i += 256) {
    const int v = i >> 10, k = i & 1023;
    const float x = (v == 0) ? p.in[7][k] : p.in[6][(v - 1) * 1024 + k];
    ssilu[i] = silu_f(x);
  }
  __syncthreads();
  const int col = tid & 63, kq = tid >> 6;
  const float* w = p.in[8] + (size_t)l * 1024 * 3072 + col0 + col;
  float acc[9];
#pragma unroll
  for (int v = 0; v < 9; ++v) acc[v] = 0.f;
  for (int k = kq * 256; k < kq * 256 + 256; ++k) {
    const float wv = w[(size_t)k * 3072];
#pragma unroll
    for (int v = 0; v < 9; ++v) acc[v] += ssilu[v * 1024 + k] * wv;
  }
#pragma unroll
  for (int v = 0; v < 9; ++v) red[(kq * 9 + v) * 64 + col] = acc[v];
  __syncthreads();
  float* mod = (float*)(p.ws + OFF_MISC);
  for (int i = tid; i < 9 * 64; i += 256) {
    const int v = i >> 6, cc = i & 63;
    const float s = red[(0 * 9 + v) * 64 + cc] + red[(1 * 9 + v) * 64 + cc] + red[(2 * 9 + v) * 64 + cc] + red[(3 * 9 + v) * 64 + cc];
    mod[(size_t)(l * 9 + v) * 3072 + col0 + cc] = s + p.in[9][l * 3072 + col0 + cc];
  }
  __syncthreads();
}

__device__ __forceinline__ void rope_item(const Params& p, int it) {
  const int idx = it * 256 + HTID;
  const int t = idx >> 5, pp = idx & 31;
  const int pos = pp < 16 ? (t >> 6) : (t & 63);
  const float inv = exp2f(-(float)(pp & 15) * (13.287712379549449f / 16.f));
  const float ang = (float)pos * inv;
  const double a = (double)ang;
  const double r = a - 6.283185307179586 * rint(a * 0.15915494309189535);
  const float rf = (float)r;
  float2* tab = (float2*)(p.ws + OFF_MISC + MISC_ROPE);
  tab[idx] = make_float2(__cosf(rf), __sinf(rf));
}

__device__ __forceinline__ void phase0(const Params& p, unsigned char* lds) {
  const int nw = conv_weights_count(p, 0);
  const int total = 192 + 256 + nw;
  for (int it = VBID; it < total; it += VGDIM) {
    if (it < 192) mod_item(p, it, lds);
    else if (it < 448) rope_item(p, it - 192);
    else conv_weights_item(p, 0, it - 448, lds);
  }
}

__device__ __forceinline__ void post_phase(const Params& p, int lprev, int lnext, unsigned char* lds, const bool dry) {
  const int tid = HTID, lane = tid & 63, w = tid >> 6;
  const float* mod = (const float*)(p.ws + OFF_MISC);
  const bf16_t* Y = nullptr;
  if (lprev >= 0) {
    const int kind = layer_info(p, lprev).kind;
    Y = (const bf16_t*)(p.ws + (kind == 1 ? 96 * MIB : 0));
  }
  bf16_t* hp = (bf16_t*)(p.ws + OFF_HP);
  bf16_t* hs = lnext < 4 ? hs_ptr(p, lnext) : nullptr;
  for (int row = VBID * 4 + w; row < 24576; row += VGDIM * 4) {
    const int mv = row < 8192 ? 0 : 1 + ((row - 8192) >> 11);
    const float* xs = (lprev <= 0) ? (row < 8192 ? p.in[0] + (size_t)row * 1024 : p.in[1] + (size_t)(row - 8192) * 1024) : p.out + (size_t)row * 1024;
    float4 x[4];
#pragma unroll
    for (int j = 0; j < 4; ++j) x[j] = *(const float4*)(xs + lane * 4 + 256 * j);
    if (lprev >= 0) {
      float4 y[4];
      float ss = 0.f;
#pragma unroll
      for (int j = 0; j < 4; ++j) { const uint2 yw = *(const uint2*)(Y + (size_t)row * 1024 + lane * 4 + 256 * j); y[j] = make_float4(lo_f(yw.x), hi_f(yw.x), lo_f(yw.y), hi_f(yw.y)); ss += y[j].x * y[j].x + y[j].y * y[j].y + y[j].z * y[j].z + y[j].w * y[j].w; }
      ss = wave_sum(ss);
      const float rstd = rsqrtf(ss * (1.f / 1024.f) + 1e-6f);
      const float* ga = mod + (size_t)(lprev * 9 + mv) * 3072 + 2048;
      const float* gp = p.in[11] + lprev * 1024;
#pragma unroll
      for (int j = 0; j < 4; ++j) {
        const int c = lane * 4 + 256 * j;
        const float4 g4 = *(const float4*)(ga + c), p4 = *(const float4*)(gp + c);
        x[j].x += g4.x * (y[j].x * rstd * p4.x); x[j].y += g4.y * (y[j].y * rstd * p4.y);
        x[j].z += g4.z * (y[j].z * rstd * p4.z); x[j].w += g4.w * (y[j].w * rstd * p4.w);
        if (!dry) *(float4*)(p.out + (size_t)row * 1024 + c) = x[j];
      }
    }
    if (lnext < 4) {
      float ss = 0.f;
#pragma unroll
      for (int j = 0; j < 4; ++j) ss += x[j].x * x[j].x + x[j].y * x[j].y + x[j].z * x[j].z + x[j].w * x[j].w;
      ss = wave_sum(ss);
      const float rstd = rsqrtf(ss * (1.f / 1024.f) + 1e-6f);
      const float* sh = mod + (size_t)(lnext * 9 + mv) * 3072;
      const float* sc = sh + 1024;
      const float* gp = p.in[10] + lnext * 1024;
      bf16_t* hd = row < 8192 ? hp + (size_t)row * 1024 : hs + (size_t)(row - 8192) * 1024;
#pragma unroll
      for (int j = 0; j < 4; ++j) {
        const int c = lane * 4 + 256 * j;
        const float4 s4 = *(const float4*)(sh + c), c4 = *(const float4*)(sc + c), p4 = *(const float4*)(gp + c);
        const float h0 = x[j].x * rstd * p4.x * (1.f + c4.x) + s4.x, h1 = x[j].y * rstd * p4.y * (1.f + c4.y) + s4.y;
        const float h2 = x[j].z * rstd * p4.z * (1.f + c4.z) + s4.z, h3 = x[j].w * rstd * p4.w * (1.f + c4.w) + s4.w;
        *(uint2*)(hd + c) = make_uint2(pack2(h0, h1), pack2(h2, h3));
      }
    }
  }
  if (lprev >= 0 && lnext < 4) {
    const int nw = conv_weights_count(p, lnext);
    for (int it = VBID; it < nw; it += VGDIM) conv_weights_item(p, lnext, it, lds);
  }
}


__device__ __forceinline__ unsigned xcc_id() { return (unsigned)__builtin_amdgcn_s_getreg((3 << 11) | 20) & 7u; }
__device__ __forceinline__ bool wq_next(unsigned* ctr, int nst, int mult, unsigned xcd, int& qstate, int& q, int& idx, unsigned char* lds) {
  volatile int* slot = (volatile int*)(lds + LDS_SLOT);
  __syncthreads();
  if (HTID == 0) {
    int qq = -1, ii = 0, st = qstate;
    while (st < 8) {
      const int cand = (int)((xcd + (unsigned)st) & 7u);
      const int got = (int)atomicAdd(ctr + cand, 1u);
      if (got < mult * ((nst - cand + 7) >> 3)) { qq = cand; ii = got; break; }
      ++st;
    }
    slot[0] = qq; slot[1] = ii; slot[2] = st;
  }
  __syncthreads();
  q = slot[0]; idx = slot[1]; qstate = slot[2];
  return q >= 0;
}

#define LAS __attribute__((address_space(3)))
template <bool SWAP>
__device__ __forceinline__ void gemm_tile_compute(const bf16_t* __restrict__ Ag, const bf16_t* __restrict__ Bg, int K, unsigned char* lds, f32x4 (&acc)[8][4],
                                                  const bool pre, const bf16_t* __restrict__ An, const bf16_t* __restrict__ Bn, const bool hasn) {
  const int tid = threadIdx.x, lane = tid & 63, wid = __builtin_amdgcn_readfirstlane(tid >> 6), wm = wid >> 2, wn = wid & 3;
  const int lr = lane & 15, lg = lane >> 4;
  LAS unsigned char* l3 = (LAS unsigned char*)lds;
  const int prow = lane >> 3;
  const int pgo0 = prow * K + (((lane & 7) ^ ((prow >> 1) & 7)) << 3);
  const int pgo1 = prow * K + (((lane & 7) ^ ((4 + (prow >> 1)) & 7)) << 3);
  const bf16_t* asrc = Ag + (size_t)(wid * 32) * K;
  const bf16_t* bsrc = Bg + (size_t)(wid * 32) * K;
  const size_t pstep = (size_t)8 * K;
#pragma unroll
  for (int mi = 0; mi < 8; ++mi)
#pragma unroll
    for (int ni = 0; ni < 4; ++ni) acc[mi][ni] = (f32x4){0.f, 0.f, 0.f, 0.f};
#define GEMM_STAGE_P(ap_, bp_, s, k0)                                                                                                      \
  {                                                                                                                                        \
    _Pragma("unroll") for (int j = 0; j < 4; ++j) {                                                                                        \
      __builtin_amdgcn_global_load_lds((const unsigned*)((ap_) + j * pstep + ((j & 1) ? pgo1 : pgo0) + (k0)), (LAS unsigned*)(l3 + (s) * 65536 + (wid * 4 + j) * 1024), 16, 0, 0);          \
      __builtin_amdgcn_global_load_lds((const unsigned*)((bp_) + j * pstep + ((j & 1) ? pgo1 : pgo0) + (k0)), (LAS unsigned*)(l3 + (s) * 65536 + 32768 + (wid * 4 + j) * 1024), 16, 0, 0);  \
    }                                                                                                                                      \
  }
#define GEMM_STAGE(s, k0) GEMM_STAGE_P(asrc, bsrc, s, k0)
  const int nk = K >> 6;
  if (!pre) GEMM_STAGE(0, 0);
  asm volatile("s_waitcnt vmcnt(0)" ::: "memory");
  __syncthreads();
  const int x0 = lg ^ ((lr >> 1) & 7);
  const int aoff0 = (wm * 128 + lr) * 128 + x0 * 16, aoff1 = (wm * 128 + lr) * 128 + (x0 ^ 4) * 16;
  const int boff0 = 32768 + (wn * 64 + lr) * 128 + x0 * 16, boff1 = 32768 + (wn * 64 + lr) * 128 + (x0 ^ 4) * 16;
  for (int kt = 0; kt < nk; ++kt) {
    if (kt + 1 < nk) GEMM_STAGE((kt + 1) & 1, (kt + 1) * 64);
    const unsigned char* st = lds + (kt & 1) * 65536;
#pragma unroll
    for (int kk = 0; kk < 2; ++kk) {
      bf16x8 af[8], bfr[4];
#pragma unroll
      for (int ni = 0; ni < 4; ++ni) bfr[ni] = *(const bf16x8*)(st + (kk ? boff1 : boff0) + ni * 2048);
#pragma unroll
      for (int mi = 0; mi < 8; ++mi) af[mi] = *(const bf16x8*)(st + (kk ? aoff1 : aoff0) + mi * 2048);
#pragma unroll
      for (int mi = 0; mi < 8; ++mi)
#pragma unroll
        for (int ni = 0; ni < 4; ++ni)
          acc[mi][ni] = SWAP ? MFMA(bfr[ni], af[mi], acc[mi][ni]) : MFMA(af[mi], bfr[ni], acc[mi][ni]);
    }
    asm volatile("s_waitcnt vmcnt(0)" ::: "memory");
    __syncthreads();
  }
  if (hasn) { const bf16_t* an_ = An + (size_t)(wid * 32) * K; const bf16_t* bn_ = Bn + (size_t)(wid * 32) * K; GEMM_STAGE_P(an_, bn_, 0, 0); }
#undef GEMM_STAGE
#undef GEMM_STAGE_P
}

enum { GM_IN_DA = 0, GM_IN_RET_QKV = 1, GM_IN_RET_G = 2, GM_IN_HG = 3, GM_OUT = 4 };

__device__ __forceinline__ void epi_swapped(const Params& p, int mode, int slot, int ykind, int m, int n, f32x4 v) {
  bf16_t* R0 = (bf16_t*)p.ws;
  if (mode == GM_OUT) {
    bf16_t* Y = (bf16_t*)(p.ws + (ykind == 1 ? 96 * MIB : 0));
    *(uint2*)(Y + (size_t)m * 1024 + n) = make_uint2(pack2(v[0], v[1]), pack2(v[2], v[3]));
  } else if (mode == GM_IN_DA) {
    const bool smp = m >= 8192;
    const int ms = m - 8192;
    const int b = smp ? (ms >> 11) : (m >> 8), t = smp ? (ms & 2047) : (m & 255);
    if (n < 2048) {
      if (smp) {
        const float4 cs = *(const float4*)((const float*)(p.ws + OFF_MISC + MISC_ROPE) + (size_t)(t * 32 + ((n & 63) >> 1)) * 2);
        const float a0 = v[0] * cs.x - v[1] * cs.y, a1 = v[0] * cs.y + v[1] * cs.x;
        const float a2 = v[2] * cs.z - v[3] * cs.w, a3 = v[2] * cs.w + v[3] * cs.z;
        v = (f32x4){a0, a1, a2, a3};
      }
      if (n < 1024) {
        *(uint2*)(R0 + (size_t)m * 1024 + n) = make_uint2(pack2(v[0] * QSCALE, v[1] * QSCALE), pack2(v[2] * QSCALE, v[3] * QSCALE));
      } else {
        const int c = n - 1024;
        const uint2 pk = make_uint2(pack2(v[0], v[1]), pack2(v[2], v[3]));
        if (smp) {
          *(uint2*)(R0 + 64 * MIB / 2 + ((size_t)b * 2560 + t) * 1024 + c) = pk;
        } else {
          *(f32x4*)(p.out + OUT_CK + ((size_t)((b * 2 + slot) * 256 + t)) * 1024 + c) = v;
          *(uint2*)(R0 + 48 * MIB / 2 + (size_t)m * 1024 + c) = pk;
        }
      }
    } else {
      *(uint2*)(R0 + 160 * MIB / 2 + (size_t)m * 1024 + (n - 3072)) = make_uint2(pack2(silu_f(v[0]), silu_f(v[1])), pack2(silu_f(v[2]), silu_f(v[3])));
    }
  } else if (mode == GM_IN_RET_QKV) {
    if (n < 1024) *(uint2*)(R0 + (size_t)m * 1024 + n) = make_uint2(pack2(v[0], v[1]), pack2(v[2], v[3]));
    else if (n < 2048) { const float s = 0.08838834764831845f; *(uint2*)(R0 + PLANE_E + (size_t)m * 1024 + (n - 1024)) = make_uint2(pack2(v[0] * s, v[1] * s), pack2(v[2] * s, v[3] * s)); }
    else *(uint2*)(R0 + 2 * PLANE_E + (size_t)m * 2048 + (n - 2048)) = make_uint2(pack2(v[0], v[1]), pack2(v[2], v[3]));
  } else if (mode == GM_IN_RET_G) {
    *(uint2*)(R0 + (size_t)m * 2048 + n) = make_uint2(pack2(silu_f(v[0]), silu_f(v[1])), pack2(silu_f(v[2]), silu_f(v[3])));
  } else {
    if (n < 1024 || n >= 4096) v = (f32x4){silu_f(v[0]), silu_f(v[1]), silu_f(v[2]), silu_f(v[3])};
    *(uint2*)(R0 + (size_t)(n >> 10) * PLANE_E + (size_t)m * 1024 + (n & 1023)) = make_uint2(pack2(v[0], v[1]), pack2(v[2], v[3]));
  }
}

__device__ __forceinline__ void epi_da_v(const Params& p, int slot, int m, int n, f32x4 v) {
  bf16_t* R0 = (bf16_t*)p.ws;
  const int c = n - 2048, hh = c >> 7, e = c & 127;
  const uint2 pk = make_uint2(pack2(v[0], v[1]), pack2(v[2], v[3]));
  if (m >= 8192) {
    const int ms = m - 8192, b = ms >> 11, t = ms & 2047;
    *(uint2*)(R0 + 120 * MIB / 2 + ((size_t)((b * 8 + hh) * 128 + e)) * 2560 + t) = pk;
  } else {
    const int b = m >> 8, t = m & 255;
    float* o = p.out + OUT_CV + ((size_t)((b * 2 + slot) * 256 + t)) * 1024 + c;
    o[0] = v[0]; o[1024] = v[1]; o[2048] = v[2]; o[3072] = v[3];
    *(uint2*)(R0 + 104 * MIB / 2 + ((size_t)((b * 8 + hh) * 128 + e)) * 256 + t) = pk;
  }
}

__device__ __forceinline__ void gemm_phase(const Params& p, int l, int mode, unsigned char* lds, int phid) {
  const LayerInfo L = layer_info(p, l);
  bf16_t* R0 = (bf16_t*)p.ws;
  const bf16_t *Ap, *As, *Bt;
  int K, N;
  if (mode == GM_OUT) {
    K = L.WIDTH; N = 1024; Bt = (const bf16_t*)(p.ws + OFF_WOUT);
    const bf16_t* base = R0 + (L.kind == 0 ? 160 * MIB / 2 : (L.kind == 1 ? 4 * PLANE_E : 5 * PLANE_E));
    Ap = base; As = base + (size_t)8192 * K;
  } else {
    K = 1024; Ap = (const bf16_t*)(p.ws + OFF_HP); As = hs_ptr(p, l);
    Bt = (const bf16_t*)(p.ws + OFF_WIN) + (mode == GM_IN_RET_G ? (size_t)4096 * 1024 : 0);
    N = (mode == GM_IN_DA || mode == GM_IN_RET_QKV) ? 4096 : (mode == GM_IN_RET_G ? 2048 : 5120);
  }
  const int ntn = N >> 8, ntiles = 96 * ntn;
  const int extra = (mode == GM_IN_DA) ? 3072 : 0;
  const int tid = threadIdx.x, lane = tid & 63, wid = tid >> 6, wm = wid >> 2, wn = wid & 3, lr = lane & 15, lg = lane >> 4;
  const int G = gridDim.x;
  const bool swz = (G & 7) == 0;
  const int xcd = blockIdx.x & 7, snn = ntn >> 2, nst = 12 * snn;
  const int q0 = swz ? (int)(blockIdx.x >> 3) : (int)blockIdx.x, qstep = swz ? (G >> 3) : G;
  const int qlen = swz ? 32 * ((nst - xcd + 7) >> 3) : ntiles;
#define GEMM_TILE_OF(qq, m0_, n0_)                                                   \
  {                                                                                    \
    int it_ = (qq);                                                                    \
    if (swz) {                                                                         \
      const int st_ = xcd + 8 * ((qq) >> 5), tin_ = (qq) & 31;                         \
      const int smt_ = st_ / snn, snt_ = st_ - smt_ * snn;                             \
      it_ = (smt_ * 8 + (tin_ >> 2)) * ntn + snt_ * 4 + (tin_ & 3);                    \
    }                                                                                  \
    const int mt_ = it_ / ntn;                                                         \
    m0_ = mt_ * 256; n0_ = (it_ - mt_ * ntn) * 256;                                    \
  }
  bool pre = false;
  for (int q = q0; q < qlen; q += qstep) {
    int m0, n0;
    GEMM_TILE_OF(q, m0, n0)
    const bf16_t* A = m0 < 8192 ? Ap + (size_t)m0 * K : As + (size_t)(m0 - 8192) * K;
    const bf16_t* B = Bt + (size_t)n0 * K;
    const bool hasn = q + qstep < qlen;
    const bf16_t *An = A, *Bn = B;
    if (hasn) {
      int m1, n1;
      GEMM_TILE_OF(q + qstep, m1, n1)
      An = m1 < 8192 ? Ap + (size_t)m1 * K : As + (size_t)(m1 - 8192) * K;
      Bn = Bt + (size_t)n1 * K;
    }
    {
      f32x4 acc[8][4];
      if (mode == GM_IN_DA && n0 >= 2048 && n0 < 3072) {
        gemm_tile_compute<false>(A, B, K, lds, acc, pre, An, Bn, hasn);
#pragma unroll
        for (int mi = 0; mi < 8; ++mi)
#pragma unroll
          for (int ni = 0; ni < 4; ++ni)
            epi_da_v(p, L.slot, m0 + wm * 128 + mi * 16 + 4 * lg, n0 + wn * 64 + ni * 16 + lr, acc[mi][ni]);
      } else {
        gemm_tile_compute<true>(A, B, K, lds, acc, pre, An, Bn, hasn);
#pragma unroll
        for (int mi = 0; mi < 8; ++mi)
#pragma unroll
          for (int ni = 0; ni < 4; ++ni)
            epi_swapped(p, mode, L.slot, L.kind, m0 + wm * 128 + mi * 16 + lr, n0 + wn * 64 + ni * 16 + 4 * lg, acc[mi][ni]);
      }
    }
    pre = hasn;
  }
#undef GEMM_TILE_OF
  if (extra) { asm volatile("s_waitcnt vmcnt(0)" ::: "memory"); __syncthreads(); }
  for (int ci = VBID; ci < extra; ci += VGDIM) {
    {
      if (ci < 2048) {
        const int idx = (ci * 256 + HTID) * 8;
        const int b = idx >> 19, rem = idx & 524287, tp = rem >> 10, c = rem & 1023;
        const float* src = p.in[2] + ((size_t)((b * 2 + L.slot) * 512 + tp)) * 1024 + c;
        const float4 u0 = *(const float4*)src, u1 = *(const float4*)(src + 4);
        *(uint4*)(R0 + 64 * MIB / 2 + ((size_t)b * 2560 + 2048 + tp) * 1024 + c) = make_uint4(pack2(u0.x, u0.y), pack2(u0.z, u0.w), pack2(u1.x, u1.y), pack2(u1.z, u1.w));
      } else {
        const int i2 = ci - 2048;
        const int b = i2 >> 7, hh = (i2 >> 4) & 7, tt = (i2 >> 1) & 7, et = i2 & 1;
        convT_tile(p.in[3] + ((size_t)((b * 2 + L.slot) * 512 + tt * 64)) * 1024 + hh * 128 + et * 64, 1024,
                   R0 + 120 * MIB / 2 + ((size_t)((b * 8 + hh) * 128 + et * 64)) * 2560 + 2048 + tt * 64, 2560, lds + HALFID * HALF_LDS);
      }
    }
  }
}

__device__ __forceinline__ void attn_phase(const Params& p, int l, unsigned char* lds, const bool dry, int phid) {
  const int slot = l == 3 ? 1 : 0;
  const float lam_init = 0.8f - 0.6f * expf(-0.3f * (float)l);
  const int tid = threadIdx.x, lane = tid & 63, w = tid >> 6, lr = lane & 15, lg = lane >> 4;
  float lam;
  {
    const float* lf = p.in[14] + slot * 256;
    const float a = wave_sum(lf[lane] * lf[64 + lane]);
    const float b2 = wave_sum(lf[128 + lane] * lf[192 + lane]);
    lam = expf(a) - expf(b2) + lam_init;
  }
  bf16_t* R0 = (bf16_t*)p.ws;
  const float* subg = p.in[15] + slot * 128;
  for (int item = blockIdx.x; item < 1536; item += gridDim.x) {
    int grp, b, h, qt;
    if (item < 1024) { grp = 1; b = item >> 7; h = (item >> 4) & 7; qt = item & 15; }
    else { const int i2 = item - 1024; grp = 0; b = i2 >> 4; h = (i2 >> 1) & 7; qt = i2 & 1; }
    const int nkeys = grp ? 2560 : 256, ntile = nkeys >> 6;
    const int mq = (grp ? 8192 + b * 2048 : b * 256) + qt * 128 + w * 16 + lr;
    const bf16_t* Kg = grp ? R0 + 64 * MIB / 2 + (size_t)b * 2560 * 1024 + h * 128 : R0 + 48 * MIB / 2 + (size_t)b * 256 * 1024 + h * 128;
    const bf16_t* Vg = grp ? R0 + 120 * MIB / 2 + (size_t)(b * 8 + h) * 128 * 2560 : R0 + 104 * MIB / 2 + (size_t)(b * 8 + h) * 128 * 256;
    bf16x8 qf[2][2];
#pragma unroll
    for (int sub = 0; sub < 2; ++sub)
#pragma unroll
      for (int ks = 0; ks < 2; ++ks) qf[sub][ks] = *(const bf16x8*)(R0 + (size_t)mq * 1024 + h * 128 + sub * 64 + ks * 32 + lg * 8);
    LAS unsigned char* l3 = (LAS unsigned char*)lds;
    const int wu = __builtin_amdgcn_readfirstlane(w);
    int koff[2], voff[2];
#pragma unroll
    for (int j = 0; j < 2; ++j) {
      const int kr = (wu * 2 + j) * 4 + (lane >> 4);
      koff[j] = kr * 1024 + (((lane & 15) ^ (kr & 15)) << 3);
      const int er = (wu * 2 + j) * 8 + (lane >> 3);
      voff[j] = er * nkeys + (((lane & 7) ^ ((er >> 1) & 7)) << 3);
    }
#define ATT_STAGE_K(s, key0)                                                                                  \
  {                                                                                                           \
    _Pragma("unroll") for (int j = 0; j < 2; ++j)                                                             \
      __builtin_amdgcn_global_load_lds((const unsigned*)(Kg + (size_t)(key0) * 1024 + koff[j]), (LAS unsigned*)(l3 + (s) * 32768 + (wu * 2 + j) * 1024), 16, 0, 0); \
  }
#define ATT_STAGE_V(s, key0)                                                                                  \
  {                                                                                                           \
    _Pragma("unroll") for (int j = 0; j < 2; ++j)                                                             \
      __builtin_amdgcn_global_load_lds((const unsigned*)(Vg + (key0) + voff[j]), (LAS unsigned*)(l3 + (s) * 32768 + 16384 + (wu * 2 + j) * 1024), 16, 0, 0); \
  }
    const int xl = lg ^ lr;
    const int vsw = (lr >> 1) & 7;
    const int vlo = lr * 128 + ((((lg >> 1)) ^ vsw) << 4) + (lg & 1) * 8;
    float mx[2] = {-1e30f, -1e30f}, ls[2] = {0.f, 0.f};
    f32x4 o0[8], o1[8];
#pragma unroll
    for (int et = 0; et < 8; ++et) { o0[et] = (f32x4){0.f, 0.f, 0.f, 0.f}; o1[et] = (f32x4){0.f, 0.f, 0.f, 0.f}; }
    ATT_STAGE_K(0, 0);
    ATT_STAGE_V(0, 0);
    asm volatile("s_waitcnt vmcnt(0)" ::: "memory");
    __syncthreads();
    for (int kt = 0; kt < ntile; ++kt) {
      if (kt + 1 < ntile) { ATT_STAGE_K((kt + 1) & 1, (kt + 1) * 64); ATT_STAGE_V((kt + 1) & 1, (kt + 1) * 64); }
      const unsigned char* ks_ = lds + (kt & 1) * 32768 + lr * 256;
      const unsigned char* vs_ = lds + (kt & 1) * 32768 + 16384;
#pragma unroll
      for (int k2 = 0; k2 < 2; ++k2) {
        bf16x8 kfr[8];
        uint2 vlo_[8], vhi_[8];
#pragma unroll
        for (int sub = 0; sub < 2; ++sub)
#pragma unroll
          for (int nn = 0; nn < 2; ++nn)
#pragma unroll
            for (int ks = 0; ks < 2; ++ks)
              kfr[sub * 4 + nn * 2 + ks] = *(const bf16x8*)(ks_ + (2 * k2 + nn) * 4096 + ((xl ^ (sub * 8 + ks * 4)) << 4));
#pragma unroll
        for (int et = 0; et < 8; ++et) {
          vlo_[et] = *(const uint2*)(vs_ + et * 2048 + (vlo ^ (k2 << 6)));
          vhi_[et] = *(const uint2*)(vs_ + et * 2048 + (vlo ^ (k2 << 6) ^ 32));
        }
        SB;
        f32x4 s[2][2];
#pragma unroll
        for (int sub = 0; sub < 2; ++sub)
#pragma unroll
          for (int nn = 0; nn < 2; ++nn) {
            s[sub][nn] = MFMA(kfr[sub * 4 + nn * 2], qf[sub][0], ((f32x4){0.f, 0.f, 0.f, 0.f}));
            s[sub][nn] = MFMA(kfr[sub * 4 + nn * 2 + 1], qf[sub][1], s[sub][nn]);
          }
        SB;
        bf16x8 pf[2];
        float tmx[2];
#pragma unroll
        for (int sub = 0; sub < 2; ++sub) {
          float tm = fmaxf(fmaxf(fmaxf(s[sub][0][0], s[sub][0][1]), fmaxf(s[sub][0][2], s[sub][0][3])), fmaxf(fmaxf(s[sub][1][0], s[sub][1][1]), fmaxf(s[sub][1][2], s[sub][1][3])));
          tm = fmaxf(tm, __shfl_xor(tm, 16));
          tm = fmaxf(tm, __shfl_xor(tm, 32));
          tmx[sub] = tm;
        }
        if (__any((tmx[0] > mx[0] + 8.f) || (tmx[1] > mx[1] + 8.f))) {
#pragma unroll
          for (int sub = 0; sub < 2; ++sub) {
            const float mn = (tmx[sub] > mx[sub] + 8.f) ? tmx[sub] : mx[sub];
            const float sc = __builtin_amdgcn_exp2f(mx[sub] - mn);
            mx[sub] = mn;
            ls[sub] *= sc;
#pragma unroll
            for (int et = 0; et < 8; ++et) {
              if (sub == 0) { o0[et][0] *= sc; o0[et][1] *= sc; o0[et][2] *= sc; o0[et][3] *= sc; }
              else { o1[et][0] *= sc; o1[et][1] *= sc; o1[et][2] *= sc; o1[et][3] *= sc; }
            }
          }
        }
#pragma unroll
        for (int sub = 0; sub < 2; ++sub) {
          unsigned pw[4];
          float acc = 0.f;
#pragma unroll
          for (int nn = 0; nn < 2; ++nn) {
            float a[4];
#pragma unroll
            for (int r = 0; r < 4; ++r) { a[r] = __builtin_amdgcn_exp2f(s[sub][nn][r] - mx[sub]); acc += a[r]; }
            pw[nn * 2] = pack2(a[0], a[1]);
            pw[nn * 2 + 1] = pack2(a[2], a[3]);
          }
          ls[sub] += acc;
          union { unsigned u[4]; bf16x8 v; } cp;
          cp.u[0] = pw[0]; cp.u[1] = pw[1]; cp.u[2] = pw[2]; cp.u[3] = pw[3];
          pf[sub] = cp.v;
        }
        SB;
#pragma unroll
        for (int et = 0; et < 8; ++et) {
          union { unsigned u[4]; bf16x8 v; } cv;
          cv.u[0] = vlo_[et].x; cv.u[1] = vlo_[et].y; cv.u[2] = vhi_[et].x; cv.u[3] = vhi_[et].y;
          o0[et] = MFMA(cv.v, pf[0], o0[et]);
          o1[et] = MFMA(cv.v, pf[1], o1[et]);
        }
        SB;
      }
      asm volatile("s_waitcnt vmcnt(0)" ::: "memory");
      __syncthreads();
    }
    f32x4 o[8];
    {
      float t0 = ls[0], t1 = ls[1];
      t0 += __shfl_xor(t0, 16); t0 += __shfl_xor(t0, 32);
      t1 += __shfl_xor(t1, 16); t1 += __shfl_xor(t1, 32);
      const float c1 = 1.f / t0, c2 = lam / t1;
#pragma unroll
      for (int et = 0; et < 8; ++et)
#pragma unroll
        for (int r = 0; r < 4; ++r) o[et][r] = o0[et][r] * c1 - o1[et][r] * c2;
    }
#undef ATT_STAGE_K
#undef ATT_STAGE_V
    float ss = 0.f;
#pragma unroll
    for (int et = 0; et < 8; ++et)
#pragma unroll
      for (int r = 0; r < 4; ++r) ss += o[et][r] * o[et][r];
    ss += __shfl_xor(ss, 16);
    ss += __shfl_xor(ss, 32);
    const float rs = rsqrtf(ss * (1.f / 128.f) + 1e-6f) * (1.f - lam_init);
    bf16_t* gp = R0 + 160 * MIB / 2 + (size_t)mq * 1024 + h * 128;
#pragma unroll
    for (int et = 0; et < 8; ++et) {
      const int e0 = 16 * et + 4 * lg;
      const uint2 g = *(const uint2*)(gp + e0);
      const float4 sg = *(const float4*)(subg + e0);
      const float v0 = o[et][0] * rs * sg.x * lo_f(g.x), v1 = o[et][1] * rs * sg.y * hi_f(g.x);
      const float v2 = o[et][2] * rs * sg.z * lo_f(g.y), v3 = o[et][3] * rs * sg.w * hi_f(g.y);
      if (!dry) *(uint2*)(gp + e0) = make_uint2(pack2(v0, v1), pack2(v2, v3));
    }
  }
}

template <int KIND, int DIR>
__device__ __forceinline__ void scan_item(const Params& p, int item, unsigned char* lds, const bool dry) {
  constexpr int DV = KIND == 1 ? 256 : 128, NSL = DV / 64, LDV = KIND == 1 ? 2048 : 1024;
  const int tid = HTID, lane = tid & 63, w = tid >> 6, lr = lane & 15, lg = lane >> 4;
  int grp, b, h, sl;
  {
    int it = item;
    if (it < 64 * NSL) grp = 1; else { grp = 0; it -= 64 * NSL; }
    sl = it % NSL; h = (it / NSL) & 7; b = it / (NSL * 8);
  }
  const int T = grp ? 2048 : 256, nch = T >> 6;
  const size_t mbase = grp ? (size_t)8192 + (size_t)b * 2048 : (size_t)b * 256;
  bf16_t* R0 = (bf16_t*)p.ws;
  const bf16_t* Qg = R0 + mbase * 1024 + h * 128;
  const bf16_t* Kg = R0 + (KIND == 1 ? PLANE_E : (DIR ? 2 * PLANE_E : PLANE_E)) + mbase * 1024 + h * 128;
  const bf16_t* Vg = R0 + (KIND == 1 ? 2 * PLANE_E : 3 * PLANE_E) + mbase * LDV + h * DV + sl * 64;
  bf16_t* Og = R0 + (KIND == 1 ? 4 * PLANE_E : 5 * PLANE_E) + mbase * LDV + h * DV + sl * 64;
  unsigned char* Qs = lds;
  unsigned char* X = lds + 17408;
  unsigned char* Vt = lds + 35840;
  unsigned char* StS = lds + 45056;
  unsigned char* Pm = lds + 62464;
  float* xch = (float*)(lds + 71680);
  float* blA = xch + 512;
  float* erA = xch + 640;
  const int dp = tid & 63, tq = tid >> 6, r0 = tq * 16, d0 = dp * 2;
  float cst0, cst1;
  if (KIND == 1) { cst0 = cst1 = log1pf(-expf(p.in[18][DIR * 8 + h])); }
  else {
    const float* lbp = p.in[21] + DIR * 4096 + h * 128 + d0;
    {
      const float x0 = lbp[0], x1 = lbp[1024], x2 = lbp[2048], x3 = lbp[3072];
      const float m = fmaxf(fmaxf(x0, x1), fmaxf(x2, x3));
      const float e0 = expf(x0 - m), e1 = expf(x1 - m), e2 = expf(x2 - m), e3 = expf(x3 - m);
      cst0 = (e1 + e2) / (e0 + e1 + e2 + e3);
    }
    {
      const float x0 = lbp[1], x1 = lbp[1025], x2 = lbp[2049], x3 = lbp[3073];
      const float m = fmaxf(fmaxf(x0, x1), fmaxf(x2, x3));
      const float e0 = expf(x0 - m), e1 = expf(x1 - m), e2 = expf(x2 - m), e3 = expf(x3 - m);
      cst1 = (e1 + e2) / (e0 + e1 + e2 + e3);
    }
  }
  f32x4 S[8];
  if (grp) {
    const float* s0 = (KIND == 1 ? p.in[4] : p.in[5]) + ((size_t)((b * 2 + DIR) * 8 + h) * 128) * DV + sl * 64 + 16 * w + lr + (size_t)(4 * lg) * DV;
    asm volatile("" : "+v"(s0));
#pragma unroll
    for (int dt = 0; dt < 8; ++dt)
#pragma unroll
      for (int r = 0; r < 4; ++r) S[dt][r] = s0[(16 * dt + r) * DV];
  } else {
#pragma unroll
    for (int dt = 0; dt < 8; ++dt) S[dt] = (f32x4){0.f, 0.f, 0.f, 0.f};
  }
  unsigned qv[16], kv[16], vv[8];
  const int ve2 = tid & 31, vq = tid >> 5;
  const int qoff = r0 * 512 + dp;
  const int voff = (8 * vq) * (LDV / 2) + ve2;
  const unsigned* Qg32 = (const unsigned*)Qg;
  const unsigned* Kg32 = (const unsigned*)Kg;
  const unsigned* Vg32 = (const unsigned*)Vg;
#define SCAN_ISSUE(c)                                                                                   \
  {                                                                                                     \
    const unsigned* q_ = Qg32 + (size_t)(c) * (64 * 512) + qoff;                                        \
    const unsigned* k_ = Kg32 + (size_t)(c) * (64 * 512) + qoff;                                        \
    const unsigned* v_ = Vg32 + (size_t)(c) * (64 * (LDV / 2)) + voff;                                  \
    asm volatile("" : "+v"(q_), "+v"(k_), "+v"(v_));                                                    \
    _Pragma("unroll") for (int i = 0; i < 16; ++i) { qv[i] = q_[i * 512]; kv[i] = k_[i * 512]; }        \
    _Pragma("unroll") for (int i = 0; i < 8; ++i) vv[i] = v_[i * (LDV / 2)];                            \
  }
  SCAN_ISSUE(DIR ? nch - 1 : 0);
  for (int ci = 0; ci < nch; ++ci) {
    const int c = DIR ? nch - 1 - ci : ci;
    float tot0 = 0.f, tot1 = 0.f;
    if (KIND == 1) { tot0 = tot1 = 16.f * cst0; }
    else {
#pragma unroll
      for (int i = 0; i < 16; ++i) {
        const float s0_ = 1.f / (1.f + __expf(-lo_f(kv[i]))), s1_ = 1.f / (1.f + __expf(-hi_f(kv[i])));
        tot0 += __logf(cst0 + (1.f - cst0) * s0_);
        tot1 += __logf(cst1 + (1.f - cst1) * s1_);
      }
    }
    *(float2*)(xch + tq * 128 + d0) = make_float2(tot0, tot1);
    __syncthreads();
    const float2 t0 = *(const float2*)(xch + d0), t1 = *(const float2*)(xch + 128 + d0), t2 = *(const float2*)(xch + 256 + d0), t3 = *(const float2*)(xch + 384 + d0);
    const float blast0 = (t0.x + t1.x) + (t2.x + t3.x), blast1 = (t0.y + t1.y) + (t2.y + t3.y);
    float ref0, ref1, run0, run1;
    if (DIR == 0) {
      ref0 = t0.x + t1.x; ref1 = t0.y + t1.y;
      run0 = (tq > 0 ? t0.x : 0.f) + (tq > 1 ? t1.x : 0.f) + (tq > 2 ? t2.x : 0.f);
      run1 = (tq > 0 ? t0.y : 0.f) + (tq > 1 ? t1.y : 0.f) + (tq > 2 ? t2.y : 0.f);
    } else {
      ref0 = t2.x + t3.x; ref1 = t2.y + t3.y;
      run0 = (tq < 3 ? t3.x : 0.f) + (tq < 2 ? t2.x : 0.f) + (tq < 1 ? t1.x : 0.f);
      run1 = (tq < 3 ? t3.y : 0.f) + (tq < 2 ? t2.y : 0.f) + (tq < 1 ? t1.y : 0.f);
    }
    unsigned ktp0[8], ktp1[8];
#pragma unroll
    for (int jj = 0; jj < 8; ++jj) {
      const int j = DIR ? 7 - jj : jj;
      float ka[2], kb[2];
#pragma unroll
      for (int hh = 0; hh < 2; ++hh) {
        const int i = 2 * j + (DIR ? 1 - hh : hh);
        float g0, g1, k0, k1;
        if (KIND == 1) { g0 = g1 = cst0; k0 = lo_f(kv[i]); k1 = hi_f(kv[i]); }
        else {
          const float s0_ = 1.f / (1.f + __expf(-lo_f(kv[i]))), s1_ = 1.f / (1.f + __expf(-hi_f(kv[i])));
          g0 = __logf(cst0 + (1.f - cst0) * s0_); g1 = __logf(cst1 + (1.f - cst1) * s1_);
          k0 = (1.f - cst0) * (1.f - s0_); k1 = (1.f - cst1) * (1.f - s1_);
        }
        run0 += g0; run1 += g1;
        *(unsigned*)(Qs + (r0 + i) * 272 + d0 * 2) = pack2(lo_f(qv[i]) * __expf(run0 - ref0), hi_f(qv[i]) * __expf(run1 - ref1));
        *(unsigned*)(X + (r0 + i) * 272 + d0 * 2) = pack2(k0 * __expf(ref0 - run0), k1 * __expf(ref1 - run1));
        ka[i & 1] = k0 * __expf(blast0 - run0);
        kb[i & 1] = k1 * __expf(blast1 - run1);
      }
      ktp0[j] = pack2(ka[0], ka[1]);
      ktp1[j] = pack2(kb[0], kb[1]);
    }
    if (tq == 0) { *(float2*)(blA + d0) = make_float2(__expf(blast0), __expf(blast1)); *(float2*)(erA + d0) = make_float2(__expf(ref0), __expf(ref1)); }
    {
      const unsigned a0 = (vv[0] & 0xffffu) | (vv[1] << 16), a1 = (vv[2] & 0xffffu) | (vv[3] << 16), a2 = (vv[4] & 0xffffu) | (vv[5] << 16), a3 = (vv[6] & 0xffffu) | (vv[7] << 16);
      const unsigned b0 = (vv[0] >> 16) | (vv[1] & 0xffff0000u), b1 = (vv[2] >> 16) | (vv[3] & 0xffff0000u), b2 = (vv[4] >> 16) | (vv[5] & 0xffff0000u), b3 = (vv[6] >> 16) | (vv[7] & 0xffff0000u);
      *(uint4*)(Vt + (2 * ve2) * 144 + vq * 16) = make_uint4(a0, a1, a2, a3);
      *(uint4*)(Vt + (2 * ve2 + 1) * 144 + vq * 16) = make_uint4(b0, b1, b2, b3);
    }
    if (ci + 1 < nch) { SCAN_ISSUE(DIR ? c - 1 : c + 1); }
    __syncthreads();
#pragma unroll
    for (int dt = 0; dt < 8; ++dt) {
      const float4 er4 = *(const float4*)(erA + 16 * dt + 4 * lg);
      *(uint2*)(StS + (16 * w + lr) * 272 + (16 * dt + 4 * lg) * 2) = make_uint2(pack2(S[dt][0] * er4.x, S[dt][1] * er4.y), pack2(S[dt][2] * er4.z, S[dt][3] * er4.w));
    }
    bf16x8 qf[4];
#pragma unroll
    for (int ks = 0; ks < 4; ++ks) qf[ks] = *(const bf16x8*)(Qs + (16 * w + lr) * 272 + ks * 64 + lg * 16);
    uint2 pv[4];
    {
      const int t = 16 * w + lr;
#pragma unroll
      for (int st = 0; st < 4; ++st) {
        f32x4 s = (f32x4){0.f, 0.f, 0.f, 0.f};
#pragma unroll
        for (int ks = 0; ks < 4; ++ks) {
          const bf16x8 kf = *(const bf16x8*)(X + (16 * st + lr) * 272 + ks * 64 + lg * 16);
          s = MFMA(kf, qf[ks], s);
        }
        float v[4];
#pragma unroll
        for (int r = 0; r < 4; ++r) {
          const int si = 16 * st + 4 * lg + r;
          const bool keep = DIR ? (t <= si) : (t >= si);
          v[r] = keep ? s[r] : 0.f;
        }
        pv[st] = make_uint2(pack2(v[0], v[1]), pack2(v[2], v[3]));
      }
    }
    __syncthreads();
#pragma unroll
    for (int st = 0; st < 4; ++st) *(uint2*)(Pm + (16 * w + lr) * 144 + (16 * st + 4 * lg) * 2) = pv[st];
    *(uint4*)(X + d0 * 144 + r0 * 2) = make_uint4(ktp0[0], ktp0[1], ktp0[2], ktp0[3]);
    *(uint4*)(X + d0 * 144 + r0 * 2 + 16) = make_uint4(ktp0[4], ktp0[5], ktp0[6], ktp0[7]);
    *(uint4*)(X + (d0 + 1) * 144 + r0 * 2) = make_uint4(ktp1[0], ktp1[1], ktp1[2], ktp1[3]);
    *(uint4*)(X + (d0 + 1) * 144 + r0 * 2 + 16) = make_uint4(ktp1[4], ktp1[5], ktp1[6], ktp1[7]);
    __syncthreads();
    {
      bf16x8 pf[2];
#pragma unroll
      for (int ks = 0; ks < 2; ++ks) pf[ks] = *(const bf16x8*)(Pm + (16 * w + lr) * 144 + ks * 64 + lg * 16);
#pragma unroll
      for (int et = 0; et < 4; ++et) {
        f32x4 o = (f32x4){0.f, 0.f, 0.f, 0.f};
#pragma unroll
        for (int ks = 0; ks < 2; ++ks) {
          const bf16x8 vf = *(const bf16x8*)(Vt + (16 * et + lr) * 144 + ks * 64 + lg * 16);
          o = MFMA(vf, pf[ks], o);
        }
#pragma unroll
        for (int ks = 0; ks < 4; ++ks) {
          const bf16x8 sf = *(const bf16x8*)(StS + (16 * et + lr) * 272 + ks * 64 + lg * 16);
          o = MFMA(sf, qf[ks], o);
        }
        bf16_t* op = Og + (size_t)(c * 64 + 16 * w + lr) * LDV + 16 * et + 4 * lg;
        if (DIR) {
          const uint2 old = *(const uint2*)op;
          o[0] += lo_f(old.x); o[1] += hi_f(old.x); o[2] += lo_f(old.y); o[3] += hi_f(old.y);
        }
        if (!(DIR && dry)) *(uint2*)op = make_uint2(pack2(o[0], o[1]), pack2(o[2], o[3]));
      }
    }
    {
      bf16x8 vtf[2];
#pragma unroll
      for (int ks = 0; ks < 2; ++ks) vtf[ks] = *(const bf16x8*)(Vt + (16 * w + lr) * 144 + ks * 64 + lg * 16);
#pragma unroll
      for (int dt = 0; dt < 8; ++dt) {
        const float4 bl4 = *(const float4*)(blA + 16 * dt + 4 * lg);
        S[dt][0] *= bl4.x; S[dt][1] *= bl4.y; S[dt][2] *= bl4.z; S[dt][3] *= bl4.w;
#pragma unroll
        for (int ks = 0; ks < 2; ++ks) {
          const bf16x8 kf = *(const bf16x8*)(X + (16 * dt + lr) * 144 + ks * 64 + lg * 16);
          S[dt] = MFMA(kf, vtf[ks], S[dt]);
        }
      }
    }
    __syncthreads();
  }
#undef SCAN_ISSUE
  if (!grp) {
    float* so = p.out + (KIND == 1 ? OUT_SR : OUT_SH) + ((size_t)((b * 2 + DIR) * 8 + h) * 128) * DV + sl * 64 + 16 * w + lr + (size_t)(4 * lg) * DV;
    asm volatile("" : "+v"(so));
#pragma unroll
    for (int dt = 0; dt < 8; ++dt)
#pragma unroll
      for (int r = 0; r < 4; ++r) so[(16 * dt + r) * DV] = S[dt][r];
  }
}

template <int KIND, int DIR>
__device__ __forceinline__ void scan_phase(const Params& p, unsigned char* lds, const bool dry) {
  constexpr int NSL = (KIND == 1 ? 256 : 128) / 64;
  const int ns = 64 * NSL, npr = 256 * NSL;
  const int G = VGDIM, bid = VBID;
  int it, step, end = ns + npr;
  if (G > ns) {
    if (bid < ns) { it = bid; step = end; }
    else { it = ns + (bid - ns); step = G - ns; }
  } else { it = bid; step = G; }
  for (; it < end; it += step) scan_item<KIND, DIR>(p, it, lds, dry);
}

template <int KIND>
__device__ __forceinline__ void normgate_phase(const Params& p, const bool dry) {
  constexpr int NCH = KIND == 1 ? 4 : 2, DV = KIND == 1 ? 256 : 128, LD = KIND == 1 ? 2048 : 1024;
  const int tid = HTID, lane = tid & 63, w = tid >> 6;
  const int hh = lane >> 3, sub = lane & 7;
  bf16_t* R0 = (bf16_t*)p.ws;
  bf16_t* Ob = R0 + (KIND == 1 ? 4 * PLANE_E : 5 * PLANE_E) + hh * DV + sub * 8;
  const bf16_t* Gb = R0 + (KIND == 1 ? 0 : 4 * PLANE_E) + hh * DV + sub * 8;
  float gn[NCH][8];
#pragma unroll
  for (int j = 0; j < NCH; ++j)
#pragma unroll
    for (int i = 0; i < 8; ++i) gn[j][i] = (KIND == 1) ? 1.f : p.in[22][j * 64 + sub * 8 + i];
  for (int row = VBID * 4 + w; row < 24576; row += VGDIM * 4) {
    bf16_t* op = Ob + (size_t)row * LD;
    const bf16_t* gp = Gb + (size_t)row * LD;
    uint4 ov[NCH], gv[NCH];
#pragma unroll
    for (int j = 0; j < NCH; ++j) { ov[j] = *(const uint4*)(op + j * 64); gv[j] = *(const uint4*)(gp + j * 64); }
    float ss = 0.f;
#pragma unroll
    for (int j = 0; j < NCH; ++j) {
      const unsigned wv[4] = {ov[j].x, ov[j].y, ov[j].z, ov[j].w};
#pragma unroll
      for (int i = 0; i < 4; ++i) { const float a = lo_f(wv[i]), b2 = hi_f(wv[i]); ss += a * a + b2 * b2; }
    }
    ss += __shfl_xor(ss, 1);
    ss += __shfl_xor(ss, 2);
    ss += __shfl_xor(ss, 4);
    const float rs = rsqrtf(ss * (1.f / (float)DV) + 1e-6f);
#pragma unroll
    for (int j = 0; j < NCH; ++j) {
      const unsigned wv[4] = {ov[j].x, ov[j].y, ov[j].z, ov[j].w};
      const unsigned gw[4] = {gv[j].x, gv[j].y, gv[j].z, gv[j].w};
      unsigned r[4];
#pragma unroll
      for (int i = 0; i < 4; ++i)
        r[i] = pack2(lo_f(wv[i]) * rs * gn[j][2 * i] * lo_f(gw[i]), hi_f(wv[i]) * rs * gn[j][2 * i + 1] * hi_f(gw[i]));
      if (!dry) *(uint4*)(op + j * 64) = make_uint4(r[0], r[1], r[2], r[3]);
    }
  }
}

__device__ __forceinline__ void opaque_params(Params& q) {
  asm volatile("" : "+s"(q.out), "+s"(q.ws));
#pragma unroll
  for (int i = 0; i < 23; ++i) asm volatile("" : "+s"(q.in[i]));
}

#if defined(PH_ONLY)
#define PHASE(n, call) if (n == PH_ONLY) { const bool dry = false; call; }
#elif defined(REP_N)
#define PHASE(n, call) if (lo <= n && n < hi) { for (int rep = (n == REP_N ? 0 : 1); rep < 2; ++rep) { const bool dry = (rep == 0); call; if (!(fin && n + 1 == hi && rep == 1)) grid.sync(); } }
#else
#define PHASE(n, call) if (lo <= n && n < hi) { const bool dry = false; call; if (!(fin && n + 1 == hi)) grid.sync(); }
#endif

__device__ __forceinline__ void run_range(const Params& q, int lo, int hi, bool fin, cg::grid_group& grid, unsigned char* lds) {
  unsigned char* ldh = lds + HALFID * HALF_LDS;
  PHASE(0, phase0(q, ldh))
  PHASE(1, post_phase(q, -1, 0, ldh, dry))
  PHASE(2, gemm_phase(q, 0, GM_IN_DA, lds, 2))
  PHASE(3, attn_phase(q, 0, lds, dry, 3))
  PHASE(4, gemm_phase(q, 0, GM_OUT, lds, 4))
  PHASE(5, post_phase(q, 0, 1, ldh, dry))
  PHASE(6, gemm_phase(q, 1, GM_IN_RET_QKV, lds, 6))
  PHASE(7, (scan_phase<1, 0>(q, ldh, dry)))
  PHASE(8, (scan_phase<1, 1>(q, ldh, dry)))
  PHASE(9, gemm_phase(q, 1, GM_IN_RET_G, lds, 9))
  PHASE(10, normgate_phase<1>(q, dry))
  PHASE(11, gemm_phase(q, 1, GM_OUT, lds, 11))
  PHASE(12, post_phase(q, 1, 2, ldh, dry))
  PHASE(13, gemm_phase(q, 2, GM_IN_HG, lds, 13))
  PHASE(14, (scan_phase<2, 0>(q, ldh, dry)))
  PHASE(15, (scan_phase<2, 1>(q, ldh, dry)))
  PHASE(16, normgate_phase<2>(q, dry))
  PHASE(17, gemm_phase(q, 2, GM_OUT, lds, 17))
  PHASE(18, post_phase(q, 2, 3, ldh, dry))
  PHASE(19, gemm_phase(q, 3, GM_IN_DA, lds, 19))
  PHASE(20, attn_phase(q, 3, lds, dry, 20))
  PHASE(21, gemm_phase(q, 3, GM_OUT, lds, 21))
  PHASE(22, post_phase(q, 3, 4, ldh, dry))
}

__global__ void __launch_bounds__(NTHR, 2) mega_fwd(Params p) {
  extern __shared__ __attribute__((aligned(16))) unsigned char lds[];
  cg::grid_group grid = cg::this_grid();
  run_range(p, p.ph_lo, p.ph_hi, true, grid, lds);
}

extern "C" void kernel_launch(void* const* d_in, const int* in_sizes, int n_in, void* d_out, int out_size, void* d_ws, size_t ws_size, hipStream_t stream) {
  static int grid_blocks = 0;
  if (grid_blocks == 0) {
    int dev = 0, cus = 0, per_cu = 0;
    hipGetDevice(&dev);
    hipDeviceGetAttribute(&cus, hipDeviceAttributeMultiprocessorCount, dev);
    hipFuncSetAttribute((const void*)mega_fwd, hipFuncAttributeMaxDynamicSharedMemorySize, LDS_BYTES);
    hipOccupancyMaxActiveBlocksPerMultiprocessor(&per_cu, (const void*)mega_fwd, NTHR, LDS_BYTES);
    if (per_cu < 1) per_cu = 1;
    if (per_cu > 1) per_cu = 1;
    if (cus < 1) cus = 256;
    grid_blocks = cus * per_cu;
    (void)hipGetLastError();
    if (n_in != 23 || ws_size < WS_NEED) { fprintf(stderr, "kernel_launch: unexpected n_in %d / ws_size %zu (need %zu)\n", n_in, ws_size, (size_t)WS_NEED); }
  }
  Params p{};
  for (int i = 0; i < 23; ++i) p.in[i] = (const float*)d_in[i];
  p.out = (float*)d_out;
  p.ws = (unsigned char*)d_ws;
#if ONE_LAUNCH
  p.ph_lo = 0; p.ph_hi = NPH;
  void* args[] = {&p};
  hipError_t e = hipLaunchCooperativeKernel((const void*)mega_fwd, dim3(grid_blocks), dim3(NTHR), args, LDS_BYTES, stream);
  if (e != hipSuccess) fprintf(stderr, "cooperative launch failed: %s (grid %d)\n", hipGetErrorString(e), grid_blocks);
#else
  for (int ph = 0; ph < NPH; ++ph) {
    p.ph_lo = ph; p.ph_hi = ph + 1;
    hipLaunchKernelGGL(mega_fwd, dim3(grid_blocks), dim3(NTHR), LDS_BYTES, stream, p);
  }
#endif
}
```

```cpp
#include <hip/hip_runtime.h>
#include <hip/hip_cooperative_groups.h>
#include <cstdint>
#include <cstdio>
namespace cg = cooperative_groups;

#ifndef ONE_LAUNCH
#define ONE_LAUNCH 1
#endif

typedef unsigned short bf16_t;
typedef short bf16x8 __attribute__((ext_vector_type(8)));
typedef float f32x4 __attribute__((ext_vector_type(4)));

#define NTHR 512
#define HTID ((int)(threadIdx.x & 255))
#define HALFID ((int)(threadIdx.x >> 8))
#define VBID ((int)(blockIdx.x * 2 + (threadIdx.x >> 8)))
#define VGDIM ((int)(gridDim.x * 2))
#define HALF_LDS 74816
#define MIB ((size_t)1 << 20)
#define NPH 23
#define LDS_BYTES (2 * HALF_LDS)
#define LDS_SLOT 74752
#define MISC_CTR (MISC_ROPE + 524288)

#define OFF_WIN  (288 * MIB)
#define OFF_WOUT (300 * MIB)
#define OFF_HP   (304 * MIB)
#define OFF_MISC (320 * MIB)
#define MISC_ROPE 524288
#define WS_NEED  (322 * MIB)
#define PLANE_E  ((size_t)25165824)
#define OUT_YP 0
#define OUT_YS 8388608
#define OUT_CK 25165824
#define OUT_CV 41943040
#define OUT_SR 58720256
#define OUT_SH 75497472

struct Params {
  const float* in[23];
  float* out;
  unsigned char* ws;
  int ph_lo, ph_hi;
};

struct LayerInfo { int kind, slot, IN, WIDTH; const float* w_in; const float* w_out; };

__device__ __forceinline__ LayerInfo layer_info(const Params& p, int l) {
  LayerInfo L;
  if (l == 0)      { L.kind = 0; L.slot = 0; L.IN = 4096; L.WIDTH = 1024; L.w_in = p.in[12]; L.w_out = p.in[13]; }
  else if (l == 1) { L.kind = 1; L.slot = 0; L.IN = 6144; L.WIDTH = 2048; L.w_in = p.in[16]; L.w_out = p.in[17]; }
  else if (l == 2) { L.kind = 2; L.slot = 0; L.IN = 5120; L.WIDTH = 1024; L.w_in = p.in[19]; L.w_out = p.in[20]; }
  else             { L.kind = 0; L.slot = 1; L.IN = 4096; L.WIDTH = 1024; L.w_in = p.in[12] + (size_t)1024 * 4096; L.w_out = p.in[13] + (size_t)1024 * 1024; }
  return L;
}
__device__ __forceinline__ bf16_t* hs_ptr(const Params& p, int l) {
  return l < 3 ? (bf16_t*)(p.out + OUT_SH) : (bf16_t*)(p.ws + 240 * MIB);
}

typedef __bf16 nbf16x2 __attribute__((ext_vector_type(2)));
typedef float f32x2 __attribute__((ext_vector_type(2)));
__device__ __forceinline__ float bf2f(unsigned h) { return __uint_as_float(h << 16); }
__device__ __forceinline__ unsigned pack2(float a, float b) { const f32x2 f = {a, b}; return __builtin_bit_cast(unsigned, __builtin_convertvector(f, nbf16x2)); }
__device__ __forceinline__ float lo_f(unsigned w) { return __uint_as_float(w << 16); }
__device__ __forceinline__ float hi_f(unsigned w) { return __uint_as_float(w & 0xffff0000u); }
__device__ __forceinline__ float silu_f(float x) { return x / (1.f + __expf(-x)); }
__device__ __forceinline__ float wave_sum(float v) {
#pragma unroll
  for (int o = 32; o > 0; o >>= 1) v += __shfl_xor(v, o);
  return v;
}
#define QSCALE 0.18033688011112042f
#define SB __builtin_amdgcn_sched_barrier(0)
#define MFMA(a, b, c) __builtin_amdgcn_mfma_f32_16x16x32_bf16((a), (b), (c), 0, 0, 0)

__device__ __forceinline__ void convT_tile(const float* __restrict__ src, int src_ld, bf16_t* __restrict__ dst, int dst_ld, unsigned char* lds) {
  float* t = (float*)lds;
  const int tid = HTID;
  const int kr = tid >> 4, nc = (tid & 15) * 4;
#pragma unroll
  for (int j = 0; j < 4; ++j) {
    const float4 v = *(const float4*)(src + (size_t)(kr + 16 * j) * src_ld + nc);
    float* tp = t + (kr + 16 * j) * 65 + nc;
    tp[0] = v.x; tp[1] = v.y; tp[2] = v.z; tp[3] = v.w;
  }
  __syncthreads();
  const int n = tid >> 2, kc = (tid & 3) * 16;
  unsigned w[8];
#pragma unroll
  for (int i = 0; i < 8; ++i) w[i] = pack2(t[(kc + 2 * i) * 65 + n], t[(kc + 2 * i + 1) * 65 + n]);
  uint4* d = (uint4*)(dst + (size_t)n * dst_ld + kc);
  d[0] = make_uint4(w[0], w[1], w[2], w[3]);
  d[1] = make_uint4(w[4], w[5], w[6], w[7]);
  __syncthreads();
}

__device__ __forceinline__ int conv_weights_count(const Params& p, int l) {
  const LayerInfo L = layer_info(p, l);
  return (L.IN / 64) * 16 + (L.WIDTH / 64) * 16;
}
__device__ __forceinline__ void conv_weights_item(const Params& p, int l, int it, unsigned char* lds) {
  const LayerInfo L = layer_info(p, l);
  const int nin = (L.IN / 64) * 16;
  if (it < nin) {
    const int kt = it & 15, nt = it >> 4;
    convT_tile(L.w_in + (size_t)(kt * 64) * L.IN + nt * 64, L.IN, (bf16_t*)(p.ws + OFF_WIN) + (size_t)(nt * 64) * 1024 + kt * 64, 1024, lds);
  } else {
    const int it2 = it - nin, nkt = L.WIDTH / 64;
    const int kt = it2 % nkt, nt = it2 / nkt;
    convT_tile(L.w_out + (size_t)(kt * 64) * 1024 + nt * 64, 1024, (bf16_t*)(p.ws + OFF_WOUT) + (size_t)(nt * 64) * L.WIDTH + kt * 64, L.WIDTH, lds);
  }
}

__device__ __forceinline__ void mod_item(const Params& p, int it, unsigned char* lds) {
  float* ssilu = (float*)lds;
  float* red = ssilu + 9 * 1024;
  const int tid = HTID;
  const int l = it / 48, col0 = (it % 48) * 64;
  for (int i = tid; i < 9 * 1024; i += 256) {
    const int v = i >> 10, k = i & 1023;
    const float x = (v == 0) ? p.in[7][k] : p.in[6][(v - 1) * 1024 + k];
    ssilu[i] = silu_f(x);
  }
  __syncthreads();
  const int col = tid & 63, kq = tid >> 6;
  const float* w = p.in[8] + (size_t)l * 1024 * 3072 + col0 + col;
  float acc[9];
#pragma unroll
  for (int v = 0; v < 9; ++v) acc[v] = 0.f;
  for (int k = kq * 256; k < kq * 256 + 256; ++k) {
    const float wv = w[(size_t)k * 3072];
#pragma unroll
    for (int v = 0; v < 9; ++v) acc[v] += ssilu[v * 1024 + k] * wv;
  }
#pragma unroll
  for (int v = 0; v < 9; ++v) red[(kq * 9 + v) * 64 + col] = acc[v];
  __syncthreads();
  float* mod = (float*)(p.ws + OFF_MISC);
  for (int i = tid; i < 9 * 64; i += 256) {
    const int v = i >> 6, cc = i & 63;
    const float s = red[(0 * 9 + v) * 64 + cc] + red[(1 * 9 + v) * 64 + cc] + red[(2 * 9 + v) * 64 + cc] + red[(3 * 9 + v) * 64 + cc];
    mod[(size_t)(l * 9 + v) * 3072 + col0 + cc] = s + p.in[9][l * 3072 + col0 + cc];
  }
  __syncthreads();
}

__device__ __forceinline__ void rope_item(const Params& p, int it) {
  const int idx = it * 256 + HTID;
  const int t = idx >> 5, pp = idx & 31;
  const int pos = pp < 16 ? (t >> 6) : (t & 63);
  const float inv = exp2f(-(float)(pp & 15) * (13.287712379549449f / 16.f));
  const float ang = (float)pos * inv;
  const double a = (double)ang;
  const double r = a - 6.283185307179586 * rint(a * 0.15915494309189535);
  const float rf = (float)r;
  float2* tab = (float2*)(p.ws + OFF_MISC + MISC_ROPE);
  tab[idx] = make_float2(__cosf(rf), __sinf(rf));
}

__device__ __forceinline__ void phase0(const Params& p, unsigned char* lds) {
  const int nw = conv_weights_count(p, 0);
  const int total = 192 + 256 + nw;
  for (int it = VBID; it < total; it += VGDIM) {
    if (it < 192) mod_item(p, it, lds);
    else if (it < 448) rope_item(p, it - 192);
    else conv_weights_item(p, 0, it - 448, lds);
  }
}

__device__ __forceinline__ void post_phase(const Params& p, int lprev, int lnext, unsigned char* lds, const bool dry) {
  const int tid = HTID, lane = tid & 63, w = tid >> 6;
  const float* mod = (const float*)(p.ws + OFF_MISC);
  const bf16_t* Y = nullptr;
  if (lprev >= 0) {
    const int kind = layer_info(p, lprev).kind;
    Y = (const bf16_t*)(p.ws + (kind == 1 ? 96 * MIB : 0));
  }
  bf16_t* hp = (bf16_t*)(p.ws + OFF_HP);
  bf16_t* hs = lnext < 4 ? hs_ptr(p, lnext) : nullptr;
  for (int row = VBID * 4 + w; row < 24576; row += VGDIM * 4) {
    const int mv = row < 8192 ? 0 : 1 + ((row - 8192) >> 11);
    const float* xs = (lprev <= 0) ? (row < 8192 ? p.in[0] + (size_t)row * 1024 : p.in[1] + (size_t)(row - 8192) * 1024) : p.out + (size_t)row * 1024;
    float4 x[4];
#pragma unroll
    for (int j = 0; j < 4; ++j) x[j] = *(const float4*)(xs + lane * 4 + 256 * j);
    if (lprev >= 0) {
      float4 y[4];
      float ss = 0.f;
#pragma unroll
      for (int j = 0; j < 4; ++j) { const uint2 yw = *(const uint2*)(Y + (size_t)row * 1024 + lane * 4 + 256 * j); y[j] = make_float4(lo_f(yw.x), hi_f(yw.x), lo_f(yw.y), hi_f(yw.y)); ss += y[j].x * y[j].x + y[j].y * y[j].y + y[j].z * y[j].z + y[j].w * y[j].w; }
      ss = wave_sum(ss);
      const float rstd = rsqrtf(ss * (1.f / 1024.f) + 1e-6f);
      const float* ga = mod + (size_t)(lprev * 9 + mv) * 3072 + 2048;
      const float* gp = p.in[11] + lprev * 1024;
#pragma unroll
      for (int j = 0; j < 4; ++j) {
        const int c = lane * 4 + 256 * j;
        const float4 g4 = *(const float4*)(ga + c), p4 = *(const float4*)(gp + c);
        x[j].x += g4.x * (y[j].x * rstd * p4.x); x[j].y += g4.y * (y[j].y * rstd * p4.y);
        x[j].z += g4.z * (y[j].z * rstd * p4.z); x[j].w += g4.w * (y[j].w * rstd * p4.w);
        if (!dry) *(float4*)(p.out + (size_t)row * 1024 + c) = x[j];
      }
    }
    if (lnext < 4) {
      float ss = 0.f;
#pragma unroll
      for (int j = 0; j < 4; ++j) ss += x[j].x * x[j].x + x[j].y * x[j].y + x[j].z * x[j].z + x[j].w * x[j].w;
      ss = wave_sum(ss);
      const float rstd = rsqrtf(ss * (1.f / 1024.f) + 1e-6f);
      const float* sh = mod + (size_t)(lnext * 9 + mv) * 3072;
      const float* sc = sh + 1024;
      const float* gp = p.in[10] + lnext * 1024;
      bf16_t* hd = row < 8192 ? hp + (size_t)row * 1024 : hs + (size_t)(row - 8192) * 1024;
#pragma unroll
      for (int j = 0; j < 4; ++j) {
        const int c = lane * 4 + 256 * j;
        const float4 s4 = *(const float4*)(sh + c), c4 = *(const float4*)(sc + c), p4 = *(const float4*)(gp + c);
        const float h0 = x[j].x * rstd * p4.x * (1.f + c4.x) + s4.x, h1 = x[j].y * rstd * p4.y * (1.f + c4.y) + s4.y;
        const float h2 = x[j].z * rstd * p4.z * (1.f + c4.z) + s4.z, h3 = x[j].w * rstd * p4.w * (1.f + c4.w) + s4.w;
        *(uint2*)(hd + c) = make_uint2(pack2(h0, h1), pack2(h2, h3));
      }
    }
  }
  if (lprev >= 0 && lnext < 4) {
    const int nw = conv_weights_count(p, lnext);
    for (int it = VBID; it < nw; it += VGDIM) conv_weights_item(p, lnext, it, lds);
  }
}


__device__ __forceinline__ unsigned xcc_id() { return (unsigned)__builtin_amdgcn_s_getreg((3 << 11) | 20) & 7u; }
__device__ __forceinline__ bool wq_next(unsigned* ctr, int nst, int mult, unsigned xcd, int& qstate, int& q, int& idx, unsigned char* lds) {
  volatile int* slot = (volatile int*)(lds + LDS_SLOT);
  __syncthreads();
  if (HTID == 0) {
    int qq = -1, ii = 0, st = qstate;
    while (st < 8) {
      const int cand = (int)((xcd + (unsigned)st) & 7u);
      const int got = (int)atomicAdd(ctr + cand, 1u);
      if (got < mult * ((nst - cand + 7) >> 3)) { qq = cand; ii = got; break; }
      ++st;
    }
    slot[0] = qq; slot[1] = ii; slot[2] = st;
  }
  __syncthreads();
  q = slot[0]; idx = slot[1]; qstate = slot[2];
  return q >= 0;
}

#define LAS __attribute__((address_space(3)))
template <bool SWAP>
__device__ __forceinline__ void gemm_tile_compute(const bf16_t* __restrict__ Ag, const bf16_t* __restrict__ Bg, int K, unsigned char* lds, f32x4 (&acc)[8][4],
                                                  const bool pre, const bf16_t* __restrict__ An, const bf16_t* __restrict__ Bn, const bool hasn) {
  const int tid = threadIdx.x, lane = tid & 63, wid = __builtin_amdgcn_readfirstlane(tid >> 6), wm = wid >> 2, wn = wid & 3;
  const int lr = lane & 15, lg = lane >> 4;
  LAS unsigned char* l3 = (LAS unsigned char*)lds;
  const int prow = lane >> 3;
  const int pgo0 = prow * K + (((lane & 7) ^ ((prow >> 1) & 7)) << 3);
  const int pgo1 = prow * K + (((lane & 7) ^ ((4 + (prow >> 1)) & 7)) << 3);
  const bf16_t* asrc = Ag + (size_t)(wid * 32) * K;
  const bf16_t* bsrc = Bg + (size_t)(wid * 32) * K;
  const size_t pstep = (size_t)8 * K;
#pragma unroll
  for (int mi = 0; mi < 8; ++mi)
#pragma unroll
    for (int ni = 0; ni < 4; ++ni) acc[mi][ni] = (f32x4){0.f, 0.f, 0.f, 0.f};
#define GEMM_STAGE_P(ap_, bp_, s, k0)                                                                                                      \
  {                                                                                                                                        \
    _Pragma("unroll") for (int j = 0; j < 4; ++j) {                                                                                        \
      __builtin_amdgcn_global_load_lds((const unsigned*)((ap_) + j * pstep + ((j & 1) ? pgo1 : pgo0) + (k0)), (LAS unsigned*)(l3 + (s) * 65536 + (wid * 4 + j) * 1024), 16, 0, 0);          \
      __builtin_amdgcn_global_load_lds((const unsigned*)((bp_) + j * pstep + ((j & 1) ? pgo1 : pgo0) + (k0)), (LAS unsigned*)(l3 + (s) * 65536 + 32768 + (wid * 4 + j) * 1024), 16, 0, 0);  \
    }                                                                                                                                      \
  }
#define GEMM_STAGE(s, k0) GEMM_STAGE_P(asrc, bsrc, s, k0)
  const int nk = K >> 6;
  if (!pre) GEMM_STAGE(0, 0);
  asm volatile("s_waitcnt vmcnt(0)" ::: "memory");
  __syncthreads();
  const int x0 = lg ^ ((lr >> 1) & 7);
  const int aoff0 = (wm * 128 + lr) * 128 + x0 * 16, aoff1 = (wm * 128 + lr) * 128 + (x0 ^ 4) * 16;
  const int boff0 = 32768 + (wn * 64 + lr) * 128 + x0 * 16, boff1 = 32768 + (wn * 64 + lr) * 128 + (x0 ^ 4) * 16;
  for (int kt = 0; kt < nk; ++kt) {
    if (kt + 1 < nk) GEMM_STAGE((kt + 1) & 1, (kt + 1) * 64);
    const unsigned char* st = lds + (kt & 1) * 65536;
#pragma unroll
    for (int kk = 0; kk < 2; ++kk) {
      bf16x8 af[8], bfr[4];
#pragma unroll
      for (int ni = 0; ni < 4; ++ni) bfr[ni] = *(const bf16x8*)(st + (kk ? boff1 : boff0) + ni * 2048);
#pragma unroll
      for (int mi = 0; mi < 8; ++mi) af[mi] = *(const bf16x8*)(st + (kk ? aoff1 : aoff0) + mi * 2048);
#pragma unroll
      for (int mi = 0; mi < 8; ++mi)
#pragma unroll
        for (int ni = 0; ni < 4; ++ni)
          acc[mi][ni] = SWAP ? MFMA(bfr[ni], af[mi], acc[mi][ni]) : MFMA(af[mi], bfr[ni], acc[mi][ni]);
    }
    asm volatile("s_waitcnt vmcnt(0)" ::: "memory");
    __syncthreads();
  }
  if (hasn) { const bf16_t* an_ = An + (size_t)(wid * 32) * K; const bf16_t* bn_ = Bn + (size_t)(wid * 32) * K; GEMM_STAGE_P(an_, bn_, 0, 0); }
#undef GEMM_STAGE
#undef GEMM_STAGE_P
}

enum { GM_IN_DA = 0, GM_IN_RET_QKV = 1, GM_IN_RET_G = 2, GM_IN_HG = 3, GM_OUT = 4 };

__device__ __forceinline__ void epi_swapped(const Params& p, int mode, int slot, int ykind, int m, int n, f32x4 v) {
  bf16_t* R0 = (bf16_t*)p.ws;
  if (mode == GM_OUT) {
    bf16_t* Y = (bf16_t*)(p.ws + (ykind == 1 ? 96 * MIB : 0));
    *(uint2*)(Y + (size_t)m * 1024 + n) = make_uint2(pack2(v[0], v[1]), pack2(v[2], v[3]));
  } else if (mode == GM_IN_DA) {
    const bool smp = m >= 8192;
    const int ms = m - 8192;
    const int b = smp ? (ms >> 11) : (m >> 8), t = smp ? (ms & 2047) : (m & 255);
    if (n < 2048) {
      if (smp) {
        const float4 cs = *(const float4*)((const float*)(p.ws + OFF_MISC + MISC_ROPE) + (size_t)(t * 32 + ((n & 63) >> 1)) * 2);
        const float a0 = v[0] * cs.x - v[1] * cs.y, a1 = v[0] * cs.y + v[1] * cs.x;
        const float a2 = v[2] * cs.z - v[3] * cs.w, a3 = v[2] * cs.w + v[3] * cs.z;
        v = (f32x4){a0, a1, a2, a3};
      }
      if (n < 1024) {
        *(uint2*)(R0 + (size_t)m * 1024 + n) = make_uint2(pack2(v[0] * QSCALE, v[1] * QSCALE), pack2(v[2] * QSCALE, v[3] * QSCALE));
      } else {
        const int c = n - 1024;
        const uint2 pk = make_uint2(pack2(v[0], v[1]), pack2(v[2], v[3]));
        if (smp) {
          *(uint2*)(R0 + 64 * MIB / 2 + ((size_t)b * 2560 + t) * 1024 + c) = pk;
        } else {
          *(f32x4*)(p.out + OUT_CK + ((size_t)((b * 2 + slot) * 256 + t)) * 1024 + c) = v;
          *(uint2*)(R0 + 48 * MIB / 2 + (size_t)m * 1024 + c) = pk;
        }
      }
    } else {
      *(uint2*)(R0 + 160 * MIB / 2 + (size_t)m * 1024 + (n - 3072)) = make_uint2(pack2(silu_f(v[0]), silu_f(v[1])), pack2(silu_f(v[2]), silu_f(v[3])));
    }
  } else if (mode == GM_IN_RET_QKV) {
    if (n < 1024) *(uint2*)(R0 + (size_t)m * 1024 + n) = make_uint2(pack2(v[0], v[1]), pack2(v[2], v[3]));
    else if (n < 2048) { const float s = 0.08838834764831845f; *(uint2*)(R0 + PLANE_E + (size_t)m * 1024 + (n - 1024)) = make_uint2(pack2(v[0] * s, v[1] * s), pack2(v[2] * s, v[3] * s)); }
    else *(uint2*)(R0 + 2 * PLANE_E + (size_t)m * 2048 + (n - 2048)) = make_uint2(pack2(v[0], v[1]), pack2(v[2], v[3]));
  } else if (mode == GM_IN_RET_G) {
    *(uint2*)(R0 + (size_t)m * 2048 + n) = make_uint2(pack2(silu_f(v[0]), silu_f(v[1])), pack2(silu_f(v[2]), silu_f(v[3])));
  } else {
    if (n < 1024 || n >= 4096) v = (f32x4){silu_f(v[0]), silu_f(v[1]), silu_f(v[2]), silu_f(v[3])};
    *(uint2*)(R0 + (size_t)(n >> 10) * PLANE_E + (size_t)m * 1024 + (n & 1023)) = make_uint2(pack2(v[0], v[1]), pack2(v[2], v[3]));
  }
}

__device__ __forceinline__ void epi_da_v(const Params& p, int slot, int m, int n, f32x4 v) {
  bf16_t* R0 = (bf16_t*)p.ws;
  const int c = n - 2048, hh = c >> 7, e = c & 127;
  const uint2 pk = make_uint2(pack2(v[0], v[1]), pack2(v[2], v[3]));
  if (m >= 8192) {
    const int ms = m - 8192, b = ms >> 11, t = ms & 2047;
    *(uint2*)(R0 + 120 * MIB / 2 + ((size_t)((b * 8 + hh) * 128 + e)) * 2560 + t) = pk;
  } else {
    const int b = m >> 8, t = m & 255;
    float* o = p.out + OUT_CV + ((size_t)((b * 2 + slot) * 256 + t)) * 1024 + c;
    o[0] = v[0]; o[1024] = v[1]; o[2048] = v[2]; o[3072] = v[3];
    *(uint2*)(R0 + 104 * MIB / 2 + ((size_t)((b * 8 + hh) * 128 + e)) * 256 + t) = pk;
  }
}

__device__ __forceinline__ void gemm_phase(const Params& p, int l, int mode, unsigned char* lds, int phid) {
  const LayerInfo L = layer_info(p, l);
  bf16_t* R0 = (bf16_t*)p.ws;
  const bf16_t *Ap, *As, *Bt;
  int K, N;
  if (mode == GM_OUT) {
    K = L.WIDTH; N = 1024; Bt = (const bf16_t*)(p.ws + OFF_WOUT);
    const bf16_t* base = R0 + (L.kind == 0 ? 160 * MIB / 2 : (L.kind == 1 ? 4 * PLANE_E : 5 * PLANE_E));
    Ap = base; As = base + (size_t)8192 * K;
  } else {
    K = 1024; Ap = (const bf16_t*)(p.ws + OFF_HP); As = hs_ptr(p, l);
    Bt = (const bf16_t*)(p.ws + OFF_WIN) + (mode == GM_IN_RET_G ? (size_t)4096 * 1024 : 0);
    N = (mode == GM_IN_DA || mode == GM_IN_RET_QKV) ? 4096 : (mode == GM_IN_RET_G ? 2048 : 5120);
  }
  const int ntn = N >> 8, ntiles = 96 * ntn;
  const int extra = (mode == GM_IN_DA) ? 3072 : 0;
  const int tid = threadIdx.x, lane = tid & 63, wid = tid >> 6, wm = wid >> 2, wn = wid & 3, lr = lane & 15, lg = lane >> 4;
  const int G = gridDim.x;
  const bool swz = (G & 7) == 0;
  const int xcd = blockIdx.x & 7, snn = ntn >> 2, nst = 12 * snn;
  const int q0 = swz ? (int)(blockIdx.x >> 3) : (int)blockIdx.x, qstep = swz ? (G >> 3) : G;
  const int qlen = swz ? 32 * ((nst - xcd + 7) >> 3) : ntiles;
#define GEMM_TILE_OF(qq, m0_, n0_)                                                   \
  {                                                                                    \
    int it_ = (qq);                                                                    \
    if (swz) {                                                                         \
      const int st_ = xcd + 8 * ((qq) >> 5), tin_ = (qq) & 31;                         \
      const int smt_ = st_ / snn, snt_ = st_ - smt_ * snn;                             \
      it_ = (smt_ * 8 + (tin_ >> 2)) * ntn + snt_ * 4 + (tin_ & 3);                    \
    }                                                                                  \
    const int mt_ = it_ / ntn;                                                         \
    m0_ = mt_ * 256; n0_ = (it_ - mt_ * ntn) * 256;                                    \
  }
  bool pre = false;
  for (int q = q0; q < qlen; q += qstep) {
    int m0, n0;
    GEMM_TILE_OF(q, m0, n0)
    const bf16_t* A = m0 < 8192 ? Ap + (size_t)m0 * K : As + (size_t)(m0 - 8192) * K;
    const bf16_t* B = Bt + (size_t)n0 * K;
    const bool hasn = q + qstep < qlen;
    const bf16_t *An = A, *Bn = B;
    if (hasn) {
      int m1, n1;
      GEMM_TILE_OF(q + qstep, m1, n1)
      An = m1 < 8192 ? Ap + (size_t)m1 * K : As + (size_t)(m1 - 8192) * K;
      Bn = Bt + (size_t)n1 * K;
    }
    {
      f32x4 acc[8][4];
      if (mode == GM_IN_DA && n0 >= 2048 && n0 < 3072) {
        gemm_tile_compute<false>(A, B, K, lds, acc, pre, An, Bn, hasn);
#pragma unroll
        for (int mi = 0; mi < 8; ++mi)
#pragma unroll
          for (int ni = 0; ni < 4; ++ni)
            epi_da_v(p, L.slot, m0 + wm * 128 + mi * 16 + 4 * lg, n0 + wn * 64 + ni * 16 + lr, acc[mi][ni]);
      } else {
        gemm_tile_compute<true>(A, B, K, lds, acc, pre, An, Bn, hasn);
#pragma unroll
        for (int mi = 0; mi < 8; ++mi)
#pragma unroll
          for (int ni = 0; ni < 4; ++ni)
            epi_swapped(p, mode, L.slot, L.kind, m0 + wm * 128 + mi * 16 + lr, n0 + wn * 64 + ni * 16 + 4 * lg, acc[mi][ni]);
      }
    }
    pre = hasn;
  }
#undef GEMM_TILE_OF
  if (extra) { asm volatile("s_waitcnt vmcnt(0)" ::: "memory"); __syncthreads(); }
  for (int ci = VBID; ci < extra; ci += VGDIM) {
    {
      if (ci < 2048) {
        const int idx = (ci * 256 + HTID) * 8;
        const int b = idx >> 19, rem = idx & 524287, tp = rem >> 10, c = rem & 1023;
        const float* src = p.in[2] + ((size_t)((b * 2 + L.slot) * 512 + tp)) * 1024 + c;
        const float4 u0 = *(const float4*)src, u1 = *(const float4*)(src + 4);
        *(uint4*)(R0 + 64 * MIB / 2 + ((size_t)b * 2560 + 2048 + tp) * 1024 + c) = make_uint4(pack2(u0.x, u0.y), pack2(u0.z, u0.w), pack2(u1.x, u1.y), pack2(u1.z, u1.w));
      } else {
        const int i2 = ci - 2048;
        const int b = i2 >> 7, hh = (i2 >> 4) & 7, tt = (i2 >> 1) & 7, et = i2 & 1;
        convT_tile(p.in[3] + ((size_t)((b * 2 + L.slot) * 512 + tt * 64)) * 1024 + hh * 128 + et * 64, 1024,
                   R0 + 120 * MIB / 2 + ((size_t)((b * 8 + hh) * 128 + et * 64)) * 2560 + 2048 + tt * 64, 2560, lds + HALFID * HALF_LDS);
      }
    }
  }
}

__device__ __forceinline__ void attn_phase(const Params& p, int l, unsigned char* lds, const bool dry, int phid) {
  const int slot = l == 3 ? 1 : 0;
  const float lam_init = 0.8f - 0.6f * expf(-0.3f * (float)l);
  const int tid = threadIdx.x, lane = tid & 63, w = tid >> 6, lr = lane & 15, lg = lane >> 4;
  float lam;
  {
    const float* lf = p.in[14] + slot * 256;
    const float a = wave_sum(lf[lane] * lf[64 + lane]);
    const float b2 = wave_sum(lf[128 + lane] * lf[192 + lane]);
    lam = expf(a) - expf(b2) + lam_init;
  }
  bf16_t* R0 = (bf16_t*)p.ws;
  const float* subg = p.in[15] + slot * 128;
  for (int item = blockIdx.x; item < 1536; item += gridDim.x) {
    int grp, b, h, qt;
    if (item < 1024) { grp = 1; b = item >> 7; h = (item >> 4) & 7; qt = item & 15; }
    else { const int i2 = item - 1024; grp = 0; b = i2 >> 4; h = (i2 >> 1) & 7; qt = i2 & 1; }
    const int nkeys = grp ? 2560 : 256, ntile = nkeys >> 6;
    const int mq = (grp ? 8192 + b * 2048 : b * 256) + qt * 128 + w * 16 + lr;
    const bf16_t* Kg = grp ? R0 + 64 * MIB / 2 + (size_t)b * 2560 * 1024 + h * 128 : R0 + 48 * MIB / 2 + (size_t)b * 256 * 1024 + h * 128;
    const bf16_t* Vg = grp ? R0 + 120 * MIB / 2 + (size_t)(b * 8 + h) * 128 * 2560 : R0 + 104 * MIB / 2 + (size_t)(b * 8 + h) * 128 * 256;
    bf16x8 qf[2][2];
#pragma unroll
    for (int sub = 0; sub < 2; ++sub)
#pragma unroll
      for (int ks = 0; ks < 2; ++ks) qf[sub][ks] = *(const bf16x8*)(R0 + (size_t)mq * 1024 + h * 128 + sub * 64 + ks * 32 + lg * 8);
    LAS unsigned char* l3 = (LAS unsigned char*)lds;
    const int wu = __builtin_amdgcn_readfirstlane(w);
    int koff[2], voff[2];
#pragma unroll
    for (int j = 0; j < 2; ++j) {
      const int kr = (wu * 2 + j) * 4 + (lane >> 4);
      koff[j] = kr * 1024 + (((lane & 15) ^ (kr & 15)) << 3);
      const int er = (wu * 2 + j) * 8 + (lane >> 3);
      voff[j] = er * nkeys + (((lane & 7) ^ ((er >> 1) & 7)) << 3);
    }
#define ATT_STAGE_K(s, key0)                                                                                  \
  {                                                                                                           \
    _Pragma("unroll") for (int j = 0; j < 2; ++j)                                                             \
      __builtin_amdgcn_global_load_lds((const unsigned*)(Kg + (size_t)(key0) * 1024 + koff[j]), (LAS unsigned*)(l3 + (s) * 32768 + (wu * 2 + j) * 1024), 16, 0, 0); \
  }
#define ATT_STAGE_V(s, key0)                                                                                  \
  {                                                                                                           \
    _Pragma("unroll") for (int j = 0; j < 2; ++j)                                                             \
      __builtin_amdgcn_global_load_lds((const unsigned*)(Vg + (key0) + voff[j]), (LAS unsigned*)(l3 + (s) * 32768 + 16384 + (wu * 2 + j) * 1024), 16, 0, 0); \
  }
    const int xl = lg ^ lr;
    const int vsw = (lr >> 1) & 7;
    const int vlo = lr * 128 + ((((lg >> 1)) ^ vsw) << 4) + (lg & 1) * 8;
    float mx[2] = {-1e30f, -1e30f}, ls[2] = {0.f, 0.f};
    f32x4 o0[8], o1[8];
#pragma unroll
    for (int et = 0; et < 8; ++et) { o0[et] = (f32x4){0.f, 0.f, 0.f, 0.f}; o1[et] = (f32x4){0.f, 0.f, 0.f, 0.f}; }
    ATT_STAGE_K(0, 0);
    ATT_STAGE_V(0, 0);
    asm volatile("s_waitcnt vmcnt(0)" ::: "memory");
    __syncthreads();
    for (int kt = 0; kt < ntile; ++kt) {
      if (kt + 1 < ntile) { ATT_STAGE_K((kt + 1) & 1, (kt + 1) * 64); ATT_STAGE_V((kt + 1) & 1, (kt + 1) * 64); }
      const unsigned char* ks_ = lds + (kt & 1) * 32768 + lr * 256;
      const unsigned char* vs_ = lds + (kt & 1) * 32768 + 16384;
#pragma unroll
      for (int k2 = 0; k2 < 2; ++k2) {
        bf16x8 kfr[8];
        uint2 vlo_[8], vhi_[8];
#pragma unroll
        for (int sub = 0; sub < 2; ++sub)
#pragma unroll
          for (int nn = 0; nn < 2; ++nn)
#pragma unroll
            for (int ks = 0; ks < 2; ++ks)
              kfr[sub * 4 + nn * 2 + ks] = *(const bf16x8*)(ks_ + (2 * k2 + nn) * 4096 + ((xl ^ (sub * 8 + ks * 4)) << 4));
#pragma unroll
        for (int et = 0; et < 8; ++et) {
          vlo_[et] = *(const uint2*)(vs_ + et * 2048 + (vlo ^ (k2 << 6)));
          vhi_[et] = *(const uint2*)(vs_ + et * 2048 + (vlo ^ (k2 << 6) ^ 32));
        }
        SB;
        f32x4 s[2][2];
#pragma unroll
        for (int sub = 0; sub < 2; ++sub)
#pragma unroll
          for (int nn = 0; nn < 2; ++nn) {
            s[sub][nn] = MFMA(kfr[sub * 4 + nn * 2], qf[sub][0], ((f32x4){0.f, 0.f, 0.f, 0.f}));
            s[sub][nn] = MFMA(kfr[sub * 4 + nn * 2 + 1], qf[sub][1], s[sub][nn]);
          }
        SB;
        bf16x8 pf[2];
        float tmx[2];
#pragma unroll
        for (int sub = 0; sub < 2; ++sub) {
          float tm = fmaxf(fmaxf(fmaxf(s[sub][0][0], s[sub][0][1]), fmaxf(s[sub][0][2], s[sub][0][3])), fmaxf(fmaxf(s[sub][1][0], s[sub][1][1]), fmaxf(s[sub][1][2], s[sub][1][3])));
          tm = fmaxf(tm, __shfl_xor(tm, 16));
          tm = fmaxf(tm, __shfl_xor(tm, 32));
          tmx[sub] = tm;
        }
        if (__any((tmx[0] > mx[0] + 8.f) || (tmx[1] > mx[1] + 8.f))) {
#pragma unroll
          for (int sub = 0; sub < 2; ++sub) {
            const float mn = (tmx[sub] > mx[sub] + 8.f) ? tmx[sub] : mx[sub];
            const float sc = __builtin_amdgcn_exp2f(mx[sub] - mn);
            mx[sub] = mn;
            ls[sub] *= sc;
#pragma unroll
            for (int et = 0; et < 8; ++et) {
              if (sub == 0) { o0[et][0] *= sc; o0[et][1] *= sc; o0[et][2] *= sc; o0[et][3] *= sc; }
              else { o1[et][0] *= sc; o1[et][1] *= sc; o1[et][2] *= sc; o1[et][3] *= sc; }
            }
          }
        }
#pragma unroll
        for (int sub = 0; sub < 2; ++sub) {
          unsigned pw[4];
          float acc = 0.f;
#pragma unroll
          for (int nn = 0; nn < 2; ++nn) {
            float a[4];
#pragma unroll
            for (int r = 0; r < 4; ++r) { a[r] = __builtin_amdgcn_exp2f(s[sub][nn][r] - mx[sub]); acc += a[r]; }
            pw[nn * 2] = pack2(a[0], a[1]);
            pw[nn * 2 + 1] = pack2(a[2], a[3]);
          }
          ls[sub] += acc;
          union { unsigned u[4]; bf16x8 v; } cp;
          cp.u[0] = pw[0]; cp.u[1] = pw[1]; cp.u[2] = pw[2]; cp.u[3] = pw[3];
          pf[sub] = cp.v;
        }
        SB;
#pragma unroll
        for (int et = 0; et < 8; ++et) {
          union { unsigned u[4]; bf16x8 v; } cv;
          cv.u[0] = vlo_[et].x; cv.u[1] = vlo_[et].y; cv.u[2] = vhi_[et].x; cv.u[3] = vhi_[et].y;
          o0[et] = MFMA(cv.v, pf[0], o0[et]);
          o1[et] = MFMA(cv.v, pf[1], o1[et]);
        }
        SB;
      }
      asm volatile("s_waitcnt vmcnt(0)" ::: "memory");
      __syncthreads();
    }
    f32x4 o[8];
    {
      float t0 = ls[0], t1 = ls[1];
      t0 += __shfl_xor(t0, 16); t0 += __shfl_xor(t0, 32);
      t1 += __shfl_xor(t1, 16); t1 += __shfl_xor(t1, 32);
      const float c1 = 1.f / t0, c2 = lam / t1;
#pragma unroll
      for (int et = 0; et < 8; ++et)
#pragma unroll
        for (int r = 0; r < 4; ++r) o[et][r] = o0[et][r] * c1 - o1[et][r] * c2;
    }
#undef ATT_STAGE_K
#undef ATT_STAGE_V
    float ss = 0.f;
#pragma unroll
    for (int et = 0; et < 8; ++et)
#pragma unroll
      for (int r = 0; r < 4; ++r) ss += o[et][r] * o[et][r];
    ss += __shfl_xor(ss, 16);
    ss += __shfl_xor(ss, 32);
    const float rs = rsqrtf(ss * (1.f / 128.f) + 1e-6f) * (1.f - lam_init);
    bf16_t* gp = R0 + 160 * MIB / 2 + (size_t)mq * 1024 + h * 128;
#pragma unroll
    for (int et = 0; et < 8; ++et) {
      const int e0 = 16 * et + 4 * lg;
      const uint2 g = *(const uint2*)(gp + e0);
      const float4 sg = *(const float4*)(subg + e0);
      const float v0 = o[et][0] * rs * sg.x * lo_f(g.x), v1 = o[et][1] * rs * sg.y * hi_f(g.x);
      const float v2 = o[et][2] * rs * sg.z * lo_f(g.y), v3 = o[et][3] * rs * sg.w * hi_f(g.y);
      if (!dry) *(uint2*)(gp + e0) = make_uint2(pack2(v0, v1), pack2(v2, v3));
    }
  }
}

template <int KIND, int DIR>
__device__ __forceinline__ void scan_item(const Params& p, int item, unsigned char* lds, const bool dry) {
  constexpr int DV = KIND == 1 ? 256 : 128, NSL = DV / 64, LDV = KIND == 1 ? 2048 : 1024;
  const int tid = HTID, lane = tid & 63, w = tid >> 6, lr = lane & 15, lg = lane >> 4;
  int grp, b, h, sl;
  {
    int it = item;
    if (it < 64 * NSL) grp = 1; else { grp = 0; it -= 64 * NSL; }
    sl = it % NSL; h = (it / NSL) & 7; b = it / (NSL * 8);
  }
  const int T = grp ? 2048 : 256, nch = T >> 6;
  const size_t mbase = grp ? (size_t)8192 + (size_t)b * 2048 : (size_t)b * 256;
  bf16_t* R0 = (bf16_t*)p.ws;
  const bf16_t* Qg = R0 + mbase * 1024 + h * 128;
  const bf16_t* Kg = R0 + (KIND == 1 ? PLANE_E : (DIR ? 2 * PLANE_E : PLANE_E)) + mbase * 1024 + h * 128;
  const bf16_t* Vg = R0 + (KIND == 1 ? 2 * PLANE_E : 3 * PLANE_E) + mbase * LDV + h * DV + sl * 64;
  bf16_t* Og = R0 + (KIND == 1 ? 4 * PLANE_E : 5 * PLANE_E) + mbase * LDV + h * DV + sl * 64;
  unsigned char* Qs = lds;
  unsigned char* X = lds + 17408;
  unsigned char* Vt = lds + 35840;
  unsigned char* StS = lds + 45056;
  unsigned char* Pm = lds + 62464;
  float* xch = (float*)(lds + 71680);
  float* blA = xch + 512;
  float* erA = xch + 640;
  const int dp = tid & 63, tq = tid >> 6, r0 = tq * 16, d0 = dp * 2;
  float cst0, cst1;
  if (KIND == 1) { cst0 = cst1 = log1pf(-expf(p.in[18][DIR * 8 + h])); }
  else {
    const float* lbp = p.in[21] + DIR * 4096 + h * 128 + d0;
    {
      const float x0 = lbp[0], x1 = lbp[1024], x2 = lbp[2048], x3 = lbp[3072];
      const float m = fmaxf(fmaxf(x0, x1), fmaxf(x2, x3));
      const float e0 = expf(x0 - m), e1 = expf(x1 - m), e2 = expf(x2 - m), e3 = expf(x3 - m);
      cst0 = (e1 + e2) / (e0 + e1 + e2 + e3);
    }
    {
      const float x0 = lbp[1], x1 = lbp[1025], x2 = lbp[2049], x3 = lbp[3073];
      const float m = fmaxf(fmaxf(x0, x1), fmaxf(x2, x3));
      const float e0 = expf(x0 - m), e1 = expf(x1 - m), e2 = expf(x2 - m), e3 = expf(x3 - m);
      cst1 = (e1 + e2) / (e0 + e1 + e2 + e3);
    }
  }
  f32x4 S[8];
  if (grp) {
    const float* s0 = (KIND == 1 ? p.in[4] : p.in[5]) + ((size_t)((b * 2 + DIR) * 8 + h) * 128) * DV + sl * 64 + 16 * w + lr + (size_t)(4 * lg) * DV;
    asm volatile("" : "+v"(s0));
#pragma unroll
    for (int dt = 0; dt < 8; ++dt)
#pragma unroll
      for (int r = 0; r < 4; ++r) S[dt][r] = s0[(16 * dt + r) * DV];
  } else {
#pragma unroll
    for (int dt = 0; dt < 8; ++dt) S[dt] = (f32x4){0.f, 0.f, 0.f, 0.f};
  }
  unsigned qv[16], kv[16], vv[8];
  const int ve2 = tid & 31, vq = tid >> 5;
  const int qoff = r0 * 512 + dp;
  const int voff = (8 * vq) * (LDV / 2) + ve2;
  const unsigned* Qg32 = (const unsigned*)Qg;
  const unsigned* Kg32 = (const unsigned*)Kg;
  const unsigned* Vg32 = (const unsigned*)Vg;
#define SCAN_ISSUE(c)                                                                                   \
  {                                                                                                     \
    const unsigned* q_ = Qg32 + (size_t)(c) * (64 * 512) + qoff;                                        \
    const unsigned* k_ = Kg32 + (size_t)(c) * (64 * 512) + qoff;                                        \
    const unsigned* v_ = Vg32 + (size_t)(c) * (64 * (LDV / 2)) + voff;                                  \
    asm volatile("" : "+v"(q_), "+v"(k_), "+v"(v_));                                                    \
    _Pragma("unroll") for (int i = 0; i < 16; ++i) { qv[i] = q_[i * 512]; kv[i] = k_[i * 512]; }        \
    _Pragma("unroll") for (int i = 0; i < 8; ++i) vv[i] = v_[i * (LDV / 2)];                            \
  }
  SCAN_ISSUE(DIR ? nch - 1 : 0);
  for (int ci = 0; ci < nch; ++ci) {
    const int c = DIR ? nch - 1 - ci : ci;
    float tot0 = 0.f, tot1 = 0.f;
    if (KIND == 1) { tot0 = tot1 = 16.f * cst0; }
    else {
#pragma unroll
      for (int i = 0; i < 16; ++i) {
        const float s0_ = 1.f / (1.f + __expf(-lo_f(kv[i]))), s1_ = 1.f / (1.f + __expf(-hi_f(kv[i])));
        tot0 += __logf(cst0 + (1.f - cst0) * s0_);
        tot1 += __logf(cst1 + (1.f - cst1) * s1_);
      }
    }
    *(float2*)(xch + tq * 128 + d0) = make_float2(tot0, tot1);
    __syncthreads();
    const float2 t0 = *(const float2*)(xch + d0), t1 = *(const float2*)(xch + 128 + d0), t2 = *(const float2*)(xch + 256 + d0), t3 = *(const float2*)(xch + 384 + d0);
    const float blast0 = (t0.x + t1.x) + (t2.x + t3.x), blast1 = (t0.y + t1.y) + (t2.y + t3.y);
    float ref0, ref1, run0, run1;
    if (DIR == 0) {
      ref0 = t0.x + t1.x; ref1 = t0.y + t1.y;
      run0 = (tq > 0 ? t0.x : 0.f) + (tq > 1 ? t1.x : 0.f) + (tq > 2 ? t2.x : 0.f);
      run1 = (tq > 0 ? t0.y : 0.f) + (tq > 1 ? t1.y : 0.f) + (tq > 2 ? t2.y : 0.f);
    } else {
      ref0 = t2.x + t3.x; ref1 = t2.y + t3.y;
      run0 = (tq < 3 ? t3.x : 0.f) + (tq < 2 ? t2.x : 0.f) + (tq < 1 ? t1.x : 0.f);
      run1 = (tq < 3 ? t3.y : 0.f) + (tq < 2 ? t2.y : 0.f) + (tq < 1 ? t1.y : 0.f);
    }
    unsigned ktp0[8], ktp1[8];
#pragma unroll
    for (int jj = 0; jj < 8; ++jj) {
      const int j = DIR ? 7 - jj : jj;
      float ka[2], kb[2];
#pragma unroll
      for (int hh = 0; hh < 2; ++hh) {
        const int i = 2 * j + (DIR ? 1 - hh : hh);
        float g0, g1, k0, k1;
        if (KIND == 1) { g0 = g1 = cst0; k0 = lo_f(kv[i]); k1 = hi_f(kv[i]); }
        else {
          const float s0_ = 1.f / (1.f + __expf(-lo_f(kv[i]))), s1_ = 1.f / (1.f + __expf(-hi_f(kv[i])));
          g0 = __logf(cst0 + (1.f - cst0) * s0_); g1 = __logf(cst1 + (1.f - cst1) * s1_);
          k0 = (1.f - cst0) * (1.f - s0_); k1 = (1.f - cst1) * (1.f - s1_);
        }
        run0 += g0; run1 += g1;
        *(unsigned*)(Qs + (r0 + i) * 272 + d0 * 2) = pack2(lo_f(qv[i]) * __expf(run0 - ref0), hi_f(qv[i]) * __expf(run1 - ref1));
        *(unsigned*)(X + (r0 + i) * 272 + d0 * 2) = pack2(k0 * __expf(ref0 - run0), k1 * __expf(ref1 - run1));
        ka[i & 1] = k0 * __expf(blast0 - run0);
        kb[i & 1] = k1 * __expf(blast1 - run1);
      }
      ktp0[j] = pack2(ka[0], ka[1]);
      ktp1[j] = pack2(kb[0], kb[1]);
    }
    if (tq == 0) { *(float2*)(blA + d0) = make_float2(__expf(blast0), __expf(blast1)); *(float2*)(erA + d0) = make_float2(__expf(ref0), __expf(ref1)); }
    {
      const unsigned a0 = (vv[0] & 0xffffu) | (vv[1] << 16), a1 = (vv[2] & 0xffffu) | (vv[3] << 16), a2 = (vv[4] & 0xffffu) | (vv[5] << 16), a3 = (vv[6] & 0xffffu) | (vv[7] << 16);
      const unsigned b0 = (vv[0] >> 16) | (vv[1] & 0xffff0000u), b1 = (vv[2] >> 16) | (vv[3] & 0xffff0000u), b2 = (vv[4] >> 16) | (vv[5] & 0xffff0000u), b3 = (vv[6] >> 16) | (vv[7] & 0xffff0000u);
      *(uint4*)(Vt + (2 * ve2) * 144 + vq * 16) = make_uint4(a0, a1, a2, a3);
      *(uint4*)(Vt + (2 * ve2 + 1) * 144 + vq * 16) = make_uint4(b0, b1, b2, b3);
    }
    if (ci + 1 < nch) { SCAN_ISSUE(DIR ? c - 1 : c + 1); }
    __syncthreads();
#pragma unroll
    for (int dt = 0; dt < 8; ++dt) {
      const float4 er4 = *(const float4*)(erA + 16 * dt + 4 * lg);
      *(uint2*)(StS + (16 * w + lr) * 272 + (16 * dt + 4 * lg) * 2) = make_uint2(pack2(S[dt][0] * er4.x, S[dt][1] * er4.y), pack2(S[dt][2] * er4.z, S[dt][3] * er4.w));
    }
    bf16x8 qf[4];
#pragma unroll
    for (int ks = 0; ks < 4; ++ks) qf[ks] = *(const bf16x8*)(Qs + (16 * w + lr) * 272 + ks * 64 + lg * 16);
    uint2 pv[4];
    {
      const int t = 16 * w + lr;
#pragma unroll
      for (int st = 0; st < 4; ++st) {
        f32x4 s = (f32x4){0.f, 0.f, 0.f, 0.f};
#pragma unroll
        for (int ks = 0; ks < 4; ++ks) {
          const bf16x8 kf = *(const bf16x8*)(X + (16 * st + lr) * 272 + ks * 64 + lg * 16);
          s = MFMA(kf, qf[ks], s);
        }
        float v[4];
#pragma unroll
        for (int r = 0; r < 4; ++r) {
          const int si = 16 * st + 4 * lg + r;
          const bool keep = DIR ? (t <= si) : (t >= si);
          v[r] = keep ? s[r] : 0.f;
        }
        pv[st] = make_uint2(pack2(v[0], v[1]), pack2(v[2], v[3]));
      }
    }
    __syncthreads();
#pragma unroll
    for (int st = 0; st < 4; ++st) *(uint2*)(Pm + (16 * w + lr) * 144 + (16 * st + 4 * lg) * 2) = pv[st];
    *(uint4*)(X + d0 * 144 + r0 * 2) = make_uint4(ktp0[0], ktp0[1], ktp0[2], ktp0[3]);
    *(uint4*)(X + d0 * 144 + r0 * 2 + 16) = make_uint4(ktp0[4], ktp0[5], ktp0[6], ktp0[7]);
    *(uint4*)(X + (d0 + 1) * 144 + r0 * 2) = make_uint4(ktp1[0], ktp1[1], ktp1[2], ktp1[3]);
    *(uint4*)(X + (d0 + 1) * 144 + r0 * 2 + 16) = make_uint4(ktp1[4], ktp1[5], ktp1[6], ktp1[7]);
    __syncthreads();
    {
      bf16x8 pf[2];
#pragma unroll
      for (int ks = 0; ks < 2; ++ks) pf[ks] = *(const bf16x8*)(Pm + (16 * w + lr) * 144 + ks * 64 + lg * 16);
#pragma unroll
      for (int et = 0; et < 4; ++et) {
        f32x4 o = (f32x4){0.f, 0.f, 0.f, 0.f};
#pragma unroll
        for (int ks = 0; ks < 2; ++ks) {
          const bf16x8 vf = *(const bf16x8*)(Vt + (16 * et + lr) * 144 + ks * 64 + lg * 16);
          o = MFMA(vf, pf[ks], o);
        }
#pragma unroll
        for (int ks = 0; ks < 4; ++ks) {
          const bf16x8 sf = *(const bf16x8*)(StS + (16 * et + lr) * 272 + ks * 64 + lg * 16);
          o = MFMA(sf, qf[ks], o);
        }
        bf16_t* op = Og + (size_t)(c * 64 + 16 * w + lr) * LDV + 16 * et + 4 * lg;
        if (DIR) {
          const uint2 old = *(const uint2*)op;
          o[0] += lo_f(old.x); o[1] += hi_f(old.x); o[2] += lo_f(old.y); o[3] += hi_f(old.y);
        }
        if (!(DIR && dry)) *(uint2*)op = make_uint2(pack2(o[0], o[1]), pack2(o[2], o[3]));
      }
    }
    {
      bf16x8 vtf[2];
#pragma unroll
      for (int ks = 0; ks < 2; ++ks) vtf[ks] = *(const bf16x8*)(Vt + (16 * w + lr) * 144 + ks * 64 + lg * 16);
#pragma unroll
      for (int dt = 0; dt < 8; ++dt) {
        const float4 bl4 = *(const float4*)(blA + 16 * dt + 4 * lg);
        S[dt][0] *= bl4.x; S[dt][1] *= bl4.y; S[dt][2] *= bl4.z; S[dt][3] *= bl4.w;
#pragma unroll
        for (int ks = 0; ks < 2; ++ks) {
          const bf16x8 kf = *(const bf16x8*)(X + (16 * dt + lr) * 144 + ks * 64 + lg * 16);
          S[dt] = MFMA(kf, vtf[ks], S[dt]);
        }
      }
    }
    __syncthreads();
  }
#undef SCAN_ISSUE
  if (!grp) {
    float* so = p.out + (KIND == 1 ? OUT_SR : OUT_SH) + ((size_t)((b * 2 + DIR) * 8 + h) * 128) * DV + sl * 64 + 16 * w + lr + (size_t)(4 * lg) * DV;
    asm volatile("" : "+v"(so));
#pragma unroll
    for (int dt = 0; dt < 8; ++dt)
#pragma unroll
      for (int r = 0; r < 4; ++r) so[(16 * dt + r) * DV] = S[dt][r];
  }
}

template <int KIND, int DIR>
__device__ __forceinline__ void scan_phase(const Params& p, unsigned char* lds, const bool dry) {
  constexpr int NSL = (KIND == 1 ? 256 : 128) / 64;
  const int ns = 64 * NSL, npr = 256 * NSL;
  const int G = VGDIM, bid = VBID;
  int it, step, end = ns + npr;
  if (G > ns) {
    if (bid < ns) { it = bid; step = end; }
    else { it = ns + (bid - ns); step = G - ns; }
  } else { it = bid; step = G; }
  for (; it < end; it += step) scan_item<KIND, DIR>(p, it, lds, dry);
}

template <int KIND>
__device__ __forceinline__ void normgate_phase(const Params& p, const bool dry) {
  constexpr int NCH = KIND == 1 ? 4 : 2, DV = KIND == 1 ? 256 : 128, LD = KIND == 1 ? 2048 : 1024;
  const int tid = HTID, lane = tid & 63, w = tid >> 6;
  const int hh = lane >> 3, sub = lane & 7;
  bf16_t* R0 = (bf16_t*)p.ws;
  bf16_t* Ob = R0 + (KIND == 1 ? 4 * PLANE_E : 5 * PLANE_E) + hh * DV + sub * 8;
  const bf16_t* Gb = R0 + (KIND == 1 ? 0 : 4 * PLANE_E) + hh * DV + sub * 8;
  float gn[NCH][8];
#pragma unroll
  for (int j = 0; j < NCH; ++j)
#pragma unroll
    for (int i = 0; i < 8; ++i) gn[j][i] = (KIND == 1) ? 1.f : p.in[22][j * 64 + sub * 8 + i];
  for (int row = VBID * 4 + w; row < 24576; row += VGDIM * 4) {
    bf16_t* op = Ob + (size_t)row * LD;
    const bf16_t* gp = Gb + (size_t)row * LD;
    uint4 ov[NCH], gv[NCH];
#pragma unroll
    for (int j = 0; j < NCH; ++j) { ov[j] = *(const uint4*)(op + j * 64); gv[j] = *(const uint4*)(gp + j * 64); }
    float ss = 0.f;
#pragma unroll
    for (int j = 0; j < NCH; ++j) {
      const unsigned wv[4] = {ov[j].x, ov[j].y, ov[j].z, ov[j].w};
#pragma unroll
      for (int i = 0; i < 4; ++i) { const float a = lo_f(wv[i]), b2 = hi_f(wv[i]); ss += a * a + b2 * b2; }
    }
    ss += __shfl_xor(ss, 1);
    ss += __shfl_xor(ss, 2);
    ss += __shfl_xor(ss, 4);
    const float rs = rsqrtf(ss * (1.f / (float)DV) + 1e-6f);
#pragma unroll
    for (int j = 0; j < NCH; ++j) {
      const unsigned wv[4] = {ov[j].x, ov[j].y, ov[j].z, ov[j].w};
      const unsigned gw[4] = {gv[j].x, gv[j].y, gv[j].z, gv[j].w};
      unsigned r[4];
#pragma unroll
      for (int i = 0; i < 4; ++i)
        r[i] = pack2(lo_f(wv[i]) * rs * gn[j][2 * i] * lo_f(gw[i]), hi_f(wv[i]) * rs * gn[j][2 * i + 1] * hi_f(gw[i]));
      if (!dry) *(uint4*)(op + j * 64) = make_uint4(r[0], r[1], r[2], r[3]);
    }
  }
}

__device__ __forceinline__ void opaque_params(Params& q) {
  asm volatile("" : "+s"(q.out), "+s"(q.ws));
#pragma unroll
  for (int i = 0; i < 23; ++i) asm volatile("" : "+s"(q.in[i]));
}

struct BarState { unsigned* base; unsigned xcd, mycnt, nact, esub, etop; };
__device__ __forceinline__ void grid_barrier(BarState& b) {
  asm volatile("s_waitcnt vmcnt(0) lgkmcnt(0)" ::: "memory");
  __syncthreads();
  if (threadIdx.x == 0) {
    b.esub += b.mycnt; b.etop += b.nact;
    __builtin_amdgcn_fence(__ATOMIC_RELEASE, "agent");
    const unsigned old = __hip_atomic_fetch_add(b.base + 64 * b.xcd, 1u, __ATOMIC_RELAXED, __HIP_MEMORY_SCOPE_AGENT);
    if (old + 1u == b.esub) __hip_atomic_fetch_add(b.base + 512, 1u, __ATOMIC_RELAXED, __HIP_MEMORY_SCOPE_AGENT);
    while (__hip_atomic_load(b.base + 512, __ATOMIC_RELAXED, __HIP_MEMORY_SCOPE_AGENT) < b.etop) __builtin_amdgcn_s_sleep(1);
    __builtin_amdgcn_fence(__ATOMIC_ACQUIRE, "agent");
  }
  __syncthreads();
}
__device__ __forceinline__ void bar_census_post(BarState& b) {
  if (threadIdx.x == 0) __hip_atomic_fetch_add(b.base + 1024 + 64 * b.xcd, 1u, __ATOMIC_RELAXED, __HIP_MEMORY_SCOPE_AGENT);
}
__device__ __forceinline__ void bar_census_read(BarState& b) {
  if (threadIdx.x == 0) {
    unsigned n = 0;
    for (unsigned j = 0; j < 8; ++j) {
      const unsigned c = __hip_atomic_load(b.base + 1024 + 64 * j, __ATOMIC_RELAXED, __HIP_MEMORY_SCOPE_AGENT);
      n += (c != 0u);
      if (j == b.xcd) b.mycnt = c;
    }
    b.nact = n;
  }
}
#define GSYNC(n) { if ((n) == 0) { grid.sync(); bar_census_read(bst); } else grid_barrier(bst); }

#if defined(PH_ONLY)
#define PHASE(n, call) if (n == PH_ONLY) { const bool dry = false; call; }
#elif defined(REP_N)
#define PHASE(n, call) if (lo <= n && n < hi) { for (int rep = (n == REP_N ? 0 : 1); rep < 2; ++rep) { const bool dry = (rep == 0); call; if (!(fin && n + 1 == hi && rep == 1)) GSYNC(n) } }
#else
#define PHASE(n, call) if (lo <= n && n < hi) { const bool dry = false; call; if (!(fin && n + 1 == hi)) GSYNC(n) }
#endif

__device__ __forceinline__ void run_range(const Params& q, int lo, int hi, bool fin, cg::grid_group& grid, unsigned char* lds) {
  unsigned char* ldh = lds + HALFID * HALF_LDS;
  BarState bst; bst.base = (unsigned*)(q.ws + OFF_MISC + MISC_CTR); bst.xcd = xcc_id(); bst.mycnt = 0; bst.nact = 0; bst.esub = 0; bst.etop = 0;
  if (lo == 0) bar_census_post(bst);
  PHASE(0, phase0(q, ldh))
  PHASE(1, post_phase(q, -1, 0, ldh, dry))
  PHASE(2, gemm_phase(q, 0, GM_IN_DA, lds, 2))
  PHASE(3, attn_phase(q, 0, lds, dry, 3))
  PHASE(4, gemm_phase(q, 0, GM_OUT, lds, 4))
  PHASE(5, post_phase(q, 0, 1, ldh, dry))
  PHASE(6, gemm_phase(q, 1, GM_IN_RET_QKV, lds, 6))
  PHASE(7, (scan_phase<1, 0>(q, ldh, dry)))
  PHASE(8, (scan_phase<1, 1>(q, ldh, dry)))
  PHASE(9, gemm_phase(q, 1, GM_IN_RET_G, lds, 9))
  PHASE(10, normgate_phase<1>(q, dry))
  PHASE(11, gemm_phase(q, 1, GM_OUT, lds, 11))
  PHASE(12, post_phase(q, 1, 2, ldh, dry))
  PHASE(13, gemm_phase(q, 2, GM_IN_HG, lds, 13))
  PHASE(14, (scan_phase<2, 0>(q, ldh, dry)))
  PHASE(15, (scan_phase<2, 1>(q, ldh, dry)))
  PHASE(16, normgate_phase<2>(q, dry))
  PHASE(17, gemm_phase(q, 2, GM_OUT, lds, 17))
  PHASE(18, post_phase(q, 2, 3, ldh, dry))
  PHASE(19, gemm_phase(q, 3, GM_IN_DA, lds, 19))
  PHASE(20, attn_phase(q, 3, lds, dry, 20))
  PHASE(21, gemm_phase(q, 3, GM_OUT, lds, 21))
  PHASE(22, post_phase(q, 3, 4, ldh, dry))
}

__global__ void __launch_bounds__(NTHR, 2) mega_fwd(Params p) {
  extern __shared__ __attribute__((aligned(16))) unsigned char lds[];
  cg::grid_group grid = cg::this_grid();
  run_range(p, p.ph_lo, p.ph_hi, true, grid, lds);
}

extern "C" void kernel_launch(void* const* d_in, const int* in_sizes, int n_in, void* d_out, int out_size, void* d_ws, size_t ws_size, hipStream_t stream) {
  static int grid_blocks = 0;
  if (grid_blocks == 0) {
    int dev = 0, cus = 0, per_cu = 0;
    hipGetDevice(&dev);
    hipDeviceGetAttribute(&cus, hipDeviceAttributeMultiprocessorCount, dev);
    hipFuncSetAttribute((const void*)mega_fwd, hipFuncAttributeMaxDynamicSharedMemorySize, LDS_BYTES);
    hipOccupancyMaxActiveBlocksPerMultiprocessor(&per_cu, (const void*)mega_fwd, NTHR, LDS_BYTES);
    if (per_cu < 1) per_cu = 1;
    if (per_cu > 1) per_cu = 1;
    if (cus < 1) cus = 256;
    grid_blocks = cus * per_cu;
    (void)hipGetLastError();
    if (n_in != 23 || ws_size < WS_NEED) { fprintf(stderr, "kernel_launch: unexpected n_in %d / ws_size %zu (need %zu)\n", n_in, ws_size, (size_t)WS_NEED); }
  }
  hipMemsetAsync((unsigned char*)d_ws + OFF_MISC + MISC_CTR, 0, 8192, stream);
  Params p{};
  for (int i = 0; i < 23; ++i) p.in[i] = (const float*)d_in[i];
  p.out = (float*)d_out;
  p.ws = (unsigned char*)d_ws;
#if ONE_LAUNCH
  p.ph_lo = 0; p.ph_hi = NPH;
  void* args[] = {&p};
  hipError_t e = hipLaunchCooperativeKernel((const void*)mega_fwd, dim3(grid_blocks), dim3(NTHR), args, LDS_BYTES, stream);
  if (e != hipSuccess) fprintf(stderr, "cooperative launch failed: %s (grid %d)\n", hipGetErrorString(e), grid_blocks);
#else
  for (int ph = 0; ph < NPH; ++ph) {
    p.ph_lo = ph; p.ph_hi = ph + 1;
    hipLaunchKernelGGL(mega_fwd, dim3(grid_blocks), dim3(NTHR), LDS_BYTES, stream, p);
  }
#endif
}
```

```cpp
#include <hip/hip_runtime.h>
#include <hip/hip_cooperative_groups.h>
#include <cstdint>
#include <cstdio>
namespace cg = cooperative_groups;

#ifndef ONE_LAUNCH
#define ONE_LAUNCH 1
#endif

typedef unsigned short bf16_t;
typedef short bf16x8 __attribute__((ext_vector_type(8)));
typedef float f32x4 __attribute__((ext_vector_type(4)));

#define NTHR 512
#define HTID ((int)(threadIdx.x & 255))
#define HALFID ((int)(threadIdx.x >> 8))
#define VBID ((int)(blockIdx.x * 2 + (threadIdx.x >> 8)))
#define VGDIM ((int)(gridDim.x * 2))
#define HALF_LDS 74816
#define MIB ((size_t)1 << 20)
#define NPH 23
#define LDS_BYTES (2 * HALF_LDS)
#define LDS_SLOT 74752
#define MISC_CTR (MISC_ROPE + 524288)

#define OFF_WIN  (288 * MIB)
#define OFF_WOUT (300 * MIB)
#define OFF_HP   (304 * MIB)
#define OFF_MISC (320 * MIB)
#define MISC_ROPE 524288
#define WS_NEED  (322 * MIB)
#define PLANE_E  ((size_t)25165824)
#define OUT_YP 0
#define OUT_YS 8388608
#define OUT_CK 25165824
#define OUT_CV 41943040
#define OUT_SR 58720256
#define OUT_SH 75497472

struct Params {
  const float* in[23];
  float* out;
  unsigned char* ws;
  int ph_lo, ph_hi;
};

struct LayerInfo { int kind, slot, IN, WIDTH; const float* w_in; const float* w_out; };

__device__ __forceinline__ LayerInfo layer_info(const Params& p, int l) {
  LayerInfo L;
  if (l == 0)      { L.kind = 0; L.slot = 0; L.IN = 4096; L.WIDTH = 1024; L.w_in = p.in[12]; L.w_out = p.in[13]; }
  else if (l == 1) { L.kind = 1; L.slot = 0; L.IN = 6144; L.WIDTH = 2048; L.w_in = p.in[16]; L.w_out = p.in[17]; }
  else if (l == 2) { L.kind = 2; L.slot = 0; L.IN = 5120; L.WIDTH = 1024; L.w_in = p.in[19]; L.w_out = p.in[20]; }
  else             { L.kind = 0; L.slot = 1; L.IN = 4096; L.WIDTH = 1024; L.w_in = p.in[12] + (size_t)1024 * 4096; L.w_out = p.in[13] + (size_t)1024 * 1024; }
  return L;
}
__device__ __forceinline__ bf16_t* hs_ptr(const Params& p, int l) {
  return l < 3 ? (bf16_t*)(p.out + OUT_SH) : (bf16_t*)(p.ws + 240 * MIB);
}

typedef __bf16 nbf16x2 __attribute__((ext_vector_type(2)));
typedef float f32x2 __attribute__((ext_vector_type(2)));
__device__ __forceinline__ float bf2f(unsigned h) { return __uint_as_float(h << 16); }
__device__ __forceinline__ unsigned pack2(float a, float b) { const f32x2 f = {a, b}; return __builtin_bit_cast(unsigned, __builtin_convertvector(f, nbf16x2)); }
__device__ __forceinline__ float lo_f(unsigned w) { return __uint_as_float(w << 16); }
__device__ __forceinline__ float hi_f(unsigned w) { return __uint_as_float(w & 0xffff0000u); }
__device__ __forceinline__ float silu_f(float x) { return x / (1.f + __expf(-x)); }
__device__ __forceinline__ float wave_sum(float v) {
#pragma unroll
  for (int o = 32; o > 0; o >>= 1) v += __shfl_xor(v, o);
  return v;
}
#define QSCALE 0.18033688011112042f
#define SB __builtin_amdgcn_sched_barrier(0)
#define MFMA(a, b, c) __builtin_amdgcn_mfma_f32_16x16x32_bf16((a), (b), (c), 0, 0, 0)

__device__ __forceinline__ void convT_tile(const float* __restrict__ src, int src_ld, bf16_t* __restrict__ dst, int dst_ld, unsigned char* lds) {
  float* t = (float*)lds;
  const int tid = HTID;
  const int kr = tid >> 4, nc = (tid & 15) * 4;
#pragma unroll
  for (int j = 0; j < 4; ++j) {
    const float4 v = *(const float4*)(src + (size_t)(kr + 16 * j) * src_ld + nc);
    float* tp = t + (kr + 16 * j) * 65 + nc;
    tp[0] = v.x; tp[1] = v.y; tp[2] = v.z; tp[3] = v.w;
  }
  __syncthreads();
  const int n = tid >> 2, kc = (tid & 3) * 16;
  unsigned w[8];
#pragma unroll
  for (int i = 0; i < 8; ++i) w[i] = pack2(t[(kc + 2 * i) * 65 + n], t[(kc + 2 * i + 1) * 65 + n]);
  uint4* d = (uint4*)(dst + (size_t)n * dst_ld + kc);
  d[0] = make_uint4(w[0], w[1], w[2], w[3]);
  d[1] = make_uint4(w[4], w[5], w[6], w[7]);
  __syncthreads();
}

__device__ __forceinline__ int conv_weights_count(const Params& p, int l) {
  const LayerInfo L = layer_info(p, l);
  return (L.IN / 64) * 16 + (L.WIDTH / 64) * 16;
}
__device__ __forceinline__ void conv_weights_item(const Params& p, int l, int it, unsigned char* lds) {
  const LayerInfo L = layer_info(p, l);
  const int nin = (L.IN / 64) * 16;
  if (it < nin) {
    const int kt = it & 15, nt = it >> 4;
    convT_tile(L.w_in + (size_t)(kt * 64) * L.IN + nt * 64, L.IN, (bf16_t*)(p.ws + OFF_WIN) + (size_t)(nt * 64) * 1024 + kt * 64, 1024, lds);
  } else {
    const int it2 = it - nin, nkt = L.WIDTH / 64;
    const int kt = it2 % nkt, nt = it2 / nkt;
    convT_tile(L.w_out + (size_t)(kt * 64) * 1024 + nt * 64, 1024, (bf16_t*)(p.ws + OFF_WOUT) + (size_t)(nt * 64) * L.WIDTH + kt * 64, L.WIDTH, lds);
  }
}

__device__ __forceinline__ void mod_item(const Params& p, int it, unsigned char* lds) {
  float* ssilu = (float*)lds;
  float* red = ssilu + 9 * 1024;
  const int tid = HTID;
  const int l = it / 48, col0 = (it % 48) * 64;
  for (int i = tid; i < 9 * 1024; i += 256) {
    const int v = i >> 10, k = i & 1023;
    const float x = (v == 0) ? p.in[7][k] : p.in[6][(v - 1) * 1024 + k];
    ssilu[i] = silu_f(x);
  }
  __syncthreads();
  const int col = tid & 63, kq = tid >> 6;
  const float* w = p.in[8] + (size_t)l * 1024 * 3072 + col0 + col;
  float acc[9];
#pragma unroll
  for (int v = 0; v < 9; ++v) acc[v] = 0.f;
  for (int k = kq * 256; k < kq * 256 + 256; ++k) {
    const float wv = w[(size_t)k * 3072];
#pragma unroll
    for (int v = 0; v < 9; ++v) acc[v] += ssilu[v * 1024 + k] * wv;
  }
#pragma unroll
  for (int v = 0; v < 9; ++v) red[(kq * 9 + v) * 64 + col] = acc[v];
  __syncthreads();
  float* mod = (float*)(p.ws + OFF_MISC);
  for (int i = tid; i < 9 * 64; i += 256) {
    const int v = i >> 6, cc = i & 63;
    const float s = red[(0 * 9 + v) * 64 + cc] + red[(1 * 9 + v) * 64 + cc] + red[(2 * 9 + v) * 64 + cc] + red[(3 * 9 + v) * 64 + cc];
    mod[(size_t)(l * 9 + v) * 3072 + col0 + cc] = s + p.in[9][l * 3072 + col0 + cc];
  }
  __syncthreads();
}

__device__ __forceinline__ void rope_item(const Params& p, int it) {
  const int idx = it * 256 + HTID;
  const int t = idx >> 5, pp = idx & 31;
  const int pos = pp < 16 ? (t >> 6) : (t & 63);
  const float inv = exp2f(-(float)(pp & 15) * (13.287712379549449f / 16.f));
  const float ang = (float)pos * inv;
  const double a = (double)ang;
  const double r = a - 6.283185307179586 * rint(a * 0.15915494309189535);
  const float rf = (float)r;
  float2* tab = (float2*)(p.ws + OFF_MISC + MISC_ROPE);
  tab[idx] = make_float2(__cosf(rf), __sinf(rf));
}

__device__ __forceinline__ void phase0(const Params& p, unsigned char* lds) {
  const int nw = conv_weights_count(p, 0);
  const int total = 192 + 256 + nw;
  for (int it = VBID; it < total; it += VGDIM) {
    if (it < 192) mod_item(p, it, lds);
    else if (it < 448) rope_item(p, it - 192);
    else conv_weights_item(p, 0, it - 448, lds);
  }
}

__device__ __forceinline__ void post_phase(const Params& p, int lprev, int lnext, unsigned char* lds, const bool dry) {
  const int tid = HTID, lane = tid & 63, w = tid >> 6;
  const float* mod = (const float*)(p.ws + OFF_MISC);
  const bf16_t* Y = nullptr;
  if (lprev >= 0) {
    const int kind = layer_info(p, lprev).kind;
    Y = (const bf16_t*)(p.ws + (kind == 1 ? 96 * MIB : 0));
  }
  bf16_t* hp = (bf16_t*)(p.ws + OFF_HP);
  bf16_t* hs = lnext < 4 ? hs_ptr(p, lnext) : nullptr;
  for (int row = VBID * 4 + w; row < 24576; row += VGDIM * 4) {
    const int mv = row < 8192 ? 0 : 1 + ((row - 8192) >> 11);
    const float* xs = (lprev <= 0) ? (row < 8192 ? p.in[0] + (size_t)row * 1024 : p.in[1] + (size_t)(row - 8192) * 1024) : p.out + (size_t)row * 1024;
    float4 x[4];
#pragma unroll
    for (int j = 0; j < 4; ++j) x[j] = *(const float4*)(xs + lane * 4 + 256 * j);
    if (lprev >= 0) {
      float4 y[4];
      float ss = 0.f;
#pragma unroll
      for (int j = 0; j < 4; ++j) { const uint2 yw = *(const uint2*)(Y + (size_t)row * 1024 + lane * 4 + 256 * j); y[j] = make_float4(lo_f(yw.x), hi_f(yw.x), lo_f(yw.y), hi_f(yw.y)); ss += y[j].x * y[j].x + y[j].y * y[j].y + y[j].z * y[j].z + y[j].w * y[j].w; }
      ss = wave_sum(ss);
      const float rstd = rsqrtf(ss * (1.f / 1024.f) + 1e-6f);
      const float* ga = mod + (size_t)(lprev * 9 + mv) * 3072 + 2048;
      const float* gp = p.in[11] + lprev * 1024;
#pragma unroll
      for (int j = 0; j < 4; ++j) {
        const int c = lane * 4 + 256 * j;
        const float4 g4 = *(const float4*)(ga + c), p4 = *(const float4*)(gp + c);
        x[j].x += g4.x * (y[j].x * rstd * p4.x); x[j].y += g4.y * (y[j].y * rstd * p4.y);
        x[j].z += g4.z * (y[j].z * rstd * p4.z); x[j].w += g4.w * (y[j].w * rstd * p4.w);
        if (!dry) *(float4*)(p.out + (size_t)row * 1024 + c) = x[j];
      }
    }
    if (lnext < 4) {
      float ss = 0.f;
#pragma unroll
      for (int j = 0; j < 4; ++j) ss += x[j].x * x[j].x + x[j].y * x[j].y + x[j].z * x[j].z + x[j].w * x[j].w;
      ss = wave_sum(ss);
      const float rstd = rsqrtf(ss * (1.f / 1024.f) + 1e-6f);
      const float* sh = mod + (size_t)(lnext * 9 + mv) * 3072;
      const float* sc = sh + 1024;
      const float* gp = p.in[10] + lnext * 1024;
      bf16_t* hd = row < 8192 ? hp + (size_t)row * 1024 : hs + (size_t)(row - 8192) * 1024;
#pragma unroll
      for (int j = 0; j < 4; ++j) {
        const int c = lane * 4 + 256 * j;
        const float4 s4 = *(const float4*)(sh + c), c4 = *(const float4*)(sc + c), p4 = *(const float4*)(gp + c);
        const float h0 = x[j].x * rstd * p4.x * (1.f + c4.x) + s4.x, h1 = x[j].y * rstd * p4.y * (1.f + c4.y) + s4.y;
        const float h2 = x[j].z * rstd * p4.z * (1.f + c4.z) + s4.z, h3 = x[j].w * rstd * p4.w * (1.f + c4.w) + s4.w;
        *(uint2*)(hd + c) = make_uint2(pack2(h0, h1), pack2(h2, h3));
      }
    }
  }
  if (lprev >= 0 && lnext < 4) {
    const int nw = conv_weights_count(p, lnext);
    for (int it = VBID; it < nw; it += VGDIM) conv_weights_item(p, lnext, it, lds);
  }
}


__device__ __forceinline__ unsigned xcc_id() { return (unsigned)__builtin_amdgcn_s_getreg((3 << 11) | 20) & 7u; }
__device__ __forceinline__ bool wq_next(unsigned* ctr, int nst, int mult, unsigned xcd, int& qstate, int& q, int& idx, unsigned char* lds) {
  volatile int* slot = (volatile int*)(lds + LDS_SLOT);
  __syncthreads();
  if (HTID == 0) {
    int qq = -1, ii = 0, st = qstate;
    while (st < 8) {
      const int cand = (int)((xcd + (unsigned)st) & 7u);
      const int got = (int)atomicAdd(ctr + cand, 1u);
      if (got < mult * ((nst - cand + 7) >> 3)) { qq = cand; ii = got; break; }
      ++st;
    }
    slot[0] = qq; slot[1] = ii; slot[2] = st;
  }
  __syncthreads();
  q = slot[0]; idx = slot[1]; qstate = slot[2];
  return q >= 0;
}

#define LAS __attribute__((address_space(3)))
template <bool SWAP>
__device__ __forceinline__ void gemm_tile_compute(const bf16_t* __restrict__ Ag, const bf16_t* __restrict__ Bg, int K, unsigned char* lds, f32x4 (&acc)[8][4],
                                                  const bool pre, const bf16_t* __restrict__ An, const bf16_t* __restrict__ Bn, const bool hasn) {
  const int tid = threadIdx.x, lane = tid & 63, wid = __builtin_amdgcn_readfirstlane(tid >> 6), wm = wid >> 2, wn = wid & 3;
  const int lr = lane & 15, lg = lane >> 4;
  LAS unsigned char* l3 = (LAS unsigned char*)lds;
  const int prow = lane >> 3;
  const int pgo0 = prow * K + (((lane & 7) ^ ((prow >> 1) & 7)) << 3);
  const int pgo1 = prow * K + (((lane & 7) ^ ((4 + (prow >> 1)) & 7)) << 3);
  const bf16_t* asrc = Ag + (size_t)(wid * 32) * K;
  const bf16_t* bsrc = Bg + (size_t)(wid * 32) * K;
  const size_t pstep = (size_t)8 * K;
#pragma unroll
  for (int mi = 0; mi < 8; ++mi)
#pragma unroll
    for (int ni = 0; ni < 4; ++ni) acc[mi][ni] = (f32x4){0.f, 0.f, 0.f, 0.f};
#define GEMM_STAGE_P(ap_, bp_, s, k0)                                                                                                      \
  {                                                                                                                                        \
    _Pragma("unroll") for (int j = 0; j < 4; ++j) {                                                                                        \
      __builtin_amdgcn_global_load_lds((const unsigned*)((ap_) + j * pstep + ((j & 1) ? pgo1 : pgo0) + (k0)), (LAS unsigned*)(l3 + (s) * 65536 + (wid * 4 + j) * 1024), 16, 0, 0);          \
      __builtin_amdgcn_global_load_lds((const unsigned*)((bp_) + j * pstep + ((j & 1) ? pgo1 : pgo0) + (k0)), (LAS unsigned*)(l3 + (s) * 65536 + 32768 + (wid * 4 + j) * 1024), 16, 0, 0);  \
    }                                                                                                                                      \
  }
#define GEMM_STAGE(s, k0) GEMM_STAGE_P(asrc, bsrc, s, k0)
  const int nk = K >> 6;
  if (!pre) GEMM_STAGE(0, 0);
  asm volatile("s_waitcnt vmcnt(0)" ::: "memory");
  __syncthreads();
  const int x0 = lg ^ ((lr >> 1) & 7);
  const int aoff0 = (wm * 128 + lr) * 128 + x0 * 16, aoff1 = (wm * 128 + lr) * 128 + (x0 ^ 4) * 16;
  const int boff0 = 32768 + (wn * 64 + lr) * 128 + x0 * 16, boff1 = 32768 + (wn * 64 + lr) * 128 + (x0 ^ 4) * 16;
  for (int kt = 0; kt < nk; ++kt) {
    if (kt + 1 < nk) GEMM_STAGE((kt + 1) & 1, (kt + 1) * 64);
    const unsigned char* st = lds + (kt & 1) * 65536;
#pragma unroll
    for (int kk = 0; kk < 2; ++kk) {
      bf16x8 af[8], bfr[4];
#pragma unroll
      for (int ni = 0; ni < 4; ++ni) bfr[ni] = *(const bf16x8*)(st + (kk ? boff1 : boff0) + ni * 2048);
#pragma unroll
      for (int mi = 0; mi < 8; ++mi) af[mi] = *(const bf16x8*)(st + (kk ? aoff1 : aoff0) + mi * 2048);
#pragma unroll
      for (int mi = 0; mi < 8; ++mi)
#pragma unroll
        for (int ni = 0; ni < 4; ++ni)
          acc[mi][ni] = SWAP ? MFMA(bfr[ni], af[mi], acc[mi][ni]) : MFMA(af[mi], bfr[ni], acc[mi][ni]);
    }
    asm volatile("s_waitcnt vmcnt(0)" ::: "memory");
    __syncthreads();
  }
  if (hasn) { const bf16_t* an_ = An + (size_t)(wid * 32) * K; const bf16_t* bn_ = Bn + (size_t)(wid * 32) * K; GEMM_STAGE_P(an_, bn_, 0, 0); }
#undef GEMM_STAGE
#undef GEMM_STAGE_P
}

enum { GM_IN_DA = 0, GM_IN_RET_QKV = 1, GM_IN_RET_G = 2, GM_IN_HG = 3, GM_OUT = 4 };

__device__ __forceinline__ void epi_swapped(const Params& p, int mode, int slot, int ykind, int m, int n, f32x4 v) {
  bf16_t* R0 = (bf16_t*)p.ws;
  if (mode == GM_OUT) {
    bf16_t* Y = (bf16_t*)(p.ws + (ykind == 1 ? 96 * MIB : 0));
    *(uint2*)(Y + (size_t)m * 1024 + n) = make_uint2(pack2(v[0], v[1]), pack2(v[2], v[3]));
  } else if (mode == GM_IN_DA) {
    const bool smp = m >= 8192;
    const int ms = m - 8192;
    const int b = smp ? (ms >> 11) : (m >> 8), t = smp ? (ms & 2047) : (m & 255);
    if (n < 2048) {
      if (smp) {
        const float4 cs = *(const float4*)((const float*)(p.ws + OFF_MISC + MISC_ROPE) + (size_t)(t * 32 + ((n & 63) >> 1)) * 2);
        const float a0 = v[0] * cs.x - v[1] * cs.y, a1 = v[0] * cs.y + v[1] * cs.x;
        const float a2 = v[2] * cs.z - v[3] * cs.w, a3 = v[2] * cs.w + v[3] * cs.z;
        v = (f32x4){a0, a1, a2, a3};
      }
      if (n < 1024) {
        *(uint2*)(R0 + (size_t)m * 1024 + n) = make_uint2(pack2(v[0] * QSCALE, v[1] * QSCALE), pack2(v[2] * QSCALE, v[3] * QSCALE));
      } else {
        const int c = n - 1024;
        const uint2 pk = make_uint2(pack2(v[0], v[1]), pack2(v[2], v[3]));
        if (smp) {
          *(uint2*)(R0 + 64 * MIB / 2 + ((size_t)b * 2560 + t) * 1024 + c) = pk;
        } else {
          *(f32x4*)(p.out + OUT_CK + ((size_t)((b * 2 + slot) * 256 + t)) * 1024 + c) = v;
          *(uint2*)(R0 + 48 * MIB / 2 + (size_t)m * 1024 + c) = pk;
        }
      }
    } else {
      *(uint2*)(R0 + 160 * MIB / 2 + (size_t)m * 1024 + (n - 3072)) = make_uint2(pack2(silu_f(v[0]), silu_f(v[1])), pack2(silu_f(v[2]), silu_f(v[3])));
    }
  } else if (mode == GM_IN_RET_QKV) {
    if (n < 1024) *(uint2*)(R0 + (size_t)m * 1024 + n) = make_uint2(pack2(v[0], v[1]), pack2(v[2], v[3]));
    else if (n < 2048) { const float s = 0.08838834764831845f; *(uint2*)(R0 + PLANE_E + (size_t)m * 1024 + (n - 1024)) = make_uint2(pack2(v[0] * s, v[1] * s), pack2(v[2] * s, v[3] * s)); }
    else *(uint2*)(R0 + 2 * PLANE_E + (size_t)m * 2048 + (n - 2048)) = make_uint2(pack2(v[0], v[1]), pack2(v[2], v[3]));
  } else if (mode == GM_IN_RET_G) {
    *(uint2*)(R0 + (size_t)m * 2048 + n) = make_uint2(pack2(silu_f(v[0]), silu_f(v[1])), pack2(silu_f(v[2]), silu_f(v[3])));
  } else {
    if (n < 1024 || n >= 4096) v = (f32x4){silu_f(v[0]), silu_f(v[1]), silu_f(v[2]), silu_f(v[3])};
    *(uint2*)(R0 + (size_t)(n >> 10) * PLANE_E + (size_t)m * 1024 + (n & 1023)) = make_uint2(pack2(v[0], v[1]), pack2(v[2], v[3]));
  }
}

__device__ __forceinline__ void epi_da_v(const Params& p, int slot, int m, int n, f32x4 v) {
  bf16_t* R0 = (bf16_t*)p.ws;
  const int c = n - 2048, hh = c >> 7, e = c & 127;
  const uint2 pk = make_uint2(pack2(v[0], v[1]), pack2(v[2], v[3]));
  if (m >= 8192) {
    const int ms = m - 8192, b = ms >> 11, t = ms & 2047;
    *(uint2*)(R0 + 120 * MIB / 2 + ((size_t)((b * 8 + hh) * 128 + e)) * 2560 + t) = pk;
  } else {
    const int b = m >> 8, t = m & 255;
    float* o = p.out + OUT_CV + ((size_t)((b * 2 + slot) * 256 + t)) * 1024 + c;
    o[0] = v[0]; o[1024] = v[1]; o[2048] = v[2]; o[3072] = v[3];
    *(uint2*)(R0 + 104 * MIB / 2 + ((size_t)((b * 8 + hh) * 128 + e)) * 256 + t) = pk;
  }
}

__device__ __forceinline__ void gemm_phase(const Params& p, int l, int mode, unsigned char* lds, int phid) {
  const LayerInfo L = layer_info(p, l);
  bf16_t* R0 = (bf16_t*)p.ws;
  const bf16_t *Ap, *As, *Bt;
  int K, N;
  if (mode == GM_OUT) {
    K = L.WIDTH; N = 1024; Bt = (const bf16_t*)(p.ws + OFF_WOUT);
    const bf16_t* base = R0 + (L.kind == 0 ? 160 * MIB / 2 : (L.kind == 1 ? 4 * PLANE_E : 5 * PLANE_E));
    Ap = base; As = base + (size_t)8192 * K;
  } else {
    K = 1024; Ap = (const bf16_t*)(p.ws + OFF_HP); As = hs_ptr(p, l);
    Bt = (const bf16_t*)(p.ws + OFF_WIN) + (mode == GM_IN_RET_G ? (size_t)4096 * 1024 : 0);
    N = (mode == GM_IN_DA || mode == GM_IN_RET_QKV) ? 4096 : (mode == GM_IN_RET_G ? 2048 : 5120);
  }
  const int ntn = N >> 8, ntiles = 96 * ntn;
  const int extra = (mode == GM_IN_DA) ? 3072 : 0;
  const int tid = threadIdx.x, lane = tid & 63, wid = tid >> 6, wm = wid >> 2, wn = wid & 3, lr = lane & 15, lg = lane >> 4;
  const int G = gridDim.x;
  const bool swz = (G & 7) == 0;
  const int xcd = blockIdx.x & 7, snn = ntn >> 2, nst = 12 * snn;
  const int q0 = swz ? (int)(blockIdx.x >> 3) : (int)blockIdx.x, qstep = swz ? (G >> 3) : G;
  const int qlen = swz ? 32 * ((nst - xcd + 7) >> 3) : ntiles;
#define GEMM_TILE_OF(qq, m0_, n0_)                                                   \
  {                                                                                    \
    int it_ = (qq);                                                                    \
    if (swz) {                                                                         \
      const int st_ = xcd + 8 * ((qq) >> 5), tin_ = (qq) & 31;                         \
      const int smt_ = st_ / snn, snt_ = st_ - smt_ * snn;                             \
      it_ = (smt_ * 8 + (tin_ >> 2)) * ntn + snt_ * 4 + (tin_ & 3);                    \
    }                                                                                  \
    const int mt_ = it_ / ntn;                                                         \
    m0_ = mt_ * 256; n0_ = (it_ - mt_ * ntn) * 256;                                    \
  }
  bool pre = false;
  for (int q = q0; q < qlen; q += qstep) {
    int m0, n0;
    GEMM_TILE_OF(q, m0, n0)
    const bf16_t* A = m0 < 8192 ? Ap + (size_t)m0 * K : As + (size_t)(m0 - 8192) * K;
    const bf16_t* B = Bt + (size_t)n0 * K;
    const bool hasn = q + qstep < qlen;
    const bf16_t *An = A, *Bn = B;
    if (hasn) {
      int m1, n1;
      GEMM_TILE_OF(q + qstep, m1, n1)
      An = m1 < 8192 ? Ap + (size_t)m1 * K : As + (size_t)(m1 - 8192) * K;
      Bn = Bt + (size_t)n1 * K;
    }
    {
      f32x4 acc[8][4];
      if (mode == GM_IN_DA && n0 >= 2048 && n0 < 3072) {
        gemm_tile_compute<false>(A, B, K, lds, acc, pre, An, Bn, hasn);
#pragma unroll
        for (int mi = 0; mi < 8; ++mi)
#pragma unroll
          for (int ni = 0; ni < 4; ++ni)
            epi_da_v(p, L.slot, m0 + wm * 128 + mi * 16 + 4 * lg, n0 + wn * 64 + ni * 16 + lr, acc[mi][ni]);
      } else {
        gemm_tile_compute<true>(A, B, K, lds, acc, pre, An, Bn, hasn);
#pragma unroll
        for (int mi = 0; mi < 8; ++mi)
#pragma unroll
          for (int ni = 0; ni < 4; ++ni)
            epi_swapped(p, mode, L.slot, L.kind, m0 + wm * 128 + mi * 16 + lr, n0 + wn * 64 + ni * 16 + 4 * lg, acc[mi][ni]);
      }
    }
    pre = hasn;
  }
#undef GEMM_TILE_OF
  if (extra) { asm volatile("s_waitcnt vmcnt(0)" ::: "memory"); __syncthreads(); }
  for (int ci = VBID; ci < extra; ci += VGDIM) {
    {
      if (ci < 2048) {
        const int idx = (ci * 256 + HTID) * 8;
        const int b = idx >> 19, rem = idx & 524287, tp = rem >> 10, c = rem & 1023;
        const float* src = p.in[2] + ((size_t)((b * 2 + L.slot) * 512 + tp)) * 1024 + c;
        const float4 u0 = *(const float4*)src, u1 = *(const float4*)(src + 4);
        *(uint4*)(R0 + 64 * MIB / 2 + ((size_t)b * 2560 + 2048 + tp) * 1024 + c) = make_uint4(pack2(u0.x, u0.y), pack2(u0.z, u0.w), pack2(u1.x, u1.y), pack2(u1.z, u1.w));
      } else {
        const int i2 = ci - 2048;
        const int b = i2 >> 7, hh = (i2 >> 4) & 7, tt = (i2 >> 1) & 7, et = i2 & 1;
        convT_tile(p.in[3] + ((size_t)((b * 2 + L.slot) * 512 + tt * 64)) * 1024 + hh * 128 + et * 64, 1024,
                   R0 + 120 * MIB / 2 + ((size_t)((b * 8 + hh) * 128 + et * 64)) * 2560 + 2048 + tt * 64, 2560, lds + HALFID * HALF_LDS);
      }
    }
  }
}

__device__ __forceinline__ void attn_phase(const Params& p, int l, unsigned char* lds, const bool dry, int phid) {
  const int slot = l == 3 ? 1 : 0;
  const float lam_init = 0.8f - 0.6f * expf(-0.3f * (float)l);
  const int tid = threadIdx.x, lane = tid & 63, w = tid >> 6, lr = lane & 15, lg = lane >> 4;
  float lam;
  {
    const float* lf = p.in[14] + slot * 256;
    const float a = wave_sum(lf[lane] * lf[64 + lane]);
    const float b2 = wave_sum(lf[128 + lane] * lf[192 + lane]);
    lam = expf(a) - expf(b2) + lam_init;
  }
  bf16_t* R0 = (bf16_t*)p.ws;
  const float* subg = p.in[15] + slot * 128;
  for (int item = blockIdx.x; item < 1536; item += gridDim.x) {
    int grp, b, h, qt;
    if (item < 1024) { grp = 1; b = item >> 7; h = (item >> 4) & 7; qt = item & 15; }
    else { const int i2 = item - 1024; grp = 0; b = i2 >> 4; h = (i2 >> 1) & 7; qt = i2 & 1; }
    const int nkeys = grp ? 2560 : 256, ntile = nkeys >> 6;
    const int mq = (grp ? 8192 + b * 2048 : b * 256) + qt * 128 + w * 16 + lr;
    const bf16_t* Kg = grp ? R0 + 64 * MIB / 2 + (size_t)b * 2560 * 1024 + h * 128 : R0 + 48 * MIB / 2 + (size_t)b * 256 * 1024 + h * 128;
    const bf16_t* Vg = grp ? R0 + 120 * MIB / 2 + (size_t)(b * 8 + h) * 128 * 2560 : R0 + 104 * MIB / 2 + (size_t)(b * 8 + h) * 128 * 256;
    bf16x8 qf[2][2];
#pragma unroll
    for (int sub = 0; sub < 2; ++sub)
#pragma unroll
      for (int ks = 0; ks < 2; ++ks) qf[sub][ks] = *(const bf16x8*)(R0 + (size_t)mq * 1024 + h * 128 + sub * 64 + ks * 32 + lg * 8);
    LAS unsigned char* l3 = (LAS unsigned char*)lds;
    const int wu = __builtin_amdgcn_readfirstlane(w);
    int koff[2], voff[2];
#pragma unroll
    for (int j = 0; j < 2; ++j) {
      const int kr = (wu * 2 + j) * 4 + (lane >> 4);
      koff[j] = kr * 1024 + (((lane & 15) ^ (kr & 15)) << 3);
      const int er = (wu * 2 + j) * 8 + (lane >> 3);
      voff[j] = er * nkeys + (((lane & 7) ^ ((er >> 1) & 7)) << 3);
    }
#define ATT_STAGE_K(s, key0)                                                                                  \
  {                                                                                                           \
    _Pragma("unroll") for (int j = 0; j < 2; ++j)                                                             \
      __builtin_amdgcn_global_load_lds((const unsigned*)(Kg + (size_t)(key0) * 1024 + koff[j]), (LAS unsigned*)(l3 + (s) * 32768 + (wu * 2 + j) * 1024), 16, 0, 0); \
  }
#define ATT_STAGE_V(s, key0)                                                                                  \
  {                                                                                                           \
    _Pragma("unroll") for (int j = 0; j < 2; ++j)                                                             \
      __builtin_amdgcn_global_load_lds((const unsigned*)(Vg + (key0) + voff[j]), (LAS unsigned*)(l3 + (s) * 32768 + 16384 + (wu * 2 + j) * 1024), 16, 0, 0); \
  }
    const int xl = lg ^ lr;
    const int vsw = (lr >> 1) & 7;
    const int vlo = lr * 128 + ((((lg >> 1)) ^ vsw) << 4) + (lg & 1) * 8;
    float mx[2] = {-1e30f, -1e30f}, ls[2] = {0.f, 0.f};
    f32x4 o0[8], o1[8];
#pragma unroll
    for (int et = 0; et < 8; ++et) { o0[et] = (f32x4){0.f, 0.f, 0.f, 0.f}; o1[et] = (f32x4){0.f, 0.f, 0.f, 0.f}; }
    ATT_STAGE_K(0, 0);
    ATT_STAGE_V(0, 0);
    asm volatile("s_waitcnt vmcnt(0)" ::: "memory");
    __syncthreads();
    for (int kt = 0; kt < ntile; ++kt) {
      if (kt + 1 < ntile) { ATT_STAGE_K((kt + 1) & 1, (kt + 1) * 64); ATT_STAGE_V((kt + 1) & 1, (kt + 1) * 64); }
      const unsigned char* ks_ = lds + (kt & 1) * 32768 + lr * 256;
      const unsigned char* vs_ = lds + (kt & 1) * 32768 + 16384;
#pragma unroll
      for (int k2 = 0; k2 < 2; ++k2) {
        bf16x8 kfr[8];
        uint2 vlo_[8], vhi_[8];
#pragma unroll
        for (int sub = 0; sub < 2; ++sub)
#pragma unroll
          for (int nn = 0; nn < 2; ++nn)
#pragma unroll
            for (int ks = 0; ks < 2; ++ks)
              kfr[sub * 4 + nn * 2 + ks] = *(const bf16x8*)(ks_ + (2 * k2 + nn) * 4096 + ((xl ^ (sub * 8 + ks * 4)) << 4));
#pragma unroll
        for (int et = 0; et < 8; ++et) {
          vlo_[et] = *(const uint2*)(vs_ + et * 2048 + (vlo ^ (k2 << 6)));
          vhi_[et] = *(const uint2*)(vs_ + et * 2048 + (vlo ^ (k2 << 6) ^ 32));
        }
        SB;
        f32x4 s[2][2];
#pragma unroll
        for (int sub = 0; sub < 2; ++sub)
#pragma unroll
          for (int nn = 0; nn < 2; ++nn) {
            s[sub][nn] = MFMA(kfr[sub * 4 + nn * 2], qf[sub][0], ((f32x4){0.f, 0.f, 0.f, 0.f}));
            s[sub][nn] = MFMA(kfr[sub * 4 + nn * 2 + 1], qf[sub][1], s[sub][nn]);
          }
        SB;
        bf16x8 pf[2];
        float tmx[2];
#pragma unroll
        for (int sub = 0; sub < 2; ++sub) {
          float tm = fmaxf(fmaxf(fmaxf(s[sub][0][0], s[sub][0][1]), fmaxf(s[sub][0][2], s[sub][0][3])), fmaxf(fmaxf(s[sub][1][0], s[sub][1][1]), fmaxf(s[sub][1][2], s[sub][1][3])));
          tm = fmaxf(tm, __shfl_xor(tm, 16));
          tm = fmaxf(tm, __shfl_xor(tm, 32));
          tmx[sub] = tm;
        }
        if (__any((tmx[0] > mx[0] + 8.f) || (tmx[1] > mx[1] + 8.f))) {
#pragma unroll
          for (int sub = 0; sub < 2; ++sub) {
            const float mn = (tmx[sub] > mx[sub] + 8.f) ? tmx[sub] : mx[sub];
            const float sc = __builtin_amdgcn_exp2f(mx[sub] - mn);
            mx[sub] = mn;
            ls[sub] *= sc;
#pragma unroll
            for (int et = 0; et < 8; ++et) {
              if (sub == 0) { o0[et][0] *= sc; o0[et][1] *= sc; o0[et][2] *= sc; o0[et][3] *= sc; }
              else { o1[et][0] *= sc; o1[et][1] *= sc; o1[et][2] *= sc; o1[et][3] *= sc; }
            }
          }
        }
#pragma unroll
        for (int sub = 0; sub < 2; ++sub) {
          unsigned pw[4];
          float acc = 0.f;
#pragma unroll
          for (int nn = 0; nn < 2; ++nn) {
            float a[4];
#pragma unroll
            for (int r = 0; r < 4; ++r) { a[r] = __builtin_amdgcn_exp2f(s[sub][nn][r] - mx[sub]); acc += a[r]; }
            pw[nn * 2] = pack2(a[0], a[1]);
            pw[nn * 2 + 1] = pack2(a[2], a[3]);
          }
          ls[sub] += acc;
          union { unsigned u[4]; bf16x8 v; } cp;
          cp.u[0] = pw[0]; cp.u[1] = pw[1]; cp.u[2] = pw[2]; cp.u[3] = pw[3];
          pf[sub] = cp.v;
        }
        SB;
#pragma unroll
        for (int et = 0; et < 8; ++et) {
          union { unsigned u[4]; bf16x8 v; } cv;
          cv.u[0] = vlo_[et].x; cv.u[1] = vlo_[et].y; cv.u[2] = vhi_[et].x; cv.u[3] = vhi_[et].y;
          o0[et] = MFMA(cv.v, pf[0], o0[et]);
          o1[et] = MFMA(cv.v, pf[1], o1[et]);
        }
        SB;
      }
      asm volatile("s_waitcnt vmcnt(0)" ::: "memory");
      __syncthreads();
    }
    f32x4 o[8];
    {
      float t0 = ls[0], t1 = ls[1];
      t0 += __shfl_xor(t0, 16); t0 += __shfl_xor(t0, 32);
      t1 += __shfl_xor(t1, 16); t1 += __shfl_xor(t1, 32);
      const float c1 = 1.f / t0, c2 = lam / t1;
#pragma unroll
      for (int et = 0; et < 8; ++et)
#pragma unroll
        for (int r = 0; r < 4; ++r) o[et][r] = o0[et][r] * c1 - o1[et][r] * c2;
    }
#undef ATT_STAGE_K
#undef ATT_STAGE_V
    float ss = 0.f;
#pragma unroll
    for (int et = 0; et < 8; ++et)
#pragma unroll
      for (int r = 0; r < 4; ++r) ss += o[et][r] * o[et][r];
    ss += __shfl_xor(ss, 16);
    ss += __shfl_xor(ss, 32);
    const float rs = rsqrtf(ss * (1.f / 128.f) + 1e-6f) * (1.f - lam_init);
    bf16_t* gp = R0 + 160 * MIB / 2 + (size_t)mq * 1024 + h * 128;
#pragma unroll
    for (int et = 0; et < 8; ++et) {
      const int e0 = 16 * et + 4 * lg;
      const uint2 g = *(const uint2*)(gp + e0);
      const float4 sg = *(const float4*)(subg + e0);
      const float v0 = o[et][0] * rs * sg.x * lo_f(g.x), v1 = o[et][1] * rs * sg.y * hi_f(g.x);
      const float v2 = o[et][2] * rs * sg.z * lo_f(g.y), v3 = o[et][3] * rs * sg.w * hi_f(g.y);
      if (!dry) *(uint2*)(gp + e0) = make_uint2(pack2(v0, v1), pack2(v2, v3));
    }
  }
}

__device__ __forceinline__ bf16_t* hg_ob_row(const Params& p, int m) {
  const int c = m >> 9;
  float* base = c < 32 ? p.out + OUT_CK + (size_t)(c * 2 + 1) * 262144 : p.out + OUT_CV + (size_t)((c - 32) * 2 + 1) * 262144;
  return (bf16_t*)base + (size_t)(m & 511) * 1024;
}

template <int KIND, int DIR>
__device__ __forceinline__ void scan_item(const Params& p, int item, unsigned char* lds, const bool dry) {
  constexpr int DV = KIND == 1 ? 256 : 128, NSL = DV / 64, LDV = KIND == 1 ? 2048 : 1024;
  const int tid = HTID, lane = tid & 63, w = tid >> 6, lr = lane & 15, lg = lane >> 4;
  int grp, b, h, sl;
  {
    int it = item;
    if (it < 64 * NSL) grp = 1; else { grp = 0; it -= 64 * NSL; }
    sl = it % NSL; h = (it / NSL) & 7; b = it / (NSL * 8);
  }
  const int T = grp ? 2048 : 256, nch = T >> 6;
  const size_t mbase = grp ? (size_t)8192 + (size_t)b * 2048 : (size_t)b * 256;
  bf16_t* R0 = (bf16_t*)p.ws;
  const bf16_t* Qg = R0 + mbase * 1024 + h * 128;
  const bf16_t* Kg = R0 + (KIND == 1 ? PLANE_E : (DIR ? 2 * PLANE_E : PLANE_E)) + mbase * 1024 + h * 128;
  const bf16_t* Vg = R0 + (KIND == 1 ? 2 * PLANE_E : 3 * PLANE_E) + mbase * LDV + h * DV + sl * 64;
  bf16_t* Og = R0 + (KIND == 1 ? 4 * PLANE_E : 5 * PLANE_E) + mbase * LDV + h * DV + sl * 64;
  unsigned char* Qs = lds;
  unsigned char* X = lds + 17408;
  unsigned char* Vt = lds + 35840;
  unsigned char* StS = lds + 45056;
  unsigned char* Pm = lds + 62464;
  float* xch = (float*)(lds + 71680);
  float* blA = xch + 512;
  float* erA = xch + 640;
  const int dp = tid & 63, tq = tid >> 6, r0 = tq * 16, d0 = dp * 2;
  float cst0, cst1;
  if (KIND == 1) { cst0 = cst1 = log1pf(-expf(p.in[18][DIR * 8 + h])); }
  else {
    const float* lbp = p.in[21] + DIR * 4096 + h * 128 + d0;
    {
      const float x0 = lbp[0], x1 = lbp[1024], x2 = lbp[2048], x3 = lbp[3072];
      const float m = fmaxf(fmaxf(x0, x1), fmaxf(x2, x3));
      const float e0 = expf(x0 - m), e1 = expf(x1 - m), e2 = expf(x2 - m), e3 = expf(x3 - m);
      cst0 = (e1 + e2) / (e0 + e1 + e2 + e3);
    }
    {
      const float x0 = lbp[1], x1 = lbp[1025], x2 = lbp[2049], x3 = lbp[3073];
      const float m = fmaxf(fmaxf(x0, x1), fmaxf(x2, x3));
      const float e0 = expf(x0 - m), e1 = expf(x1 - m), e2 = expf(x2 - m), e3 = expf(x3 - m);
      cst1 = (e1 + e2) / (e0 + e1 + e2 + e3);
    }
  }
  f32x4 S[8];
  if (grp) {
    const float* s0 = (KIND == 1 ? p.in[4] : p.in[5]) + ((size_t)((b * 2 + DIR) * 8 + h) * 128) * DV + sl * 64 + 16 * w + lr + (size_t)(4 * lg) * DV;
    asm volatile("" : "+v"(s0));
#pragma unroll
    for (int dt = 0; dt < 8; ++dt)
#pragma unroll
      for (int r = 0; r < 4; ++r) S[dt][r] = s0[(16 * dt + r) * DV];
  } else {
#pragma unroll
    for (int dt = 0; dt < 8; ++dt) S[dt] = (f32x4){0.f, 0.f, 0.f, 0.f};
  }
  unsigned qv[16], kv[16], vv[8];
  const int ve2 = tid & 31, vq = tid >> 5;
  const int qoff = r0 * 512 + dp;
  const int voff = (8 * vq) * (LDV / 2) + ve2;
  const unsigned* Qg32 = (const unsigned*)Qg;
  const unsigned* Kg32 = (const unsigned*)Kg;
  const unsigned* Vg32 = (const unsigned*)Vg;
#define SCAN_ISSUE(c)                                                                                   \
  {                                                                                                     \
    const unsigned* q_ = Qg32 + (size_t)(c) * (64 * 512) + qoff;                                        \
    const unsigned* k_ = Kg32 + (size_t)(c) * (64 * 512) + qoff;                                        \
    const unsigned* v_ = Vg32 + (size_t)(c) * (64 * (LDV / 2)) + voff;                                  \
    asm volatile("" : "+v"(q_), "+v"(k_), "+v"(v_));                                                    \
    _Pragma("unroll") for (int i = 0; i < 16; ++i) { qv[i] = q_[i * 512]; kv[i] = k_[i * 512]; }        \
    _Pragma("unroll") for (int i = 0; i < 8; ++i) vv[i] = v_[i * (LDV / 2)];                            \
  }
  SCAN_ISSUE(DIR ? nch - 1 : 0);
  for (int ci = 0; ci < nch; ++ci) {
    const int c = DIR ? nch - 1 - ci : ci;
    float tot0 = 0.f, tot1 = 0.f;
    if (KIND == 1) { tot0 = tot1 = 16.f * cst0; }
    else {
#pragma unroll
      for (int i = 0; i < 16; ++i) {
        const float s0_ = 1.f / (1.f + __expf(-lo_f(kv[i]))), s1_ = 1.f / (1.f + __expf(-hi_f(kv[i])));
        tot0 += __logf(cst0 + (1.f - cst0) * s0_);
        tot1 += __logf(cst1 + (1.f - cst1) * s1_);
      }
    }
    *(float2*)(xch + tq * 128 + d0) = make_float2(tot0, tot1);
    __syncthreads();
    const float2 t0 = *(const float2*)(xch + d0), t1 = *(const float2*)(xch + 128 + d0), t2 = *(const float2*)(xch + 256 + d0), t3 = *(const float2*)(xch + 384 + d0);
    const float blast0 = (t0.x + t1.x) + (t2.x + t3.x), blast1 = (t0.y + t1.y) + (t2.y + t3.y);
    float ref0, ref1, run0, run1;
    if (DIR == 0) {
      ref0 = t0.x + t1.x; ref1 = t0.y + t1.y;
      run0 = (tq > 0 ? t0.x : 0.f) + (tq > 1 ? t1.x : 0.f) + (tq > 2 ? t2.x : 0.f);
      run1 = (tq > 0 ? t0.y : 0.f) + (tq > 1 ? t1.y : 0.f) + (tq > 2 ? t2.y : 0.f);
    } else {
      ref0 = t2.x + t3.x; ref1 = t2.y + t3.y;
      run0 = (tq < 3 ? t3.x : 0.f) + (tq < 2 ? t2.x : 0.f) + (tq < 1 ? t1.x : 0.f);
      run1 = (tq < 3 ? t3.y : 0.f) + (tq < 2 ? t2.y : 0.f) + (tq < 1 ? t1.y : 0.f);
    }
    unsigned ktp0[8], ktp1[8];
#pragma unroll
    for (int jj = 0; jj < 8; ++jj) {
      const int j = DIR ? 7 - jj : jj;
      float ka[2], kb[2];
#pragma unroll
      for (int hh = 0; hh < 2; ++hh) {
        const int i = 2 * j + (DIR ? 1 - hh : hh);
        float g0, g1, k0, k1;
        if (KIND == 1) { g0 = g1 = cst0; k0 = lo_f(kv[i]); k1 = hi_f(kv[i]); }
        else {
          const float s0_ = 1.f / (1.f + __expf(-lo_f(kv[i]))), s1_ = 1.f / (1.f + __expf(-hi_f(kv[i])));
          g0 = __logf(cst0 + (1.f - cst0) * s0_); g1 = __logf(cst1 + (1.f - cst1) * s1_);
          k0 = (1.f - cst0) * (1.f - s0_); k1 = (1.f - cst1) * (1.f - s1_);
        }
        run0 += g0; run1 += g1;
        *(unsigned*)(Qs + (r0 + i) * 272 + d0 * 2) = pack2(lo_f(qv[i]) * __expf(run0 - ref0), hi_f(qv[i]) * __expf(run1 - ref1));
        *(unsigned*)(X + (r0 + i) * 272 + d0 * 2) = pack2(k0 * __expf(ref0 - run0), k1 * __expf(ref1 - run1));
        ka[i & 1] = k0 * __expf(blast0 - run0);
        kb[i & 1] = k1 * __expf(blast1 - run1);
      }
      ktp0[j] = pack2(ka[0], ka[1]);
      ktp1[j] = pack2(kb[0], kb[1]);
    }
    if (tq == 0) { *(float2*)(blA + d0) = make_float2(__expf(blast0), __expf(blast1)); *(float2*)(erA + d0) = make_float2(__expf(ref0), __expf(ref1)); }
    {
      const unsigned a0 = (vv[0] & 0xffffu) | (vv[1] << 16), a1 = (vv[2] & 0xffffu) | (vv[3] << 16), a2 = (vv[4] & 0xffffu) | (vv[5] << 16), a3 = (vv[6] & 0xffffu) | (vv[7] << 16);
      const unsigned b0 = (vv[0] >> 16) | (vv[1] & 0xffff0000u), b1 = (vv[2] >> 16) | (vv[3] & 0xffff0000u), b2 = (vv[4] >> 16) | (vv[5] & 0xffff0000u), b3 = (vv[6] >> 16) | (vv[7] & 0xffff0000u);
      *(uint4*)(Vt + (2 * ve2) * 144 + vq * 16) = make_uint4(a0, a1, a2, a3);
      *(uint4*)(Vt + (2 * ve2 + 1) * 144 + vq * 16) = make_uint4(b0, b1, b2, b3);
    }
    if (ci + 1 < nch) { SCAN_ISSUE(DIR ? c - 1 : c + 1); }
    __syncthreads();
#pragma unroll
    for (int dt = 0; dt < 8; ++dt) {
      const float4 er4 = *(const float4*)(erA + 16 * dt + 4 * lg);
      *(uint2*)(StS + (16 * w + lr) * 272 + (16 * dt + 4 * lg) * 2) = make_uint2(pack2(S[dt][0] * er4.x, S[dt][1] * er4.y), pack2(S[dt][2] * er4.z, S[dt][3] * er4.w));
    }
    bf16x8 qf[4];
#pragma unroll
    for (int ks = 0; ks < 4; ++ks) qf[ks] = *(const bf16x8*)(Qs + (16 * w + lr) * 272 + ks * 64 + lg * 16);
    uint2 pv[4];
    {
      const int t = 16 * w + lr;
#pragma unroll
      for (int st = 0; st < 4; ++st) {
        f32x4 s = (f32x4){0.f, 0.f, 0.f, 0.f};
#pragma unroll
        for (int ks = 0; ks < 4; ++ks) {
          const bf16x8 kf = *(const bf16x8*)(X + (16 * st + lr) * 272 + ks * 64 + lg * 16);
          s = MFMA(kf, qf[ks], s);
        }
        float v[4];
#pragma unroll
        for (int r = 0; r < 4; ++r) {
          const int si = 16 * st + 4 * lg + r;
          const bool keep = DIR ? (t <= si) : (t >= si);
          v[r] = keep ? s[r] : 0.f;
        }
        pv[st] = make_uint2(pack2(v[0], v[1]), pack2(v[2], v[3]));
      }
    }
    __syncthreads();
#pragma unroll
    for (int st = 0; st < 4; ++st) *(uint2*)(Pm + (16 * w + lr) * 144 + (16 * st + 4 * lg) * 2) = pv[st];
    *(uint4*)(X + d0 * 144 + r0 * 2) = make_uint4(ktp0[0], ktp0[1], ktp0[2], ktp0[3]);
    *(uint4*)(X + d0 * 144 + r0 * 2 + 16) = make_uint4(ktp0[4], ktp0[5], ktp0[6], ktp0[7]);
    *(uint4*)(X + (d0 + 1) * 144 + r0 * 2) = make_uint4(ktp1[0], ktp1[1], ktp1[2], ktp1[3]);
    *(uint4*)(X + (d0 + 1) * 144 + r0 * 2 + 16) = make_uint4(ktp1[4], ktp1[5], ktp1[6], ktp1[7]);
    __syncthreads();
    {
      bf16x8 pf[2];
#pragma unroll
      for (int ks = 0; ks < 2; ++ks) pf[ks] = *(const bf16x8*)(Pm + (16 * w + lr) * 144 + ks * 64 + lg * 16);
      bf16_t* orow = (KIND == 2 && DIR) ? hg_ob_row(p, (int)mbase + c * 64 + 16 * w + lr) + h * DV + sl * 64 + 4 * lg
                                        : Og + (size_t)(c * 64 + 16 * w + lr) * LDV + 4 * lg;
#pragma unroll
      for (int et = 0; et < 4; ++et) {
        f32x4 o = (f32x4){0.f, 0.f, 0.f, 0.f};
#pragma unroll
        for (int ks = 0; ks < 2; ++ks) {
          const bf16x8 vf = *(const bf16x8*)(Vt + (16 * et + lr) * 144 + ks * 64 + lg * 16);
          o = MFMA(vf, pf[ks], o);
        }
#pragma unroll
        for (int ks = 0; ks < 4; ++ks) {
          const bf16x8 sf = *(const bf16x8*)(StS + (16 * et + lr) * 272 + ks * 64 + lg * 16);
          o = MFMA(sf, qf[ks], o);
        }
        bf16_t* op = orow + 16 * et;
        if (KIND == 1 && DIR) {
          const uint2 old = *(const uint2*)op;
          o[0] += lo_f(old.x); o[1] += hi_f(old.x); o[2] += lo_f(old.y); o[3] += hi_f(old.y);
        }
        if (!(KIND == 1 && DIR && dry)) *(uint2*)op = make_uint2(pack2(o[0], o[1]), pack2(o[2], o[3]));
      }
    }
    {
      bf16x8 vtf[2];
#pragma unroll
      for (int ks = 0; ks < 2; ++ks) vtf[ks] = *(const bf16x8*)(Vt + (16 * w + lr) * 144 + ks * 64 + lg * 16);
#pragma unroll
      for (int dt = 0; dt < 8; ++dt) {
        const float4 bl4 = *(const float4*)(blA + 16 * dt + 4 * lg);
        S[dt][0] *= bl4.x; S[dt][1] *= bl4.y; S[dt][2] *= bl4.z; S[dt][3] *= bl4.w;
#pragma unroll
        for (int ks = 0; ks < 2; ++ks) {
          const bf16x8 kf = *(const bf16x8*)(X + (16 * dt + lr) * 144 + ks * 64 + lg * 16);
          S[dt] = MFMA(kf, vtf[ks], S[dt]);
        }
      }
    }
    __syncthreads();
  }
#undef SCAN_ISSUE
  if (!grp) {
    float* so = p.out + (KIND == 1 ? OUT_SR : OUT_SH) + ((size_t)((b * 2 + DIR) * 8 + h) * 128) * DV + sl * 64 + 16 * w + lr + (size_t)(4 * lg) * DV;
    asm volatile("" : "+v"(so));
#pragma unroll
    for (int dt = 0; dt < 8; ++dt)
#pragma unroll
      for (int r = 0; r < 4; ++r) so[(16 * dt + r) * DV] = S[dt][r];
  }
}

template <int KIND, int DIR>
__device__ __forceinline__ void scan_phase(const Params& p, unsigned char* lds, const bool dry) {
  constexpr int NSL = (KIND == 1 ? 256 : 128) / 64;
  const int ns = 64 * NSL, npr = 256 * NSL;
  const int G = VGDIM, bid = VBID;
  int it, step, end = ns + npr;
  if (G > ns) {
    if (bid < ns) { it = bid; step = end; }
    else { it = ns + (bid - ns); step = G - ns; }
  } else { it = bid; step = G; }
  for (; it < end; it += step) scan_item<KIND, DIR>(p, it, lds, dry);
}

__device__ __forceinline__ void scan_phase_hg_both(const Params& p, unsigned char* lds, const bool dry) {
  const int G = VGDIM >> 1, bid = VBID;
  const int role = bid >= G;
  const int rb = role ? bid - G : bid;
  int it, step;
  if (G > 128) {
    if (rb < 128) { it = rb; step = 1 << 20; } else { it = rb; step = G - 128; }
  } else { it = rb; step = G; }
  if (role == 0) { for (; it < 640; it += step) scan_item<2, 0>(p, it, lds, dry); }
  else           { for (; it < 640; it += step) scan_item<2, 1>(p, it, lds, dry); }
}

template <int KIND>
__device__ __forceinline__ void normgate_phase(const Params& p, const bool dry) {
  constexpr int NCH = KIND == 1 ? 4 : 2, DV = KIND == 1 ? 256 : 128, LD = KIND == 1 ? 2048 : 1024;
  const int tid = HTID, lane = tid & 63, w = tid >> 6;
  const int hh = lane >> 3, sub = lane & 7;
  bf16_t* R0 = (bf16_t*)p.ws;
  bf16_t* Ob = R0 + (KIND == 1 ? 4 * PLANE_E : 5 * PLANE_E) + hh * DV + sub * 8;
  const bf16_t* Gb = R0 + (KIND == 1 ? 0 : 4 * PLANE_E) + hh * DV + sub * 8;
  float gn[NCH][8];
#pragma unroll
  for (int j = 0; j < NCH; ++j)
#pragma unroll
    for (int i = 0; i < 8; ++i) gn[j][i] = (KIND == 1) ? 1.f : p.in[22][j * 64 + sub * 8 + i];
  for (int row = VBID * 4 + w; row < 24576; row += VGDIM * 4) {
    bf16_t* op = Ob + (size_t)row * LD;
    const bf16_t* gp = Gb + (size_t)row * LD;
    uint4 ov[NCH], gv[NCH];
#pragma unroll
    for (int j = 0; j < NCH; ++j) { ov[j] = *(const uint4*)(op + j * 64); gv[j] = *(const uint4*)(gp + j * 64); }
    if (KIND == 2) {
      const bf16_t* bp = hg_ob_row(p, row) + hh * DV + sub * 8;
#pragma unroll
      for (int j = 0; j < NCH; ++j) {
        const uint4 bv = *(const uint4*)(bp + j * 64);
        ov[j].x = pack2(lo_f(ov[j].x) + lo_f(bv.x), hi_f(ov[j].x) + hi_f(bv.x));
        ov[j].y = pack2(lo_f(ov[j].y) + lo_f(bv.y), hi_f(ov[j].y) + hi_f(bv.y));
        ov[j].z = pack2(lo_f(ov[j].z) + lo_f(bv.z), hi_f(ov[j].z) + hi_f(bv.z));
        ov[j].w = pack2(lo_f(ov[j].w) + lo_f(bv.w), hi_f(ov[j].w) + hi_f(bv.w));
      }
    }
    float ss = 0.f;
#pragma unroll
    for (int j = 0; j < NCH; ++j) {
      const unsigned wv[4] = {ov[j].x, ov[j].y, ov[j].z, ov[j].w};
#pragma unroll
      for (int i = 0; i < 4; ++i) { const float a = lo_f(wv[i]), b2 = hi_f(wv[i]); ss += a * a + b2 * b2; }
    }
    ss += __shfl_xor(ss, 1);
    ss += __shfl_xor(ss, 2);
    ss += __shfl_xor(ss, 4);
    const float rs = rsqrtf(ss * (1.f / (float)DV) + 1e-6f);
#pragma unroll
    for (int j = 0; j < NCH; ++j) {
      const unsigned wv[4] = {ov[j].x, ov[j].y, ov[j].z, ov[j].w};
      const unsigned gw[4] = {gv[j].x, gv[j].y, gv[j].z, gv[j].w};
      unsigned r[4];
#pragma unroll
      for (int i = 0; i < 4; ++i)
        r[i] = pack2(lo_f(wv[i]) * rs * gn[j][2 * i] * lo_f(gw[i]), hi_f(wv[i]) * rs * gn[j][2 * i + 1] * hi_f(gw[i]));
      if (!dry) *(uint4*)(op + j * 64) = make_uint4(r[0], r[1], r[2], r[3]);
    }
  }
}

__device__ __forceinline__ void opaque_params(Params& q) {
  asm volatile("" : "+s"(q.out), "+s"(q.ws));
#pragma unroll
  for (int i = 0; i < 23; ++i) asm volatile("" : "+s"(q.in[i]));
}

struct BarState { unsigned* base; unsigned xcd, mycnt, nact, esub, etop; };
__device__ __forceinline__ void grid_barrier(BarState& b) {
  asm volatile("s_waitcnt vmcnt(0) lgkmcnt(0)" ::: "memory");
  __syncthreads();
  if (threadIdx.x == 0) {
    b.esub += b.mycnt; b.etop += b.nact;
    __builtin_amdgcn_fence(__ATOMIC_RELEASE, "agent");
    const unsigned old = __hip_atomic_fetch_add(b.base + 64 * b.xcd, 1u, __ATOMIC_RELAXED, __HIP_MEMORY_SCOPE_AGENT);
    if (old + 1u == b.esub) __hip_atomic_fetch_add(b.base + 512, 1u, __ATOMIC_RELAXED, __HIP_MEMORY_SCOPE_AGENT);
    while (__hip_atomic_load(b.base + 512, __ATOMIC_RELAXED, __HIP_MEMORY_SCOPE_AGENT) < b.etop) __builtin_amdgcn_s_sleep(1);
    __builtin_amdgcn_fence(__ATOMIC_ACQUIRE, "agent");
  }
  __syncthreads();
}
__device__ __forceinline__ void bar_census_post(BarState& b) {
  if (threadIdx.x == 0) __hip_atomic_fetch_add(b.base + 1024 + 64 * b.xcd, 1u, __ATOMIC_RELAXED, __HIP_MEMORY_SCOPE_AGENT);
}
__device__ __forceinline__ void bar_census_read(BarState& b) {
  if (threadIdx.x == 0) {
    unsigned n = 0;
    for (unsigned j = 0; j < 8; ++j) {
      const unsigned c = __hip_atomic_load(b.base + 1024 + 64 * j, __ATOMIC_RELAXED, __HIP_MEMORY_SCOPE_AGENT);
      n += (c != 0u);
      if (j == b.xcd) b.mycnt = c;
    }
    b.nact = n;
  }
}
#define GSYNC(n) { if ((n) == 0) { grid.sync(); bar_census_read(bst); } else grid_barrier(bst); }

#if defined(PH_ONLY)
#define PHASE(n, call) if (n == PH_ONLY) { const bool dry = false; call; }
#elif defined(REP_N)
#define PHASE(n, call) if (lo <= n && n < hi) { for (int rep = (n == REP_N ? 0 : 1); rep < 2; ++rep) { const bool dry = (rep == 0); call; if (!(fin && n + 1 == hi && rep == 1)) GSYNC(n) } }
#else
#define PHASE(n, call) if (lo <= n && n < hi) { const bool dry = false; call; if (!(fin && n + 1 == hi)) GSYNC(n) }
#endif

__device__ __forceinline__ void run_range(const Params& q, int lo, int hi, bool fin, cg::grid_group& grid, unsigned char* lds) {
  unsigned char* ldh = lds + HALFID * HALF_LDS;
  BarState bst; bst.base = (unsigned*)(q.ws + OFF_MISC + MISC_CTR); bst.xcd = xcc_id(); bst.mycnt = 0; bst.nact = 0; bst.esub = 0; bst.etop = 0;
  if (lo == 0) bar_census_post(bst);
  PHASE(0, phase0(q, ldh))
  PHASE(1, post_phase(q, -1, 0, ldh, dry))
  PHASE(2, gemm_phase(q, 0, GM_IN_DA, lds, 2))
  PHASE(3, attn_phase(q, 0, lds, dry, 3))
  PHASE(4, gemm_phase(q, 0, GM_OUT, lds, 4))
  PHASE(5, post_phase(q, 0, 1, ldh, dry))
  PHASE(6, gemm_phase(q, 1, GM_IN_RET_QKV, lds, 6))
  PHASE(7, (scan_phase<1, 0>(q, ldh, dry)))
  PHASE(8, (scan_phase<1, 1>(q, ldh, dry)))
  PHASE(9, gemm_phase(q, 1, GM_IN_RET_G, lds, 9))
  PHASE(10, normgate_phase<1>(q, dry))
  PHASE(11, gemm_phase(q, 1, GM_OUT, lds, 11))
  PHASE(12, post_phase(q, 1, 2, ldh, dry))
  PHASE(13, gemm_phase(q, 2, GM_IN_HG, lds, 13))
  PHASE(14, scan_phase_hg_both(q, ldh, dry))
  PHASE(16, normgate_phase<2>(q, dry))
  PHASE(17, gemm_phase(q, 2, GM_OUT, lds, 17))
  PHASE(18, post_phase(q, 2, 3, ldh, dry))
  PHASE(19, gemm_phase(q, 3, GM_IN_DA, lds, 19))
  PHASE(20, attn_phase(q, 3, lds, dry, 20))
  PHASE(21, gemm_phase(q, 3, GM_OUT, lds, 21))
  PHASE(22, post_phase(q, 3, 4, ldh, dry))
}

__global__ void __launch_bounds__(NTHR, 2) mega_fwd(Params p) {
  extern __shared__ __attribute__((aligned(16))) unsigned char lds[];
  cg::grid_group grid = cg::this_grid();
  run_range(p, p.ph_lo, p.ph_hi, true, grid, lds);
}

extern "C" void kernel_launch(void* const* d_in, const int* in_sizes, int n_in, void* d_out, int out_size, void* d_ws, size_t ws_size, hipStream_t stream) {
  static int grid_blocks = 0;
  if (grid_blocks == 0) {
    int dev = 0, cus = 0, per_cu = 0;
    hipGetDevice(&dev);
    hipDeviceGetAttribute(&cus, hipDeviceAttributeMultiprocessorCount, dev);
    hipFuncSetAttribute((const void*)mega_fwd, hipFuncAttributeMaxDynamicSharedMemorySize, LDS_BYTES);
    hipOccupancyMaxActiveBlocksPerMultiprocessor(&per_cu, (const void*)mega_fwd, NTHR, LDS_BYTES);
    if (per_cu < 1) per_cu = 1;
    if (per_cu > 1) per_cu = 1;
    if (cus < 1) cus = 256;
    grid_blocks = cus * per_cu;
    (void)hipGetLastError();
    if (n_in != 23 || ws_size < WS_NEED) { fprintf(stderr, "kernel_launch: unexpected n_in %d / ws_size %zu (need %zu)\n", n_in, ws_size, (size_t)WS_NEED); }
  }
  hipMemsetAsync((unsigned char*)d_ws + OFF_MISC + MISC_CTR, 0, 8192, stream);
  Params p{};
  for (int i = 0; i < 23; ++i) p.in[i] = (const float*)d_in[i];
  p.out = (float*)d_out;
  p.ws = (unsigned char*)d_ws;
#if ONE_LAUNCH
  p.ph_lo = 0; p.ph_hi = NPH;
  void* args[] = {&p};
  hipError_t e = hipLaunchCooperativeKernel((const void*)mega_fwd, dim3(grid_blocks), dim3(NTHR), args, LDS_BYTES, stream);
  if (e != hipSuccess) fprintf(stderr, "cooperative launch failed: %s (grid %d)\n", hipGetErrorString(e), grid_blocks);
#else
  for (int ph = 0; ph < NPH; ++ph) {
    p.ph_lo = ph; p.ph_hi = ph + 1;
    hipLaunchKernelGGL(mega_fwd, dim3(grid_blocks), dim3(NTHR), LDS_BYTES, stream, p);
  }
#endif
}
```

```cpp
#include <hip/hip_runtime.h>
#include <hip/hip_cooperative_groups.h>
#include <cstdint>
#include <cstdio>
namespace cg = cooperative_groups;

#ifndef ONE_LAUNCH
#define ONE_LAUNCH 1
#endif

typedef unsigned short bf16_t;
typedef short bf16x8 __attribute__((ext_vector_type(8)));
typedef float f32x4 __attribute__((ext_vector_type(4)));

#define NTHR 512
#define HTID ((int)(threadIdx.x & 255))
#define HALFID ((int)(threadIdx.x >> 8))
#define VBID ((int)(blockIdx.x * 2 + (threadIdx.x >> 8)))
#define VGDIM ((int)(gridDim.x * 2))
#define HALF_LDS 74816
#define MIB ((size_t)1 << 20)
#define NPH 23
#define LDS_BYTES (2 * HALF_LDS)
#define LDS_SLOT 74752
#define MISC_CTR (MISC_ROPE + 524288)

#define OFF_WIN  (288 * MIB)
#define OFF_WOUT (300 * MIB)
#define OFF_HP   (304 * MIB)
#define OFF_MISC (320 * MIB)
#define MISC_ROPE 524288
#define WS_NEED  (322 * MIB)
#define PLANE_E  ((size_t)25165824)
#define OUT_YP 0
#define OUT_YS 8388608
#define OUT_CK 25165824
#define OUT_CV 41943040
#define OUT_SR 58720256
#define OUT_SH 75497472

struct Params {
  const float* in[23];
  float* out;
  unsigned char* ws;
  int ph_lo, ph_hi;
};

struct LayerInfo { int kind, slot, IN, WIDTH; const float* w_in; const float* w_out; };

__device__ __forceinline__ LayerInfo layer_info(const Params& p, int l) {
  LayerInfo L;
  if (l == 0)      { L.kind = 0; L.slot = 0; L.IN = 4096; L.WIDTH = 1024; L.w_in = p.in[12]; L.w_out = p.in[13]; }
  else if (l == 1) { L.kind = 1; L.slot = 0; L.IN = 6144; L.WIDTH = 2048; L.w_in = p.in[16]; L.w_out = p.in[17]; }
  else if (l == 2) { L.kind = 2; L.slot = 0; L.IN = 5120; L.WIDTH = 1024; L.w_in = p.in[19]; L.w_out = p.in[20]; }
  else             { L.kind = 0; L.slot = 1; L.IN = 4096; L.WIDTH = 1024; L.w_in = p.in[12] + (size_t)1024 * 4096; L.w_out = p.in[13] + (size_t)1024 * 1024; }
  return L;
}
__device__ __forceinline__ bf16_t* hs_ptr(const Params& p, int l) {
  return l < 3 ? (bf16_t*)(p.out + OUT_SH) : (bf16_t*)(p.ws + 240 * MIB);
}

typedef __bf16 nbf16x2 __attribute__((ext_vector_type(2)));
typedef float f32x2 __attribute__((ext_vector_type(2)));
__device__ __forceinline__ float bf2f(unsigned h) { return __uint_as_float(h << 16); }
__device__ __forceinline__ unsigned pack2(float a, float b) { const f32x2 f = {a, b}; return __builtin_bit_cast(unsigned, __builtin_convertvector(f, nbf16x2)); }
__device__ __forceinline__ float lo_f(unsigned w) { return __uint_as_float(w << 16); }
__device__ __forceinline__ float hi_f(unsigned w) { return __uint_as_float(w & 0xffff0000u); }
__device__ __forceinline__ float silu_f(float x) { return x / (1.f + __expf(-x)); }
__device__ __forceinline__ float wave_sum(float v) {
#pragma unroll
  for (int o = 32; o > 0; o >>= 1) v += __shfl_xor(v, o);
  return v;
}
#define QSCALE 0.18033688011112042f
#define SB __builtin_amdgcn_sched_barrier(0)
#define MFMA(a, b, c) __builtin_amdgcn_mfma_f32_16x16x32_bf16((a), (b), (c), 0, 0, 0)

__device__ __forceinline__ void convT_tile(const float* __restrict__ src, int src_ld, bf16_t* __restrict__ dst, int dst_ld, unsigned char* lds) {
  float* t = (float*)lds;
  const int tid = HTID;
  const int kr = tid >> 4, nc = (tid & 15) * 4;
#pragma unroll
  for (int j = 0; j < 4; ++j) {
    const float4 v = *(const float4*)(src + (size_t)(kr + 16 * j) * src_ld + nc);
    float* tp = t + (kr + 16 * j) * 65 + nc;
    tp[0] = v.x; tp[1] = v.y; tp[2] = v.z; tp[3] = v.w;
  }
  __syncthreads();
  const int n = tid >> 2, kc = (tid & 3) * 16;
  unsigned w[8];
#pragma unroll
  for (int i = 0; i < 8; ++i) w[i] = pack2(t[(kc + 2 * i) * 65 + n], t[(kc + 2 * i + 1) * 65 + n]);
  uint4* d = (uint4*)(dst + (size_t)n * dst_ld + kc);
  d[0] = make_uint4(w[0], w[1], w[2], w[3]);
  d[1] = make_uint4(w[4], w[5], w[6], w[7]);
  __syncthreads();
}

__device__ __forceinline__ int conv_weights_count(const Params& p, int l) {
  const LayerInfo L = layer_info(p, l);
  return (L.IN / 64) * 16 + (L.WIDTH / 64) * 16;
}
__device__ __forceinline__ void conv_weights_item(const Params& p, int l, int it, unsigned char* lds) {
  const LayerInfo L = layer_info(p, l);
  const int nin = (L.IN / 64) * 16;
  if (it < nin) {
    const int kt = it & 15, nt = it >> 4;
    convT_tile(L.w_in + (size_t)(kt * 64) * L.IN + nt * 64, L.IN, (bf16_t*)(p.ws + OFF_WIN) + (size_t)(nt * 64) * 1024 + kt * 64, 1024, lds);
  } else {
    const int it2 = it - nin, nkt = L.WIDTH / 64;
    const int kt = it2 % nkt, nt = it2 / nkt;
    convT_tile(L.w_out + (size_t)(kt * 64) * 1024 + nt * 64, 1024, (bf16_t*)(p.ws + OFF_WOUT) + (size_t)(nt * 64) * L.WIDTH + kt * 64, L.WIDTH, lds);
  }
}

__device__ __forceinline__ void mod_item(const Params& p, int it, unsigned char* lds) {
  float* ssilu = (float*)lds;
  float* red = ssilu + 9 * 1024;
  const int tid = HTID;
  const int l = it / 48, col0 = (it % 48) * 64;
  for (int i = tid; i < 9 * 1024; i += 256) {
    const int v = i >> 10, k = i & 1023;
    const float x = (v == 0) ? p.in[7][k] : p.in[6][(v - 1) * 1024 + k];
    ssilu[i] = silu_f(x);
  }
  __syncthreads();
  const int col = tid & 63, kq = tid >> 6;
  const float* w = p.in[8] + (size_t)l * 1024 * 3072 + col0 + col;
  float acc[9];
#pragma unroll
  for (int v = 0; v < 9; ++v) acc[v] = 0.f;
  for (int k = kq * 256; k < kq * 256 + 256; ++k) {
    const float wv = w[(size_t)k * 3072];
#pragma unroll
    for (int v = 0; v < 9; ++v) acc[v] += ssilu[v * 1024 + k] * wv;
  }
#pragma unroll
  for (int v = 0; v < 9; ++v) red[(kq * 9 + v) * 64 + col] = acc[v];
  __syncthreads();
  float* mod = (float*)(p.ws + OFF_MISC);
  for (int i = tid; i < 9 * 64; i += 256) {
    const int v = i >> 6, cc = i & 63;
    const float s = red[(0 * 9 + v) * 64 + cc] + red[(1 * 9 + v) * 64 + cc] + red[(2 * 9 + v) * 64 + cc] + red[(3 * 9 + v) * 64 + cc];
    mod[(size_t)(l * 9 + v) * 3072 + col0 + cc] = s + p.in[9][l * 3072 + col0 + cc];
  }
  __syncthreads();
}

__device__ __forceinline__ void rope_item(const Params& p, int it) {
  const int idx = it * 256 + HTID;
  const int t = idx >> 5, pp = idx & 31;
  const int pos = pp < 16 ? (t >> 6) : (t & 63);
  const float inv = exp2f(-(float)(pp & 15) * (13.287712379549449f / 16.f));
  const float ang = (float)pos * inv;
  const double a = (double)ang;
  const double r = a - 6.283185307179586 * rint(a * 0.15915494309189535);
  const float rf = (float)r;
  float2* tab = (float2*)(p.ws + OFF_MISC + MISC_ROPE);
  tab[idx] = make_float2(__cosf(rf), __sinf(rf));
}

__device__ __forceinline__ void phase0(const Params& p, unsigned char* lds) {
  const int nw = conv_weights_count(p, 0);
  const int total = 192 + 256 + nw;
  for (int it = VBID; it < total; it += VGDIM) {
    if (it < 192) mod_item(p, it, lds);
    else if (it < 448) rope_item(p, it - 192);
    else conv_weights_item(p, 0, it - 448, lds);
  }
}

__device__ __forceinline__ void post_phase(const Params& p, int lprev, int lnext, unsigned char* lds, const bool dry) {
  const int tid = HTID, lane = tid & 63, w = tid >> 6;
  const float* mod = (const float*)(p.ws + OFF_MISC);
  const bf16_t* Y = nullptr;
  if (lprev >= 0) {
    const int kind = layer_info(p, lprev).kind;
    Y = (const bf16_t*)(p.ws + (kind == 1 ? 96 * MIB : 0));
  }
  bf16_t* hp = (bf16_t*)(p.ws + OFF_HP);
  bf16_t* hs = lnext < 4 ? hs_ptr(p, lnext) : nullptr;
  for (int row = VBID * 4 + w; row < 24576; row += VGDIM * 4) {
    const int mv = row < 8192 ? 0 : 1 + ((row - 8192) >> 11);
    const float* xs = (lprev <= 0) ? (row < 8192 ? p.in[0] + (size_t)row * 1024 : p.in[1] + (size_t)(row - 8192) * 1024) : p.out + (size_t)row * 1024;
    float4 x[4];
#pragma unroll
    for (int j = 0; j < 4; ++j) x[j] = *(const float4*)(xs + lane * 4 + 256 * j);
    if (lprev >= 0) {
      float4 y[4];
      float ss = 0.f;
#pragma unroll
      for (int j = 0; j < 4; ++j) { const uint2 yw = *(const uint2*)(Y + (size_t)row * 1024 + lane * 4 + 256 * j); y[j] = make_float4(lo_f(yw.x), hi_f(yw.x), lo_f(yw.y), hi_f(yw.y)); ss += y[j].x * y[j].x + y[j].y * y[j].y + y[j].z * y[j].z + y[j].w * y[j].w; }
      ss = wave_sum(ss);
      const float rstd = rsqrtf(ss * (1.f / 1024.f) + 1e-6f);
      const float* ga = mod + (size_t)(lprev * 9 + mv) * 3072 + 2048;
      const float* gp = p.in[11] + lprev * 1024;
#pragma unroll
      for (int j = 0; j < 4; ++j) {
        const int c = lane * 4 + 256 * j;
        const float4 g4 = *(const float4*)(ga + c), p4 = *(const float4*)(gp + c);
        x[j].x += g4.x * (y[j].x * rstd * p4.x); x[j].y += g4.y * (y[j].y * rstd * p4.y);
        x[j].z += g4.z * (y[j].z * rstd * p4.z); x[j].w += g4.w * (y[j].w * rstd * p4.w);
        if (!dry) *(float4*)(p.out + (size_t)row * 1024 + c) = x[j];
      }
    }
    if (lnext < 4) {
      float ss = 0.f;
#pragma unroll
      for (int j = 0; j < 4; ++j) ss += x[j].x * x[j].x + x[j].y * x[j].y + x[j].z * x[j].z + x[j].w * x[j].w;
      ss = wave_sum(ss);
      const float rstd = rsqrtf(ss * (1.f / 1024.f) + 1e-6f);
      const float* sh = mod + (size_t)(lnext * 9 + mv) * 3072;
      const float* sc = sh + 1024;
      const float* gp = p.in[10] + lnext * 1024;
      bf16_t* hd = row < 8192 ? hp + (size_t)row * 1024 : hs + (size_t)(row - 8192) * 1024;
#pragma unroll
      for (int j = 0; j < 4; ++j) {
        const int c = lane * 4 + 256 * j;
        const float4 s4 = *(const float4*)(sh + c), c4 = *(const float4*)(sc + c), p4 = *(const float4*)(gp + c);
        const float h0 = x[j].x * rstd * p4.x * (1.f + c4.x) + s4.x, h1 = x[j].y * rstd * p4.y * (1.f + c4.y) + s4.y;
        const float h2 = x[j].z * rstd * p4.z * (1.f + c4.z) + s4.z, h3 = x[j].w * rstd * p4.w * (1.f + c4.w) + s4.w;
        *(uint2*)(hd + c) = make_uint2(pack2(h0, h1), pack2(h2, h3));
      }
    }
  }
  if (lprev >= 0 && lnext < 4) {
    const int nw = conv_weights_count(p, lnext);
    for (int it = VBID; it < nw; it += VGDIM) conv_weights_item(p, lnext, it, lds);
  }
}


__device__ __forceinline__ unsigned xcc_id() { return (unsigned)__builtin_amdgcn_s_getreg((3 << 11) | 20) & 7u; }
__device__ __forceinline__ bool wq_next(unsigned* ctr, int nst, int mult, unsigned xcd, int& qstate, int& q, int& idx, unsigned char* lds) {
  volatile int* slot = (volatile int*)(lds + LDS_SLOT);
  __syncthreads();
  if (HTID == 0) {
    int qq = -1, ii = 0, st = qstate;
    while (st < 8) {
      const int cand = (int)((xcd + (unsigned)st) & 7u);
      const int got = (int)atomicAdd(ctr + cand, 1u);
      if (got < mult * ((nst - cand + 7) >> 3)) { qq = cand; ii = got; break; }
      ++st;
    }
    slot[0] = qq; slot[1] = ii; slot[2] = st;
  }
  __syncthreads();
  q = slot[0]; idx = slot[1]; qstate = slot[2];
  return q >= 0;
}

#define LAS __attribute__((address_space(3)))
template <bool SWAP>
__device__ __forceinline__ void gemm_tile_compute(const bf16_t* __restrict__ Ag, const bf16_t* __restrict__ Bg, int K, unsigned char* lds, f32x4 (&acc)[8][4],
                                                  const bool pre, const bf16_t* __restrict__ An, const bf16_t* __restrict__ Bn, const bool hasn) {
  const int tid = threadIdx.x, lane = tid & 63, wid = __builtin_amdgcn_readfirstlane(tid >> 6), wm = wid >> 2, wn = wid & 3;
  const int lr = lane & 15, lg = lane >> 4;
  LAS unsigned char* l3 = (LAS unsigned char*)lds;
  const int prow = lane >> 3;
  const int pgo0 = prow * K + (((lane & 7) ^ ((prow >> 1) & 7)) << 3);
  const int pgo1 = prow * K + (((lane & 7) ^ ((4 + (prow >> 1)) & 7)) << 3);
  const bf16_t* asrc = Ag + (size_t)(wid * 32) * K;
  const bf16_t* bsrc = Bg + (size_t)(wid * 32) * K;
  const size_t pstep = (size_t)8 * K;
#pragma unroll
  for (int mi = 0; mi < 8; ++mi)
#pragma unroll
    for (int ni = 0; ni < 4; ++ni) acc[mi][ni] = (f32x4){0.f, 0.f, 0.f, 0.f};
#define GEMM_STAGE_P(ap_, bp_, s, k0)                                                                                                      \
  {                                                                                                                                        \
    _Pragma("unroll") for (int j = 0; j < 4; ++j) {                                                                                        \
      __builtin_amdgcn_global_load_lds((const unsigned*)((ap_) + j * pstep + ((j & 1) ? pgo1 : pgo0) + (k0)), (LAS unsigned*)(l3 + (s) * 65536 + (wid * 4 + j) * 1024), 16, 0, 0);          \
      __builtin_amdgcn_global_load_lds((const unsigned*)((bp_) + j * pstep + ((j & 1) ? pgo1 : pgo0) + (k0)), (LAS unsigned*)(l3 + (s) * 65536 + 32768 + (wid * 4 + j) * 1024), 16, 0, 0);  \
    }                                                                                                                                      \
  }
#define GEMM_STAGE(s, k0) GEMM_STAGE_P(asrc, bsrc, s, k0)
  const int nk = K >> 6;
  if (!pre) GEMM_STAGE(0, 0);
  asm volatile("s_waitcnt vmcnt(0)" ::: "memory");
  __syncthreads();
  const int x0 = lg ^ ((lr >> 1) & 7);
  const int aoff0 = (wm * 128 + lr) * 128 + x0 * 16, aoff1 = (wm * 128 + lr) * 128 + (x0 ^ 4) * 16;
  const int boff0 = 32768 + (wn * 64 + lr) * 128 + x0 * 16, boff1 = 32768 + (wn * 64 + lr) * 128 + (x0 ^ 4) * 16;
  for (int kt = 0; kt < nk; ++kt) {
    if (kt + 1 < nk) GEMM_STAGE((kt + 1) & 1, (kt + 1) * 64);
    const unsigned char* st = lds + (kt & 1) * 65536;
#pragma unroll
    for (int kk = 0; kk < 2; ++kk) {
      bf16x8 af[8], bfr[4];
#pragma unroll
      for (int ni = 0; ni < 4; ++ni) bfr[ni] = *(const bf16x8*)(st + (kk ? boff1 : boff0) + ni * 2048);
#pragma unroll
      for (int mi = 0; mi < 8; ++mi) af[mi] = *(const bf16x8*)(st + (kk ? aoff1 : aoff0) + mi * 2048);
#pragma unroll
      for (int mi = 0; mi < 8; ++mi)
#pragma unroll
        for (int ni = 0; ni < 4; ++ni)
          acc[mi][ni] = SWAP ? MFMA(bfr[ni], af[mi], acc[mi][ni]) : MFMA(af[mi], bfr[ni], acc[mi][ni]);
    }
    asm volatile("s_waitcnt vmcnt(0)" ::: "memory");
    __syncthreads();
  }
  if (hasn) { const bf16_t* an_ = An + (size_t)(wid * 32) * K; const bf16_t* bn_ = Bn + (size_t)(wid * 32) * K; GEMM_STAGE_P(an_, bn_, 0, 0); }
#undef GEMM_STAGE
#undef GEMM_STAGE_P
}

enum { GM_IN_DA = 0, GM_IN_RET_QKV = 1, GM_IN_RET_G = 2, GM_IN_HG = 3, GM_OUT = 4 };

__device__ __forceinline__ void epi_swapped(const Params& p, int mode, int slot, int ykind, int m, int n, f32x4 v) {
  bf16_t* R0 = (bf16_t*)p.ws;
  if (mode == GM_OUT) {
    bf16_t* Y = (bf16_t*)(p.ws + (ykind == 1 ? 96 * MIB : 0));
    *(uint2*)(Y + (size_t)m * 1024 + n) = make_uint2(pack2(v[0], v[1]), pack2(v[2], v[3]));
  } else if (mode == GM_IN_DA) {
    const bool smp = m >= 8192;
    const int ms = m - 8192;
    const int b = smp ? (ms >> 11) : (m >> 8), t = smp ? (ms & 2047) : (m & 255);
    if (n < 2048) {
      if (smp) {
        const float4 cs = *(const float4*)((const float*)(p.ws + OFF_MISC + MISC_ROPE) + (size_t)(t * 32 + ((n & 63) >> 1)) * 2);
        const float a0 = v[0] * cs.x - v[1] * cs.y, a1 = v[0] * cs.y + v[1] * cs.x;
        const float a2 = v[2] * cs.z - v[3] * cs.w, a3 = v[2] * cs.w + v[3] * cs.z;
        v = (f32x4){a0, a1, a2, a3};
      }
      if (n < 1024) {
        *(uint2*)(R0 + (size_t)m * 1024 + n) = make_uint2(pack2(v[0] * QSCALE, v[1] * QSCALE), pack2(v[2] * QSCALE, v[3] * QSCALE));
      } else {
        const int c = n - 1024;
        const uint2 pk = make_uint2(pack2(v[0], v[1]), pack2(v[2], v[3]));
        if (smp) {
          *(uint2*)(R0 + 64 * MIB / 2 + ((size_t)b * 2560 + t) * 1024 + c) = pk;
        } else {
          *(f32x4*)(p.out + OUT_CK + ((size_t)((b * 2 + slot) * 256 + t)) * 1024 + c) = v;
          *(uint2*)(R0 + 48 * MIB / 2 + (size_t)m * 1024 + c) = pk;
        }
      }
    } else {
      *(uint2*)(R0 + 160 * MIB / 2 + (size_t)m * 1024 + (n - 3072)) = make_uint2(pack2(silu_f(v[0]), silu_f(v[1])), pack2(silu_f(v[2]), silu_f(v[3])));
    }
  } else if (mode == GM_IN_RET_QKV) {
    if (n < 1024) *(uint2*)(R0 + (size_t)m * 1024 + n) = make_uint2(pack2(v[0], v[1]), pack2(v[2], v[3]));
    else if (n < 2048) { const float s = 0.08838834764831845f; *(uint2*)(R0 + PLANE_E + (size_t)m * 1024 + (n - 1024)) = make_uint2(pack2(v[0] * s, v[1] * s), pack2(v[2] * s, v[3] * s)); }
    else *(uint2*)(R0 + 2 * PLANE_E + (size_t)m * 2048 + (n - 2048)) = make_uint2(pack2(v[0], v[1]), pack2(v[2], v[3]));
  } else if (mode == GM_IN_RET_G) {
    *(uint2*)(R0 + (size_t)m * 2048 + n) = make_uint2(pack2(silu_f(v[0]), silu_f(v[1])), pack2(silu_f(v[2]), silu_f(v[3])));
  } else {
    if (n < 1024 || n >= 4096) v = (f32x4){silu_f(v[0]), silu_f(v[1]), silu_f(v[2]), silu_f(v[3])};
    *(uint2*)(R0 + (size_t)(n >> 10) * PLANE_E + (size_t)m * 1024 + (n & 1023)) = make_uint2(pack2(v[0], v[1]), pack2(v[2], v[3]));
  }
}

__device__ __forceinline__ void epi_da_v(const Params& p, int slot, int m, int n, f32x4 v) {
  bf16_t* R0 = (bf16_t*)p.ws;
  const int c = n - 2048, hh = c >> 7, e = c & 127;
  const uint2 pk = make_uint2(pack2(v[0], v[1]), pack2(v[2], v[3]));
  if (m >= 8192) {
    const int ms = m - 8192, b = ms >> 11, t = ms & 2047;
    *(uint2*)(R0 + 120 * MIB / 2 + ((size_t)((b * 8 + hh) * 128 + e)) * 2560 + t) = pk;
  } else {
    const int b = m >> 8, t = m & 255;
    float* o = p.out + OUT_CV + ((size_t)((b * 2 + slot) * 256 + t)) * 1024 + c;
    o[0] = v[0]; o[1024] = v[1]; o[2048] = v[2]; o[3072] = v[3];
    *(uint2*)(R0 + 104 * MIB / 2 + ((size_t)((b * 8 + hh) * 128 + e)) * 256 + t) = pk;
  }
}

__device__ __forceinline__ void gemm_phase(const Params& p, int l, int mode, unsigned char* lds, int phid) {
  const LayerInfo L = layer_info(p, l);
  bf16_t* R0 = (bf16_t*)p.ws;
  const bf16_t *Ap, *As, *Bt;
  int K, N;
  if (mode == GM_OUT) {
    K = L.WIDTH; N = 1024; Bt = (const bf16_t*)(p.ws + OFF_WOUT);
    const bf16_t* base = R0 + (L.kind == 0 ? 160 * MIB / 2 : (L.kind == 1 ? 4 * PLANE_E : 5 * PLANE_E));
    Ap = base; As = base + (size_t)8192 * K;
  } else {
    K = 1024; Ap = (const bf16_t*)(p.ws + OFF_HP); As = hs_ptr(p, l);
    Bt = (const bf16_t*)(p.ws + OFF_WIN) + (mode == GM_IN_RET_G ? (size_t)4096 * 1024 : 0);
    N = (mode == GM_IN_DA || mode == GM_IN_RET_QKV) ? 4096 : (mode == GM_IN_RET_G ? 2048 : 5120);
  }
  const int ntn = N >> 8, ntiles = 96 * ntn;
  const int extra = (mode == GM_IN_DA) ? 3072 : 0;
  const int tid = threadIdx.x, lane = tid & 63, wid = tid >> 6, wm = wid >> 2, wn = wid & 3, lr = lane & 15, lg = lane >> 4;
  const int G = gridDim.x;
  const bool swz = (G & 7) == 0;
  const int xcd = blockIdx.x & 7, snn = ntn >> 2, nst = 12 * snn;
  const int q0 = swz ? (int)(blockIdx.x >> 3) : (int)blockIdx.x, qstep = swz ? (G >> 3) : G;
  const int qlen = swz ? 32 * ((nst - xcd + 7) >> 3) : ntiles;
#define GEMM_TILE_OF(qq, m0_, n0_)                                                   \
  {                                                                                    \
    int it_ = (qq);                                                                    \
    if (swz) {                                                                         \
      const int st_ = xcd + 8 * ((qq) >> 5), tin_ = (qq) & 31;                         \
      const int smt_ = st_ / snn, snt_ = st_ - smt_ * snn;                             \
      it_ = (smt_ * 8 + (tin_ >> 2)) * ntn + snt_ * 4 + (tin_ & 3);                    \
    }                                                                                  \
    const int mt_ = it_ / ntn;                                                         \
    m0_ = mt_ * 256; n0_ = (it_ - mt_ * ntn) * 256;                                    \
  }
  bool pre = false;
  for (int q = q0; q < qlen; q += qstep) {
    int m0, n0;
    GEMM_TILE_OF(q, m0, n0)
    const bf16_t* A = m0 < 8192 ? Ap + (size_t)m0 * K : As + (size_t)(m0 - 8192) * K;
    const bf16_t* B = Bt + (size_t)n0 * K;
    const bool hasn = q + qstep < qlen;
    const bf16_t *An = A, *Bn = B;
    if (hasn) {
      int m1, n1;
      GEMM_TILE_OF(q + qstep, m1, n1)
      An = m1 < 8192 ? Ap + (size_t)m1 * K : As + (size_t)(m1 - 8192) * K;
      Bn = Bt + (size_t)n1 * K;
    }
    {
      f32x4 acc[8][4];
      if (mode == GM_IN_DA && n0 >= 2048 && n0 < 3072) {
        gemm_tile_compute<false>(A, B, K, lds, acc, pre, An, Bn, hasn);
#pragma unroll
        for (int mi = 0; mi < 8; ++mi)
#pragma unroll
          for (int ni = 0; ni < 4; ++ni)
            epi_da_v(p, L.slot, m0 + wm * 128 + mi * 16 + 4 * lg, n0 + wn * 64 + ni * 16 + lr, acc[mi][ni]);
      } else {
        gemm_tile_compute<true>(A, B, K, lds, acc, pre, An, Bn, hasn);
#pragma unroll
        for (int mi = 0; mi < 8; ++mi)
#pragma unroll
          for (int ni = 0; ni < 4; ++ni)
            epi_swapped(p, mode, L.slot, L.kind, m0 + wm * 128 + mi * 16 + lr, n0 + wn * 64 + ni * 16 + 4 * lg, acc[mi][ni]);
      }
    }
    pre = hasn;
  }
#undef GEMM_TILE_OF
  if (extra) { asm volatile("s_waitcnt vmcnt(0)" ::: "memory"); __syncthreads(); }
  for (int ci = VBID; ci < extra; ci += VGDIM) {
    {
      if (ci < 2048) {
        const int idx = (ci * 256 + HTID) * 8;
        const int b = idx >> 19, rem = idx & 524287, tp = rem >> 10, c = rem & 1023;
        const float* src = p.in[2] + ((size_t)((b * 2 + L.slot) * 512 + tp)) * 1024 + c;
        const float4 u0 = *(const float4*)src, u1 = *(const float4*)(src + 4);
        *(uint4*)(R0 + 64 * MIB / 2 + ((size_t)b * 2560 + 2048 + tp) * 1024 + c) = make_uint4(pack2(u0.x, u0.y), pack2(u0.z, u0.w), pack2(u1.x, u1.y), pack2(u1.z, u1.w));
      } else {
        const int i2 = ci - 2048;
        const int b = i2 >> 7, hh = (i2 >> 4) & 7, tt = (i2 >> 1) & 7, et = i2 & 1;
        convT_tile(p.in[3] + ((size_t)((b * 2 + L.slot) * 512 + tt * 64)) * 1024 + hh * 128 + et * 64, 1024,
                   R0 + 120 * MIB / 2 + ((size_t)((b * 8 + hh) * 128 + et * 64)) * 2560 + 2048 + tt * 64, 2560, lds + HALFID * HALF_LDS);
      }
    }
  }
}

__device__ __forceinline__ void attn_phase(const Params& p, int l, unsigned char* lds, const bool dry, int phid) {
  const int slot = l == 3 ? 1 : 0;
  const float lam_init = 0.8f - 0.6f * expf(-0.3f * (float)l);
  const int tid = threadIdx.x, lane = tid & 63, w = tid >> 6, lr = lane & 15, lg = lane >> 4;
  float lam;
  {
    const float* lf = p.in[14] + slot * 256;
    const float a = wave_sum(lf[lane] * lf[64 + lane]);
    const float b2 = wave_sum(lf[128 + lane] * lf[192 + lane]);
    lam = expf(a) - expf(b2) + lam_init;
  }
  bf16_t* R0 = (bf16_t*)p.ws;
  const float* subg = p.in[15] + slot * 128;
  for (int item = blockIdx.x; item < 1536; item += gridDim.x) {
    int grp, b, h, qt;
    if (item < 1024) { grp = 1; b = item >> 7; h = (item >> 4) & 7; qt = item & 15; }
    else { const int i2 = item - 1024; grp = 0; b = i2 >> 4; h = (i2 >> 1) & 7; qt = i2 & 1; }
    const int nkeys = grp ? 2560 : 256, ntile = nkeys >> 6;
    const int mq = (grp ? 8192 + b * 2048 : b * 256) + qt * 128 + w * 16 + lr;
    const bf16_t* Kg = grp ? R0 + 64 * MIB / 2 + (size_t)b * 2560 * 1024 + h * 128 : R0 + 48 * MIB / 2 + (size_t)b * 256 * 1024 + h * 128;
    const bf16_t* Vg = grp ? R0 + 120 * MIB / 2 + (size_t)(b * 8 + h) * 128 * 2560 : R0 + 104 * MIB / 2 + (size_t)(b * 8 + h) * 128 * 256;
    bf16x8 qf[2][2];
#pragma unroll
    for (int sub = 0; sub < 2; ++sub)
#pragma unroll
      for (int ks = 0; ks < 2; ++ks) qf[sub][ks] = *(const bf16x8*)(R0 + (size_t)mq * 1024 + h * 128 + sub * 64 + ks * 32 + lg * 8);
    LAS unsigned char* l3 = (LAS unsigned char*)lds;
    const int wu = __builtin_amdgcn_readfirstlane(w);
    int koff[2], voff[2];
#pragma unroll
    for (int j = 0; j < 2; ++j) {
      const int kr = (wu * 2 + j) * 4 + (lane >> 4);
      koff[j] = kr * 1024 + (((lane & 15) ^ (kr & 15)) << 3);
      const int er = (wu * 2 + j) * 8 + (lane >> 3);
      voff[j] = er * nkeys + (((lane & 7) ^ ((er >> 1) & 7)) << 3);
    }
#define ATT_STAGE_K(s, key0)                                                                                  \
  {                                                                                                           \
    _Pragma("unroll") for (int j = 0; j < 2; ++j)                                                             \
      __builtin_amdgcn_global_load_lds((const unsigned*)(Kg + (size_t)(key0) * 1024 + koff[j]), (LAS unsigned*)(l3 + (s) * 32768 + (wu * 2 + j) * 1024), 16, 0, 0); \
  }
#define ATT_STAGE_V(s, key0)                                                                                  \
  {                                                                                                           \
    _Pragma("unroll") for (int j = 0; j < 2; ++j)                                                             \
      __builtin_amdgcn_global_load_lds((const unsigned*)(Vg + (key0) + voff[j]), (LAS unsigned*)(l3 + (s) * 32768 + 16384 + (wu * 2 + j) * 1024), 16, 0, 0); \
  }
    const int xl = lg ^ lr;
    const int vsw = (lr >> 1) & 7;
    const int vlo = lr * 128 + ((((lg >> 1)) ^ vsw) << 4) + (lg & 1) * 8;
    float mx[2] = {-1e30f, -1e30f}, ls[2] = {0.f, 0.f};
    f32x4 o0[8], o1[8];
#pragma unroll
    for (int et = 0; et < 8; ++et) { o0[et] = (f32x4){0.f, 0.f, 0.f, 0.f}; o1[et] = (f32x4){0.f, 0.f, 0.f, 0.f}; }
    ATT_STAGE_K(0, 0);
    ATT_STAGE_V(0, 0);
    asm volatile("s_waitcnt vmcnt(0)" ::: "memory");
    __syncthreads();
    for (int kt = 0; kt < ntile; ++kt) {
      if (kt + 1 < ntile) { ATT_STAGE_K((kt + 1) & 1, (kt + 1) * 64); ATT_STAGE_V((kt + 1) & 1, (kt + 1) * 64); }
      const unsigned char* ks_ = lds + (kt & 1) * 32768 + lr * 256;
      const unsigned char* vs_ = lds + (kt & 1) * 32768 + 16384;
#pragma unroll
      for (int k2 = 0; k2 < 2; ++k2) {
        bf16x8 kfr[8];
        uint2 vlo_[8], vhi_[8];
#pragma unroll
        for (int sub = 0; sub < 2; ++sub)
#pragma unroll
          for (int nn = 0; nn < 2; ++nn)
#pragma unroll
            for (int ks = 0; ks < 2; ++ks)
              kfr[sub * 4 + nn * 2 + ks] = *(const bf16x8*)(ks_ + (2 * k2 + nn) * 4096 + ((xl ^ (sub * 8 + ks * 4)) << 4));
#pragma unroll
        for (int et = 0; et < 8; ++et) {
          vlo_[et] = *(const uint2*)(vs_ + et * 2048 + (vlo ^ (k2 << 6)));
          vhi_[et] = *(const uint2*)(vs_ + et * 2048 + (vlo ^ (k2 << 6) ^ 32));
        }
        SB;
        f32x4 s[2][2];
#pragma unroll
        for (int sub = 0; sub < 2; ++sub)
#pragma unroll
          for (int nn = 0; nn < 2; ++nn) {
            s[sub][nn] = MFMA(kfr[sub * 4 + nn * 2], qf[sub][0], ((f32x4){0.f, 0.f, 0.f, 0.f}));
            s[sub][nn] = MFMA(kfr[sub * 4 + nn * 2 + 1], qf[sub][1], s[sub][nn]);
          }
        SB;
        bf16x8 pf[2];
        float tmx[2];
#pragma unroll
        for (int sub = 0; sub < 2; ++sub) {
          float tm = fmaxf(fmaxf(fmaxf(s[sub][0][0], s[sub][0][1]), fmaxf(s[sub][0][2], s[sub][0][3])), fmaxf(fmaxf(s[sub][1][0], s[sub][1][1]), fmaxf(s[sub][1][2], s[sub][1][3])));
          tm = fmaxf(tm, __shfl_xor(tm, 16));
          tm = fmaxf(tm, __shfl_xor(tm, 32));
          tmx[sub] = tm;
        }
        if (__any((tmx[0] > mx[0] + 8.f) || (tmx[1] > mx[1] + 8.f))) {
#pragma unroll
          for (int sub = 0; sub < 2; ++sub) {
            const float mn = (tmx[sub] > mx[sub] + 8.f) ? tmx[sub] : mx[sub];
            const float sc = __builtin_amdgcn_exp2f(mx[sub] - mn);
            mx[sub] = mn;
            ls[sub] *= sc;
#pragma unroll
            for (int et = 0; et < 8; ++et) {
              if (sub == 0) { o0[et][0] *= sc; o0[et][1] *= sc; o0[et][2] *= sc; o0[et][3] *= sc; }
              else { o1[et][0] *= sc; o1[et][1] *= sc; o1[et][2] *= sc; o1[et][3] *= sc; }
            }
          }
        }
#pragma unroll
        for (int sub = 0; sub < 2; ++sub) {
          unsigned pw[4];
          float acc = 0.f;
#pragma unroll
          for (int nn = 0; nn < 2; ++nn) {
            float a[4];
#pragma unroll
            for (int r = 0; r < 4; ++r) { a[r] = __builtin_amdgcn_exp2f(s[sub][nn][r] - mx[sub]); acc += a[r]; }
            pw[nn * 2] = pack2(a[0], a[1]);
            pw[nn * 2 + 1] = pack2(a[2], a[3]);
          }
          ls[sub] += acc;
          union { unsigned u[4]; bf16x8 v; } cp;
          cp.u[0] = pw[0]; cp.u[1] = pw[1]; cp.u[2] = pw[2]; cp.u[3] = pw[3];
          pf[sub] = cp.v;
        }
        SB;
#pragma unroll
        for (int et = 0; et < 8; ++et) {
          union { unsigned u[4]; bf16x8 v; } cv;
          cv.u[0] = vlo_[et].x; cv.u[1] = vlo_[et].y; cv.u[2] = vhi_[et].x; cv.u[3] = vhi_[et].y;
          o0[et] = MFMA(cv.v, pf[0], o0[et]);
          o1[et] = MFMA(cv.v, pf[1], o1[et]);
        }
        SB;
      }
      asm volatile("s_waitcnt vmcnt(0)" ::: "memory");
      __syncthreads();
    }
    f32x4 o[8];
    {
      float t0 = ls[0], t1 = ls[1];
      t0 += __shfl_xor(t0, 16); t0 += __shfl_xor(t0, 32);
      t1 += __shfl_xor(t1, 16); t1 += __shfl_xor(t1, 32);
      const float c1 = 1.f / t0, c2 = lam / t1;
#pragma unroll
      for (int et = 0; et < 8; ++et)
#pragma unroll
        for (int r = 0; r < 4; ++r) o[et][r] = o0[et][r] * c1 - o1[et][r] * c2;
    }
#undef ATT_STAGE_K
#undef ATT_STAGE_V
    float ss = 0.f;
#pragma unroll
    for (int et = 0; et < 8; ++et)
#pragma unroll
      for (int r = 0; r < 4; ++r) ss += o[et][r] * o[et][r];
    ss += __shfl_xor(ss, 16);
    ss += __shfl_xor(ss, 32);
    const float rs = rsqrtf(ss * (1.f / 128.f) + 1e-6f) * (1.f - lam_init);
    bf16_t* gp = R0 + 160 * MIB / 2 + (size_t)mq * 1024 + h * 128;
#pragma unroll
    for (int et = 0; et < 8; ++et) {
      const int e0 = 16 * et + 4 * lg;
      const uint2 g = *(const uint2*)(gp + e0);
      const float4 sg = *(const float4*)(subg + e0);
      const float v0 = o[et][0] * rs * sg.x * lo_f(g.x), v1 = o[et][1] * rs * sg.y * hi_f(g.x);
      const float v2 = o[et][2] * rs * sg.z * lo_f(g.y), v3 = o[et][3] * rs * sg.w * hi_f(g.y);
      if (!dry) *(uint2*)(gp + e0) = make_uint2(pack2(v0, v1), pack2(v2, v3));
    }
  }
}

__device__ __forceinline__ bf16_t* hg_ob_row(const Params& p, int m) {
  const int c = m >> 9;
  float* base = c < 32 ? p.out + OUT_CK + (size_t)(c * 2 + 1) * 262144 : p.out + OUT_CV + (size_t)((c - 32) * 2 + 1) * 262144;
  return (bf16_t*)base + (size_t)(m & 511) * 1024;
}

__device__ __forceinline__ bf16_t* ret_ob_row(const Params& p, int ms) {
  const int c = ms >> 8;
  float* base = c < 32 ? p.out + OUT_CK + (size_t)(c * 2 + 1) * 262144 : p.out + OUT_CV + (size_t)((c - 32) * 2 + 1) * 262144;
  return (bf16_t*)base + (size_t)(ms & 255) * 2048;
}

template <int KIND, int DIR>
__device__ __forceinline__ void scan_item(const Params& p, int item, unsigned char* lds, const bool dry) {
  constexpr int DV = KIND == 1 ? 256 : 128, NSL = DV / 64, LDV = KIND == 1 ? 2048 : 1024;
  const int tid = HTID, lane = tid & 63, w = tid >> 6, lr = lane & 15, lg = lane >> 4;
  int grp, b, h, sl;
  {
    int it = item;
    if (it < 64 * NSL) grp = 1; else { grp = 0; it -= 64 * NSL; }
    sl = it % NSL; h = (it / NSL) & 7; b = it / (NSL * 8);
  }
  const int T = grp ? 2048 : 256, nch = T >> 6;
  const size_t mbase = grp ? (size_t)8192 + (size_t)b * 2048 : (size_t)b * 256;
  bf16_t* R0 = (bf16_t*)p.ws;
  const bf16_t* Qg = R0 + mbase * 1024 + h * 128;
  const bf16_t* Kg = R0 + (KIND == 1 ? PLANE_E : (DIR ? 2 * PLANE_E : PLANE_E)) + mbase * 1024 + h * 128;
  const bf16_t* Vg = R0 + (KIND == 1 ? 2 * PLANE_E : 3 * PLANE_E) + mbase * LDV + h * DV + sl * 64;
  bf16_t* Og = R0 + (KIND == 1 ? 4 * PLANE_E : 5 * PLANE_E) + mbase * LDV + h * DV + sl * 64;
  unsigned char* Qs = lds;
  unsigned char* X = lds + 17408;
  unsigned char* Vt = lds + 35840;
  unsigned char* StS = lds + 45056;
  unsigned char* Pm = lds + 62464;
  float* xch = (float*)(lds + 71680);
  float* blA = xch + 512;
  float* erA = xch + 640;
  const int dp = tid & 63, tq = tid >> 6, r0 = tq * 16, d0 = dp * 2;
  float cst0, cst1;
  if (KIND == 1) { cst0 = cst1 = log1pf(-expf(p.in[18][DIR * 8 + h])); }
  else {
    const float* lbp = p.in[21] + DIR * 4096 + h * 128 + d0;
    {
      const float x0 = lbp[0], x1 = lbp[1024], x2 = lbp[2048], x3 = lbp[3072];
      const float m = fmaxf(fmaxf(x0, x1), fmaxf(x2, x3));
      const float e0 = expf(x0 - m), e1 = expf(x1 - m), e2 = expf(x2 - m), e3 = expf(x3 - m);
      cst0 = (e1 + e2) / (e0 + e1 + e2 + e3);
    }
    {
      const float x0 = lbp[1], x1 = lbp[1025], x2 = lbp[2049], x3 = lbp[3073];
      const float m = fmaxf(fmaxf(x0, x1), fmaxf(x2, x3));
      const float e0 = expf(x0 - m), e1 = expf(x1 - m), e2 = expf(x2 - m), e3 = expf(x3 - m);
      cst1 = (e1 + e2) / (e0 + e1 + e2 + e3);
    }
  }
  f32x4 S[8];
  if (grp) {
    const float* s0 = (KIND == 1 ? p.in[4] : p.in[5]) + ((size_t)((b * 2 + DIR) * 8 + h) * 128) * DV + sl * 64 + 16 * w + lr + (size_t)(4 * lg) * DV;
    asm volatile("" : "+v"(s0));
#pragma unroll
    for (int dt = 0; dt < 8; ++dt)
#pragma unroll
      for (int r = 0; r < 4; ++r) S[dt][r] = s0[(16 * dt + r) * DV];
  } else {
#pragma unroll
    for (int dt = 0; dt < 8; ++dt) S[dt] = (f32x4){0.f, 0.f, 0.f, 0.f};
  }
  unsigned qv[16], kv[16], vv[8];
  const int ve2 = tid & 31, vq = tid >> 5;
  const int qoff = r0 * 512 + dp;
  const int voff = (8 * vq) * (LDV / 2) + ve2;
  const unsigned* Qg32 = (const unsigned*)Qg;
  const unsigned* Kg32 = (const unsigned*)Kg;
  const unsigned* Vg32 = (const unsigned*)Vg;
#define SCAN_ISSUE(c)                                                                                   \
  {                                                                                                     \
    const unsigned* q_ = Qg32 + (size_t)(c) * (64 * 512) + qoff;                                        \
    const unsigned* k_ = Kg32 + (size_t)(c) * (64 * 512) + qoff;                                        \
    const unsigned* v_ = Vg32 + (size_t)(c) * (64 * (LDV / 2)) + voff;                                  \
    asm volatile("" : "+v"(q_), "+v"(k_), "+v"(v_));                                                    \
    _Pragma("unroll") for (int i = 0; i < 16; ++i) { qv[i] = q_[i * 512]; kv[i] = k_[i * 512]; }        \
    _Pragma("unroll") for (int i = 0; i < 8; ++i) vv[i] = v_[i * (LDV / 2)];                            \
  }
  SCAN_ISSUE(DIR ? nch - 1 : 0);
  for (int ci = 0; ci < nch; ++ci) {
    const int c = DIR ? nch - 1 - ci : ci;
    float tot0 = 0.f, tot1 = 0.f;
    if (KIND == 1) { tot0 = tot1 = 16.f * cst0; }
    else {
#pragma unroll
      for (int i = 0; i < 16; ++i) {
        const float s0_ = 1.f / (1.f + __expf(-lo_f(kv[i]))), s1_ = 1.f / (1.f + __expf(-hi_f(kv[i])));
        tot0 += __logf(cst0 + (1.f - cst0) * s0_);
        tot1 += __logf(cst1 + (1.f - cst1) * s1_);
      }
    }
    *(float2*)(xch + tq * 128 + d0) = make_float2(tot0, tot1);
    __syncthreads();
    const float2 t0 = *(const float2*)(xch + d0), t1 = *(const float2*)(xch + 128 + d0), t2 = *(const float2*)(xch + 256 + d0), t3 = *(const float2*)(xch + 384 + d0);
    const float blast0 = (t0.x + t1.x) + (t2.x + t3.x), blast1 = (t0.y + t1.y) + (t2.y + t3.y);
    float ref0, ref1, run0, run1;
    if (DIR == 0) {
      ref0 = t0.x + t1.x; ref1 = t0.y + t1.y;
      run0 = (tq > 0 ? t0.x : 0.f) + (tq > 1 ? t1.x : 0.f) + (tq > 2 ? t2.x : 0.f);
      run1 = (tq > 0 ? t0.y : 0.f) + (tq > 1 ? t1.y : 0.f) + (tq > 2 ? t2.y : 0.f);
    } else {
      ref0 = t2.x + t3.x; ref1 = t2.y + t3.y;
      run0 = (tq < 3 ? t3.x : 0.f) + (tq < 2 ? t2.x : 0.f) + (tq < 1 ? t1.x : 0.f);
      run1 = (tq < 3 ? t3.y : 0.f) + (tq < 2 ? t2.y : 0.f) + (tq < 1 ? t1.y : 0.f);
    }
    unsigned ktp0[8], ktp1[8];
#pragma unroll
    for (int jj = 0; jj < 8; ++jj) {
      const int j = DIR ? 7 - jj : jj;
      float ka[2], kb[2];
#pragma unroll
      for (int hh = 0; hh < 2; ++hh) {
        const int i = 2 * j + (DIR ? 1 - hh : hh);
        float g0, g1, k0, k1;
        if (KIND == 1) { g0 = g1 = cst0; k0 = lo_f(kv[i]); k1 = hi_f(kv[i]); }
        else {
          const float s0_ = 1.f / (1.f + __expf(-lo_f(kv[i]))), s1_ = 1.f / (1.f + __expf(-hi_f(kv[i])));
          g0 = __logf(cst0 + (1.f - cst0) * s0_); g1 = __logf(cst1 + (1.f - cst1) * s1_);
          k0 = (1.f - cst0) * (1.f - s0_); k1 = (1.f - cst1) * (1.f - s1_);
        }
        run0 += g0; run1 += g1;
        *(unsigned*)(Qs + (r0 + i) * 272 + d0 * 2) = pack2(lo_f(qv[i]) * __expf(run0 - ref0), hi_f(qv[i]) * __expf(run1 - ref1));
        *(unsigned*)(X + (r0 + i) * 272 + d0 * 2) = pack2(k0 * __expf(ref0 - run0), k1 * __expf(ref1 - run1));
        ka[i & 1] = k0 * __expf(blast0 - run0);
        kb[i & 1] = k1 * __expf(blast1 - run1);
      }
      ktp0[j] = pack2(ka[0], ka[1]);
      ktp1[j] = pack2(kb[0], kb[1]);
    }
    if (tq == 0) { *(float2*)(blA + d0) = make_float2(__expf(blast0), __expf(blast1)); *(float2*)(erA + d0) = make_float2(__expf(ref0), __expf(ref1)); }
    {
      const unsigned a0 = (vv[0] & 0xffffu) | (vv[1] << 16), a1 = (vv[2] & 0xffffu) | (vv[3] << 16), a2 = (vv[4] & 0xffffu) | (vv[5] << 16), a3 = (vv[6] & 0xffffu) | (vv[7] << 16);
      const unsigned b0 = (vv[0] >> 16) | (vv[1] & 0xffff0000u), b1 = (vv[2] >> 16) | (vv[3] & 0xffff0000u), b2 = (vv[4] >> 16) | (vv[5] & 0xffff0000u), b3 = (vv[6] >> 16) | (vv[7] & 0xffff0000u);
      *(uint4*)(Vt + (2 * ve2) * 144 + vq * 16) = make_uint4(a0, a1, a2, a3);
      *(uint4*)(Vt + (2 * ve2 + 1) * 144 + vq * 16) = make_uint4(b0, b1, b2, b3);
    }
    if (ci + 1 < nch) { SCAN_ISSUE(DIR ? c - 1 : c + 1); }
    __syncthreads();
#pragma unroll
    for (int dt = 0; dt < 8; ++dt) {
      const float4 er4 = *(const float4*)(erA + 16 * dt + 4 * lg);
      *(uint2*)(StS + (16 * w + lr) * 272 + (16 * dt + 4 * lg) * 2) = make_uint2(pack2(S[dt][0] * er4.x, S[dt][1] * er4.y), pack2(S[dt][2] * er4.z, S[dt][3] * er4.w));
    }
    bf16x8 qf[4];
#pragma unroll
    for (int ks = 0; ks < 4; ++ks) qf[ks] = *(const bf16x8*)(Qs + (16 * w + lr) * 272 + ks * 64 + lg * 16);
    uint2 pv[4];
    {
      const int t = 16 * w + lr;
#pragma unroll
      for (int st = 0; st < 4; ++st) {
        f32x4 s = (f32x4){0.f, 0.f, 0.f, 0.f};
#pragma unroll
        for (int ks = 0; ks < 4; ++ks) {
          const bf16x8 kf = *(const bf16x8*)(X + (16 * st + lr) * 272 + ks * 64 + lg * 16);
          s = MFMA(kf, qf[ks], s);
        }
        float v[4];
#pragma unroll
        for (int r = 0; r < 4; ++r) {
          const int si = 16 * st + 4 * lg + r;
          const bool keep = DIR ? (t <= si) : (t >= si);
          v[r] = keep ? s[r] : 0.f;
        }
        pv[st] = make_uint2(pack2(v[0], v[1]), pack2(v[2], v[3]));
      }
    }
    __syncthreads();
#pragma unroll
    for (int st = 0; st < 4; ++st) *(uint2*)(Pm + (16 * w + lr) * 144 + (16 * st + 4 * lg) * 2) = pv[st];
    *(uint4*)(X + d0 * 144 + r0 * 2) = make_uint4(ktp0[0], ktp0[1], ktp0[2], ktp0[3]);
    *(uint4*)(X + d0 * 144 + r0 * 2 + 16) = make_uint4(ktp0[4], ktp0[5], ktp0[6], ktp0[7]);
    *(uint4*)(X + (d0 + 1) * 144 + r0 * 2) = make_uint4(ktp1[0], ktp1[1], ktp1[2], ktp1[3]);
    *(uint4*)(X + (d0 + 1) * 144 + r0 * 2 + 16) = make_uint4(ktp1[4], ktp1[5], ktp1[6], ktp1[7]);
    __syncthreads();
    {
      bf16x8 pf[2];
#pragma unroll
      for (int ks = 0; ks < 2; ++ks) pf[ks] = *(const bf16x8*)(Pm + (16 * w + lr) * 144 + ks * 64 + lg * 16);
      const bool sep = DIR && (KIND == 2 || grp);
      bf16_t* orow = (KIND == 2 && DIR) ? hg_ob_row(p, (int)mbase + c * 64 + 16 * w + lr) + h * DV + sl * 64 + 4 * lg
                   : (KIND == 1 && DIR && grp) ? ret_ob_row(p, b * 2048 + c * 64 + 16 * w + lr) + h * DV + sl * 64 + 4 * lg
                                               : Og + (size_t)(c * 64 + 16 * w + lr) * LDV + 4 * lg;
#pragma unroll
      for (int et = 0; et < 4; ++et) {
        f32x4 o = (f32x4){0.f, 0.f, 0.f, 0.f};
#pragma unroll
        for (int ks = 0; ks < 2; ++ks) {
          const bf16x8 vf = *(const bf16x8*)(Vt + (16 * et + lr) * 144 + ks * 64 + lg * 16);
          o = MFMA(vf, pf[ks], o);
        }
#pragma unroll
        for (int ks = 0; ks < 4; ++ks) {
          const bf16x8 sf = *(const bf16x8*)(StS + (16 * et + lr) * 272 + ks * 64 + lg * 16);
          o = MFMA(sf, qf[ks], o);
        }
        bf16_t* op = orow + 16 * et;
        if (DIR && !sep) {
          const uint2 old = *(const uint2*)op;
          o[0] += lo_f(old.x); o[1] += hi_f(old.x); o[2] += lo_f(old.y); o[3] += hi_f(old.y);
        }
        if (!(DIR && !sep && dry)) *(uint2*)op = make_uint2(pack2(o[0], o[1]), pack2(o[2], o[3]));
      }
    }
    {
      bf16x8 vtf[2];
#pragma unroll
      for (int ks = 0; ks < 2; ++ks) vtf[ks] = *(const bf16x8*)(Vt + (16 * w + lr) * 144 + ks * 64 + lg * 16);
#pragma unroll
      for (int dt = 0; dt < 8; ++dt) {
        const float4 bl4 = *(const float4*)(blA + 16 * dt + 4 * lg);
        S[dt][0] *= bl4.x; S[dt][1] *= bl4.y; S[dt][2] *= bl4.z; S[dt][3] *= bl4.w;
#pragma unroll
        for (int ks = 0; ks < 2; ++ks) {
          const bf16x8 kf = *(const bf16x8*)(X + (16 * dt + lr) * 144 + ks * 64 + lg * 16);
          S[dt] = MFMA(kf, vtf[ks], S[dt]);
        }
      }
    }
    __syncthreads();
  }
#undef SCAN_ISSUE
  if (!grp) {
    float* so = p.out + (KIND == 1 ? OUT_SR : OUT_SH) + ((size_t)((b * 2 + DIR) * 8 + h) * 128) * DV + sl * 64 + 16 * w + lr + (size_t)(4 * lg) * DV;
    asm volatile("" : "+v"(so));
#pragma unroll
    for (int dt = 0; dt < 8; ++dt)
#pragma unroll
      for (int r = 0; r < 4; ++r) so[(16 * dt + r) * DV] = S[dt][r];
  }
}

template <int KIND, int DIR>
__device__ __forceinline__ void scan_phase(const Params& p, unsigned char* lds, const bool dry) {
  constexpr int NSL = (KIND == 1 ? 256 : 128) / 64;
  const int ns = 64 * NSL, npr = 256 * NSL;
  const int G = VGDIM, bid = VBID;
  int it, step, end = ns + npr;
  if (G > ns) {
    if (bid < ns) { it = bid; step = end; }
    else { it = ns + (bid - ns); step = G - ns; }
  } else { it = bid; step = G; }
  for (; it < end; it += step) scan_item<KIND, DIR>(p, it, lds, dry);
}

__device__ __forceinline__ void scan_phase_ret_sample(const Params& p, unsigned char* lds, const bool dry) {
  const int G = VGDIM >> 1, bid = VBID;
  const int role = bid >= G;
  const int rb = role ? bid - G : bid;
  if (role == 0) { for (int it = rb; it < 256; it += G) scan_item<1, 0>(p, it, lds, dry); }
  else           { for (int it = rb; it < 256; it += G) scan_item<1, 1>(p, it, lds, dry); }
}
template <int DIR>
__device__ __forceinline__ void scan_phase_ret_prompt(const Params& p, unsigned char* lds, const bool dry) {
  for (int it = VBID; it < 1024; it += VGDIM) scan_item<1, DIR>(p, 256 + it, lds, dry);
}

__device__ __forceinline__ void scan_phase_hg_both(const Params& p, unsigned char* lds, const bool dry) {
  const int G = VGDIM >> 1, bid = VBID;
  const int role = bid >= G;
  const int rb = role ? bid - G : bid;
  int it, step;
  if (G > 128) {
    if (rb < 128) { it = rb; step = 1 << 20; } else { it = rb; step = G - 128; }
  } else { it = rb; step = G; }
  if (role == 0) { for (; it < 640; it += step) scan_item<2, 0>(p, it, lds, dry); }
  else           { for (; it < 640; it += step) scan_item<2, 1>(p, it, lds, dry); }
}

template <int KIND>
__device__ __forceinline__ void normgate_phase(const Params& p, const bool dry) {
  constexpr int NCH = KIND == 1 ? 4 : 2, DV = KIND == 1 ? 256 : 128, LD = KIND == 1 ? 2048 : 1024;
  const int tid = HTID, lane = tid & 63, w = tid >> 6;
  const int hh = lane >> 3, sub = lane & 7;
  bf16_t* R0 = (bf16_t*)p.ws;
  bf16_t* Ob = R0 + (KIND == 1 ? 4 * PLANE_E : 5 * PLANE_E) + hh * DV + sub * 8;
  const bf16_t* Gb = R0 + (KIND == 1 ? 0 : 4 * PLANE_E) + hh * DV + sub * 8;
  float gn[NCH][8];
#pragma unroll
  for (int j = 0; j < NCH; ++j)
#pragma unroll
    for (int i = 0; i < 8; ++i) gn[j][i] = (KIND == 1) ? 1.f : p.in[22][j * 64 + sub * 8 + i];
  for (int row = VBID * 4 + w; row < 24576; row += VGDIM * 4) {
    bf16_t* op = Ob + (size_t)row * LD;
    const bf16_t* gp = Gb + (size_t)row * LD;
    uint4 ov[NCH], gv[NCH];
#pragma unroll
    for (int j = 0; j < NCH; ++j) { ov[j] = *(const uint4*)(op + j * 64); gv[j] = *(const uint4*)(gp + j * 64); }
    if (KIND == 2 || row >= 8192) {
      const bf16_t* bp = (KIND == 2 ? hg_ob_row(p, row) : ret_ob_row(p, row - 8192)) + hh * DV + sub * 8;
#pragma unroll
      for (int j = 0; j < NCH; ++j) {
        const uint4 bv = *(const uint4*)(bp + j * 64);
        ov[j].x = pack2(lo_f(ov[j].x) + lo_f(bv.x), hi_f(ov[j].x) + hi_f(bv.x));
        ov[j].y = pack2(lo_f(ov[j].y) + lo_f(bv.y), hi_f(ov[j].y) + hi_f(bv.y));
        ov[j].z = pack2(lo_f(ov[j].z) + lo_f(bv.z), hi_f(ov[j].z) + hi_f(bv.z));
        ov[j].w = pack2(lo_f(ov[j].w) + lo_f(bv.w), hi_f(ov[j].w) + hi_f(bv.w));
      }
    }
    float ss = 0.f;
#pragma unroll
    for (int j = 0; j < NCH; ++j) {
      const unsigned wv[4] = {ov[j].x, ov[j].y, ov[j].z, ov[j].w};
#pragma unroll
      for (int i = 0; i < 4; ++i) { const float a = lo_f(wv[i]), b2 = hi_f(wv[i]); ss += a * a + b2 * b2; }
    }
    ss += __shfl_xor(ss, 1);
    ss += __shfl_xor(ss, 2);
    ss += __shfl_xor(ss, 4);
    const float rs = rsqrtf(ss * (1.f / (float)DV) + 1e-6f);
#pragma unroll
    for (int j = 0; j < NCH; ++j) {
      const unsigned wv[4] = {ov[j].x, ov[j].y, ov[j].z, ov[j].w};
      const unsigned gw[4] = {gv[j].x, gv[j].y, gv[j].z, gv[j].w};
      unsigned r[4];
#pragma unroll
      for (int i = 0; i < 4; ++i)
        r[i] = pack2(lo_f(wv[i]) * rs * gn[j][2 * i] * lo_f(gw[i]), hi_f(wv[i]) * rs * gn[j][2 * i + 1] * hi_f(gw[i]));
      if (!dry) *(uint4*)(op + j * 64) = make_uint4(r[0], r[1], r[2], r[3]);
    }
  }
}

__device__ __forceinline__ void opaque_params(Params& q) {
  asm volatile("" : "+s"(q.out), "+s"(q.ws));
#pragma unroll
  for (int i = 0; i < 23; ++i) asm volatile("" : "+s"(q.in[i]));
}

struct BarState { unsigned* base; unsigned xcd, mycnt, nact, esub, etop; };
__device__ __forceinline__ void grid_barrier(BarState& b) {
  asm volatile("s_waitcnt vmcnt(0) lgkmcnt(0)" ::: "memory");
  __syncthreads();
  if (threadIdx.x == 0) {
    b.esub += b.mycnt; b.etop += b.nact;
    __builtin_amdgcn_fence(__ATOMIC_RELEASE, "agent");
    const unsigned old = __hip_atomic_fetch_add(b.base + 64 * b.xcd, 1u, __ATOMIC_RELAXED, __HIP_MEMORY_SCOPE_AGENT);
    if (old + 1u == b.esub) __hip_atomic_fetch_add(b.base + 512, 1u, __ATOMIC_RELAXED, __HIP_MEMORY_SCOPE_AGENT);
    while (__hip_atomic_load(b.base + 512, __ATOMIC_RELAXED, __HIP_MEMORY_SCOPE_AGENT) < b.etop) __builtin_amdgcn_s_sleep(1);
    __builtin_amdgcn_fence(__ATOMIC_ACQUIRE, "agent");
  }
  __syncthreads();
}
__device__ __forceinline__ void bar_census_post(BarState& b) {
  if (threadIdx.x == 0) __hip_atomic_fetch_add(b.base + 1024 + 64 * b.xcd, 1u, __ATOMIC_RELAXED, __HIP_MEMORY_SCOPE_AGENT);
}
__device__ __forceinline__ void bar_census_read(BarState& b) {
  if (threadIdx.x == 0) {
    unsigned n = 0;
    for (unsigned j = 0; j < 8; ++j) {
      const unsigned c = __hip_atomic_load(b.base + 1024 + 64 * j, __ATOMIC_RELAXED, __HIP_MEMORY_SCOPE_AGENT);
      n += (c != 0u);
      if (j == b.xcd) b.mycnt = c;
    }
    b.nact = n;
  }
}
#define GSYNC(n) { if ((n) == 0) { grid.sync(); bar_census_read(bst); } else grid_barrier(bst); }

#if defined(PH_ONLY)
#define PHASE(n, call) if (n == PH_ONLY) { const bool dry = false; call; }
#elif defined(REP_N)
#define PHASE(n, call) if (lo <= n && n < hi) { for (int rep = (n == REP_N ? 0 : 1); rep < 2; ++rep) { const bool dry = (rep == 0); call; if (!(fin && n + 1 == hi && rep == 1)) GSYNC(n) } }
#else
#define PHASE(n, call) if (lo <= n && n < hi) { const bool dry = false; call; if (!(fin && n + 1 == hi)) GSYNC(n) }
#endif

__device__ __forceinline__ void run_range(const Params& q, int lo, int hi, bool fin, cg::grid_group& grid, unsigned char* lds) {
  unsigned char* ldh = lds + HALFID * HALF_LDS;
  BarState bst; bst.base = (unsigned*)(q.ws + OFF_MISC + MISC_CTR); bst.xcd = xcc_id(); bst.mycnt = 0; bst.nact = 0; bst.esub = 0; bst.etop = 0;
  if (lo == 0) bar_census_post(bst);
  PHASE(0, phase0(q, ldh))
  PHASE(1, post_phase(q, -1, 0, ldh, dry))
  PHASE(2, gemm_phase(q, 0, GM_IN_DA, lds, 2))
  PHASE(3, attn_phase(q, 0, lds, dry, 3))
  PHASE(4, gemm_phase(q, 0, GM_OUT, lds, 4))
  PHASE(5, post_phase(q, 0, 1, ldh, dry))
  PHASE(6, gemm_phase(q, 1, GM_IN_RET_QKV, lds, 6))
  PHASE(7, scan_phase_ret_sample(q, ldh, dry))
  PHASE(8, scan_phase_ret_prompt<0>(q, ldh, dry))
  PHASE(8, scan_phase_ret_prompt<1>(q, ldh, dry))
  PHASE(9, gemm_phase(q, 1, GM_IN_RET_G, lds, 9))
  PHASE(10, normgate_phase<1>(q, dry))
  PHASE(11, gemm_phase(q, 1, GM_OUT, lds, 11))
  PHASE(12, post_phase(q, 1, 2, ldh, dry))
  PHASE(13, gemm_phase(q, 2, GM_IN_HG, lds, 13))
  PHASE(14, scan_phase_hg_both(q, ldh, dry))
  PHASE(16, normgate_phase<2>(q, dry))
  PHASE(17, gemm_phase(q, 2, GM_OUT, lds, 17))
  PHASE(18, post_phase(q, 2, 3, ldh, dry))
  PHASE(19, gemm_phase(q, 3, GM_IN_DA, lds, 19))
  PHASE(20, attn_phase(q, 3, lds, dry, 20))
  PHASE(21, gemm_phase(q, 3, GM_OUT, lds, 21))
  PHASE(22, post_phase(q, 3, 4, ldh, dry))
}

__global__ void __launch_bounds__(NTHR, 2) mega_fwd(Params p) {
  extern __shared__ __attribute__((aligned(16))) unsigned char lds[];
  cg::grid_group grid = cg::this_grid();
  run_range(p, p.ph_lo, p.ph_hi, true, grid, lds);
}

extern "C" void kernel_launch(void* const* d_in, const int* in_sizes, int n_in, void* d_out, int out_size, void* d_ws, size_t ws_size, hipStream_t stream) {
  static int grid_blocks = 0;
  if (grid_blocks == 0) {
    int dev = 0, cus = 0, per_cu = 0;
    hipGetDevice(&dev);
    hipDeviceGetAttribute(&cus, hipDeviceAttributeMultiprocessorCount, dev);
    hipFuncSetAttribute((const void*)mega_fwd, hipFuncAttributeMaxDynamicSharedMemorySize, LDS_BYTES);
    hipOccupancyMaxActiveBlocksPerMultiprocessor(&per_cu, (const void*)mega_fwd, NTHR, LDS_BYTES);
    if (per_cu < 1) per_cu = 1;
    if (per_cu > 1) per_cu = 1;
    if (cus < 1) cus = 256;
    grid_blocks = cus * per_cu;
    (void)hipGetLastError();
    if (n_in != 23 || ws_size < WS_NEED) { fprintf(stderr, "kernel_launch: unexpected n_in %d / ws_size %zu (need %zu)\n", n_in, ws_size, (size_t)WS_NEED); }
  }
  hipMemsetAsync((unsigned char*)d_ws + OFF_MISC + MISC_CTR, 0, 8192, stream);
  Params p{};
  for (int i = 0; i < 23; ++i) p.in[i] = (const float*)d_in[i];
  p.out = (float*)d_out;
  p.ws = (unsigned char*)d_ws;
#if ONE_LAUNCH
  p.ph_lo = 0; p.ph_hi = NPH;
  void* args[] = {&p};
  hipError_t e = hipLaunchCooperativeKernel((const void*)mega_fwd, dim3(grid_blocks), dim3(NTHR), args, LDS_BYTES, stream);
  if (e != hipSuccess) fprintf(stderr, "cooperative launch failed: %s (grid %d)\n", hipGetErrorString(e), grid_blocks);
#else
  for (int ph = 0; ph < NPH; ++ph) {
    p.ph_lo = ph; p.ph_hi = ph + 1;
    hipLaunchKernelGGL(mega_fwd, dim3(grid_blocks), dim3(NTHR), LDS_BYTES, stream, p);
  }
#endif
}
```

```cpp
#include <hip/hip_runtime.h>
#include <hip/hip_cooperative_groups.h>
#include <cstdint>
#include <cstdio>
namespace cg = cooperative_groups;

#ifndef ONE_LAUNCH
#define ONE_LAUNCH 1
#endif

typedef unsigned short bf16_t;
typedef short bf16x8 __attribute__((ext_vector_type(8)));
typedef float f32x4 __attribute__((ext_vector_type(4)));

#define NTHR 512
#define HTID ((int)(threadIdx.x & 255))
#define HALFID ((int)(threadIdx.x >> 8))
#define VBID ((int)(blockIdx.x * 2 + (threadIdx.x >> 8)))
#define VGDIM ((int)(gridDim.x * 2))
#define HALF_LDS 74816
#define MIB ((size_t)1 << 20)
#define NPH 23
#define LDS_BYTES (2 * HALF_LDS)
#define LDS_SLOT 74752
#define MISC_CTR (MISC_ROPE + 524288)

#define OFF_WIN  (288 * MIB)
#define OFF_WOUT (300 * MIB)
#define OFF_HP   (304 * MIB)
#define OFF_MISC (320 * MIB)
#define MISC_ROPE 524288
#define WS_NEED  (322 * MIB)
#define PLANE_E  ((size_t)25165824)
#define OUT_YP 0
#define OUT_YS 8388608
#define OUT_CK 25165824
#define OUT_CV 41943040
#define OUT_SR 58720256
#define OUT_SH 75497472

struct Params {
  const float* in[23];
  float* out;
  unsigned char* ws;
  int ph_lo, ph_hi;
};

struct LayerInfo { int kind, slot, IN, WIDTH; const float* w_in; const float* w_out; };

__device__ __forceinline__ LayerInfo layer_info(const Params& p, int l) {
  LayerInfo L;
  if (l == 0)      { L.kind = 0; L.slot = 0; L.IN = 4096; L.WIDTH = 1024; L.w_in = p.in[12]; L.w_out = p.in[13]; }
  else if (l == 1) { L.kind = 1; L.slot = 0; L.IN = 6144; L.WIDTH = 2048; L.w_in = p.in[16]; L.w_out = p.in[17]; }
  else if (l == 2) { L.kind = 2; L.slot = 0; L.IN = 5120; L.WIDTH = 1024; L.w_in = p.in[19]; L.w_out = p.in[20]; }
  else             { L.kind = 0; L.slot = 1; L.IN = 4096; L.WIDTH = 1024; L.w_in = p.in[12] + (size_t)1024 * 4096; L.w_out = p.in[13] + (size_t)1024 * 1024; }
  return L;
}
__device__ __forceinline__ bf16_t* hs_ptr(const Params& p, int l) {
  return l < 3 ? (bf16_t*)(p.out + OUT_SH) : (bf16_t*)(p.ws + 240 * MIB);
}

typedef __bf16 nbf16x2 __attribute__((ext_vector_type(2)));
typedef float f32x2 __attribute__((ext_vector_type(2)));
__device__ __forceinline__ float bf2f(unsigned h) { return __uint_as_float(h << 16); }
__device__ __forceinline__ unsigned pack2(float a, float b) { const f32x2 f = {a, b}; return __builtin_bit_cast(unsigned, __builtin_convertvector(f, nbf16x2)); }
__device__ __forceinline__ float lo_f(unsigned w) { return __uint_as_float(w << 16); }
__device__ __forceinline__ float hi_f(unsigned w) { return __uint_as_float(w & 0xffff0000u); }
__device__ __forceinline__ float silu_f(float x) { return x / (1.f + __expf(-x)); }
__device__ __forceinline__ float wave_sum(float v) {
#pragma unroll
  for (int o = 32; o > 0; o >>= 1) v += __shfl_xor(v, o);
  return v;
}
#define QSCALE 0.18033688011112042f
#define SB __builtin_amdgcn_sched_barrier(0)
#define MFMA(a, b, c) __builtin_amdgcn_mfma_f32_16x16x32_bf16((a), (b), (c), 0, 0, 0)

__device__ __forceinline__ void convT_tile(const float* __restrict__ src, int src_ld, bf16_t* __restrict__ dst, int dst_ld, unsigned char* lds) {
  float* t = (float*)lds;
  const int tid = HTID;
  const int kr = tid >> 4, nc = (tid & 15) * 4;
#pragma unroll
  for (int j = 0; j < 4; ++j) {
    const float4 v = *(const float4*)(src + (size_t)(kr + 16 * j) * src_ld + nc);
    float* tp = t + (kr + 16 * j) * 65 + nc;
    tp[0] = v.x; tp[1] = v.y; tp[2] = v.z; tp[3] = v.w;
  }
  __syncthreads();
  const int n = tid >> 2, kc = (tid & 3) * 16;
  unsigned w[8];
#pragma unroll
  for (int i = 0; i < 8; ++i) w[i] = pack2(t[(kc + 2 * i) * 65 + n], t[(kc + 2 * i + 1) * 65 + n]);
  uint4* d = (uint4*)(dst + (size_t)n * dst_ld + kc);
  d[0] = make_uint4(w[0], w[1], w[2], w[3]);
  d[1] = make_uint4(w[4], w[5], w[6], w[7]);
  __syncthreads();
}

__device__ __forceinline__ int conv_weights_count(const Params& p, int l) {
  const LayerInfo L = layer_info(p, l);
  return (L.IN / 64) * 16 + (L.WIDTH / 64) * 16;
}
__device__ __forceinline__ void conv_weights_item(const Params& p, int l, int it, unsigned char* lds) {
  const LayerInfo L = layer_info(p, l);
  const int nin = (L.IN / 64) * 16;
  if (it < nin) {
    const int kt = it & 15, nt = it >> 4;
    convT_tile(L.w_in + (size_t)(kt * 64) * L.IN + nt * 64, L.IN, (bf16_t*)(p.ws + OFF_WIN) + (size_t)(nt * 64) * 1024 + kt * 64, 1024, lds);
  } else {
    const int it2 = it - nin, nkt = L.WIDTH / 64;
    const int kt = it2 % nkt, nt = it2 / nkt;
    convT_tile(L.w_out + (size_t)(kt * 64) * 1024 + nt * 64, 1024, (bf16_t*)(p.ws + OFF_WOUT) + (size_t)(nt * 64) * L.WIDTH + kt * 64, L.WIDTH, lds);
  }
}

__device__ __forceinline__ void mod_item(const Params& p, int it, unsigned char* lds) {
  float* ssilu = (float*)lds;
  float* red = ssilu + 9 * 1024;
  const int tid = HTID;
  const int l = it / 48, col0 = (it % 48) * 64;
  for (int i = tid; i < 9 * 1024; i += 256) {
    const int v = i >> 10, k = i & 1023;
    const float x = (v == 0) ? p.in[7][k] : p.in[6][(v - 1) * 1024 + k];
    ssilu[i] = silu_f(x);
  }
  __syncthreads();
  const int col = tid & 63, kq = tid >> 6;
  const float* w = p.in[8] + (size_t)l * 1024 * 3072 + col0 + col;
  float acc[9];
#pragma unroll
  for (int v = 0; v < 9; ++v) acc[v] = 0.f;
  for (int k = kq * 256; k < kq * 256 + 256; ++k) {
    const float wv = w[(size_t)k * 3072];
#pragma unroll
    for (int v = 0; v < 9; ++v) acc[v] += ssilu[v * 1024 + k] * wv;
  }
#pragma unroll
  for (int v = 0; v < 9; ++v) red[(kq * 9 + v) * 64 + col] = acc[v];
  __syncthreads();
  float* mod = (float*)(p.ws + OFF_MISC);
  for (int i = tid; i < 9 * 64; i += 256) {
    const int v = i >> 6, cc = i & 63;
    const float s = red[(0 * 9 + v) * 64 + cc] + red[(1 * 9 + v) * 64 + cc] + red[(2 * 9 + v) * 64 + cc] + red[(3 * 9 + v) * 64 + cc];
    mod[(size_t)(l * 9 + v) * 3072 + col0 + cc] = s + p.in[9][l * 3072 + col0 + cc];
  }
  __syncthreads();
}

__device__ __forceinline__ void rope_item(const Params& p, int it) {
  const int idx = it * 256 + HTID;
  const int t = idx >> 5, pp = idx & 31;
  const int pos = pp < 16 ? (t >> 6) : (t & 63);
  const float inv = exp2f(-(float)(pp & 15) * (13.287712379549449f / 16.f));
  const float ang = (float)pos * inv;
  const double a = (double)ang;
  const double r = a - 6.283185307179586 * rint(a * 0.15915494309189535);
  const float rf = (float)r;
  float2* tab = (float2*)(p.ws + OFF_MISC + MISC_ROPE);
  tab[idx] = make_float2(__cosf(rf), __sinf(rf));
}

__device__ __forceinline__ void phase0(const Params& p, unsigned char* lds) {
  const int nw = conv_weights_count(p, 0);
  const int total = 192 + 256 + nw;
  for (int it = VBID; it < total; it += VGDIM) {
    if (it < 192) mod_item(p, it, lds);
    else if (it < 448) rope_item(p, it - 192);
    else conv_weights_item(p, 0, it - 448, lds);
  }
}

__device__ __forceinline__ void post_phase(const Params& p, int lprev, int lnext, unsigned char* lds, const bool dry) {
  const int tid = HTID, lane = tid & 63, w = tid >> 6;
  const float* mod = (const float*)(p.ws + OFF_MISC);
  const bf16_t* Y = nullptr;
  if (lprev >= 0) {
    const int kind = layer_info(p, lprev).kind;
    Y = (const bf16_t*)(p.ws + (kind == 1 ? 96 * MIB : 0));
  }
  bf16_t* hp = (bf16_t*)(p.ws + OFF_HP);
  bf16_t* hs = lnext < 4 ? hs_ptr(p, lnext) : nullptr;
  for (int row = VBID * 4 + w; row < 24576; row += VGDIM * 4) {
    const int mv = row < 8192 ? 0 : 1 + ((row - 8192) >> 11);
    const float* xs = (lprev <= 0) ? (row < 8192 ? p.in[0] + (size_t)row * 1024 : p.in[1] + (size_t)(row - 8192) * 1024) : p.out + (size_t)row * 1024;
    float4 x[4];
#pragma unroll
    for (int j = 0; j < 4; ++j) x[j] = *(const float4*)(xs + lane * 4 + 256 * j);
    if (lprev >= 0) {
      float4 y[4];
      float ss = 0.f;
#pragma unroll
      for (int j = 0; j < 4; ++j) { const uint2 yw = *(const uint2*)(Y + (size_t)row * 1024 + lane * 4 + 256 * j); y[j] = make_float4(lo_f(yw.x), hi_f(yw.x), lo_f(yw.y), hi_f(yw.y)); ss += y[j].x * y[j].x + y[j].y * y[j].y + y[j].z * y[j].z + y[j].w * y[j].w; }
      ss = wave_sum(ss);
      const float rstd = rsqrtf(ss * (1.f / 1024.f) + 1e-6f);
      const float* ga = mod + (size_t)(lprev * 9 + mv) * 3072 + 2048;
      const float* gp = p.in[11] + lprev * 1024;
#pragma unroll
      for (int j = 0; j < 4; ++j) {
        const int c = lane * 4 + 256 * j;
        const float4 g4 = *(const float4*)(ga + c), p4 = *(const float4*)(gp + c);
        x[j].x += g4.x * (y[j].x * rstd * p4.x); x[j].y += g4.y * (y[j].y * rstd * p4.y);
        x[j].z += g4.z * (y[j].z * rstd * p4.z); x[j].w += g4.w * (y[j].w * rstd * p4.w);
        if (!dry) *(float4*)(p.out + (size_t)row * 1024 + c) = x[j];
      }
    }
    if (lnext < 4) {
      float ss = 0.f;
#pragma unroll
      for (int j = 0; j < 4; ++j) ss += x[j].x * x[j].x + x[j].y * x[j].y + x[j].z * x[j].z + x[j].w * x[j].w;
      ss = wave_sum(ss);
      const float rstd = rsqrtf(ss * (1.f / 1024.f) + 1e-6f);
      const float* sh = mod + (size_t)(lnext * 9 + mv) * 3072;
      const float* sc = sh + 1024;
      const float* gp = p.in[10] + lnext * 1024;
      bf16_t* hd = row < 8192 ? hp + (size_t)row * 1024 : hs + (size_t)(row - 8192) * 1024;
#pragma unroll
      for (int j = 0; j < 4; ++j) {
        const int c = lane * 4 + 256 * j;
        const float4 s4 = *(const float4*)(sh + c), c4 = *(const float4*)(sc + c), p4 = *(const float4*)(gp + c);
        const float h0 = x[j].x * rstd * p4.x * (1.f + c4.x) + s4.x, h1 = x[j].y * rstd * p4.y * (1.f + c4.y) + s4.y;
        const float h2 = x[j].z * rstd * p4.z * (1.f + c4.z) + s4.z, h3 = x[j].w * rstd * p4.w * (1.f + c4.w) + s4.w;
        *(uint2*)(hd + c) = make_uint2(pack2(h0, h1), pack2(h2, h3));
      }
    }
  }
  if (lprev >= 0 && lnext < 4) {
    const int nw = conv_weights_count(p, lnext);
    for (int it = VBID; it < nw; it += VGDIM) conv_weights_item(p, lnext, it, lds);
  }
}


__device__ __forceinline__ unsigned xcc_id() { return (unsigned)__builtin_amdgcn_s_getreg((3 << 11) | 20) & 7u; }
__device__ __forceinline__ bool wq_next(unsigned* ctr, int nst, int mult, unsigned xcd, int& qstate, int& q, int& idx, unsigned char* lds) {
  volatile int* slot = (volatile int*)(lds + LDS_SLOT);
  __syncthreads();
  if (HTID == 0) {
    int qq = -1, ii = 0, st = qstate;
    while (st < 8) {
      const int cand = (int)((xcd + (unsigned)st) & 7u);
      const int got = (int)atomicAdd(ctr + cand, 1u);
      if (got < mult * ((nst - cand + 7) >> 3)) { qq = cand; ii = got; break; }
      ++st;
    }
    slot[0] = qq; slot[1] = ii; slot[2] = st;
  }
  __syncthreads();
  q = slot[0]; idx = slot[1]; qstate = slot[2];
  return q >= 0;
}

#define LAS __attribute__((address_space(3)))
template <bool SWAP>
__device__ __forceinline__ void gemm_tile_compute(const bf16_t* __restrict__ Ag, const bf16_t* __restrict__ Bg, int K, unsigned char* lds, f32x4 (&acc)[8][4],
                                                  const bool pre, const bf16_t* __restrict__ An, const bf16_t* __restrict__ Bn, const bool hasn) {
  const int tid = threadIdx.x, lane = tid & 63, wid = __builtin_amdgcn_readfirstlane(tid >> 6), wm = wid >> 2, wn = wid & 3;
  const int lr = lane & 15, lg = lane >> 4;
  LAS unsigned char* l3 = (LAS unsigned char*)lds;
  const int prow = lane >> 3;
  const int pgo0 = prow * K + (((lane & 7) ^ ((prow >> 1) & 7)) << 3);
  const int pgo1 = prow * K + (((lane & 7) ^ ((4 + (prow >> 1)) & 7)) << 3);
  const bf16_t* asrc = Ag + (size_t)(wid * 32) * K;
  const bf16_t* bsrc = Bg + (size_t)(wid * 32) * K;
  const size_t pstep = (size_t)8 * K;
#pragma unroll
  for (int mi = 0; mi < 8; ++mi)
#pragma unroll
    for (int ni = 0; ni < 4; ++ni) acc[mi][ni] = (f32x4){0.f, 0.f, 0.f, 0.f};
#define GEMM_STAGE_P(ap_, bp_, s, k0)                                                                                                      \
  {                                                                                                                                        \
    _Pragma("unroll") for (int j = 0; j < 4; ++j) {                                                                                        \
      __builtin_amdgcn_global_load_lds((const unsigned*)((ap_) + j * pstep + ((j & 1) ? pgo1 : pgo0) + (k0)), (LAS unsigned*)(l3 + (s) * 65536 + (wid * 4 + j) * 1024), 16, 0, 0);          \
      __builtin_amdgcn_global_load_lds((const unsigned*)((bp_) + j * pstep + ((j & 1) ? pgo1 : pgo0) + (k0)), (LAS unsigned*)(l3 + (s) * 65536 + 32768 + (wid * 4 + j) * 1024), 16, 0, 0);  \
    }                                                                                                                                      \
  }
#define GEMM_STAGE(s, k0) GEMM_STAGE_P(asrc, bsrc, s, k0)
  const int nk = K >> 6;
  if (!pre) GEMM_STAGE(0, 0);
  asm volatile("s_waitcnt vmcnt(0)" ::: "memory");
  __syncthreads();
  const int x0 = lg ^ ((lr >> 1) & 7);
  const int aoff0 = (wm * 128 + lr) * 128 + x0 * 16, aoff1 = (wm * 128 + lr) * 128 + (x0 ^ 4) * 16;
  const int boff0 = 32768 + (wn * 64 + lr) * 128 + x0 * 16, boff1 = 32768 + (wn * 64 + lr) * 128 + (x0 ^ 4) * 16;
  for (int kt = 0; kt < nk; ++kt) {
    if (kt + 1 < nk) GEMM_STAGE((kt + 1) & 1, (kt + 1) * 64);
    const unsigned char* st = lds + (kt & 1) * 65536;
#pragma unroll
    for (int kk = 0; kk < 2; ++kk) {
      bf16x8 af[8], bfr[4];
#pragma unroll
      for (int ni = 0; ni < 4; ++ni) bfr[ni] = *(const bf16x8*)(st + (kk ? boff1 : boff0) + ni * 2048);
#pragma unroll
      for (int mi = 0; mi < 8; ++mi) af[mi] = *(const bf16x8*)(st + (kk ? aoff1 : aoff0) + mi * 2048);
#pragma unroll
      for (int mi = 0; mi < 8; ++mi)
#pragma unroll
        for (int ni = 0; ni < 4; ++ni)
          acc[mi][ni] = SWAP ? MFMA(bfr[ni], af[mi], acc[mi][ni]) : MFMA(af[mi], bfr[ni], acc[mi][ni]);
    }
    asm volatile("s_waitcnt vmcnt(0)" ::: "memory");
    __syncthreads();
  }
  if (hasn) { const bf16_t* an_ = An + (size_t)(wid * 32) * K; const bf16_t* bn_ = Bn + (size_t)(wid * 32) * K; GEMM_STAGE_P(an_, bn_, 0, 0); }
#undef GEMM_STAGE
#undef GEMM_STAGE_P
}

enum { GM_IN_DA = 0, GM_IN_RET_QKV = 1, GM_IN_RET_G = 2, GM_IN_HG = 3, GM_OUT = 4 };

__device__ __forceinline__ void epi_swapped(const Params& p, int mode, int slot, int ykind, int m, int n, f32x4 v) {
  bf16_t* R0 = (bf16_t*)p.ws;
  if (mode == GM_OUT) {
    bf16_t* Y = (bf16_t*)(p.ws + (ykind == 1 ? 96 * MIB : 0));
    *(uint2*)(Y + (size_t)m * 1024 + n) = make_uint2(pack2(v[0], v[1]), pack2(v[2], v[3]));
  } else if (mode == GM_IN_DA) {
    const bool smp = m >= 8192;
    const int ms = m - 8192;
    const int b = smp ? (ms >> 11) : (m >> 8), t = smp ? (ms & 2047) : (m & 255);
    if (n < 2048) {
      if (smp) {
        const float4 cs = *(const float4*)((const float*)(p.ws + OFF_MISC + MISC_ROPE) + (size_t)(t * 32 + ((n & 63) >> 1)) * 2);
        const float a0 = v[0] * cs.x - v[1] * cs.y, a1 = v[0] * cs.y + v[1] * cs.x;
        const float a2 = v[2] * cs.z - v[3] * cs.w, a3 = v[2] * cs.w + v[3] * cs.z;
        v = (f32x4){a0, a1, a2, a3};
      }
      if (n < 1024) {
        *(uint2*)(R0 + (size_t)m * 1024 + n) = make_uint2(pack2(v[0] * QSCALE, v[1] * QSCALE), pack2(v[2] * QSCALE, v[3] * QSCALE));
      } else {
        const int c = n - 1024;
        const uint2 pk = make_uint2(pack2(v[0], v[1]), pack2(v[2], v[3]));
        if (smp) {
          *(uint2*)(R0 + 64 * MIB / 2 + ((size_t)b * 2560 + t) * 1024 + c) = pk;
        } else {
          *(f32x4*)(p.out + OUT_CK + ((size_t)((b * 2 + slot) * 256 + t)) * 1024 + c) = v;
          *(uint2*)(R0 + 48 * MIB / 2 + (size_t)m * 1024 + c) = pk;
        }
      }
    } else {
      *(uint2*)(R0 + 160 * MIB / 2 + (size_t)m * 1024 + (n - 3072)) = make_uint2(pack2(silu_f(v[0]), silu_f(v[1])), pack2(silu_f(v[2]), silu_f(v[3])));
    }
  } else if (mode == GM_IN_RET_QKV) {
    if (n < 1024) *(uint2*)(R0 + (size_t)m * 1024 + n) = make_uint2(pack2(v[0], v[1]), pack2(v[2], v[3]));
    else if (n < 2048) { const float s = 0.08838834764831845f; *(uint2*)(R0 + PLANE_E + (size_t)m * 1024 + (n - 1024)) = make_uint2(pack2(v[0] * s, v[1] * s), pack2(v[2] * s, v[3] * s)); }
    else *(uint2*)(R0 + 2 * PLANE_E + (size_t)m * 2048 + (n - 2048)) = make_uint2(pack2(v[0], v[1]), pack2(v[2], v[3]));
  } else if (mode == GM_IN_RET_G) {
    *(uint2*)(R0 + (size_t)m * 2048 + n) = make_uint2(pack2(silu_f(v[0]), silu_f(v[1])), pack2(silu_f(v[2]), silu_f(v[3])));
  } else {
    if (n < 1024 || n >= 4096) v = (f32x4){silu_f(v[0]), silu_f(v[1]), silu_f(v[2]), silu_f(v[3])};
    *(uint2*)(R0 + (size_t)(n >> 10) * PLANE_E + (size_t)m * 1024 + (n & 1023)) = make_uint2(pack2(v[0], v[1]), pack2(v[2], v[3]));
  }
}

__device__ __forceinline__ void epi_da_v(const Params& p, int slot, int m, int n, f32x4 v) {
  bf16_t* R0 = (bf16_t*)p.ws;
  const int c = n - 2048, hh = c >> 7, e = c & 127;
  const uint2 pk = make_uint2(pack2(v[0], v[1]), pack2(v[2], v[3]));
  if (m >= 8192) {
    const int ms = m - 8192, b = ms >> 11, t = ms & 2047;
    *(uint2*)(R0 + 120 * MIB / 2 + ((size_t)((b * 8 + hh) * 128 + e)) * 2560 + t) = pk;
  } else {
    const int b = m >> 8, t = m & 255;
    float* o = p.out + OUT_CV + ((size_t)((b * 2 + slot) * 256 + t)) * 1024 + c;
    o[0] = v[0]; o[1024] = v[1]; o[2048] = v[2]; o[3072] = v[3];
    *(uint2*)(R0 + 104 * MIB / 2 + ((size_t)((b * 8 + hh) * 128 + e)) * 256 + t) = pk;
  }
}

__device__ __forceinline__ void gemm_phase(const Params& p, int l, int mode, unsigned char* lds, int phid) {
  const LayerInfo L = layer_info(p, l);
  bf16_t* R0 = (bf16_t*)p.ws;
  const bf16_t *Ap, *As, *Bt;
  int K, N;
  if (mode == GM_OUT) {
    K = L.WIDTH; N = 1024; Bt = (const bf16_t*)(p.ws + OFF_WOUT);
    const bf16_t* base = R0 + (L.kind == 0 ? 160 * MIB / 2 : (L.kind == 1 ? 4 * PLANE_E : 5 * PLANE_E));
    Ap = base; As = base + (size_t)8192 * K;
  } else {
    K = 1024; Ap = (const bf16_t*)(p.ws + OFF_HP); As = hs_ptr(p, l);
    Bt = (const bf16_t*)(p.ws + OFF_WIN) + (mode == GM_IN_RET_G ? (size_t)4096 * 1024 : 0);
    N = (mode == GM_IN_DA || mode == GM_IN_RET_QKV) ? 4096 : (mode == GM_IN_RET_G ? 2048 : 5120);
  }
  const int ntn = N >> 8, ntiles = 96 * ntn;
  const int extra = (mode == GM_IN_DA) ? 3072 : 0;
  const int tid = threadIdx.x, lane = tid & 63, wid = tid >> 6, wm = wid >> 2, wn = wid & 3, lr = lane & 15, lg = lane >> 4;
  const int G = gridDim.x;
  const bool swz = (G & 7) == 0;
  const int xcd = blockIdx.x & 7, snn = ntn >> 2, nst = 12 * snn;
  const int q0 = swz ? (int)(blockIdx.x >> 3) : (int)blockIdx.x, qstep = swz ? (G >> 3) : G;
  const int qlen = swz ? 32 * ((nst - xcd + 7) >> 3) : ntiles;
#define GEMM_TILE_OF(qq, m0_, n0_)                                                   \
  {                                                                                    \
    int it_ = (qq);                                                                    \
    if (swz) {                                                                         \
      const int st_ = xcd + 8 * ((qq) >> 5), tin_ = (qq) & 31;                         \
      const int smt_ = st_ / snn, snt_ = st_ - smt_ * snn;                             \
      it_ = (smt_ * 8 + (tin_ >> 2)) * ntn + snt_ * 4 + (tin_ & 3);                    \
    }                                                                                  \
    const int mt_ = it_ / ntn;                                                         \
    m0_ = mt_ * 256; n0_ = (it_ - mt_ * ntn) * 256;                                    \
  }
  bool pre = false;
  for (int q = q0; q < qlen; q += qstep) {
    int m0, n0;
    GEMM_TILE_OF(q, m0, n0)
    const bf16_t* A = m0 < 8192 ? Ap + (size_t)m0 * K : As + (size_t)(m0 - 8192) * K;
    const bf16_t* B = Bt + (size_t)n0 * K;
    const bool hasn = q + qstep < qlen;
    const bf16_t *An = A, *Bn = B;
    if (hasn) {
      int m1, n1;
      GEMM_TILE_OF(q + qstep, m1, n1)
      An = m1 < 8192 ? Ap + (size_t)m1 * K : As + (size_t)(m1 - 8192) * K;
      Bn = Bt + (size_t)n1 * K;
    }
    {
      f32x4 acc[8][4];
      if (mode == GM_IN_DA && n0 >= 2048 && n0 < 3072) {
        gemm_tile_compute<false>(A, B, K, lds, acc, pre, An, Bn, hasn);
#pragma unroll
        for (int mi = 0; mi < 8; ++mi)
#pragma unroll
          for (int ni = 0; ni < 4; ++ni)
            epi_da_v(p, L.slot, m0 + wm * 128 + mi * 16 + 4 * lg, n0 + wn * 64 + ni * 16 + lr, acc[mi][ni]);
      } else {
        gemm_tile_compute<true>(A, B, K, lds, acc, pre, An, Bn, hasn);
#pragma unroll
        for (int mi = 0; mi < 8; ++mi)
#pragma unroll
          for (int ni = 0; ni < 4; ++ni)
            epi_swapped(p, mode, L.slot, L.kind, m0 + wm * 128 + mi * 16 + lr, n0 + wn * 64 + ni * 16 + 4 * lg, acc[mi][ni]);
      }
    }
    pre = hasn;
  }
#undef GEMM_TILE_OF
  if (extra) { asm volatile("s_waitcnt vmcnt(0)" ::: "memory"); __syncthreads(); }
  for (int ci = VBID; ci < extra; ci += VGDIM) {
    {
      if (ci < 2048) {
        const int idx = (ci * 256 + HTID) * 8;
        const int b = idx >> 19, rem = idx & 524287, tp = rem >> 10, c = rem & 1023;
        const float* src = p.in[2] + ((size_t)((b * 2 + L.slot) * 512 + tp)) * 1024 + c;
        const float4 u0 = *(const float4*)src, u1 = *(const float4*)(src + 4);
        *(uint4*)(R0 + 64 * MIB / 2 + ((size_t)b * 2560 + 2048 + tp) * 1024 + c) = make_uint4(pack2(u0.x, u0.y), pack2(u0.z, u0.w), pack2(u1.x, u1.y), pack2(u1.z, u1.w));
      } else {
        const int i2 = ci - 2048;
        const int b = i2 >> 7, hh = (i2 >> 4) & 7, tt = (i2 >> 1) & 7, et = i2 & 1;
        convT_tile(p.in[3] + ((size_t)((b * 2 + L.slot) * 512 + tt * 64)) * 1024 + hh * 128 + et * 64, 1024,
                   R0 + 120 * MIB / 2 + ((size_t)((b * 8 + hh) * 128 + et * 64)) * 2560 + 2048 + tt * 64, 2560, lds + HALFID * HALF_LDS);
      }
    }
  }
}

__device__ __forceinline__ void attn_phase(const Params& p, int l, unsigned char* lds, const bool dry, int phid) {
  const int slot = l == 3 ? 1 : 0;
  const float lam_init = 0.8f - 0.6f * expf(-0.3f * (float)l);
  const int tid = threadIdx.x, lane = tid & 63, w = tid >> 6, lr = lane & 15, lg = lane >> 4;
  float lam;
  {
    const float* lf = p.in[14] + slot * 256;
    const float a = wave_sum(lf[lane] * lf[64 + lane]);
    const float b2 = wave_sum(lf[128 + lane] * lf[192 + lane]);
    lam = expf(a) - expf(b2) + lam_init;
  }
  bf16_t* R0 = (bf16_t*)p.ws;
  const float* subg = p.in[15] + slot * 128;
  for (int item = blockIdx.x; item < 1536; item += gridDim.x) {
    int grp, b, h, qt;
    if (item < 1024) { grp = 1; b = item >> 7; h = (item >> 4) & 7; qt = item & 15; }
    else { const int i2 = item - 1024; grp = 0; b = i2 >> 4; h = (i2 >> 1) & 7; qt = i2 & 1; }
    const int nkeys = grp ? 2560 : 256, ntile = nkeys >> 6;
    const int mq = (grp ? 8192 + b * 2048 : b * 256) + qt * 128 + w * 16 + lr;
    const bf16_t* Kg = grp ? R0 + 64 * MIB / 2 + (size_t)b * 2560 * 1024 + h * 128 : R0 + 48 * MIB / 2 + (size_t)b * 256 * 1024 + h * 128;
    const bf16_t* Vg = grp ? R0 + 120 * MIB / 2 + (size_t)(b * 8 + h) * 128 * 2560 : R0 + 104 * MIB / 2 + (size_t)(b * 8 + h) * 128 * 256;
    bf16x8 qf[2][2];
#pragma unroll
    for (int sub = 0; sub < 2; ++sub)
#pragma unroll
      for (int ks = 0; ks < 2; ++ks) qf[sub][ks] = *(const bf16x8*)(R0 + (size_t)mq * 1024 + h * 128 + sub * 64 + ks * 32 + lg * 8);
    LAS unsigned char* l3 = (LAS unsigned char*)lds;
    const int wu = __builtin_amdgcn_readfirstlane(w);
    int koff[2], voff[2];
#pragma unroll
    for (int j = 0; j < 2; ++j) {
      const int kr = (wu * 2 + j) * 4 + (lane >> 4);
      koff[j] = kr * 1024 + (((lane & 15) ^ (kr & 15)) << 3);
      const int er = (wu * 2 + j) * 8 + (lane >> 3);
      voff[j] = er * nkeys + (((lane & 7) ^ ((er >> 1) & 7)) << 3);
    }
#define ATT_STAGE_K(s, key0)                                                                                  \
  {                                                                                                           \
    _Pragma("unroll") for (int j = 0; j < 2; ++j)                                                             \
      __builtin_amdgcn_global_load_lds((const unsigned*)(Kg + (size_t)(key0) * 1024 + koff[j]), (LAS unsigned*)(l3 + (s) * 32768 + (wu * 2 + j) * 1024), 16, 0, 0); \
  }
#define ATT_STAGE_V(s, key0)                                                                                  \
  {                                                                                                           \
    _Pragma("unroll") for (int j = 0; j < 2; ++j)                                                             \
      __builtin_amdgcn_global_load_lds((const unsigned*)(Vg + (key0) + voff[j]), (LAS unsigned*)(l3 + (s) * 32768 + 16384 + (wu * 2 + j) * 1024), 16, 0, 0); \
  }
    const int xl = lg ^ lr;
    const int vsw = (lr >> 1) & 7;
    const int vlo = lr * 128 + ((((lg >> 1)) ^ vsw) << 4) + (lg & 1) * 8;
    float mx[2] = {-1e30f, -1e30f}, ls[2] = {0.f, 0.f};
    f32x4 o0[8], o1[8];
#pragma unroll
    for (int et = 0; et < 8; ++et) { o0[et] = (f32x4){0.f, 0.f, 0.f, 0.f}; o1[et] = (f32x4){0.f, 0.f, 0.f, 0.f}; }
    ATT_STAGE_K(0, 0);
    ATT_STAGE_V(0, 0);
    asm volatile("s_waitcnt vmcnt(0)" ::: "memory");
    __syncthreads();
    for (int kt = 0; kt < ntile; ++kt) {
      if (kt + 1 < ntile) { ATT_STAGE_K((kt + 1) & 1, (kt + 1) * 64); ATT_STAGE_V((kt + 1) & 1, (kt + 1) * 64); }
      const unsigned char* ks_ = lds + (kt & 1) * 32768 + lr * 256;
      const unsigned char* vs_ = lds + (kt & 1) * 32768 + 16384;
#pragma unroll
      for (int k2 = 0; k2 < 2; ++k2) {
        bf16x8 kfr[8];
        uint2 vlo_[8], vhi_[8];
#pragma unroll
        for (int sub = 0; sub < 2; ++sub)
#pragma unroll
          for (int nn = 0; nn < 2; ++nn)
#pragma unroll
            for (int ks = 0; ks < 2; ++ks)
              kfr[sub * 4 + nn * 2 + ks] = *(const bf16x8*)(ks_ + (2 * k2 + nn) * 4096 + ((xl ^ (sub * 8 + ks * 4)) << 4));
#pragma unroll
        for (int et = 0; et < 8; ++et) {
          vlo_[et] = *(const uint2*)(vs_ + et * 2048 + (vlo ^ (k2 << 6)));
          vhi_[et] = *(const uint2*)(vs_ + et * 2048 + (vlo ^ (k2 << 6) ^ 32));
        }
        SB;
        f32x4 s[2][2];
#pragma unroll
        for (int sub = 0; sub < 2; ++sub)
#pragma unroll
          for (int nn = 0; nn < 2; ++nn) {
            s[sub][nn] = MFMA(kfr[sub * 4 + nn * 2], qf[sub][0], ((f32x4){0.f, 0.f, 0.f, 0.f}));
            s[sub][nn] = MFMA(kfr[sub * 4 + nn * 2 + 1], qf[sub][1], s[sub][nn]);
          }
        SB;
        bf16x8 pf[2];
        float tmx[2];
#pragma unroll
        for (int sub = 0; sub < 2; ++sub) {
          float tm = fmaxf(fmaxf(fmaxf(s[sub][0][0], s[sub][0][1]), fmaxf(s[sub][0][2], s[sub][0][3])), fmaxf(fmaxf(s[sub][1][0], s[sub][1][1]), fmaxf(s[sub][1][2], s[sub][1][3])));
          tm = fmaxf(tm, __shfl_xor(tm, 16));
          tm = fmaxf(tm, __shfl_xor(tm, 32));
          tmx[sub] = tm;
        }
        if (__any((tmx[0] > mx[0] + 8.f) || (tmx[1] > mx[1] + 8.f))) {
#pragma unroll
          for (int sub = 0; sub < 2; ++sub) {
            const float mn = (tmx[sub] > mx[sub] + 8.f) ? tmx[sub] : mx[sub];
            const float sc = __builtin_amdgcn_exp2f(mx[sub] - mn);
            mx[sub] = mn;
            ls[sub] *= sc;
#pragma unroll
            for (int et = 0; et < 8; ++et) {
              if (sub == 0) { o0[et][0] *= sc; o0[et][1] *= sc; o0[et][2] *= sc; o0[et][3] *= sc; }
              else { o1[et][0] *= sc; o1[et][1] *= sc; o1[et][2] *= sc; o1[et][3] *= sc; }
            }
          }
        }
#pragma unroll
        for (int sub = 0; sub < 2; ++sub) {
          unsigned pw[4];
          float acc = 0.f;
#pragma unroll
          for (int nn = 0; nn < 2; ++nn) {
            float a[4];
#pragma unroll
            for (int r = 0; r < 4; ++r) { a[r] = __builtin_amdgcn_exp2f(s[sub][nn][r] - mx[sub]); acc += a[r]; }
            pw[nn * 2] = pack2(a[0], a[1]);
            pw[nn * 2 + 1] = pack2(a[2], a[3]);
          }
          ls[sub] += acc;
          union { unsigned u[4]; bf16x8 v; } cp;
          cp.u[0] = pw[0]; cp.u[1] = pw[1]; cp.u[2] = pw[2]; cp.u[3] = pw[3];
          pf[sub] = cp.v;
        }
        SB;
#pragma unroll
        for (int et = 0; et < 8; ++et) {
          union { unsigned u[4]; bf16x8 v; } cv;
          cv.u[0] = vlo_[et].x; cv.u[1] = vlo_[et].y; cv.u[2] = vhi_[et].x; cv.u[3] = vhi_[et].y;
          o0[et] = MFMA(cv.v, pf[0], o0[et]);
          o1[et] = MFMA(cv.v, pf[1], o1[et]);
        }
        SB;
      }
      asm volatile("s_waitcnt vmcnt(0)" ::: "memory");
      __syncthreads();
    }
    f32x4 o[8];
    {
      float t0 = ls[0], t1 = ls[1];
      t0 += __shfl_xor(t0, 16); t0 += __shfl_xor(t0, 32);
      t1 += __shfl_xor(t1, 16); t1 += __shfl_xor(t1, 32);
      const float c1 = 1.f / t0, c2 = lam / t1;
#pragma unroll
      for (int et = 0; et < 8; ++et)
#pragma unroll
        for (int r = 0; r < 4; ++r) o[et][r] = o0[et][r] * c1 - o1[et][r] * c2;
    }
#undef ATT_STAGE_K
#undef ATT_STAGE_V
    float ss = 0.f;
#pragma unroll
    for (int et = 0; et < 8; ++et)
#pragma unroll
      for (int r = 0; r < 4; ++r) ss += o[et][r] * o[et][r];
    ss += __shfl_xor(ss, 16);
    ss += __shfl_xor(ss, 32);
    const float rs = rsqrtf(ss * (1.f / 128.f) + 1e-6f) * (1.f - lam_init);
    bf16_t* gp = R0 + 160 * MIB / 2 + (size_t)mq * 1024 + h * 128;
#pragma unroll
    for (int et = 0; et < 8; ++et) {
      const int e0 = 16 * et + 4 * lg;
      const uint2 g = *(const uint2*)(gp + e0);
      const float4 sg = *(const float4*)(subg + e0);
      const float v0 = o[et][0] * rs * sg.x * lo_f(g.x), v1 = o[et][1] * rs * sg.y * hi_f(g.x);
      const float v2 = o[et][2] * rs * sg.z * lo_f(g.y), v3 = o[et][3] * rs * sg.w * hi_f(g.y);
      if (!dry) *(uint2*)(gp + e0) = make_uint2(pack2(v0, v1), pack2(v2, v3));
    }
  }
}

__device__ __forceinline__ bf16_t* hg_ob_row(const Params& p, int m) {
  const int c = m >> 9;
  float* base = c < 32 ? p.out + OUT_CK + (size_t)(c * 2 + 1) * 262144 : p.out + OUT_CV + (size_t)((c - 32) * 2 + 1) * 262144;
  return (bf16_t*)base + (size_t)(m & 511) * 1024;
}

__device__ __forceinline__ bf16_t* ret_ob_row(const Params& p, int ms) {
  const int c = ms >> 8;
  float* base = c < 32 ? p.out + OUT_CK + (size_t)(c * 2 + 1) * 262144 : p.out + OUT_CV + (size_t)((c - 32) * 2 + 1) * 262144;
  return (bf16_t*)base + (size_t)(ms & 255) * 2048;
}

template <int KIND, int DIR>
__device__ __forceinline__ void scan_item(const Params& p, int item, unsigned char* lds, const bool dry) {
  constexpr int DV = KIND == 1 ? 256 : 128, NSL = DV / 64, LDV = KIND == 1 ? 2048 : 1024;
  const int tid = HTID, lane = tid & 63, w = tid >> 6, lr = lane & 15, lg = lane >> 4;
  int grp, b, h, sl;
  {
    int it = item;
    if (it < 64 * NSL) grp = 1; else { grp = 0; it -= 64 * NSL; }
    sl = it % NSL; h = (it / NSL) & 7; b = it / (NSL * 8);
  }
  const int T = grp ? 2048 : 256, nch = T >> 6;
  const size_t mbase = grp ? (size_t)8192 + (size_t)b * 2048 : (size_t)b * 256;
  bf16_t* R0 = (bf16_t*)p.ws;
  const bf16_t* Qg = R0 + mbase * 1024 + h * 128;
  const bf16_t* Kg = R0 + (KIND == 1 ? PLANE_E : (DIR ? 2 * PLANE_E : PLANE_E)) + mbase * 1024 + h * 128;
  const bf16_t* Vg = R0 + (KIND == 1 ? 2 * PLANE_E : 3 * PLANE_E) + mbase * LDV + h * DV + sl * 64;
  bf16_t* Og = R0 + (KIND == 1 ? 4 * PLANE_E : 5 * PLANE_E) + mbase * LDV + h * DV + sl * 64;
  unsigned char* Qs = lds;
  unsigned char* X = lds + 17408;
  unsigned char* Vt = lds + 35840;
  unsigned char* StS = lds + 45056;
  unsigned char* Pm = lds + 62464;
  float* xch = (float*)(lds + 71680);
  float* blA = xch + 512;
  float* erA = xch + 640;
  const int dp = tid & 63, tq = tid >> 6, r0 = tq * 16, d0 = dp * 2;
  float cst0, cst1;
  if (KIND == 1) { cst0 = cst1 = log1pf(-expf(p.in[18][DIR * 8 + h])); }
  else {
    const float* lbp = p.in[21] + DIR * 4096 + h * 128 + d0;
    {
      const float x0 = lbp[0], x1 = lbp[1024], x2 = lbp[2048], x3 = lbp[3072];
      const float m = fmaxf(fmaxf(x0, x1), fmaxf(x2, x3));
      const float e0 = expf(x0 - m), e1 = expf(x1 - m), e2 = expf(x2 - m), e3 = expf(x3 - m);
      cst0 = (e1 + e2) / (e0 + e1 + e2 + e3);
    }
    {
      const float x0 = lbp[1], x1 = lbp[1025], x2 = lbp[2049], x3 = lbp[3073];
      const float m = fmaxf(fmaxf(x0, x1), fmaxf(x2, x3));
      const float e0 = expf(x0 - m), e1 = expf(x1 - m), e2 = expf(x2 - m), e3 = expf(x3 - m);
      cst1 = (e1 + e2) / (e0 + e1 + e2 + e3);
    }
  }
  f32x4 S[8];
  if (grp) {
    const float* s0 = (KIND == 1 ? p.in[4] : p.in[5]) + ((size_t)((b * 2 + DIR) * 8 + h) * 128) * DV + sl * 64 + 16 * w + lr + (size_t)(4 * lg) * DV;
    asm volatile("" : "+v"(s0));
#pragma unroll
    for (int dt = 0; dt < 8; ++dt)
#pragma unroll
      for (int r = 0; r < 4; ++r) S[dt][r] = s0[(16 * dt + r) * DV];
  } else {
#pragma unroll
    for (int dt = 0; dt < 8; ++dt) S[dt] = (f32x4){0.f, 0.f, 0.f, 0.f};
  }
  unsigned qv[16], kv[16], vv[8];
  const int ve2 = tid & 31, vq = tid >> 5;
  const int qoff = r0 * 512 + dp;
  const int voff = (8 * vq) * (LDV / 2) + ve2;
  const unsigned* Qg32 = (const unsigned*)Qg;
  const unsigned* Kg32 = (const unsigned*)Kg;
  const unsigned* Vg32 = (const unsigned*)Vg;
#define SCAN_ISSUE(c)                                                                                   \
  {                                                                                                     \
    const unsigned* q_ = Qg32 + (size_t)(c) * (64 * 512) + qoff;                                        \
    const unsigned* k_ = Kg32 + (size_t)(c) * (64 * 512) + qoff;                                        \
    const unsigned* v_ = Vg32 + (size_t)(c) * (64 * (LDV / 2)) + voff;                                  \
    asm volatile("" : "+v"(q_), "+v"(k_), "+v"(v_));                                                    \
    _Pragma("unroll") for (int i = 0; i < 16; ++i) { qv[i] = q_[i * 512]; kv[i] = k_[i * 512]; }        \
    _Pragma("unroll") for (int i = 0; i < 8; ++i) vv[i] = v_[i * (LDV / 2)];                            \
  }
  SCAN_ISSUE(DIR ? nch - 1 : 0);
  for (int ci = 0; ci < nch; ++ci) {
    const int c = DIR ? nch - 1 - ci : ci;
    float tot0 = 0.f, tot1 = 0.f;
    if (KIND == 1) { tot0 = tot1 = 16.f * cst0; }
    else {
#pragma unroll
      for (int i = 0; i < 16; ++i) {
        const float s0_ = 1.f / (1.f + __expf(-lo_f(kv[i]))), s1_ = 1.f / (1.f + __expf(-hi_f(kv[i])));
        tot0 += __logf(cst0 + (1.f - cst0) * s0_);
        tot1 += __logf(cst1 + (1.f - cst1) * s1_);
      }
    }
    *(float2*)(xch + tq * 128 + d0) = make_float2(tot0, tot1);
    __syncthreads();
    const float2 t0 = *(const float2*)(xch + d0), t1 = *(const float2*)(xch + 128 + d0), t2 = *(const float2*)(xch + 256 + d0), t3 = *(const float2*)(xch + 384 + d0);
    const float blast0 = (t0.x + t1.x) + (t2.x + t3.x), blast1 = (t0.y + t1.y) + (t2.y + t3.y);
    float ref0, ref1, run0, run1;
    if (DIR == 0) {
      ref0 = t0.x + t1.x; ref1 = t0.y + t1.y;
      run0 = (tq > 0 ? t0.x : 0.f) + (tq > 1 ? t1.x : 0.f) + (tq > 2 ? t2.x : 0.f);
      run1 = (tq > 0 ? t0.y : 0.f) + (tq > 1 ? t1.y : 0.f) + (tq > 2 ? t2.y : 0.f);
    } else {
      ref0 = t2.x + t3.x; ref1 = t2.y + t3.y;
      run0 = (tq < 3 ? t3.x : 0.f) + (tq < 2 ? t2.x : 0.f) + (tq < 1 ? t1.x : 0.f);
      run1 = (tq < 3 ? t3.y : 0.f) + (tq < 2 ? t2.y : 0.f) + (tq < 1 ? t1.y : 0.f);
    }
    unsigned ktp0[8], ktp1[8];
#pragma unroll
    for (int jj = 0; jj < 8; ++jj) {
      const int j = DIR ? 7 - jj : jj;
      float ka[2], kb[2];
#pragma unroll
      for (int hh = 0; hh < 2; ++hh) {
        const int i = 2 * j + (DIR ? 1 - hh : hh);
        float g0, g1, k0, k1;
        if (KIND == 1) { g0 = g1 = cst0; k0 = lo_f(kv[i]); k1 = hi_f(kv[i]); }
        else {
          const float s0_ = 1.f / (1.f + __expf(-lo_f(kv[i]))), s1_ = 1.f / (1.f + __expf(-hi_f(kv[i])));
          g0 = __logf(cst0 + (1.f - cst0) * s0_); g1 = __logf(cst1 + (1.f - cst1) * s1_);
          k0 = (1.f - cst0) * (1.f - s0_); k1 = (1.f - cst1) * (1.f - s1_);
        }
        run0 += g0; run1 += g1;
        *(unsigned*)(Qs + (r0 + i) * 272 + d0 * 2) = pack2(lo_f(qv[i]) * __expf(run0 - ref0), hi_f(qv[i]) * __expf(run1 - ref1));
        *(unsigned*)(X + (r0 + i) * 272 + d0 * 2) = pack2(k0 * __expf(ref0 - run0), k1 * __expf(ref1 - run1));
        ka[i & 1] = k0 * __expf(blast0 - run0);
        kb[i & 1] = k1 * __expf(blast1 - run1);
      }
      ktp0[j] = pack2(ka[0], ka[1]);
      ktp1[j] = pack2(kb[0], kb[1]);
    }
    if (tq == 0) { *(float2*)(blA + d0) = make_float2(__expf(blast0), __expf(blast1)); *(float2*)(erA + d0) = make_float2(__expf(ref0), __expf(ref1)); }
    {
      const unsigned a0 = (vv[0] & 0xffffu) | (vv[1] << 16), a1 = (vv[2] & 0xffffu) | (vv[3] << 16), a2 = (vv[4] & 0xffffu) | (vv[5] << 16), a3 = (vv[6] & 0xffffu) | (vv[7] << 16);
      const unsigned b0 = (vv[0] >> 16) | (vv[1] & 0xffff0000u), b1 = (vv[2] >> 16) | (vv[3] & 0xffff0000u), b2 = (vv[4] >> 16) | (vv[5] & 0xffff0000u), b3 = (vv[6] >> 16) | (vv[7] & 0xffff0000u);
      *(uint4*)(Vt + (2 * ve2) * 144 + vq * 16) = make_uint4(a0, a1, a2, a3);
      *(uint4*)(Vt + (2 * ve2 + 1) * 144 + vq * 16) = make_uint4(b0, b1, b2, b3);
    }
    if (ci + 1 < nch) { SCAN_ISSUE(DIR ? c - 1 : c + 1); }
    __syncthreads();
#pragma unroll
    for (int dt = 0; dt < 8; ++dt) {
      const float4 er4 = *(const float4*)(erA + 16 * dt + 4 * lg);
      *(uint2*)(StS + (16 * w + lr) * 272 + (16 * dt + 4 * lg) * 2) = make_uint2(pack2(S[dt][0] * er4.x, S[dt][1] * er4.y), pack2(S[dt][2] * er4.z, S[dt][3] * er4.w));
    }
    bf16x8 qf[4];
#pragma unroll
    for (int ks = 0; ks < 4; ++ks) qf[ks] = *(const bf16x8*)(Qs + (16 * w + lr) * 272 + ks * 64 + lg * 16);
    uint2 pv[4];
    {
      const int t = 16 * w + lr;
#pragma unroll
      for (int st = 0; st < 4; ++st) {
        f32x4 s = (f32x4){0.f, 0.f, 0.f, 0.f};
#pragma unroll
        for (int ks = 0; ks < 4; ++ks) {
          const bf16x8 kf = *(const bf16x8*)(X + (16 * st + lr) * 272 + ks * 64 + lg * 16);
          s = MFMA(kf, qf[ks], s);
        }
        float v[4];
#pragma unroll
        for (int r = 0; r < 4; ++r) {
          const int si = 16 * st + 4 * lg + r;
          const bool keep = DIR ? (t <= si) : (t >= si);
          v[r] = keep ? s[r] : 0.f;
        }
        pv[st] = make_uint2(pack2(v[0], v[1]), pack2(v[2], v[3]));
      }
    }
    __syncthreads();
#pragma unroll
    for (int st = 0; st < 4; ++st) *(uint2*)(Pm + (16 * w + lr) * 144 + (16 * st + 4 * lg) * 2) = pv[st];
    *(uint4*)(X + d0 * 144 + r0 * 2) = make_uint4(ktp0[0], ktp0[1], ktp0[2], ktp0[3]);
    *(uint4*)(X + d0 * 144 + r0 * 2 + 16) = make_uint4(ktp0[4], ktp0[5], ktp0[6], ktp0[7]);
    *(uint4*)(X + (d0 + 1) * 144 + r0 * 2) = make_uint4(ktp1[0], ktp1[1], ktp1[2], ktp1[3]);
    *(uint4*)(X + (d0 + 1) * 144 + r0 * 2 + 16) = make_uint4(ktp1[4], ktp1[5], ktp1[6], ktp1[7]);
    __syncthreads();
    {
      bf16x8 pf[2];
#pragma unroll
      for (int ks = 0; ks < 2; ++ks) pf[ks] = *(const bf16x8*)(Pm + (16 * w + lr) * 144 + ks * 64 + lg * 16);
      const bool sep = DIR && (KIND == 2 || grp);
      bf16_t* orow = (KIND == 2 && DIR) ? hg_ob_row(p, (int)mbase + c * 64 + 16 * w + lr) + h * DV + sl * 64 + 4 * lg
                   : (KIND == 1 && DIR && grp) ? ret_ob_row(p, b * 2048 + c * 64 + 16 * w + lr) + h * DV + sl * 64 + 4 * lg
                                               : Og + (size_t)(c * 64 + 16 * w + lr) * LDV + 4 * lg;
#pragma unroll
      for (int et = 0; et < 4; ++et) {
        f32x4 o = (f32x4){0.f, 0.f, 0.f, 0.f};
#pragma unroll
        for (int ks = 0; ks < 2; ++ks) {
          const bf16x8 vf = *(const bf16x8*)(Vt + (16 * et + lr) * 144 + ks * 64 + lg * 16);
          o = MFMA(vf, pf[ks], o);
        }
#pragma unroll
        for (int ks = 0; ks < 4; ++ks) {
          const bf16x8 sf = *(const bf16x8*)(StS + (16 * et + lr) * 272 + ks * 64 + lg * 16);
          o = MFMA(sf, qf[ks], o);
        }
        bf16_t* op = orow + 16 * et;
        if (DIR && !sep) {
          const uint2 old = *(const uint2*)op;
          o[0] += lo_f(old.x); o[1] += hi_f(old.x); o[2] += lo_f(old.y); o[3] += hi_f(old.y);
        }
        if (!(DIR && !sep && dry)) *(uint2*)op = make_uint2(pack2(o[0], o[1]), pack2(o[2], o[3]));
      }
    }
    {
      bf16x8 vtf[2];
#pragma unroll
      for (int ks = 0; ks < 2; ++ks) vtf[ks] = *(const bf16x8*)(Vt + (16 * w + lr) * 144 + ks * 64 + lg * 16);
#pragma unroll
      for (int dt = 0; dt < 8; ++dt) {
        const float4 bl4 = *(const float4*)(blA + 16 * dt + 4 * lg);
        S[dt][0] *= bl4.x; S[dt][1] *= bl4.y; S[dt][2] *= bl4.z; S[dt][3] *= bl4.w;
#pragma unroll
        for (int ks = 0; ks < 2; ++ks) {
          const bf16x8 kf = *(const bf16x8*)(X + (16 * dt + lr) * 144 + ks * 64 + lg * 16);
          S[dt] = MFMA(kf, vtf[ks], S[dt]);
        }
      }
    }
    __syncthreads();
  }
#undef SCAN_ISSUE
  if (!grp) {
    float* so = p.out + (KIND == 1 ? OUT_SR : OUT_SH) + ((size_t)((b * 2 + DIR) * 8 + h) * 128) * DV + sl * 64 + 16 * w + lr + (size_t)(4 * lg) * DV;
    asm volatile("" : "+v"(so));
#pragma unroll
    for (int dt = 0; dt < 8; ++dt)
#pragma unroll
      for (int r = 0; r < 4; ++r) so[(16 * dt + r) * DV] = S[dt][r];
  }
}

template <int KIND, int DIR>
__device__ __forceinline__ void scan_phase(const Params& p, unsigned char* lds, const bool dry) {
  constexpr int NSL = (KIND == 1 ? 256 : 128) / 64;
  const int ns = 64 * NSL, npr = 256 * NSL;
  const int G = VGDIM, bid = VBID;
  int it, step, end = ns + npr;
  if (G > ns) {
    if (bid < ns) { it = bid; step = end; }
    else { it = ns + (bid - ns); step = G - ns; }
  } else { it = bid; step = G; }
  for (; it < end; it += step) scan_item<KIND, DIR>(p, it, lds, dry);
}

__device__ __forceinline__ void scan_phase_ret_sample(const Params& p, unsigned char* lds, const bool dry) {
  const int G = VGDIM >> 1, bid = VBID;
  const int role = bid >= G;
  const int rb = role ? bid - G : bid;
  if (role == 0) { for (int it = rb; it < 256; it += G) scan_item<1, 0>(p, it, lds, dry); }
  else           { for (int it = rb; it < 256; it += G) scan_item<1, 1>(p, it, lds, dry); }
}
template <int DIR>
__device__ __forceinline__ void scan_phase_ret_prompt(const Params& p, unsigned char* lds, const bool dry) {
  for (int it = VBID; it < 1024; it += VGDIM) scan_item<1, DIR>(p, 256 + it, lds, dry);
}

__device__ __forceinline__ void scan_phase_hg_both(const Params& p, unsigned char* lds, const bool dry) {
  const int G = VGDIM >> 1, bid = VBID;
  const int role = bid >= G;
  const int rb = role ? bid - G : bid;
  int it, step;
  if (G > 128) {
    if (rb < 128) { it = rb; step = 1 << 20; } else { it = rb; step = G - 128; }
  } else { it = rb; step = G; }
  if (role == 0) { for (; it < 640; it += step) scan_item<2, 0>(p, it, lds, dry); }
  else           { for (; it < 640; it += step) scan_item<2, 1>(p, it, lds, dry); }
}

template <int KIND>
__device__ __forceinline__ void normgate_phase(const Params& p, const bool dry) {
  constexpr int NCH = KIND == 1 ? 4 : 2, DV = KIND == 1 ? 256 : 128, LD = KIND == 1 ? 2048 : 1024;
  const int tid = HTID, lane = tid & 63, w = tid >> 6;
  const int hh = lane >> 3, sub = lane & 7;
  bf16_t* R0 = (bf16_t*)p.ws;
  bf16_t* Ob = R0 + (KIND == 1 ? 4 * PLANE_E : 5 * PLANE_E) + hh * DV + sub * 8;
  const bf16_t* Gb = R0 + (KIND == 1 ? 0 : 4 * PLANE_E) + hh * DV + sub * 8;
  float gn[NCH][8];
#pragma unroll
  for (int j = 0; j < NCH; ++j)
#pragma unroll
    for (int i = 0; i < 8; ++i) gn[j][i] = (KIND == 1) ? 1.f : p.in[22][j * 64 + sub * 8 + i];
  for (int row = VBID * 4 + w; row < 24576; row += VGDIM * 4) {
    bf16_t* op = Ob + (size_t)row * LD;
    const bf16_t* gp = Gb + (size_t)row * LD;
    uint4 ov[NCH], gv[NCH];
#pragma unroll
    for (int j = 0; j < NCH; ++j) { ov[j] = *(const uint4*)(op + j * 64); gv[j] = *(const uint4*)(gp + j * 64); }
    if (KIND == 2 || row >= 8192) {
      const bf16_t* bp = (KIND == 2 ? hg_ob_row(p, row) : ret_ob_row(p, row - 8192)) + hh * DV + sub * 8;
#pragma unroll
      for (int j = 0; j < NCH; ++j) {
        const uint4 bv = *(const uint4*)(bp + j * 64);
        ov[j].x = pack2(lo_f(ov[j].x) + lo_f(bv.x), hi_f(ov[j].x) + hi_f(bv.x));
        ov[j].y = pack2(lo_f(ov[j].y) + lo_f(bv.y), hi_f(ov[j].y) + hi_f(bv.y));
        ov[j].z = pack2(lo_f(ov[j].z) + lo_f(bv.z), hi_f(ov[j].z) + hi_f(bv.z));
        ov[j].w = pack2(lo_f(ov[j].w) + lo_f(bv.w), hi_f(ov[j].w) + hi_f(bv.w));
      }
    }
    float ss = 0.f;
#pragma unroll
    for (int j = 0; j < NCH; ++j) {
      const unsigned wv[4] = {ov[j].x, ov[j].y, ov[j].z, ov[j].w};
#pragma unroll
      for (int i = 0; i < 4; ++i) { const float a = lo_f(wv[i]), b2 = hi_f(wv[i]); ss += a * a + b2 * b2; }
    }
    ss += __shfl_xor(ss, 1);
    ss += __shfl_xor(ss, 2);
    ss += __shfl_xor(ss, 4);
    const float rs = rsqrtf(ss * (1.f / (float)DV) + 1e-6f);
#pragma unroll
    for (int j = 0; j < NCH; ++j) {
      const unsigned wv[4] = {ov[j].x, ov[j].y, ov[j].z, ov[j].w};
      const unsigned gw[4] = {gv[j].x, gv[j].y, gv[j].z, gv[j].w};
      unsigned r[4];
#pragma unroll
      for (int i = 0; i < 4; ++i)
        r[i] = pack2(lo_f(wv[i]) * rs * gn[j][2 * i] * lo_f(gw[i]), hi_f(wv[i]) * rs * gn[j][2 * i + 1] * hi_f(gw[i]));
      if (!dry) *(uint4*)(op + j * 64) = make_uint4(r[0], r[1], r[2], r[3]);
    }
  }
}

__device__ __forceinline__ void opaque_params(Params& q) {
  asm volatile("" : "+s"(q.out), "+s"(q.ws));
#pragma unroll
  for (int i = 0; i < 23; ++i) asm volatile("" : "+s"(q.in[i]));
}

struct BarState { unsigned* base; unsigned xcd, mycnt, nact, esub, etop; };
__device__ __forceinline__ void grid_barrier(BarState& b) {
  asm volatile("s_waitcnt vmcnt(0) lgkmcnt(0)" ::: "memory");
  __syncthreads();
  if (threadIdx.x == 0) {
    b.esub += b.mycnt; b.etop += b.nact;
    const unsigned old = __hip_atomic_fetch_add(b.base + 64 * b.xcd, 1u, __ATOMIC_RELAXED, __HIP_MEMORY_SCOPE_AGENT);
    if (old + 1u == b.esub) {
      __builtin_amdgcn_fence(__ATOMIC_RELEASE, "agent");
      __hip_atomic_fetch_add(b.base + 512, 1u, __ATOMIC_RELAXED, __HIP_MEMORY_SCOPE_AGENT);
    }
    while (__hip_atomic_load(b.base + 512, __ATOMIC_RELAXED, __HIP_MEMORY_SCOPE_AGENT) < b.etop) __builtin_amdgcn_s_sleep(1);
    __builtin_amdgcn_fence(__ATOMIC_ACQUIRE, "agent");
  }
  __syncthreads();
}
__device__ __forceinline__ void bar_census_post(BarState& b) {
  if (threadIdx.x == 0) __hip_atomic_fetch_add(b.base + 1024 + 64 * b.xcd, 1u, __ATOMIC_RELAXED, __HIP_MEMORY_SCOPE_AGENT);
}
__device__ __forceinline__ void bar_census_read(BarState& b) {
  if (threadIdx.x == 0) {
    unsigned n = 0;
    for (unsigned j = 0; j < 8; ++j) {
      const unsigned c = __hip_atomic_load(b.base + 1024 + 64 * j, __ATOMIC_RELAXED, __HIP_MEMORY_SCOPE_AGENT);
      n += (c != 0u);
      if (j == b.xcd) b.mycnt = c;
    }
    b.nact = n;
  }
}
#define GSYNC(n) { if ((n) == 0) { grid.sync(); bar_census_read(bst); } else grid_barrier(bst); }

#if defined(PH_ONLY)
#define PHASE(n, call) if (n == PH_ONLY) { const bool dry = false; call; }
#elif defined(REP_N)
#define PHASE(n, call) if (lo <= n && n < hi) { for (int rep = (n == REP_N ? 0 : 1); rep < 2; ++rep) { const bool dry = (rep == 0); call; if (!(fin && n + 1 == hi && rep == 1)) GSYNC(n) } }
#else
#define PHASE(n, call) if (lo <= n && n < hi) { const bool dry = false; call; if (!(fin && n + 1 == hi)) GSYNC(n) }
#endif

__device__ __forceinline__ void run_range(const Params& q, int lo, int hi, bool fin, cg::grid_group& grid, unsigned char* lds) {
  unsigned char* ldh = lds + HALFID * HALF_LDS;
  BarState bst; bst.base = (unsigned*)(q.ws + OFF_MISC + MISC_CTR); bst.xcd = xcc_id(); bst.mycnt = 0; bst.nact = 0; bst.esub = 0; bst.etop = 0;
  if (lo == 0) bar_census_post(bst);
  PHASE(0, phase0(q, ldh))
  PHASE(1, post_phase(q, -1, 0, ldh, dry))
  PHASE(2, gemm_phase(q, 0, GM_IN_DA, lds, 2))
  PHASE(3, attn_phase(q, 0, lds, dry, 3))
  PHASE(4, gemm_phase(q, 0, GM_OUT, lds, 4))
  PHASE(5, post_phase(q, 0, 1, ldh, dry))
  PHASE(6, gemm_phase(q, 1, GM_IN_RET_QKV, lds, 6))
  PHASE(7, scan_phase_ret_sample(q, ldh, dry))
  PHASE(8, scan_phase_ret_prompt<0>(q, ldh, dry))
  PHASE(8, scan_phase_ret_prompt<1>(q, ldh, dry))
  PHASE(9, gemm_phase(q, 1, GM_IN_RET_G, lds, 9))
  PHASE(10, normgate_phase<1>(q, dry))
  PHASE(11, gemm_phase(q, 1, GM_OUT, lds, 11))
  PHASE(12, post_phase(q, 1, 2, ldh, dry))
  PHASE(13, gemm_phase(q, 2, GM_IN_HG, lds, 13))
  PHASE(14, scan_phase_hg_both(q, ldh, dry))
  PHASE(16, normgate_phase<2>(q, dry))
  PHASE(17, gemm_phase(q, 2, GM_OUT, lds, 17))
  PHASE(18, post_phase(q, 2, 3, ldh, dry))
  PHASE(19, gemm_phase(q, 3, GM_IN_DA, lds, 19))
  PHASE(20, attn_phase(q, 3, lds, dry, 20))
  PHASE(21, gemm_phase(q, 3, GM_OUT, lds, 21))
  PHASE(22, post_phase(q, 3, 4, ldh, dry))
}

__global__ void __launch_bounds__(NTHR, 2) mega_fwd(Params p) {
  extern __shared__ __attribute__((aligned(16))) unsigned char lds[];
  cg::grid_group grid = cg::this_grid();
  run_range(p, p.ph_lo, p.ph_hi, true, grid, lds);
}

extern "C" void kernel_launch(void* const* d_in, const int* in_sizes, int n_in, void* d_out, int out_size, void* d_ws, size_t ws_size, hipStream_t stream) {
  static int grid_blocks = 0;
  if (grid_blocks == 0) {
    int dev = 0, cus = 0, per_cu = 0;
    hipGetDevice(&dev);
    hipDeviceGetAttribute(&cus, hipDeviceAttributeMultiprocessorCount, dev);
    hipFuncSetAttribute((const void*)mega_fwd, hipFuncAttributeMaxDynamicSharedMemorySize, LDS_BYTES);
    hipOccupancyMaxActiveBlocksPerMultiprocessor(&per_cu, (const void*)mega_fwd, NTHR, LDS_BYTES);
    if (per_cu < 1) per_cu = 1;
    if (per_cu > 1) per_cu = 1;
    if (cus < 1) cus = 256;
    grid_blocks = cus * per_cu;
    (void)hipGetLastError();
    if (n_in != 23 || ws_size < WS_NEED) { fprintf(stderr, "kernel_launch: unexpected n_in %d / ws_size %zu (need %zu)\n", n_in, ws_size, (size_t)WS_NEED); }
  }
  hipMemsetAsync((unsigned char*)d_ws + OFF_MISC + MISC_CTR, 0, 8192, stream);
  Params p{};
  for (int i = 0; i < 23; ++i) p.in[i] = (const float*)d_in[i];
  p.out = (float*)d_out;
  p.ws = (unsigned char*)d_ws;
#if ONE_LAUNCH
  p.ph_lo = 0; p.ph_hi = NPH;
  void* args[] = {&p};
  hipError_t e = hipLaunchCooperativeKernel((const void*)mega_fwd, dim3(grid_blocks), dim3(NTHR), args, LDS_BYTES, stream);
  if (e != hipSuccess) fprintf(stderr, "cooperative launch failed: %s (grid %d)\n", hipGetErrorString(e), grid_blocks);
#else
  for (int ph = 0; ph < NPH; ++ph) {
    p.ph_lo = ph; p.ph_hi = ph + 1;
    hipLaunchKernelGGL(mega_fwd, dim3(grid_blocks), dim3(NTHR), LDS_BYTES, stream, p);
  }
#endif
}
```

```cpp
#include <hip/hip_runtime.h>
#include <hip/hip_cooperative_groups.h>
#include <cstdint>
#include <cstdio>
namespace cg = cooperative_groups;

#ifndef ONE_LAUNCH
#define ONE_LAUNCH 1
#endif

typedef unsigned short bf16_t;
typedef short bf16x8 __attribute__((ext_vector_type(8)));
typedef float f32x4 __attribute__((ext_vector_type(4)));

#define NTHR 512
#define HTID ((int)(threadIdx.x & 255))
#define HALFID ((int)(threadIdx.x >> 8))
#define VBID ((int)(blockIdx.x * 2 + (threadIdx.x >> 8)))
#define VGDIM ((int)(gridDim.x * 2))
#define HALF_LDS 74816
#define MIB ((size_t)1 << 20)
#define NPH 23
#define LDS_BYTES (2 * HALF_LDS)
#define LDS_SLOT 74752
#define MISC_CTR (MISC_ROPE + 524288)

#define OFF_WIN  (288 * MIB)
#define OFF_WOUT (300 * MIB)
#define OFF_HP   (304 * MIB)
#define OFF_MISC (320 * MIB)
#define MISC_ROPE 524288
#define WS_NEED  (322 * MIB)
#define PLANE_E  ((size_t)25165824)
#define OUT_YP 0
#define OUT_YS 8388608
#define OUT_CK 25165824
#define OUT_CV 41943040
#define OUT_SR 58720256
#define OUT_SH 75497472

struct Params {
  const float* in[23];
  float* out;
  unsigned char* ws;
  int ph_lo, ph_hi;
};

struct LayerInfo { int kind, slot, IN, WIDTH; const float* w_in; const float* w_out; };

__device__ __forceinline__ LayerInfo layer_info(const Params& p, int l) {
  LayerInfo L;
  if (l == 0)      { L.kind = 0; L.slot = 0; L.IN = 4096; L.WIDTH = 1024; L.w_in = p.in[12]; L.w_out = p.in[13]; }
  else if (l == 1) { L.kind = 1; L.slot = 0; L.IN = 6144; L.WIDTH = 2048; L.w_in = p.in[16]; L.w_out = p.in[17]; }
  else if (l == 2) { L.kind = 2; L.slot = 0; L.IN = 5120; L.WIDTH = 1024; L.w_in = p.in[19]; L.w_out = p.in[20]; }
  else             { L.kind = 0; L.slot = 1; L.IN = 4096; L.WIDTH = 1024; L.w_in = p.in[12] + (size_t)1024 * 4096; L.w_out = p.in[13] + (size_t)1024 * 1024; }
  return L;
}
__device__ __forceinline__ bf16_t* hs_ptr(const Params& p, int l) {
  return l < 3 ? (bf16_t*)(p.out + OUT_SH) : (bf16_t*)(p.ws + 240 * MIB);
}

typedef __bf16 nbf16x2 __attribute__((ext_vector_type(2)));
typedef float f32x2 __attribute__((ext_vector_type(2)));
__device__ __forceinline__ float bf2f(unsigned h) { return __uint_as_float(h << 16); }
__device__ __forceinline__ unsigned pack2(float a, float b) { const f32x2 f = {a, b}; return __builtin_bit_cast(unsigned, __builtin_convertvector(f, nbf16x2)); }
__device__ __forceinline__ float lo_f(unsigned w) { return __uint_as_float(w << 16); }
__device__ __forceinline__ float hi_f(unsigned w) { return __uint_as_float(w & 0xffff0000u); }
__device__ __forceinline__ float silu_f(float x) { return x / (1.f + __expf(-x)); }
__device__ __forceinline__ float wave_sum(float v) {
#pragma unroll
  for (int o = 32; o > 0; o >>= 1) v += __shfl_xor(v, o);
  return v;
}
#define QSCALE 0.18033688011112042f
#define SB __builtin_amdgcn_sched_barrier(0)
#define MFMA(a, b, c) __builtin_amdgcn_mfma_f32_16x16x32_bf16((a), (b), (c), 0, 0, 0)

__device__ __forceinline__ void convT_tile(const float* __restrict__ src, int src_ld, bf16_t* __restrict__ dst, int dst_ld, unsigned char* lds) {
  float* t = (float*)lds;
  const int tid = HTID;
  const int kr = tid >> 4, nc = (tid & 15) * 4;
#pragma unroll
  for (int j = 0; j < 4; ++j) {
    const float4 v = *(const float4*)(src + (size_t)(kr + 16 * j) * src_ld + nc);
    float* tp = t + (kr + 16 * j) * 65 + nc;
    tp[0] = v.x; tp[1] = v.y; tp[2] = v.z; tp[3] = v.w;
  }
  __syncthreads();
  const int n = tid >> 2, kc = (tid & 3) * 16;
  unsigned w[8];
#pragma unroll
  for (int i = 0; i < 8; ++i) w[i] = pack2(t[(kc + 2 * i) * 65 + n], t[(kc + 2 * i + 1) * 65 + n]);
  uint4* d = (uint4*)(dst + (size_t)n * dst_ld + kc);
  d[0] = make_uint4(w[0], w[1], w[2], w[3]);
  d[1] = make_uint4(w[4], w[5], w[6], w[7]);
  __syncthreads();
}

__device__ __forceinline__ int conv_weights_count(const Params& p, int l) {
  const LayerInfo L = layer_info(p, l);
  return (L.IN / 64) * 16 + (L.WIDTH / 64) * 16;
}
__device__ __forceinline__ void conv_weights_item(const Params& p, int l, int it, unsigned char* lds) {
  const LayerInfo L = layer_info(p, l);
  const int nin = (L.IN / 64) * 16;
  if (it < nin) {
    const int kt = it & 15, nt = it >> 4;
    convT_tile(L.w_in + (size_t)(kt * 64) * L.IN + nt * 64, L.IN, (bf16_t*)(p.ws + OFF_WIN) + (size_t)(nt * 64) * 1024 + kt * 64, 1024, lds);
  } else {
    const int it2 = it - nin, nkt = L.WIDTH / 64;
    const int kt = it2 % nkt, nt = it2 / nkt;
    convT_tile(L.w_out + (size_t)(kt * 64) * 1024 + nt * 64, 1024, (bf16_t*)(p.ws + OFF_WOUT) + (size_t)(nt * 64) * L.WIDTH + kt * 64, L.WIDTH, lds);
  }
}

__device__ __forceinline__ void mod_item(const Params& p, int it, unsigned char* lds) {
  float* ssilu = (float*)lds;
  float* red = ssilu + 9 * 1024;
  const int tid = HTID;
  const int l = it / 48, col0 = (it % 48) * 64;
  for (int i = tid; i < 9 * 1024; i += 256) {
    const int v = i >> 10, k = i & 1023;
    const float x = (v == 0) ? p.in[7][k] : p.in[6][(v - 1) * 1024 + k];
    ssilu[i] = silu_f(x);
  }
  __syncthreads();
  const int col = tid & 63, kq = tid >> 6;
  const float* w = p.in[8] + (size_t)l * 1024 * 3072 + col0 + col;
  float acc[9];
#pragma unroll
  for (int v = 0; v < 9; ++v) acc[v] = 0.f;
  for (int k = kq * 256; k < kq * 256 + 256; ++k) {
    const float wv = w[(size_t)k * 3072];
#pragma unroll
    for (int v = 0; v < 9; ++v) acc[v] += ssilu[v * 1024 + k] * wv;
  }
#pragma unroll
  for (int v = 0; v < 9; ++v) red[(kq * 9 + v) * 64 + col] = acc[v];
  __syncthreads();
  float* mod = (float*)(p.ws + OFF_MISC);
  for (int i = tid; i < 9 * 64; i += 256) {
    const int v = i >> 6, cc = i & 63;
    const float s = red[(0 * 9 + v) * 64 + cc] + red[(1 * 9 + v) * 64 + cc] + red[(2 * 9 + v) * 64 + cc] + red[(3 * 9 + v) * 64 + cc];
    mod[(size_t)(l * 9 + v) * 3072 + col0 + cc] = s + p.in[9][l * 3072 + col0 + cc];
  }
  __syncthreads();
}

__device__ __forceinline__ void rope_item(const Params& p, int it) {
  const int idx = it * 256 + HTID;
  const int t = idx >> 5, pp = idx & 31;
  const int pos = pp < 16 ? (t >> 6) : (t & 63);
  const float inv = exp2f(-(float)(pp & 15) * (13.287712379549449f / 16.f));
  const float ang = (float)pos * inv;
  const double a = (double)ang;
  const double r = a - 6.283185307179586 * rint(a * 0.15915494309189535);
  const float rf = (float)r;
  float2* tab = (float2*)(p.ws + OFF_MISC + MISC_ROPE);
  tab[idx] = make_float2(__cosf(rf), __sinf(rf));
}

__device__ __forceinline__ void phase0(const Params& p, unsigned char* lds) {
  const int nw = conv_weights_count(p, 0);
  const int total = 192 + 256 + nw;
  for (int it = VBID; it < total; it += VGDIM) {
    if (it < 192) mod_item(p, it, lds);
    else if (it < 448) rope_item(p, it - 192);
    else conv_weights_item(p, 0, it - 448, lds);
  }
}

__device__ __forceinline__ void post_phase(const Params& p, int lprev, int lnext, unsigned char* lds, const bool dry) {
  const int tid = HTID, lane = tid & 63, w = tid >> 6;
  const float* mod = (const float*)(p.ws + OFF_MISC);
  const bf16_t* Y = nullptr;
  if (lprev >= 0) {
    const int kind = layer_info(p, lprev).kind;
    Y = (const bf16_t*)(p.ws + (kind == 1 ? 96 * MIB : 0));
  }
  bf16_t* hp = (bf16_t*)(p.ws + OFF_HP);
  bf16_t* hs = lnext < 4 ? hs_ptr(p, lnext) : nullptr;
  for (int row = VBID * 4 + w; row < 24576; row += VGDIM * 4) {
    const int mv = row < 8192 ? 0 : 1 + ((row - 8192) >> 11);
    const float* xs = (lprev <= 0) ? (row < 8192 ? p.in[0] + (size_t)row * 1024 : p.in[1] + (size_t)(row - 8192) * 1024) : p.out + (size_t)row * 1024;
    float4 x[4];
#pragma unroll
    for (int j = 0; j < 4; ++j) x[j] = *(const float4*)(xs + lane * 4 + 256 * j);
    if (lprev >= 0) {
      float4 y[4];
      float ss = 0.f;
#pragma unroll
      for (int j = 0; j < 4; ++j) { const uint2 yw = *(const uint2*)(Y + (size_t)row * 1024 + lane * 4 + 256 * j); y[j] = make_float4(lo_f(yw.x), hi_f(yw.x), lo_f(yw.y), hi_f(yw.y)); ss += y[j].x * y[j].x + y[j].y * y[j].y + y[j].z * y[j].z + y[j].w * y[j].w; }
      ss = wave_sum(ss);
      const float rstd = rsqrtf(ss * (1.f / 1024.f) + 1e-6f);
      const float* ga = mod + (size_t)(lprev * 9 + mv) * 3072 + 2048;
      const float* gp = p.in[11] + lprev * 1024;
#pragma unroll
      for (int j = 0; j < 4; ++j) {
        const int c = lane * 4 + 256 * j;
        const float4 g4 = *(const float4*)(ga + c), p4 = *(const float4*)(gp + c);
        x[j].x += g4.x * (y[j].x * rstd * p4.x); x[j].y += g4.y * (y[j].y * rstd * p4.y);
        x[j].z += g4.z * (y[j].z * rstd * p4.z); x[j].w += g4.w * (y[j].w * rstd * p4.w);
        if (!dry) *(float4*)(p.out + (size_t)row * 1024 + c) = x[j];
      }
    }
    if (lnext < 4) {
      float ss = 0.f;
#pragma unroll
      for (int j = 0; j < 4; ++j) ss += x[j].x * x[j].x + x[j].y * x[j].y + x[j].z * x[j].z + x[j].w * x[j].w;
      ss = wave_sum(ss);
      const float rstd = rsqrtf(ss * (1.f / 1024.f) + 1e-6f);
      const float* sh = mod + (size_t)(lnext * 9 + mv) * 3072;
      const float* sc = sh + 1024;
      const float* gp = p.in[10] + lnext * 1024;
      bf16_t* hd = row < 8192 ? hp + (size_t)row * 1024 : hs + (size_t)(row - 8192) * 1024;
#pragma unroll
      for (int j = 0; j < 4; ++j) {
        const int c = lane * 4 + 256 * j;
        const float4 s4 = *(const float4*)(sh + c), c4 = *(const float4*)(sc + c), p4 = *(const float4*)(gp + c);
        const float h0 = x[j].x * rstd * p4.x * (1.f + c4.x) + s4.x, h1 = x[j].y * rstd * p4.y * (1.f + c4.y) + s4.y;
        const float h2 = x[j].z * rstd * p4.z * (1.f + c4.z) + s4.z, h3 = x[j].w * rstd * p4.w * (1.f + c4.w) + s4.w;
        *(uint2*)(hd + c) = make_uint2(pack2(h0, h1), pack2(h2, h3));
      }
    }
  }
  if (lprev >= 0 && lnext < 4) {
    const int nw = conv_weights_count(p, lnext);
    for (int it = VBID; it < nw; it += VGDIM) conv_weights_item(p, lnext, it, lds);
  }
}


__device__ __forceinline__ unsigned xcc_id() { return (unsigned)__builtin_amdgcn_s_getreg((3 << 11) | 20) & 7u; }
__device__ __forceinline__ bool wq_next(unsigned* ctr, int nst, int mult, unsigned xcd, int& qstate, int& q, int& idx, unsigned char* lds) {
  volatile int* slot = (volatile int*)(lds + LDS_SLOT);
  __syncthreads();
  if (HTID == 0) {
    int qq = -1, ii = 0, st = qstate;
    while (st < 8) {
      const int cand = (int)((xcd + (unsigned)st) & 7u);
      const int got = (int)atomicAdd(ctr + cand, 1u);
      if (got < mult * ((nst - cand + 7) >> 3)) { qq = cand; ii = got; break; }
      ++st;
    }
    slot[0] = qq; slot[1] = ii; slot[2] = st;
  }
  __syncthreads();
  q = slot[0]; idx = slot[1]; qstate = slot[2];
  return q >= 0;
}

#define LAS __attribute__((address_space(3)))
template <bool SWAP>
__device__ __forceinline__ void gemm_tile_compute(const bf16_t* __restrict__ Ag, const bf16_t* __restrict__ Bg, int K, unsigned char* lds, f32x4 (&acc)[8][4],
                                                  const bool pre, const bf16_t* __restrict__ An, const bf16_t* __restrict__ Bn, const bool hasn) {
  const int tid = threadIdx.x, lane = tid & 63, wid = __builtin_amdgcn_readfirstlane(tid >> 6), wm = wid >> 2, wn = wid & 3;
  const int lr = lane & 15, lg = lane >> 4;
  LAS unsigned char* l3 = (LAS unsigned char*)lds;
  const int prow = lane >> 3;
  const int pgo0 = prow * K + (((lane & 7) ^ ((prow >> 1) & 7)) << 3);
  const int pgo1 = prow * K + (((lane & 7) ^ ((4 + (prow >> 1)) & 7)) << 3);
  const bf16_t* asrc = Ag + (size_t)(wid * 32) * K;
  const bf16_t* bsrc = Bg + (size_t)(wid * 32) * K;
  const size_t pstep = (size_t)8 * K;
#pragma unroll
  for (int mi = 0; mi < 8; ++mi)
#pragma unroll
    for (int ni = 0; ni < 4; ++ni) acc[mi][ni] = (f32x4){0.f, 0.f, 0.f, 0.f};
#define GEMM_STAGE_P(ap_, bp_, s, k0)                                                                                                      \
  {                                                                                                                                        \
    _Pragma("unroll") for (int j = 0; j < 4; ++j) {                                                                                        \
      __builtin_amdgcn_global_load_lds((const unsigned*)((ap_) + j * pstep + ((j & 1) ? pgo1 : pgo0) + (k0)), (LAS unsigned*)(l3 + (s) * 65536 + (wid * 4 + j) * 1024), 16, 0, 0);          \
      __builtin_amdgcn_global_load_lds((const unsigned*)((bp_) + j * pstep + ((j & 1) ? pgo1 : pgo0) + (k0)), (LAS unsigned*)(l3 + (s) * 65536 + 32768 + (wid * 4 + j) * 1024), 16, 0, 0);  \
    }                                                                                                                                      \
  }
#define GEMM_STAGE(s, k0) GEMM_STAGE_P(asrc, bsrc, s, k0)
  const int nk = K >> 6;
  if (!pre) GEMM_STAGE(0, 0);
  asm volatile("s_waitcnt vmcnt(0)" ::: "memory");
  __syncthreads();
  const int x0 = lg ^ ((lr >> 1) & 7);
  const int aoff0 = (wm * 128 + lr) * 128 + x0 * 16, aoff1 = (wm * 128 + lr) * 128 + (x0 ^ 4) * 16;
  const int boff0 = 32768 + (wn * 64 + lr) * 128 + x0 * 16, boff1 = 32768 + (wn * 64 + lr) * 128 + (x0 ^ 4) * 16;
  for (int kt = 0; kt < nk; ++kt) {
    if (kt + 1 < nk) GEMM_STAGE((kt + 1) & 1, (kt + 1) * 64);
    const unsigned char* st = lds + (kt & 1) * 65536;
#pragma unroll
    for (int kk = 0; kk < 2; ++kk) {
      bf16x8 af[8], bfr[4];
#pragma unroll
      for (int ni = 0; ni < 4; ++ni) bfr[ni] = *(const bf16x8*)(st + (kk ? boff1 : boff0) + ni * 2048);
#pragma unroll
      for (int mi = 0; mi < 8; ++mi) af[mi] = *(const bf16x8*)(st + (kk ? aoff1 : aoff0) + mi * 2048);
#pragma unroll
      for (int mi = 0; mi < 8; ++mi)
#pragma unroll
        for (int ni = 0; ni < 4; ++ni)
          acc[mi][ni] = SWAP ? MFMA(bfr[ni], af[mi], acc[mi][ni]) : MFMA(af[mi], bfr[ni], acc[mi][ni]);
    }
    asm volatile("s_waitcnt vmcnt(0)" ::: "memory");
    __syncthreads();
  }
  if (hasn) { const bf16_t* an_ = An + (size_t)(wid * 32) * K; const bf16_t* bn_ = Bn + (size_t)(wid * 32) * K; GEMM_STAGE_P(an_, bn_, 0, 0); }
#undef GEMM_STAGE
#undef GEMM_STAGE_P
}

enum { GM_IN_DA = 0, GM_IN_RET_QKV = 1, GM_IN_RET_G = 2, GM_IN_HG = 3, GM_OUT = 4 };

__device__ __forceinline__ void epi_swapped(const Params& p, int mode, int slot, int ykind, int m, int n, f32x4 v) {
  bf16_t* R0 = (bf16_t*)p.ws;
  if (mode == GM_OUT) {
    bf16_t* Y = (bf16_t*)(p.ws + (ykind == 1 ? 96 * MIB : 0));
    *(uint2*)(Y + (size_t)m * 1024 + n) = make_uint2(pack2(v[0], v[1]), pack2(v[2], v[3]));
  } else if (mode == GM_IN_DA) {
    const bool smp = m >= 8192;
    const int ms = m - 8192;
    const int b = smp ? (ms >> 11) : (m >> 8), t = smp ? (ms & 2047) : (m & 255);
    if (n < 2048) {
      if (smp) {
        const float4 cs = *(const float4*)((const float*)(p.ws + OFF_MISC + MISC_ROPE) + (size_t)(t * 32 + ((n & 63) >> 1)) * 2);
        const float a0 = v[0] * cs.x - v[1] * cs.y, a1 = v[0] * cs.y + v[1] * cs.x;
        const float a2 = v[2] * cs.z - v[3] * cs.w, a3 = v[2] * cs.w + v[3] * cs.z;
        v = (f32x4){a0, a1, a2, a3};
      }
      if (n < 1024) {
        *(uint2*)(R0 + (size_t)m * 1024 + n) = make_uint2(pack2(v[0] * QSCALE, v[1] * QSCALE), pack2(v[2] * QSCALE, v[3] * QSCALE));
      } else {
        const int c = n - 1024;
        const uint2 pk = make_uint2(pack2(v[0], v[1]), pack2(v[2], v[3]));
        if (smp) {
          *(uint2*)(R0 + 64 * MIB / 2 + ((size_t)b * 2560 + t) * 1024 + c) = pk;
        } else {
          *(f32x4*)(p.out + OUT_CK + ((size_t)((b * 2 + slot) * 256 + t)) * 1024 + c) = v;
          *(uint2*)(R0 + 48 * MIB / 2 + (size_t)m * 1024 + c) = pk;
        }
      }
    } else {
      *(uint2*)(R0 + 160 * MIB / 2 + (size_t)m * 1024 + (n - 3072)) = make_uint2(pack2(silu_f(v[0]), silu_f(v[1])), pack2(silu_f(v[2]), silu_f(v[3])));
    }
  } else if (mode == GM_IN_RET_QKV) {
    if (n < 1024) *(uint2*)(R0 + (size_t)m * 1024 + n) = make_uint2(pack2(v[0], v[1]), pack2(v[2], v[3]));
    else if (n < 2048) { const float s = 0.08838834764831845f; *(uint2*)(R0 + PLANE_E + (size_t)m * 1024 + (n - 1024)) = make_uint2(pack2(v[0] * s, v[1] * s), pack2(v[2] * s, v[3] * s)); }
    else *(uint2*)(R0 + 2 * PLANE_E + (size_t)m * 2048 + (n - 2048)) = make_uint2(pack2(v[0], v[1]), pack2(v[2], v[3]));
  } else if (mode == GM_IN_RET_G) {
    *(uint2*)(R0 + (size_t)m * 2048 + n) = make_uint2(pack2(silu_f(v[0]), silu_f(v[1])), pack2(silu_f(v[2]), silu_f(v[3])));
  } else {
    if (n < 1024 || n >= 4096) v = (f32x4){silu_f(v[0]), silu_f(v[1]), silu_f(v[2]), silu_f(v[3])};
    *(uint2*)(R0 + (size_t)(n >> 10) * PLANE_E + (size_t)m * 1024 + (n & 1023)) = make_uint2(pack2(v[0], v[1]), pack2(v[2], v[3]));
  }
}

__device__ __forceinline__ void epi_da_v(const Params& p, int slot, int m, int n, f32x4 v) {
  bf16_t* R0 = (bf16_t*)p.ws;
  const int c = n - 2048, hh = c >> 7, e = c & 127;
  const uint2 pk = make_uint2(pack2(v[0], v[1]), pack2(v[2], v[3]));
  if (m >= 8192) {
    const int ms = m - 8192, b = ms >> 11, t = ms & 2047;
    *(uint2*)(R0 + 120 * MIB / 2 + ((size_t)((b * 8 + hh) * 128 + e)) * 2560 + t) = pk;
  } else {
    const int b = m >> 8, t = m & 255;
    float* o = p.out + OUT_CV + ((size_t)((b * 2 + slot) * 256 + t)) * 1024 + c;
    o[0] = v[0]; o[1024] = v[1]; o[2048] = v[2]; o[3072] = v[3];
    *(uint2*)(R0 + 104 * MIB / 2 + ((size_t)((b * 8 + hh) * 128 + e)) * 256 + t) = pk;
  }
}

__device__ __forceinline__ void gemm_phase(const Params& p, int l, int mode, unsigned char* lds, int phid) {
  const LayerInfo L = layer_info(p, l);
  bf16_t* R0 = (bf16_t*)p.ws;
  const bf16_t *Ap, *As, *Bt;
  int K, N;
  if (mode == GM_OUT) {
    K = L.WIDTH; N = 1024; Bt = (const bf16_t*)(p.ws + OFF_WOUT);
    const bf16_t* base = R0 + (L.kind == 0 ? 160 * MIB / 2 : (L.kind == 1 ? 4 * PLANE_E : 5 * PLANE_E));
    Ap = base; As = base + (size_t)8192 * K;
  } else {
    K = 1024; Ap = (const bf16_t*)(p.ws + OFF_HP); As = hs_ptr(p, l);
    Bt = (const bf16_t*)(p.ws + OFF_WIN) + (mode == GM_IN_RET_G ? (size_t)4096 * 1024 : 0);
    N = (mode == GM_IN_DA || mode == GM_IN_RET_QKV) ? 4096 : (mode == GM_IN_RET_G ? 2048 : 5120);
  }
  const int ntn = N >> 8, ntiles = 96 * ntn;
  const int extra = (mode == GM_IN_DA) ? 3072 : 0;
  const int tid = threadIdx.x, lane = tid & 63, wid = tid >> 6, wm = wid >> 2, wn = wid & 3, lr = lane & 15, lg = lane >> 4;
  const int G = gridDim.x;
  const bool swz = (G & 7) == 0;
  const int xcd = blockIdx.x & 7, snn = ntn >> 2, nst = 12 * snn;
  const int q0 = swz ? (int)(blockIdx.x >> 3) : (int)blockIdx.x, qstep = swz ? (G >> 3) : G;
  const int qlen = swz ? 32 * ((nst - xcd + 7) >> 3) : ntiles;
#define GEMM_TILE_OF(qq, m0_, n0_)                                                   \
  {                                                                                    \
    int it_ = (qq);                                                                    \
    if (swz) {                                                                         \
      const int st_ = xcd + 8 * ((qq) >> 5), tin_ = (qq) & 31;                         \
      const int smt_ = st_ / snn, snt_ = st_ - smt_ * snn;                             \
      it_ = (smt_ * 8 + (tin_ >> 2)) * ntn + snt_ * 4 + (tin_ & 3);                    \
    }                                                                                  \
    const int mt_ = it_ / ntn;                                                         \
    m0_ = mt_ * 256; n0_ = (it_ - mt_ * ntn) * 256;                                    \
  }
  bool pre = false;
  for (int q = q0; q < qlen; q += qstep) {
    int m0, n0;
    GEMM_TILE_OF(q, m0, n0)
    const bf16_t* A = m0 < 8192 ? Ap + (size_t)m0 * K : As + (size_t)(m0 - 8192) * K;
    const bf16_t* B = Bt + (size_t)n0 * K;
    const bool hasn = q + qstep < qlen;
    const bf16_t *An = A, *Bn = B;
    if (hasn) {
      int m1, n1;
      GEMM_TILE_OF(q + qstep, m1, n1)
      An = m1 < 8192 ? Ap + (size_t)m1 * K : As + (size_t)(m1 - 8192) * K;
      Bn = Bt + (size_t)n1 * K;
    }
    {
      f32x4 acc[8][4];
      if (mode == GM_IN_DA && n0 >= 2048 && n0 < 3072) {
        gemm_tile_compute<false>(A, B, K, lds, acc, pre, An, Bn, hasn);
#pragma unroll
        for (int mi = 0; mi < 8; ++mi)
#pragma unroll
          for (int ni = 0; ni < 4; ++ni)
            epi_da_v(p, L.slot, m0 + wm * 128 + mi * 16 + 4 * lg, n0 + wn * 64 + ni * 16 + lr, acc[mi][ni]);
      } else {
        gemm_tile_compute<true>(A, B, K, lds, acc, pre, An, Bn, hasn);
#pragma unroll
        for (int mi = 0; mi < 8; ++mi)
#pragma unroll
          for (int ni = 0; ni < 4; ++ni)
            epi_swapped(p, mode, L.slot, L.kind, m0 + wm * 128 + mi * 16 + lr, n0 + wn * 64 + ni * 16 + 4 * lg, acc[mi][ni]);
      }
    }
    pre = hasn;
  }
#undef GEMM_TILE_OF
  if (extra) { asm volatile("s_waitcnt vmcnt(0)" ::: "memory"); __syncthreads(); }
  for (int ci = VBID; ci < extra; ci += VGDIM) {
    {
      if (ci < 2048) {
        const int idx = (ci * 256 + HTID) * 8;
        const int b = idx >> 19, rem = idx & 524287, tp = rem >> 10, c = rem & 1023;
        const float* src = p.in[2] + ((size_t)((b * 2 + L.slot) * 512 + tp)) * 1024 + c;
        const float4 u0 = *(const float4*)src, u1 = *(const float4*)(src + 4);
        *(uint4*)(R0 + 64 * MIB / 2 + ((size_t)b * 2560 + 2048 + tp) * 1024 + c) = make_uint4(pack2(u0.x, u0.y), pack2(u0.z, u0.w), pack2(u1.x, u1.y), pack2(u1.z, u1.w));
      } else {
        const int i2 = ci - 2048;
        const int b = i2 >> 7, hh = (i2 >> 4) & 7, tt = (i2 >> 1) & 7, et = i2 & 1;
        convT_tile(p.in[3] + ((size_t)((b * 2 + L.slot) * 512 + tt * 64)) * 1024 + hh * 128 + et * 64, 1024,
                   R0 + 120 * MIB / 2 + ((size_t)((b * 8 + hh) * 128 + et * 64)) * 2560 + 2048 + tt * 64, 2560, lds + HALFID * HALF_LDS);
      }
    }
  }
}

__device__ __forceinline__ void attn_phase(const Params& p, int l, unsigned char* lds, const bool dry, int phid) {
  const int slot = l == 3 ? 1 : 0;
  const float lam_init = 0.8f - 0.6f * expf(-0.3f * (float)l);
  const int tid = threadIdx.x, lane = tid & 63, w = tid >> 6, lr = lane & 15, lg = lane >> 4;
  float lam;
  {
    const float* lf = p.in[14] + slot * 256;
    const float a = wave_sum(lf[lane] * lf[64 + lane]);
    const float b2 = wave_sum(lf[128 + lane] * lf[192 + lane]);
    lam = expf(a) - expf(b2) + lam_init;
  }
  bf16_t* R0 = (bf16_t*)p.ws;
  const float* subg = p.in[15] + slot * 128;
  for (int item = blockIdx.x; item < 1536; item += gridDim.x) {
    int grp, b, h, qt;
    if (item < 1024) { grp = 1; b = item >> 7; h = (item >> 4) & 7; qt = item & 15; }
    else { const int i2 = item - 1024; grp = 0; b = i2 >> 4; h = (i2 >> 1) & 7; qt = i2 & 1; }
    const int nkeys = grp ? 2560 : 256, ntile = nkeys >> 6;
    const int mq = (grp ? 8192 + b * 2048 : b * 256) + qt * 128 + w * 16 + lr;
    const bf16_t* Kg = grp ? R0 + 64 * MIB / 2 + (size_t)b * 2560 * 1024 + h * 128 : R0 + 48 * MIB / 2 + (size_t)b * 256 * 1024 + h * 128;
    const bf16_t* Vg = grp ? R0 + 120 * MIB / 2 + (size_t)(b * 8 + h) * 128 * 2560 : R0 + 104 * MIB / 2 + (size_t)(b * 8 + h) * 128 * 256;
    bf16x8 qf[2][2];
#pragma unroll
    for (int sub = 0; sub < 2; ++sub)
#pragma unroll
      for (int ks = 0; ks < 2; ++ks) qf[sub][ks] = *(const bf16x8*)(R0 + (size_t)mq * 1024 + h * 128 + sub * 64 + ks * 32 + lg * 8);
    LAS unsigned char* l3 = (LAS unsigned char*)lds;
    const int wu = __builtin_amdgcn_readfirstlane(w);
    int koff[2], voff[2];
#pragma unroll
    for (int j = 0; j < 2; ++j) {
      const int kr = (wu * 2 + j) * 4 + (lane >> 4);
      koff[j] = kr * 1024 + (((lane & 15) ^ (kr & 15)) << 3);
      const int er = (wu * 2 + j) * 8 + (lane >> 3);
      voff[j] = er * nkeys + (((lane & 7) ^ ((er >> 1) & 7)) << 3);
    }
#define ATT_STAGE_K(s, key0)                                                                                  \
  {                                                                                                           \
    _Pragma("unroll") for (int j = 0; j < 2; ++j)                                                             \
      __builtin_amdgcn_global_load_lds((const unsigned*)(Kg + (size_t)(key0) * 1024 + koff[j]), (LAS unsigned*)(l3 + (s) * 32768 + (wu * 2 + j) * 1024), 16, 0, 0); \
  }
#define ATT_STAGE_V(s, key0)                                                                                  \
  {                                                                                                           \
    _Pragma("unroll") for (int j = 0; j < 2; ++j)                                                             \
      __builtin_amdgcn_global_load_lds((const unsigned*)(Vg + (key0) + voff[j]), (LAS unsigned*)(l3 + (s) * 32768 + 16384 + (wu * 2 + j) * 1024), 16, 0, 0); \
  }
    const int xl = lg ^ lr;
    const int vsw = (lr >> 1) & 7;
    const int vlo = lr * 128 + ((((lg >> 1)) ^ vsw) << 4) + (lg & 1) * 8;
    float mx[2] = {-1e30f, -1e30f}, ls[2] = {0.f, 0.f};
    f32x4 o0[8], o1[8];
#pragma unroll
    for (int et = 0; et < 8; ++et) { o0[et] = (f32x4){0.f, 0.f, 0.f, 0.f}; o1[et] = (f32x4){0.f, 0.f, 0.f, 0.f}; }
    ATT_STAGE_K(0, 0);
    ATT_STAGE_V(0, 0);
    asm volatile("s_waitcnt vmcnt(0)" ::: "memory");
    __syncthreads();
    for (int kt = 0; kt < ntile; ++kt) {
      if (kt + 1 < ntile) { ATT_STAGE_K((kt + 1) & 1, (kt + 1) * 64); ATT_STAGE_V((kt + 1) & 1, (kt + 1) * 64); }
      const unsigned char* ks_ = lds + (kt & 1) * 32768 + lr * 256;
      const unsigned char* vs_ = lds + (kt & 1) * 32768 + 16384;
#pragma unroll
      for (int k2 = 0; k2 < 2; ++k2) {
        bf16x8 kfr[8];
        uint2 vlo_[8], vhi_[8];
#pragma unroll
        for (int sub = 0; sub < 2; ++sub)
#pragma unroll
          for (int nn = 0; nn < 2; ++nn)
#pragma unroll
            for (int ks = 0; ks < 2; ++ks)
              kfr[sub * 4 + nn * 2 + ks] = *(const bf16x8*)(ks_ + (2 * k2 + nn) * 4096 + ((xl ^ (sub * 8 + ks * 4)) << 4));
#pragma unroll
        for (int et = 0; et < 8; ++et) {
          vlo_[et] = *(const uint2*)(vs_ + et * 2048 + (vlo ^ (k2 << 6)));
          vhi_[et] = *(const uint2*)(vs_ + et * 2048 + (vlo ^ (k2 << 6) ^ 32));
        }
        SB;
        f32x4 s[2][2];
#pragma unroll
        for (int sub = 0; sub < 2; ++sub)
#pragma unroll
          for (int nn = 0; nn < 2; ++nn) {
            s[sub][nn] = MFMA(kfr[sub * 4 + nn * 2], qf[sub][0], ((f32x4){0.f, 0.f, 0.f, 0.f}));
            s[sub][nn] = MFMA(kfr[sub * 4 + nn * 2 + 1], qf[sub][1], s[sub][nn]);
          }
        SB;
        bf16x8 pf[2];
        float tmx[2];
#pragma unroll
        for (int sub = 0; sub < 2; ++sub) {
          float tm = fmaxf(fmaxf(fmaxf(s[sub][0][0], s[sub][0][1]), fmaxf(s[sub][0][2], s[sub][0][3])), fmaxf(fmaxf(s[sub][1][0], s[sub][1][1]), fmaxf(s[sub][1][2], s[sub][1][3])));
          tm = fmaxf(tm, __shfl_xor(tm, 16));
          tm = fmaxf(tm, __shfl_xor(tm, 32));
          tmx[sub] = tm;
        }
        if (__any((tmx[0] > mx[0] + 8.f) || (tmx[1] > mx[1] + 8.f))) {
#pragma unroll
          for (int sub = 0; sub < 2; ++sub) {
            const float mn = (tmx[sub] > mx[sub] + 8.f) ? tmx[sub] : mx[sub];
            const float sc = __builtin_amdgcn_exp2f(mx[sub] - mn);
            mx[sub] = mn;
            ls[sub] *= sc;
#pragma unroll
            for (int et = 0; et < 8; ++et) {
              if (sub == 0) { o0[et][0] *= sc; o0[et][1] *= sc; o0[et][2] *= sc; o0[et][3] *= sc; }
              else { o1[et][0] *= sc; o1[et][1] *= sc; o1[et][2] *= sc; o1[et][3] *= sc; }
            }
          }
        }
#pragma unroll
        for (int sub = 0; sub < 2; ++sub) {
          unsigned pw[4];
          float acc = 0.f;
#pragma unroll
          for (int nn = 0; nn < 2; ++nn) {
            float a[4];
#pragma unroll
            for (int r = 0; r < 4; ++r) { a[r] = __builtin_amdgcn_exp2f(s[sub][nn][r] - mx[sub]); acc += a[r]; }
            pw[nn * 2] = pack2(a[0], a[1]);
            pw[nn * 2 + 1] = pack2(a[2], a[3]);
          }
          ls[sub] += acc;
          union { unsigned u[4]; bf16x8 v; } cp;
          cp.u[0] = pw[0]; cp.u[1] = pw[1]; cp.u[2] = pw[2]; cp.u[3] = pw[3];
          pf[sub] = cp.v;
        }
        SB;
#pragma unroll
        for (int et = 0; et < 8; ++et) {
          union { unsigned u[4]; bf16x8 v; } cv;
          cv.u[0] = vlo_[et].x; cv.u[1] = vlo_[et].y; cv.u[2] = vhi_[et].x; cv.u[3] = vhi_[et].y;
          o0[et] = MFMA(cv.v, pf[0], o0[et]);
          o1[et] = MFMA(cv.v, pf[1], o1[et]);
        }
        SB;
      }
      asm volatile("s_waitcnt vmcnt(0)" ::: "memory");
      __syncthreads();
    }
    f32x4 o[8];
    {
      float t0 = ls[0], t1 = ls[1];
      t0 += __shfl_xor(t0, 16); t0 += __shfl_xor(t0, 32);
      t1 += __shfl_xor(t1, 16); t1 += __shfl_xor(t1, 32);
      const float c1 = 1.f / t0, c2 = lam / t1;
#pragma unroll
      for (int et = 0; et < 8; ++et)
#pragma unroll
        for (int r = 0; r < 4; ++r) o[et][r] = o0[et][r] * c1 - o1[et][r] * c2;
    }
#undef ATT_STAGE_K
#undef ATT_STAGE_V
    float ss = 0.f;
#pragma unroll
    for (int et = 0; et < 8; ++et)
#pragma unroll
      for (int r = 0; r < 4; ++r) ss += o[et][r] * o[et][r];
    ss += __shfl_xor(ss, 16);
    ss += __shfl_xor(ss, 32);
    const float rs = rsqrtf(ss * (1.f / 128.f) + 1e-6f) * (1.f - lam_init);
    bf16_t* gp = R0 + 160 * MIB / 2 + (size_t)mq * 1024 + h * 128;
#pragma unroll
    for (int et = 0; et < 8; ++et) {
      const int e0 = 16 * et + 4 * lg;
      const uint2 g = *(const uint2*)(gp + e0);
      const float4 sg = *(const float4*)(subg + e0);
      const float v0 = o[et][0] * rs * sg.x * lo_f(g.x), v1 = o[et][1] * rs * sg.y * hi_f(g.x);
      const float v2 = o[et][2] * rs * sg.z * lo_f(g.y), v3 = o[et][3] * rs * sg.w * hi_f(g.y);
      if (!dry) *(uint2*)(gp + e0) = make_uint2(pack2(v0, v1), pack2(v2, v3));
    }
  }
}

__device__ __forceinline__ bf16_t* hg_ob_row(const Params& p, int m) {
  const int c = m >> 9;
  float* base = c < 32 ? p.out + OUT_CK + (size_t)(c * 2 + 1) * 262144 : p.out + OUT_CV + (size_t)((c - 32) * 2 + 1) * 262144;
  return (bf16_t*)base + (size_t)(m & 511) * 1024;
}

__device__ __forceinline__ bf16_t* ret_ob_row(const Params& p, int ms) {
  const int c = ms >> 8;
  float* base = c < 32 ? p.out + OUT_CK + (size_t)(c * 2 + 1) * 262144 : p.out + OUT_CV + (size_t)((c - 32) * 2 + 1) * 262144;
  return (bf16_t*)base + (size_t)(ms & 255) * 2048;
}

template <int KIND, int DIR>
__device__ __forceinline__ void scan_item(const Params& p, int item, unsigned char* lds, const bool dry) {
  constexpr int DV = KIND == 1 ? 256 : 128, NSL = DV / 64, LDV = KIND == 1 ? 2048 : 1024;
  const int tid = HTID, lane = tid & 63, w = tid >> 6, lr = lane & 15, lg = lane >> 4;
  int grp, b, h, sl;
  {
    int it = item;
    if (it < 64 * NSL) grp = 1; else { grp = 0; it -= 64 * NSL; }
    sl = it % NSL; h = (it / NSL) & 7; b = it / (NSL * 8);
  }
  const int T = grp ? 2048 : 256, nch = T >> 6;
  const size_t mbase = grp ? (size_t)8192 + (size_t)b * 2048 : (size_t)b * 256;
  bf16_t* R0 = (bf16_t*)p.ws;
  const bf16_t* Qg = R0 + mbase * 1024 + h * 128;
  const bf16_t* Kg = R0 + (KIND == 1 ? PLANE_E : (DIR ? 2 * PLANE_E : PLANE_E)) + mbase * 1024 + h * 128;
  const bf16_t* Vg = R0 + (KIND == 1 ? 2 * PLANE_E : 3 * PLANE_E) + mbase * LDV + h * DV + sl * 64;
  bf16_t* Og = R0 + (KIND == 1 ? 4 * PLANE_E : 5 * PLANE_E) + mbase * LDV + h * DV + sl * 64;
  unsigned char* Qs = lds;
  unsigned char* X = lds + 17408;
  unsigned char* Vt = lds + 35840;
  unsigned char* StS = lds + 45056;
  unsigned char* Pm = lds + 62464;
  float* xch = (float*)(lds + 71680);
  float* blA = xch + 512;
  float* erA = xch + 640;
  const int dp = tid & 63, tq = tid >> 6, r0 = tq * 16, d0 = dp * 2;
  float cst0, cst1;
  if (KIND == 1) { cst0 = cst1 = log1pf(-expf(p.in[18][DIR * 8 + h])) * 1.4426950408889634f; }
  else {
    const float* lbp = p.in[21] + DIR * 4096 + h * 128 + d0;
    {
      const float x0 = lbp[0], x1 = lbp[1024], x2 = lbp[2048], x3 = lbp[3072];
      const float m = fmaxf(fmaxf(x0, x1), fmaxf(x2, x3));
      const float e0 = expf(x0 - m), e1 = expf(x1 - m), e2 = expf(x2 - m), e3 = expf(x3 - m);
      cst0 = (e1 + e2) / (e0 + e1 + e2 + e3);
    }
    {
      const float x0 = lbp[1], x1 = lbp[1025], x2 = lbp[2049], x3 = lbp[3073];
      const float m = fmaxf(fmaxf(x0, x1), fmaxf(x2, x3));
      const float e0 = expf(x0 - m), e1 = expf(x1 - m), e2 = expf(x2 - m), e3 = expf(x3 - m);
      cst1 = (e1 + e2) / (e0 + e1 + e2 + e3);
    }
  }
  f32x4 S[8];
  if (grp) {
    const float* s0 = (KIND == 1 ? p.in[4] : p.in[5]) + ((size_t)((b * 2 + DIR) * 8 + h) * 128) * DV + sl * 64 + 16 * w + lr + (size_t)(4 * lg) * DV;
    asm volatile("" : "+v"(s0));
#pragma unroll
    for (int dt = 0; dt < 8; ++dt)
#pragma unroll
      for (int r = 0; r < 4; ++r) S[dt][r] = s0[(16 * dt + r) * DV];
  } else {
#pragma unroll
    for (int dt = 0; dt < 8; ++dt) S[dt] = (f32x4){0.f, 0.f, 0.f, 0.f};
  }
  unsigned qv[16], kv[16], vv[8];
  const int ve2 = tid & 31, vq = tid >> 5;
  const int qoff = r0 * 512 + dp;
  const int voff = (8 * vq) * (LDV / 2) + ve2;
  const unsigned* Qg32 = (const unsigned*)Qg;
  const unsigned* Kg32 = (const unsigned*)Kg;
  const unsigned* Vg32 = (const unsigned*)Vg;
#define SCAN_ISSUE(c)                                                                                   \
  {                                                                                                     \
    const unsigned* q_ = Qg32 + (size_t)(c) * (64 * 512) + qoff;                                        \
    const unsigned* k_ = Kg32 + (size_t)(c) * (64 * 512) + qoff;                                        \
    const unsigned* v_ = Vg32 + (size_t)(c) * (64 * (LDV / 2)) + voff;                                  \
    asm volatile("" : "+v"(q_), "+v"(k_), "+v"(v_));                                                    \
    _Pragma("unroll") for (int i = 0; i < 16; ++i) { qv[i] = q_[i * 512]; kv[i] = k_[i * 512]; }        \
    _Pragma("unroll") for (int i = 0; i < 8; ++i) vv[i] = v_[i * (LDV / 2)];                            \
  }
  SCAN_ISSUE(DIR ? nch - 1 : 0);
  for (int ci = 0; ci < nch; ++ci) {
    const int c = DIR ? nch - 1 - ci : ci;
    float tot0 = 0.f, tot1 = 0.f;
    if (KIND == 1) { tot0 = tot1 = 16.f * cst0; }
    else {
#pragma unroll
      for (int i = 0; i < 16; ++i) {
        const float s0_ = 1.f / (1.f + __expf(-lo_f(kv[i]))), s1_ = 1.f / (1.f + __expf(-hi_f(kv[i])));
        tot0 += __log2f(cst0 + (1.f - cst0) * s0_);
        tot1 += __log2f(cst1 + (1.f - cst1) * s1_);
      }
    }
    *(float2*)(xch + tq * 128 + d0) = make_float2(tot0, tot1);
    __syncthreads();
    const float2 t0 = *(const float2*)(xch + d0), t1 = *(const float2*)(xch + 128 + d0), t2 = *(const float2*)(xch + 256 + d0), t3 = *(const float2*)(xch + 384 + d0);
    const float blast0 = (t0.x + t1.x) + (t2.x + t3.x), blast1 = (t0.y + t1.y) + (t2.y + t3.y);
    float ref0, ref1, run0, run1;
    if (DIR == 0) {
      ref0 = t0.x + t1.x; ref1 = t0.y + t1.y;
      run0 = (tq > 0 ? t0.x : 0.f) + (tq > 1 ? t1.x : 0.f) + (tq > 2 ? t2.x : 0.f);
      run1 = (tq > 0 ? t0.y : 0.f) + (tq > 1 ? t1.y : 0.f) + (tq > 2 ? t2.y : 0.f);
    } else {
      ref0 = t2.x + t3.x; ref1 = t2.y + t3.y;
      run0 = (tq < 3 ? t3.x : 0.f) + (tq < 2 ? t2.x : 0.f) + (tq < 1 ? t1.x : 0.f);
      run1 = (tq < 3 ? t3.y : 0.f) + (tq < 2 ? t2.y : 0.f) + (tq < 1 ? t1.y : 0.f);
    }
    const float cbr0 = __builtin_amdgcn_exp2f(blast0 - ref0), cbr1 = __builtin_amdgcn_exp2f(blast1 - ref1);
    unsigned ktp0[8], ktp1[8];
#pragma unroll
    for (int jj = 0; jj < 8; ++jj) {
      const int j = DIR ? 7 - jj : jj;
      float ka[2], kb[2];
#pragma unroll
      for (int hh = 0; hh < 2; ++hh) {
        const int i = 2 * j + (DIR ? 1 - hh : hh);
        float g0, g1, k0, k1;
        if (KIND == 1) { g0 = g1 = cst0; k0 = lo_f(kv[i]); k1 = hi_f(kv[i]); }
        else {
          const float s0_ = 1.f / (1.f + __expf(-lo_f(kv[i]))), s1_ = 1.f / (1.f + __expf(-hi_f(kv[i])));
          g0 = __log2f(cst0 + (1.f - cst0) * s0_); g1 = __log2f(cst1 + (1.f - cst1) * s1_);
          k0 = (1.f - cst0) * (1.f - s0_); k1 = (1.f - cst1) * (1.f - s1_);
        }
        run0 += g0; run1 += g1;
        *(unsigned*)(Qs + (r0 + i) * 272 + d0 * 2) = pack2(lo_f(qv[i]) * __builtin_amdgcn_exp2f(run0 - ref0), hi_f(qv[i]) * __builtin_amdgcn_exp2f(run1 - ref1));
        const float kh0 = k0 * __builtin_amdgcn_exp2f(ref0 - run0), kh1 = k1 * __builtin_amdgcn_exp2f(ref1 - run1);
        *(unsigned*)(X + (r0 + i) * 272 + d0 * 2) = pack2(kh0, kh1);
        ka[i & 1] = kh0 * cbr0;
        kb[i & 1] = kh1 * cbr1;
      }
      ktp0[j] = pack2(ka[0], ka[1]);
      ktp1[j] = pack2(kb[0], kb[1]);
    }
    if (tq == 0) { *(float2*)(blA + d0) = make_float2(__builtin_amdgcn_exp2f(blast0), __builtin_amdgcn_exp2f(blast1)); *(float2*)(erA + d0) = make_float2(__builtin_amdgcn_exp2f(ref0), __builtin_amdgcn_exp2f(ref1)); }
    {
      const unsigned a0 = (vv[0] & 0xffffu) | (vv[1] << 16), a1 = (vv[2] & 0xffffu) | (vv[3] << 16), a2 = (vv[4] & 0xffffu) | (vv[5] << 16), a3 = (vv[6] & 0xffffu) | (vv[7] << 16);
      const unsigned b0 = (vv[0] >> 16) | (vv[1] & 0xffff0000u), b1 = (vv[2] >> 16) | (vv[3] & 0xffff0000u), b2 = (vv[4] >> 16) | (vv[5] & 0xffff0000u), b3 = (vv[6] >> 16) | (vv[7] & 0xffff0000u);
      *(uint4*)(Vt + (2 * ve2) * 144 + vq * 16) = make_uint4(a0, a1, a2, a3);
      *(uint4*)(Vt + (2 * ve2 + 1) * 144 + vq * 16) = make_uint4(b0, b1, b2, b3);
    }
    if (ci + 1 < nch) { SCAN_ISSUE(DIR ? c - 1 : c + 1); }
    __syncthreads();
#pragma unroll
    for (int dt = 0; dt < 8; ++dt) {
      const float4 er4 = *(const float4*)(erA + 16 * dt + 4 * lg);
      *(uint2*)(StS + (16 * w + lr) * 272 + (16 * dt + 4 * lg) * 2) = make_uint2(pack2(S[dt][0] * er4.x, S[dt][1] * er4.y), pack2(S[dt][2] * er4.z, S[dt][3] * er4.w));
    }
    bf16x8 qf[4];
#pragma unroll
    for (int ks = 0; ks < 4; ++ks) qf[ks] = *(const bf16x8*)(Qs + (16 * w + lr) * 272 + ks * 64 + lg * 16);
    uint2 pv[4];
    {
      const int t = 16 * w + lr;
#pragma unroll
      for (int st = 0; st < 4; ++st) {
        f32x4 s = (f32x4){0.f, 0.f, 0.f, 0.f};
#pragma unroll
        for (int ks = 0; ks < 4; ++ks) {
          const bf16x8 kf = *(const bf16x8*)(X + (16 * st + lr) * 272 + ks * 64 + lg * 16);
          s = MFMA(kf, qf[ks], s);
        }
        float v[4];
#pragma unroll
        for (int r = 0; r < 4; ++r) {
          const int si = 16 * st + 4 * lg + r;
          const bool keep = DIR ? (t <= si) : (t >= si);
          v[r] = keep ? s[r] : 0.f;
        }
        pv[st] = make_uint2(pack2(v[0], v[1]), pack2(v[2], v[3]));
      }
    }
    __syncthreads();
#pragma unroll
    for (int st = 0; st < 4; ++st) *(uint2*)(Pm + (16 * w + lr) * 144 + (16 * st + 4 * lg) * 2) = pv[st];
    *(uint4*)(X + d0 * 144 + r0 * 2) = make_uint4(ktp0[0], ktp0[1], ktp0[2], ktp0[3]);
    *(uint4*)(X + d0 * 144 + r0 * 2 + 16) = make_uint4(ktp0[4], ktp0[5], ktp0[6], ktp0[7]);
    *(uint4*)(X + (d0 + 1) * 144 + r0 * 2) = make_uint4(ktp1[0], ktp1[1], ktp1[2], ktp1[3]);
    *(uint4*)(X + (d0 + 1) * 144 + r0 * 2 + 16) = make_uint4(ktp1[4], ktp1[5], ktp1[6], ktp1[7]);
    __syncthreads();
    {
      bf16x8 pf[2];
#pragma unroll
      for (int ks = 0; ks < 2; ++ks) pf[ks] = *(const bf16x8*)(Pm + (16 * w + lr) * 144 + ks * 64 + lg * 16);
      const bool sep = DIR && (KIND == 2 || grp);
      bf16_t* orow = (KIND == 2 && DIR) ? hg_ob_row(p, (int)mbase + c * 64 + 16 * w + lr) + h * DV + sl * 64 + 4 * lg
                   : (KIND == 1 && DIR && grp) ? ret_ob_row(p, b * 2048 + c * 64 + 16 * w + lr) + h * DV + sl * 64 + 4 * lg
                                               : Og + (size_t)(c * 64 + 16 * w + lr) * LDV + 4 * lg;
#pragma unroll
      for (int et = 0; et < 4; ++et) {
        f32x4 o = (f32x4){0.f, 0.f, 0.f, 0.f};
#pragma unroll
        for (int ks = 0; ks < 2; ++ks) {
          const bf16x8 vf = *(const bf16x8*)(Vt + (16 * et + lr) * 144 + ks * 64 + lg * 16);
          o = MFMA(vf, pf[ks], o);
        }
#pragma unroll
        for (int ks = 0; ks < 4; ++ks) {
          const bf16x8 sf = *(const bf16x8*)(StS + (16 * et + lr) * 272 + ks * 64 + lg * 16);
          o = MFMA(sf, qf[ks], o);
        }
        bf16_t* op = orow + 16 * et;
        if (DIR && !sep) {
          const uint2 old = *(const uint2*)op;
          o[0] += lo_f(old.x); o[1] += hi_f(old.x); o[2] += lo_f(old.y); o[3] += hi_f(old.y);
        }
        if (!(DIR && !sep && dry)) *(uint2*)op = make_uint2(pack2(o[0], o[1]), pack2(o[2], o[3]));
      }
    }
    {
      bf16x8 vtf[2];
#pragma unroll
      for (int ks = 0; ks < 2; ++ks) vtf[ks] = *(const bf16x8*)(Vt + (16 * w + lr) * 144 + ks * 64 + lg * 16);
#pragma unroll
      for (int dt = 0; dt < 8; ++dt) {
        const float4 bl4 = *(const float4*)(blA + 16 * dt + 4 * lg);
        S[dt][0] *= bl4.x; S[dt][1] *= bl4.y; S[dt][2] *= bl4.z; S[dt][3] *= bl4.w;
#pragma unroll
        for (int ks = 0; ks < 2; ++ks) {
          const bf16x8 kf = *(const bf16x8*)(X + (16 * dt + lr) * 144 + ks * 64 + lg * 16);
          S[dt] = MFMA(kf, vtf[ks], S[dt]);
        }
      }
    }
    __syncthreads();
  }
#undef SCAN_ISSUE
  if (!grp) {
    float* so = p.out + (KIND == 1 ? OUT_SR : OUT_SH) + ((size_t)((b * 2 + DIR) * 8 + h) * 128) * DV + sl * 64 + 16 * w + lr + (size_t)(4 * lg) * DV;
    asm volatile("" : "+v"(so));
#pragma unroll
    for (int dt = 0; dt < 8; ++dt)
#pragma unroll
      for (int r = 0; r < 4; ++r) so[(16 * dt + r) * DV] = S[dt][r];
  }
}

template <int KIND, int DIR>
__device__ __forceinline__ void scan_phase(const Params& p, unsigned char* lds, const bool dry) {
  constexpr int NSL = (KIND == 1 ? 256 : 128) / 64;
  const int ns = 64 * NSL, npr = 256 * NSL;
  const int G = VGDIM, bid = VBID;
  int it, step, end = ns + npr;
  if (G > ns) {
    if (bid < ns) { it = bid; step = end; }
    else { it = ns + (bid - ns); step = G - ns; }
  } else { it = bid; step = G; }
  for (; it < end; it += step) scan_item<KIND, DIR>(p, it, lds, dry);
}

__device__ __forceinline__ void scan_phase_ret_sample(const Params& p, unsigned char* lds, const bool dry) {
  const int G = VGDIM >> 1, bid = VBID;
  const int role = bid >= G;
  const int rb = role ? bid - G : bid;
  if (role == 0) { for (int it = rb; it < 256; it += G) scan_item<1, 0>(p, it, lds, dry); }
  else           { for (int it = rb; it < 256; it += G) scan_item<1, 1>(p, it, lds, dry); }
}
template <int DIR>
__device__ __forceinline__ void scan_phase_ret_prompt(const Params& p, unsigned char* lds, const bool dry) {
  for (int it = VBID; it < 1024; it += VGDIM) scan_item<1, DIR>(p, 256 + it, lds, dry);
}

__device__ __forceinline__ void scan_phase_hg_both(const Params& p, unsigned char* lds, const bool dry) {
  const int G = VGDIM >> 1, bid = VBID;
  const int role = bid >= G;
  const int rb = role ? bid - G : bid;
  int it, step;
  if (G > 128) {
    if (rb < 128) { it = rb; step = 1 << 20; } else { it = rb; step = G - 128; }
  } else { it = rb; step = G; }
  if (role == 0) { for (; it < 640; it += step) scan_item<2, 0>(p, it, lds, dry); }
  else           { for (; it < 640; it += step) scan_item<2, 1>(p, it, lds, dry); }
}

template <int KIND>
__device__ __forceinline__ void normgate_phase(const Params& p, const bool dry) {
  constexpr int NCH = KIND == 1 ? 4 : 2, DV = KIND == 1 ? 256 : 128, LD = KIND == 1 ? 2048 : 1024;
  const int tid = HTID, lane = tid & 63, w = tid >> 6;
  const int hh = lane >> 3, sub = lane & 7;
  bf16_t* R0 = (bf16_t*)p.ws;
  bf16_t* Ob = R0 + (KIND == 1 ? 4 * PLANE_E : 5 * PLANE_E) + hh * DV + sub * 8;
  const bf16_t* Gb = R0 + (KIND == 1 ? 0 : 4 * PLANE_E) + hh * DV + sub * 8;
  float gn[NCH][8];
#pragma unroll
  for (int j = 0; j < NCH; ++j)
#pragma unroll
    for (int i = 0; i < 8; ++i) gn[j][i] = (KIND == 1) ? 1.f : p.in[22][j * 64 + sub * 8 + i];
  for (int row = VBID * 4 + w; row < 24576; row += VGDIM * 4) {
    bf16_t* op = Ob + (size_t)row * LD;
    const bf16_t* gp = Gb + (size_t)row * LD;
    uint4 ov[NCH], gv[NCH];
#pragma unroll
    for (int j = 0; j < NCH; ++j) { ov[j] = *(const uint4*)(op + j * 64); gv[j] = *(const uint4*)(gp + j * 64); }
    if (KIND == 2 || row >= 8192) {
      const bf16_t* bp = (KIND == 2 ? hg_ob_row(p, row) : ret_ob_row(p, row - 8192)) + hh * DV + sub * 8;
#pragma unroll
      for (int j = 0; j < NCH; ++j) {
        const uint4 bv = *(const uint4*)(bp + j * 64);
        ov[j].x = pack2(lo_f(ov[j].x) + lo_f(bv.x), hi_f(ov[j].x) + hi_f(bv.x));
        ov[j].y = pack2(lo_f(ov[j].y) + lo_f(bv.y), hi_f(ov[j].y) + hi_f(bv.y));
        ov[j].z = pack2(lo_f(ov[j].z) + lo_f(bv.z), hi_f(ov[j].z) + hi_f(bv.z));
        ov[j].w = pack2(lo_f(ov[j].w) + lo_f(bv.w), hi_f(ov[j].w) + hi_f(bv.w));
      }
    }
    float ss = 0.f;
#pragma unroll
    for (int j = 0; j < NCH; ++j) {
      const unsigned wv[4] = {ov[j].x, ov[j].y, ov[j].z, ov[j].w};
#pragma unroll
      for (int i = 0; i < 4; ++i) { const float a = lo_f(wv[i]), b2 = hi_f(wv[i]); ss += a * a + b2 * b2; }
    }
    ss += __shfl_xor(ss, 1);
    ss += __shfl_xor(ss, 2);
    ss += __shfl_xor(ss, 4);
    const float rs = rsqrtf(ss * (1.f / (float)DV) + 1e-6f);
#pragma unroll
    for (int j = 0; j < NCH; ++j) {
      const unsigned wv[4] = {ov[j].x, ov[j].y, ov[j].z, ov[j].w};
      const unsigned gw[4] = {gv[j].x, gv[j].y, gv[j].z, gv[j].w};
      unsigned r[4];
#pragma unroll
      for (int i = 0; i < 4; ++i)
        r[i] = pack2(lo_f(wv[i]) * rs * gn[j][2 * i] * lo_f(gw[i]), hi_f(wv[i]) * rs * gn[j][2 * i + 1] * hi_f(gw[i]));
      if (!dry) *(uint4*)(op + j * 64) = make_uint4(r[0], r[1], r[2], r[3]);
    }
  }
}

__device__ __forceinline__ void opaque_params(Params& q) {
  asm volatile("" : "+s"(q.out), "+s"(q.ws));
#pragma unroll
  for (int i = 0; i < 23; ++i) asm volatile("" : "+s"(q.in[i]));
}

struct BarState { unsigned* base; unsigned xcd, mycnt, nact, esub, etop; };
__device__ __forceinline__ void grid_barrier(BarState& b) {
  asm volatile("s_waitcnt vmcnt(0) lgkmcnt(0)" ::: "memory");
  __syncthreads();
  if (threadIdx.x == 0) {
    b.esub += b.mycnt; b.etop += b.nact;
    const unsigned old = __hip_atomic_fetch_add(b.base + 64 * b.xcd, 1u, __ATOMIC_RELAXED, __HIP_MEMORY_SCOPE_AGENT);
    if (old + 1u == b.esub) {
      __builtin_amdgcn_fence(__ATOMIC_RELEASE, "agent");
      __hip_atomic_fetch_add(b.base + 512, 1u, __ATOMIC_RELAXED, __HIP_MEMORY_SCOPE_AGENT);
    }
    while (__hip_atomic_load(b.base + 512, __ATOMIC_RELAXED, __HIP_MEMORY_SCOPE_AGENT) < b.etop) __builtin_amdgcn_s_sleep(1);
    __builtin_amdgcn_fence(__ATOMIC_ACQUIRE, "agent");
  }
  __syncthreads();
}
__device__ __forceinline__ void bar_census_post(BarState& b) {
  if (threadIdx.x == 0) __hip_atomic_fetch_add(b.base + 1024 + 64 * b.xcd, 1u, __ATOMIC_RELAXED, __HIP_MEMORY_SCOPE_AGENT);
}
__device__ __forceinline__ void bar_census_read(BarState& b) {
  if (threadIdx.x == 0) {
    unsigned n = 0;
    for (unsigned j = 0; j < 8; ++j) {
      const unsigned c = __hip_atomic_load(b.base + 1024 + 64 * j, __ATOMIC_RELAXED, __HIP_MEMORY_SCOPE_AGENT);
      n += (c != 0u);
      if (j == b.xcd) b.mycnt = c;
    }
    b.nact = n;
  }
}
#define GSYNC(n) { if ((n) == 0) { grid.sync(); bar_census_read(bst); } else grid_barrier(bst); }

#if defined(PH_ONLY)
#define PHASE(n, call) if (n == PH_ONLY) { const bool dry = false; call; }
#elif defined(REP_N)
#define PHASE(n, call) if (lo <= n && n < hi) { for (int rep = (n == REP_N ? 0 : 1); rep < 2; ++rep) { const bool dry = (rep == 0); call; if (!(fin && n + 1 == hi && rep == 1)) GSYNC(n) } }
#else
#define PHASE(n, call) if (lo <= n && n < hi) { const bool dry = false; call; if (!(fin && n + 1 == hi)) GSYNC(n) }
#endif

__device__ __forceinline__ void run_range(const Params& q, int lo, int hi, bool fin, cg::grid_group& grid, unsigned char* lds) {
  unsigned char* ldh = lds + HALFID * HALF_LDS;
  BarState bst; bst.base = (unsigned*)(q.ws + OFF_MISC + MISC_CTR); bst.xcd = xcc_id(); bst.mycnt = 0; bst.nact = 0; bst.esub = 0; bst.etop = 0;
  if (lo == 0) bar_census_post(bst);
  PHASE(0, phase0(q, ldh))
  PHASE(1, post_phase(q, -1, 0, ldh, dry))
  PHASE(2, gemm_phase(q, 0, GM_IN_DA, lds, 2))
  PHASE(3, attn_phase(q, 0, lds, dry, 3))
  PHASE(4, gemm_phase(q, 0, GM_OUT, lds, 4))
  PHASE(5, post_phase(q, 0, 1, ldh, dry))
  PHASE(6, gemm_phase(q, 1, GM_IN_RET_QKV, lds, 6))
  PHASE(7, scan_phase_ret_sample(q, ldh, dry))
  PHASE(8, scan_phase_ret_prompt<0>(q, ldh, dry))
  PHASE(8, scan_phase_ret_prompt<1>(q, ldh, dry))
  PHASE(9, gemm_phase(q, 1, GM_IN_RET_G, lds, 9))
  PHASE(10, normgate_phase<1>(q, dry))
  PHASE(11, gemm_phase(q, 1, GM_OUT, lds, 11))
  PHASE(12, post_phase(q, 1, 2, ldh, dry))
  PHASE(13, gemm_phase(q, 2, GM_IN_HG, lds, 13))
  PHASE(14, scan_phase_hg_both(q, ldh, dry))
  PHASE(16, normgate_phase<2>(q, dry))
  PHASE(17, gemm_phase(q, 2, GM_OUT, lds, 17))
  PHASE(18, post_phase(q, 2, 3, ldh, dry))
  PHASE(19, gemm_phase(q, 3, GM_IN_DA, lds, 19))
  PHASE(20, attn_phase(q, 3, lds, dry, 20))
  PHASE(21, gemm_phase(q, 3, GM_OUT, lds, 21))
  PHASE(22, post_phase(q, 3, 4, ldh, dry))
}

__global__ void __launch_bounds__(NTHR, 2) mega_fwd(Params p) {
  extern __shared__ __attribute__((aligned(16))) unsigned char lds[];
  cg::grid_group grid = cg::this_grid();
  run_range(p, p.ph_lo, p.ph_hi, true, grid, lds);
}

extern "C" void kernel_launch(void* const* d_in, const int* in_sizes, int n_in, void* d_out, int out_size, void* d_ws, size_t ws_size, hipStream_t stream) {
  static int grid_blocks = 0;
  if (grid_blocks == 0) {
    int dev = 0, cus = 0, per_cu = 0;
    hipGetDevice(&dev);
    hipDeviceGetAttribute(&cus, hipDeviceAttributeMultiprocessorCount, dev);
    hipFuncSetAttribute((const void*)mega_fwd, hipFuncAttributeMaxDynamicSharedMemorySize, LDS_BYTES);
    hipOccupancyMaxActiveBlocksPerMultiprocessor(&per_cu, (const void*)mega_fwd, NTHR, LDS_BYTES);
    if (per_cu < 1) per_cu = 1;
    if (per_cu > 1) per_cu = 1;
    if (cus < 1) cus = 256;
    grid_blocks = cus * per_cu;
    (void)hipGetLastError();
    if (n_in != 23 || ws_size < WS_NEED) { fprintf(stderr, "kernel_launch: unexpected n_in %d / ws_size %zu (need %zu)\n", n_in, ws_size, (size_t)WS_NEED); }
  }
  hipMemsetAsync((unsigned char*)d_ws + OFF_MISC + MISC_CTR, 0, 8192, stream);
  Params p{};
  for (int i = 0; i < 23; ++i) p.in[i] = (const float*)d_in[i];
  p.out = (float*)d_out;
  p.ws = (unsigned char*)d_ws;
#if ONE_LAUNCH
  p.ph_lo = 0; p.ph_hi = NPH;
  void* args[] = {&p};
  hipError_t e = hipLaunchCooperativeKernel((const void*)mega_fwd, dim3(grid_blocks), dim3(NTHR), args, LDS_BYTES, stream);
  if (e != hipSuccess) fprintf(stderr, "cooperative launch failed: %s (grid %d)\n", hipGetErrorString(e), grid_blocks);
#else
  for (int ph = 0; ph < NPH; ++ph) {
    p.ph_lo = ph; p.ph_hi = ph + 1;
    hipLaunchKernelGGL(mega_fwd, dim3(grid_blocks), dim3(NTHR), LDS_BYTES, stream, p);
  }
#endif
}
```

```cpp
#include <hip/hip_runtime.h>
#include <hip/hip_cooperative_groups.h>
#include <cstdint>
#include <cstdio>
namespace cg = cooperative_groups;

#ifndef ONE_LAUNCH
#define ONE_LAUNCH 1
#endif

typedef unsigned short bf16_t;
typedef short bf16x8 __attribute__((ext_vector_type(8)));
typedef float f32x4 __attribute__((ext_vector_type(4)));

#define NTHR 512
#define HTID ((int)(threadIdx.x & 255))
#define HALFID ((int)(threadIdx.x >> 8))
#define VBID ((int)(blockIdx.x * 2 + (threadIdx.x >> 8)))
#define VGDIM ((int)(gridDim.x * 2))
#define HALF_LDS 74816
#define MIB ((size_t)1 << 20)
#define NPH 23
#define LDS_BYTES (2 * HALF_LDS)
#define LDS_SLOT 74752
#define MISC_CTR (MISC_ROPE + 524288)

#define OFF_WIN  (288 * MIB)
#define OFF_WOUT (300 * MIB)
#define OFF_HP   (304 * MIB)
#define OFF_MISC (320 * MIB)
#define MISC_ROPE 524288
#define WS_NEED  (322 * MIB)
#define PLANE_E  ((size_t)25165824)
#define OUT_YP 0
#define OUT_YS 8388608
#define OUT_CK 25165824
#define OUT_CV 41943040
#define OUT_SR 58720256
#define OUT_SH 75497472

struct Params {
  const float* in[23];
  float* out;
  unsigned char* ws;
  int ph_lo, ph_hi;
};

struct LayerInfo { int kind, slot, IN, WIDTH; const float* w_in; const float* w_out; };

__device__ __forceinline__ LayerInfo layer_info(const Params& p, int l) {
  LayerInfo L;
  if (l == 0)      { L.kind = 0; L.slot = 0; L.IN = 4096; L.WIDTH = 1024; L.w_in = p.in[12]; L.w_out = p.in[13]; }
  else if (l == 1) { L.kind = 1; L.slot = 0; L.IN = 6144; L.WIDTH = 2048; L.w_in = p.in[16]; L.w_out = p.in[17]; }
  else if (l == 2) { L.kind = 2; L.slot = 0; L.IN = 5120; L.WIDTH = 1024; L.w_in = p.in[19]; L.w_out = p.in[20]; }
  else             { L.kind = 0; L.slot = 1; L.IN = 4096; L.WIDTH = 1024; L.w_in = p.in[12] + (size_t)1024 * 4096; L.w_out = p.in[13] + (size_t)1024 * 1024; }
  return L;
}
__device__ __forceinline__ bf16_t* hs_ptr(const Params& p, int l) {
  return l < 3 ? (bf16_t*)(p.out + OUT_SH) : (bf16_t*)(p.ws + 240 * MIB);
}

typedef __bf16 nbf16x2 __attribute__((ext_vector_type(2)));
typedef float f32x2 __attribute__((ext_vector_type(2)));
__device__ __forceinline__ float bf2f(unsigned h) { return __uint_as_float(h << 16); }
__device__ __forceinline__ unsigned pack2(float a, float b) { const f32x2 f = {a, b}; return __builtin_bit_cast(unsigned, __builtin_convertvector(f, nbf16x2)); }
__device__ __forceinline__ float lo_f(unsigned w) { return __uint_as_float(w << 16); }
__device__ __forceinline__ float hi_f(unsigned w) { return __uint_as_float(w & 0xffff0000u); }
__device__ __forceinline__ float silu_f(float x) { return x / (1.f + __expf(-x)); }
__device__ __forceinline__ float wave_sum(float v) {
#pragma unroll
  for (int o = 32; o > 0; o >>= 1) v += __shfl_xor(v, o);
  return v;
}
#define QSCALE 0.18033688011112042f
#define SB __builtin_amdgcn_sched_barrier(0)
#define MFMA(a, b, c) __builtin_amdgcn_mfma_f32_16x16x32_bf16((a), (b), (c), 0, 0, 0)

__device__ __forceinline__ void convT_tile(const float* __restrict__ src, int src_ld, bf16_t* __restrict__ dst, int dst_ld, unsigned char* lds) {
  float* t = (float*)lds;
  const int tid = HTID;
  const int kr = tid >> 4, nc = (tid & 15) * 4;
#pragma unroll
  for (int j = 0; j < 4; ++j) {
    const float4 v = *(const float4*)(src + (size_t)(kr + 16 * j) * src_ld + nc);
    float* tp = t + (kr + 16 * j) * 65 + nc;
    tp[0] = v.x; tp[1] = v.y; tp[2] = v.z; tp[3] = v.w;
  }
  __syncthreads();
  const int n = tid >> 2, kc = (tid & 3) * 16;
  unsigned w[8];
#pragma unroll
  for (int i = 0; i < 8; ++i) w[i] = pack2(t[(kc + 2 * i) * 65 + n], t[(kc + 2 * i + 1) * 65 + n]);
  uint4* d = (uint4*)(dst + (size_t)n * dst_ld + kc);
  d[0] = make_uint4(w[0], w[1], w[2], w[3]);
  d[1] = make_uint4(w[4], w[5], w[6], w[7]);
  __syncthreads();
}

__device__ __forceinline__ int conv_weights_count(const Params& p, int l) {
  const LayerInfo L = layer_info(p, l);
  return (L.IN / 64) * 16 + (L.WIDTH / 64) * 16;
}
__device__ __forceinline__ void conv_weights_item(const Params& p, int l, int it, unsigned char* lds) {
  const LayerInfo L = layer_info(p, l);
  const int nin = (L.IN / 64) * 16;
  if (it < nin) {
    const int kt = it & 15, nt = it >> 4;
    convT_tile(L.w_in + (size_t)(kt * 64) * L.IN + nt * 64, L.IN, (bf16_t*)(p.ws + OFF_WIN) + (size_t)(nt * 64) * 1024 + kt * 64, 1024, lds);
  } else {
    const int it2 = it - nin, nkt = L.WIDTH / 64;
    const int kt = it2 % nkt, nt = it2 / nkt;
    convT_tile(L.w_out + (size_t)(kt * 64) * 1024 + nt * 64, 1024, (bf16_t*)(p.ws + OFF_WOUT) + (size_t)(nt * 64) * L.WIDTH + kt * 64, L.WIDTH, lds);
  }
}

__device__ __forceinline__ void mod_item(const Params& p, int it, unsigned char* lds) {
  float* ssilu = (float*)lds;
  float* red = ssilu + 9 * 1024;
  const int tid = HTID;
  const int l = it / 48, col0 = (it % 48) * 64;
  for (int i = tid; i < 9 * 1024; i += 256) {
    const int v = i >> 10, k = i & 1023;
    const float x = (v == 0) ? p.in[7][k] : p.in[6][(v - 1) * 1024 + k];
    ssilu[i] = silu_f(x);
  }
  __syncthreads();
  const int col = tid & 63, kq = tid >> 6;
  const float* w = p.in[8] + (size_t)l * 1024 * 3072 + col0 + col;
  float acc[9];
#pragma unroll
  for (int v = 0; v < 9; ++v) acc[v] = 0.f;
  for (int k = kq * 256; k < kq * 256 + 256; ++k) {
    const float wv = w[(size_t)k * 3072];
#pragma unroll
    for (int v = 0; v < 9; ++v) acc[v] += ssilu[v * 1024 + k] * wv;
  }
#pragma unroll
  for (int v = 0; v < 9; ++v) red[(kq * 9 + v) * 64 + col] = acc[v];
  __syncthreads();
  float* mod = (float*)(p.ws + OFF_MISC);
  for (int i = tid; i < 9 * 64; i += 256) {
    const int v = i >> 6, cc = i & 63;
    const float s = red[(0 * 9 + v) * 64 + cc] + red[(1 * 9 + v) * 64 + cc] + red[(2 * 9 + v) * 64 + cc] + red[(3 * 9 + v) * 64 + cc];
    mod[(size_t)(l * 9 + v) * 3072 + col0 + cc] = s + p.in[9][l * 3072 + col0 + cc];
  }
  __syncthreads();
}

__device__ __forceinline__ void rope_item(const Params& p, int it) {
  const int idx = it * 256 + HTID;
  const int t = idx >> 5, pp = idx & 31;
  const int pos = pp < 16 ? (t >> 6) : (t & 63);
  const float inv = exp2f(-(float)(pp & 15) * (13.287712379549449f / 16.f));
  const float ang = (float)pos * inv;
  const double a = (double)ang;
  const double r = a - 6.283185307179586 * rint(a * 0.15915494309189535);
  const float rf = (float)r;
  float2* tab = (float2*)(p.ws + OFF_MISC + MISC_ROPE);
  tab[idx] = make_float2(__cosf(rf), __sinf(rf));
}

__device__ __forceinline__ void phase0(const Params& p, unsigned char* lds) {
  const int nw = conv_weights_count(p, 0);
  const int total = 192 + 256 + nw;
  for (int it = VBID; it < total; it += VGDIM) {
    if (it < 192) mod_item(p, it, lds);
    else if (it < 448) rope_item(p, it - 192);
    else conv_weights_item(p, 0, it - 448, lds);
  }
}

__device__ __forceinline__ void post_phase(const Params& p, int lprev, int lnext, unsigned char* lds, const bool dry) {
  const int tid = HTID, lane = tid & 63, w = tid >> 6;
  const float* mod = (const float*)(p.ws + OFF_MISC);
  const bf16_t* Y = nullptr;
  if (lprev >= 0) {
    const int kind = layer_info(p, lprev).kind;
    Y = (const bf16_t*)(p.ws + (kind == 1 ? 96 * MIB : 0));
  }
  bf16_t* hp = (bf16_t*)(p.ws + OFF_HP);
  bf16_t* hs = lnext < 4 ? hs_ptr(p, lnext) : nullptr;
  for (int row = VBID * 4 + w; row < 24576; row += VGDIM * 4) {
    const int mv = row < 8192 ? 0 : 1 + ((row - 8192) >> 11);
    const float* xs = (lprev <= 0) ? (row < 8192 ? p.in[0] + (size_t)row * 1024 : p.in[1] + (size_t)(row - 8192) * 1024) : p.out + (size_t)row * 1024;
    float4 x[4];
#pragma unroll
    for (int j = 0; j < 4; ++j) x[j] = *(const float4*)(xs + lane * 4 + 256 * j);
    if (lprev >= 0) {
      float4 y[4];
      float ss = 0.f;
#pragma unroll
      for (int j = 0; j < 4; ++j) { const uint2 yw = *(const uint2*)(Y + (size_t)row * 1024 + lane * 4 + 256 * j); y[j] = make_float4(lo_f(yw.x), hi_f(yw.x), lo_f(yw.y), hi_f(yw.y)); ss += y[j].x * y[j].x + y[j].y * y[j].y + y[j].z * y[j].z + y[j].w * y[j].w; }
      ss = wave_sum(ss);
      const float rstd = rsqrtf(ss * (1.f / 1024.f) + 1e-6f);
      const float* ga = mod + (size_t)(lprev * 9 + mv) * 3072 + 2048;
      const float* gp = p.in[11] + lprev * 1024;
#pragma unroll
      for (int j = 0; j < 4; ++j) {
        const int c = lane * 4 + 256 * j;
        const float4 g4 = *(const float4*)(ga + c), p4 = *(const float4*)(gp + c);
        x[j].x += g4.x * (y[j].x * rstd * p4.x); x[j].y += g4.y * (y[j].y * rstd * p4.y);
        x[j].z += g4.z * (y[j].z * rstd * p4.z); x[j].w += g4.w * (y[j].w * rstd * p4.w);
        if (!dry) *(float4*)(p.out + (size_t)row * 1024 + c) = x[j];
      }
    }
    if (lnext < 4) {
      float ss = 0.f;
#pragma unroll
      for (int j = 0; j < 4; ++j) ss += x[j].x * x[j].x + x[j].y * x[j].y + x[j].z * x[j].z + x[j].w * x[j].w;
      ss = wave_sum(ss);
      const float rstd = rsqrtf(ss * (1.f / 1024.f) + 1e-6f);
      const float* sh = mod + (size_t)(lnext * 9 + mv) * 3072;
      const float* sc = sh + 1024;
      const float* gp = p.in[10] + lnext * 1024;
      bf16_t* hd = row < 8192 ? hp + (size_t)row * 1024 : hs + (size_t)(row - 8192) * 1024;
#pragma unroll
      for (int j = 0; j < 4; ++j) {
        const int c = lane * 4 + 256 * j;
        const float4 s4 = *(const float4*)(sh + c), c4 = *(const float4*)(sc + c), p4 = *(const float4*)(gp + c);
        const float h0 = x[j].x * rstd * p4.x * (1.f + c4.x) + s4.x, h1 = x[j].y * rstd * p4.y * (1.f + c4.y) + s4.y;
        const float h2 = x[j].z * rstd * p4.z * (1.f + c4.z) + s4.z, h3 = x[j].w * rstd * p4.w * (1.f + c4.w) + s4.w;
        *(uint2*)(hd + c) = make_uint2(pack2(h0, h1), pack2(h2, h3));
      }
    }
  }
  if (lprev >= 0 && lnext < 4) {
    const int nw = conv_weights_count(p, lnext);
    for (int it = VBID; it < nw; it += VGDIM) conv_weights_item(p, lnext, it, lds);
  }
}


__device__ __forceinline__ unsigned xcc_id() { return (unsigned)__builtin_amdgcn_s_getreg((3 << 11) | 20) & 7u; }
__device__ __forceinline__ bool wq_next(unsigned* ctr, int nst, int mult, unsigned xcd, int& qstate, int& q, int& idx, unsigned char* lds) {
  volatile int* slot = (volatile int*)(lds + LDS_SLOT);
  __syncthreads();
  if (HTID == 0) {
    int qq = -1, ii = 0, st = qstate;
    while (st < 8) {
      const int cand = (int)((xcd + (unsigned)st) & 7u);
      const int got = (int)atomicAdd(ctr + cand, 1u);
      if (got < mult * ((nst - cand + 7) >> 3)) { qq = cand; ii = got; break; }
      ++st;
    }
    slot[0] = qq; slot[1] = ii; slot[2] = st;
  }
  __syncthreads();
  q = slot[0]; idx = slot[1]; qstate = slot[2];
  return q >= 0;
}

#define LAS __attribute__((address_space(3)))
template <bool SWAP>
__device__ __forceinline__ void gemm_tile_compute(const bf16_t* __restrict__ Ag, const bf16_t* __restrict__ Bg, int K, unsigned char* lds, f32x4 (&acc)[8][4],
                                                  const bool pre, const bf16_t* __restrict__ An, const bf16_t* __restrict__ Bn, const bool hasn) {
  const int tid = threadIdx.x, lane = tid & 63, wid = __builtin_amdgcn_readfirstlane(tid >> 6), wm = wid >> 2, wn = wid & 3;
  const int lr = lane & 15, lg = lane >> 4;
  LAS unsigned char* l3 = (LAS unsigned char*)lds;
  const int prow = lane >> 3;
  const int pgo0 = prow * K + (((lane & 7) ^ ((prow >> 1) & 7)) << 3);
  const int pgo1 = prow * K + (((lane & 7) ^ ((4 + (prow >> 1)) & 7)) << 3);
  const bf16_t* asrc = Ag + (size_t)(wid * 32) * K;
  const bf16_t* bsrc = Bg + (size_t)(wid * 32) * K;
  const size_t pstep = (size_t)8 * K;
#pragma unroll
  for (int mi = 0; mi < 8; ++mi)
#pragma unroll
    for (int ni = 0; ni < 4; ++ni) acc[mi][ni] = (f32x4){0.f, 0.f, 0.f, 0.f};
#define GEMM_STAGE_P(ap_, bp_, s, k0)                                                                                                      \
  {                                                                                                                                        \
    _Pragma("unroll") for (int j = 0; j < 4; ++j) {                                                                                        \
      __builtin_amdgcn_global_load_lds((const unsigned*)((ap_) + j * pstep + ((j & 1) ? pgo1 : pgo0) + (k0)), (LAS unsigned*)(l3 + (s) * 65536 + (wid * 4 + j) * 1024), 16, 0, 0);          \
      __builtin_amdgcn_global_load_lds((const unsigned*)((bp_) + j * pstep + ((j & 1) ? pgo1 : pgo0) + (k0)), (LAS unsigned*)(l3 + (s) * 65536 + 32768 + (wid * 4 + j) * 1024), 16, 0, 0);  \
    }                                                                                                                                      \
  }
#define GEMM_STAGE(s, k0) GEMM_STAGE_P(asrc, bsrc, s, k0)
  const int nk = K >> 6;
  if (!pre) GEMM_STAGE(0, 0);
  asm volatile("s_waitcnt vmcnt(0)" ::: "memory");
  __syncthreads();
  const int x0 = lg ^ ((lr >> 1) & 7);
  const int aoff0 = (wm * 128 + lr) * 128 + x0 * 16, aoff1 = (wm * 128 + lr) * 128 + (x0 ^ 4) * 16;
  const int boff0 = 32768 + (wn * 64 + lr) * 128 + x0 * 16, boff1 = 32768 + (wn * 64 + lr) * 128 + (x0 ^ 4) * 16;
  for (int kt = 0; kt < nk; ++kt) {
    if (kt + 1 < nk) GEMM_STAGE((kt + 1) & 1, (kt + 1) * 64);
    const unsigned char* st = lds + (kt & 1) * 65536;
#pragma unroll
    for (int kk = 0; kk < 2; ++kk) {
      bf16x8 af[8], bfr[4];
#pragma unroll
      for (int ni = 0; ni < 4; ++ni) bfr[ni] = *(const bf16x8*)(st + (kk ? boff1 : boff0) + ni * 2048);
#pragma unroll
      for (int mi = 0; mi < 8; ++mi) af[mi] = *(const bf16x8*)(st + (kk ? aoff1 : aoff0) + mi * 2048);
#pragma unroll
      for (int mi = 0; mi < 8; ++mi)
#pragma unroll
        for (int ni = 0; ni < 4; ++ni)
          acc[mi][ni] = SWAP ? MFMA(bfr[ni], af[mi], acc[mi][ni]) : MFMA(af[mi], bfr[ni], acc[mi][ni]);
    }
    asm volatile("s_waitcnt vmcnt(0)" ::: "memory");
    __syncthreads();
  }
  if (hasn) { const bf16_t* an_ = An + (size_t)(wid * 32) * K; const bf16_t* bn_ = Bn + (size_t)(wid * 32) * K; GEMM_STAGE_P(an_, bn_, 0, 0); }
#undef GEMM_STAGE
#undef GEMM_STAGE_P
}

enum { GM_IN_DA = 0, GM_IN_RET_QKV = 1, GM_IN_RET_G = 2, GM_IN_HG = 3, GM_OUT = 4 };

__device__ __forceinline__ void epi_swapped(const Params& p, int mode, int slot, int ykind, int m, int n, f32x4 v) {
  bf16_t* R0 = (bf16_t*)p.ws;
  if (mode == GM_OUT) {
    bf16_t* Y = (bf16_t*)(p.ws + (ykind == 1 ? 96 * MIB : 0));
    *(uint2*)(Y + (size_t)m * 1024 + n) = make_uint2(pack2(v[0], v[1]), pack2(v[2], v[3]));
  } else if (mode == GM_IN_DA) {
    const bool smp = m >= 8192;
    const int ms = m - 8192;
    const int b = smp ? (ms >> 11) : (m >> 8), t = smp ? (ms & 2047) : (m & 255);
    if (n < 2048) {
      if (smp) {
        const float4 cs = *(const float4*)((const float*)(p.ws + OFF_MISC + MISC_ROPE) + (size_t)(t * 32 + ((n & 63) >> 1)) * 2);
        const float a0 = v[0] * cs.x - v[1] * cs.y, a1 = v[0] * cs.y + v[1] * cs.x;
        const float a2 = v[2] * cs.z - v[3] * cs.w, a3 = v[2] * cs.w + v[3] * cs.z;
        v = (f32x4){a0, a1, a2, a3};
      }
      if (n < 1024) {
        *(uint2*)(R0 + (size_t)m * 1024 + n) = make_uint2(pack2(v[0] * QSCALE, v[1] * QSCALE), pack2(v[2] * QSCALE, v[3] * QSCALE));
      } else {
        const int c = n - 1024;
        const uint2 pk = make_uint2(pack2(v[0], v[1]), pack2(v[2], v[3]));
        if (smp) {
          *(uint2*)(R0 + 64 * MIB / 2 + ((size_t)b * 2560 + t) * 1024 + c) = pk;
        } else {
          *(f32x4*)(p.out + OUT_CK + ((size_t)((b * 2 + slot) * 256 + t)) * 1024 + c) = v;
          *(uint2*)(R0 + 48 * MIB / 2 + (size_t)m * 1024 + c) = pk;
        }
      }
    } else {
      *(uint2*)(R0 + 160 * MIB / 2 + (size_t)m * 1024 + (n - 3072)) = make_uint2(pack2(silu_f(v[0]), silu_f(v[1])), pack2(silu_f(v[2]), silu_f(v[3])));
    }
  } else if (mode == GM_IN_RET_QKV) {
    if (n < 1024) *(uint2*)(R0 + (size_t)m * 1024 + n) = make_uint2(pack2(v[0], v[1]), pack2(v[2], v[3]));
    else if (n < 2048) { const float s = 0.08838834764831845f; *(uint2*)(R0 + PLANE_E + (size_t)m * 1024 + (n - 1024)) = make_uint2(pack2(v[0] * s, v[1] * s), pack2(v[2] * s, v[3] * s)); }
    else *(uint2*)(R0 + 2 * PLANE_E + (size_t)m * 2048 + (n - 2048)) = make_uint2(pack2(v[0], v[1]), pack2(v[2], v[3]));
  } else if (mode == GM_IN_RET_G) {
    *(uint2*)(R0 + (size_t)m * 2048 + n) = make_uint2(pack2(silu_f(v[0]), silu_f(v[1])), pack2(silu_f(v[2]), silu_f(v[3])));
  } else {
    if (n < 1024 || n >= 4096) v = (f32x4){silu_f(v[0]), silu_f(v[1]), silu_f(v[2]), silu_f(v[3])};
    *(uint2*)(R0 + (size_t)(n >> 10) * PLANE_E + (size_t)m * 1024 + (n & 1023)) = make_uint2(pack2(v[0], v[1]), pack2(v[2], v[3]));
  }
}

__device__ __forceinline__ void epi_da_v(const Params& p, int slot, int m, int n, f32x4 v) {
  bf16_t* R0 = (bf16_t*)p.ws;
  const int c = n - 2048, hh = c >> 7, e = c & 127;
  const uint2 pk = make_uint2(pack2(v[0], v[1]), pack2(v[2], v[3]));
  if (m >= 8192) {
    const int ms = m - 8192, b = ms >> 11, t = ms & 2047;
    *(uint2*)(R0 + 120 * MIB / 2 + ((size_t)((b * 8 + hh) * 128 + e)) * 2560 + t) = pk;
  } else {
    const int b = m >> 8, t = m & 255;
    float* o = p.out + OUT_CV + ((size_t)((b * 2 + slot) * 256 + t)) * 1024 + c;
    o[0] = v[0]; o[1024] = v[1]; o[2048] = v[2]; o[3072] = v[3];
    *(uint2*)(R0 + 104 * MIB / 2 + ((size_t)((b * 8 + hh) * 128 + e)) * 256 + t) = pk;
  }
}

__device__ __forceinline__ void gemm_phase(const Params& p, int l, int mode, unsigned char* lds, int phid) {
  const LayerInfo L = layer_info(p, l);
  bf16_t* R0 = (bf16_t*)p.ws;
  const bf16_t *Ap, *As, *Bt;
  int K, N;
  if (mode == GM_OUT) {
    K = L.WIDTH; N = 1024; Bt = (const bf16_t*)(p.ws + OFF_WOUT);
    const bf16_t* base = R0 + (L.kind == 0 ? 160 * MIB / 2 : (L.kind == 1 ? 4 * PLANE_E : 5 * PLANE_E));
    Ap = base; As = base + (size_t)8192 * K;
  } else {
    K = 1024; Ap = (const bf16_t*)(p.ws + OFF_HP); As = hs_ptr(p, l);
    Bt = (const bf16_t*)(p.ws + OFF_WIN) + (mode == GM_IN_RET_G ? (size_t)4096 * 1024 : 0);
    N = (mode == GM_IN_DA || mode == GM_IN_RET_QKV) ? 4096 : (mode == GM_IN_RET_G ? 2048 : 5120);
  }
  const int ntn = N >> 8, ntiles = 96 * ntn;
  const int extra = (mode == GM_IN_DA) ? 3072 : 0;
  const int tid = threadIdx.x, lane = tid & 63, wid = tid >> 6, wm = wid >> 2, wn = wid & 3, lr = lane & 15, lg = lane >> 4;
  const int G = gridDim.x;
  const bool swz = (G & 7) == 0;
  const int xcd = blockIdx.x & 7, snn = ntn >> 2, nst = 12 * snn;
  const int q0 = swz ? (int)(blockIdx.x >> 3) : (int)blockIdx.x, qstep = swz ? (G >> 3) : G;
  const int qlen = swz ? 32 * ((nst - xcd + 7) >> 3) : ntiles;
#define GEMM_TILE_OF(qq, m0_, n0_)                                                   \
  {                                                                                    \
    int it_ = (qq);                                                                    \
    if (swz) {                                                                         \
      const int st_ = xcd + 8 * ((qq) >> 5), tin_ = (qq) & 31;                         \
      const int smt_ = st_ / snn, snt_ = st_ - smt_ * snn;                             \
      it_ = (smt_ * 8 + (tin_ >> 2)) * ntn + snt_ * 4 + (tin_ & 3);                    \
    }                                                                                  \
    const int mt_ = it_ / ntn;                                                         \
    m0_ = mt_ * 256; n0_ = (it_ - mt_ * ntn) * 256;                                    \
  }
  bool pre = false;
  for (int q = q0; q < qlen; q += qstep) {
    int m0, n0;
    GEMM_TILE_OF(q, m0, n0)
    const bf16_t* A = m0 < 8192 ? Ap + (size_t)m0 * K : As + (size_t)(m0 - 8192) * K;
    const bf16_t* B = Bt + (size_t)n0 * K;
    const bool hasn = q + qstep < qlen;
    const bf16_t *An = A, *Bn = B;
    if (hasn) {
      int m1, n1;
      GEMM_TILE_OF(q + qstep, m1, n1)
      An = m1 < 8192 ? Ap + (size_t)m1 * K : As + (size_t)(m1 - 8192) * K;
      Bn = Bt + (size_t)n1 * K;
    }
    {
      f32x4 acc[8][4];
      if (mode == GM_IN_DA && n0 >= 2048 && n0 < 3072) {
        gemm_tile_compute<false>(A, B, K, lds, acc, pre, An, Bn, hasn);
#pragma unroll
        for (int mi = 0; mi < 8; ++mi)
#pragma unroll
          for (int ni = 0; ni < 4; ++ni)
            epi_da_v(p, L.slot, m0 + wm * 128 + mi * 16 + 4 * lg, n0 + wn * 64 + ni * 16 + lr, acc[mi][ni]);
      } else {
        gemm_tile_compute<true>(A, B, K, lds, acc, pre, An, Bn, hasn);
#pragma unroll
        for (int mi = 0; mi < 8; ++mi)
#pragma unroll
          for (int ni = 0; ni < 4; ++ni)
            epi_swapped(p, mode, L.slot, L.kind, m0 + wm * 128 + mi * 16 + lr, n0 + wn * 64 + ni * 16 + 4 * lg, acc[mi][ni]);
      }
    }
    pre = hasn;
  }
#undef GEMM_TILE_OF
  if (extra) { asm volatile("s_waitcnt vmcnt(0)" ::: "memory"); __syncthreads(); }
  for (int ci = VBID; ci < extra; ci += VGDIM) {
    {
      if (ci < 2048) {
        const int idx = (ci * 256 + HTID) * 8;
        const int b = idx >> 19, rem = idx & 524287, tp = rem >> 10, c = rem & 1023;
        const float* src = p.in[2] + ((size_t)((b * 2 + L.slot) * 512 + tp)) * 1024 + c;
        const float4 u0 = *(const float4*)src, u1 = *(const float4*)(src + 4);
        *(uint4*)(R0 + 64 * MIB / 2 + ((size_t)b * 2560 + 2048 + tp) * 1024 + c) = make_uint4(pack2(u0.x, u0.y), pack2(u0.z, u0.w), pack2(u1.x, u1.y), pack2(u1.z, u1.w));
      } else {
        const int i2 = ci - 2048;
        const int b = i2 >> 7, hh = (i2 >> 4) & 7, tt = (i2 >> 1) & 7, et = i2 & 1;
        convT_tile(p.in[3] + ((size_t)((b * 2 + L.slot) * 512 + tt * 64)) * 1024 + hh * 128 + et * 64, 1024,
                   R0 + 120 * MIB / 2 + ((size_t)((b * 8 + hh) * 128 + et * 64)) * 2560 + 2048 + tt * 64, 2560, lds + HALFID * HALF_LDS);
      }
    }
  }
}

__device__ __forceinline__ void attn_phase(const Params& p, int l, unsigned char* lds, const bool dry, int phid) {
  const int slot = l == 3 ? 1 : 0;
  const float lam_init = 0.8f - 0.6f * expf(-0.3f * (float)l);
  const int tid = threadIdx.x, lane = tid & 63, w = tid >> 6, lr = lane & 15, lg = lane >> 4;
  float lam;
  {
    const float* lf = p.in[14] + slot * 256;
    const float a = wave_sum(lf[lane] * lf[64 + lane]);
    const float b2 = wave_sum(lf[128 + lane] * lf[192 + lane]);
    lam = expf(a) - expf(b2) + lam_init;
  }
  bf16_t* R0 = (bf16_t*)p.ws;
  const float* subg = p.in[15] + slot * 128;
  for (int item = blockIdx.x; item < 1536; item += gridDim.x) {
    int grp, b, h, qt;
    if (item < 1024) { grp = 1; b = item >> 7; h = (item >> 4) & 7; qt = item & 15; }
    else { const int i2 = item - 1024; grp = 0; b = i2 >> 4; h = (i2 >> 1) & 7; qt = i2 & 1; }
    const int nkeys = grp ? 2560 : 256, ntile = nkeys >> 6;
    const int mq = (grp ? 8192 + b * 2048 : b * 256) + qt * 128 + w * 16 + lr;
    const bf16_t* Kg = grp ? R0 + 64 * MIB / 2 + (size_t)b * 2560 * 1024 + h * 128 : R0 + 48 * MIB / 2 + (size_t)b * 256 * 1024 + h * 128;
    const bf16_t* Vg = grp ? R0 + 120 * MIB / 2 + (size_t)(b * 8 + h) * 128 * 2560 : R0 + 104 * MIB / 2 + (size_t)(b * 8 + h) * 128 * 256;
    bf16x8 qf[2][2];
#pragma unroll
    for (int sub = 0; sub < 2; ++sub)
#pragma unroll
      for (int ks = 0; ks < 2; ++ks) qf[sub][ks] = *(const bf16x8*)(R0 + (size_t)mq * 1024 + h * 128 + sub * 64 + ks * 32 + lg * 8);
    LAS unsigned char* l3 = (LAS unsigned char*)lds;
    const int wu = __builtin_amdgcn_readfirstlane(w);
    int koff[2], voff[2];
#pragma unroll
    for (int j = 0; j < 2; ++j) {
      const int kr = (wu * 2 + j) * 4 + (lane >> 4);
      koff[j] = kr * 1024 + (((lane & 15) ^ (kr & 15)) << 3);
      const int er = (wu * 2 + j) * 8 + (lane >> 3);
      voff[j] = er * nkeys + (((lane & 7) ^ ((er >> 1) & 7)) << 3);
    }
#define ATT_STAGE_K(s, key0)                                                                                  \
  {                                                                                                           \
    _Pragma("unroll") for (int j = 0; j < 2; ++j)                                                             \
      __builtin_amdgcn_global_load_lds((const unsigned*)(Kg + (size_t)(key0) * 1024 + koff[j]), (LAS unsigned*)(l3 + (s) * 32768 + (wu * 2 + j) * 1024), 16, 0, 0); \
  }
#define ATT_STAGE_V(s, key0)                                                                                  \
  {                                                                                                           \
    _Pragma("unroll") for (int j = 0; j < 2; ++j)                                                             \
      __builtin_amdgcn_global_load_lds((const unsigned*)(Vg + (key0) + voff[j]), (LAS unsigned*)(l3 + (s) * 32768 + 16384 + (wu * 2 + j) * 1024), 16, 0, 0); \
  }
    const int xl = lg ^ lr;
    const int vsw = (lr >> 1) & 7;
    const int vlo = lr * 128 + ((((lg >> 1)) ^ vsw) << 4) + (lg & 1) * 8;
    float mx[2] = {-1e30f, -1e30f}, ls[2] = {0.f, 0.f};
    f32x4 o0[8], o1[8];
#pragma unroll
    for (int et = 0; et < 8; ++et) { o0[et] = (f32x4){0.f, 0.f, 0.f, 0.f}; o1[et] = (f32x4){0.f, 0.f, 0.f, 0.f}; }
    ATT_STAGE_K(0, 0);
    ATT_STAGE_V(0, 0);
    asm volatile("s_waitcnt vmcnt(0)" ::: "memory");
    __syncthreads();
    for (int kt = 0; kt < ntile; ++kt) {
      if (kt + 1 < ntile) { ATT_STAGE_K((kt + 1) & 1, (kt + 1) * 64); ATT_STAGE_V((kt + 1) & 1, (kt + 1) * 64); }
      const unsigned char* ks_ = lds + (kt & 1) * 32768 + lr * 256;
      const unsigned char* vs_ = lds + (kt & 1) * 32768 + 16384;
#pragma unroll
      for (int k2 = 0; k2 < 2; ++k2) {
        bf16x8 kfr[8];
        uint2 vlo_[8], vhi_[8];
#pragma unroll
        for (int sub = 0; sub < 2; ++sub)
#pragma unroll
          for (int nn = 0; nn < 2; ++nn)
#pragma unroll
            for (int ks = 0; ks < 2; ++ks)
              kfr[sub * 4 + nn * 2 + ks] = *(const bf16x8*)(ks_ + (2 * k2 + nn) * 4096 + ((xl ^ (sub * 8 + ks * 4)) << 4));
#pragma unroll
        for (int et = 0; et < 8; ++et) {
          vlo_[et] = *(const uint2*)(vs_ + et * 2048 + (vlo ^ (k2 << 6)));
          vhi_[et] = *(const uint2*)(vs_ + et * 2048 + (vlo ^ (k2 << 6) ^ 32));
        }
        SB;
        f32x4 s[2][2];
#pragma unroll
        for (int sub = 0; sub < 2; ++sub)
#pragma unroll
          for (int nn = 0; nn < 2; ++nn) {
            s[sub][nn] = MFMA(kfr[sub * 4 + nn * 2], qf[sub][0], ((f32x4){0.f, 0.f, 0.f, 0.f}));
            s[sub][nn] = MFMA(kfr[sub * 4 + nn * 2 + 1], qf[sub][1], s[sub][nn]);
          }
        SB;
        bf16x8 pf[2];
        float tmx[2];
#pragma unroll
        for (int sub = 0; sub < 2; ++sub) {
          float tm = fmaxf(fmaxf(fmaxf(s[sub][0][0], s[sub][0][1]), fmaxf(s[sub][0][2], s[sub][0][3])), fmaxf(fmaxf(s[sub][1][0], s[sub][1][1]), fmaxf(s[sub][1][2], s[sub][1][3])));
          tm = fmaxf(tm, __shfl_xor(tm, 16));
          tm = fmaxf(tm, __shfl_xor(tm, 32));
          tmx[sub] = tm;
        }
        if (__any((tmx[0] > mx[0] + 8.f) || (tmx[1] > mx[1] + 8.f))) {
#pragma unroll
          for (int sub = 0; sub < 2; ++sub) {
            const float mn = (tmx[sub] > mx[sub] + 8.f) ? tmx[sub] : mx[sub];
            const float sc = __builtin_amdgcn_exp2f(mx[sub] - mn);
            mx[sub] = mn;
            ls[sub] *= sc;
#pragma unroll
            for (int et = 0; et < 8; ++et) {
              if (sub == 0) { o0[et][0] *= sc; o0[et][1] *= sc; o0[et][2] *= sc; o0[et][3] *= sc; }
              else { o1[et][0] *= sc; o1[et][1] *= sc; o1[et][2] *= sc; o1[et][3] *= sc; }
            }
          }
        }
#pragma unroll
        for (int sub = 0; sub < 2; ++sub) {
          unsigned pw[4];
          float acc = 0.f;
#pragma unroll
          for (int nn = 0; nn < 2; ++nn) {
            float a[4];
#pragma unroll
            for (int r = 0; r < 4; ++r) { a[r] = __builtin_amdgcn_exp2f(s[sub][nn][r] - mx[sub]); acc += a[r]; }
            pw[nn * 2] = pack2(a[0], a[1]);
            pw[nn * 2 + 1] = pack2(a[2], a[3]);
          }
          ls[sub] += acc;
          union { unsigned u[4]; bf16x8 v; } cp;
          cp.u[0] = pw[0]; cp.u[1] = pw[1]; cp.u[2] = pw[2]; cp.u[3] = pw[3];
          pf[sub] = cp.v;
        }
        SB;
#pragma unroll
        for (int et = 0; et < 8; ++et) {
          union { unsigned u[4]; bf16x8 v; } cv;
          cv.u[0] = vlo_[et].x; cv.u[1] = vlo_[et].y; cv.u[2] = vhi_[et].x; cv.u[3] = vhi_[et].y;
          o0[et] = MFMA(cv.v, pf[0], o0[et]);
          o1[et] = MFMA(cv.v, pf[1], o1[et]);
        }
        SB;
      }
      asm volatile("s_waitcnt vmcnt(0)" ::: "memory");
      __syncthreads();
    }
    f32x4 o[8];
    {
      float t0 = ls[0], t1 = ls[1];
      t0 += __shfl_xor(t0, 16); t0 += __shfl_xor(t0, 32);
      t1 += __shfl_xor(t1, 16); t1 += __shfl_xor(t1, 32);
      const float c1 = 1.f / t0, c2 = lam / t1;
#pragma unroll
      for (int et = 0; et < 8; ++et)
#pragma unroll
        for (int r = 0; r < 4; ++r) o[et][r] = o0[et][r] * c1 - o1[et][r] * c2;
    }
#undef ATT_STAGE_K
#undef ATT_STAGE_V
    float ss = 0.f;
#pragma unroll
    for (int et = 0; et < 8; ++et)
#pragma unroll
      for (int r = 0; r < 4; ++r) ss += o[et][r] * o[et][r];
    ss += __shfl_xor(ss, 16);
    ss += __shfl_xor(ss, 32);
    const float rs = rsqrtf(ss * (1.f / 128.f) + 1e-6f) * (1.f - lam_init);
    bf16_t* gp = R0 + 160 * MIB / 2 + (size_t)mq * 1024 + h * 128;
#pragma unroll
    for (int et = 0; et < 8; ++et) {
      const int e0 = 16 * et + 4 * lg;
      const uint2 g = *(const uint2*)(gp + e0);
      const float4 sg = *(const float4*)(subg + e0);
      const float v0 = o[et][0] * rs * sg.x * lo_f(g.x), v1 = o[et][1] * rs * sg.y * hi_f(g.x);
      const float v2 = o[et][2] * rs * sg.z * lo_f(g.y), v3 = o[et][3] * rs * sg.w * hi_f(g.y);
      if (!dry) *(uint2*)(gp + e0) = make_uint2(pack2(v0, v1), pack2(v2, v3));
    }
  }
}

__device__ __forceinline__ bf16_t* hg_ob_row(const Params& p, int m) {
  const int c = m >> 9;
  float* base = c < 32 ? p.out + OUT_CK + (size_t)(c * 2 + 1) * 262144 : p.out + OUT_CV + (size_t)((c - 32) * 2 + 1) * 262144;
  return (bf16_t*)base + (size_t)(m & 511) * 1024;
}

__device__ __forceinline__ bf16_t* ret_ob_row(const Params& p, int ms) {
  const int c = ms >> 8;
  float* base = c < 32 ? p.out + OUT_CK + (size_t)(c * 2 + 1) * 262144 : p.out + OUT_CV + (size_t)((c - 32) * 2 + 1) * 262144;
  return (bf16_t*)base + (size_t)(ms & 255) * 2048;
}

template <int KIND, int DIR>
__device__ __forceinline__ void scan_item(const Params& p, int item, unsigned char* lds, const bool dry) {
  constexpr int DV = KIND == 1 ? 256 : 128, NSL = DV / 64, LDV = KIND == 1 ? 2048 : 1024;
  const int tid = HTID, lane = tid & 63, w = tid >> 6, lr = lane & 15, lg = lane >> 4;
  int grp, b, h, sl;
  {
    int it = item;
    if (it < 64 * NSL) grp = 1; else { grp = 0; it -= 64 * NSL; }
    sl = it % NSL; h = (it / NSL) & 7; b = it / (NSL * 8);
  }
  const int T = grp ? 2048 : 256, nch = T >> 6;
  const size_t mbase = grp ? (size_t)8192 + (size_t)b * 2048 : (size_t)b * 256;
  bf16_t* R0 = (bf16_t*)p.ws;
  const bf16_t* Qg = R0 + mbase * 1024 + h * 128;
  const bf16_t* Kg = R0 + (KIND == 1 ? PLANE_E : (DIR ? 2 * PLANE_E : PLANE_E)) + mbase * 1024 + h * 128;
  const bf16_t* Vg = R0 + (KIND == 1 ? 2 * PLANE_E : 3 * PLANE_E) + mbase * LDV + h * DV + sl * 64;
  bf16_t* Og = R0 + (KIND == 1 ? 4 * PLANE_E : 5 * PLANE_E) + mbase * LDV + h * DV + sl * 64;
  unsigned char* Qs = lds;
  unsigned char* X = lds + 17408;
  unsigned char* Vt = lds + 35840;
  unsigned char* StS = lds + 45056;
  unsigned char* Pm = lds + 62464;
  float* xch = (float*)(lds + 71680);
  float* blA = xch + 512;
  float* erA = xch + 640;
  const int dp = tid & 63, tq = tid >> 6, r0 = tq * 16, d0 = dp * 2;
  float cst0, cst1;
  if (KIND == 1) { cst0 = cst1 = log1pf(-expf(p.in[18][DIR * 8 + h])) * 1.4426950408889634f; }
  else {
    const float* lbp = p.in[21] + DIR * 4096 + h * 128 + d0;
    {
      const float x0 = lbp[0], x1 = lbp[1024], x2 = lbp[2048], x3 = lbp[3072];
      const float m = fmaxf(fmaxf(x0, x1), fmaxf(x2, x3));
      const float e0 = expf(x0 - m), e1 = expf(x1 - m), e2 = expf(x2 - m), e3 = expf(x3 - m);
      cst0 = (e1 + e2) / (e0 + e1 + e2 + e3);
    }
    {
      const float x0 = lbp[1], x1 = lbp[1025], x2 = lbp[2049], x3 = lbp[3073];
      const float m = fmaxf(fmaxf(x0, x1), fmaxf(x2, x3));
      const float e0 = expf(x0 - m), e1 = expf(x1 - m), e2 = expf(x2 - m), e3 = expf(x3 - m);
      cst1 = (e1 + e2) / (e0 + e1 + e2 + e3);
    }
  }
  f32x4 S[8];
  if (grp) {
    const float* s0 = (KIND == 1 ? p.in[4] : p.in[5]) + ((size_t)((b * 2 + DIR) * 8 + h) * 128) * DV + sl * 64 + 16 * w + lr + (size_t)(4 * lg) * DV;
    asm volatile("" : "+v"(s0));
#pragma unroll
    for (int dt = 0; dt < 8; ++dt)
#pragma unroll
      for (int r = 0; r < 4; ++r) S[dt][r] = s0[(16 * dt + r) * DV];
  } else {
#pragma unroll
    for (int dt = 0; dt < 8; ++dt) S[dt] = (f32x4){0.f, 0.f, 0.f, 0.f};
  }
  unsigned qv[16], kv[16], vv[8];
  const int ve2 = tid & 31, vq = tid >> 5;
  const int qoff = r0 * 512 + dp;
  const int voff = (8 * vq) * (LDV / 2) + ve2;
  const unsigned* Qg32 = (const unsigned*)Qg;
  const unsigned* Kg32 = (const unsigned*)Kg;
  const unsigned* Vg32 = (const unsigned*)Vg;
#define SCAN_ISSUE(c)                                                                                   \
  {                                                                                                     \
    const unsigned* q_ = Qg32 + (size_t)(c) * (64 * 512) + qoff;                                        \
    const unsigned* k_ = Kg32 + (size_t)(c) * (64 * 512) + qoff;                                        \
    const unsigned* v_ = Vg32 + (size_t)(c) * (64 * (LDV / 2)) + voff;                                  \
    asm volatile("" : "+v"(q_), "+v"(k_), "+v"(v_));                                                    \
    _Pragma("unroll") for (int i = 0; i < 16; ++i) { qv[i] = q_[i * 512]; kv[i] = k_[i * 512]; }        \
    _Pragma("unroll") for (int i = 0; i < 8; ++i) vv[i] = v_[i * (LDV / 2)];                            \
  }
  if (KIND == 1) {
    if (tid < 64) {
      const float ex = (DIR ? (float)(32 - tid) : (float)(tid - 31)) * cst0;
      *(float2*)(xch + 2 * tid) = make_float2(__builtin_amdgcn_exp2f(ex), __builtin_amdgcn_exp2f(-ex));
    }
    if (tid < 128) { blA[tid] = __builtin_amdgcn_exp2f(64.f * cst0); erA[tid] = __builtin_amdgcn_exp2f(32.f * cst0); }
    __syncthreads();
  }
  SCAN_ISSUE(DIR ? nch - 1 : 0);
  for (int ci = 0; ci < nch; ++ci) {
    const int c = DIR ? nch - 1 - ci : ci;
    unsigned ktp0[8], ktp1[8];
    if (KIND == 1) {
      const float cbr = __builtin_amdgcn_exp2f(32.f * cst0);
#pragma unroll
      for (int j = 0; j < 8; ++j) {
        float ka[2], kb[2];
#pragma unroll
        for (int hh = 0; hh < 2; ++hh) {
          const int i = 2 * j + hh;
          const float2 e = *(const float2*)(xch + 2 * (r0 + i));
          *(unsigned*)(Qs + (r0 + i) * 272 + d0 * 2) = pack2(lo_f(qv[i]) * e.x, hi_f(qv[i]) * e.x);
          const float kh0 = lo_f(kv[i]) * e.y, kh1 = hi_f(kv[i]) * e.y;
          *(unsigned*)(X + (r0 + i) * 272 + d0 * 2) = pack2(kh0, kh1);
          ka[hh] = kh0 * cbr;
          kb[hh] = kh1 * cbr;
        }
        ktp0[j] = pack2(ka[0], ka[1]);
        ktp1[j] = pack2(kb[0], kb[1]);
      }
    } else {
    float tot0 = 0.f, tot1 = 0.f;
#pragma unroll
    for (int i = 0; i < 16; ++i) {
      const float s0_ = 1.f / (1.f + __expf(-lo_f(kv[i]))), s1_ = 1.f / (1.f + __expf(-hi_f(kv[i])));
      tot0 += __log2f(cst0 + (1.f - cst0) * s0_);
      tot1 += __log2f(cst1 + (1.f - cst1) * s1_);
    }
    *(float2*)(xch + tq * 128 + d0) = make_float2(tot0, tot1);
    __syncthreads();
    const float2 t0 = *(const float2*)(xch + d0), t1 = *(const float2*)(xch + 128 + d0), t2 = *(const float2*)(xch + 256 + d0), t3 = *(const float2*)(xch + 384 + d0);
    const float blast0 = (t0.x + t1.x) + (t2.x + t3.x), blast1 = (t0.y + t1.y) + (t2.y + t3.y);
    float ref0, ref1, run0, run1;
    if (DIR == 0) {
      ref0 = t0.x + t1.x; ref1 = t0.y + t1.y;
      run0 = (tq > 0 ? t0.x : 0.f) + (tq > 1 ? t1.x : 0.f) + (tq > 2 ? t2.x : 0.f);
      run1 = (tq > 0 ? t0.y : 0.f) + (tq > 1 ? t1.y : 0.f) + (tq > 2 ? t2.y : 0.f);
    } else {
      ref0 = t2.x + t3.x; ref1 = t2.y + t3.y;
      run0 = (tq < 3 ? t3.x : 0.f) + (tq < 2 ? t2.x : 0.f) + (tq < 1 ? t1.x : 0.f);
      run1 = (tq < 3 ? t3.y : 0.f) + (tq < 2 ? t2.y : 0.f) + (tq < 1 ? t1.y : 0.f);
    }
    const float cbr0 = __builtin_amdgcn_exp2f(blast0 - ref0), cbr1 = __builtin_amdgcn_exp2f(blast1 - ref1);
#pragma unroll
    for (int jj = 0; jj < 8; ++jj) {
      const int j = DIR ? 7 - jj : jj;
      float ka[2], kb[2];
#pragma unroll
      for (int hh = 0; hh < 2; ++hh) {
        const int i = 2 * j + (DIR ? 1 - hh : hh);
        const float s0_ = 1.f / (1.f + __expf(-lo_f(kv[i]))), s1_ = 1.f / (1.f + __expf(-hi_f(kv[i])));
        const float g0 = __log2f(cst0 + (1.f - cst0) * s0_), g1 = __log2f(cst1 + (1.f - cst1) * s1_);
        const float k0 = (1.f - cst0) * (1.f - s0_), k1 = (1.f - cst1) * (1.f - s1_);
        run0 += g0; run1 += g1;
        *(unsigned*)(Qs + (r0 + i) * 272 + d0 * 2) = pack2(lo_f(qv[i]) * __builtin_amdgcn_exp2f(run0 - ref0), hi_f(qv[i]) * __builtin_amdgcn_exp2f(run1 - ref1));
        const float kh0 = k0 * __builtin_amdgcn_exp2f(ref0 - run0), kh1 = k1 * __builtin_amdgcn_exp2f(ref1 - run1);
        *(unsigned*)(X + (r0 + i) * 272 + d0 * 2) = pack2(kh0, kh1);
        ka[i & 1] = kh0 * cbr0;
        kb[i & 1] = kh1 * cbr1;
      }
      ktp0[j] = pack2(ka[0], ka[1]);
      ktp1[j] = pack2(kb[0], kb[1]);
    }
    if (tq == 0) { *(float2*)(blA + d0) = make_float2(__builtin_amdgcn_exp2f(blast0), __builtin_amdgcn_exp2f(blast1)); *(float2*)(erA + d0) = make_float2(__builtin_amdgcn_exp2f(ref0), __builtin_amdgcn_exp2f(ref1)); }
    }
    {
      const unsigned a0 = (vv[0] & 0xffffu) | (vv[1] << 16), a1 = (vv[2] & 0xffffu) | (vv[3] << 16), a2 = (vv[4] & 0xffffu) | (vv[5] << 16), a3 = (vv[6] & 0xffffu) | (vv[7] << 16);
      const unsigned b0 = (vv[0] >> 16) | (vv[1] & 0xffff0000u), b1 = (vv[2] >> 16) | (vv[3] & 0xffff0000u), b2 = (vv[4] >> 16) | (vv[5] & 0xffff0000u), b3 = (vv[6] >> 16) | (vv[7] & 0xffff0000u);
      *(uint4*)(Vt + (2 * ve2) * 144 + vq * 16) = make_uint4(a0, a1, a2, a3);
      *(uint4*)(Vt + (2 * ve2 + 1) * 144 + vq * 16) = make_uint4(b0, b1, b2, b3);
    }
    if (ci + 1 < nch) { SCAN_ISSUE(DIR ? c - 1 : c + 1); }
    __syncthreads();
#pragma unroll
    for (int dt = 0; dt < 8; ++dt) {
      const float4 er4 = *(const float4*)(erA + 16 * dt + 4 * lg);
      *(uint2*)(StS + (16 * w + lr) * 272 + (16 * dt + 4 * lg) * 2) = make_uint2(pack2(S[dt][0] * er4.x, S[dt][1] * er4.y), pack2(S[dt][2] * er4.z, S[dt][3] * er4.w));
    }
    bf16x8 qf[4];
#pragma unroll
    for (int ks = 0; ks < 4; ++ks) qf[ks] = *(const bf16x8*)(Qs + (16 * w + lr) * 272 + ks * 64 + lg * 16);
    uint2 pv[4];
    {
      const int t = 16 * w + lr;
#pragma unroll
      for (int st = 0; st < 4; ++st) {
        f32x4 s = (f32x4){0.f, 0.f, 0.f, 0.f};
#pragma unroll
        for (int ks = 0; ks < 4; ++ks) {
          const bf16x8 kf = *(const bf16x8*)(X + (16 * st + lr) * 272 + ks * 64 + lg * 16);
          s = MFMA(kf, qf[ks], s);
        }
        float v[4];
#pragma unroll
        for (int r = 0; r < 4; ++r) {
          const int si = 16 * st + 4 * lg + r;
          const bool keep = DIR ? (t <= si) : (t >= si);
          v[r] = keep ? s[r] : 0.f;
        }
        pv[st] = make_uint2(pack2(v[0], v[1]), pack2(v[2], v[3]));
      }
    }
    __syncthreads();
#pragma unroll
    for (int st = 0; st < 4; ++st) *(uint2*)(Pm + (16 * w + lr) * 144 + (16 * st + 4 * lg) * 2) = pv[st];
    *(uint4*)(X + d0 * 144 + r0 * 2) = make_uint4(ktp0[0], ktp0[1], ktp0[2], ktp0[3]);
    *(uint4*)(X + d0 * 144 + r0 * 2 + 16) = make_uint4(ktp0[4], ktp0[5], ktp0[6], ktp0[7]);
    *(uint4*)(X + (d0 + 1) * 144 + r0 * 2) = make_uint4(ktp1[0], ktp1[1], ktp1[2], ktp1[3]);
    *(uint4*)(X + (d0 + 1) * 144 + r0 * 2 + 16) = make_uint4(ktp1[4], ktp1[5], ktp1[6], ktp1[7]);
    __syncthreads();
    {
      bf16x8 pf[2];
#pragma unroll
      for (int ks = 0; ks < 2; ++ks) pf[ks] = *(const bf16x8*)(Pm + (16 * w + lr) * 144 + ks * 64 + lg * 16);
      const bool sep = DIR && (KIND == 2 || grp);
      bf16_t* orow = (KIND == 2 && DIR) ? hg_ob_row(p, (int)mbase + c * 64 + 16 * w + lr) + h * DV + sl * 64 + 4 * lg
                   : (KIND == 1 && DIR && grp) ? ret_ob_row(p, b * 2048 + c * 64 + 16 * w + lr) + h * DV + sl * 64 + 4 * lg
                                               : Og + (size_t)(c * 64 + 16 * w + lr) * LDV + 4 * lg;
#pragma unroll
      for (int et = 0; et < 4; ++et) {
        f32x4 o = (f32x4){0.f, 0.f, 0.f, 0.f};
#pragma unroll
        for (int ks = 0; ks < 2; ++ks) {
          const bf16x8 vf = *(const bf16x8*)(Vt + (16 * et + lr) * 144 + ks * 64 + lg * 16);
          o = MFMA(vf, pf[ks], o);
        }
#pragma unroll
        for (int ks = 0; ks < 4; ++ks) {
          const bf16x8 sf = *(const bf16x8*)(StS + (16 * et + lr) * 272 + ks * 64 + lg * 16);
          o = MFMA(sf, qf[ks], o);
        }
        bf16_t* op = orow + 16 * et;
        if (DIR && !sep) {
          const uint2 old = *(const uint2*)op;
          o[0] += lo_f(old.x); o[1] += hi_f(old.x); o[2] += lo_f(old.y); o[3] += hi_f(old.y);
        }
        if (!(DIR && !sep && dry)) *(uint2*)op = make_uint2(pack2(o[0], o[1]), pack2(o[2], o[3]));
      }
    }
    {
      bf16x8 vtf[2];
#pragma unroll
      for (int ks = 0; ks < 2; ++ks) vtf[ks] = *(const bf16x8*)(Vt + (16 * w + lr) * 144 + ks * 64 + lg * 16);
#pragma unroll
      for (int dt = 0; dt < 8; ++dt) {
        const float4 bl4 = *(const float4*)(blA + 16 * dt + 4 * lg);
        S[dt][0] *= bl4.x; S[dt][1] *= bl4.y; S[dt][2] *= bl4.z; S[dt][3] *= bl4.w;
#pragma unroll
        for (int ks = 0; ks < 2; ++ks) {
          const bf16x8 kf = *(const bf16x8*)(X + (16 * dt + lr) * 144 + ks * 64 + lg * 16);
          S[dt] = MFMA(kf, vtf[ks], S[dt]);
        }
      }
    }
    __syncthreads();
  }
#undef SCAN_ISSUE
  if (!grp) {
    float* so = p.out + (KIND == 1 ? OUT_SR : OUT_SH) + ((size_t)((b * 2 + DIR) * 8 + h) * 128) * DV + sl * 64 + 16 * w + lr + (size_t)(4 * lg) * DV;
    asm volatile("" : "+v"(so));
#pragma unroll
    for (int dt = 0; dt < 8; ++dt)
#pragma unroll
      for (int r = 0; r < 4; ++r) so[(16 * dt + r) * DV] = S[dt][r];
  }
}

template <int KIND, int DIR>
__device__ __forceinline__ void scan_phase(const Params& p, unsigned char* lds, const bool dry) {
  constexpr int NSL = (KIND == 1 ? 256 : 128) / 64;
  const int ns = 64 * NSL, npr = 256 * NSL;
  const int G = VGDIM, bid = VBID;
  int it, step, end = ns + npr;
  if (G > ns) {
    if (bid < ns) { it = bid; step = end; }
    else { it = ns + (bid - ns); step = G - ns; }
  } else { it = bid; step = G; }
  for (; it < end; it += step) scan_item<KIND, DIR>(p, it, lds, dry);
}

__device__ __forceinline__ void scan_phase_ret_sample(const Params& p, unsigned char* lds, const bool dry) {
  const int G = VGDIM >> 1, bid = VBID;
  const int role = bid >= G;
  const int rb = role ? bid - G : bid;
  if (role == 0) { for (int it = rb; it < 256; it += G) scan_item<1, 0>(p, it, lds, dry); }
  else           { for (int it = rb; it < 256; it += G) scan_item<1, 1>(p, it, lds, dry); }
}
template <int DIR>
__device__ __forceinline__ void scan_phase_ret_prompt(const Params& p, unsigned char* lds, const bool dry) {
  for (int it = VBID; it < 1024; it += VGDIM) scan_item<1, DIR>(p, 256 + it, lds, dry);
}

__device__ __forceinline__ void scan_phase_hg_both(const Params& p, unsigned char* lds, const bool dry) {
  const int G = VGDIM >> 1, bid = VBID;
  const int role = bid >= G;
  const int rb = role ? bid - G : bid;
  int it, step;
  if (G > 128) {
    if (rb < 128) { it = rb; step = 1 << 20; } else { it = rb; step = G - 128; }
  } else { it = rb; step = G; }
  if (role == 0) { for (; it < 640; it += step) scan_item<2, 0>(p, it, lds, dry); }
  else           { for (; it < 640; it += step) scan_item<2, 1>(p, it, lds, dry); }
}

template <int KIND>
__device__ __forceinline__ void normgate_phase(const Params& p, const bool dry) {
  constexpr int NCH = KIND == 1 ? 4 : 2, DV = KIND == 1 ? 256 : 128, LD = KIND == 1 ? 2048 : 1024;
  const int tid = HTID, lane = tid & 63, w = tid >> 6;
  const int hh = lane >> 3, sub = lane & 7;
  bf16_t* R0 = (bf16_t*)p.ws;
  bf16_t* Ob = R0 + (KIND == 1 ? 4 * PLANE_E : 5 * PLANE_E) + hh * DV + sub * 8;
  const bf16_t* Gb = R0 + (KIND == 1 ? 0 : 4 * PLANE_E) + hh * DV + sub * 8;
  float gn[NCH][8];
#pragma unroll
  for (int j = 0; j < NCH; ++j)
#pragma unroll
    for (int i = 0; i < 8; ++i) gn[j][i] = (KIND == 1) ? 1.f : p.in[22][j * 64 + sub * 8 + i];
  for (int row = VBID * 4 + w; row < 24576; row += VGDIM * 4) {
    bf16_t* op = Ob + (size_t)row * LD;
    const bf16_t* gp = Gb + (size_t)row * LD;
    uint4 ov[NCH], gv[NCH];
#pragma unroll
    for (int j = 0; j < NCH; ++j) { ov[j] = *(const uint4*)(op + j * 64); gv[j] = *(const uint4*)(gp + j * 64); }
    if (KIND == 2 || row >= 8192) {
      const bf16_t* bp = (KIND == 2 ? hg_ob_row(p, row) : ret_ob_row(p, row - 8192)) + hh * DV + sub * 8;
#pragma unroll
      for (int j = 0; j < NCH; ++j) {
        const uint4 bv = *(const uint4*)(bp + j * 64);
        ov[j].x = pack2(lo_f(ov[j].x) + lo_f(bv.x), hi_f(ov[j].x) + hi_f(bv.x));
        ov[j].y = pack2(lo_f(ov[j].y) + lo_f(bv.y), hi_f(ov[j].y) + hi_f(bv.y));
        ov[j].z = pack2(lo_f(ov[j].z) + lo_f(bv.z), hi_f(ov[j].z) + hi_f(bv.z));
        ov[j].w = pack2(lo_f(ov[j].w) + lo_f(bv.w), hi_f(ov[j].w) + hi_f(bv.w));
      }
    }
    float ss = 0.f;
#pragma unroll
    for (int j = 0; j < NCH; ++j) {
      const unsigned wv[4] = {ov[j].x, ov[j].y, ov[j].z, ov[j].w};
#pragma unroll
      for (int i = 0; i < 4; ++i) { const float a = lo_f(wv[i]), b2 = hi_f(wv[i]); ss += a * a + b2 * b2; }
    }
    ss += __shfl_xor(ss, 1);
    ss += __shfl_xor(ss, 2);
    ss += __shfl_xor(ss, 4);
    const float rs = rsqrtf(ss * (1.f / (float)DV) + 1e-6f);
#pragma unroll
    for (int j = 0; j < NCH; ++j) {
      const unsigned wv[4] = {ov[j].x, ov[j].y, ov[j].z, ov[j].w};
      const unsigned gw[4] = {gv[j].x, gv[j].y, gv[j].z, gv[j].w};
      unsigned r[4];
#pragma unroll
      for (int i = 0; i < 4; ++i)
        r[i] = pack2(lo_f(wv[i]) * rs * gn[j][2 * i] * lo_f(gw[i]), hi_f(wv[i]) * rs * gn[j][2 * i + 1] * hi_f(gw[i]));
      if (!dry) *(uint4*)(op + j * 64) = make_uint4(r[0], r[1], r[2], r[3]);
    }
  }
}

__device__ __forceinline__ void opaque_params(Params& q) {
  asm volatile("" : "+s"(q.out), "+s"(q.ws));
#pragma unroll
  for (int i = 0; i < 23; ++i) asm volatile("" : "+s"(q.in[i]));
}

struct BarState { unsigned* base; unsigned xcd, mycnt, nact, esub, etop; };
__device__ __forceinline__ void grid_barrier(BarState& b) {
  asm volatile("s_waitcnt vmcnt(0) lgkmcnt(0)" ::: "memory");
  __syncthreads();
  if (threadIdx.x == 0) {
    b.esub += b.mycnt; b.etop += b.nact;
    const unsigned old = __hip_atomic_fetch_add(b.base + 64 * b.xcd, 1u, __ATOMIC_RELAXED, __HIP_MEMORY_SCOPE_AGENT);
    if (old + 1u == b.esub) {
      __builtin_amdgcn_fence(__ATOMIC_RELEASE, "agent");
      __hip_atomic_fetch_add(b.base + 512, 1u, __ATOMIC_RELAXED, __HIP_MEMORY_SCOPE_AGENT);
    }
    while (__hip_atomic_load(b.base + 512, __ATOMIC_RELAXED, __HIP_MEMORY_SCOPE_AGENT) < b.etop) __builtin_amdgcn_s_sleep(1);
    __builtin_amdgcn_fence(__ATOMIC_ACQUIRE, "agent");
  }
  __syncthreads();
}
__device__ __forceinline__ void bar_census_post(BarState& b) {
  if (threadIdx.x == 0) __hip_atomic_fetch_add(b.base + 1024 + 64 * b.xcd, 1u, __ATOMIC_RELAXED, __HIP_MEMORY_SCOPE_AGENT);
}
__device__ __forceinline__ void bar_census_read(BarState& b) {
  if (threadIdx.x == 0) {
    unsigned n = 0;
    for (unsigned j = 0; j < 8; ++j) {
      const unsigned c = __hip_atomic_load(b.base + 1024 + 64 * j, __ATOMIC_RELAXED, __HIP_MEMORY_SCOPE_AGENT);
      n += (c != 0u);
      if (j == b.xcd) b.mycnt = c;
    }
    b.nact = n;
  }
}
#define GSYNC(n) { if ((n) == 0) { grid.sync(); bar_census_read(bst); } else grid_barrier(bst); }

#if defined(PH_ONLY)
#define PHASE(n, call) if (n == PH_ONLY) { const bool dry = false; call; }
#elif defined(REP_N)
#define PHASE(n, call) if (lo <= n && n < hi) { for (int rep = (n == REP_N ? 0 : 1); rep < 2; ++rep) { const bool dry = (rep == 0); call; if (!(fin && n + 1 == hi && rep == 1)) GSYNC(n) } }
#else
#define PHASE(n, call) if (lo <= n && n < hi) { const bool dry = false; call; if (!(fin && n + 1 == hi)) GSYNC(n) }
#endif

__device__ __forceinline__ void run_range(const Params& q, int lo, int hi, bool fin, cg::grid_group& grid, unsigned char* lds) {
  unsigned char* ldh = lds + HALFID * HALF_LDS;
  BarState bst; bst.base = (unsigned*)(q.ws + OFF_MISC + MISC_CTR); bst.xcd = xcc_id(); bst.mycnt = 0; bst.nact = 0; bst.esub = 0; bst.etop = 0;
  if (lo == 0) bar_census_post(bst);
  PHASE(0, phase0(q, ldh))
  PHASE(1, post_phase(q, -1, 0, ldh, dry))
  PHASE(2, gemm_phase(q, 0, GM_IN_DA, lds, 2))
  PHASE(3, attn_phase(q, 0, lds, dry, 3))
  PHASE(4, gemm_phase(q, 0, GM_OUT, lds, 4))
  PHASE(5, post_phase(q, 0, 1, ldh, dry))
  PHASE(6, gemm_phase(q, 1, GM_IN_RET_QKV, lds, 6))
  PHASE(7, scan_phase_ret_sample(q, ldh, dry))
  PHASE(8, scan_phase_ret_prompt<0>(q, ldh, dry))
  PHASE(8, scan_phase_ret_prompt<1>(q, ldh, dry))
  PHASE(9, gemm_phase(q, 1, GM_IN_RET_G, lds, 9))
  PHASE(10, normgate_phase<1>(q, dry))
  PHASE(11, gemm_phase(q, 1, GM_OUT, lds, 11))
  PHASE(12, post_phase(q, 1, 2, ldh, dry))
  PHASE(13, gemm_phase(q, 2, GM_IN_HG, lds, 13))
  PHASE(14, scan_phase_hg_both(q, ldh, dry))
  PHASE(16, normgate_phase<2>(q, dry))
  PHASE(17, gemm_phase(q, 2, GM_OUT, lds, 17))
  PHASE(18, post_phase(q, 2, 3, ldh, dry))
  PHASE(19, gemm_phase(q, 3, GM_IN_DA, lds, 19))
  PHASE(20, attn_phase(q, 3, lds, dry, 20))
  PHASE(21, gemm_phase(q, 3, GM_OUT, lds, 21))
  PHASE(22, post_phase(q, 3, 4, ldh, dry))
}

__global__ void __launch_bounds__(NTHR, 2) mega_fwd(Params p) {
  extern __shared__ __attribute__((aligned(16))) unsigned char lds[];
  cg::grid_group grid = cg::this_grid();
  run_range(p, p.ph_lo, p.ph_hi, true, grid, lds);
}

extern "C" void kernel_launch(void* const* d_in, const int* in_sizes, int n_in, void* d_out, int out_size, void* d_ws, size_t ws_size, hipStream_t stream) {
  static int grid_blocks = 0;
  if (grid_blocks == 0) {
    int dev = 0, cus = 0, per_cu = 0;
    hipGetDevice(&dev);
    hipDeviceGetAttribute(&cus, hipDeviceAttributeMultiprocessorCount, dev);
    hipFuncSetAttribute((const void*)mega_fwd, hipFuncAttributeMaxDynamicSharedMemorySize, LDS_BYTES);
    hipOccupancyMaxActiveBlocksPerMultiprocessor(&per_cu, (const void*)mega_fwd, NTHR, LDS_BYTES);
    if (per_cu < 1) per_cu = 1;
    if (per_cu > 1) per_cu = 1;
    if (cus < 1) cus = 256;
    grid_blocks = cus * per_cu;
    (void)hipGetLastError();
    if (n_in != 23 || ws_size < WS_NEED) { fprintf(stderr, "kernel_launch: unexpected n_in %d / ws_size %zu (need %zu)\n", n_in, ws_size, (size_t)WS_NEED); }
  }
  hipMemsetAsync((unsigned char*)d_ws + OFF_MISC + MISC_CTR, 0, 8192, stream);
  Params p{};
  for (int i = 0; i < 23; ++i) p.in[i] = (const float*)d_in[i];
  p.out = (float*)d_out;
  p.ws = (unsigned char*)d_ws;
#if ONE_LAUNCH
  p.ph_lo = 0; p.ph_hi = NPH;
  void* args[] = {&p};
  hipError_t e = hipLaunchCooperativeKernel((const void*)mega_fwd, dim3(grid_blocks), dim3(NTHR), args, LDS_BYTES, stream);
  if (e != hipSuccess) fprintf(stderr, "cooperative launch failed: %s (grid %d)\n", hipGetErrorString(e), grid_blocks);
#else
  for (int ph = 0; ph < NPH; ++ph) {
    p.ph_lo = ph; p.ph_hi = ph + 1;
    hipLaunchKernelGGL(mega_fwd, dim3(grid_blocks), dim3(NTHR), LDS_BYTES, stream, p);
  }
#endif
}
```

```cpp
#include <hip/hip_runtime.h>
#include <hip/hip_cooperative_groups.h>
#include <cstdint>
#include <cstdio>
namespace cg = cooperative_groups;

#ifndef ONE_LAUNCH
#define ONE_LAUNCH 1
#endif

typedef unsigned short bf16_t;
typedef short bf16x8 __attribute__((ext_vector_type(8)));
typedef float f32x4 __attribute__((ext_vector_type(4)));

#define NTHR 512
#define HTID ((int)(threadIdx.x & 255))
#define HALFID ((int)(threadIdx.x >> 8))
#define VBID ((int)(blockIdx.x * 2 + (threadIdx.x >> 8)))
#define VGDIM ((int)(gridDim.x * 2))
#define HALF_LDS 74816
#define MIB ((size_t)1 << 20)
#define NPH 23
#define LDS_BYTES (2 * HALF_LDS)
#define LDS_SLOT 74752
#define MISC_CTR (MISC_ROPE + 524288)

#define OFF_WIN  (288 * MIB)
#define OFF_WOUT (300 * MIB)
#define OFF_HP   (304 * MIB)
#define OFF_MISC (320 * MIB)
#define MISC_ROPE 524288
#define WS_NEED  (322 * MIB)
#define PLANE_E  ((size_t)25165824)
#define OUT_YP 0
#define OUT_YS 8388608
#define OUT_CK 25165824
#define OUT_CV 41943040
#define OUT_SR 58720256
#define OUT_SH 75497472

struct Params {
  const float* in[23];
  float* out;
  unsigned char* ws;
  int ph_lo, ph_hi;
};

struct LayerInfo { int kind, slot, IN, WIDTH; const float* w_in; const float* w_out; };

__device__ __forceinline__ LayerInfo layer_info(const Params& p, int l) {
  LayerInfo L;
  if (l == 0)      { L.kind = 0; L.slot = 0; L.IN = 4096; L.WIDTH = 1024; L.w_in = p.in[12]; L.w_out = p.in[13]; }
  else if (l == 1) { L.kind = 1; L.slot = 0; L.IN = 6144; L.WIDTH = 2048; L.w_in = p.in[16]; L.w_out = p.in[17]; }
  else if (l == 2) { L.kind = 2; L.slot = 0; L.IN = 5120; L.WIDTH = 1024; L.w_in = p.in[19]; L.w_out = p.in[20]; }
  else             { L.kind = 0; L.slot = 1; L.IN = 4096; L.WIDTH = 1024; L.w_in = p.in[12] + (size_t)1024 * 4096; L.w_out = p.in[13] + (size_t)1024 * 1024; }
  return L;
}
__device__ __forceinline__ bf16_t* hs_ptr(const Params& p, int l) {
  return l < 3 ? (bf16_t*)(p.out + OUT_SH) : (bf16_t*)(p.ws + 240 * MIB);
}

typedef __bf16 nbf16x2 __attribute__((ext_vector_type(2)));
typedef float f32x2 __attribute__((ext_vector_type(2)));
__device__ __forceinline__ float bf2f(unsigned h) { return __uint_as_float(h << 16); }
__device__ __forceinline__ unsigned pack2(float a, float b) { const f32x2 f = {a, b}; return __builtin_bit_cast(unsigned, __builtin_convertvector(f, nbf16x2)); }
__device__ __forceinline__ float lo_f(unsigned w) { return __uint_as_float(w << 16); }
__device__ __forceinline__ float hi_f(unsigned w) { return __uint_as_float(w & 0xffff0000u); }
__device__ __forceinline__ float silu_f(float x) { return x / (1.f + __expf(-x)); }
__device__ __forceinline__ float wave_sum(float v) {
#pragma unroll
  for (int o = 32; o > 0; o >>= 1) v += __shfl_xor(v, o);
  return v;
}
#define QSCALE 0.18033688011112042f
#define SB __builtin_amdgcn_sched_barrier(0)
#define MFMA(a, b, c) __builtin_amdgcn_mfma_f32_16x16x32_bf16((a), (b), (c), 0, 0, 0)

__device__ __forceinline__ void convT_tile(const float* __restrict__ src, int src_ld, bf16_t* __restrict__ dst, int dst_ld, unsigned char* lds) {
  float* t = (float*)lds;
  const int tid = HTID;
  const int kr = tid >> 4, nc = (tid & 15) * 4;
#pragma unroll
  for (int j = 0; j < 4; ++j) {
    const float4 v = *(const float4*)(src + (size_t)(kr + 16 * j) * src_ld + nc);
    float* tp = t + (kr + 16 * j) * 65 + nc;
    tp[0] = v.x; tp[1] = v.y; tp[2] = v.z; tp[3] = v.w;
  }
  __syncthreads();
  const int n = tid >> 2, kc = (tid & 3) * 16;
  unsigned w[8];
#pragma unroll
  for (int i = 0; i < 8; ++i) w[i] = pack2(t[(kc + 2 * i) * 65 + n], t[(kc + 2 * i + 1) * 65 + n]);
  uint4* d = (uint4*)(dst + (size_t)n * dst_ld + kc);
  d[0] = make_uint4(w[0], w[1], w[2], w[3]);
  d[1] = make_uint4(w[4], w[5], w[6], w[7]);
  __syncthreads();
}

__device__ __forceinline__ int conv_weights_count(const Params& p, int l) {
  const LayerInfo L = layer_info(p, l);
  return (L.IN / 64) * 16 + (L.WIDTH / 64) * 16;
}
__device__ __forceinline__ void conv_weights_item(const Params& p, int l, int it, unsigned char* lds) {
  const LayerInfo L = layer_info(p, l);
  const int nin = (L.IN / 64) * 16;
  if (it < nin) {
    const int kt = it & 15, nt = it >> 4;
    convT_tile(L.w_in + (size_t)(kt * 64) * L.IN + nt * 64, L.IN, (bf16_t*)(p.ws + OFF_WIN) + (size_t)(nt * 64) * 1024 + kt * 64, 1024, lds);
  } else {
    const int it2 = it - nin, nkt = L.WIDTH / 64;
    const int kt = it2 % nkt, nt = it2 / nkt;
    convT_tile(L.w_out + (size_t)(kt * 64) * 1024 + nt * 64, 1024, (bf16_t*)(p.ws + OFF_WOUT) + (size_t)(nt * 64) * L.WIDTH + kt * 64, L.WIDTH, lds);
  }
}

__device__ __forceinline__ void mod_item(const Params& p, int it, unsigned char* lds) {
  float* ssilu = (float*)lds;
  float* red = ssilu + 9 * 1024;
  const int tid = HTID;
  const int l = it / 48, col0 = (it % 48) * 64;
  for (int i = tid; i < 9 * 1024; i += 256) {
    const int v = i >> 10, k = i & 1023;
    const float x = (v == 0) ? p.in[7][k] : p.in[6][(v - 1) * 1024 + k];
    ssilu[i] = silu_f(x);
  }
  __syncthreads();
  const int col = tid & 63, kq = tid >> 6;
  const float* w = p.in[8] + (size_t)l * 1024 * 3072 + col0 + col;
  float acc[9];
#pragma unroll
  for (int v = 0; v < 9; ++v) acc[v] = 0.f;
  for (int k = kq * 256; k < kq * 256 + 256; ++k) {
    const float wv = w[(size_t)k * 3072];
#pragma unroll
    for (int v = 0; v < 9; ++v) acc[v] += ssilu[v * 1024 + k] * wv;
  }
#pragma unroll
  for (int v = 0; v < 9; ++v) red[(kq * 9 + v) * 64 + col] = acc[v];
  __syncthreads();
  float* mod = (float*)(p.ws + OFF_MISC);
  for (int i = tid; i < 9 * 64; i += 256) {
    const int v = i >> 6, cc = i & 63;
    const float s = red[(0 * 9 + v) * 64 + cc] + red[(1 * 9 + v) * 64 + cc] + red[(2 * 9 + v) * 64 + cc] + red[(3 * 9 + v) * 64 + cc];
    mod[(size_t)(l * 9 + v) * 3072 + col0 + cc] = s + p.in[9][l * 3072 + col0 + cc];
  }
  __syncthreads();
}

__device__ __forceinline__ void rope_item(const Params& p, int it) {
  const int idx = it * 256 + HTID;
  const int t = idx >> 5, pp = idx & 31;
  const int pos = pp < 16 ? (t >> 6) : (t & 63);
  const float inv = exp2f(-(float)(pp & 15) * (13.287712379549449f / 16.f));
  const float ang = (float)pos * inv;
  const double a = (double)ang;
  const double r = a - 6.283185307179586 * rint(a * 0.15915494309189535);
  const float rf = (float)r;
  float2* tab = (float2*)(p.ws + OFF_MISC + MISC_ROPE);
  tab[idx] = make_float2(__cosf(rf), __sinf(rf));
}

__device__ __forceinline__ void phase0(const Params& p, unsigned char* lds) {
  const int nw = conv_weights_count(p, 0);
  const int total = 192 + 256 + nw;
  for (int it = VBID; it < total; it += VGDIM) {
    if (it < 192) mod_item(p, it, lds);
    else if (it < 448) rope_item(p, it - 192);
    else conv_weights_item(p, 0, it - 448, lds);
  }
}

__device__ __forceinline__ void post_phase(const Params& p, int lprev, int lnext, unsigned char* lds, const bool dry) {
  const int tid = HTID, lane = tid & 63, w = tid >> 6;
  const float* mod = (const float*)(p.ws + OFF_MISC);
  const bf16_t* Y = nullptr;
  if (lprev >= 0) {
    const int kind = layer_info(p, lprev).kind;
    Y = (const bf16_t*)(p.ws + (kind == 1 ? 96 * MIB : 0));
  }
  bf16_t* hp = (bf16_t*)(p.ws + OFF_HP);
  bf16_t* hs = lnext < 4 ? hs_ptr(p, lnext) : nullptr;
  for (int row = VBID * 4 + w; row < 24576; row += VGDIM * 4) {
    const int mv = row < 8192 ? 0 : 1 + ((row - 8192) >> 11);
    const float* xs = (lprev <= 0) ? (row < 8192 ? p.in[0] + (size_t)row * 1024 : p.in[1] + (size_t)(row - 8192) * 1024) : p.out + (size_t)row * 1024;
    float4 x[4];
#pragma unroll
    for (int j = 0; j < 4; ++j) x[j] = *(const float4*)(xs + lane * 4 + 256 * j);
    if (lprev >= 0) {
      float4 y[4];
      float ss = 0.f;
#pragma unroll
      for (int j = 0; j < 4; ++j) { const uint2 yw = *(const uint2*)(Y + (size_t)row * 1024 + lane * 4 + 256 * j); y[j] = make_float4(lo_f(yw.x), hi_f(yw.x), lo_f(yw.y), hi_f(yw.y)); ss += y[j].x * y[j].x + y[j].y * y[j].y + y[j].z * y[j].z + y[j].w * y[j].w; }
      ss = wave_sum(ss);
      const float rstd = rsqrtf(ss * (1.f / 1024.f) + 1e-6f);
      const float* ga = mod + (size_t)(lprev * 9 + mv) * 3072 + 2048;
      const float* gp = p.in[11] + lprev * 1024;
#pragma unroll
      for (int j = 0; j < 4; ++j) {
        const int c = lane * 4 + 256 * j;
        const float4 g4 = *(const float4*)(ga + c), p4 = *(const float4*)(gp + c);
        x[j].x += g4.x * (y[j].x * rstd * p4.x); x[j].y += g4.y * (y[j].y * rstd * p4.y);
        x[j].z += g4.z * (y[j].z * rstd * p4.z); x[j].w += g4.w * (y[j].w * rstd * p4.w);
        if (!dry) *(float4*)(p.out + (size_t)row * 1024 + c) = x[j];
      }
    }
    if (lnext < 4) {
      float ss = 0.f;
#pragma unroll
      for (int j = 0; j < 4; ++j) ss += x[j].x * x[j].x + x[j].y * x[j].y + x[j].z * x[j].z + x[j].w * x[j].w;
      ss = wave_sum(ss);
      const float rstd = rsqrtf(ss * (1.f / 1024.f) + 1e-6f);
      const float* sh = mod + (size_t)(lnext * 9 + mv) * 3072;
      const float* sc = sh + 1024;
      const float* gp = p.in[10] + lnext * 1024;
      bf16_t* hd = row < 8192 ? hp + (size_t)row * 1024 : hs + (size_t)(row - 8192) * 1024;
#pragma unroll
      for (int j = 0; j < 4; ++j) {
        const int c = lane * 4 + 256 * j;
        const float4 s4 = *(const float4*)(sh + c), c4 = *(const float4*)(sc + c), p4 = *(const float4*)(gp + c);
        const float h0 = x[j].x * rstd * p4.x * (1.f + c4.x) + s4.x, h1 = x[j].y * rstd * p4.y * (1.f + c4.y) + s4.y;
        const float h2 = x[j].z * rstd * p4.z * (1.f + c4.z) + s4.z, h3 = x[j].w * rstd * p4.w * (1.f + c4.w) + s4.w;
        *(uint2*)(hd + c) = make_uint2(pack2(h0, h1), pack2(h2, h3));
      }
    }
  }
  if (lprev >= 0 && lnext < 4) {
    const int nw = conv_weights_count(p, lnext);
    for (int it = VBID; it < nw; it += VGDIM) conv_weights_item(p, lnext, it, lds);
  }
}


__device__ __forceinline__ unsigned xcc_id() { return (unsigned)__builtin_amdgcn_s_getreg((3 << 11) | 20) & 7u; }
__device__ __forceinline__ bool wq_next(unsigned* ctr, int nst, int mult, unsigned xcd, int& qstate, int& q, int& idx, unsigned char* lds) {
  volatile int* slot = (volatile int*)(lds + LDS_SLOT);
  __syncthreads();
  if (HTID == 0) {
    int qq = -1, ii = 0, st = qstate;
    while (st < 8) {
      const int cand = (int)((xcd + (unsigned)st) & 7u);
      const int got = (int)atomicAdd(ctr + cand, 1u);
      if (got < mult * ((nst - cand + 7) >> 3)) { qq = cand; ii = got; break; }
      ++st;
    }
    slot[0] = qq; slot[1] = ii; slot[2] = st;
  }
  __syncthreads();
  q = slot[0]; idx = slot[1]; qstate = slot[2];
  return q >= 0;
}

#define LAS __attribute__((address_space(3)))
template <bool SWAP>
__device__ __forceinline__ void gemm_tile_compute(const bf16_t* __restrict__ Ag, const bf16_t* __restrict__ Bg, int K, unsigned char* lds, f32x4 (&acc)[8][4],
                                                  const bool pre, const bf16_t* __restrict__ An, const bf16_t* __restrict__ Bn, const bool hasn) {
  const int tid = threadIdx.x, lane = tid & 63, wid = __builtin_amdgcn_readfirstlane(tid >> 6), wm = wid >> 2, wn = wid & 3;
  const int lr = lane & 15, lg = lane >> 4;
  LAS unsigned char* l3 = (LAS unsigned char*)lds;
  const int prow = lane >> 3;
  const int pgo0 = prow * K + (((lane & 7) ^ ((prow >> 1) & 7)) << 3);
  const int pgo1 = prow * K + (((lane & 7) ^ ((4 + (prow >> 1)) & 7)) << 3);
  const bf16_t* asrc = Ag + (size_t)(wid * 32) * K;
  const bf16_t* bsrc = Bg + (size_t)(wid * 32) * K;
  const size_t pstep = (size_t)8 * K;
#pragma unroll
  for (int mi = 0; mi < 8; ++mi)
#pragma unroll
    for (int ni = 0; ni < 4; ++ni) acc[mi][ni] = (f32x4){0.f, 0.f, 0.f, 0.f};
#define GEMM_STAGE_P(ap_, bp_, s, k0)                                                                                                      \
  {                                                                                                                                        \
    _Pragma("unroll") for (int j = 0; j < 4; ++j) {                                                                                        \
      __builtin_amdgcn_global_load_lds((const unsigned*)((ap_) + j * pstep + ((j & 1) ? pgo1 : pgo0) + (k0)), (LAS unsigned*)(l3 + (s) * 65536 + (wid * 4 + j) * 1024), 16, 0, 0);          \
      __builtin_amdgcn_global_load_lds((const unsigned*)((bp_) + j * pstep + ((j & 1) ? pgo1 : pgo0) + (k0)), (LAS unsigned*)(l3 + (s) * 65536 + 32768 + (wid * 4 + j) * 1024), 16, 0, 0);  \
    }                                                                                                                                      \
  }
#define GEMM_STAGE(s, k0) GEMM_STAGE_P(asrc, bsrc, s, k0)
  const int nk = K >> 6;
  if (!pre) GEMM_STAGE(0, 0);
  asm volatile("s_waitcnt vmcnt(0)" ::: "memory");
  __syncthreads();
  const int x0 = lg ^ ((lr >> 1) & 7);
  const int aoff0 = (wm * 128 + lr) * 128 + x0 * 16, aoff1 = (wm * 128 + lr) * 128 + (x0 ^ 4) * 16;
  const int boff0 = 32768 + (wn * 64 + lr) * 128 + x0 * 16, boff1 = 32768 + (wn * 64 + lr) * 128 + (x0 ^ 4) * 16;
  for (int kt = 0; kt < nk; ++kt) {
    if (kt + 1 < nk) GEMM_STAGE((kt + 1) & 1, (kt + 1) * 64);
    const unsigned char* st = lds + (kt & 1) * 65536;
#pragma unroll
    for (int kk = 0; kk < 2; ++kk) {
      bf16x8 af[8], bfr[4];
#pragma unroll
      for (int ni = 0; ni < 4; ++ni) bfr[ni] = *(const bf16x8*)(st + (kk ? boff1 : boff0) + ni * 2048);
#pragma unroll
      for (int mi = 0; mi < 8; ++mi) af[mi] = *(const bf16x8*)(st + (kk ? aoff1 : aoff0) + mi * 2048);
#pragma unroll
      for (int mi = 0; mi < 8; ++mi)
#pragma unroll
        for (int ni = 0; ni < 4; ++ni)
          acc[mi][ni] = SWAP ? MFMA(bfr[ni], af[mi], acc[mi][ni]) : MFMA(af[mi], bfr[ni], acc[mi][ni]);
    }
    asm volatile("s_waitcnt vmcnt(0)" ::: "memory");
    __syncthreads();
  }
  if (hasn) { const bf16_t* an_ = An + (size_t)(wid * 32) * K; const bf16_t* bn_ = Bn + (size_t)(wid * 32) * K; GEMM_STAGE_P(an_, bn_, 0, 0); }
#undef GEMM_STAGE
#undef GEMM_STAGE_P
}

enum { GM_IN_DA = 0, GM_IN_RET_QKV = 1, GM_IN_RET_G = 2, GM_IN_HG = 3, GM_OUT = 4 };

__device__ __forceinline__ void epi_swapped(const Params& p, int mode, int slot, int ykind, int m, int n, f32x4 v) {
  bf16_t* R0 = (bf16_t*)p.ws;
  if (mode == GM_OUT) {
    bf16_t* Y = (bf16_t*)(p.ws + (ykind == 1 ? 96 * MIB : 0));
    *(uint2*)(Y + (size_t)m * 1024 + n) = make_uint2(pack2(v[0], v[1]), pack2(v[2], v[3]));
  } else if (mode == GM_IN_DA) {
    const bool smp = m >= 8192;
    const int ms = m - 8192;
    const int b = smp ? (ms >> 11) : (m >> 8), t = smp ? (ms & 2047) : (m & 255);
    if (n < 2048) {
      if (smp) {
        const float4 cs = *(const float4*)((const float*)(p.ws + OFF_MISC + MISC_ROPE) + (size_t)(t * 32 + ((n & 63) >> 1)) * 2);
        const float a0 = v[0] * cs.x - v[1] * cs.y, a1 = v[0] * cs.y + v[1] * cs.x;
        const float a2 = v[2] * cs.z - v[3] * cs.w, a3 = v[2] * cs.w + v[3] * cs.z;
        v = (f32x4){a0, a1, a2, a3};
      }
      if (n < 1024) {
        *(uint2*)(R0 + (size_t)m * 1024 + n) = make_uint2(pack2(v[0] * QSCALE, v[1] * QSCALE), pack2(v[2] * QSCALE, v[3] * QSCALE));
      } else {
        const int c = n - 1024;
        const uint2 pk = make_uint2(pack2(v[0], v[1]), pack2(v[2], v[3]));
        if (smp) {
          *(uint2*)(R0 + 64 * MIB / 2 + ((size_t)b * 2560 + t) * 1024 + c) = pk;
        } else {
          *(f32x4*)(p.out + OUT_CK + ((size_t)((b * 2 + slot) * 256 + t)) * 1024 + c) = v;
          *(uint2*)(R0 + 48 * MIB / 2 + (size_t)m * 1024 + c) = pk;
        }
      }
    } else {
      *(uint2*)(R0 + 160 * MIB / 2 + (size_t)m * 1024 + (n - 3072)) = make_uint2(pack2(silu_f(v[0]), silu_f(v[1])), pack2(silu_f(v[2]), silu_f(v[3])));
    }
  } else if (mode == GM_IN_RET_QKV) {
    if (n < 1024) *(uint2*)(R0 + (size_t)m * 1024 + n) = make_uint2(pack2(v[0], v[1]), pack2(v[2], v[3]));
    else if (n < 2048) { const float s = 0.08838834764831845f; *(uint2*)(R0 + PLANE_E + (size_t)m * 1024 + (n - 1024)) = make_uint2(pack2(v[0] * s, v[1] * s), pack2(v[2] * s, v[3] * s)); }
    else *(uint2*)(R0 + 2 * PLANE_E + (size_t)m * 2048 + (n - 2048)) = make_uint2(pack2(v[0], v[1]), pack2(v[2], v[3]));
  } else if (mode == GM_IN_RET_G) {
    *(uint2*)(R0 + (size_t)m * 2048 + n) = make_uint2(pack2(silu_f(v[0]), silu_f(v[1])), pack2(silu_f(v[2]), silu_f(v[3])));
  } else {
    if (n < 1024 || n >= 4096) v = (f32x4){silu_f(v[0]), silu_f(v[1]), silu_f(v[2]), silu_f(v[3])};
    *(uint2*)(R0 + (size_t)(n >> 10) * PLANE_E + (size_t)m * 1024 + (n & 1023)) = make_uint2(pack2(v[0], v[1]), pack2(v[2], v[3]));
  }
}

__device__ __forceinline__ void epi_da_v(const Params& p, int slot, int m, int n, f32x4 v) {
  bf16_t* R0 = (bf16_t*)p.ws;
  const int c = n - 2048, hh = c >> 7, e = c & 127;
  const uint2 pk = make_uint2(pack2(v[0], v[1]), pack2(v[2], v[3]));
  if (m >= 8192) {
    const int ms = m - 8192, b = ms >> 11, t = ms & 2047;
    *(uint2*)(R0 + 120 * MIB / 2 + ((size_t)((b * 8 + hh) * 128 + e)) * 2560 + t) = pk;
  } else {
    const int b = m >> 8, t = m & 255;
    float* o = p.out + OUT_CV + ((size_t)((b * 2 + slot) * 256 + t)) * 1024 + c;
    o[0] = v[0]; o[1024] = v[1]; o[2048] = v[2]; o[3072] = v[3];
    *(uint2*)(R0 + 104 * MIB / 2 + ((size_t)((b * 8 + hh) * 128 + e)) * 256 + t) = pk;
  }
}

__device__ __forceinline__ void gemm_phase(const Params& p, int l, int mode, unsigned char* lds, int phid) {
  const LayerInfo L = layer_info(p, l);
  bf16_t* R0 = (bf16_t*)p.ws;
  const bf16_t *Ap, *As, *Bt;
  int K, N;
  if (mode == GM_OUT) {
    K = L.WIDTH; N = 1024; Bt = (const bf16_t*)(p.ws + OFF_WOUT);
    const bf16_t* base = R0 + (L.kind == 0 ? 160 * MIB / 2 : (L.kind == 1 ? 4 * PLANE_E : 5 * PLANE_E));
    Ap = base; As = base + (size_t)8192 * K;
  } else {
    K = 1024; Ap = (const bf16_t*)(p.ws + OFF_HP); As = hs_ptr(p, l);
    Bt = (const bf16_t*)(p.ws + OFF_WIN) + (mode == GM_IN_RET_G ? (size_t)4096 * 1024 : 0);
    N = (mode == GM_IN_DA || mode == GM_IN_RET_QKV) ? 4096 : (mode == GM_IN_RET_G ? 2048 : 5120);
  }
  const int ntn = N >> 8, ntiles = 96 * ntn;
  const int extra = (mode == GM_IN_DA) ? 3072 : 0;
  const int tid = threadIdx.x, lane = tid & 63, wid = tid >> 6, wm = wid >> 2, wn = wid & 3, lr = lane & 15, lg = lane >> 4;
  const int G = gridDim.x;
  const bool swz = (G & 7) == 0;
  const int xcd = blockIdx.x & 7, snn = ntn >> 2, nst = 12 * snn;
  const int q0 = swz ? (int)(blockIdx.x >> 3) : (int)blockIdx.x, qstep = swz ? (G >> 3) : G;
  const int qlen = swz ? 32 * ((nst - xcd + 7) >> 3) : ntiles;
#define GEMM_TILE_OF(qq, m0_, n0_)                                                   \
  {                                                                                    \
    int it_ = (qq);                                                                    \
    if (swz) {                                                                         \
      const int st_ = xcd + 8 * ((qq) >> 5), tin_ = (qq) & 31;                         \
      const int smt_ = st_ / snn, snt_ = st_ - smt_ * snn;                             \
      it_ = (smt_ * 8 + (tin_ >> 2)) * ntn + snt_ * 4 + (tin_ & 3);                    \
    }                                                                                  \
    const int mt_ = it_ / ntn;                                                         \
    m0_ = mt_ * 256; n0_ = (it_ - mt_ * ntn) * 256;                                    \
  }
  bool pre = false;
  for (int q = q0; q < qlen; q += qstep) {
    int m0, n0;
    GEMM_TILE_OF(q, m0, n0)
    const bf16_t* A = m0 < 8192 ? Ap + (size_t)m0 * K : As + (size_t)(m0 - 8192) * K;
    const bf16_t* B = Bt + (size_t)n0 * K;
    const bool hasn = q + qstep < qlen;
    const bf16_t *An = A, *Bn = B;
    if (hasn) {
      int m1, n1;
      GEMM_TILE_OF(q + qstep, m1, n1)
      An = m1 < 8192 ? Ap + (size_t)m1 * K : As + (size_t)(m1 - 8192) * K;
      Bn = Bt + (size_t)n1 * K;
    }
    {
      f32x4 acc[8][4];
      if (mode == GM_IN_DA && n0 >= 2048 && n0 < 3072) {
        gemm_tile_compute<false>(A, B, K, lds, acc, pre, An, Bn, hasn);
#pragma unroll
        for (int mi = 0; mi < 8; ++mi)
#pragma unroll
          for (int ni = 0; ni < 4; ++ni)
            epi_da_v(p, L.slot, m0 + wm * 128 + mi * 16 + 4 * lg, n0 + wn * 64 + ni * 16 + lr, acc[mi][ni]);
      } else {
        gemm_tile_compute<true>(A, B, K, lds, acc, pre, An, Bn, hasn);
#pragma unroll
        for (int mi = 0; mi < 8; ++mi)
#pragma unroll
          for (int ni = 0; ni < 4; ++ni)
            epi_swapped(p, mode, L.slot, L.kind, m0 + wm * 128 + mi * 16 + lr, n0 + wn * 64 + ni * 16 + 4 * lg, acc[mi][ni]);
      }
    }
    pre = hasn;
  }
#undef GEMM_TILE_OF
  if (extra) { asm volatile("s_waitcnt vmcnt(0)" ::: "memory"); __syncthreads(); }
  for (int ci = VBID; ci < extra; ci += VGDIM) {
    {
      if (ci < 2048) {
        const int idx = (ci * 256 + HTID) * 8;
        const int b = idx >> 19, rem = idx & 524287, tp = rem >> 10, c = rem & 1023;
        const float* src = p.in[2] + ((size_t)((b * 2 + L.slot) * 512 + tp)) * 1024 + c;
        const float4 u0 = *(const float4*)src, u1 = *(const float4*)(src + 4);
        *(uint4*)(R0 + 64 * MIB / 2 + ((size_t)b * 2560 + 2048 + tp) * 1024 + c) = make_uint4(pack2(u0.x, u0.y), pack2(u0.z, u0.w), pack2(u1.x, u1.y), pack2(u1.z, u1.w));
      } else {
        const int i2 = ci - 2048;
        const int b = i2 >> 7, hh = (i2 >> 4) & 7, tt = (i2 >> 1) & 7, et = i2 & 1;
        convT_tile(p.in[3] + ((size_t)((b * 2 + L.slot) * 512 + tt * 64)) * 1024 + hh * 128 + et * 64, 1024,
                   R0 + 120 * MIB / 2 + ((size_t)((b * 8 + hh) * 128 + et * 64)) * 2560 + 2048 + tt * 64, 2560, lds + HALFID * HALF_LDS);
      }
    }
  }
}

__device__ __forceinline__ void attn_phase(const Params& p, int l, unsigned char* lds, const bool dry, int phid) {
  const int slot = l == 3 ? 1 : 0;
  const float lam_init = 0.8f - 0.6f * expf(-0.3f * (float)l);
  const int tid = threadIdx.x, lane = tid & 63, w = tid >> 6, lr = lane & 15, lg = lane >> 4;
  float lam;
  {
    const float* lf = p.in[14] + slot * 256;
    const float a = wave_sum(lf[lane] * lf[64 + lane]);
    const float b2 = wave_sum(lf[128 + lane] * lf[192 + lane]);
    lam = expf(a) - expf(b2) + lam_init;
  }
  bf16_t* R0 = (bf16_t*)p.ws;
  const float* subg = p.in[15] + slot * 128;
  for (int item = blockIdx.x; item < 1536; item += gridDim.x) {
    int grp, b, h, qt;
    if (item < 1024) { grp = 1; b = item >> 7; h = (item >> 4) & 7; qt = item & 15; }
    else { const int i2 = item - 1024; grp = 0; b = i2 >> 4; h = (i2 >> 1) & 7; qt = i2 & 1; }
    const int nkeys = grp ? 2560 : 256, ntile = nkeys >> 7;
    const int mq = (grp ? 8192 + b * 2048 : b * 256) + qt * 128 + w * 16 + lr;
    const bf16_t* Kg = grp ? R0 + 64 * MIB / 2 + (size_t)b * 2560 * 1024 + h * 128 : R0 + 48 * MIB / 2 + (size_t)b * 256 * 1024 + h * 128;
    const bf16_t* Vg = grp ? R0 + 120 * MIB / 2 + (size_t)(b * 8 + h) * 128 * 2560 : R0 + 104 * MIB / 2 + (size_t)(b * 8 + h) * 128 * 256;
    bf16x8 qf[2][2];
#pragma unroll
    for (int sub = 0; sub < 2; ++sub)
#pragma unroll
      for (int ks = 0; ks < 2; ++ks) qf[sub][ks] = *(const bf16x8*)(R0 + (size_t)mq * 1024 + h * 128 + sub * 64 + ks * 32 + lg * 8);
    LAS unsigned char* l3 = (LAS unsigned char*)lds;
    const int wu = __builtin_amdgcn_readfirstlane(w);
    int koff[4], voff[4];
#pragma unroll
    for (int j = 0; j < 4; ++j) {
      const int kr = (wu * 4 + j) * 4 + (lane >> 4);
      koff[j] = kr * 1024 + (((lane & 15) ^ (kr & 15)) << 3);
      voff[j] = kr * nkeys + (((lane & 15) ^ (kr & 15)) << 3);
    }
#define ATT_STAGE_K(s, key0)                                                                                  \
  {                                                                                                           \
    _Pragma("unroll") for (int j = 0; j < 4; ++j)                                                             \
      __builtin_amdgcn_global_load_lds((const unsigned*)(Kg + (size_t)(key0) * 1024 + koff[j]), (LAS unsigned*)(l3 + (s) * 65536 + (wu * 4 + j) * 1024), 16, 0, 0); \
  }
#define ATT_STAGE_V(s, key0)                                                                                  \
  {                                                                                                           \
    _Pragma("unroll") for (int j = 0; j < 4; ++j)                                                             \
      __builtin_amdgcn_global_load_lds((const unsigned*)(Vg + (key0) + voff[j]), (LAS unsigned*)(l3 + (s) * 65536 + 32768 + (wu * 4 + j) * 1024), 16, 0, 0); \
  }
    const int xl = lg ^ lr;
    const int vsw = (lr >> 1) & 7;
    const int vlo = lr * 256 + ((((lg >> 1)) ^ lr) << 4) + (lg & 1) * 8;
    float mx[2] = {-1e30f, -1e30f}, ls[2] = {0.f, 0.f};
    f32x4 o0[8], o1[8];
#pragma unroll
    for (int et = 0; et < 8; ++et) { o0[et] = (f32x4){0.f, 0.f, 0.f, 0.f}; o1[et] = (f32x4){0.f, 0.f, 0.f, 0.f}; }
    ATT_STAGE_K(0, 0);
    ATT_STAGE_V(0, 0);
    asm volatile("s_waitcnt vmcnt(0)" ::: "memory");
    __syncthreads();
    for (int kt = 0; kt < ntile; ++kt) {
      if (kt + 1 < ntile) { ATT_STAGE_K((kt + 1) & 1, (kt + 1) * 128); ATT_STAGE_V((kt + 1) & 1, (kt + 1) * 128); }
      const unsigned char* ks_ = lds + (kt & 1) * 65536 + lr * 256;
      const unsigned char* vs_ = lds + (kt & 1) * 65536 + 32768;
#pragma unroll
      for (int k2 = 0; k2 < 4; ++k2) {
        bf16x8 kfr[8];
        uint2 vlo_[8], vhi_[8];
#pragma unroll
        for (int sub = 0; sub < 2; ++sub)
#pragma unroll
          for (int nn = 0; nn < 2; ++nn)
#pragma unroll
            for (int ks = 0; ks < 2; ++ks)
              kfr[sub * 4 + nn * 2 + ks] = *(const bf16x8*)(ks_ + (2 * k2 + nn) * 4096 + ((xl ^ (sub * 8 + ks * 4)) << 4));
#pragma unroll
        for (int et = 0; et < 8; ++et) {
          vlo_[et] = *(const uint2*)(vs_ + et * 4096 + (vlo ^ (k2 << 6)));
          vhi_[et] = *(const uint2*)(vs_ + et * 4096 + (vlo ^ (k2 << 6) ^ 32));
        }
        SB;
        f32x4 s[2][2];
#pragma unroll
        for (int sub = 0; sub < 2; ++sub)
#pragma unroll
          for (int nn = 0; nn < 2; ++nn) {
            s[sub][nn] = MFMA(kfr[sub * 4 + nn * 2], qf[sub][0], ((f32x4){0.f, 0.f, 0.f, 0.f}));
            s[sub][nn] = MFMA(kfr[sub * 4 + nn * 2 + 1], qf[sub][1], s[sub][nn]);
          }
        SB;
        bf16x8 pf[2];
        float tmx[2];
#pragma unroll
        for (int sub = 0; sub < 2; ++sub) {
          float tm = fmaxf(fmaxf(fmaxf(s[sub][0][0], s[sub][0][1]), fmaxf(s[sub][0][2], s[sub][0][3])), fmaxf(fmaxf(s[sub][1][0], s[sub][1][1]), fmaxf(s[sub][1][2], s[sub][1][3])));
          tm = fmaxf(tm, __shfl_xor(tm, 16));
          tm = fmaxf(tm, __shfl_xor(tm, 32));
          tmx[sub] = tm;
        }
        if (__any((tmx[0] > mx[0] + 8.f) || (tmx[1] > mx[1] + 8.f))) {
#pragma unroll
          for (int sub = 0; sub < 2; ++sub) {
            const float mn = (tmx[sub] > mx[sub] + 8.f) ? tmx[sub] : mx[sub];
            const float sc = __builtin_amdgcn_exp2f(mx[sub] - mn);
            mx[sub] = mn;
            ls[sub] *= sc;
#pragma unroll
            for (int et = 0; et < 8; ++et) {
              if (sub == 0) { o0[et][0] *= sc; o0[et][1] *= sc; o0[et][2] *= sc; o0[et][3] *= sc; }
              else { o1[et][0] *= sc; o1[et][1] *= sc; o1[et][2] *= sc; o1[et][3] *= sc; }
            }
          }
        }
#pragma unroll
        for (int sub = 0; sub < 2; ++sub) {
          unsigned pw[4];
          float acc = 0.f;
#pragma unroll
          for (int nn = 0; nn < 2; ++nn) {
            float a[4];
#pragma unroll
            for (int r = 0; r < 4; ++r) { a[r] = __builtin_amdgcn_exp2f(s[sub][nn][r] - mx[sub]); acc += a[r]; }
            pw[nn * 2] = pack2(a[0], a[1]);
            pw[nn * 2 + 1] = pack2(a[2], a[3]);
          }
          ls[sub] += acc;
          union { unsigned u[4]; bf16x8 v; } cp;
          cp.u[0] = pw[0]; cp.u[1] = pw[1]; cp.u[2] = pw[2]; cp.u[3] = pw[3];
          pf[sub] = cp.v;
        }
        SB;
#pragma unroll
        for (int et = 0; et < 8; ++et) {
          union { unsigned u[4]; bf16x8 v; } cv;
          cv.u[0] = vlo_[et].x; cv.u[1] = vlo_[et].y; cv.u[2] = vhi_[et].x; cv.u[3] = vhi_[et].y;
          o0[et] = MFMA(cv.v, pf[0], o0[et]);
          o1[et] = MFMA(cv.v, pf[1], o1[et]);
        }
        SB;
      }
      asm volatile("s_waitcnt vmcnt(0)" ::: "memory");
      __syncthreads();
    }
    f32x4 o[8];
    {
      float t0 = ls[0], t1 = ls[1];
      t0 += __shfl_xor(t0, 16); t0 += __shfl_xor(t0, 32);
      t1 += __shfl_xor(t1, 16); t1 += __shfl_xor(t1, 32);
      const float c1 = 1.f / t0, c2 = lam / t1;
#pragma unroll
      for (int et = 0; et < 8; ++et)
#pragma unroll
        for (int r = 0; r < 4; ++r) o[et][r] = o0[et][r] * c1 - o1[et][r] * c2;
    }
#undef ATT_STAGE_K
#undef ATT_STAGE_V
    float ss = 0.f;
#pragma unroll
    for (int et = 0; et < 8; ++et)
#pragma unroll
      for (int r = 0; r < 4; ++r) ss += o[et][r] * o[et][r];
    ss += __shfl_xor(ss, 16);
    ss += __shfl_xor(ss, 32);
    const float rs = rsqrtf(ss * (1.f / 128.f) + 1e-6f) * (1.f - lam_init);
    bf16_t* gp = R0 + 160 * MIB / 2 + (size_t)mq * 1024 + h * 128;
#pragma unroll
    for (int et = 0; et < 8; ++et) {
      const int e0 = 16 * et + 4 * lg;
      const uint2 g = *(const uint2*)(gp + e0);
      const float4 sg = *(const float4*)(subg + e0);
      const float v0 = o[et][0] * rs * sg.x * lo_f(g.x), v1 = o[et][1] * rs * sg.y * hi_f(g.x);
      const float v2 = o[et][2] * rs * sg.z * lo_f(g.y), v3 = o[et][3] * rs * sg.w * hi_f(g.y);
      if (!dry) *(uint2*)(gp + e0) = make_uint2(pack2(v0, v1), pack2(v2, v3));
    }
  }
}

__device__ __forceinline__ bf16_t* hg_ob_row(const Params& p, int m) {
  const int c = m >> 9;
  float* base = c < 32 ? p.out + OUT_CK + (size_t)(c * 2 + 1) * 262144 : p.out + OUT_CV + (size_t)((c - 32) * 2 + 1) * 262144;
  return (bf16_t*)base + (size_t)(m & 511) * 1024;
}

__device__ __forceinline__ bf16_t* ret_ob_row(const Params& p, int ms) {
  const int c = ms >> 8;
  float* base = c < 32 ? p.out + OUT_CK + (size_t)(c * 2 + 1) * 262144 : p.out + OUT_CV + (size_t)((c - 32) * 2 + 1) * 262144;
  return (bf16_t*)base + (size_t)(ms & 255) * 2048;
}

template <int KIND, int DIR>
__device__ __forceinline__ void scan_item(const Params& p, int item, unsigned char* lds, const bool dry) {
  constexpr int DV = KIND == 1 ? 256 : 128, NSL = DV / 64, LDV = KIND == 1 ? 2048 : 1024;
  const int tid = HTID, lane = tid & 63, w = tid >> 6, lr = lane & 15, lg = lane >> 4;
  int grp, b, h, sl;
  {
    int it = item;
    if (it < 64 * NSL) grp = 1; else { grp = 0; it -= 64 * NSL; }
    sl = it % NSL; h = (it / NSL) & 7; b = it / (NSL * 8);
  }
  const int T = grp ? 2048 : 256, nch = T >> 6;
  const size_t mbase = grp ? (size_t)8192 + (size_t)b * 2048 : (size_t)b * 256;
  bf16_t* R0 = (bf16_t*)p.ws;
  const bf16_t* Qg = R0 + mbase * 1024 + h * 128;
  const bf16_t* Kg = R0 + (KIND == 1 ? PLANE_E : (DIR ? 2 * PLANE_E : PLANE_E)) + mbase * 1024 + h * 128;
  const bf16_t* Vg = R0 + (KIND == 1 ? 2 * PLANE_E : 3 * PLANE_E) + mbase * LDV + h * DV + sl * 64;
  bf16_t* Og = R0 + (KIND == 1 ? 4 * PLANE_E : 5 * PLANE_E) + mbase * LDV + h * DV + sl * 64;
  unsigned char* Qs = lds;
  unsigned char* X = lds + 17408;
  unsigned char* Vt = lds + 35840;
  unsigned char* StS = lds + 45056;
  unsigned char* Pm = lds + 62464;
  float* xch = (float*)(lds + 71680);
  float* blA = xch + 512;
  float* erA = xch + 640;
  const int dp = tid & 63, tq = tid >> 6, r0 = tq * 16, d0 = dp * 2;
  float cst0, cst1;
  if (KIND == 1) { cst0 = cst1 = log1pf(-expf(p.in[18][DIR * 8 + h])) * 1.4426950408889634f; }
  else {
    const float* lbp = p.in[21] + DIR * 4096 + h * 128 + d0;
    {
      const float x0 = lbp[0], x1 = lbp[1024], x2 = lbp[2048], x3 = lbp[3072];
      const float m = fmaxf(fmaxf(x0, x1), fmaxf(x2, x3));
      const float e0 = expf(x0 - m), e1 = expf(x1 - m), e2 = expf(x2 - m), e3 = expf(x3 - m);
      cst0 = (e1 + e2) / (e0 + e1 + e2 + e3);
    }
    {
      const float x0 = lbp[1], x1 = lbp[1025], x2 = lbp[2049], x3 = lbp[3073];
      const float m = fmaxf(fmaxf(x0, x1), fmaxf(x2, x3));
      const float e0 = expf(x0 - m), e1 = expf(x1 - m), e2 = expf(x2 - m), e3 = expf(x3 - m);
      cst1 = (e1 + e2) / (e0 + e1 + e2 + e3);
    }
  }
  f32x4 S[8];
  if (grp) {
    const float* s0 = (KIND == 1 ? p.in[4] : p.in[5]) + ((size_t)((b * 2 + DIR) * 8 + h) * 128) * DV + sl * 64 + 16 * w + lr + (size_t)(4 * lg) * DV;
    asm volatile("" : "+v"(s0));
#pragma unroll
    for (int dt = 0; dt < 8; ++dt)
#pragma unroll
      for (int r = 0; r < 4; ++r) S[dt][r] = s0[(16 * dt + r) * DV];
  } else {
#pragma unroll
    for (int dt = 0; dt < 8; ++dt) S[dt] = (f32x4){0.f, 0.f, 0.f, 0.f};
  }
  unsigned qv[16], kv[16], vv[8];
  const int ve2 = tid & 31, vq = tid >> 5;
  const int qoff = r0 * 512 + dp;
  const int voff = (8 * vq) * (LDV / 2) + ve2;
  const unsigned* Qg32 = (const unsigned*)Qg;
  const unsigned* Kg32 = (const unsigned*)Kg;
  const unsigned* Vg32 = (const unsigned*)Vg;
#define SCAN_ISSUE(c)                                                                                   \
  {                                                                                                     \
    const unsigned* q_ = Qg32 + (size_t)(c) * (64 * 512) + qoff;                                        \
    const unsigned* k_ = Kg32 + (size_t)(c) * (64 * 512) + qoff;                                        \
    const unsigned* v_ = Vg32 + (size_t)(c) * (64 * (LDV / 2)) + voff;                                  \
    asm volatile("" : "+v"(q_), "+v"(k_), "+v"(v_));                                                    \
    _Pragma("unroll") for (int i = 0; i < 16; ++i) { qv[i] = q_[i * 512]; kv[i] = k_[i * 512]; }        \
    _Pragma("unroll") for (int i = 0; i < 8; ++i) vv[i] = v_[i * (LDV / 2)];                            \
  }
  if (KIND == 1) {
    if (tid < 64) {
      const float ex = (DIR ? (float)(32 - tid) : (float)(tid - 31)) * cst0;
      *(float2*)(xch + 2 * tid) = make_float2(__builtin_amdgcn_exp2f(ex), __builtin_amdgcn_exp2f(-ex));
    }
    if (tid < 128) { blA[tid] = __builtin_amdgcn_exp2f(64.f * cst0); erA[tid] = __builtin_amdgcn_exp2f(32.f * cst0); }
    __syncthreads();
  }
  SCAN_ISSUE(DIR ? nch - 1 : 0);
  for (int ci = 0; ci < nch; ++ci) {
    const int c = DIR ? nch - 1 - ci : ci;
    unsigned ktp0[8], ktp1[8];
    if (KIND == 1) {
      const float cbr = __builtin_amdgcn_exp2f(32.f * cst0);
#pragma unroll
      for (int j = 0; j < 8; ++j) {
        float ka[2], kb[2];
#pragma unroll
        for (int hh = 0; hh < 2; ++hh) {
          const int i = 2 * j + hh;
          const float2 e = *(const float2*)(xch + 2 * (r0 + i));
          *(unsigned*)(Qs + (r0 + i) * 272 + d0 * 2) = pack2(lo_f(qv[i]) * e.x, hi_f(qv[i]) * e.x);
          const float kh0 = lo_f(kv[i]) * e.y, kh1 = hi_f(kv[i]) * e.y;
          *(unsigned*)(X + (r0 + i) * 272 + d0 * 2) = pack2(kh0, kh1);
          ka[hh] = kh0 * cbr;
          kb[hh] = kh1 * cbr;
        }
        ktp0[j] = pack2(ka[0], ka[1]);
        ktp1[j] = pack2(kb[0], kb[1]);
      }
    } else {
    float tot0 = 0.f, tot1 = 0.f;
#pragma unroll
    for (int i = 0; i < 16; ++i) {
      const float s0_ = 1.f / (1.f + __expf(-lo_f(kv[i]))), s1_ = 1.f / (1.f + __expf(-hi_f(kv[i])));
      tot0 += __log2f(cst0 + (1.f - cst0) * s0_);
      tot1 += __log2f(cst1 + (1.f - cst1) * s1_);
    }
    *(float2*)(xch + tq * 128 + d0) = make_float2(tot0, tot1);
    __syncthreads();
    const float2 t0 = *(const float2*)(xch + d0), t1 = *(const float2*)(xch + 128 + d0), t2 = *(const float2*)(xch + 256 + d0), t3 = *(const float2*)(xch + 384 + d0);
    const float blast0 = (t0.x + t1.x) + (t2.x + t3.x), blast1 = (t0.y + t1.y) + (t2.y + t3.y);
    float ref0, ref1, run0, run1;
    if (DIR == 0) {
      ref0 = t0.x + t1.x; ref1 = t0.y + t1.y;
      run0 = (tq > 0 ? t0.x : 0.f) + (tq > 1 ? t1.x : 0.f) + (tq > 2 ? t2.x : 0.f);
      run1 = (tq > 0 ? t0.y : 0.f) + (tq > 1 ? t1.y : 0.f) + (tq > 2 ? t2.y : 0.f);
    } else {
      ref0 = t2.x + t3.x; ref1 = t2.y + t3.y;
      run0 = (tq < 3 ? t3.x : 0.f) + (tq < 2 ? t2.x : 0.f) + (tq < 1 ? t1.x : 0.f);
      run1 = (tq < 3 ? t3.y : 0.f) + (tq < 2 ? t2.y : 0.f) + (tq < 1 ? t1.y : 0.f);
    }
    const float cbr0 = __builtin_amdgcn_exp2f(blast0 - ref0), cbr1 = __builtin_amdgcn_exp2f(blast1 - ref1);
#pragma unroll
    for (int jj = 0; jj < 8; ++jj) {
      const int j = DIR ? 7 - jj : jj;
      float ka[2], kb[2];
#pragma unroll
      for (int hh = 0; hh < 2; ++hh) {
        const int i = 2 * j + (DIR ? 1 - hh : hh);
        const float s0_ = 1.f / (1.f + __expf(-lo_f(kv[i]))), s1_ = 1.f / (1.f + __expf(-hi_f(kv[i])));
        const float g0 = __log2f(cst0 + (1.f - cst0) * s0_), g1 = __log2f(cst1 + (1.f - cst1) * s1_);
        const float k0 = (1.f - cst0) * (1.f - s0_), k1 = (1.f - cst1) * (1.f - s1_);
        run0 += g0; run1 += g1;
        *(unsigned*)(Qs + (r0 + i) * 272 + d0 * 2) = pack2(lo_f(qv[i]) * __builtin_amdgcn_exp2f(run0 - ref0), hi_f(qv[i]) * __builtin_amdgcn_exp2f(run1 - ref1));
        const float kh0 = k0 * __builtin_amdgcn_exp2f(ref0 - run0), kh1 = k1 * __builtin_amdgcn_exp2f(ref1 - run1);
        *(unsigned*)(X + (r0 + i) * 272 + d0 * 2) = pack2(kh0, kh1);
        ka[i & 1] = kh0 * cbr0;
        kb[i & 1] = kh1 * cbr1;
      }
      ktp0[j] = pack2(ka[0], ka[1]);
      ktp1[j] = pack2(kb[0], kb[1]);
    }
    if (tq == 0) { *(float2*)(blA + d0) = make_float2(__builtin_amdgcn_exp2f(blast0), __builtin_amdgcn_exp2f(blast1)); *(float2*)(erA + d0) = make_float2(__builtin_amdgcn_exp2f(ref0), __builtin_amdgcn_exp2f(ref1)); }
    }
    {
      const unsigned a0 = (vv[0] & 0xffffu) | (vv[1] << 16), a1 = (vv[2] & 0xffffu) | (vv[3] << 16), a2 = (vv[4] & 0xffffu) | (vv[5] << 16), a3 = (vv[6] & 0xffffu) | (vv[7] << 16);
      const unsigned b0 = (vv[0] >> 16) | (vv[1] & 0xffff0000u), b1 = (vv[2] >> 16) | (vv[3] & 0xffff0000u), b2 = (vv[4] >> 16) | (vv[5] & 0xffff0000u), b3 = (vv[6] >> 16) | (vv[7] & 0xffff0000u);
      *(uint4*)(Vt + (2 * ve2) * 144 + vq * 16) = make_uint4(a0, a1, a2, a3);
      *(uint4*)(Vt + (2 * ve2 + 1) * 144 + vq * 16) = make_uint4(b0, b1, b2, b3);
    }
    if (ci + 1 < nch) { SCAN_ISSUE(DIR ? c - 1 : c + 1); }
    __syncthreads();
#pragma unroll
    for (int dt = 0; dt < 8; ++dt) {
      const float4 er4 = *(const float4*)(erA + 16 * dt + 4 * lg);
      *(uint2*)(StS + (16 * w + lr) * 272 + (16 * dt + 4 * lg) * 2) = make_uint2(pack2(S[dt][0] * er4.x, S[dt][1] * er4.y), pack2(S[dt][2] * er4.z, S[dt][3] * er4.w));
    }
    bf16x8 qf[4];
#pragma unroll
    for (int ks = 0; ks < 4; ++ks) qf[ks] = *(const bf16x8*)(Qs + (16 * w + lr) * 272 + ks * 64 + lg * 16);
    uint2 pv[4];
    {
      const int t = 16 * w + lr;
#pragma unroll
      for (int st = 0; st < 4; ++st) {
        f32x4 s = (f32x4){0.f, 0.f, 0.f, 0.f};
#pragma unroll
        for (int ks = 0; ks < 4; ++ks) {
          const bf16x8 kf = *(const bf16x8*)(X + (16 * st + lr) * 272 + ks * 64 + lg * 16);
          s = MFMA(kf, qf[ks], s);
        }
        float v[4];
#pragma unroll
        for (int r = 0; r < 4; ++r) {
          const int si = 16 * st + 4 * lg + r;
          const bool keep = DIR ? (t <= si) : (t >= si);
          v[r] = keep ? s[r] : 0.f;
        }
        pv[st] = make_uint2(pack2(v[0], v[1]), pack2(v[2], v[3]));
      }
    }
    __syncthreads();
#pragma unroll
    for (int st = 0; st < 4; ++st) *(uint2*)(Pm + (16 * w + lr) * 144 + (16 * st + 4 * lg) * 2) = pv[st];
    *(uint4*)(X + d0 * 144 + r0 * 2) = make_uint4(ktp0[0], ktp0[1], ktp0[2], ktp0[3]);
    *(uint4*)(X + d0 * 144 + r0 * 2 + 16) = make_uint4(ktp0[4], ktp0[5], ktp0[6], ktp0[7]);
    *(uint4*)(X + (d0 + 1) * 144 + r0 * 2) = make_uint4(ktp1[0], ktp1[1], ktp1[2], ktp1[3]);
    *(uint4*)(X + (d0 + 1) * 144 + r0 * 2 + 16) = make_uint4(ktp1[4], ktp1[5], ktp1[6], ktp1[7]);
    __syncthreads();
    {
      bf16x8 pf[2];
#pragma unroll
      for (int ks = 0; ks < 2; ++ks) pf[ks] = *(const bf16x8*)(Pm + (16 * w + lr) * 144 + ks * 64 + lg * 16);
      const bool sep = DIR && (KIND == 2 || grp);
      bf16_t* orow = (KIND == 2 && DIR) ? hg_ob_row(p, (int)mbase + c * 64 + 16 * w + lr) + h * DV + sl * 64 + 4 * lg
                   : (KIND == 1 && DIR && grp) ? ret_ob_row(p, b * 2048 + c * 64 + 16 * w + lr) + h * DV + sl * 64 + 4 * lg
                                               : Og + (size_t)(c * 64 + 16 * w + lr) * LDV + 4 * lg;
#pragma unroll
      for (int et = 0; et < 4; ++et) {
        f32x4 o = (f32x4){0.f, 0.f, 0.f, 0.f};
#pragma unroll
        for (int ks = 0; ks < 2; ++ks) {
          const bf16x8 vf = *(const bf16x8*)(Vt + (16 * et + lr) * 144 + ks * 64 + lg * 16);
          o = MFMA(vf, pf[ks], o);
        }
#pragma unroll
        for (int ks = 0; ks < 4; ++ks) {
          const bf16x8 sf = *(const bf16x8*)(StS + (16 * et + lr) * 272 + ks * 64 + lg * 16);
          o = MFMA(sf, qf[ks], o);
        }
        bf16_t* op = orow + 16 * et;
        if (DIR && !sep) {
          const uint2 old = *(const uint2*)op;
          o[0] += lo_f(old.x); o[1] += hi_f(old.x); o[2] += lo_f(old.y); o[3] += hi_f(old.y);
        }
        if (!(DIR && !sep && dry)) *(uint2*)op = make_uint2(pack2(o[0], o[1]), pack2(o[2], o[3]));
      }
    }
    {
      bf16x8 vtf[2];
#pragma unroll
      for (int ks = 0; ks < 2; ++ks) vtf[ks] = *(const bf16x8*)(Vt + (16 * w + lr) * 144 + ks * 64 + lg * 16);
#pragma unroll
      for (int dt = 0; dt < 8; ++dt) {
        const float4 bl4 = *(const float4*)(blA + 16 * dt + 4 * lg);
        S[dt][0] *= bl4.x; S[dt][1] *= bl4.y; S[dt][2] *= bl4.z; S[dt][3] *= bl4.w;
#pragma unroll
        for (int ks = 0; ks < 2; ++ks) {
          const bf16x8 kf = *(const bf16x8*)(X + (16 * dt + lr) * 144 + ks * 64 + lg * 16);
          S[dt] = MFMA(kf, vtf[ks], S[dt]);
        }
      }
    }
    __syncthreads();
  }
#undef SCAN_ISSUE
  if (!grp) {
    float* so = p.out + (KIND == 1 ? OUT_SR : OUT_SH) + ((size_t)((b * 2 + DIR) * 8 + h) * 128) * DV + sl * 64 + 16 * w + lr + (size_t)(4 * lg) * DV;
    asm volatile("" : "+v"(so));
#pragma unroll
    for (int dt = 0; dt < 8; ++dt)
#pragma unroll
      for (int r = 0; r < 4; ++r) so[(16 * dt + r) * DV] = S[dt][r];
  }
}

template <int KIND, int DIR>
__device__ __forceinline__ void scan_phase(const Params& p, unsigned char* lds, const bool dry) {
  constexpr int NSL = (KIND == 1 ? 256 : 128) / 64;
  const int ns = 64 * NSL, npr = 256 * NSL;
  const int G = VGDIM, bid = VBID;
  int it, step, end = ns + npr;
  if (G > ns) {
    if (bid < ns) { it = bid; step = end; }
    else { it = ns + (bid - ns); step = G - ns; }
  } else { it = bid; step = G; }
  for (; it < end; it += step) scan_item<KIND, DIR>(p, it, lds, dry);
}

__device__ __forceinline__ void scan_phase_ret_sample(const Params& p, unsigned char* lds, const bool dry) {
  const int G = VGDIM >> 1, bid = VBID;
  const int role = bid >= G;
  const int rb = role ? bid - G : bid;
  if (role == 0) { for (int it = rb; it < 256; it += G) scan_item<1, 0>(p, it, lds, dry); }
  else           { for (int it = rb; it < 256; it += G) scan_item<1, 1>(p, it, lds, dry); }
}
template <int DIR>
__device__ __forceinline__ void scan_phase_ret_prompt(const Params& p, unsigned char* lds, const bool dry) {
  for (int it = VBID; it < 1024; it += VGDIM) scan_item<1, DIR>(p, 256 + it, lds, dry);
}

__device__ __forceinline__ void scan_phase_hg_both(const Params& p, unsigned char* lds, const bool dry) {
  const int G = VGDIM >> 1, bid = VBID;
  const int role = bid >= G;
  const int rb = role ? bid - G : bid;
  int it, step;
  if (G > 128) {
    if (rb < 128) { it = rb; step = 1 << 20; } else { it = rb; step = G - 128; }
  } else { it = rb; step = G; }
  if (role == 0) { for (; it < 640; it += step) scan_item<2, 0>(p, it, lds, dry); }
  else           { for (; it < 640; it += step) scan_item<2, 1>(p, it, lds, dry); }
}

template <int KIND>
__device__ __forceinline__ void normgate_phase(const Params& p, const bool dry) {
  constexpr int NCH = KIND == 1 ? 4 : 2, DV = KIND == 1 ? 256 : 128, LD = KIND == 1 ? 2048 : 1024;
  const int tid = HTID, lane = tid & 63, w = tid >> 6;
  const int hh = lane >> 3, sub = lane & 7;
  bf16_t* R0 = (bf16_t*)p.ws;
  bf16_t* Ob = R0 + (KIND == 1 ? 4 * PLANE_E : 5 * PLANE_E) + hh * DV + sub * 8;
  const bf16_t* Gb = R0 + (KIND == 1 ? 0 : 4 * PLANE_E) + hh * DV + sub * 8;
  float gn[NCH][8];
#pragma unroll
  for (int j = 0; j < NCH; ++j)
#pragma unroll
    for (int i = 0; i < 8; ++i) gn[j][i] = (KIND == 1) ? 1.f : p.in[22][j * 64 + sub * 8 + i];
  for (int row = VBID * 4 + w; row < 24576; row += VGDIM * 4) {
    bf16_t* op = Ob + (size_t)row * LD;
    const bf16_t* gp = Gb + (size_t)row * LD;
    uint4 ov[NCH], gv[NCH];
#pragma unroll
    for (int j = 0; j < NCH; ++j) { ov[j] = *(const uint4*)(op + j * 64); gv[j] = *(const uint4*)(gp + j * 64); }
    if (KIND == 2 || row >= 8192) {
      const bf16_t* bp = (KIND == 2 ? hg_ob_row(p, row) : ret_ob_row(p, row - 8192)) + hh * DV + sub * 8;
#pragma unroll
      for (int j = 0; j < NCH; ++j) {
        const uint4 bv = *(const uint4*)(bp + j * 64);
        ov[j].x = pack2(lo_f(ov[j].x) + lo_f(bv.x), hi_f(ov[j].x) + hi_f(bv.x));
        ov[j].y = pack2(lo_f(ov[j].y) + lo_f(bv.y), hi_f(ov[j].y) + hi_f(bv.y));
        ov[j].z = pack2(lo_f(ov[j].z) + lo_f(bv.z), hi_f(ov[j].z) + hi_f(bv.z));
        ov[j].w = pack2(lo_f(ov[j].w) + lo_f(bv.w), hi_f(ov[j].w) + hi_f(bv.w));
      }
    }
    float ss = 0.f;
#pragma unroll
    for (int j = 0; j < NCH; ++j) {
      const unsigned wv[4] = {ov[j].x, ov[j].y, ov[j].z, ov[j].w};
#pragma unroll
      for (int i = 0; i < 4; ++i) { const float a = lo_f(wv[i]), b2 = hi_f(wv[i]); ss += a * a + b2 * b2; }
    }
    ss += __shfl_xor(ss, 1);
    ss += __shfl_xor(ss, 2);
    ss += __shfl_xor(ss, 4);
    const float rs = rsqrtf(ss * (1.f / (float)DV) + 1e-6f);
#pragma unroll
    for (int j = 0; j < NCH; ++j) {
      const unsigned wv[4] = {ov[j].x, ov[j].y, ov[j].z, ov[j].w};
      const unsigned gw[4] = {gv[j].x, gv[j].y, gv[j].z, gv[j].w};
      unsigned r[4];
#pragma unroll
      for (int i = 0; i < 4; ++i)
        r[i] = pack2(lo_f(wv[i]) * rs * gn[j][2 * i] * lo_f(gw[i]), hi_f(wv[i]) * rs * gn[j][2 * i + 1] * hi_f(gw[i]));
      if (!dry) *(uint4*)(op + j * 64) = make_uint4(r[0], r[1], r[2], r[3]);
    }
  }
}

__device__ __forceinline__ void opaque_params(Params& q) {
  asm volatile("" : "+s"(q.out), "+s"(q.ws));
#pragma unroll
  for (int i = 0; i < 23; ++i) asm volatile("" : "+s"(q.in[i]));
}

struct BarState { unsigned* base; unsigned xcd, mycnt, nact, esub, etop; };
__device__ __forceinline__ void grid_barrier(BarState& b) {
  asm volatile("s_waitcnt vmcnt(0) lgkmcnt(0)" ::: "memory");
  __syncthreads();
  if (threadIdx.x == 0) {
    b.esub += b.mycnt; b.etop += b.nact;
    const unsigned old = __hip_atomic_fetch_add(b.base + 64 * b.xcd, 1u, __ATOMIC_RELAXED, __HIP_MEMORY_SCOPE_AGENT);
    if (old + 1u == b.esub) {
      __builtin_amdgcn_fence(__ATOMIC_RELEASE, "agent");
      __hip_atomic_fetch_add(b.base + 512, 1u, __ATOMIC_RELAXED, __HIP_MEMORY_SCOPE_AGENT);
    }
    while (__hip_atomic_load(b.base + 512, __ATOMIC_RELAXED, __HIP_MEMORY_SCOPE_AGENT) < b.etop) __builtin_amdgcn_s_sleep(1);
    __builtin_amdgcn_fence(__ATOMIC_ACQUIRE, "agent");
  }
  __syncthreads();
}
__device__ __forceinline__ void bar_census_post(BarState& b) {
  if (threadIdx.x == 0) __hip_atomic_fetch_add(b.base + 1024 + 64 * b.xcd, 1u, __ATOMIC_RELAXED, __HIP_MEMORY_SCOPE_AGENT);
}
__device__ __forceinline__ void bar_census_read(BarState& b) {
  if (threadIdx.x == 0) {
    unsigned n = 0;
    for (unsigned j = 0; j < 8; ++j) {
      const unsigned c = __hip_atomic_load(b.base + 1024 + 64 * j, __ATOMIC_RELAXED, __HIP_MEMORY_SCOPE_AGENT);
      n += (c != 0u);
      if (j == b.xcd) b.mycnt = c;
    }
    b.nact = n;
  }
}
#define GSYNC(n) { if ((n) == 0) { grid.sync(); bar_census_read(bst); } else grid_barrier(bst); }

#if defined(PH_ONLY)
#define PHASE(n, call) if (n == PH_ONLY) { const bool dry = false; call; }
#elif defined(REP_N)
#define PHASE(n, call) if (lo <= n && n < hi) { for (int rep = (n == REP_N ? 0 : 1); rep < 2; ++rep) { const bool dry = (rep == 0); call; if (!(fin && n + 1 == hi && rep == 1)) GSYNC(n) } }
#else
#define PHASE(n, call) if (lo <= n && n < hi) { const bool dry = false; call; if (!(fin && n + 1 == hi)) GSYNC(n) }
#endif

__device__ __forceinline__ void run_range(const Params& q, int lo, int hi, bool fin, cg::grid_group& grid, unsigned char* lds) {
  unsigned char* ldh = lds + HALFID * HALF_LDS;
  BarState bst; bst.base = (unsigned*)(q.ws + OFF_MISC + MISC_CTR); bst.xcd = xcc_id(); bst.mycnt = 0; bst.nact = 0; bst.esub = 0; bst.etop = 0;
  if (lo == 0) bar_census_post(bst);
  PHASE(0, phase0(q, ldh))
  PHASE(1, post_phase(q, -1, 0, ldh, dry))
  PHASE(2, gemm_phase(q, 0, GM_IN_DA, lds, 2))
  PHASE(3, attn_phase(q, 0, lds, dry, 3))
  PHASE(4, gemm_phase(q, 0, GM_OUT, lds, 4))
  PHASE(5, post_phase(q, 0, 1, ldh, dry))
  PHASE(6, gemm_phase(q, 1, GM_IN_RET_QKV, lds, 6))
  PHASE(7, scan_phase_ret_sample(q, ldh, dry))
  PHASE(8, scan_phase_ret_prompt<0>(q, ldh, dry))
  PHASE(8, scan_phase_ret_prompt<1>(q, ldh, dry))
  PHASE(9, gemm_phase(q, 1, GM_IN_RET_G, lds, 9))
  PHASE(10, normgate_phase<1>(q, dry))
  PHASE(11, gemm_phase(q, 1, GM_OUT, lds, 11))
  PHASE(12, post_phase(q, 1, 2, ldh, dry))
  PHASE(13, gemm_phase(q, 2, GM_IN_HG, lds, 13))
  PHASE(14, scan_phase_hg_both(q, ldh, dry))
  PHASE(16, normgate_phase<2>(q, dry))
  PHASE(17, gemm_phase(q, 2, GM_OUT, lds, 17))
  PHASE(18, post_phase(q, 2, 3, ldh, dry))
  PHASE(19, gemm_phase(q, 3, GM_IN_DA, lds, 19))
  PHASE(20, attn_phase(q, 3, lds, dry, 20))
  PHASE(21, gemm_phase(q, 3, GM_OUT, lds, 21))
  PHASE(22, post_phase(q, 3, 4, ldh, dry))
}

__global__ void __launch_bounds__(NTHR, 2) mega_fwd(Params p) {
  extern __shared__ __attribute__((aligned(16))) unsigned char lds[];
  cg::grid_group grid = cg::this_grid();
  run_range(p, p.ph_lo, p.ph_hi, true, grid, lds);
}

extern "C" void kernel_launch(void* const* d_in, const int* in_sizes, int n_in, void* d_out, int out_size, void* d_ws, size_t ws_size, hipStream_t stream) {
  static int grid_blocks = 0;
  if (grid_blocks == 0) {
    int dev = 0, cus = 0, per_cu = 0;
    hipGetDevice(&dev);
    hipDeviceGetAttribute(&cus, hipDeviceAttributeMultiprocessorCount, dev);
    hipFuncSetAttribute((const void*)mega_fwd, hipFuncAttributeMaxDynamicSharedMemorySize, LDS_BYTES);
    hipOccupancyMaxActiveBlocksPerMultiprocessor(&per_cu, (const void*)mega_fwd, NTHR, LDS_BYTES);
    if (per_cu < 1) per_cu = 1;
    if (per_cu > 1) per_cu = 1;
    if (cus < 1) cus = 256;
    grid_blocks = cus * per_cu;
    (void)hipGetLastError();
    if (n_in != 23 || ws_size < WS_NEED) { fprintf(stderr, "kernel_launch: unexpected n_in %d / ws_size %zu (need %zu)\n", n_in, ws_size, (size_t)WS_NEED); }
  }
  hipMemsetAsync((unsigned char*)d_ws + OFF_MISC + MISC_CTR, 0, 8192, stream);
  Params p{};
  for (int i = 0; i < 23; ++i) p.in[i] = (const float*)d_in[i];
  p.out = (float*)d_out;
  p.ws = (unsigned char*)d_ws;
#if ONE_LAUNCH
  p.ph_lo = 0; p.ph_hi = NPH;
  void* args[] = {&p};
  hipError_t e = hipLaunchCooperativeKernel((const void*)mega_fwd, dim3(grid_blocks), dim3(NTHR), args, LDS_BYTES, stream);
  if (e != hipSuccess) fprintf(stderr, "cooperative launch failed: %s (grid %d)\n", hipGetErrorString(e), grid_blocks);
#else
  for (int ph = 0; ph < NPH; ++ph) {
    p.ph_lo = ph; p.ph_hi = ph + 1;
    hipLaunchKernelGGL(mega_fwd, dim3(grid_blocks), dim3(NTHR), LDS_BYTES, stream, p);
  }
#endif
}
```

```cpp
#include <hip/hip_runtime.h>
#include <hip/hip_cooperative_groups.h>
#include <cstdint>
#include <cstdio>
namespace cg = cooperative_groups;

#ifndef ONE_LAUNCH
#define ONE_LAUNCH 1
#endif

typedef unsigned short bf16_t;
typedef short bf16x8 __attribute__((ext_vector_type(8)));
typedef float f32x4 __attribute__((ext_vector_type(4)));

#define NTHR 512
#define HTID ((int)(threadIdx.x & 255))
#define HALFID ((int)(threadIdx.x >> 8))
#define VBID ((int)(blockIdx.x * 2 + (threadIdx.x >> 8)))
#define VGDIM ((int)(gridDim.x * 2))
#define HALF_LDS 74816
#define MIB ((size_t)1 << 20)
#define NPH 23
#define LDS_BYTES (2 * HALF_LDS)
#define LDS_SLOT 74752
#define MISC_CTR (MISC_ROPE + 524288)

#define OFF_WIN  (288 * MIB)
#define OFF_WOUT (300 * MIB)
#define OFF_HP   (304 * MIB)
#define OFF_MISC (320 * MIB)
#define MISC_ROPE 524288
#define WS_NEED  (322 * MIB)
#define PLANE_E  ((size_t)25165824)
#define OUT_YP 0
#define OUT_YS 8388608
#define OUT_CK 25165824
#define OUT_CV 41943040
#define OUT_SR 58720256
#define OUT_SH 75497472

struct Params {
  const float* in[23];
  float* out;
  unsigned char* ws;
  int ph_lo, ph_hi;
};

struct LayerInfo { int kind, slot, IN, WIDTH; const float* w_in; const float* w_out; };

__device__ __forceinline__ LayerInfo layer_info(const Params& p, int l) {
  LayerInfo L;
  if (l == 0)      { L.kind = 0; L.slot = 0; L.IN = 4096; L.WIDTH = 1024; L.w_in = p.in[12]; L.w_out = p.in[13]; }
  else if (l == 1) { L.kind = 1; L.slot = 0; L.IN = 6144; L.WIDTH = 2048; L.w_in = p.in[16]; L.w_out = p.in[17]; }
  else if (l == 2) { L.kind = 2; L.slot = 0; L.IN = 5120; L.WIDTH = 1024; L.w_in = p.in[19]; L.w_out = p.in[20]; }
  else             { L.kind = 0; L.slot = 1; L.IN = 4096; L.WIDTH = 1024; L.w_in = p.in[12] + (size_t)1024 * 4096; L.w_out = p.in[13] + (size_t)1024 * 1024; }
  return L;
}
__device__ __forceinline__ bf16_t* hs_ptr(const Params& p, int l) {
  return l < 3 ? (bf16_t*)(p.out + OUT_SH) : (bf16_t*)(p.ws + 240 * MIB);
}

typedef __bf16 nbf16x2 __attribute__((ext_vector_type(2)));
typedef float f32x2 __attribute__((ext_vector_type(2)));
__device__ __forceinline__ float bf2f(unsigned h) { return __uint_as_float(h << 16); }
__device__ __forceinline__ unsigned pack2(float a, float b) { const f32x2 f = {a, b}; return __builtin_bit_cast(unsigned, __builtin_convertvector(f, nbf16x2)); }
__device__ __forceinline__ float lo_f(unsigned w) { return __uint_as_float(w << 16); }
__device__ __forceinline__ float hi_f(unsigned w) { return __uint_as_float(w & 0xffff0000u); }
__device__ __forceinline__ float silu_f(float x) { return x / (1.f + __expf(-x)); }
__device__ __forceinline__ float wave_sum(float v) {
#pragma unroll
  for (int o = 32; o > 0; o >>= 1) v += __shfl_xor(v, o);
  return v;
}
#define QSCALE 0.18033688011112042f
#define SB __builtin_amdgcn_sched_barrier(0)
#define MFMA(a, b, c) __builtin_amdgcn_mfma_f32_16x16x32_bf16((a), (b), (c), 0, 0, 0)

__device__ __forceinline__ void convT_tile(const float* __restrict__ src, int src_ld, bf16_t* __restrict__ dst, int dst_ld, unsigned char* lds) {
  float* t = (float*)lds;
  const int tid = HTID;
  const int kr = tid >> 4, nc = (tid & 15) * 4;
#pragma unroll
  for (int j = 0; j < 4; ++j) {
    const float4 v = *(const float4*)(src + (size_t)(kr + 16 * j) * src_ld + nc);
    float* tp = t + (kr + 16 * j) * 65 + nc;
    tp[0] = v.x; tp[1] = v.y; tp[2] = v.z; tp[3] = v.w;
  }
  __syncthreads();
  const int n = tid >> 2, kc = (tid & 3) * 16;
  unsigned w[8];
#pragma unroll
  for (int i = 0; i < 8; ++i) w[i] = pack2(t[(kc + 2 * i) * 65 + n], t[(kc + 2 * i + 1) * 65 + n]);
  uint4* d = (uint4*)(dst + (size_t)n * dst_ld + kc);
  d[0] = make_uint4(w[0], w[1], w[2], w[3]);
  d[1] = make_uint4(w[4], w[5], w[6], w[7]);
  __syncthreads();
}

__device__ __forceinline__ int conv_weights_count(const Params& p, int l) {
  const LayerInfo L = layer_info(p, l);
  return (L.IN / 64) * 16 + (L.WIDTH / 64) * 16;
}
__device__ __forceinline__ void conv_weights_item(const Params& p, int l, int it, unsigned char* lds) {
  const LayerInfo L = layer_info(p, l);
  const int nin = (L.IN / 64) * 16;
  if (it < nin) {
    const int kt = it & 15, nt = it >> 4;
    convT_tile(L.w_in + (size_t)(kt * 64) * L.IN + nt * 64, L.IN, (bf16_t*)(p.ws + OFF_WIN) + (size_t)(nt * 64) * 1024 + kt * 64, 1024, lds);
  } else {
    const int it2 = it - nin, nkt = L.WIDTH / 64;
    const int kt = it2 % nkt, nt = it2 / nkt;
    convT_tile(L.w_out + (size_t)(kt * 64) * 1024 + nt * 64, 1024, (bf16_t*)(p.ws + OFF_WOUT) + (size_t)(nt * 64) * L.WIDTH + kt * 64, L.WIDTH, lds);
  }
}

__device__ __forceinline__ void mod_item(const Params& p, int it, unsigned char* lds) {
  float* ssilu = (float*)lds;
  float* red = ssilu + 9 * 1024;
  const int tid = HTID;
  const int l = it / 48, col0 = (it % 48) * 64;
  for (int i = tid; i < 9 * 1024; i += 256) {
    const int v = i >> 10, k = i & 1023;
    const float x = (v == 0) ? p.in[7][k] : p.in[6][(v - 1) * 1024 + k];
    ssilu[i] = silu_f(x);
  }
  __syncthreads();
  const int col = tid & 63, kq = tid >> 6;
  const float* w = p.in[8] + (size_t)l * 1024 * 3072 + col0 + col;
  float acc[9];
#pragma unroll
  for (int v = 0; v < 9; ++v) acc[v] = 0.f;
  for (int k = kq * 256; k < kq * 256 + 256; ++k) {
    const float wv = w[(size_t)k * 3072];
#pragma unroll
    for (int v = 0; v < 9; ++v) acc[v] += ssilu[v * 1024 + k] * wv;
  }
#pragma unroll
  for (int v = 0; v < 9; ++v) red[(kq * 9 + v) * 64 + col] = acc[v];
  __syncthreads();
  float* mod = (float*)(p.ws + OFF_MISC);
  for (int i = tid; i < 9 * 64; i += 256) {
    const int v = i >> 6, cc = i & 63;
    const float s = red[(0 * 9 + v) * 64 + cc] + red[(1 * 9 + v) * 64 + cc] + red[(2 * 9 + v) * 64 + cc] + red[(3 * 9 + v) * 64 + cc];
    mod[(size_t)(l * 9 + v) * 3072 + col0 + cc] = s + p.in[9][l * 3072 + col0 + cc];
  }
  __syncthreads();
}

__device__ __forceinline__ void rope_item(const Params& p, int it) {
  const int idx = it * 256 + HTID;
  const int t = idx >> 5, pp = idx & 31;
  const int pos = pp < 16 ? (t >> 6) : (t & 63);
  const float inv = exp2f(-(float)(pp & 15) * (13.287712379549449f / 16.f));
  const float ang = (float)pos * inv;
  const double a = (double)ang;
  const double r = a - 6.283185307179586 * rint(a * 0.15915494309189535);
  const float rf = (float)r;
  float2* tab = (float2*)(p.ws + OFF_MISC + MISC_ROPE);
  tab[idx] = make_float2(__cosf(rf), __sinf(rf));
}

__device__ __forceinline__ void phase0(const Params& p, unsigned char* lds) {
  const int nw = conv_weights_count(p, 0);
  const int total = 192 + 256 + nw;
  for (int it = VBID; it < total; it += VGDIM) {
    if (it < 192) mod_item(p, it, lds);
    else if (it < 448) rope_item(p, it - 192);
    else conv_weights_item(p, 0, it - 448, lds);
  }
}

__device__ __forceinline__ void post_phase(const Params& p, int lprev, int lnext, unsigned char* lds, const bool dry) {
  const int tid = HTID, lane = tid & 63, w = tid >> 6;
  const float* mod = (const float*)(p.ws + OFF_MISC);
  const bf16_t* Y = nullptr;
  if (lprev >= 0) {
    const int kind = layer_info(p, lprev).kind;
    Y = (const bf16_t*)(p.ws + (kind == 1 ? 96 * MIB : 0));
  }
  bf16_t* hp = (bf16_t*)(p.ws + OFF_HP);
  bf16_t* hs = lnext < 4 ? hs_ptr(p, lnext) : nullptr;
  for (int row = VBID * 4 + w; row < 24576; row += VGDIM * 4) {
    const int mv = row < 8192 ? 0 : 1 + ((row - 8192) >> 11);
    const float* xs = (lprev <= 0) ? (row < 8192 ? p.in[0] + (size_t)row * 1024 : p.in[1] + (size_t)(row - 8192) * 1024) : p.out + (size_t)row * 1024;
    float4 x[4];
#pragma unroll
    for (int j = 0; j < 4; ++j) x[j] = *(const float4*)(xs + lane * 4 + 256 * j);
    if (lprev >= 0) {
      float4 y[4];
      float ss = 0.f;
#pragma unroll
      for (int j = 0; j < 4; ++j) { const uint2 yw = *(const uint2*)(Y + (size_t)row * 1024 + lane * 4 + 256 * j); y[j] = make_float4(lo_f(yw.x), hi_f(yw.x), lo_f(yw.y), hi_f(yw.y)); ss += y[j].x * y[j].x + y[j].y * y[j].y + y[j].z * y[j].z + y[j].w * y[j].w; }
      ss = wave_sum(ss);
      const float rstd = rsqrtf(ss * (1.f / 1024.f) + 1e-6f);
      const float* ga = mod + (size_t)(lprev * 9 + mv) * 3072 + 2048;
      const float* gp = p.in[11] + lprev * 1024;
#pragma unroll
      for (int j = 0; j < 4; ++j) {
        const int c = lane * 4 + 256 * j;
        const float4 g4 = *(const float4*)(ga + c), p4 = *(const float4*)(gp + c);
        x[j].x += g4.x * (y[j].x * rstd * p4.x); x[j].y += g4.y * (y[j].y * rstd * p4.y);
        x[j].z += g4.z * (y[j].z * rstd * p4.z); x[j].w += g4.w * (y[j].w * rstd * p4.w);
        if (!dry) *(float4*)(p.out + (size_t)row * 1024 + c) = x[j];
      }
    }
    if (lnext < 4) {
      float ss = 0.f;
#pragma unroll
      for (int j = 0; j < 4; ++j) ss += x[j].x * x[j].x + x[j].y * x[j].y + x[j].z * x[j].z + x[j].w * x[j].w;
      ss = wave_sum(ss);
      const float rstd = rsqrtf(ss * (1.f / 1024.f) + 1e-6f);
      const float* sh = mod + (size_t)(lnext * 9 + mv) * 3072;
      const float* sc = sh + 1024;
      const float* gp = p.in[10] + lnext * 1024;
      bf16_t* hd = row < 8192 ? hp + (size_t)row * 1024 : hs + (size_t)(row - 8192) * 1024;
#pragma unroll
      for (int j = 0; j < 4; ++j) {
        const int c = lane * 4 + 256 * j;
        const float4 s4 = *(const float4*)(sh + c), c4 = *(const float4*)(sc + c), p4 = *(const float4*)(gp + c);
        const float h0 = x[j].x * rstd * p4.x * (1.f + c4.x) + s4.x, h1 = x[j].y * rstd * p4.y * (1.f + c4.y) + s4.y;
        const float h2 = x[j].z * rstd * p4.z * (1.f + c4.z) + s4.z, h3 = x[j].w * rstd * p4.w * (1.f + c4.w) + s4.w;
        *(uint2*)(hd + c) = make_uint2(pack2(h0, h1), pack2(h2, h3));
      }
    }
  }
  if (lprev >= 0 && lnext < 4) {
    const int nw = conv_weights_count(p, lnext);
    for (int it = VBID; it < nw; it += VGDIM) conv_weights_item(p, lnext, it, lds);
  }
}


__device__ __forceinline__ unsigned xcc_id() { return (unsigned)__builtin_amdgcn_s_getreg((3 << 11) | 20) & 7u; }
#define LAS __attribute__((address_space(3)))
template <bool SWAP>
__device__ __forceinline__ void gemm_tile_compute(const bf16_t* __restrict__ Ag, const bf16_t* __restrict__ Bg, int K, unsigned char* lds, f32x4 (&acc)[8][4],
                                                  const bool pre, const bf16_t* __restrict__ An, const bf16_t* __restrict__ Bn, const bool hasn) {
  const int tid = threadIdx.x, lane = tid & 63, wid = __builtin_amdgcn_readfirstlane(tid >> 6), wm = wid >> 2, wn = wid & 3;
  const int lr = lane & 15, lg = lane >> 4;
  LAS unsigned char* l3 = (LAS unsigned char*)lds;
  const int prow = lane >> 3;
  const int pgo0 = prow * K + (((lane & 7) ^ ((prow >> 1) & 7)) << 3);
  const int pgo1 = prow * K + (((lane & 7) ^ ((4 + (prow >> 1)) & 7)) << 3);
  const bf16_t* asrc = Ag + (size_t)(wid * 32) * K;
  const bf16_t* bsrc = Bg + (size_t)(wid * 32) * K;
  const size_t pstep = (size_t)8 * K;
#pragma unroll
  for (int mi = 0; mi < 8; ++mi)
#pragma unroll
    for (int ni = 0; ni < 4; ++ni) acc[mi][ni] = (f32x4){0.f, 0.f, 0.f, 0.f};
#define GEMM_STAGE_P(ap_, bp_, s, k0)                                                                                                      \
  {                                                                                                                                        \
    _Pragma("unroll") for (int j = 0; j < 4; ++j) {                                                                                        \
      __builtin_amdgcn_global_load_lds((const unsigned*)((ap_) + j * pstep + ((j & 1) ? pgo1 : pgo0) + (k0)), (LAS unsigned*)(l3 + (s) * 65536 + (wid * 4 + j) * 1024), 16, 0, 0);          \
      __builtin_amdgcn_global_load_lds((const unsigned*)((bp_) + j * pstep + ((j & 1) ? pgo1 : pgo0) + (k0)), (LAS unsigned*)(l3 + (s) * 65536 + 32768 + (wid * 4 + j) * 1024), 16, 0, 0);  \
    }                                                                                                                                      \
  }
#define GEMM_STAGE(s, k0) GEMM_STAGE_P(asrc, bsrc, s, k0)
  const int nk = K >> 6;
  if (!pre) GEMM_STAGE(0, 0);
  asm volatile("s_waitcnt vmcnt(0)" ::: "memory");
  __syncthreads();
  const int x0 = lg ^ ((lr >> 1) & 7);
  const int aoff0 = (wm * 128 + lr) * 128 + x0 * 16, aoff1 = (wm * 128 + lr) * 128 + (x0 ^ 4) * 16;
  const int boff0 = 32768 + (wn * 64 + lr) * 128 + x0 * 16, boff1 = 32768 + (wn * 64 + lr) * 128 + (x0 ^ 4) * 16;
  for (int kt = 0; kt < nk; ++kt) {
    if (kt + 1 < nk) GEMM_STAGE((kt + 1) & 1, (kt + 1) * 64);
    const unsigned char* st = lds + (kt & 1) * 65536;
#pragma unroll
    for (int kk = 0; kk < 2; ++kk) {
      bf16x8 af[8], bfr[4];
#pragma unroll
      for (int ni = 0; ni < 4; ++ni) bfr[ni] = *(const bf16x8*)(st + (kk ? boff1 : boff0) + ni * 2048);
#pragma unroll
      for (int mi = 0; mi < 8; ++mi) af[mi] = *(const bf16x8*)(st + (kk ? aoff1 : aoff0) + mi * 2048);
#pragma unroll
      for (int mi = 0; mi < 8; ++mi)
#pragma unroll
        for (int ni = 0; ni < 4; ++ni)
          acc[mi][ni] = SWAP ? MFMA(bfr[ni], af[mi], acc[mi][ni]) : MFMA(af[mi], bfr[ni], acc[mi][ni]);
    }
    asm volatile("s_waitcnt vmcnt(0)" ::: "memory");
    __syncthreads();
  }
  if (hasn) { const bf16_t* an_ = An + (size_t)(wid * 32) * K; const bf16_t* bn_ = Bn + (size_t)(wid * 32) * K; GEMM_STAGE_P(an_, bn_, 0, 0); }
#undef GEMM_STAGE
#undef GEMM_STAGE_P
}

enum { GM_IN_DA = 0, GM_IN_RET_QKV = 1, GM_IN_RET_G = 2, GM_IN_HG = 3, GM_OUT = 4 };

__device__ __forceinline__ void epi_swapped(const Params& p, int mode, int slot, int ykind, int m, int n, f32x4 v) {
  bf16_t* R0 = (bf16_t*)p.ws;
  if (mode == GM_OUT) {
    bf16_t* Y = (bf16_t*)(p.ws + (ykind == 1 ? 96 * MIB : 0));
    *(uint2*)(Y + (size_t)m * 1024 + n) = make_uint2(pack2(v[0], v[1]), pack2(v[2], v[3]));
  } else if (mode == GM_IN_DA) {
    const bool smp = m >= 8192;
    const int ms = m - 8192;
    const int b = smp ? (ms >> 11) : (m >> 8), t = smp ? (ms & 2047) : (m & 255);
    if (n < 2048) {
      if (smp) {
        const float4 cs = *(const float4*)((const float*)(p.ws + OFF_MISC + MISC_ROPE) + (size_t)(t * 32 + ((n & 63) >> 1)) * 2);
        const float a0 = v[0] * cs.x - v[1] * cs.y, a1 = v[0] * cs.y + v[1] * cs.x;
        const float a2 = v[2] * cs.z - v[3] * cs.w, a3 = v[2] * cs.w + v[3] * cs.z;
        v = (f32x4){a0, a1, a2, a3};
      }
      if (n < 1024) {
        *(uint2*)(R0 + (size_t)m * 1024 + n) = make_uint2(pack2(v[0] * QSCALE, v[1] * QSCALE), pack2(v[2] * QSCALE, v[3] * QSCALE));
      } else {
        const int c = n - 1024;
        const uint2 pk = make_uint2(pack2(v[0], v[1]), pack2(v[2], v[3]));
        if (smp) {
          *(uint2*)(R0 + 64 * MIB / 2 + ((size_t)b * 2560 + t) * 1024 + c) = pk;
        } else {
          *(f32x4*)(p.out + OUT_CK + ((size_t)((b * 2 + slot) * 256 + t)) * 1024 + c) = v;
          *(uint2*)(R0 + 48 * MIB / 2 + (size_t)m * 1024 + c) = pk;
        }
      }
    } else {
      *(uint2*)(R0 + 160 * MIB / 2 + (size_t)m * 1024 + (n - 3072)) = make_uint2(pack2(silu_f(v[0]), silu_f(v[1])), pack2(silu_f(v[2]), silu_f(v[3])));
    }
  } else if (mode == GM_IN_RET_QKV) {
    if (n < 1024) *(uint2*)(R0 + (size_t)m * 1024 + n) = make_uint2(pack2(v[0], v[1]), pack2(v[2], v[3]));
    else if (n < 2048) { const float s = 0.08838834764831845f; *(uint2*)(R0 + PLANE_E + (size_t)m * 1024 + (n - 1024)) = make_uint2(pack2(v[0] * s, v[1] * s), pack2(v[2] * s, v[3] * s)); }
    else *(uint2*)(R0 + 2 * PLANE_E + (size_t)m * 2048 + (n - 2048)) = make_uint2(pack2(v[0], v[1]), pack2(v[2], v[3]));
  } else if (mode == GM_IN_RET_G) {
    *(uint2*)(R0 + (size_t)m * 2048 + n) = make_uint2(pack2(silu_f(v[0]), silu_f(v[1])), pack2(silu_f(v[2]), silu_f(v[3])));
  } else {
    if (n < 1024 || n >= 4096) v = (f32x4){silu_f(v[0]), silu_f(v[1]), silu_f(v[2]), silu_f(v[3])};
    *(uint2*)(R0 + (size_t)(n >> 10) * PLANE_E + (size_t)m * 1024 + (n & 1023)) = make_uint2(pack2(v[0], v[1]), pack2(v[2], v[3]));
  }
}

__device__ __forceinline__ void epi_da_v(const Params& p, int slot, int m, int n, f32x4 v) {
  bf16_t* R0 = (bf16_t*)p.ws;
  const int c = n - 2048, hh = c >> 7, e = c & 127;
  const uint2 pk = make_uint2(pack2(v[0], v[1]), pack2(v[2], v[3]));
  if (m >= 8192) {
    const int ms = m - 8192, b = ms >> 11, t = ms & 2047;
    *(uint2*)(R0 + 120 * MIB / 2 + ((size_t)((b * 8 + hh) * 128 + e)) * 2560 + t) = pk;
  } else {
    const int b = m >> 8, t = m & 255;
    float* o = p.out + OUT_CV + ((size_t)((b * 2 + slot) * 256 + t)) * 1024 + c;
    o[0] = v[0]; o[1024] = v[1]; o[2048] = v[2]; o[3072] = v[3];
    *(uint2*)(R0 + 104 * MIB / 2 + ((size_t)((b * 8 + hh) * 128 + e)) * 256 + t) = pk;
  }
}

__device__ __forceinline__ void gemm_phase(const Params& p, int l, int mode, unsigned char* lds, int phid) {
  const LayerInfo L = layer_info(p, l);
  bf16_t* R0 = (bf16_t*)p.ws;
  const bf16_t *Ap, *As, *Bt;
  int K, N;
  if (mode == GM_OUT) {
    K = L.WIDTH; N = 1024; Bt = (const bf16_t*)(p.ws + OFF_WOUT);
    const bf16_t* base = R0 + (L.kind == 0 ? 160 * MIB / 2 : (L.kind == 1 ? 4 * PLANE_E : 5 * PLANE_E));
    Ap = base; As = base + (size_t)8192 * K;
  } else {
    K = 1024; Ap = (const bf16_t*)(p.ws + OFF_HP); As = hs_ptr(p, l);
    Bt = (const bf16_t*)(p.ws + OFF_WIN) + (mode == GM_IN_RET_G ? (size_t)4096 * 1024 : 0);
    N = (mode == GM_IN_DA || mode == GM_IN_RET_QKV) ? 4096 : (mode == GM_IN_RET_G ? 2048 : 5120);
  }
  const int ntn = N >> 8, ntiles = 96 * ntn;
  const int extra = (mode == GM_IN_DA) ? 3072 : 0;
  const int tid = threadIdx.x, lane = tid & 63, wid = tid >> 6, wm = wid >> 2, wn = wid & 3, lr = lane & 15, lg = lane >> 4;
  const int G = gridDim.x;
  const bool swz = (G & 7) == 0;
  const int xcd = blockIdx.x & 7, snn = ntn >> 2, nst = 12 * snn;
  const int q0 = swz ? (int)(blockIdx.x >> 3) : (int)blockIdx.x, qstep = swz ? (G >> 3) : G;
  const int qlen = swz ? 32 * ((nst - xcd + 7) >> 3) : ntiles;
#define GEMM_TILE_OF(qq, m0_, n0_)                                                   \
  {                                                                                    \
    int it_ = (qq);                                                                    \
    if (swz) {                                                                         \
      const int st_ = xcd + 8 * ((qq) >> 5), tin_ = (qq) & 31;                         \
      const int smt_ = st_ / snn, snt_ = st_ - smt_ * snn;                             \
      it_ = (smt_ * 8 + (tin_ >> 2)) * ntn + snt_ * 4 + (tin_ & 3);                    \
    }                                                                                  \
    const int mt_ = it_ / ntn;                                                         \
    m0_ = mt_ * 256; n0_ = (it_ - mt_ * ntn) * 256;                                    \
  }
  bool pre = false;
  for (int q = q0; q < qlen; q += qstep) {
    int m0, n0;
    GEMM_TILE_OF(q, m0, n0)
    const bf16_t* A = m0 < 8192 ? Ap + (size_t)m0 * K : As + (size_t)(m0 - 8192) * K;
    const bf16_t* B = Bt + (size_t)n0 * K;
    const bool hasn = q + qstep < qlen;
    const bf16_t *An = A, *Bn = B;
    if (hasn) {
      int m1, n1;
      GEMM_TILE_OF(q + qstep, m1, n1)
      An = m1 < 8192 ? Ap + (size_t)m1 * K : As + (size_t)(m1 - 8192) * K;
      Bn = Bt + (size_t)n1 * K;
    }
    {
      f32x4 acc[8][4];
      if (mode == GM_IN_DA && n0 >= 2048 && n0 < 3072) {
        gemm_tile_compute<false>(A, B, K, lds, acc, pre, An, Bn, hasn);
#pragma unroll
        for (int mi = 0; mi < 8; ++mi)
#pragma unroll
          for (int ni = 0; ni < 4; ++ni)
            epi_da_v(p, L.slot, m0 + wm * 128 + mi * 16 + 4 * lg, n0 + wn * 64 + ni * 16 + lr, acc[mi][ni]);
      } else {
        gemm_tile_compute<true>(A, B, K, lds, acc, pre, An, Bn, hasn);
#pragma unroll
        for (int mi = 0; mi < 8; ++mi)
#pragma unroll
          for (int ni = 0; ni < 4; ++ni)
            epi_swapped(p, mode, L.slot, L.kind, m0 + wm * 128 + mi * 16 + lr, n0 + wn * 64 + ni * 16 + 4 * lg, acc[mi][ni]);
      }
    }
    pre = hasn;
  }
#undef GEMM_TILE_OF
  if (extra) { asm volatile("s_waitcnt vmcnt(0)" ::: "memory"); __syncthreads(); }
  for (int ci = VBID; ci < extra; ci += VGDIM) {
    {
      if (ci < 2048) {
        const int idx = (ci * 256 + HTID) * 8;
        const int b = idx >> 19, rem = idx & 524287, tp = rem >> 10, c = rem & 1023;
        const float* src = p.in[2] + ((size_t)((b * 2 + L.slot) * 512 + tp)) * 1024 + c;
        const float4 u0 = *(const float4*)src, u1 = *(const float4*)(src + 4);
        *(uint4*)(R0 + 64 * MIB / 2 + ((size_t)b * 2560 + 2048 + tp) * 1024 + c) = make_uint4(pack2(u0.x, u0.y), pack2(u0.z, u0.w), pack2(u1.x, u1.y), pack2(u1.z, u1.w));
      } else {
        const int i2 = ci - 2048;
        const int b = i2 >> 7, hh = (i2 >> 4) & 7, tt = (i2 >> 1) & 7, et = i2 & 1;
        convT_tile(p.in[3] + ((size_t)((b * 2 + L.slot) * 512 + tt * 64)) * 1024 + hh * 128 + et * 64, 1024,
                   R0 + 120 * MIB / 2 + ((size_t)((b * 8 + hh) * 128 + et * 64)) * 2560 + 2048 + tt * 64, 2560, lds + HALFID * HALF_LDS);
      }
    }
  }
}

__device__ __forceinline__ void attn_phase(const Params& p, int l, unsigned char* lds, const bool dry, int phid) {
  const int slot = l == 3 ? 1 : 0;
  const float lam_init = 0.8f - 0.6f * expf(-0.3f * (float)l);
  const int tid = threadIdx.x, lane = tid & 63, w = tid >> 6, lr = lane & 15, lg = lane >> 4;
  float lam;
  {
    const float* lf = p.in[14] + slot * 256;
    const float a = wave_sum(lf[lane] * lf[64 + lane]);
    const float b2 = wave_sum(lf[128 + lane] * lf[192 + lane]);
    lam = expf(a) - expf(b2) + lam_init;
  }
  bf16_t* R0 = (bf16_t*)p.ws;
  const float* subg = p.in[15] + slot * 128;
  for (int item = blockIdx.x; item < 1536; item += gridDim.x) {
    int grp, b, h, qt;
    if (item < 1024) { grp = 1; b = item >> 7; h = (item >> 4) & 7; qt = item & 15; }
    else { const int i2 = item - 1024; grp = 0; b = i2 >> 4; h = (i2 >> 1) & 7; qt = i2 & 1; }
    const int nkeys = grp ? 2560 : 256, ntile = nkeys >> 7;
    const int mq = (grp ? 8192 + b * 2048 : b * 256) + qt * 128 + w * 16 + lr;
    const bf16_t* Kg = grp ? R0 + 64 * MIB / 2 + (size_t)b * 2560 * 1024 + h * 128 : R0 + 48 * MIB / 2 + (size_t)b * 256 * 1024 + h * 128;
    const bf16_t* Vg = grp ? R0 + 120 * MIB / 2 + (size_t)(b * 8 + h) * 128 * 2560 : R0 + 104 * MIB / 2 + (size_t)(b * 8 + h) * 128 * 256;
    bf16x8 qf[2][2];
#pragma unroll
    for (int sub = 0; sub < 2; ++sub)
#pragma unroll
      for (int ks = 0; ks < 2; ++ks) qf[sub][ks] = *(const bf16x8*)(R0 + (size_t)mq * 1024 + h * 128 + sub * 64 + ks * 32 + lg * 8);
    LAS unsigned char* l3 = (LAS unsigned char*)lds;
    const int wu = __builtin_amdgcn_readfirstlane(w);
    int koff[4], voff[4];
#pragma unroll
    for (int j = 0; j < 4; ++j) {
      const int kr = (wu * 4 + j) * 4 + (lane >> 4);
      koff[j] = kr * 1024 + (((lane & 15) ^ (kr & 15)) << 3);
      voff[j] = kr * nkeys + (((lane & 15) ^ (kr & 15)) << 3);
    }
#define ATT_STAGE_K(s, key0)                                                                                  \
  {                                                                                                           \
    _Pragma("unroll") for (int j = 0; j < 4; ++j)                                                             \
      __builtin_amdgcn_global_load_lds((const unsigned*)(Kg + (size_t)(key0) * 1024 + koff[j]), (LAS unsigned*)(l3 + (s) * 65536 + (wu * 4 + j) * 1024), 16, 0, 0); \
  }
#define ATT_STAGE_V(s, key0)                                                                                  \
  {                                                                                                           \
    _Pragma("unroll") for (int j = 0; j < 4; ++j)                                                             \
      __builtin_amdgcn_global_load_lds((const unsigned*)(Vg + (key0) + voff[j]), (LAS unsigned*)(l3 + (s) * 65536 + 32768 + (wu * 4 + j) * 1024), 16, 0, 0); \
  }
    const int xl = lg ^ lr;
    const int vsw = (lr >> 1) & 7;
    const int vlo = lr * 256 + ((((lg >> 1)) ^ lr) << 4) + (lg & 1) * 8;
    float mx[2] = {-1e30f, -1e30f}, ls[2] = {0.f, 0.f};
    f32x4 o0[8], o1[8];
#pragma unroll
    for (int et = 0; et < 8; ++et) { o0[et] = (f32x4){0.f, 0.f, 0.f, 0.f}; o1[et] = (f32x4){0.f, 0.f, 0.f, 0.f}; }
    ATT_STAGE_K(0, 0);
    ATT_STAGE_V(0, 0);
    asm volatile("s_waitcnt vmcnt(0)" ::: "memory");
    __syncthreads();
    for (int kt = 0; kt < ntile; ++kt) {
      if (kt + 1 < ntile) { ATT_STAGE_K((kt + 1) & 1, (kt + 1) * 128); ATT_STAGE_V((kt + 1) & 1, (kt + 1) * 128); }
      const unsigned char* ks_ = lds + (kt & 1) * 65536 + lr * 256;
      const unsigned char* vs_ = lds + (kt & 1) * 65536 + 32768;
#pragma unroll
      for (int k2 = 0; k2 < 4; ++k2) {
        bf16x8 kfr[8];
        uint2 vlo_[8], vhi_[8];
#pragma unroll
        for (int sub = 0; sub < 2; ++sub)
#pragma unroll
          for (int nn = 0; nn < 2; ++nn)
#pragma unroll
            for (int ks = 0; ks < 2; ++ks)
              kfr[sub * 4 + nn * 2 + ks] = *(const bf16x8*)(ks_ + (2 * k2 + nn) * 4096 + ((xl ^ (sub * 8 + ks * 4)) << 4));
#pragma unroll
        for (int et = 0; et < 8; ++et) {
          vlo_[et] = *(const uint2*)(vs_ + et * 4096 + (vlo ^ (k2 << 6)));
          vhi_[et] = *(const uint2*)(vs_ + et * 4096 + (vlo ^ (k2 << 6) ^ 32));
        }
        SB;
        f32x4 s[2][2];
#pragma unroll
        for (int sub = 0; sub < 2; ++sub)
#pragma unroll
          for (int nn = 0; nn < 2; ++nn) {
            s[sub][nn] = MFMA(kfr[sub * 4 + nn * 2], qf[sub][0], ((f32x4){0.f, 0.f, 0.f, 0.f}));
            s[sub][nn] = MFMA(kfr[sub * 4 + nn * 2 + 1], qf[sub][1], s[sub][nn]);
          }
        SB;
        bf16x8 pf[2];
        float tmx[2];
#pragma unroll
        for (int sub = 0; sub < 2; ++sub) {
          float tm = fmaxf(fmaxf(fmaxf(s[sub][0][0], s[sub][0][1]), fmaxf(s[sub][0][2], s[sub][0][3])), fmaxf(fmaxf(s[sub][1][0], s[sub][1][1]), fmaxf(s[sub][1][2], s[sub][1][3])));
          tm = fmaxf(tm, __shfl_xor(tm, 16));
          tm = fmaxf(tm, __shfl_xor(tm, 32));
          tmx[sub] = tm;
        }
        if (__any((tmx[0] > mx[0] + 8.f) || (tmx[1] > mx[1] + 8.f))) {
#pragma unroll
          for (int sub = 0; sub < 2; ++sub) {
            const float mn = (tmx[sub] > mx[sub] + 8.f) ? tmx[sub] : mx[sub];
            const float sc = __builtin_amdgcn_exp2f(mx[sub] - mn);
            mx[sub] = mn;
            ls[sub] *= sc;
#pragma unroll
            for (int et = 0; et < 8; ++et) {
              if (sub == 0) { o0[et][0] *= sc; o0[et][1] *= sc; o0[et][2] *= sc; o0[et][3] *= sc; }
              else { o1[et][0] *= sc; o1[et][1] *= sc; o1[et][2] *= sc; o1[et][3] *= sc; }
            }
          }
        }
#pragma unroll
        for (int sub = 0; sub < 2; ++sub) {
          unsigned pw[4];
          float acc = 0.f;
#pragma unroll
          for (int nn = 0; nn < 2; ++nn) {
            float a[4];
#pragma unroll
            for (int r = 0; r < 4; ++r) { a[r] = __builtin_amdgcn_exp2f(s[sub][nn][r] - mx[sub]); acc += a[r]; }
            pw[nn * 2] = pack2(a[0], a[1]);
            pw[nn * 2 + 1] = pack2(a[2], a[3]);
          }
          ls[sub] += acc;
          union { unsigned u[4]; bf16x8 v; } cp;
          cp.u[0] = pw[0]; cp.u[1] = pw[1]; cp.u[2] = pw[2]; cp.u[3] = pw[3];
          pf[sub] = cp.v;
        }
        SB;
#pragma unroll
        for (int et = 0; et < 8; ++et) {
          union { unsigned u[4]; bf16x8 v; } cv;
          cv.u[0] = vlo_[et].x; cv.u[1] = vlo_[et].y; cv.u[2] = vhi_[et].x; cv.u[3] = vhi_[et].y;
          o0[et] = MFMA(cv.v, pf[0], o0[et]);
          o1[et] = MFMA(cv.v, pf[1], o1[et]);
        }
        SB;
      }
      asm volatile("s_waitcnt vmcnt(0)" ::: "memory");
      __syncthreads();
    }
    f32x4 o[8];
    {
      float t0 = ls[0], t1 = ls[1];
      t0 += __shfl_xor(t0, 16); t0 += __shfl_xor(t0, 32);
      t1 += __shfl_xor(t1, 16); t1 += __shfl_xor(t1, 32);
      const float c1 = 1.f / t0, c2 = lam / t1;
#pragma unroll
      for (int et = 0; et < 8; ++et)
#pragma unroll
        for (int r = 0; r < 4; ++r) o[et][r] = o0[et][r] * c1 - o1[et][r] * c2;
    }
#undef ATT_STAGE_K
#undef ATT_STAGE_V
    float ss = 0.f;
#pragma unroll
    for (int et = 0; et < 8; ++et)
#pragma unroll
      for (int r = 0; r < 4; ++r) ss += o[et][r] * o[et][r];
    ss += __shfl_xor(ss, 16);
    ss += __shfl_xor(ss, 32);
    const float rs = rsqrtf(ss * (1.f / 128.f) + 1e-6f) * (1.f - lam_init);
    bf16_t* gp = R0 + 160 * MIB / 2 + (size_t)mq * 1024 + h * 128;
#pragma unroll
    for (int et = 0; et < 8; ++et) {
      const int e0 = 16 * et + 4 * lg;
      const uint2 g = *(const uint2*)(gp + e0);
      const float4 sg = *(const float4*)(subg + e0);
      const float v0 = o[et][0] * rs * sg.x * lo_f(g.x), v1 = o[et][1] * rs * sg.y * hi_f(g.x);
      const float v2 = o[et][2] * rs * sg.z * lo_f(g.y), v3 = o[et][3] * rs * sg.w * hi_f(g.y);
      if (!dry) *(uint2*)(gp + e0) = make_uint2(pack2(v0, v1), pack2(v2, v3));
    }
  }
}

__device__ __forceinline__ bf16_t* hg_ob_row(const Params& p, int m) {
  const int c = m >> 9;
  float* base = c < 32 ? p.out + OUT_CK + (size_t)(c * 2 + 1) * 262144 : p.out + OUT_CV + (size_t)((c - 32) * 2 + 1) * 262144;
  return (bf16_t*)base + (size_t)(m & 511) * 1024;
}

__device__ __forceinline__ bf16_t* ret_ob_row(const Params& p, int ms) {
  const int c = ms >> 8;
  float* base = c < 32 ? p.out + OUT_CK + (size_t)(c * 2 + 1) * 262144 : p.out + OUT_CV + (size_t)((c - 32) * 2 + 1) * 262144;
  return (bf16_t*)base + (size_t)(ms & 255) * 2048;
}

template <int KIND, int DIR>
__device__ __forceinline__ void scan_item(const Params& p, int item, unsigned char* lds, const bool dry) {
  constexpr int DV = KIND == 1 ? 256 : 128, NSL = DV / 64, LDV = KIND == 1 ? 2048 : 1024;
  const int tid = HTID, lane = tid & 63, w = tid >> 6, lr = lane & 15, lg = lane >> 4;
  int grp, b, h, sl;
  {
    int it = item;
    if (it < 64 * NSL) grp = 1; else { grp = 0; it -= 64 * NSL; }
    sl = it % NSL; h = (it / NSL) & 7; b = it / (NSL * 8);
  }
  const int T = grp ? 2048 : 256, nch = T >> 6;
  const size_t mbase = grp ? (size_t)8192 + (size_t)b * 2048 : (size_t)b * 256;
  bf16_t* R0 = (bf16_t*)p.ws;
  const bf16_t* Qg = R0 + mbase * 1024 + h * 128;
  const bf16_t* Kg = R0 + (KIND == 1 ? PLANE_E : (DIR ? 2 * PLANE_E : PLANE_E)) + mbase * 1024 + h * 128;
  const bf16_t* Vg = R0 + (KIND == 1 ? 2 * PLANE_E : 3 * PLANE_E) + mbase * LDV + h * DV + sl * 64;
  bf16_t* Og = R0 + (KIND == 1 ? 4 * PLANE_E : 5 * PLANE_E) + mbase * LDV + h * DV + sl * 64;
  unsigned char* Qs = lds;
  unsigned char* X = lds + 17408;
  unsigned char* Vt = lds + 35840;
  unsigned char* StS = lds + 45056;
  unsigned char* Pm = lds + 62464;
  float* xch = (float*)(lds + 71680);
  float* blA = xch + 512;
  float* erA = xch + 640;
  const int dp = tid & 63, tq = tid >> 6, r0 = tq * 16, d0 = dp * 2;
  float cst0, cst1;
  if (KIND == 1) { cst0 = cst1 = log1pf(-expf(p.in[18][DIR * 8 + h])) * 1.4426950408889634f; }
  else {
    const float* lbp = p.in[21] + DIR * 4096 + h * 128 + d0;
    {
      const float x0 = lbp[0], x1 = lbp[1024], x2 = lbp[2048], x3 = lbp[3072];
      const float m = fmaxf(fmaxf(x0, x1), fmaxf(x2, x3));
      const float e0 = expf(x0 - m), e1 = expf(x1 - m), e2 = expf(x2 - m), e3 = expf(x3 - m);
      cst0 = (e1 + e2) / (e0 + e1 + e2 + e3);
    }
    {
      const float x0 = lbp[1], x1 = lbp[1025], x2 = lbp[2049], x3 = lbp[3073];
      const float m = fmaxf(fmaxf(x0, x1), fmaxf(x2, x3));
      const float e0 = expf(x0 - m), e1 = expf(x1 - m), e2 = expf(x2 - m), e3 = expf(x3 - m);
      cst1 = (e1 + e2) / (e0 + e1 + e2 + e3);
    }
  }
  f32x4 S[8];
  if (grp) {
    const float* s0 = (KIND == 1 ? p.in[4] : p.in[5]) + ((size_t)((b * 2 + DIR) * 8 + h) * 128) * DV + sl * 64 + 16 * w + lr + (size_t)(4 * lg) * DV;
    asm volatile("" : "+v"(s0));
#pragma unroll
    for (int dt = 0; dt < 8; ++dt)
#pragma unroll
      for (int r = 0; r < 4; ++r) S[dt][r] = s0[(16 * dt + r) * DV];
  } else {
#pragma unroll
    for (int dt = 0; dt < 8; ++dt) S[dt] = (f32x4){0.f, 0.f, 0.f, 0.f};
  }
  unsigned qv[16], kv[16], vv[8];
  const int ve2 = tid & 31, vq = tid >> 5;
  const int qoff = r0 * 512 + dp;
  const int voff = (8 * vq) * (LDV / 2) + ve2;
  const unsigned* Qg32 = (const unsigned*)Qg;
  const unsigned* Kg32 = (const unsigned*)Kg;
  const unsigned* Vg32 = (const unsigned*)Vg;
#define SCAN_ISSUE(c)                                                                                   \
  {                                                                                                     \
    const unsigned* q_ = Qg32 + (size_t)(c) * (64 * 512) + qoff;                                        \
    const unsigned* k_ = Kg32 + (size_t)(c) * (64 * 512) + qoff;                                        \
    const unsigned* v_ = Vg32 + (size_t)(c) * (64 * (LDV / 2)) + voff;                                  \
    asm volatile("" : "+v"(q_), "+v"(k_), "+v"(v_));                                                    \
    _Pragma("unroll") for (int i = 0; i < 16; ++i) { qv[i] = q_[i * 512]; kv[i] = k_[i * 512]; }        \
    _Pragma("unroll") for (int i = 0; i < 8; ++i) vv[i] = v_[i * (LDV / 2)];                            \
  }
  if (KIND == 1) {
    if (tid < 64) {
      const float ex = (DIR ? (float)(32 - tid) : (float)(tid - 31)) * cst0;
      *(float2*)(xch + 2 * tid) = make_float2(__builtin_amdgcn_exp2f(ex), __builtin_amdgcn_exp2f(-ex));
    }
    if (tid < 128) { blA[tid] = __builtin_amdgcn_exp2f(64.f * cst0); erA[tid] = __builtin_amdgcn_exp2f(32.f * cst0); }
    __syncthreads();
  }
  SCAN_ISSUE(DIR ? nch - 1 : 0);
  for (int ci = 0; ci < nch; ++ci) {
    const int c = DIR ? nch - 1 - ci : ci;
    unsigned ktp0[8], ktp1[8];
    if (KIND == 1) {
      const float cbr = __builtin_amdgcn_exp2f(32.f * cst0);
#pragma unroll
      for (int j = 0; j < 8; ++j) {
        float ka[2], kb[2];
#pragma unroll
        for (int hh = 0; hh < 2; ++hh) {
          const int i = 2 * j + hh;
          const float2 e = *(const float2*)(xch + 2 * (r0 + i));
          *(unsigned*)(Qs + (r0 + i) * 272 + d0 * 2) = pack2(lo_f(qv[i]) * e.x, hi_f(qv[i]) * e.x);
          const float kh0 = lo_f(kv[i]) * e.y, kh1 = hi_f(kv[i]) * e.y;
          *(unsigned*)(X + (r0 + i) * 272 + d0 * 2) = pack2(kh0, kh1);
          ka[hh] = kh0 * cbr;
          kb[hh] = kh1 * cbr;
        }
        ktp0[j] = pack2(ka[0], ka[1]);
        ktp1[j] = pack2(kb[0], kb[1]);
      }
    } else {
    float tot0 = 0.f, tot1 = 0.f;
#pragma unroll
    for (int i = 0; i < 16; ++i) {
      const float s0_ = 1.f / (1.f + __expf(-lo_f(kv[i]))), s1_ = 1.f / (1.f + __expf(-hi_f(kv[i])));
      tot0 += __log2f(cst0 + (1.f - cst0) * s0_);
      tot1 += __log2f(cst1 + (1.f - cst1) * s1_);
    }
    *(float2*)(xch + tq * 128 + d0) = make_float2(tot0, tot1);
    __syncthreads();
    const float2 t0 = *(const float2*)(xch + d0), t1 = *(const float2*)(xch + 128 + d0), t2 = *(const float2*)(xch + 256 + d0), t3 = *(const float2*)(xch + 384 + d0);
    const float blast0 = (t0.x + t1.x) + (t2.x + t3.x), blast1 = (t0.y + t1.y) + (t2.y + t3.y);
    float ref0, ref1, run0, run1;
    if (DIR == 0) {
      ref0 = t0.x + t1.x; ref1 = t0.y + t1.y;
      run0 = (tq > 0 ? t0.x : 0.f) + (tq > 1 ? t1.x : 0.f) + (tq > 2 ? t2.x : 0.f);
      run1 = (tq > 0 ? t0.y : 0.f) + (tq > 1 ? t1.y : 0.f) + (tq > 2 ? t2.y : 0.f);
    } else {
      ref0 = t2.x + t3.x; ref1 = t2.y + t3.y;
      run0 = (tq < 3 ? t3.x : 0.f) + (tq < 2 ? t2.x : 0.f) + (tq < 1 ? t1.x : 0.f);
      run1 = (tq < 3 ? t3.y : 0.f) + (tq < 2 ? t2.y : 0.f) + (tq < 1 ? t1.y : 0.f);
    }
    const float cbr0 = __builtin_amdgcn_exp2f(blast0 - ref0), cbr1 = __builtin_amdgcn_exp2f(blast1 - ref1);
#pragma unroll
    for (int jj = 0; jj < 8; ++jj) {
      const int j = DIR ? 7 - jj : jj;
      float ka[2], kb[2];
#pragma unroll
      for (int hh = 0; hh < 2; ++hh) {
        const int i = 2 * j + (DIR ? 1 - hh : hh);
        const float s0_ = 1.f / (1.f + __expf(-lo_f(kv[i]))), s1_ = 1.f / (1.f + __expf(-hi_f(kv[i])));
        const float g0 = __log2f(cst0 + (1.f - cst0) * s0_), g1 = __log2f(cst1 + (1.f - cst1) * s1_);
        const float k0 = (1.f - cst0) * (1.f - s0_), k1 = (1.f - cst1) * (1.f - s1_);
        run0 += g0; run1 += g1;
        *(unsigned*)(Qs + (r0 + i) * 272 + d0 * 2) = pack2(lo_f(qv[i]) * __builtin_amdgcn_exp2f(run0 - ref0), hi_f(qv[i]) * __builtin_amdgcn_exp2f(run1 - ref1));
        const float kh0 = k0 * __builtin_amdgcn_exp2f(ref0 - run0), kh1 = k1 * __builtin_amdgcn_exp2f(ref1 - run1);
        *(unsigned*)(X + (r0 + i) * 272 + d0 * 2) = pack2(kh0, kh1);
        ka[i & 1] = kh0 * cbr0;
        kb[i & 1] = kh1 * cbr1;
      }
      ktp0[j] = pack2(ka[0], ka[1]);
      ktp1[j] = pack2(kb[0], kb[1]);
    }
    if (tq == 0) { *(float2*)(blA + d0) = make_float2(__builtin_amdgcn_exp2f(blast0), __builtin_amdgcn_exp2f(blast1)); *(float2*)(erA + d0) = make_float2(__builtin_amdgcn_exp2f(ref0), __builtin_amdgcn_exp2f(ref1)); }
    }
    {
      const unsigned a0 = (vv[0] & 0xffffu) | (vv[1] << 16), a1 = (vv[2] & 0xffffu) | (vv[3] << 16), a2 = (vv[4] & 0xffffu) | (vv[5] << 16), a3 = (vv[6] & 0xffffu) | (vv[7] << 16);
      const unsigned b0 = (vv[0] >> 16) | (vv[1] & 0xffff0000u), b1 = (vv[2] >> 16) | (vv[3] & 0xffff0000u), b2 = (vv[4] >> 16) | (vv[5] & 0xffff0000u), b3 = (vv[6] >> 16) | (vv[7] & 0xffff0000u);
      *(uint4*)(Vt + (2 * ve2) * 144 + vq * 16) = make_uint4(a0, a1, a2, a3);
      *(uint4*)(Vt + (2 * ve2 + 1) * 144 + vq * 16) = make_uint4(b0, b1, b2, b3);
    }
    if (ci + 1 < nch) { SCAN_ISSUE(DIR ? c - 1 : c + 1); }
    __syncthreads();
#pragma unroll
    for (int dt = 0; dt < 8; ++dt) {
      const float4 er4 = *(const float4*)(erA + 16 * dt + 4 * lg);
      *(uint2*)(StS + (16 * w + lr) * 272 + (16 * dt + 4 * lg) * 2) = make_uint2(pack2(S[dt][0] * er4.x, S[dt][1] * er4.y), pack2(S[dt][2] * er4.z, S[dt][3] * er4.w));
    }
    bf16x8 qf[4];
#pragma unroll
    for (int ks = 0; ks < 4; ++ks) qf[ks] = *(const bf16x8*)(Qs + (16 * w + lr) * 272 + ks * 64 + lg * 16);
    uint2 pv[4];
    {
      const int t = 16 * w + lr;
#pragma unroll
      for (int st = 0; st < 4; ++st) {
        f32x4 s = (f32x4){0.f, 0.f, 0.f, 0.f};
#pragma unroll
        for (int ks = 0; ks < 4; ++ks) {
          const bf16x8 kf = *(const bf16x8*)(X + (16 * st + lr) * 272 + ks * 64 + lg * 16);
          s = MFMA(kf, qf[ks], s);
        }
        float v[4];
#pragma unroll
        for (int r = 0; r < 4; ++r) {
          const int si = 16 * st + 4 * lg + r;
          const bool keep = DIR ? (t <= si) : (t >= si);
          v[r] = keep ? s[r] : 0.f;
        }
        pv[st] = make_uint2(pack2(v[0], v[1]), pack2(v[2], v[3]));
      }
    }
    __syncthreads();
#pragma unroll
    for (int st = 0; st < 4; ++st) *(uint2*)(Pm + (16 * w + lr) * 144 + (16 * st + 4 * lg) * 2) = pv[st];
    *(uint4*)(X + d0 * 144 + r0 * 2) = make_uint4(ktp0[0], ktp0[1], ktp0[2], ktp0[3]);
    *(uint4*)(X + d0 * 144 + r0 * 2 + 16) = make_uint4(ktp0[4], ktp0[5], ktp0[6], ktp0[7]);
    *(uint4*)(X + (d0 + 1) * 144 + r0 * 2) = make_uint4(ktp1[0], ktp1[1], ktp1[2], ktp1[3]);
    *(uint4*)(X + (d0 + 1) * 144 + r0 * 2 + 16) = make_uint4(ktp1[4], ktp1[5], ktp1[6], ktp1[7]);
    __syncthreads();
    {
      bf16x8 pf[2];
#pragma unroll
      for (int ks = 0; ks < 2; ++ks) pf[ks] = *(const bf16x8*)(Pm + (16 * w + lr) * 144 + ks * 64 + lg * 16);
      const bool sep = DIR && (KIND == 2 || grp);
      bf16_t* orow = (KIND == 2 && DIR) ? hg_ob_row(p, (int)mbase + c * 64 + 16 * w + lr) + h * DV + sl * 64 + 4 * lg
                   : (KIND == 1 && DIR && grp) ? ret_ob_row(p, b * 2048 + c * 64 + 16 * w + lr) + h * DV + sl * 64 + 4 * lg
                                               : Og + (size_t)(c * 64 + 16 * w + lr) * LDV + 4 * lg;
#pragma unroll
      for (int et = 0; et < 4; ++et) {
        f32x4 o = (f32x4){0.f, 0.f, 0.f, 0.f};
#pragma unroll
        for (int ks = 0; ks < 2; ++ks) {
          const bf16x8 vf = *(const bf16x8*)(Vt + (16 * et + lr) * 144 + ks * 64 + lg * 16);
          o = MFMA(vf, pf[ks], o);
        }
#pragma unroll
        for (int ks = 0; ks < 4; ++ks) {
          const bf16x8 sf = *(const bf16x8*)(StS + (16 * et + lr) * 272 + ks * 64 + lg * 16);
          o = MFMA(sf, qf[ks], o);
        }
        bf16_t* op = orow + 16 * et;
        if (DIR && !sep) {
          const uint2 old = *(const uint2*)op;
          o[0] += lo_f(old.x); o[1] += hi_f(old.x); o[2] += lo_f(old.y); o[3] += hi_f(old.y);
        }
        if (!(DIR && !sep && dry)) *(uint2*)op = make_uint2(pack2(o[0], o[1]), pack2(o[2], o[3]));
      }
    }
    {
      bf16x8 vtf[2];
#pragma unroll
      for (int ks = 0; ks < 2; ++ks) vtf[ks] = *(const bf16x8*)(Vt + (16 * w + lr) * 144 + ks * 64 + lg * 16);
#pragma unroll
      for (int dt = 0; dt < 8; ++dt) {
        const float4 bl4 = *(const float4*)(blA + 16 * dt + 4 * lg);
        S[dt][0] *= bl4.x; S[dt][1] *= bl4.y; S[dt][2] *= bl4.z; S[dt][3] *= bl4.w;
#pragma unroll
        for (int ks = 0; ks < 2; ++ks) {
          const bf16x8 kf = *(const bf16x8*)(X + (16 * dt + lr) * 144 + ks * 64 + lg * 16);
          S[dt] = MFMA(kf, vtf[ks], S[dt]);
        }
      }
    }
    __syncthreads();
  }
#undef SCAN_ISSUE
  if (!grp) {
    float* so = p.out + (KIND == 1 ? OUT_SR : OUT_SH) + ((size_t)((b * 2 + DIR) * 8 + h) * 128) * DV + sl * 64 + 16 * w + lr + (size_t)(4 * lg) * DV;
    asm volatile("" : "+v"(so));
#pragma unroll
    for (int dt = 0; dt < 8; ++dt)
#pragma unroll
      for (int r = 0; r < 4; ++r) so[(16 * dt + r) * DV] = S[dt][r];
  }
}

template <int KIND, int DIR>
__device__ __forceinline__ void scan_phase(const Params& p, unsigned char* lds, const bool dry) {
  constexpr int NSL = (KIND == 1 ? 256 : 128) / 64;
  const int ns = 64 * NSL, npr = 256 * NSL;
  const int G = VGDIM, bid = VBID;
  int it, step, end = ns + npr;
  if (G > ns) {
    if (bid < ns) { it = bid; step = end; }
    else { it = ns + (bid - ns); step = G - ns; }
  } else { it = bid; step = G; }
  for (; it < end; it += step) scan_item<KIND, DIR>(p, it, lds, dry);
}

__device__ __forceinline__ void scan_phase_ret_sample(const Params& p, unsigned char* lds, const bool dry) {
  const int G = VGDIM >> 1, bid = VBID;
  const int role = bid >= G;
  const int rb = role ? bid - G : bid;
  if (role == 0) { for (int it = rb; it < 256; it += G) scan_item<1, 0>(p, it, lds, dry); }
  else           { for (int it = rb; it < 256; it += G) scan_item<1, 1>(p, it, lds, dry); }
}
template <int DIR>
__device__ __forceinline__ void scan_phase_ret_prompt(const Params& p, unsigned char* lds, const bool dry) {
  for (int it = VBID; it < 1024; it += VGDIM) scan_item<1, DIR>(p, 256 + it, lds, dry);
}

__device__ __forceinline__ void scan_phase_hg_both(const Params& p, unsigned char* lds, const bool dry) {
  const int G = VGDIM >> 1, bid = VBID;
  const int role = bid >= G;
  const int rb = role ? bid - G : bid;
  int it, step;
  if (G > 128) {
    if (rb < 128) { it = rb; step = 1 << 20; } else { it = rb; step = G - 128; }
  } else { it = rb; step = G; }
  if (role == 0) { for (; it < 640; it += step) scan_item<2, 0>(p, it, lds, dry); }
  else           { for (; it < 640; it += step) scan_item<2, 1>(p, it, lds, dry); }
}

template <int KIND>
__device__ __forceinline__ void normgate_phase(const Params& p, const bool dry) {
  constexpr int NCH = KIND == 1 ? 4 : 2, DV = KIND == 1 ? 256 : 128, LD = KIND == 1 ? 2048 : 1024;
  const int tid = HTID, lane = tid & 63, w = tid >> 6;
  const int hh = lane >> 3, sub = lane & 7;
  bf16_t* R0 = (bf16_t*)p.ws;
  bf16_t* Ob = R0 + (KIND == 1 ? 4 * PLANE_E : 5 * PLANE_E) + hh * DV + sub * 8;
  const bf16_t* Gb = R0 + (KIND == 1 ? 0 : 4 * PLANE_E) + hh * DV + sub * 8;
  float gn[NCH][8];
#pragma unroll
  for (int j = 0; j < NCH; ++j)
#pragma unroll
    for (int i = 0; i < 8; ++i) gn[j][i] = (KIND == 1) ? 1.f : p.in[22][j * 64 + sub * 8 + i];
  for (int row = VBID * 4 + w; row < 24576; row += VGDIM * 4) {
    bf16_t* op = Ob + (size_t)row * LD;
    const bf16_t* gp = Gb + (size_t)row * LD;
    uint4 ov[NCH], gv[NCH];
#pragma unroll
    for (int j = 0; j < NCH; ++j) { ov[j] = *(const uint4*)(op + j * 64); gv[j] = *(const uint4*)(gp + j * 64); }
    if (KIND == 2 || row >= 8192) {
      const bf16_t* bp = (KIND == 2 ? hg_ob_row(p, row) : ret_ob_row(p, row - 8192)) + hh * DV + sub * 8;
#pragma unroll
      for (int j = 0; j < NCH; ++j) {
        const uint4 bv = *(const uint4*)(bp + j * 64);
        ov[j].x = pack2(lo_f(ov[j].x) + lo_f(bv.x), hi_f(ov[j].x) + hi_f(bv.x));
        ov[j].y = pack2(lo_f(ov[j].y) + lo_f(bv.y), hi_f(ov[j].y) + hi_f(bv.y));
        ov[j].z = pack2(lo_f(ov[j].z) + lo_f(bv.z), hi_f(ov[j].z) + hi_f(bv.z));
        ov[j].w = pack2(lo_f(ov[j].w) + lo_f(bv.w), hi_f(ov[j].w) + hi_f(bv.w));
      }
    }
    float ss = 0.f;
#pragma unroll
    for (int j = 0; j < NCH; ++j) {
      const unsigned wv[4] = {ov[j].x, ov[j].y, ov[j].z, ov[j].w};
#pragma unroll
      for (int i = 0; i < 4; ++i) { const float a = lo_f(wv[i]), b2 = hi_f(wv[i]); ss += a * a + b2 * b2; }
    }
    ss += __shfl_xor(ss, 1);
    ss += __shfl_xor(ss, 2);
    ss += __shfl_xor(ss, 4);
    const float rs = rsqrtf(ss * (1.f / (float)DV) + 1e-6f);
#pragma unroll
    for (int j = 0; j < NCH; ++j) {
      const unsigned wv[4] = {ov[j].x, ov[j].y, ov[j].z, ov[j].w};
      const unsigned gw[4] = {gv[j].x, gv[j].y, gv[j].z, gv[j].w};
      unsigned r[4];
#pragma unroll
      for (int i = 0; i < 4; ++i)
        r[i] = pack2(lo_f(wv[i]) * rs * gn[j][2 * i] * lo_f(gw[i]), hi_f(wv[i]) * rs * gn[j][2 * i + 1] * hi_f(gw[i]));
      if (!dry) *(uint4*)(op + j * 64) = make_uint4(r[0], r[1], r[2], r[3]);
    }
  }
}

__device__ __forceinline__ void opaque_params(Params& q) {
  asm volatile("" : "+s"(q.out), "+s"(q.ws));
#pragma unroll
  for (int i = 0; i < 23; ++i) asm volatile("" : "+s"(q.in[i]));
}

struct BarState { unsigned* base; unsigned xcd, mycnt, nact, esub, etop; };
__device__ __forceinline__ void grid_barrier(BarState& b) {
  asm volatile("s_waitcnt vmcnt(0) lgkmcnt(0)" ::: "memory");
  __syncthreads();
  if (threadIdx.x == 0) {
    b.esub += b.mycnt; b.etop += b.nact;
    const unsigned old = __hip_atomic_fetch_add(b.base + 64 * b.xcd, 1u, __ATOMIC_RELAXED, __HIP_MEMORY_SCOPE_AGENT);
    if (old + 1u == b.esub) {
      __builtin_amdgcn_fence(__ATOMIC_RELEASE, "agent");
      __hip_atomic_fetch_add(b.base + 512, 1u, __ATOMIC_RELAXED, __HIP_MEMORY_SCOPE_AGENT);
    }
    while (__hip_atomic_load(b.base + 512, __ATOMIC_RELAXED, __HIP_MEMORY_SCOPE_AGENT) < b.etop) __builtin_amdgcn_s_sleep(1);
    __builtin_amdgcn_fence(__ATOMIC_ACQUIRE, "agent");
  }
  __syncthreads();
}
__device__ __forceinline__ void bar_census_post(BarState& b) {
  if (threadIdx.x == 0) __hip_atomic_fetch_add(b.base + 1024 + 64 * b.xcd, 1u, __ATOMIC_RELAXED, __HIP_MEMORY_SCOPE_AGENT);
}
__device__ __forceinline__ void bar_census_read(BarState& b) {
  if (threadIdx.x == 0) {
    unsigned n = 0;
    for (unsigned j = 0; j < 8; ++j) {
      const unsigned c = __hip_atomic_load(b.base + 1024 + 64 * j, __ATOMIC_RELAXED, __HIP_MEMORY_SCOPE_AGENT);
      n += (c != 0u);
      if (j == b.xcd) b.mycnt = c;
    }
    b.nact = n;
  }
}
#define GSYNC(n) { if ((n) == 0) { grid.sync(); bar_census_read(bst); } else grid_barrier(bst); }

#if defined(PH_ONLY)
#define PHASE(n, call) if (n == PH_ONLY) { const bool dry = false; call; }
#elif defined(REP_N)
#define PHASE(n, call) if (lo <= n && n < hi) { for (int rep = (n == REP_N ? 0 : 1); rep < 2; ++rep) { const bool dry = (rep == 0); call; if (!(fin && n + 1 == hi && rep == 1)) GSYNC(n) } }
#else
#define PHASE(n, call) if (lo <= n && n < hi) { const bool dry = false; call; if (!(fin && n + 1 == hi)) GSYNC(n) }
#endif

__device__ __forceinline__ void run_range(const Params& q, int lo, int hi, bool fin, cg::grid_group& grid, unsigned char* lds) {
  unsigned char* ldh = lds + HALFID * HALF_LDS;
  BarState bst; bst.base = (unsigned*)(q.ws + OFF_MISC + MISC_CTR); bst.xcd = xcc_id(); bst.mycnt = 0; bst.nact = 0; bst.esub = 0; bst.etop = 0;
  if (lo == 0) bar_census_post(bst);
  PHASE(0, phase0(q, ldh))
  PHASE(1, post_phase(q, -1, 0, ldh, dry))
  PHASE(2, gemm_phase(q, 0, GM_IN_DA, lds, 2))
  PHASE(3, attn_phase(q, 0, lds, dry, 3))
  PHASE(4, gemm_phase(q, 0, GM_OUT, lds, 4))
  PHASE(5, post_phase(q, 0, 1, ldh, dry))
  PHASE(6, gemm_phase(q, 1, GM_IN_RET_QKV, lds, 6))
  PHASE(7, scan_phase_ret_sample(q, ldh, dry))
  PHASE(8, scan_phase_ret_prompt<0>(q, ldh, dry))
  PHASE(8, scan_phase_ret_prompt<1>(q, ldh, dry))
  PHASE(9, gemm_phase(q, 1, GM_IN_RET_G, lds, 9))
  PHASE(10, normgate_phase<1>(q, dry))
  PHASE(11, gemm_phase(q, 1, GM_OUT, lds, 11))
  PHASE(12, post_phase(q, 1, 2, ldh, dry))
  PHASE(13, gemm_phase(q, 2, GM_IN_HG, lds, 13))
  PHASE(14, scan_phase_hg_both(q, ldh, dry))
  PHASE(16, normgate_phase<2>(q, dry))
  PHASE(17, gemm_phase(q, 2, GM_OUT, lds, 17))
  PHASE(18, post_phase(q, 2, 3, ldh, dry))
  PHASE(19, gemm_phase(q, 3, GM_IN_DA, lds, 19))
  PHASE(20, attn_phase(q, 3, lds, dry, 20))
  PHASE(21, gemm_phase(q, 3, GM_OUT, lds, 21))
  PHASE(22, post_phase(q, 3, 4, ldh, dry))
}

__global__ void __launch_bounds__(NTHR, 2) mega_fwd(Params p) {
  extern __shared__ __attribute__((aligned(16))) unsigned char lds[];
  cg::grid_group grid = cg::this_grid();
  run_range(p, p.ph_lo, p.ph_hi, true, grid, lds);
}

extern "C" void kernel_launch(void* const* d_in, const int* in_sizes, int n_in, void* d_out, int out_size, void* d_ws, size_t ws_size, hipStream_t stream) {
  static int grid_blocks = 0;
  if (grid_blocks == 0) {
    int dev = 0, cus = 0, per_cu = 0;
    hipGetDevice(&dev);
    hipDeviceGetAttribute(&cus, hipDeviceAttributeMultiprocessorCount, dev);
    hipFuncSetAttribute((const void*)mega_fwd, hipFuncAttributeMaxDynamicSharedMemorySize, LDS_BYTES);
    hipOccupancyMaxActiveBlocksPerMultiprocessor(&per_cu, (const void*)mega_fwd, NTHR, LDS_BYTES);
    if (per_cu < 1) per_cu = 1;
    if (per_cu > 1) per_cu = 1;
    if (cus < 1) cus = 256;
    grid_blocks = cus * per_cu;
    (void)hipGetLastError();
    if (n_in != 23 || ws_size < WS_NEED) { fprintf(stderr, "kernel_launch: unexpected n_in %d / ws_size %zu (need %zu)\n", n_in, ws_size, (size_t)WS_NEED); }
  }
  hipMemsetAsync((unsigned char*)d_ws + OFF_MISC + MISC_CTR, 0, 8192, stream);
  Params p{};
  for (int i = 0; i < 23; ++i) p.in[i] = (const float*)d_in[i];
  p.out = (float*)d_out;
  p.ws = (unsigned char*)d_ws;
#if ONE_LAUNCH
  p.ph_lo = 0; p.ph_hi = NPH;
  void* args[] = {&p};
  hipError_t e = hipLaunchCooperativeKernel((const void*)mega_fwd, dim3(grid_blocks), dim3(NTHR), args, LDS_BYTES, stream);
  if (e != hipSuccess) fprintf(stderr, "cooperative launch failed: %s (grid %d)\n", hipGetErrorString(e), grid_blocks);
#else
  for (int ph = 0; ph < NPH; ++ph) {
    p.ph_lo = ph; p.ph_hi = ph + 1;
    hipLaunchKernelGGL(mega_fwd, dim3(grid_blocks), dim3(NTHR), LDS_BYTES, stream, p);
  }
#endif
}
```

```cpp
#include <hip/hip_runtime.h>
#include <hip/hip_cooperative_groups.h>
#include <cstdint>
#include <cstdio>
namespace cg = cooperative_groups;

#ifndef ONE_LAUNCH
#define ONE_LAUNCH 1
#endif

typedef unsigned short bf16_t;
typedef short bf16x8 __attribute__((ext_vector_type(8)));
typedef float f32x4 __attribute__((ext_vector_type(4)));

#define NTHR 512
#define HTID ((int)(threadIdx.x & 255))
#define HALFID ((int)(threadIdx.x >> 8))
#define VBID ((int)(blockIdx.x * 2 + (threadIdx.x >> 8)))
#define VGDIM ((int)(gridDim.x * 2))
#define HALF_LDS 74816
#define MIB ((size_t)1 << 20)
#define NPH 23
#define LDS_BYTES (2 * HALF_LDS)
#define LDS_SLOT 74752
#define MISC_LB (MISC_ROPE + 524288 + 16384)
#define MISC_CTR (MISC_ROPE + 524288)

#define OFF_WIN  (288 * MIB)
#define OFF_WOUT (300 * MIB)
#define OFF_HP   (304 * MIB)
#define OFF_MISC (320 * MIB)
#define MISC_ROPE 524288
#define WS_NEED  (322 * MIB)
#define PLANE_E  ((size_t)25165824)
#define OUT_YP 0
#define OUT_YS 8388608
#define OUT_CK 25165824
#define OUT_CV 41943040
#define OUT_SR 58720256
#define OUT_SH 75497472

struct Params {
  const float* in[23];
  float* out;
  unsigned char* ws;
  int ph_lo, ph_hi;
};

struct LayerInfo { int kind, slot, IN, WIDTH; const float* w_in; const float* w_out; };

__device__ __forceinline__ LayerInfo layer_info(const Params& p, int l) {
  LayerInfo L;
  if (l == 0)      { L.kind = 0; L.slot = 0; L.IN = 4096; L.WIDTH = 1024; L.w_in = p.in[12]; L.w_out = p.in[13]; }
  else if (l == 1) { L.kind = 1; L.slot = 0; L.IN = 6144; L.WIDTH = 2048; L.w_in = p.in[16]; L.w_out = p.in[17]; }
  else if (l == 2) { L.kind = 2; L.slot = 0; L.IN = 5120; L.WIDTH = 1024; L.w_in = p.in[19]; L.w_out = p.in[20]; }
  else             { L.kind = 0; L.slot = 1; L.IN = 4096; L.WIDTH = 1024; L.w_in = p.in[12] + (size_t)1024 * 4096; L.w_out = p.in[13] + (size_t)1024 * 1024; }
  return L;
}
__device__ __forceinline__ bf16_t* hs_ptr(const Params& p, int l) {
  return l < 3 ? (bf16_t*)(p.out + OUT_SH) : (bf16_t*)(p.ws + 240 * MIB);
}

typedef __bf16 nbf16x2 __attribute__((ext_vector_type(2)));
typedef float f32x2 __attribute__((ext_vector_type(2)));
__device__ __forceinline__ float bf2f(unsigned h) { return __uint_as_float(h << 16); }
__device__ __forceinline__ unsigned pack2(float a, float b) { const f32x2 f = {a, b}; return __builtin_bit_cast(unsigned, __builtin_convertvector(f, nbf16x2)); }
__device__ __forceinline__ float lo_f(unsigned w) { return __uint_as_float(w << 16); }
__device__ __forceinline__ float hi_f(unsigned w) { return __uint_as_float(w & 0xffff0000u); }
__device__ __forceinline__ float silu_f(float x) { return x / (1.f + __expf(-x)); }
__device__ __forceinline__ float wave_sum(float v) {
#pragma unroll
  for (int o = 32; o > 0; o >>= 1) v += __shfl_xor(v, o);
  return v;
}
#define QSCALE 0.18033688011112042f
#define SB __builtin_amdgcn_sched_barrier(0)
#define MFMA(a, b, c) __builtin_amdgcn_mfma_f32_16x16x32_bf16((a), (b), (c), 0, 0, 0)

__device__ __forceinline__ void convT_tile(const float* __restrict__ src, int src_ld, bf16_t* __restrict__ dst, int dst_ld, unsigned char* lds) {
  float* t = (float*)lds;
  const int tid = HTID;
  const int kr = tid >> 4, nc = (tid & 15) * 4;
#pragma unroll
  for (int j = 0; j < 4; ++j) {
    const float4 v = *(const float4*)(src + (size_t)(kr + 16 * j) * src_ld + nc);
    float* tp = t + (kr + 16 * j) * 65 + nc;
    tp[0] = v.x; tp[1] = v.y; tp[2] = v.z; tp[3] = v.w;
  }
  __syncthreads();
  const int n = tid >> 2, kc = (tid & 3) * 16;
  unsigned w[8];
#pragma unroll
  for (int i = 0; i < 8; ++i) w[i] = pack2(t[(kc + 2 * i) * 65 + n], t[(kc + 2 * i + 1) * 65 + n]);
  uint4* d = (uint4*)(dst + (size_t)n * dst_ld + kc);
  d[0] = make_uint4(w[0], w[1], w[2], w[3]);
  d[1] = make_uint4(w[4], w[5], w[6], w[7]);
  __syncthreads();
}

__device__ __forceinline__ int conv_weights_count(const Params& p, int l) {
  const LayerInfo L = layer_info(p, l);
  return (L.IN / 64) * 16 + (L.WIDTH / 64) * 16;
}
__device__ __forceinline__ void conv_weights_item(const Params& p, int l, int it, unsigned char* lds) {
  const LayerInfo L = layer_info(p, l);
  const int nin = (L.IN / 64) * 16;
  if (it < nin) {
    const int kt = it & 15, nt = it >> 4;
    convT_tile(L.w_in + (size_t)(kt * 64) * L.IN + nt * 64, L.IN, (bf16_t*)(p.ws + OFF_WIN) + (size_t)(nt * 64) * 1024 + kt * 64, 1024, lds);
  } else {
    const int it2 = it - nin, nkt = L.WIDTH / 64;
    const int kt = it2 % nkt, nt = it2 / nkt;
    convT_tile(L.w_out + (size_t)(kt * 64) * 1024 + nt * 64, 1024, (bf16_t*)(p.ws + OFF_WOUT) + (size_t)(nt * 64) * L.WIDTH + kt * 64, L.WIDTH, lds);
  }
}

__device__ __forceinline__ void mod_item(const Params& p, int it, unsigned char* lds) {
  float* ssilu = (float*)lds;
  float* red = ssilu + 9 * 1024;
  const int tid = HTID;
  const int l = it / 48, col0 = (it % 48) * 64;
  for (int i = tid; i < 9 * 1024; i += 256) {
    const int v = i >> 10, k = i & 1023;
    const float x = (v == 0) ? p.in[7][k] : p.in[6][(v - 1) * 1024 + k];
    ssilu[i] = silu_f(x);
  }
  __syncthreads();
  const int col = tid & 63, kq = tid >> 6;
  const float* w = p.in[8] + (size_t)l * 1024 * 3072 + col0 + col;
  float acc[9];
#pragma unroll
  for (int v = 0; v < 9; ++v) acc[v] = 0.f;
  for (int k = kq * 256; k < kq * 256 + 256; ++k) {
    const float wv = w[(size_t)k * 3072];
#pragma unroll
    for (int v = 0; v < 9; ++v) acc[v] += ssilu[v * 1024 + k] * wv;
  }
#pragma unroll
  for (int v = 0; v < 9; ++v) red[(kq * 9 + v) * 64 + col] = acc[v];
  __syncthreads();
  float* mod = (float*)(p.ws + OFF_MISC);
  for (int i = tid; i < 9 * 64; i += 256) {
    const int v = i >> 6, cc = i & 63;
    const float s = red[(0 * 9 + v) * 64 + cc] + red[(1 * 9 + v) * 64 + cc] + red[(2 * 9 + v) * 64 + cc] + red[(3 * 9 + v) * 64 + cc];
    mod[(size_t)(l * 9 + v) * 3072 + col0 + cc] = s + p.in[9][l * 3072 + col0 + cc];
  }
  __syncthreads();
}

__device__ __forceinline__ void rope_item(const Params& p, int it) {
  const int idx = it * 256 + HTID;
  const int t = idx >> 5, pp = idx & 31;
  const int pos = pp < 16 ? (t >> 6) : (t & 63);
  const float inv = exp2f(-(float)(pp & 15) * (13.287712379549449f / 16.f));
  const float ang = (float)pos * inv;
  const double a = (double)ang;
  const double r = a - 6.283185307179586 * rint(a * 0.15915494309189535);
  const float rf = (float)r;
  float2* tab = (float2*)(p.ws + OFF_MISC + MISC_ROPE);
  tab[idx] = make_float2(__cosf(rf), __sinf(rf));
  if (it < 8) {
    const int e = it * 256 + HTID;
    const float* lbp = p.in[21] + (e >> 10) * 4096 + (e & 1023);
    const float x0 = lbp[0], x1 = lbp[1024], x2 = lbp[2048], x3 = lbp[3072];
    const float m = fmaxf(fmaxf(x0, x1), fmaxf(x2, x3));
    const float e0 = expf(x0 - m), e1 = expf(x1 - m), e2 = expf(x2 - m), e3 = expf(x3 - m);
    ((float*)(p.ws + OFF_MISC + MISC_LB))[e] = (e1 + e2) / (e0 + e1 + e2 + e3);
  }
}

__device__ __forceinline__ void phase0(const Params& p, unsigned char* lds) {
  const int nw = conv_weights_count(p, 0);
  const int total = 192 + 256 + nw;
  for (int it = VBID; it < total; it += VGDIM) {
    if (it < 192) mod_item(p, it, lds);
    else if (it < 448) rope_item(p, it - 192);
    else conv_weights_item(p, 0, it - 448, lds);
  }
}

__device__ __forceinline__ void post_phase(const Params& p, int lprev, int lnext, unsigned char* lds, const bool dry) {
  const int tid = HTID, lane = tid & 63, w = tid >> 6;
  const float* mod = (const float*)(p.ws + OFF_MISC);
  const bf16_t* Y = nullptr;
  if (lprev >= 0) {
    const int kind = layer_info(p, lprev).kind;
    Y = (const bf16_t*)(p.ws + (kind == 1 ? 96 * MIB : 0));
  }
  bf16_t* hp = (bf16_t*)(p.ws + OFF_HP);
  bf16_t* hs = lnext < 4 ? hs_ptr(p, lnext) : nullptr;
  for (int row = VBID * 4 + w; row < 24576; row += VGDIM * 4) {
    const int mv = row < 8192 ? 0 : 1 + ((row - 8192) >> 11);
    const float* xs = (lprev <= 0) ? (row < 8192 ? p.in[0] + (size_t)row * 1024 : p.in[1] + (size_t)(row - 8192) * 1024) : p.out + (size_t)row * 1024;
    float4 x[4];
#pragma unroll
    for (int j = 0; j < 4; ++j) x[j] = *(const float4*)(xs + lane * 4 + 256 * j);
    if (lprev >= 0) {
      float4 y[4];
      float ss = 0.f;
#pragma unroll
      for (int j = 0; j < 4; ++j) { const uint2 yw = *(const uint2*)(Y + (size_t)row * 1024 + lane * 4 + 256 * j); y[j] = make_float4(lo_f(yw.x), hi_f(yw.x), lo_f(yw.y), hi_f(yw.y)); ss += y[j].x * y[j].x + y[j].y * y[j].y + y[j].z * y[j].z + y[j].w * y[j].w; }
      ss = wave_sum(ss);
      const float rstd = rsqrtf(ss * (1.f / 1024.f) + 1e-6f);
      const float* ga = mod + (size_t)(lprev * 9 + mv) * 3072 + 2048;
      const float* gp = p.in[11] + lprev * 1024;
#pragma unroll
      for (int j = 0; j < 4; ++j) {
        const int c = lane * 4 + 256 * j;
        const float4 g4 = *(const float4*)(ga + c), p4 = *(const float4*)(gp + c);
        x[j].x += g4.x * (y[j].x * rstd * p4.x); x[j].y += g4.y * (y[j].y * rstd * p4.y);
        x[j].z += g4.z * (y[j].z * rstd * p4.z); x[j].w += g4.w * (y[j].w * rstd * p4.w);
        if (!dry) *(float4*)(p.out + (size_t)row * 1024 + c) = x[j];
      }
    }
    if (lnext < 4) {
      float ss = 0.f;
#pragma unroll
      for (int j = 0; j < 4; ++j) ss += x[j].x * x[j].x + x[j].y * x[j].y + x[j].z * x[j].z + x[j].w * x[j].w;
      ss = wave_sum(ss);
      const float rstd = rsqrtf(ss * (1.f / 1024.f) + 1e-6f);
      const float* sh = mod + (size_t)(lnext * 9 + mv) * 3072;
      const float* sc = sh + 1024;
      const float* gp = p.in[10] + lnext * 1024;
      bf16_t* hd = row < 8192 ? hp + (size_t)row * 1024 : hs + (size_t)(row - 8192) * 1024;
#pragma unroll
      for (int j = 0; j < 4; ++j) {
        const int c = lane * 4 + 256 * j;
        const float4 s4 = *(const float4*)(sh + c), c4 = *(const float4*)(sc + c), p4 = *(const float4*)(gp + c);
        const float h0 = x[j].x * rstd * p4.x * (1.f + c4.x) + s4.x, h1 = x[j].y * rstd * p4.y * (1.f + c4.y) + s4.y;
        const float h2 = x[j].z * rstd * p4.z * (1.f + c4.z) + s4.z, h3 = x[j].w * rstd * p4.w * (1.f + c4.w) + s4.w;
        *(uint2*)(hd + c) = make_uint2(pack2(h0, h1), pack2(h2, h3));
      }
    }
  }
  if (lprev >= 0 && lnext < 4) {
    const int nw = conv_weights_count(p, lnext);
    for (int it = VBID; it < nw; it += VGDIM) conv_weights_item(p, lnext, it, lds);
  }
}


__device__ __forceinline__ unsigned xcc_id() { return (unsigned)__builtin_amdgcn_s_getreg((3 << 11) | 20) & 7u; }
#define LAS __attribute__((address_space(3)))
template <bool SWAP>
__device__ __forceinline__ void gemm_tile_compute(const bf16_t* __restrict__ Ag, const bf16_t* __restrict__ Bg, int K, unsigned char* lds, f32x4 (&acc)[8][4],
                                                  const bool pre, const bf16_t* __restrict__ An, const bf16_t* __restrict__ Bn, const bool hasn) {
  const int tid = threadIdx.x, lane = tid & 63, wid = __builtin_amdgcn_readfirstlane(tid >> 6), wm = wid >> 2, wn = wid & 3;
  const int lr = lane & 15, lg = lane >> 4;
  LAS unsigned char* l3 = (LAS unsigned char*)lds;
  const int prow = lane >> 3;
  const int pgo0 = prow * K + (((lane & 7) ^ ((prow >> 1) & 7)) << 3);
  const int pgo1 = prow * K + (((lane & 7) ^ ((4 + (prow >> 1)) & 7)) << 3);
  const bf16_t* asrc = Ag + (size_t)(wid * 32) * K;
  const bf16_t* bsrc = Bg + (size_t)(wid * 32) * K;
  const size_t pstep = (size_t)8 * K;
#pragma unroll
  for (int mi = 0; mi < 8; ++mi)
#pragma unroll
    for (int ni = 0; ni < 4; ++ni) acc[mi][ni] = (f32x4){0.f, 0.f, 0.f, 0.f};
#define GEMM_STAGE_P(ap_, bp_, s, k0)                                                                                                      \
  {                                                                                                                                        \
    _Pragma("unroll") for (int j = 0; j < 4; ++j) {                                                                                        \
      __builtin_amdgcn_global_load_lds((const unsigned*)((ap_) + j * pstep + ((j & 1) ? pgo1 : pgo0) + (k0)), (LAS unsigned*)(l3 + (s) * 65536 + (wid * 4 + j) * 1024), 16, 0, 0);          \
      __builtin_amdgcn_global_load_lds((const unsigned*)((bp_) + j * pstep + ((j & 1) ? pgo1 : pgo0) + (k0)), (LAS unsigned*)(l3 + (s) * 65536 + 32768 + (wid * 4 + j) * 1024), 16, 0, 0);  \
    }                                                                                                                                      \
  }
#define GEMM_STAGE(s, k0) GEMM_STAGE_P(asrc, bsrc, s, k0)
  const int nk = K >> 6;
  if (!pre) GEMM_STAGE(0, 0);
  asm volatile("s_waitcnt vmcnt(0)" ::: "memory");
  __syncthreads();
  const int x0 = lg ^ ((lr >> 1) & 7);
  const int aoff0 = (wm * 128 + lr) * 128 + x0 * 16, aoff1 = (wm * 128 + lr) * 128 + (x0 ^ 4) * 16;
  const int boff0 = 32768 + (wn * 64 + lr) * 128 + x0 * 16, boff1 = 32768 + (wn * 64 + lr) * 128 + (x0 ^ 4) * 16;
  for (int kt = 0; kt < nk; ++kt) {
    if (kt + 1 < nk) GEMM_STAGE((kt + 1) & 1, (kt + 1) * 64);
    const unsigned char* st = lds + (kt & 1) * 65536;
#pragma unroll
    for (int kk = 0; kk < 2; ++kk) {
      bf16x8 af[8], bfr[4];
#pragma unroll
      for (int ni = 0; ni < 4; ++ni) bfr[ni] = *(const bf16x8*)(st + (kk ? boff1 : boff0) + ni * 2048);
#pragma unroll
      for (int mi = 0; mi < 8; ++mi) af[mi] = *(const bf16x8*)(st + (kk ? aoff1 : aoff0) + mi * 2048);
#pragma unroll
      for (int mi = 0; mi < 8; ++mi)
#pragma unroll
        for (int ni = 0; ni < 4; ++ni)
          acc[mi][ni] = SWAP ? MFMA(bfr[ni], af[mi], acc[mi][ni]) : MFMA(af[mi], bfr[ni], acc[mi][ni]);
    }
    asm volatile("s_waitcnt vmcnt(0)" ::: "memory");
    __syncthreads();
  }
  if (hasn) { const bf16_t* an_ = An + (size_t)(wid * 32) * K; const bf16_t* bn_ = Bn + (size_t)(wid * 32) * K; GEMM_STAGE_P(an_, bn_, 0, 0); }
#undef GEMM_STAGE
#undef GEMM_STAGE_P
}

enum { GM_IN_DA = 0, GM_IN_RET_QKV = 1, GM_IN_RET_G = 2, GM_IN_HG = 3, GM_OUT = 4 };

__device__ __forceinline__ void epi_swapped(const Params& p, int mode, int slot, int ykind, int m, int n, f32x4 v) {
  bf16_t* R0 = (bf16_t*)p.ws;
  if (mode == GM_OUT) {
    bf16_t* Y = (bf16_t*)(p.ws + (ykind == 1 ? 96 * MIB : 0));
    *(uint2*)(Y + (size_t)m * 1024 + n) = make_uint2(pack2(v[0], v[1]), pack2(v[2], v[3]));
  } else if (mode == GM_IN_DA) {
    const bool smp = m >= 8192;
    const int ms = m - 8192;
    const int b = smp ? (ms >> 11) : (m >> 8), t = smp ? (ms & 2047) : (m & 255);
    if (n < 2048) {
      if (smp) {
        const float4 cs = *(const float4*)((const float*)(p.ws + OFF_MISC + MISC_ROPE) + (size_t)(t * 32 + ((n & 63) >> 1)) * 2);
        const float a0 = v[0] * cs.x - v[1] * cs.y, a1 = v[0] * cs.y + v[1] * cs.x;
        const float a2 = v[2] * cs.z - v[3] * cs.w, a3 = v[2] * cs.w + v[3] * cs.z;
        v = (f32x4){a0, a1, a2, a3};
      }
      if (n < 1024) {
        *(uint2*)(R0 + (size_t)m * 1024 + n) = make_uint2(pack2(v[0] * QSCALE, v[1] * QSCALE), pack2(v[2] * QSCALE, v[3] * QSCALE));
      } else {
        const int c = n - 1024;
        const uint2 pk = make_uint2(pack2(v[0], v[1]), pack2(v[2], v[3]));
        if (smp) {
          *(uint2*)(R0 + 64 * MIB / 2 + ((size_t)b * 2560 + t) * 1024 + c) = pk;
        } else {
          *(f32x4*)(p.out + OUT_CK + ((size_t)((b * 2 + slot) * 256 + t)) * 1024 + c) = v;
          *(uint2*)(R0 + 48 * MIB / 2 + (size_t)m * 1024 + c) = pk;
        }
      }
    } else {
      *(uint2*)(R0 + 160 * MIB / 2 + (size_t)m * 1024 + (n - 3072)) = make_uint2(pack2(silu_f(v[0]), silu_f(v[1])), pack2(silu_f(v[2]), silu_f(v[3])));
    }
  } else if (mode == GM_IN_RET_QKV) {
    if (n < 1024) *(uint2*)(R0 + (size_t)m * 1024 + n) = make_uint2(pack2(v[0], v[1]), pack2(v[2], v[3]));
    else if (n < 2048) { const float s = 0.08838834764831845f; *(uint2*)(R0 + PLANE_E + (size_t)m * 1024 + (n - 1024)) = make_uint2(pack2(v[0] * s, v[1] * s), pack2(v[2] * s, v[3] * s)); }
    else *(uint2*)(R0 + 2 * PLANE_E + (size_t)m * 2048 + (n - 2048)) = make_uint2(pack2(v[0], v[1]), pack2(v[2], v[3]));
  } else if (mode == GM_IN_RET_G) {
    *(uint2*)(R0 + (size_t)m * 2048 + n) = make_uint2(pack2(silu_f(v[0]), silu_f(v[1])), pack2(silu_f(v[2]), silu_f(v[3])));
  } else {
    if (n < 1024 || n >= 4096) v = (f32x4){silu_f(v[0]), silu_f(v[1]), silu_f(v[2]), silu_f(v[3])};
    else if (n < 3072) {
      const float4 lb = *(const float4*)((const float*)(p.ws + OFF_MISC + MISC_LB) + (n - 1024));
      v = (f32x4){__log2f(lb.x + (1.f - lb.x) / (1.f + __expf(-v[0]))), __log2f(lb.y + (1.f - lb.y) / (1.f + __expf(-v[1]))),
                  __log2f(lb.z + (1.f - lb.z) / (1.f + __expf(-v[2]))), __log2f(lb.w + (1.f - lb.w) / (1.f + __expf(-v[3])))};
    }
    *(uint2*)(R0 + (size_t)(n >> 10) * PLANE_E + (size_t)m * 1024 + (n & 1023)) = make_uint2(pack2(v[0], v[1]), pack2(v[2], v[3]));
  }
}

__device__ __forceinline__ void epi_da_v(const Params& p, int slot, int m, int n, f32x4 v) {
  bf16_t* R0 = (bf16_t*)p.ws;
  const int c = n - 2048, hh = c >> 7, e = c & 127;
  const uint2 pk = make_uint2(pack2(v[0], v[1]), pack2(v[2], v[3]));
  if (m >= 8192) {
    const int ms = m - 8192, b = ms >> 11, t = ms & 2047;
    *(uint2*)(R0 + 120 * MIB / 2 + ((size_t)((b * 8 + hh) * 128 + e)) * 2560 + t) = pk;
  } else {
    const int b = m >> 8, t = m & 255;
    float* o = p.out + OUT_CV + ((size_t)((b * 2 + slot) * 256 + t)) * 1024 + c;
    o[0] = v[0]; o[1024] = v[1]; o[2048] = v[2]; o[3072] = v[3];
    *(uint2*)(R0 + 104 * MIB / 2 + ((size_t)((b * 8 + hh) * 128 + e)) * 256 + t) = pk;
  }
}

__device__ __forceinline__ void gemm_phase(const Params& p, int l, int mode, unsigned char* lds, int phid) {
  const LayerInfo L = layer_info(p, l);
  bf16_t* R0 = (bf16_t*)p.ws;
  const bf16_t *Ap, *As, *Bt;
  int K, N;
  if (mode == GM_OUT) {
    K = L.WIDTH; N = 1024; Bt = (const bf16_t*)(p.ws + OFF_WOUT);
    const bf16_t* base = R0 + (L.kind == 0 ? 160 * MIB / 2 : (L.kind == 1 ? 4 * PLANE_E : 5 * PLANE_E));
    Ap = base; As = base + (size_t)8192 * K;
  } else {
    K = 1024; Ap = (const bf16_t*)(p.ws + OFF_HP); As = hs_ptr(p, l);
    Bt = (const bf16_t*)(p.ws + OFF_WIN) + (mode == GM_IN_RET_G ? (size_t)4096 * 1024 : 0);
    N = (mode == GM_IN_DA || mode == GM_IN_RET_QKV) ? 4096 : (mode == GM_IN_RET_G ? 2048 : 5120);
  }
  const int ntn = N >> 8, ntiles = 96 * ntn;
  const int extra = (mode == GM_IN_DA) ? 3072 : 0;
  const int tid = threadIdx.x, lane = tid & 63, wid = tid >> 6, wm = wid >> 2, wn = wid & 3, lr = lane & 15, lg = lane >> 4;
  const int G = gridDim.x;
  const bool swz = (G & 7) == 0;
  const int xcd = blockIdx.x & 7, snn = ntn >> 2, nst = 12 * snn;
  const int q0 = swz ? (int)(blockIdx.x >> 3) : (int)blockIdx.x, qstep = swz ? (G >> 3) : G;
  const int qlen = swz ? 32 * ((nst - xcd + 7) >> 3) : ntiles;
#define GEMM_TILE_OF(qq, m0_, n0_)                                                   \
  {                                                                                    \
    int it_ = (qq);                                                                    \
    if (swz) {                                                                         \
      const int st_ = xcd + 8 * ((qq) >> 5), tin_ = (qq) & 31;                         \
      const int smt_ = st_ / snn, snt_ = st_ - smt_ * snn;                             \
      it_ = (smt_ * 8 + (tin_ >> 2)) * ntn + snt_ * 4 + (tin_ & 3);                    \
    }                                                                                  \
    const int mt_ = it_ / ntn;                                                         \
    m0_ = mt_ * 256; n0_ = (it_ - mt_ * ntn) * 256;                                    \
  }
  bool pre = false;
  for (int q = q0; q < qlen; q += qstep) {
    int m0, n0;
    GEMM_TILE_OF(q, m0, n0)
    const bf16_t* A = m0 < 8192 ? Ap + (size_t)m0 * K : As + (size_t)(m0 - 8192) * K;
    const bf16_t* B = Bt + (size_t)n0 * K;
    const bool hasn = q + qstep < qlen;
    const bf16_t *An = A, *Bn = B;
    if (hasn) {
      int m1, n1;
      GEMM_TILE_OF(q + qstep, m1, n1)
      An = m1 < 8192 ? Ap + (size_t)m1 * K : As + (size_t)(m1 - 8192) * K;
      Bn = Bt + (size_t)n1 * K;
    }
    {
      f32x4 acc[8][4];
      if (mode == GM_IN_DA && n0 >= 2048 && n0 < 3072) {
        gemm_tile_compute<false>(A, B, K, lds, acc, pre, An, Bn, hasn);
#pragma unroll
        for (int mi = 0; mi < 8; ++mi)
#pragma unroll
          for (int ni = 0; ni < 4; ++ni)
            epi_da_v(p, L.slot, m0 + wm * 128 + mi * 16 + 4 * lg, n0 + wn * 64 + ni * 16 + lr, acc[mi][ni]);
      } else {
        gemm_tile_compute<true>(A, B, K, lds, acc, pre, An, Bn, hasn);
#pragma unroll
        for (int mi = 0; mi < 8; ++mi)
#pragma unroll
          for (int ni = 0; ni < 4; ++ni)
            epi_swapped(p, mode, L.slot, L.kind, m0 + wm * 128 + mi * 16 + lr, n0 + wn * 64 + ni * 16 + 4 * lg, acc[mi][ni]);
      }
    }
    pre = hasn;
  }
#undef GEMM_TILE_OF
  if (extra) { asm volatile("s_waitcnt vmcnt(0)" ::: "memory"); __syncthreads(); }
  for (int ci = VBID; ci < extra; ci += VGDIM) {
    {
      if (ci < 2048) {
        const int idx = (ci * 256 + HTID) * 8;
        const int b = idx >> 19, rem = idx & 524287, tp = rem >> 10, c = rem & 1023;
        const float* src = p.in[2] + ((size_t)((b * 2 + L.slot) * 512 + tp)) * 1024 + c;
        const float4 u0 = *(const float4*)src, u1 = *(const float4*)(src + 4);
        *(uint4*)(R0 + 64 * MIB / 2 + ((size_t)b * 2560 + 2048 + tp) * 1024 + c) = make_uint4(pack2(u0.x, u0.y), pack2(u0.z, u0.w), pack2(u1.x, u1.y), pack2(u1.z, u1.w));
      } else {
        const int i2 = ci - 2048;
        const int b = i2 >> 7, hh = (i2 >> 4) & 7, tt = (i2 >> 1) & 7, et = i2 & 1;
        convT_tile(p.in[3] + ((size_t)((b * 2 + L.slot) * 512 + tt * 64)) * 1024 + hh * 128 + et * 64, 1024,
                   R0 + 120 * MIB / 2 + ((size_t)((b * 8 + hh) * 128 + et * 64)) * 2560 + 2048 + tt * 64, 2560, lds + HALFID * HALF_LDS);
      }
    }
  }
}

__device__ __forceinline__ void attn_phase(const Params& p, int l, unsigned char* lds, const bool dry, int phid) {
  const int slot = l == 3 ? 1 : 0;
  const float lam_init = 0.8f - 0.6f * expf(-0.3f * (float)l);
  const int tid = threadIdx.x, lane = tid & 63, w = tid >> 6, lr = lane & 15, lg = lane >> 4;
  float lam;
  {
    const float* lf = p.in[14] + slot * 256;
    const float a = wave_sum(lf[lane] * lf[64 + lane]);
    const float b2 = wave_sum(lf[128 + lane] * lf[192 + lane]);
    lam = expf(a) - expf(b2) + lam_init;
  }
  bf16_t* R0 = (bf16_t*)p.ws;
  const float* subg = p.in[15] + slot * 128;
  for (int item = blockIdx.x; item < 1536; item += gridDim.x) {
    int grp, b, h, qt;
    if (item < 1024) { grp = 1; b = item >> 7; h = (item >> 4) & 7; qt = item & 15; }
    else { const int i2 = item - 1024; grp = 0; b = i2 >> 4; h = (i2 >> 1) & 7; qt = i2 & 1; }
    const int nkeys = grp ? 2560 : 256, ntile = nkeys >> 7;
    const int mq = (grp ? 8192 + b * 2048 : b * 256) + qt * 128 + w * 16 + lr;
    const bf16_t* Kg = grp ? R0 + 64 * MIB / 2 + (size_t)b * 2560 * 1024 + h * 128 : R0 + 48 * MIB / 2 + (size_t)b * 256 * 1024 + h * 128;
    const bf16_t* Vg = grp ? R0 + 120 * MIB / 2 + (size_t)(b * 8 + h) * 128 * 2560 : R0 + 104 * MIB / 2 + (size_t)(b * 8 + h) * 128 * 256;
    bf16x8 qf[2][2];
#pragma unroll
    for (int sub = 0; sub < 2; ++sub)
#pragma unroll
      for (int ks = 0; ks < 2; ++ks) qf[sub][ks] = *(const bf16x8*)(R0 + (size_t)mq * 1024 + h * 128 + sub * 64 + ks * 32 + lg * 8);
    LAS unsigned char* l3 = (LAS unsigned char*)lds;
    const int wu = __builtin_amdgcn_readfirstlane(w);
    int koff[4], voff[4];
#pragma unroll
    for (int j = 0; j < 4; ++j) {
      const int kr = (wu * 4 + j) * 4 + (lane >> 4);
      koff[j] = kr * 1024 + (((lane & 15) ^ (kr & 15)) << 3);
      voff[j] = kr * nkeys + (((lane & 15) ^ (kr & 15)) << 3);
    }
#define ATT_STAGE_K(s, key0)                                                                                  \
  {                                                                                                           \
    _Pragma("unroll") for (int j = 0; j < 4; ++j)                                                             \
      __builtin_amdgcn_global_load_lds((const unsigned*)(Kg + (size_t)(key0) * 1024 + koff[j]), (LAS unsigned*)(l3 + (s) * 65536 + (wu * 4 + j) * 1024), 16, 0, 0); \
  }
#define ATT_STAGE_V(s, key0)                                                                                  \
  {                                                                                                           \
    _Pragma("unroll") for (int j = 0; j < 4; ++j)                                                             \
      __builtin_amdgcn_global_load_lds((const unsigned*)(Vg + (key0) + voff[j]), (LAS unsigned*)(l3 + (s) * 65536 + 32768 + (wu * 4 + j) * 1024), 16, 0, 0); \
  }
    const int xl = lg ^ lr;
    const int vsw = (lr >> 1) & 7;
    const int vlo = lr * 256 + ((((lg >> 1)) ^ lr) << 4) + (lg & 1) * 8;
    float mx[2] = {-1e30f, -1e30f}, ls[2] = {0.f, 0.f};
    f32x4 o0[8], o1[8];
#pragma unroll
    for (int et = 0; et < 8; ++et) { o0[et] = (f32x4){0.f, 0.f, 0.f, 0.f}; o1[et] = (f32x4){0.f, 0.f, 0.f, 0.f}; }
    ATT_STAGE_K(0, 0);
    ATT_STAGE_V(0, 0);
    asm volatile("s_waitcnt vmcnt(0)" ::: "memory");
    __syncthreads();
    for (int kt = 0; kt < ntile; ++kt) {
      if (kt + 1 < ntile) { ATT_STAGE_K((kt + 1) & 1, (kt + 1) * 128); ATT_STAGE_V((kt + 1) & 1, (kt + 1) * 128); }
      const unsigned char* ks_ = lds + (kt & 1) * 65536 + lr * 256;
      const unsigned char* vs_ = lds + (kt & 1) * 65536 + 32768;
#pragma unroll
      for (int k2 = 0; k2 < 4; ++k2) {
        bf16x8 kfr[8];
        uint2 vlo_[8], vhi_[8];
#pragma unroll
        for (int sub = 0; sub < 2; ++sub)
#pragma unroll
          for (int nn = 0; nn < 2; ++nn)
#pragma unroll
            for (int ks = 0; ks < 2; ++ks)
              kfr[sub * 4 + nn * 2 + ks] = *(const bf16x8*)(ks_ + (2 * k2 + nn) * 4096 + ((xl ^ (sub * 8 + ks * 4)) << 4));
#pragma unroll
        for (int et = 0; et < 8; ++et) {
          vlo_[et] = *(const uint2*)(vs_ + et * 4096 + (vlo ^ (k2 << 6)));
          vhi_[et] = *(const uint2*)(vs_ + et * 4096 + (vlo ^ (k2 << 6) ^ 32));
        }
        SB;
        f32x4 s[2][2];
#pragma unroll
        for (int sub = 0; sub < 2; ++sub)
#pragma unroll
          for (int nn = 0; nn < 2; ++nn) {
            s[sub][nn] = MFMA(kfr[sub * 4 + nn * 2], qf[sub][0], ((f32x4){0.f, 0.f, 0.f, 0.f}));
            s[sub][nn] = MFMA(kfr[sub * 4 + nn * 2 + 1], qf[sub][1], s[sub][nn]);
          }
        SB;
        bf16x8 pf[2];
        float tmx[2];
#pragma unroll
        for (int sub = 0; sub < 2; ++sub) {
          float tm = fmaxf(fmaxf(fmaxf(s[sub][0][0], s[sub][0][1]), fmaxf(s[sub][0][2], s[sub][0][3])), fmaxf(fmaxf(s[sub][1][0], s[sub][1][1]), fmaxf(s[sub][1][2], s[sub][1][3])));
          tm = fmaxf(tm, __shfl_xor(tm, 16));
          tm = fmaxf(tm, __shfl_xor(tm, 32));
          tmx[sub] = tm;
        }
        if (__any((tmx[0] > mx[0] + 8.f) || (tmx[1] > mx[1] + 8.f))) {
#pragma unroll
          for (int sub = 0; sub < 2; ++sub) {
            const float mn = (tmx[sub] > mx[sub] + 8.f) ? tmx[sub] : mx[sub];
            const float sc = __builtin_amdgcn_exp2f(mx[sub] - mn);
            mx[sub] = mn;
            ls[sub] *= sc;
#pragma unroll
            for (int et = 0; et < 8; ++et) {
              if (sub == 0) { o0[et][0] *= sc; o0[et][1] *= sc; o0[et][2] *= sc; o0[et][3] *= sc; }
              else { o1[et][0] *= sc; o1[et][1] *= sc; o1[et][2] *= sc; o1[et][3] *= sc; }
            }
          }
        }
#pragma unroll
        for (int sub = 0; sub < 2; ++sub) {
          unsigned pw[4];
          float acc = 0.f;
#pragma unroll
          for (int nn = 0; nn < 2; ++nn) {
            float a[4];
#pragma unroll
            for (int r = 0; r < 4; ++r) { a[r] = __builtin_amdgcn_exp2f(s[sub][nn][r] - mx[sub]); acc += a[r]; }
            pw[nn * 2] = pack2(a[0], a[1]);
            pw[nn * 2 + 1] = pack2(a[2], a[3]);
          }
          ls[sub] += acc;
          union { unsigned u[4]; bf16x8 v; } cp;
          cp.u[0] = pw[0]; cp.u[1] = pw[1]; cp.u[2] = pw[2]; cp.u[3] = pw[3];
          pf[sub] = cp.v;
        }
        SB;
#pragma unroll
        for (int et = 0; et < 8; ++et) {
          union { unsigned u[4]; bf16x8 v; } cv;
          cv.u[0] = vlo_[et].x; cv.u[1] = vlo_[et].y; cv.u[2] = vhi_[et].x; cv.u[3] = vhi_[et].y;
          o0[et] = MFMA(cv.v, pf[0], o0[et]);
          o1[et] = MFMA(cv.v, pf[1], o1[et]);
        }
        SB;
      }
      asm volatile("s_waitcnt vmcnt(0)" ::: "memory");
      __syncthreads();
    }
    f32x4 o[8];
    {
      float t0 = ls[0], t1 = ls[1];
      t0 += __shfl_xor(t0, 16); t0 += __shfl_xor(t0, 32);
      t1 += __shfl_xor(t1, 16); t1 += __shfl_xor(t1, 32);
      const float c1 = 1.f / t0, c2 = lam / t1;
#pragma unroll
      for (int et = 0; et < 8; ++et)
#pragma unroll
        for (int r = 0; r < 4; ++r) o[et][r] = o0[et][r] * c1 - o1[et][r] * c2;
    }
#undef ATT_STAGE_K
#undef ATT_STAGE_V
    float ss = 0.f;
#pragma unroll
    for (int et = 0; et < 8; ++et)
#pragma unroll
      for (int r = 0; r < 4; ++r) ss += o[et][r] * o[et][r];
    ss += __shfl_xor(ss, 16);
    ss += __shfl_xor(ss, 32);
    const float rs = rsqrtf(ss * (1.f / 128.f) + 1e-6f) * (1.f - lam_init);
    bf16_t* gp = R0 + 160 * MIB / 2 + (size_t)mq * 1024 + h * 128;
#pragma unroll
    for (int et = 0; et < 8; ++et) {
      const int e0 = 16 * et + 4 * lg;
      const uint2 g = *(const uint2*)(gp + e0);
      const float4 sg = *(const float4*)(subg + e0);
      const float v0 = o[et][0] * rs * sg.x * lo_f(g.x), v1 = o[et][1] * rs * sg.y * hi_f(g.x);
      const float v2 = o[et][2] * rs * sg.z * lo_f(g.y), v3 = o[et][3] * rs * sg.w * hi_f(g.y);
      if (!dry) *(uint2*)(gp + e0) = make_uint2(pack2(v0, v1), pack2(v2, v3));
    }
  }
}

__device__ __forceinline__ bf16_t* hg_ob_row(const Params& p, int m) {
  const int c = m >> 9;
  float* base = c < 32 ? p.out + OUT_CK + (size_t)(c * 2 + 1) * 262144 : p.out + OUT_CV + (size_t)((c - 32) * 2 + 1) * 262144;
  return (bf16_t*)base + (size_t)(m & 511) * 1024;
}

__device__ __forceinline__ bf16_t* ret_ob_row(const Params& p, int ms) {
  const int c = ms >> 8;
  float* base = c < 32 ? p.out + OUT_CK + (size_t)(c * 2 + 1) * 262144 : p.out + OUT_CV + (size_t)((c - 32) * 2 + 1) * 262144;
  return (bf16_t*)base + (size_t)(ms & 255) * 2048;
}

template <int KIND, int DIR>
__device__ __forceinline__ void scan_item(const Params& p, int item, unsigned char* lds, const bool dry) {
  constexpr int DV = KIND == 1 ? 256 : 128, NSL = DV / 64, LDV = KIND == 1 ? 2048 : 1024;
  const int tid = HTID, lane = tid & 63, w = tid >> 6, lr = lane & 15, lg = lane >> 4;
  int grp, b, h, sl;
  {
    int it = item;
    if (it < 64 * NSL) grp = 1; else { grp = 0; it -= 64 * NSL; }
    sl = it % NSL; h = (it / NSL) & 7; b = it / (NSL * 8);
  }
  const int T = grp ? 2048 : 256, nch = T >> 6;
  const size_t mbase = grp ? (size_t)8192 + (size_t)b * 2048 : (size_t)b * 256;
  bf16_t* R0 = (bf16_t*)p.ws;
  const bf16_t* Qg = R0 + mbase * 1024 + h * 128;
  const bf16_t* Kg = R0 + (KIND == 1 ? PLANE_E : (DIR ? 2 * PLANE_E : PLANE_E)) + mbase * 1024 + h * 128;
  const bf16_t* Vg = R0 + (KIND == 1 ? 2 * PLANE_E : 3 * PLANE_E) + mbase * LDV + h * DV + sl * 64;
  bf16_t* Og = R0 + (KIND == 1 ? 4 * PLANE_E : 5 * PLANE_E) + mbase * LDV + h * DV + sl * 64;
  unsigned char* Qs = lds;
  unsigned char* X = lds + 17408;
  unsigned char* Vt = lds + 35840;
  unsigned char* StS = lds + 45056;
  unsigned char* Pm = lds + 62464;
  float* xch = (float*)(lds + 71680);
  float* blA = xch + 512;
  float* erA = xch + 640;
  const int dp = tid & 63, tq = tid >> 6, r0 = tq * 16, d0 = dp * 2;
  float cst0, cst1;
  if (KIND == 1) { cst0 = cst1 = log1pf(-expf(p.in[18][DIR * 8 + h])) * 1.4426950408889634f; }
  else {
    const float* lbp = p.in[21] + DIR * 4096 + h * 128 + d0;
    {
      const float x0 = lbp[0], x1 = lbp[1024], x2 = lbp[2048], x3 = lbp[3072];
      const float m = fmaxf(fmaxf(x0, x1), fmaxf(x2, x3));
      const float e0 = expf(x0 - m), e1 = expf(x1 - m), e2 = expf(x2 - m), e3 = expf(x3 - m);
      cst0 = (e1 + e2) / (e0 + e1 + e2 + e3);
    }
    {
      const float x0 = lbp[1], x1 = lbp[1025], x2 = lbp[2049], x3 = lbp[3073];
      const float m = fmaxf(fmaxf(x0, x1), fmaxf(x2, x3));
      const float e0 = expf(x0 - m), e1 = expf(x1 - m), e2 = expf(x2 - m), e3 = expf(x3 - m);
      cst1 = (e1 + e2) / (e0 + e1 + e2 + e3);
    }
  }
  f32x4 S[8];
  if (grp) {
    const float* s0 = (KIND == 1 ? p.in[4] : p.in[5]) + ((size_t)((b * 2 + DIR) * 8 + h) * 128) * DV + sl * 64 + 16 * w + lr + (size_t)(4 * lg) * DV;
    asm volatile("" : "+v"(s0));
#pragma unroll
    for (int dt = 0; dt < 8; ++dt)
#pragma unroll
      for (int r = 0; r < 4; ++r) S[dt][r] = s0[(16 * dt + r) * DV];
  } else {
#pragma unroll
    for (int dt = 0; dt < 8; ++dt) S[dt] = (f32x4){0.f, 0.f, 0.f, 0.f};
  }
  unsigned qv[16], kv[16], vv[8];
  const int ve2 = tid & 31, vq = tid >> 5;
  const int qoff = r0 * 512 + dp;
  const int voff = (8 * vq) * (LDV / 2) + ve2;
  const unsigned* Qg32 = (const unsigned*)Qg;
  const unsigned* Kg32 = (const unsigned*)Kg;
  const unsigned* Vg32 = (const unsigned*)Vg;
#define SCAN_ISSUE(c)                                                                                   \
  {                                                                                                     \
    const unsigned* q_ = Qg32 + (size_t)(c) * (64 * 512) + qoff;                                        \
    const unsigned* k_ = Kg32 + (size_t)(c) * (64 * 512) + qoff;                                        \
    const unsigned* v_ = Vg32 + (size_t)(c) * (64 * (LDV / 2)) + voff;                                  \
    asm volatile("" : "+v"(q_), "+v"(k_), "+v"(v_));                                                    \
    _Pragma("unroll") for (int i = 0; i < 16; ++i) { qv[i] = q_[i * 512]; kv[i] = k_[i * 512]; }        \
    _Pragma("unroll") for (int i = 0; i < 8; ++i) vv[i] = v_[i * (LDV / 2)];                            \
  }
  if (KIND == 1) {
    if (tid < 64) {
      const float ex = (DIR ? (float)(32 - tid) : (float)(tid - 31)) * cst0;
      *(float2*)(xch + 2 * tid) = make_float2(__builtin_amdgcn_exp2f(ex), __builtin_amdgcn_exp2f(-ex));
    }
    if (tid < 128) { blA[tid] = __builtin_amdgcn_exp2f(64.f * cst0); erA[tid] = __builtin_amdgcn_exp2f(32.f * cst0); }
    __syncthreads();
  }
  SCAN_ISSUE(DIR ? nch - 1 : 0);
  for (int ci = 0; ci < nch; ++ci) {
    const int c = DIR ? nch - 1 - ci : ci;
    unsigned ktp0[8], ktp1[8];
    if (KIND == 1) {
      const float cbr = __builtin_amdgcn_exp2f(32.f * cst0);
#pragma unroll
      for (int j = 0; j < 8; ++j) {
        float ka[2], kb[2];
#pragma unroll
        for (int hh = 0; hh < 2; ++hh) {
          const int i = 2 * j + hh;
          const float2 e = *(const float2*)(xch + 2 * (r0 + i));
          *(unsigned*)(Qs + (r0 + i) * 272 + d0 * 2) = pack2(lo_f(qv[i]) * e.x, hi_f(qv[i]) * e.x);
          const float kh0 = lo_f(kv[i]) * e.y, kh1 = hi_f(kv[i]) * e.y;
          *(unsigned*)(X + (r0 + i) * 272 + d0 * 2) = pack2(kh0, kh1);
          ka[hh] = kh0 * cbr;
          kb[hh] = kh1 * cbr;
        }
        ktp0[j] = pack2(ka[0], ka[1]);
        ktp1[j] = pack2(kb[0], kb[1]);
      }
    } else {
    float tot0 = 0.f, tot1 = 0.f;
#pragma unroll
    for (int i = 0; i < 16; ++i) { tot0 += lo_f(kv[i]); tot1 += hi_f(kv[i]); }
    *(float2*)(xch + tq * 128 + d0) = make_float2(tot0, tot1);
    __syncthreads();
    const float2 t0 = *(const float2*)(xch + d0), t1 = *(const float2*)(xch + 128 + d0), t2 = *(const float2*)(xch + 256 + d0), t3 = *(const float2*)(xch + 384 + d0);
    const float blast0 = (t0.x + t1.x) + (t2.x + t3.x), blast1 = (t0.y + t1.y) + (t2.y + t3.y);
    float ref0, ref1, run0, run1;
    if (DIR == 0) {
      ref0 = t0.x + t1.x; ref1 = t0.y + t1.y;
      run0 = (tq > 0 ? t0.x : 0.f) + (tq > 1 ? t1.x : 0.f) + (tq > 2 ? t2.x : 0.f);
      run1 = (tq > 0 ? t0.y : 0.f) + (tq > 1 ? t1.y : 0.f) + (tq > 2 ? t2.y : 0.f);
    } else {
      ref0 = t2.x + t3.x; ref1 = t2.y + t3.y;
      run0 = (tq < 3 ? t3.x : 0.f) + (tq < 2 ? t2.x : 0.f) + (tq < 1 ? t1.x : 0.f);
      run1 = (tq < 3 ? t3.y : 0.f) + (tq < 2 ? t2.y : 0.f) + (tq < 1 ? t1.y : 0.f);
    }
    const float cbr0 = __builtin_amdgcn_exp2f(blast0 - ref0), cbr1 = __builtin_amdgcn_exp2f(blast1 - ref1);
#pragma unroll
    for (int jj = 0; jj < 8; ++jj) {
      const int j = DIR ? 7 - jj : jj;
      float ka[2], kb[2];
#pragma unroll
      for (int hh = 0; hh < 2; ++hh) {
        const int i = 2 * j + (DIR ? 1 - hh : hh);
        const float g0 = lo_f(kv[i]), g1 = hi_f(kv[i]);
        const float k0 = 1.f - __builtin_amdgcn_exp2f(g0), k1 = 1.f - __builtin_amdgcn_exp2f(g1);
        run0 += g0; run1 += g1;
        *(unsigned*)(Qs + (r0 + i) * 272 + d0 * 2) = pack2(lo_f(qv[i]) * __builtin_amdgcn_exp2f(run0 - ref0), hi_f(qv[i]) * __builtin_amdgcn_exp2f(run1 - ref1));
        const float kh0 = k0 * __builtin_amdgcn_exp2f(ref0 - run0), kh1 = k1 * __builtin_amdgcn_exp2f(ref1 - run1);
        *(unsigned*)(X + (r0 + i) * 272 + d0 * 2) = pack2(kh0, kh1);
        ka[i & 1] = kh0 * cbr0;
        kb[i & 1] = kh1 * cbr1;
      }
      ktp0[j] = pack2(ka[0], ka[1]);
      ktp1[j] = pack2(kb[0], kb[1]);
    }
    if (tq == 0) { *(float2*)(blA + d0) = make_float2(__builtin_amdgcn_exp2f(blast0), __builtin_amdgcn_exp2f(blast1)); *(float2*)(erA + d0) = make_float2(__builtin_amdgcn_exp2f(ref0), __builtin_amdgcn_exp2f(ref1)); }
    }
    {
      const unsigned a0 = (vv[0] & 0xffffu) | (vv[1] << 16), a1 = (vv[2] & 0xffffu) | (vv[3] << 16), a2 = (vv[4] & 0xffffu) | (vv[5] << 16), a3 = (vv[6] & 0xffffu) | (vv[7] << 16);
      const unsigned b0 = (vv[0] >> 16) | (vv[1] & 0xffff0000u), b1 = (vv[2] >> 16) | (vv[3] & 0xffff0000u), b2 = (vv[4] >> 16) | (vv[5] & 0xffff0000u), b3 = (vv[6] >> 16) | (vv[7] & 0xffff0000u);
      *(uint4*)(Vt + (2 * ve2) * 144 + vq * 16) = make_uint4(a0, a1, a2, a3);
      *(uint4*)(Vt + (2 * ve2 + 1) * 144 + vq * 16) = make_uint4(b0, b1, b2, b3);
    }
    if (ci + 1 < nch) { SCAN_ISSUE(DIR ? c - 1 : c + 1); }
    __syncthreads();
#pragma unroll
    for (int dt = 0; dt < 8; ++dt) {
      const float4 er4 = *(const float4*)(erA + 16 * dt + 4 * lg);
      *(uint2*)(StS + (16 * w + lr) * 272 + (16 * dt + 4 * lg) * 2) = make_uint2(pack2(S[dt][0] * er4.x, S[dt][1] * er4.y), pack2(S[dt][2] * er4.z, S[dt][3] * er4.w));
    }
    bf16x8 qf[4];
#pragma unroll
    for (int ks = 0; ks < 4; ++ks) qf[ks] = *(const bf16x8*)(Qs + (16 * w + lr) * 272 + ks * 64 + lg * 16);
    uint2 pv[4];
    {
      const int t = 16 * w + lr;
#pragma unroll
      for (int st = 0; st < 4; ++st) {
        f32x4 s = (f32x4){0.f, 0.f, 0.f, 0.f};
#pragma unroll
        for (int ks = 0; ks < 4; ++ks) {
          const bf16x8 kf = *(const bf16x8*)(X + (16 * st + lr) * 272 + ks * 64 + lg * 16);
          s = MFMA(kf, qf[ks], s);
        }
        float v[4];
#pragma unroll
        for (int r = 0; r < 4; ++r) {
          const int si = 16 * st + 4 * lg + r;
          const bool keep = DIR ? (t <= si) : (t >= si);
          v[r] = keep ? s[r] : 0.f;
        }
        pv[st] = make_uint2(pack2(v[0], v[1]), pack2(v[2], v[3]));
      }
    }
    __syncthreads();
#pragma unroll
    for (int st = 0; st < 4; ++st) *(uint2*)(Pm + (16 * w + lr) * 144 + (16 * st + 4 * lg) * 2) = pv[st];
    *(uint4*)(X + d0 * 144 + r0 * 2) = make_uint4(ktp0[0], ktp0[1], ktp0[2], ktp0[3]);
    *(uint4*)(X + d0 * 144 + r0 * 2 + 16) = make_uint4(ktp0[4], ktp0[5], ktp0[6], ktp0[7]);
    *(uint4*)(X + (d0 + 1) * 144 + r0 * 2) = make_uint4(ktp1[0], ktp1[1], ktp1[2], ktp1[3]);
    *(uint4*)(X + (d0 + 1) * 144 + r0 * 2 + 16) = make_uint4(ktp1[4], ktp1[5], ktp1[6], ktp1[7]);
    __syncthreads();
    {
      bf16x8 pf[2];
#pragma unroll
      for (int ks = 0; ks < 2; ++ks) pf[ks] = *(const bf16x8*)(Pm + (16 * w + lr) * 144 + ks * 64 + lg * 16);
      const bool sep = DIR && (KIND == 2 || grp);
      bf16_t* orow = (KIND == 2 && DIR) ? hg_ob_row(p, (int)mbase + c * 64 + 16 * w + lr) + h * DV + sl * 64 + 4 * lg
                   : (KIND == 1 && DIR && grp) ? ret_ob_row(p, b * 2048 + c * 64 + 16 * w + lr) + h * DV + sl * 64 + 4 * lg
                                               : Og + (size_t)(c * 64 + 16 * w + lr) * LDV + 4 * lg;
#pragma unroll
      for (int et = 0; et < 4; ++et) {
        f32x4 o = (f32x4){0.f, 0.f, 0.f, 0.f};
#pragma unroll
        for (int ks = 0; ks < 2; ++ks) {
          const bf16x8 vf = *(const bf16x8*)(Vt + (16 * et + lr) * 144 + ks * 64 + lg * 16);
          o = MFMA(vf, pf[ks], o);
        }
#pragma unroll
        for (int ks = 0; ks < 4; ++ks) {
          const bf16x8 sf = *(const bf16x8*)(StS + (16 * et + lr) * 272 + ks * 64 + lg * 16);
          o = MFMA(sf, qf[ks], o);
        }
        bf16_t* op = orow + 16 * et;
        if (DIR && !sep) {
          const uint2 old = *(const uint2*)op;
          o[0] += lo_f(old.x); o[1] += hi_f(old.x); o[2] += lo_f(old.y); o[3] += hi_f(old.y);
        }
        if (!(DIR && !sep && dry)) *(uint2*)op = make_uint2(pack2(o[0], o[1]), pack2(o[2], o[3]));
      }
    }
    {
      bf16x8 vtf[2];
#pragma unroll
      for (int ks = 0; ks < 2; ++ks) vtf[ks] = *(const bf16x8*)(Vt + (16 * w + lr) * 144 + ks * 64 + lg * 16);
#pragma unroll
      for (int dt = 0; dt < 8; ++dt) {
        const float4 bl4 = *(const float4*)(blA + 16 * dt + 4 * lg);
        S[dt][0] *= bl4.x; S[dt][1] *= bl4.y; S[dt][2] *= bl4.z; S[dt][3] *= bl4.w;
#pragma unroll
        for (int ks = 0; ks < 2; ++ks) {
          const bf16x8 kf = *(const bf16x8*)(X + (16 * dt + lr) * 144 + ks * 64 + lg * 16);
          S[dt] = MFMA(kf, vtf[ks], S[dt]);
        }
      }
    }
    __syncthreads();
  }
#undef SCAN_ISSUE
  if (!grp) {
    float* so = p.out + (KIND == 1 ? OUT_SR : OUT_SH) + ((size_t)((b * 2 + DIR) * 8 + h) * 128) * DV + sl * 64 + 16 * w + lr + (size_t)(4 * lg) * DV;
    asm volatile("" : "+v"(so));
#pragma unroll
    for (int dt = 0; dt < 8; ++dt)
#pragma unroll
      for (int r = 0; r < 4; ++r) so[(16 * dt + r) * DV] = S[dt][r];
  }
}

template <int KIND, int DIR>
__device__ __forceinline__ void scan_phase(const Params& p, unsigned char* lds, const bool dry) {
  constexpr int NSL = (KIND == 1 ? 256 : 128) / 64;
  const int ns = 64 * NSL, npr = 256 * NSL;
  const int G = VGDIM, bid = VBID;
  int it, step, end = ns + npr;
  if (G > ns) {
    if (bid < ns) { it = bid; step = end; }
    else { it = ns + (bid - ns); step = G - ns; }
  } else { it = bid; step = G; }
  for (; it < end; it += step) scan_item<KIND, DIR>(p, it, lds, dry);
}

__device__ __forceinline__ void scan_phase_ret_sample(const Params& p, unsigned char* lds, const bool dry) {
  const int G = VGDIM >> 1, bid = VBID;
  const int role = bid >= G;
  const int rb = role ? bid - G : bid;
  if (role == 0) { for (int it = rb; it < 256; it += G) scan_item<1, 0>(p, it, lds, dry); }
  else           { for (int it = rb; it < 256; it += G) scan_item<1, 1>(p, it, lds, dry); }
}
template <int DIR>
__device__ __forceinline__ void scan_phase_ret_prompt(const Params& p, unsigned char* lds, const bool dry) {
  for (int it = VBID; it < 1024; it += VGDIM) scan_item<1, DIR>(p, 256 + it, lds, dry);
}

__device__ __forceinline__ void scan_phase_hg_both(const Params& p, unsigned char* lds, const bool dry) {
  const int G = VGDIM >> 1, bid = VBID;
  const int role = bid >= G;
  const int rb = role ? bid - G : bid;
  int it, step;
  if (G > 128) {
    if (rb < 128) { it = rb; step = 1 << 20; } else { it = rb; step = G - 128; }
  } else { it = rb; step = G; }
  if (role == 0) { for (; it < 640; it += step) scan_item<2, 0>(p, it, lds, dry); }
  else           { for (; it < 640; it += step) scan_item<2, 1>(p, it, lds, dry); }
}

template <int KIND>
__device__ __forceinline__ void normgate_phase(const Params& p, const bool dry) {
  constexpr int NCH = KIND == 1 ? 4 : 2, DV = KIND == 1 ? 256 : 128, LD = KIND == 1 ? 2048 : 1024;
  const int tid = HTID, lane = tid & 63, w = tid >> 6;
  const int hh = lane >> 3, sub = lane & 7;
  bf16_t* R0 = (bf16_t*)p.ws;
  bf16_t* Ob = R0 + (KIND == 1 ? 4 * PLANE_E : 5 * PLANE_E) + hh * DV + sub * 8;
  const bf16_t* Gb = R0 + (KIND == 1 ? 0 : 4 * PLANE_E) + hh * DV + sub * 8;
  float gn[NCH][8];
#pragma unroll
  for (int j = 0; j < NCH; ++j)
#pragma unroll
    for (int i = 0; i < 8; ++i) gn[j][i] = (KIND == 1) ? 1.f : p.in[22][j * 64 + sub * 8 + i];
  for (int row = VBID * 4 + w; row < 24576; row += VGDIM * 4) {
    bf16_t* op = Ob + (size_t)row * LD;
    const bf16_t* gp = Gb + (size_t)row * LD;
    uint4 ov[NCH], gv[NCH];
#pragma unroll
    for (int j = 0; j < NCH; ++j) { ov[j] = *(const uint4*)(op + j * 64); gv[j] = *(const uint4*)(gp + j * 64); }
    if (KIND == 2 || row >= 8192) {
      const bf16_t* bp = (KIND == 2 ? hg_ob_row(p, row) : ret_ob_row(p, row - 8192)) + hh * DV + sub * 8;
#pragma unroll
      for (int j = 0; j < NCH; ++j) {
        const uint4 bv = *(const uint4*)(bp + j * 64);
        ov[j].x = pack2(lo_f(ov[j].x) + lo_f(bv.x), hi_f(ov[j].x) + hi_f(bv.x));
        ov[j].y = pack2(lo_f(ov[j].y) + lo_f(bv.y), hi_f(ov[j].y) + hi_f(bv.y));
        ov[j].z = pack2(lo_f(ov[j].z) + lo_f(bv.z), hi_f(ov[j].z) + hi_f(bv.z));
        ov[j].w = pack2(lo_f(ov[j].w) + lo_f(bv.w), hi_f(ov[j].w) + hi_f(bv.w));
      }
    }
    float ss = 0.f;
#pragma unroll
    for (int j = 0; j < NCH; ++j) {
      const unsigned wv[4] = {ov[j].x, ov[j].y, ov[j].z, ov[j].w};
#pragma unroll
      for (int i = 0; i < 4; ++i) { const float a = lo_f(wv[i]), b2 = hi_f(wv[i]); ss += a * a + b2 * b2; }
    }
    ss += __shfl_xor(ss, 1);
    ss += __shfl_xor(ss, 2);
    ss += __shfl_xor(ss, 4);
    const float rs = rsqrtf(ss * (1.f / (float)DV) + 1e-6f);
#pragma unroll
    for (int j = 0; j < NCH; ++j) {
      const unsigned wv[4] = {ov[j].x, ov[j].y, ov[j].z, ov[j].w};
      const unsigned gw[4] = {gv[j].x, gv[j].y, gv[j].z, gv[j].w};
      unsigned r[4];
#pragma unroll
      for (int i = 0; i < 4; ++i)
        r[i] = pack2(lo_f(wv[i]) * rs * gn[j][2 * i] * lo_f(gw[i]), hi_f(wv[i]) * rs * gn[j][2 * i + 1] * hi_f(gw[i]));
      if (!dry) *(uint4*)(op + j * 64) = make_uint4(r[0], r[1], r[2], r[3]);
    }
  }
}

__device__ __forceinline__ void opaque_params(Params& q) {
  asm volatile("" : "+s"(q.out), "+s"(q.ws));
#pragma unroll
  for (int i = 0; i < 23; ++i) asm volatile("" : "+s"(q.in[i]));
}

struct BarState { unsigned* base; unsigned xcd, mycnt, nact, esub, etop; };
__device__ __forceinline__ void grid_barrier(BarState& b) {
  asm volatile("s_waitcnt vmcnt(0) lgkmcnt(0)" ::: "memory");
  __syncthreads();
  if (threadIdx.x == 0) {
    b.esub += b.mycnt; b.etop += b.nact;
    const unsigned old = __hip_atomic_fetch_add(b.base + 64 * b.xcd, 1u, __ATOMIC_RELAXED, __HIP_MEMORY_SCOPE_AGENT);
    if (old + 1u == b.esub) {
      __builtin_amdgcn_fence(__ATOMIC_RELEASE, "agent");
      __hip_atomic_fetch_add(b.base + 512, 1u, __ATOMIC_RELAXED, __HIP_MEMORY_SCOPE_AGENT);
    }
    while (__hip_atomic_load(b.base + 512, __ATOMIC_RELAXED, __HIP_MEMORY_SCOPE_AGENT) < b.etop) __builtin_amdgcn_s_sleep(1);
    __builtin_amdgcn_fence(__ATOMIC_ACQUIRE, "agent");
  }
  __syncthreads();
}
__device__ __forceinline__ void bar_census_post(BarState& b) {
  if (threadIdx.x == 0) __hip_atomic_fetch_add(b.base + 1024 + 64 * b.xcd, 1u, __ATOMIC_RELAXED, __HIP_MEMORY_SCOPE_AGENT);
}
__device__ __forceinline__ void bar_census_read(BarState& b) {
  if (threadIdx.x == 0) {
    unsigned n = 0;
    for (unsigned j = 0; j < 8; ++j) {
      const unsigned c = __hip_atomic_load(b.base + 1024 + 64 * j, __ATOMIC_RELAXED, __HIP_MEMORY_SCOPE_AGENT);
      n += (c != 0u);
      if (j == b.xcd) b.mycnt = c;
    }
    b.nact = n;
  }
}
#define GSYNC(n) { if ((n) == 0) { grid.sync(); bar_census_read(bst); } else grid_barrier(bst); }

#if defined(PH_ONLY)
#define PHASE(n, call) if (n == PH_ONLY) { const bool dry = false; call; }
#elif defined(REP_N)
#define PHASE(n, call) if (lo <= n && n < hi) { for (int rep = (n == REP_N ? 0 : 1); rep < 2; ++rep) { const bool dry = (rep == 0); call; if (!(fin && n + 1 == hi && rep == 1)) GSYNC(n) } }
#else
#define PHASE(n, call) if (lo <= n && n < hi) { const bool dry = false; call; if (!(fin && n + 1 == hi)) GSYNC(n) }
#endif

__device__ __forceinline__ void run_range(const Params& q, int lo, int hi, bool fin, cg::grid_group& grid, unsigned char* lds) {
  unsigned char* ldh = lds + HALFID * HALF_LDS;
  BarState bst; bst.base = (unsigned*)(q.ws + OFF_MISC + MISC_CTR); bst.xcd = xcc_id(); bst.mycnt = 0; bst.nact = 0; bst.esub = 0; bst.etop = 0;
  if (lo == 0) bar_census_post(bst);
  PHASE(0, phase0(q, ldh))
  PHASE(1, post_phase(q, -1, 0, ldh, dry))
  PHASE(2, gemm_phase(q, 0, GM_IN_DA, lds, 2))
  PHASE(3, attn_phase(q, 0, lds, dry, 3))
  PHASE(4, gemm_phase(q, 0, GM_OUT, lds, 4))
  PHASE(5, post_phase(q, 0, 1, ldh, dry))
  PHASE(6, gemm_phase(q, 1, GM_IN_RET_QKV, lds, 6))
  PHASE(7, scan_phase_ret_sample(q, ldh, dry))
  PHASE(8, scan_phase_ret_prompt<0>(q, ldh, dry))
  PHASE(8, scan_phase_ret_prompt<1>(q, ldh, dry))
  PHASE(9, gemm_phase(q, 1, GM_IN_RET_G, lds, 9))
  PHASE(10, normgate_phase<1>(q, dry))
  PHASE(11, gemm_phase(q, 1, GM_OUT, lds, 11))
  PHASE(12, post_phase(q, 1, 2, ldh, dry))
  PHASE(13, gemm_phase(q, 2, GM_IN_HG, lds, 13))
  PHASE(14, scan_phase_hg_both(q, ldh, dry))
  PHASE(16, normgate_phase<2>(q, dry))
  PHASE(17, gemm_phase(q, 2, GM_OUT, lds, 17))
  PHASE(18, post_phase(q, 2, 3, ldh, dry))
  PHASE(19, gemm_phase(q, 3, GM_IN_DA, lds, 19))
  PHASE(20, attn_phase(q, 3, lds, dry, 20))
  PHASE(21, gemm_phase(q, 3, GM_OUT, lds, 21))
  PHASE(22, post_phase(q, 3, 4, ldh, dry))
}

__global__ void __launch_bounds__(NTHR, 2) mega_fwd(Params p) {
  extern __shared__ __attribute__((aligned(16))) unsigned char lds[];
  cg::grid_group grid = cg::this_grid();
  run_range(p, p.ph_lo, p.ph_hi, true, grid, lds);
}

extern "C" void kernel_launch(void* const* d_in, const int* in_sizes, int n_in, void* d_out, int out_size, void* d_ws, size_t ws_size, hipStream_t stream) {
  static int grid_blocks = 0;
  if (grid_blocks == 0) {
    int dev = 0, cus = 0, per_cu = 0;
    hipGetDevice(&dev);
    hipDeviceGetAttribute(&cus, hipDeviceAttributeMultiprocessorCount, dev);
    hipFuncSetAttribute((const void*)mega_fwd, hipFuncAttributeMaxDynamicSharedMemorySize, LDS_BYTES);
    hipOccupancyMaxActiveBlocksPerMultiprocessor(&per_cu, (const void*)mega_fwd, NTHR, LDS_BYTES);
    if (per_cu < 1) per_cu = 1;
    if (per_cu > 1) per_cu = 1;
    if (cus < 1) cus = 256;
    grid_blocks = cus * per_cu;
    (void)hipGetLastError();
    if (n_in != 23 || ws_size < WS_NEED) { fprintf(stderr, "kernel_launch: unexpected n_in %d / ws_size %zu (need %zu)\n", n_in, ws_size, (size_t)WS_NEED); }
  }
  hipMemsetAsync((unsigned char*)d_ws + OFF_MISC + MISC_CTR, 0, 8192, stream);
  Params p{};
  for (int i = 0; i < 23; ++i) p.in[i] = (const float*)d_in[i];
  p.out = (float*)d_out;
  p.ws = (unsigned char*)d_ws;
#if ONE_LAUNCH
  p.ph_lo = 0; p.ph_hi = NPH;
  void* args[] = {&p};
  hipError_t e = hipLaunchCooperativeKernel((const void*)mega_fwd, dim3(grid_blocks), dim3(NTHR), args, LDS_BYTES, stream);
  if (e != hipSuccess) fprintf(stderr, "cooperative launch failed: %s (grid %d)\n", hipGetErrorString(e), grid_blocks);
#else
  for (int ph = 0; ph < NPH; ++ph) {
    p.ph_lo = ph; p.ph_hi = ph + 1;
    hipLaunchKernelGGL(mega_fwd, dim3(grid_blocks), dim3(NTHR), LDS_BYTES, stream, p);
  }
#endif
}
```

```cpp
#include <hip/hip_runtime.h>
#include <hip/hip_cooperative_groups.h>
#include <cstdint>
#include <cstdio>
namespace cg = cooperative_groups;

#ifndef ONE_LAUNCH
#define ONE_LAUNCH 1
#endif

typedef unsigned short bf16_t;
typedef short bf16x8 __attribute__((ext_vector_type(8)));
typedef float f32x4 __attribute__((ext_vector_type(4)));

#define NTHR 512
#define HTID ((int)(threadIdx.x & 255))
#define HALFID ((int)(threadIdx.x >> 8))
#define VBID ((int)(blockIdx.x * 2 + (threadIdx.x >> 8)))
#define VGDIM ((int)(gridDim.x * 2))
#define HALF_LDS 74816
#define MIB ((size_t)1 << 20)
#define NPH 23
#define LDS_BYTES (2 * HALF_LDS)
#define LDS_SLOT 74752
#define MISC_LB (MISC_ROPE + 524288 + 16384)
#define MISC_CTR (MISC_ROPE + 524288)

#define OFF_WIN  (288 * MIB)
#define OFF_WOUT (300 * MIB)
#define OFF_HP   (304 * MIB)
#define OFF_MISC (320 * MIB)
#define MISC_ROPE 524288
#define WS_NEED  (322 * MIB)
#define PLANE_E  ((size_t)25165824)
#define OUT_YP 0
#define OUT_YS 8388608
#define OUT_CK 25165824
#define OUT_CV 41943040
#define OUT_SR 58720256
#define OUT_SH 75497472

struct Params {
  const float* in[23];
  float* out;
  unsigned char* ws;
  int ph_lo, ph_hi;
};

struct LayerInfo { int kind, slot, IN, WIDTH; const float* w_in; const float* w_out; };

__device__ __forceinline__ LayerInfo layer_info(const Params& p, int l) {
  LayerInfo L;
  if (l == 0)      { L.kind = 0; L.slot = 0; L.IN = 4096; L.WIDTH = 1024; L.w_in = p.in[12]; L.w_out = p.in[13]; }
  else if (l == 1) { L.kind = 1; L.slot = 0; L.IN = 6144; L.WIDTH = 2048; L.w_in = p.in[16]; L.w_out = p.in[17]; }
  else if (l == 2) { L.kind = 2; L.slot = 0; L.IN = 5120; L.WIDTH = 1024; L.w_in = p.in[19]; L.w_out = p.in[20]; }
  else             { L.kind = 0; L.slot = 1; L.IN = 4096; L.WIDTH = 1024; L.w_in = p.in[12] + (size_t)1024 * 4096; L.w_out = p.in[13] + (size_t)1024 * 1024; }
  return L;
}
__device__ __forceinline__ bf16_t* hs_ptr(const Params& p, int l) {
  return l < 3 ? (bf16_t*)(p.out + OUT_SH) : (bf16_t*)(p.ws + 240 * MIB);
}

typedef __bf16 nbf16x2 __attribute__((ext_vector_type(2)));
typedef float f32x2 __attribute__((ext_vector_type(2)));
__device__ __forceinline__ float bf2f(unsigned h) { return __uint_as_float(h << 16); }
__device__ __forceinline__ unsigned pack2(float a, float b) { const f32x2 f = {a, b}; return __builtin_bit_cast(unsigned, __builtin_convertvector(f, nbf16x2)); }
__device__ __forceinline__ float lo_f(unsigned w) { return __uint_as_float(w << 16); }
__device__ __forceinline__ float hi_f(unsigned w) { return __uint_as_float(w & 0xffff0000u); }
__device__ __forceinline__ float silu_f(float x) { return x / (1.f + __expf(-x)); }
__device__ __forceinline__ float wave_sum(float v) {
#pragma unroll
  for (int o = 32; o > 0; o >>= 1) v += __shfl_xor(v, o);
  return v;
}
#define QSCALE 0.18033688011112042f
#define SB __builtin_amdgcn_sched_barrier(0)
#define MFMA(a, b, c) __builtin_amdgcn_mfma_f32_16x16x32_bf16((a), (b), (c), 0, 0, 0)

__device__ __forceinline__ void convT_tile(const float* __restrict__ src, int src_ld, bf16_t* __restrict__ dst, int dst_ld, unsigned char* lds) {
  float* t = (float*)lds;
  const int tid = HTID;
  const int kr = tid >> 4, nc = (tid & 15) * 4;
#pragma unroll
  for (int j = 0; j < 4; ++j) {
    const float4 v = *(const float4*)(src + (size_t)(kr + 16 * j) * src_ld + nc);
    float* tp = t + (kr + 16 * j) * 65 + nc;
    tp[0] = v.x; tp[1] = v.y; tp[2] = v.z; tp[3] = v.w;
  }
  __syncthreads();
  const int n = tid >> 2, kc = (tid & 3) * 16;
  unsigned w[8];
#pragma unroll
  for (int i = 0; i < 8; ++i) w[i] = pack2(t[(kc + 2 * i) * 65 + n], t[(kc + 2 * i + 1) * 65 + n]);
  uint4* d = (uint4*)(dst + (size_t)n * dst_ld + kc);
  d[0] = make_uint4(w[0], w[1], w[2], w[3]);
  d[1] = make_uint4(w[4], w[5], w[6], w[7]);
  __syncthreads();
}

__device__ __forceinline__ int conv_weights_count(const Params& p, int l) {
  const LayerInfo L = layer_info(p, l);
  return (L.IN / 64) * 16 + (L.WIDTH / 64) * 16;
}
__device__ __forceinline__ void conv_weights_item(const Params& p, int l, int it, unsigned char* lds) {
  const LayerInfo L = layer_info(p, l);
  const int nin = (L.IN / 64) * 16;
  if (it < nin) {
    const int kt = it & 15, nt = it >> 4;
    convT_tile(L.w_in + (size_t)(kt * 64) * L.IN + nt * 64, L.IN, (bf16_t*)(p.ws + OFF_WIN) + (size_t)(nt * 64) * 1024 + kt * 64, 1024, lds);
  } else {
    const int it2 = it - nin, nkt = L.WIDTH / 64;
    const int kt = it2 % nkt, nt = it2 / nkt;
    convT_tile(L.w_out + (size_t)(kt * 64) * 1024 + nt * 64, 1024, (bf16_t*)(p.ws + OFF_WOUT) + (size_t)(nt * 64) * L.WIDTH + kt * 64, L.WIDTH, lds);
  }
}

__device__ __forceinline__ void mod_item(const Params& p, int it, unsigned char* lds) {
  float* ssilu = (float*)lds;
  float* red = ssilu + 9 * 1024;
  const int tid = HTID;
  const int l = it / 48, col0 = (it % 48) * 64;
  for (int i = tid; i < 9 * 1024; i += 256) {
    const int v = i >> 10, k = i & 1023;
    const float x = (v == 0) ? p.in[7][k] : p.in[6][(v - 1) * 1024 + k];
    ssilu[i] = silu_f(x);
  }
  __syncthreads();
  const int col = tid & 63, kq = tid >> 6;
  const float* w = p.in[8] + (size_t)l * 1024 * 3072 + col0 + col;
  float acc[9];
#pragma unroll
  for (int v = 0; v < 9; ++v) acc[v] = 0.f;
  for (int k = kq * 256; k < kq * 256 + 256; ++k) {
    const float wv = w[(size_t)k * 3072];
#pragma unroll
    for (int v = 0; v < 9; ++v) acc[v] += ssilu[v * 1024 + k] * wv;
  }
#pragma unroll
  for (int v = 0; v < 9; ++v) red[(kq * 9 + v) * 64 + col] = acc[v];
  __syncthreads();
  float* mod = (float*)(p.ws + OFF_MISC);
  for (int i = tid; i < 9 * 64; i += 256) {
    const int v = i >> 6, cc = i & 63;
    const float s = red[(0 * 9 + v) * 64 + cc] + red[(1 * 9 + v) * 64 + cc] + red[(2 * 9 + v) * 64 + cc] + red[(3 * 9 + v) * 64 + cc];
    mod[(size_t)(l * 9 + v) * 3072 + col0 + cc] = s + p.in[9][l * 3072 + col0 + cc];
  }
  __syncthreads();
}

__device__ __forceinline__ void rope_item(const Params& p, int it) {
  const int idx = it * 256 + HTID;
  const int t = idx >> 5, pp = idx & 31;
  const int pos = pp < 16 ? (t >> 6) : (t & 63);
  const float inv = exp2f(-(float)(pp & 15) * (13.287712379549449f / 16.f));
  const float ang = (float)pos * inv;
  const double a = (double)ang;
  const double r = a - 6.283185307179586 * rint(a * 0.15915494309189535);
  const float rf = (float)r;
  float2* tab = (float2*)(p.ws + OFF_MISC + MISC_ROPE);
  tab[idx] = make_float2(__cosf(rf), __sinf(rf));
  if (it < 8) {
    const int e = it * 256 + HTID;
    const float* lbp = p.in[21] + (e >> 10) * 4096 + (e & 1023);
    const float x0 = lbp[0], x1 = lbp[1024], x2 = lbp[2048], x3 = lbp[3072];
    const float m = fmaxf(fmaxf(x0, x1), fmaxf(x2, x3));
    const float e0 = expf(x0 - m), e1 = expf(x1 - m), e2 = expf(x2 - m), e3 = expf(x3 - m);
    ((float*)(p.ws + OFF_MISC + MISC_LB))[e] = (e1 + e2) / (e0 + e1 + e2 + e3);
  }
}

__device__ __forceinline__ void phase0(const Params& p, unsigned char* lds) {
  const int nw = conv_weights_count(p, 0);
  const int total = 192 + 256 + nw;
  for (int it = VBID; it < total; it += VGDIM) {
    if (it < 192) mod_item(p, it, lds);
    else if (it < 448) rope_item(p, it - 192);
    else conv_weights_item(p, 0, it - 448, lds);
  }
}

__device__ __forceinline__ void post_phase(const Params& p, int lprev, int lnext, unsigned char* lds, const bool dry) {
  const int tid = HTID, lane = tid & 63, w = tid >> 6;
  const float* mod = (const float*)(p.ws + OFF_MISC);
  const bf16_t* Y = nullptr;
  if (lprev >= 0) {
    const int kind = layer_info(p, lprev).kind;
    Y = (const bf16_t*)(p.ws + (kind == 1 ? 96 * MIB : 0));
  }
  bf16_t* hp = (bf16_t*)(p.ws + OFF_HP);
  bf16_t* hs = lnext < 4 ? hs_ptr(p, lnext) : nullptr;
  for (int row = VBID * 4 + w; row < 24576; row += VGDIM * 4) {
    const int mv = row < 8192 ? 0 : 1 + ((row - 8192) >> 11);
    const float* xs = (lprev <= 0) ? (row < 8192 ? p.in[0] + (size_t)row * 1024 : p.in[1] + (size_t)(row - 8192) * 1024) : p.out + (size_t)row * 1024;
    float4 x[4];
#pragma unroll
    for (int j = 0; j < 4; ++j) x[j] = *(const float4*)(xs + lane * 4 + 256 * j);
    if (lprev >= 0) {
      float4 y[4];
      float ss = 0.f;
#pragma unroll
      for (int j = 0; j < 4; ++j) { const uint2 yw = *(const uint2*)(Y + (size_t)row * 1024 + lane * 4 + 256 * j); y[j] = make_float4(lo_f(yw.x), hi_f(yw.x), lo_f(yw.y), hi_f(yw.y)); ss += y[j].x * y[j].x + y[j].y * y[j].y + y[j].z * y[j].z + y[j].w * y[j].w; }
      ss = wave_sum(ss);
      const float rstd = rsqrtf(ss * (1.f / 1024.f) + 1e-6f);
      const float* ga = mod + (size_t)(lprev * 9 + mv) * 3072 + 2048;
      const float* gp = p.in[11] + lprev * 1024;
#pragma unroll
      for (int j = 0; j < 4; ++j) {
        const int c = lane * 4 + 256 * j;
        const float4 g4 = *(const float4*)(ga + c), p4 = *(const float4*)(gp + c);
        x[j].x += g4.x * (y[j].x * rstd * p4.x); x[j].y += g4.y * (y[j].y * rstd * p4.y);
        x[j].z += g4.z * (y[j].z * rstd * p4.z); x[j].w += g4.w * (y[j].w * rstd * p4.w);
        if (!dry) *(float4*)(p.out + (size_t)row * 1024 + c) = x[j];
      }
    }
    if (lnext < 4) {
      float ss = 0.f;
#pragma unroll
      for (int j = 0; j < 4; ++j) ss += x[j].x * x[j].x + x[j].y * x[j].y + x[j].z * x[j].z + x[j].w * x[j].w;
      ss = wave_sum(ss);
      const float rstd = rsqrtf(ss * (1.f / 1024.f) + 1e-6f);
      const float* sh = mod + (size_t)(lnext * 9 + mv) * 3072;
      const float* sc = sh + 1024;
      const float* gp = p.in[10] + lnext * 1024;
      bf16_t* hd = row < 8192 ? hp + (size_t)row * 1024 : hs + (size_t)(row - 8192) * 1024;
#pragma unroll
      for (int j = 0; j < 4; ++j) {
        const int c = lane * 4 + 256 * j;
        const float4 s4 = *(const float4*)(sh + c), c4 = *(const float4*)(sc + c), p4 = *(const float4*)(gp + c);
        const float h0 = x[j].x * rstd * p4.x * (1.f + c4.x) + s4.x, h1 = x[j].y * rstd * p4.y * (1.f + c4.y) + s4.y;
        const float h2 = x[j].z * rstd * p4.z * (1.f + c4.z) + s4.z, h3 = x[j].w * rstd * p4.w * (1.f + c4.w) + s4.w;
        *(uint2*)(hd + c) = make_uint2(pack2(h0, h1), pack2(h2, h3));
      }
    }
  }
  if (lprev >= 0 && lnext < 4) {
    const int nw = conv_weights_count(p, lnext);
    for (int it = VBID; it < nw; it += VGDIM) conv_weights_item(p, lnext, it, lds);
  }
}


__device__ __forceinline__ unsigned xcc_id() { return (unsigned)__builtin_amdgcn_s_getreg((3 << 11) | 20) & 7u; }
#define LAS __attribute__((address_space(3)))
template <bool SWAP>
__device__ __forceinline__ void gemm_tile_compute(const bf16_t* __restrict__ Ag, const bf16_t* __restrict__ Bg, int K, unsigned char* lds, f32x4 (&acc)[8][4],
                                                  const bool pre, const bf16_t* __restrict__ An, const bf16_t* __restrict__ Bn, const bool hasn) {
  const int tid = threadIdx.x, lane = tid & 63, wid = __builtin_amdgcn_readfirstlane(tid >> 6), wm = wid >> 2, wn = wid & 3;
  const int lr = lane & 15, lg = lane >> 4;
  LAS unsigned char* l3 = (LAS unsigned char*)lds;
  const int prow = lane >> 3;
  const int pgo0 = prow * K + (((lane & 7) ^ ((prow >> 1) & 7)) << 3);
  const int pgo1 = prow * K + (((lane & 7) ^ ((4 + (prow >> 1)) & 7)) << 3);
  const bf16_t* asrc = Ag + (size_t)(wid * 32) * K;
  const bf16_t* bsrc = Bg + (size_t)(wid * 32) * K;
  const size_t pstep = (size_t)8 * K;
#pragma unroll
  for (int mi = 0; mi < 8; ++mi)
#pragma unroll
    for (int ni = 0; ni < 4; ++ni) acc[mi][ni] = (f32x4){0.f, 0.f, 0.f, 0.f};
#define GEMM_STAGE_P(ap_, bp_, s, k0)                                                                                                      \
  {                                                                                                                                        \
    _Pragma("unroll") for (int j = 0; j < 4; ++j) {                                                                                        \
      __builtin_amdgcn_global_load_lds((const unsigned*)((ap_) + j * pstep + ((j & 1) ? pgo1 : pgo0) + (k0)), (LAS unsigned*)(l3 + (s) * 65536 + (wid * 4 + j) * 1024), 16, 0, 0);          \
      __builtin_amdgcn_global_load_lds((const unsigned*)((bp_) + j * pstep + ((j & 1) ? pgo1 : pgo0) + (k0)), (LAS unsigned*)(l3 + (s) * 65536 + 32768 + (wid * 4 + j) * 1024), 16, 0, 0);  \
    }                                                                                                                                      \
  }
#define GEMM_STAGE(s, k0) GEMM_STAGE_P(asrc, bsrc, s, k0)
  const int nk = K >> 6;
  if (!pre) GEMM_STAGE(0, 0);
  asm volatile("s_waitcnt vmcnt(0)" ::: "memory");
  __syncthreads();
  const int x0 = lg ^ ((lr >> 1) & 7);
  const int aoff0 = (wm * 128 + lr) * 128 + x0 * 16, aoff1 = (wm * 128 + lr) * 128 + (x0 ^ 4) * 16;
  const int boff0 = 32768 + (wn * 64 + lr) * 128 + x0 * 16, boff1 = 32768 + (wn * 64 + lr) * 128 + (x0 ^ 4) * 16;
  for (int kt = 0; kt < nk; ++kt) {
    if (kt + 1 < nk) GEMM_STAGE((kt + 1) & 1, (kt + 1) * 64);
    const unsigned char* st = lds + (kt & 1) * 65536;
#pragma unroll
    for (int kk = 0; kk < 2; ++kk) {
      bf16x8 af[8], bfr[4];
#pragma unroll
      for (int ni = 0; ni < 4; ++ni) bfr[ni] = *(const bf16x8*)(st + (kk ? boff1 : boff0) + ni * 2048);
#pragma unroll
      for (int mi = 0; mi < 8; ++mi) af[mi] = *(const bf16x8*)(st + (kk ? aoff1 : aoff0) + mi * 2048);
#pragma unroll
      for (int mi = 0; mi < 8; ++mi)
#pragma unroll
        for (int ni = 0; ni < 4; ++ni)
          acc[mi][ni] = SWAP ? MFMA(bfr[ni], af[mi], acc[mi][ni]) : MFMA(af[mi], bfr[ni], acc[mi][ni]);
    }
    asm volatile("s_waitcnt vmcnt(0)" ::: "memory");
    __syncthreads();
  }
  if (hasn) { const bf16_t* an_ = An + (size_t)(wid * 32) * K; const bf16_t* bn_ = Bn + (size_t)(wid * 32) * K; GEMM_STAGE_P(an_, bn_, 0, 0); }
#undef GEMM_STAGE
#undef GEMM_STAGE_P
}

enum { GM_IN_DA = 0, GM_IN_RET_QKV = 1, GM_IN_RET_G = 2, GM_IN_HG = 3, GM_OUT = 4 };

__device__ __forceinline__ void epi_swapped(const Params& p, int mode, int slot, int ykind, int m, int n, f32x4 v) {
  bf16_t* R0 = (bf16_t*)p.ws;
  if (mode == GM_OUT) {
    bf16_t* Y = (bf16_t*)(p.ws + (ykind == 1 ? 96 * MIB : 0));
    *(uint2*)(Y + (size_t)m * 1024 + n) = make_uint2(pack2(v[0], v[1]), pack2(v[2], v[3]));
  } else if (mode == GM_IN_DA) {
    const bool smp = m >= 8192;
    const int ms = m - 8192;
    const int b = smp ? (ms >> 11) : (m >> 8), t = smp ? (ms & 2047) : (m & 255);
    if (n < 2048) {
      if (smp) {
        const float4 cs = *(const float4*)((const float*)(p.ws + OFF_MISC + MISC_ROPE) + (size_t)(t * 32 + ((n & 63) >> 1)) * 2);
        const float a0 = v[0] * cs.x - v[1] * cs.y, a1 = v[0] * cs.y + v[1] * cs.x;
        const float a2 = v[2] * cs.z - v[3] * cs.w, a3 = v[2] * cs.w + v[3] * cs.z;
        v = (f32x4){a0, a1, a2, a3};
      }
      if (n < 1024) {
        *(uint2*)(R0 + (size_t)m * 1024 + n) = make_uint2(pack2(v[0] * QSCALE, v[1] * QSCALE), pack2(v[2] * QSCALE, v[3] * QSCALE));
      } else {
        const int c = n - 1024;
        const uint2 pk = make_uint2(pack2(v[0], v[1]), pack2(v[2], v[3]));
        if (smp) {
          *(uint2*)(R0 + 64 * MIB / 2 + ((size_t)b * 2560 + t) * 1024 + c) = pk;
        } else {
          *(f32x4*)(p.out + OUT_CK + ((size_t)((b * 2 + slot) * 256 + t)) * 1024 + c) = v;
          *(uint2*)(R0 + 48 * MIB / 2 + (size_t)m * 1024 + c) = pk;
        }
      }
    } else {
      *(uint2*)(R0 + 160 * MIB / 2 + (size_t)m * 1024 + (n - 3072)) = make_uint2(pack2(silu_f(v[0]), silu_f(v[1])), pack2(silu_f(v[2]), silu_f(v[3])));
    }
  } else if (mode == GM_IN_RET_QKV) {
    if (n < 1024) *(uint2*)(R0 + (size_t)m * 1024 + n) = make_uint2(pack2(v[0], v[1]), pack2(v[2], v[3]));
    else if (n < 2048) { const float s = 0.08838834764831845f; *(uint2*)(R0 + PLANE_E + (size_t)m * 1024 + (n - 1024)) = make_uint2(pack2(v[0] * s, v[1] * s), pack2(v[2] * s, v[3] * s)); }
    else *(uint2*)(R0 + 2 * PLANE_E + (size_t)m * 2048 + (n - 2048)) = make_uint2(pack2(v[0], v[1]), pack2(v[2], v[3]));
  } else if (mode == GM_IN_RET_G) {
    *(uint2*)(R0 + (size_t)m * 2048 + n) = make_uint2(pack2(silu_f(v[0]), silu_f(v[1])), pack2(silu_f(v[2]), silu_f(v[3])));
  } else {
    if (n < 1024 || n >= 4096) v = (f32x4){silu_f(v[0]), silu_f(v[1]), silu_f(v[2]), silu_f(v[3])};
    else if (n < 3072) {
      const float4 lb = *(const float4*)((const float*)(p.ws + OFF_MISC + MISC_LB) + (n - 1024));
      v = (f32x4){__log2f(lb.x + (1.f - lb.x) / (1.f + __expf(-v[0]))), __log2f(lb.y + (1.f - lb.y) / (1.f + __expf(-v[1]))),
                  __log2f(lb.z + (1.f - lb.z) / (1.f + __expf(-v[2]))), __log2f(lb.w + (1.f - lb.w) / (1.f + __expf(-v[3])))};
    }
    *(uint2*)(R0 + (size_t)(n >> 10) * PLANE_E + (size_t)m * 1024 + (n & 1023)) = make_uint2(pack2(v[0], v[1]), pack2(v[2], v[3]));
  }
}

__device__ __forceinline__ void epi_da_v(const Params& p, int slot, int m, int n, f32x4 v) {
  bf16_t* R0 = (bf16_t*)p.ws;
  const int c = n - 2048, hh = c >> 7, e = c & 127;
  const uint2 pk = make_uint2(pack2(v[0], v[1]), pack2(v[2], v[3]));
  if (m >= 8192) {
    const int ms = m - 8192, b = ms >> 11, t = ms & 2047;
    *(uint2*)(R0 + 120 * MIB / 2 + ((size_t)((b * 8 + hh) * 128 + e)) * 2560 + t) = pk;
  } else {
    const int b = m >> 8, t = m & 255;
    float* o = p.out + OUT_CV + ((size_t)((b * 2 + slot) * 256 + t)) * 1024 + c;
    o[0] = v[0]; o[1024] = v[1]; o[2048] = v[2]; o[3072] = v[3];
    *(uint2*)(R0 + 104 * MIB / 2 + ((size_t)((b * 8 + hh) * 128 + e)) * 256 + t) = pk;
  }
}

__device__ __forceinline__ void gemm_phase(const Params& p, int l, int mode, unsigned char* lds, int phid) {
  const LayerInfo L = layer_info(p, l);
  bf16_t* R0 = (bf16_t*)p.ws;
  const bf16_t *Ap, *As, *Bt;
  int K, N;
  if (mode == GM_OUT) {
    K = L.WIDTH; N = 1024; Bt = (const bf16_t*)(p.ws + OFF_WOUT);
    const bf16_t* base = R0 + (L.kind == 0 ? 160 * MIB / 2 : (L.kind == 1 ? 4 * PLANE_E : 5 * PLANE_E));
    Ap = base; As = base + (size_t)8192 * K;
  } else {
    K = 1024; Ap = (const bf16_t*)(p.ws + OFF_HP); As = hs_ptr(p, l);
    Bt = (const bf16_t*)(p.ws + OFF_WIN) + (mode == GM_IN_RET_G ? (size_t)4096 * 1024 : 0);
    N = (mode == GM_IN_DA || mode == GM_IN_RET_QKV) ? 4096 : (mode == GM_IN_RET_G ? 2048 : 5120);
  }
  const int ntn = N >> 8, ntiles = 96 * ntn;
  const int extra = (mode == GM_IN_DA) ? 3072 : 0;
  const int tid = threadIdx.x, lane = tid & 63, wid = tid >> 6, wm = wid >> 2, wn = wid & 3, lr = lane & 15, lg = lane >> 4;
  const int G = gridDim.x;
  const bool swz = (G & 7) == 0;
  const int xcd = blockIdx.x & 7, snn = ntn >> 2, nst = 12 * snn;
  const int q0 = swz ? (int)(blockIdx.x >> 3) : (int)blockIdx.x, qstep = swz ? (G >> 3) : G;
  const int qlen = swz ? 32 * ((nst - xcd + 7) >> 3) : ntiles;
#define GEMM_TILE_OF(qq, m0_, n0_)                                                   \
  {                                                                                    \
    int it_ = (qq);                                                                    \
    if (swz) {                                                                         \
      const int st_ = xcd + 8 * ((qq) >> 5), tin_ = (qq) & 31;                         \
      const int smt_ = st_ / snn, snt_ = st_ - smt_ * snn;                             \
      it_ = (smt_ * 8 + (tin_ >> 2)) * ntn + snt_ * 4 + (tin_ & 3);                    \
    }                                                                                  \
    const int mt_ = it_ / ntn;                                                         \
    m0_ = mt_ * 256; n0_ = (it_ - mt_ * ntn) * 256;                                    \
  }
  bool pre = false;
  for (int q = q0; q < qlen; q += qstep) {
    int m0, n0;
    GEMM_TILE_OF(q, m0, n0)
    const bf16_t* A = m0 < 8192 ? Ap + (size_t)m0 * K : As + (size_t)(m0 - 8192) * K;
    const bf16_t* B = Bt + (size_t)n0 * K;
    const bool hasn = q + qstep < qlen;
    const bf16_t *An = A, *Bn = B;
    if (hasn) {
      int m1, n1;
      GEMM_TILE_OF(q + qstep, m1, n1)
      An = m1 < 8192 ? Ap + (size_t)m1 * K : As + (size_t)(m1 - 8192) * K;
      Bn = Bt + (size_t)n1 * K;
    }
    {
      f32x4 acc[8][4];
      if (mode == GM_IN_DA && n0 >= 2048 && n0 < 3072) {
        gemm_tile_compute<false>(A, B, K, lds, acc, pre, An, Bn, hasn);
#pragma unroll
        for (int mi = 0; mi < 8; ++mi)
#pragma unroll
          for (int ni = 0; ni < 4; ++ni)
            epi_da_v(p, L.slot, m0 + wm * 128 + mi * 16 + 4 * lg, n0 + wn * 64 + ni * 16 + lr, acc[mi][ni]);
      } else {
        gemm_tile_compute<true>(A, B, K, lds, acc, pre, An, Bn, hasn);
#pragma unroll
        for (int mi = 0; mi < 8; ++mi)
#pragma unroll
          for (int ni = 0; ni < 4; ++ni)
            epi_swapped(p, mode, L.slot, L.kind, m0 + wm * 128 + mi * 16 + lr, n0 + wn * 64 + ni * 16 + 4 * lg, acc[mi][ni]);
      }
    }
    pre = hasn;
  }
#undef GEMM_TILE_OF
  if (extra) { asm volatile("s_waitcnt vmcnt(0)" ::: "memory"); __syncthreads(); }
  for (int ci = VBID; ci < extra; ci += VGDIM) {
    {
      if (ci < 2048) {
        const int idx = (ci * 256 + HTID) * 8;
        const int b = idx >> 19, rem = idx & 524287, tp = rem >> 10, c = rem & 1023;
        const float* src = p.in[2] + ((size_t)((b * 2 + L.slot) * 512 + tp)) * 1024 + c;
        const float4 u0 = *(const float4*)src, u1 = *(const float4*)(src + 4);
        *(uint4*)(R0 + 64 * MIB / 2 + ((size_t)b * 2560 + 2048 + tp) * 1024 + c) = make_uint4(pack2(u0.x, u0.y), pack2(u0.z, u0.w), pack2(u1.x, u1.y), pack2(u1.z, u1.w));
      } else {
        const int i2 = ci - 2048;
        const int b = i2 >> 7, hh = (i2 >> 4) & 7, tt = (i2 >> 1) & 7, et = i2 & 1;
        convT_tile(p.in[3] + ((size_t)((b * 2 + L.slot) * 512 + tt * 64)) * 1024 + hh * 128 + et * 64, 1024,
                   R0 + 120 * MIB / 2 + ((size_t)((b * 8 + hh) * 128 + et * 64)) * 2560 + 2048 + tt * 64, 2560, lds + HALFID * HALF_LDS);
      }
    }
  }
}

__device__ __forceinline__ void attn_phase(const Params& p, int l, unsigned char* lds, const bool dry, int phid) {
  const int slot = l == 3 ? 1 : 0;
  const float lam_init = 0.8f - 0.6f * expf(-0.3f * (float)l);
  const int tid = threadIdx.x, lane = tid & 63, w = tid >> 6, lr = lane & 15, lg = lane >> 4;
  float lam;
  {
    const float* lf = p.in[14] + slot * 256;
    const float a = wave_sum(lf[lane] * lf[64 + lane]);
    const float b2 = wave_sum(lf[128 + lane] * lf[192 + lane]);
    lam = expf(a) - expf(b2) + lam_init;
  }
  bf16_t* R0 = (bf16_t*)p.ws;
  const float* subg = p.in[15] + slot * 128;
  for (int item = blockIdx.x; item < 1536; item += gridDim.x) {
    int grp, b, h, qt;
    if (item < 1024) { grp = 1; b = item >> 7; h = (item >> 4) & 7; qt = item & 15; }
    else { const int i2 = item - 1024; grp = 0; b = i2 >> 4; h = (i2 >> 1) & 7; qt = i2 & 1; }
    const int nkeys = grp ? 2560 : 256, ntile = nkeys >> 7;
    const int mq = (grp ? 8192 + b * 2048 : b * 256) + qt * 128 + w * 16 + lr;
    const bf16_t* Kg = grp ? R0 + 64 * MIB / 2 + (size_t)b * 2560 * 1024 + h * 128 : R0 + 48 * MIB / 2 + (size_t)b * 256 * 1024 + h * 128;
    const bf16_t* Vg = grp ? R0 + 120 * MIB / 2 + (size_t)(b * 8 + h) * 128 * 2560 : R0 + 104 * MIB / 2 + (size_t)(b * 8 + h) * 128 * 256;
    bf16x8 qf[2][2];
#pragma unroll
    for (int sub = 0; sub < 2; ++sub)
#pragma unroll
      for (int ks = 0; ks < 2; ++ks) qf[sub][ks] = *(const bf16x8*)(R0 + (size_t)mq * 1024 + h * 128 + sub * 64 + ks * 32 + lg * 8);
    LAS unsigned char* l3 = (LAS unsigned char*)lds;
    const int wu = __builtin_amdgcn_readfirstlane(w);
    int koff[4], voff[4];
#pragma unroll
    for (int j = 0; j < 4; ++j) {
      const int kr = (wu * 4 + j) * 4 + (lane >> 4);
      koff[j] = kr * 1024 + (((lane & 15) ^ (kr & 15)) << 3);
      voff[j] = kr * nkeys + (((lane & 15) ^ (kr & 15)) << 3);
    }
#define ATT_STAGE_K(s, key0)                                                                                  \
  {                                                                                                           \
    _Pragma("unroll") for (int j = 0; j < 4; ++j)                                                             \
      __builtin_amdgcn_global_load_lds((const unsigned*)(Kg + (size_t)(key0) * 1024 + koff[j]), (LAS unsigned*)(l3 + (s) * 65536 + (wu * 4 + j) * 1024), 16, 0, 0); \
  }
#define ATT_STAGE_V(s, key0)                                                                                  \
  {                                                                                                           \
    _Pragma("unroll") for (int j = 0; j < 4; ++j)                                                             \
      __builtin_amdgcn_global_load_lds((const unsigned*)(Vg + (key0) + voff[j]), (LAS unsigned*)(l3 + (s) * 65536 + 32768 + (wu * 4 + j) * 1024), 16, 0, 0); \
  }
    const int xl = lg ^ lr;
    const int vsw = (lr >> 1) & 7;
    const int vlo = lr * 256 + ((((lg >> 1)) ^ lr) << 4) + (lg & 1) * 8;
    float mx[2] = {-1e30f, -1e30f}, ls[2] = {0.f, 0.f};
    f32x4 o0[8], o1[8];
#pragma unroll
    for (int et = 0; et < 8; ++et) { o0[et] = (f32x4){0.f, 0.f, 0.f, 0.f}; o1[et] = (f32x4){0.f, 0.f, 0.f, 0.f}; }
    ATT_STAGE_K(0, 0);
    ATT_STAGE_V(0, 0);
    asm volatile("s_waitcnt vmcnt(0)" ::: "memory");
    __syncthreads();
    for (int kt = 0; kt < ntile; ++kt) {
      if (kt + 1 < ntile) { ATT_STAGE_K((kt + 1) & 1, (kt + 1) * 128); ATT_STAGE_V((kt + 1) & 1, (kt + 1) * 128); }
      const unsigned char* ks_ = lds + (kt & 1) * 65536 + lr * 256;
      const unsigned char* vs_ = lds + (kt & 1) * 65536 + 32768;
#pragma unroll
      for (int k2 = 0; k2 < 4; ++k2) {
        bf16x8 kfr[8];
        uint2 vlo_[8], vhi_[8];
#pragma unroll
        for (int sub = 0; sub < 2; ++sub)
#pragma unroll
          for (int nn = 0; nn < 2; ++nn)
#pragma unroll
            for (int ks = 0; ks < 2; ++ks)
              kfr[sub * 4 + nn * 2 + ks] = *(const bf16x8*)(ks_ + (2 * k2 + nn) * 4096 + ((xl ^ (sub * 8 + ks * 4)) << 4));
#pragma unroll
        for (int et = 0; et < 8; ++et) {
          vlo_[et] = *(const uint2*)(vs_ + et * 4096 + (vlo ^ (k2 << 6)));
          vhi_[et] = *(const uint2*)(vs_ + et * 4096 + (vlo ^ (k2 << 6) ^ 32));
        }
        SB;
        f32x4 s[2][2];
#pragma unroll
        for (int sub = 0; sub < 2; ++sub)
#pragma unroll
          for (int nn = 0; nn < 2; ++nn) {
            s[sub][nn] = MFMA(kfr[sub * 4 + nn * 2], qf[sub][0], ((f32x4){0.f, 0.f, 0.f, 0.f}));
            s[sub][nn] = MFMA(kfr[sub * 4 + nn * 2 + 1], qf[sub][1], s[sub][nn]);
          }
        SB;
        bf16x8 pf[2];
        float tmx[2];
#pragma unroll
        for (int sub = 0; sub < 2; ++sub) {
          float tm = fmaxf(fmaxf(fmaxf(s[sub][0][0], s[sub][0][1]), fmaxf(s[sub][0][2], s[sub][0][3])), fmaxf(fmaxf(s[sub][1][0], s[sub][1][1]), fmaxf(s[sub][1][2], s[sub][1][3])));
          tmx[sub] = tm;
        }
        if (__any((tmx[0] > mx[0] + 8.f) || (tmx[1] > mx[1] + 8.f))) {
#pragma unroll
          for (int sub = 0; sub < 2; ++sub) {
            float tm = tmx[sub];
            tm = fmaxf(tm, __shfl_xor(tm, 16));
            tm = fmaxf(tm, __shfl_xor(tm, 32));
            const float mn = (tm > mx[sub] + 8.f) ? tm : mx[sub];
            const float sc = __builtin_amdgcn_exp2f(mx[sub] - mn);
            mx[sub] = mn;
            ls[sub] *= sc;
#pragma unroll
            for (int et = 0; et < 8; ++et) {
              if (sub == 0) { o0[et][0] *= sc; o0[et][1] *= sc; o0[et][2] *= sc; o0[et][3] *= sc; }
              else { o1[et][0] *= sc; o1[et][1] *= sc; o1[et][2] *= sc; o1[et][3] *= sc; }
            }
          }
        }
#pragma unroll
        for (int sub = 0; sub < 2; ++sub) {
          unsigned pw[4];
          float acc = 0.f;
#pragma unroll
          for (int nn = 0; nn < 2; ++nn) {
            float a[4];
#pragma unroll
            for (int r = 0; r < 4; ++r) { a[r] = __builtin_amdgcn_exp2f(s[sub][nn][r] - mx[sub]); acc += a[r]; }
            pw[nn * 2] = pack2(a[0], a[1]);
            pw[nn * 2 + 1] = pack2(a[2], a[3]);
          }
          ls[sub] += acc;
          union { unsigned u[4]; bf16x8 v; } cp;
          cp.u[0] = pw[0]; cp.u[1] = pw[1]; cp.u[2] = pw[2]; cp.u[3] = pw[3];
          pf[sub] = cp.v;
        }
        SB;
#pragma unroll
        for (int et = 0; et < 8; ++et) {
          union { unsigned u[4]; bf16x8 v; } cv;
          cv.u[0] = vlo_[et].x; cv.u[1] = vlo_[et].y; cv.u[2] = vhi_[et].x; cv.u[3] = vhi_[et].y;
          o0[et] = MFMA(cv.v, pf[0], o0[et]);
          o1[et] = MFMA(cv.v, pf[1], o1[et]);
        }
        SB;
      }
      asm volatile("s_waitcnt vmcnt(0)" ::: "memory");
      __syncthreads();
    }
    f32x4 o[8];
    {
      float t0 = ls[0], t1 = ls[1];
      t0 += __shfl_xor(t0, 16); t0 += __shfl_xor(t0, 32);
      t1 += __shfl_xor(t1, 16); t1 += __shfl_xor(t1, 32);
      const float c1 = 1.f / t0, c2 = lam / t1;
#pragma unroll
      for (int et = 0; et < 8; ++et)
#pragma unroll
        for (int r = 0; r < 4; ++r) o[et][r] = o0[et][r] * c1 - o1[et][r] * c2;
    }
#undef ATT_STAGE_K
#undef ATT_STAGE_V
    float ss = 0.f;
#pragma unroll
    for (int et = 0; et < 8; ++et)
#pragma unroll
      for (int r = 0; r < 4; ++r) ss += o[et][r] * o[et][r];
    ss += __shfl_xor(ss, 16);
    ss += __shfl_xor(ss, 32);
    const float rs = rsqrtf(ss * (1.f / 128.f) + 1e-6f) * (1.f - lam_init);
    bf16_t* gp = R0 + 160 * MIB / 2 + (size_t)mq * 1024 + h * 128;
#pragma unroll
    for (int et = 0; et < 8; ++et) {
      const int e0 = 16 * et + 4 * lg;
      const uint2 g = *(const uint2*)(gp + e0);
      const float4 sg = *(const float4*)(subg + e0);
      const float v0 = o[et][0] * rs * sg.x * lo_f(g.x), v1 = o[et][1] * rs * sg.y * hi_f(g.x);
      const float v2 = o[et][2] * rs * sg.z * lo_f(g.y), v3 = o[et][3] * rs * sg.w * hi_f(g.y);
      if (!dry) *(uint2*)(gp + e0) = make_uint2(pack2(v0, v1), pack2(v2, v3));
    }
  }
}

__device__ __forceinline__ bf16_t* hg_ob_row(const Params& p, int m) {
  const int c = m >> 9;
  float* base = c < 32 ? p.out + OUT_CK + (size_t)(c * 2 + 1) * 262144 : p.out + OUT_CV + (size_t)((c - 32) * 2 + 1) * 262144;
  return (bf16_t*)base + (size_t)(m & 511) * 1024;
}

__device__ __forceinline__ bf16_t* ret_ob_row(const Params& p, int ms) {
  const int c = ms >> 8;
  float* base = c < 32 ? p.out + OUT_CK + (size_t)(c * 2 + 1) * 262144 : p.out + OUT_CV + (size_t)((c - 32) * 2 + 1) * 262144;
  return (bf16_t*)base + (size_t)(ms & 255) * 2048;
}

template <int KIND, int DIR>
__device__ __forceinline__ void scan_item(const Params& p, int item, unsigned char* lds, const bool dry) {
  constexpr int DV = KIND == 1 ? 256 : 128, NSL = DV / 64, LDV = KIND == 1 ? 2048 : 1024;
  const int tid = HTID, lane = tid & 63, w = tid >> 6, lr = lane & 15, lg = lane >> 4;
  int grp, b, h, sl;
  {
    int it = item;
    if (it < 64 * NSL) grp = 1; else { grp = 0; it -= 64 * NSL; }
    sl = it % NSL; h = (it / NSL) & 7; b = it / (NSL * 8);
  }
  const int T = grp ? 2048 : 256, nch = T >> 6;
  const size_t mbase = grp ? (size_t)8192 + (size_t)b * 2048 : (size_t)b * 256;
  bf16_t* R0 = (bf16_t*)p.ws;
  const bf16_t* Qg = R0 + mbase * 1024 + h * 128;
  const bf16_t* Kg = R0 + (KIND == 1 ? PLANE_E : (DIR ? 2 * PLANE_E : PLANE_E)) + mbase * 1024 + h * 128;
  const bf16_t* Vg = R0 + (KIND == 1 ? 2 * PLANE_E : 3 * PLANE_E) + mbase * LDV + h * DV + sl * 64;
  bf16_t* Og = R0 + (KIND == 1 ? 4 * PLANE_E : 5 * PLANE_E) + mbase * LDV + h * DV + sl * 64;
  unsigned char* Qs = lds;
  unsigned char* X = lds + 17408;
  unsigned char* Vt = lds + 35840;
  unsigned char* StS = lds + 45056;
  unsigned char* Pm = lds + 62464;
  float* xch = (float*)(lds + 71680);
  float* blA = xch + 512;
  float* erA = xch + 640;
  const int dp = tid & 63, tq = tid >> 6, r0 = tq * 16, d0 = dp * 2;
  float cst0, cst1;
  if (KIND == 1) { cst0 = cst1 = log1pf(-expf(p.in[18][DIR * 8 + h])) * 1.4426950408889634f; }
  else {
    const float* lbp = p.in[21] + DIR * 4096 + h * 128 + d0;
    {
      const float x0 = lbp[0], x1 = lbp[1024], x2 = lbp[2048], x3 = lbp[3072];
      const float m = fmaxf(fmaxf(x0, x1), fmaxf(x2, x3));
      const float e0 = expf(x0 - m), e1 = expf(x1 - m), e2 = expf(x2 - m), e3 = expf(x3 - m);
      cst0 = (e1 + e2) / (e0 + e1 + e2 + e3);
    }
    {
      const float x0 = lbp[1], x1 = lbp[1025], x2 = lbp[2049], x3 = lbp[3073];
      const float m = fmaxf(fmaxf(x0, x1), fmaxf(x2, x3));
      const float e0 = expf(x0 - m), e1 = expf(x1 - m), e2 = expf(x2 - m), e3 = expf(x3 - m);
      cst1 = (e1 + e2) / (e0 + e1 + e2 + e3);
    }
  }
  f32x4 S[8];
  if (grp) {
    const float* s0 = (KIND == 1 ? p.in[4] : p.in[5]) + ((size_t)((b * 2 + DIR) * 8 + h) * 128) * DV + sl * 64 + 16 * w + lr + (size_t)(4 * lg) * DV;
    asm volatile("" : "+v"(s0));
#pragma unroll
    for (int dt = 0; dt < 8; ++dt)
#pragma unroll
      for (int r = 0; r < 4; ++r) S[dt][r] = s0[(16 * dt + r) * DV];
  } else {
#pragma unroll
    for (int dt = 0; dt < 8; ++dt) S[dt] = (f32x4){0.f, 0.f, 0.f, 0.f};
  }
  unsigned qv[16], kv[16], vv[8];
  const int ve2 = tid & 31, vq = tid >> 5;
  const int qoff = r0 * 512 + dp;
  const int voff = (8 * vq) * (LDV / 2) + ve2;
  const unsigned* Qg32 = (const unsigned*)Qg;
  const unsigned* Kg32 = (const unsigned*)Kg;
  const unsigned* Vg32 = (const unsigned*)Vg;
#define SCAN_ISSUE(c)                                                                                   \
  {                                                                                                     \
    const unsigned* q_ = Qg32 + (size_t)(c) * (64 * 512) + qoff;                                        \
    const unsigned* k_ = Kg32 + (size_t)(c) * (64 * 512) + qoff;                                        \
    const unsigned* v_ = Vg32 + (size_t)(c) * (64 * (LDV / 2)) + voff;                                  \
    asm volatile("" : "+v"(q_), "+v"(k_), "+v"(v_));                                                    \
    _Pragma("unroll") for (int i = 0; i < 16; ++i) { qv[i] = q_[i * 512]; kv[i] = k_[i * 512]; }        \
    _Pragma("unroll") for (int i = 0; i < 8; ++i) vv[i] = v_[i * (LDV / 2)];                            \
  }
  if (KIND == 1) {
    if (tid < 64) {
      const float ex = (DIR ? (float)(32 - tid) : (float)(tid - 31)) * cst0;
      *(float2*)(xch + 2 * tid) = make_float2(__builtin_amdgcn_exp2f(ex), __builtin_amdgcn_exp2f(-ex));
    }
    if (tid < 128) { blA[tid] = __builtin_amdgcn_exp2f(64.f * cst0); erA[tid] = __builtin_amdgcn_exp2f(32.f * cst0); }
    __syncthreads();
  }
  SCAN_ISSUE(DIR ? nch - 1 : 0);
  for (int ci = 0; ci < nch; ++ci) {
    const int c = DIR ? nch - 1 - ci : ci;
    unsigned ktp0[8], ktp1[8];
    if (KIND == 1) {
      const float cbr = __builtin_amdgcn_exp2f(32.f * cst0);
#pragma unroll
      for (int j = 0; j < 8; ++j) {
        float ka[2], kb[2];
#pragma unroll
        for (int hh = 0; hh < 2; ++hh) {
          const int i = 2 * j + hh;
          const float2 e = *(const float2*)(xch + 2 * (r0 + i));
          *(unsigned*)(Qs + (r0 + i) * 272 + d0 * 2) = pack2(lo_f(qv[i]) * e.x, hi_f(qv[i]) * e.x);
          const float kh0 = lo_f(kv[i]) * e.y, kh1 = hi_f(kv[i]) * e.y;
          *(unsigned*)(X + (r0 + i) * 272 + d0 * 2) = pack2(kh0, kh1);
          ka[hh] = kh0 * cbr;
          kb[hh] = kh1 * cbr;
        }
        ktp0[j] = pack2(ka[0], ka[1]);
        ktp1[j] = pack2(kb[0], kb[1]);
      }
    } else {
    float tot0 = 0.f, tot1 = 0.f;
#pragma unroll
    for (int i = 0; i < 16; ++i) { tot0 += lo_f(kv[i]); tot1 += hi_f(kv[i]); }
    *(float2*)(xch + tq * 128 + d0) = make_float2(tot0, tot1);
    __syncthreads();
    const float2 t0 = *(const float2*)(xch + d0), t1 = *(const float2*)(xch + 128 + d0), t2 = *(const float2*)(xch + 256 + d0), t3 = *(const float2*)(xch + 384 + d0);
    const float blast0 = (t0.x + t1.x) + (t2.x + t3.x), blast1 = (t0.y + t1.y) + (t2.y + t3.y);
    float ref0, ref1, run0, run1;
    if (DIR == 0) {
      ref0 = t0.x + t1.x; ref1 = t0.y + t1.y;
      run0 = (tq > 0 ? t0.x : 0.f) + (tq > 1 ? t1.x : 0.f) + (tq > 2 ? t2.x : 0.f);
      run1 = (tq > 0 ? t0.y : 0.f) + (tq > 1 ? t1.y : 0.f) + (tq > 2 ? t2.y : 0.f);
    } else {
      ref0 = t2.x + t3.x; ref1 = t2.y + t3.y;
      run0 = (tq < 3 ? t3.x : 0.f) + (tq < 2 ? t2.x : 0.f) + (tq < 1 ? t1.x : 0.f);
      run1 = (tq < 3 ? t3.y : 0.f) + (tq < 2 ? t2.y : 0.f) + (tq < 1 ? t1.y : 0.f);
    }
    const float cbr0 = __builtin_amdgcn_exp2f(blast0 - ref0), cbr1 = __builtin_amdgcn_exp2f(blast1 - ref1);
#pragma unroll
    for (int jj = 0; jj < 8; ++jj) {
      const int j = DIR ? 7 - jj : jj;
      float ka[2], kb[2];
#pragma unroll
      for (int hh = 0; hh < 2; ++hh) {
        const int i = 2 * j + (DIR ? 1 - hh : hh);
        const float g0 = lo_f(kv[i]), g1 = hi_f(kv[i]);
        const float k0 = 1.f - __builtin_amdgcn_exp2f(g0), k1 = 1.f - __builtin_amdgcn_exp2f(g1);
        run0 += g0; run1 += g1;
        *(unsigned*)(Qs + (r0 + i) * 272 + d0 * 2) = pack2(lo_f(qv[i]) * __builtin_amdgcn_exp2f(run0 - ref0), hi_f(qv[i]) * __builtin_amdgcn_exp2f(run1 - ref1));
        const float kh0 = k0 * __builtin_amdgcn_exp2f(ref0 - run0), kh1 = k1 * __builtin_amdgcn_exp2f(ref1 - run1);
        *(unsigned*)(X + (r0 + i) * 272 + d0 * 2) = pack2(kh0, kh1);
        ka[i & 1] = kh0 * cbr0;
        kb[i & 1] = kh1 * cbr1;
      }
      ktp0[j] = pack2(ka[0], ka[1]);
      ktp1[j] = pack2(kb[0], kb[1]);
    }
    if (tq == 0) { *(float2*)(blA + d0) = make_float2(__builtin_amdgcn_exp2f(blast0), __builtin_amdgcn_exp2f(blast1)); *(float2*)(erA + d0) = make_float2(__builtin_amdgcn_exp2f(ref0), __builtin_amdgcn_exp2f(ref1)); }
    }
    {
      const unsigned a0 = (vv[0] & 0xffffu) | (vv[1] << 16), a1 = (vv[2] & 0xffffu) | (vv[3] << 16), a2 = (vv[4] & 0xffffu) | (vv[5] << 16), a3 = (vv[6] & 0xffffu) | (vv[7] << 16);
      const unsigned b0 = (vv[0] >> 16) | (vv[1] & 0xffff0000u), b1 = (vv[2] >> 16) | (vv[3] & 0xffff0000u), b2 = (vv[4] >> 16) | (vv[5] & 0xffff0000u), b3 = (vv[6] >> 16) | (vv[7] & 0xffff0000u);
      *(uint4*)(Vt + (2 * ve2) * 144 + vq * 16) = make_uint4(a0, a1, a2, a3);
      *(uint4*)(Vt + (2 * ve2 + 1) * 144 + vq * 16) = make_uint4(b0, b1, b2, b3);
    }
    if (ci + 1 < nch) { SCAN_ISSUE(DIR ? c - 1 : c + 1); }
    __syncthreads();
#pragma unroll
    for (int dt = 0; dt < 8; ++dt) {
      const float4 er4 = *(const float4*)(erA + 16 * dt + 4 * lg);
      *(uint2*)(StS + (16 * w + lr) * 272 + (16 * dt + 4 * lg) * 2) = make_uint2(pack2(S[dt][0] * er4.x, S[dt][1] * er4.y), pack2(S[dt][2] * er4.z, S[dt][3] * er4.w));
    }
    bf16x8 qf[4];
#pragma unroll
    for (int ks = 0; ks < 4; ++ks) qf[ks] = *(const bf16x8*)(Qs + (16 * w + lr) * 272 + ks * 64 + lg * 16);
    uint2 pv[4];
    {
      const int t = 16 * w + lr;
#pragma unroll
      for (int st = 0; st < 4; ++st) {
        f32x4 s = (f32x4){0.f, 0.f, 0.f, 0.f};
#pragma unroll
        for (int ks = 0; ks < 4; ++ks) {
          const bf16x8 kf = *(const bf16x8*)(X + (16 * st + lr) * 272 + ks * 64 + lg * 16);
          s = MFMA(kf, qf[ks], s);
        }
        float v[4];
#pragma unroll
        for (int r = 0; r < 4; ++r) {
          const int si = 16 * st + 4 * lg + r;
          const bool keep = DIR ? (t <= si) : (t >= si);
          v[r] = keep ? s[r] : 0.f;
        }
        pv[st] = make_uint2(pack2(v[0], v[1]), pack2(v[2], v[3]));
      }
    }
    __syncthreads();
#pragma unroll
    for (int st = 0; st < 4; ++st) *(uint2*)(Pm + (16 * w + lr) * 144 + (16 * st + 4 * lg) * 2) = pv[st];
    *(uint4*)(X + d0 * 144 + r0 * 2) = make_uint4(ktp0[0], ktp0[1], ktp0[2], ktp0[3]);
    *(uint4*)(X + d0 * 144 + r0 * 2 + 16) = make_uint4(ktp0[4], ktp0[5], ktp0[6], ktp0[7]);
    *(uint4*)(X + (d0 + 1) * 144 + r0 * 2) = make_uint4(ktp1[0], ktp1[1], ktp1[2], ktp1[3]);
    *(uint4*)(X + (d0 + 1) * 144 + r0 * 2 + 16) = make_uint4(ktp1[4], ktp1[5], ktp1[6], ktp1[7]);
    __syncthreads();
    {
      bf16x8 pf[2];
#pragma unroll
      for (int ks = 0; ks < 2; ++ks) pf[ks] = *(const bf16x8*)(Pm + (16 * w + lr) * 144 + ks * 64 + lg * 16);
      const bool sep = DIR && (KIND == 2 || grp);
      bf16_t* orow = (KIND == 2 && DIR) ? hg_ob_row(p, (int)mbase + c * 64 + 16 * w + lr) + h * DV + sl * 64 + 4 * lg
                   : (KIND == 1 && DIR && grp) ? ret_ob_row(p, b * 2048 + c * 64 + 16 * w + lr) + h * DV + sl * 64 + 4 * lg
                                               : Og + (size_t)(c * 64 + 16 * w + lr) * LDV + 4 * lg;
#pragma unroll
      for (int et = 0; et < 4; ++et) {
        f32x4 o = (f32x4){0.f, 0.f, 0.f, 0.f};
#pragma unroll
        for (int ks = 0; ks < 2; ++ks) {
          const bf16x8 vf = *(const bf16x8*)(Vt + (16 * et + lr) * 144 + ks * 64 + lg * 16);
          o = MFMA(vf, pf[ks], o);
        }
#pragma unroll
        for (int ks = 0; ks < 4; ++ks) {
          const bf16x8 sf = *(const bf16x8*)(StS + (16 * et + lr) * 272 + ks * 64 + lg * 16);
          o = MFMA(sf, qf[ks], o);
        }
        bf16_t* op = orow + 16 * et;
        if (DIR && !sep) {
          const uint2 old = *(const uint2*)op;
          o[0] += lo_f(old.x); o[1] += hi_f(old.x); o[2] += lo_f(old.y); o[3] += hi_f(old.y);
        }
        if (!(DIR && !sep && dry)) *(uint2*)op = make_uint2(pack2(o[0], o[1]), pack2(o[2], o[3]));
      }
    }
    {
      bf16x8 vtf[2];
#pragma unroll
      for (int ks = 0; ks < 2; ++ks) vtf[ks] = *(const bf16x8*)(Vt + (16 * w + lr) * 144 + ks * 64 + lg * 16);
#pragma unroll
      for (int dt = 0; dt < 8; ++dt) {
        const float4 bl4 = *(const float4*)(blA + 16 * dt + 4 * lg);
        S[dt][0] *= bl4.x; S[dt][1] *= bl4.y; S[dt][2] *= bl4.z; S[dt][3] *= bl4.w;
#pragma unroll
        for (int ks = 0; ks < 2; ++ks) {
          const bf16x8 kf = *(const bf16x8*)(X + (16 * dt + lr) * 144 + ks * 64 + lg * 16);
          S[dt] = MFMA(kf, vtf[ks], S[dt]);
        }
      }
    }
    __syncthreads();
  }
#undef SCAN_ISSUE
  if (!grp) {
    float* so = p.out + (KIND == 1 ? OUT_SR : OUT_SH) + ((size_t)((b * 2 + DIR) * 8 + h) * 128) * DV + sl * 64 + 16 * w + lr + (size_t)(4 * lg) * DV;
    asm volatile("" : "+v"(so));
#pragma unroll
    for (int dt = 0; dt < 8; ++dt)
#pragma unroll
      for (int r = 0; r < 4; ++r) so[(16 * dt + r) * DV] = S[dt][r];
  }
}

template <int KIND, int DIR>
__device__ __forceinline__ void scan_phase(const Params& p, unsigned char* lds, const bool dry) {
  constexpr int NSL = (KIND == 1 ? 256 : 128) / 64;
  const int ns = 64 * NSL, npr = 256 * NSL;
  const int G = VGDIM, bid = VBID;
  int it, step, end = ns + npr;
  if (G > ns) {
    if (bid < ns) { it = bid; step = end; }
    else { it = ns + (bid - ns); step = G - ns; }
  } else { it = bid; step = G; }
  for (; it < end; it += step) scan_item<KIND, DIR>(p, it, lds, dry);
}

__device__ __forceinline__ void scan_phase_ret_sample(const Params& p, unsigned char* lds, const bool dry) {
  const int G = VGDIM >> 1, bid = VBID;
  const int role = bid >= G;
  const int rb = role ? bid - G : bid;
  if (role == 0) { for (int it = rb; it < 256; it += G) scan_item<1, 0>(p, it, lds, dry); }
  else           { for (int it = rb; it < 256; it += G) scan_item<1, 1>(p, it, lds, dry); }
}
template <int DIR>
__device__ __forceinline__ void scan_phase_ret_prompt(const Params& p, unsigned char* lds, const bool dry) {
  for (int it = VBID; it < 1024; it += VGDIM) scan_item<1, DIR>(p, 256 + it, lds, dry);
}

__device__ __forceinline__ void scan_phase_hg_both(const Params& p, unsigned char* lds, const bool dry) {
  const int G = VGDIM >> 1, bid = VBID;
  const int role = bid >= G;
  const int rb = role ? bid - G : bid;
  int it, step;
  if (G > 128) {
    if (rb < 128) { it = rb; step = 1 << 20; } else { it = rb; step = G - 128; }
  } else { it = rb; step = G; }
  if (role == 0) { for (; it < 640; it += step) scan_item<2, 0>(p, it, lds, dry); }
  else           { for (; it < 640; it += step) scan_item<2, 1>(p, it, lds, dry); }
}

template <int KIND>
__device__ __forceinline__ void normgate_phase(const Params& p, const bool dry) {
  constexpr int NCH = KIND == 1 ? 4 : 2, DV = KIND == 1 ? 256 : 128, LD = KIND == 1 ? 2048 : 1024;
  const int tid = HTID, lane = tid & 63, w = tid >> 6;
  const int hh = lane >> 3, sub = lane & 7;
  bf16_t* R0 = (bf16_t*)p.ws;
  bf16_t* Ob = R0 + (KIND == 1 ? 4 * PLANE_E : 5 * PLANE_E) + hh * DV + sub * 8;
  const bf16_t* Gb = R0 + (KIND == 1 ? 0 : 4 * PLANE_E) + hh * DV + sub * 8;
  float gn[NCH][8];
#pragma unroll
  for (int j = 0; j < NCH; ++j)
#pragma unroll
    for (int i = 0; i < 8; ++i) gn[j][i] = (KIND == 1) ? 1.f : p.in[22][j * 64 + sub * 8 + i];
  for (int row = VBID * 4 + w; row < 24576; row += VGDIM * 4) {
    bf16_t* op = Ob + (size_t)row * LD;
    const bf16_t* gp = Gb + (size_t)row * LD;
    uint4 ov[NCH], gv[NCH];
#pragma unroll
    for (int j = 0; j < NCH; ++j) { ov[j] = *(const uint4*)(op + j * 64); gv[j] = *(const uint4*)(gp + j * 64); }
    if (KIND == 2 || row >= 8192) {
      const bf16_t* bp = (KIND == 2 ? hg_ob_row(p, row) : ret_ob_row(p, row - 8192)) + hh * DV + sub * 8;
#pragma unroll
      for (int j = 0; j < NCH; ++j) {
        const uint4 bv = *(const uint4*)(bp + j * 64);
        ov[j].x = pack2(lo_f(ov[j].x) + lo_f(bv.x), hi_f(ov[j].x) + hi_f(bv.x));
        ov[j].y = pack2(lo_f(ov[j].y) + lo_f(bv.y), hi_f(ov[j].y) + hi_f(bv.y));
        ov[j].z = pack2(lo_f(ov[j].z) + lo_f(bv.z), hi_f(ov[j].z) + hi_f(bv.z));
        ov[j].w = pack2(lo_f(ov[j].w) + lo_f(bv.w), hi_f(ov[j].w) + hi_f(bv.w));
      }
    }
    float ss = 0.f;
#pragma unroll
    for (int j = 0; j < NCH; ++j) {
      const unsigned wv[4] = {ov[j].x, ov[j].y, ov[j].z, ov[j].w};
#pragma unroll
      for (int i = 0; i < 4; ++i) { const float a = lo_f(wv[i]), b2 = hi_f(wv[i]); ss += a * a + b2 * b2; }
    }
    ss += __shfl_xor(ss, 1);
    ss += __shfl_xor(ss, 2);
    ss += __shfl_xor(ss, 4);
    const float rs = rsqrtf(ss * (1.f / (float)DV) + 1e-6f);
#pragma unroll
    for (int j = 0; j < NCH; ++j) {
      const unsigned wv[4] = {ov[j].x, ov[j].y, ov[j].z, ov[j].w};
      const unsigned gw[4] = {gv[j].x, gv[j].y, gv[j].z, gv[j].w};
      unsigned r[4];
#pragma unroll
      for (int i = 0; i < 4; ++i)
        r[i] = pack2(lo_f(wv[i]) * rs * gn[j][2 * i] * lo_f(gw[i]), hi_f(wv[i]) * rs * gn[j][2 * i + 1] * hi_f(gw[i]));
      if (!dry) *(uint4*)(op + j * 64) = make_uint4(r[0], r[1], r[2], r[3]);
    }
  }
}

__device__ __forceinline__ void opaque_params(Params& q) {
  asm volatile("" : "+s"(q.out), "+s"(q.ws));
#pragma unroll
  for (int i = 0; i < 23; ++i) asm volatile("" : "+s"(q.in[i]));
}

struct BarState { unsigned* base; unsigned xcd, mycnt, nact, esub, etop; };
__device__ __forceinline__ void grid_barrier(BarState& b) {
  asm volatile("s_waitcnt vmcnt(0) lgkmcnt(0)" ::: "memory");
  __syncthreads();
  if (threadIdx.x == 0) {
    b.esub += b.mycnt; b.etop += b.nact;
    const unsigned old = __hip_atomic_fetch_add(b.base + 64 * b.xcd, 1u, __ATOMIC_RELAXED, __HIP_MEMORY_SCOPE_AGENT);
    if (old + 1u == b.esub) {
      __builtin_amdgcn_fence(__ATOMIC_RELEASE, "agent");
      __hip_atomic_fetch_add(b.base + 512, 1u, __ATOMIC_RELAXED, __HIP_MEMORY_SCOPE_AGENT);
    }
    while (__hip_atomic_load(b.base + 512, __ATOMIC_RELAXED, __HIP_MEMORY_SCOPE_AGENT) < b.etop) __builtin_amdgcn_s_sleep(1);
    __builtin_amdgcn_fence(__ATOMIC_ACQUIRE, "agent");
  }
  __syncthreads();
}
__device__ __forceinline__ void bar_census_post(BarState& b) {
  if (threadIdx.x == 0) __hip_atomic_fetch_add(b.base + 1024 + 64 * b.xcd, 1u, __ATOMIC_RELAXED, __HIP_MEMORY_SCOPE_AGENT);
}
__device__ __forceinline__ void bar_census_read(BarState& b) {
  if (threadIdx.x == 0) {
    unsigned n = 0;
    for (unsigned j = 0; j < 8; ++j) {
      const unsigned c = __hip_atomic_load(b.base + 1024 + 64 * j, __ATOMIC_RELAXED, __HIP_MEMORY_SCOPE_AGENT);
      n += (c != 0u);
      if (j == b.xcd) b.mycnt = c;
    }
    b.nact = n;
  }
}
#define GSYNC(n) { if ((n) == 0) { grid.sync(); bar_census_read(bst); } else grid_barrier(bst); }

#if defined(PH_ONLY)
#define PHASE(n, call) if (n == PH_ONLY) { const bool dry = false; call; }
#elif defined(REP_N)
#define PHASE(n, call) if (lo <= n && n < hi) { for (int rep = (n == REP_N ? 0 : 1); rep < 2; ++rep) { const bool dry = (rep == 0); call; if (!(fin && n + 1 == hi && rep == 1)) GSYNC(n) } }
#else
#define PHASE(n, call) if (lo <= n && n < hi) { const bool dry = false; call; if (!(fin && n + 1 == hi)) GSYNC(n) }
#endif

__device__ __forceinline__ void run_range(const Params& q, int lo, int hi, bool fin, cg::grid_group& grid, unsigned char* lds) {
  unsigned char* ldh = lds + HALFID * HALF_LDS;
  BarState bst; bst.base = (unsigned*)(q.ws + OFF_MISC + MISC_CTR); bst.xcd = xcc_id(); bst.mycnt = 0; bst.nact = 0; bst.esub = 0; bst.etop = 0;
  if (lo == 0) bar_census_post(bst);
  PHASE(0, phase0(q, ldh))
  PHASE(1, post_phase(q, -1, 0, ldh, dry))
  PHASE(2, gemm_phase(q, 0, GM_IN_DA, lds, 2))
  PHASE(3, attn_phase(q, 0, lds, dry, 3))
  PHASE(4, gemm_phase(q, 0, GM_OUT, lds, 4))
  PHASE(5, post_phase(q, 0, 1, ldh, dry))
  PHASE(6, gemm_phase(q, 1, GM_IN_RET_QKV, lds, 6))
  PHASE(7, scan_phase_ret_sample(q, ldh, dry))
  PHASE(8, scan_phase_ret_prompt<0>(q, ldh, dry))
  PHASE(8, scan_phase_ret_prompt<1>(q, ldh, dry))
  PHASE(9, gemm_phase(q, 1, GM_IN_RET_G, lds, 9))
  PHASE(10, normgate_phase<1>(q, dry))
  PHASE(11, gemm_phase(q, 1, GM_OUT, lds, 11))
  PHASE(12, post_phase(q, 1, 2, ldh, dry))
  PHASE(13, gemm_phase(q, 2, GM_IN_HG, lds, 13))
  PHASE(14, scan_phase_hg_both(q, ldh, dry))
  PHASE(16, normgate_phase<2>(q, dry))
  PHASE(17, gemm_phase(q, 2, GM_OUT, lds, 17))
  PHASE(18, post_phase(q, 2, 3, ldh, dry))
  PHASE(19, gemm_phase(q, 3, GM_IN_DA, lds, 19))
  PHASE(20, attn_phase(q, 3, lds, dry, 20))
  PHASE(21, gemm_phase(q, 3, GM_OUT, lds, 21))
  PHASE(22, post_phase(q, 3, 4, ldh, dry))
}

__global__ void __launch_bounds__(NTHR, 2) mega_fwd(Params p) {
  extern __shared__ __attribute__((aligned(16))) unsigned char lds[];
  cg::grid_group grid = cg::this_grid();
  run_range(p, p.ph_lo, p.ph_hi, true, grid, lds);
}

extern "C" void kernel_launch(void* const* d_in, const int* in_sizes, int n_in, void* d_out, int out_size, void* d_ws, size_t ws_size, hipStream_t stream) {
  static int grid_blocks = 0;
  if (grid_blocks == 0) {
    int dev = 0, cus = 0, per_cu = 0;
    hipGetDevice(&dev);
    hipDeviceGetAttribute(&cus, hipDeviceAttributeMultiprocessorCount, dev);
    hipFuncSetAttribute((const void*)mega_fwd, hipFuncAttributeMaxDynamicSharedMemorySize, LDS_BYTES);
    hipOccupancyMaxActiveBlocksPerMultiprocessor(&per_cu, (const void*)mega_fwd, NTHR, LDS_BYTES);
    if (per_cu < 1) per_cu = 1;
    if (per_cu > 1) per_cu = 1;
    if (cus < 1) cus = 256;
    grid_blocks = cus * per_cu;
    (void)hipGetLastError();
    if (n_in != 23 || ws_size < WS_NEED) { fprintf(stderr, "kernel_launch: unexpected n_in %d / ws_size %zu (need %zu)\n", n_in, ws_size, (size_t)WS_NEED); }
  }
  hipMemsetAsync((unsigned char*)d_ws + OFF_MISC + MISC_CTR, 0, 8192, stream);
  Params p{};
  for (int i = 0; i < 23; ++i) p.in[i] = (const float*)d_in[i];
  p.out = (float*)d_out;
  p.ws = (unsigned char*)d_ws;
#if ONE_LAUNCH
  p.ph_lo = 0; p.ph_hi = NPH;
  void* args[] = {&p};
  hipError_t e = hipLaunchCooperativeKernel((const void*)mega_fwd, dim3(grid_blocks), dim3(NTHR), args, LDS_BYTES, stream);
  if (e != hipSuccess) fprintf(stderr, "cooperative launch failed: %s (grid %d)\n", hipGetErrorString(e), grid_blocks);
#else
  for (int ph = 0; ph < NPH; ++ph) {
    p.ph_lo = ph; p.ph_hi = ph + 1;
    hipLaunchKernelGGL(mega_fwd, dim3(grid_blocks), dim3(NTHR), LDS_BYTES, stream, p);
  }
#endif
}
```

```cpp
#include <hip/hip_runtime.h>
#include <hip/hip_cooperative_groups.h>
#include <cstdint>
#include <cstdio>
namespace cg = cooperative_groups;

#ifndef ONE_LAUNCH
#define ONE_LAUNCH 1
#endif

typedef unsigned short bf16_t;
typedef short bf16x8 __attribute__((ext_vector_type(8)));
typedef float f32x4 __attribute__((ext_vector_type(4)));

#define NTHR 512
#define HTID ((int)(threadIdx.x & 255))
#define HALFID ((int)(threadIdx.x >> 8))
#define VBID ((int)(blockIdx.x * 2 + (threadIdx.x >> 8)))
#define VGDIM ((int)(gridDim.x * 2))
#define HALF_LDS 74816
#define MIB ((size_t)1 << 20)
#define NPH 23
#define LDS_BYTES (2 * HALF_LDS)
#define LDS_SLOT 74752
#define MISC_LB (MISC_ROPE + 524288 + 16384)
#define MISC_CTR (MISC_ROPE + 524288)

#define OFF_WIN  (288 * MIB)
#define OFF_WOUT (300 * MIB)
#define OFF_HP   (304 * MIB)
#define OFF_MISC (320 * MIB)
#define MISC_ROPE 524288
#define WS_NEED  (322 * MIB)
#define PLANE_E  ((size_t)25165824)
#define OUT_YP 0
#define OUT_YS 8388608
#define OUT_CK 25165824
#define OUT_CV 41943040
#define OUT_SR 58720256
#define OUT_SH 75497472

struct Params {
  const float* in[23];
  float* out;
  unsigned char* ws;
  int ph_lo, ph_hi;
};

struct LayerInfo { int kind, slot, IN, WIDTH; const float* w_in; const float* w_out; };

__device__ __forceinline__ LayerInfo layer_info(const Params& p, int l) {
  LayerInfo L;
  if (l == 0)      { L.kind = 0; L.slot = 0; L.IN = 4096; L.WIDTH = 1024; L.w_in = p.in[12]; L.w_out = p.in[13]; }
  else if (l == 1) { L.kind = 1; L.slot = 0; L.IN = 6144; L.WIDTH = 2048; L.w_in = p.in[16]; L.w_out = p.in[17]; }
  else if (l == 2) { L.kind = 2; L.slot = 0; L.IN = 5120; L.WIDTH = 1024; L.w_in = p.in[19]; L.w_out = p.in[20]; }
  else             { L.kind = 0; L.slot = 1; L.IN = 4096; L.WIDTH = 1024; L.w_in = p.in[12] + (size_t)1024 * 4096; L.w_out = p.in[13] + (size_t)1024 * 1024; }
  return L;
}
__device__ __forceinline__ bf16_t* hs_ptr(const Params& p, int l) {
  return l < 3 ? (bf16_t*)(p.out + OUT_SH) : (bf16_t*)(p.ws + 240 * MIB);
}

typedef __bf16 nbf16x2 __attribute__((ext_vector_type(2)));
typedef float f32x2 __attribute__((ext_vector_type(2)));
__device__ __forceinline__ float bf2f(unsigned h) { return __uint_as_float(h << 16); }
__device__ __forceinline__ unsigned pack2(float a, float b) { const f32x2 f = {a, b}; return __builtin_bit_cast(unsigned, __builtin_convertvector(f, nbf16x2)); }
__device__ __forceinline__ float lo_f(unsigned w) { return __uint_as_float(w << 16); }
__device__ __forceinline__ float hi_f(unsigned w) { return __uint_as_float(w & 0xffff0000u); }
__device__ __forceinline__ float silu_f(float x) { return x / (1.f + __expf(-x)); }
__device__ __forceinline__ float wave_sum(float v) {
#pragma unroll
  for (int o = 32; o > 0; o >>= 1) v += __shfl_xor(v, o);
  return v;
}
#define QSCALE 0.18033688011112042f
#define SB __builtin_amdgcn_sched_barrier(0)
#define MFMA(a, b, c) __builtin_amdgcn_mfma_f32_16x16x32_bf16((a), (b), (c), 0, 0, 0)

__device__ __forceinline__ void convT_tile(const float* __restrict__ src, int src_ld, bf16_t* __restrict__ dst, int dst_ld, unsigned char* lds) {
  float* t = (float*)lds;
  const int tid = HTID;
  const int kr = tid >> 4, nc = (tid & 15) * 4;
#pragma unroll
  for (int j = 0; j < 4; ++j) {
    const float4 v = *(const float4*)(src + (size_t)(kr + 16 * j) * src_ld + nc);
    float* tp = t + (kr + 16 * j) * 65 + nc;
    tp[0] = v.x; tp[1] = v.y; tp[2] = v.z; tp[3] = v.w;
  }
  __syncthreads();
  const int n = tid >> 2, kc = (tid & 3) * 16;
  unsigned w[8];
#pragma unroll
  for (int i = 0; i < 8; ++i) w[i] = pack2(t[(kc + 2 * i) * 65 + n], t[(kc + 2 * i + 1) * 65 + n]);
  uint4* d = (uint4*)(dst + (size_t)n * dst_ld + kc);
  d[0] = make_uint4(w[0], w[1], w[2], w[3]);
  d[1] = make_uint4(w[4], w[5], w[6], w[7]);
  __syncthreads();
}

__device__ __forceinline__ int conv_weights_count(const Params& p, int l) {
  const LayerInfo L = layer_info(p, l);
  return (L.IN / 64) * 16 + (L.WIDTH / 64) * 16;
}
__device__ __forceinline__ void conv_weights_item(const Params& p, int l, int it, unsigned char* lds) {
  const LayerInfo L = layer_info(p, l);
  const int nin = (L.IN / 64) * 16;
  if (it < nin) {
    const int kt = it & 15, nt = it >> 4;
    convT_tile(L.w_in + (size_t)(kt * 64) * L.IN + nt * 64, L.IN, (bf16_t*)(p.ws + OFF_WIN) + (size_t)(nt * 64) * 1024 + kt * 64, 1024, lds);
  } else {
    const int it2 = it - nin, nkt = L.WIDTH / 64;
    const int kt = it2 % nkt, nt = it2 / nkt;
    convT_tile(L.w_out + (size_t)(kt * 64) * 1024 + nt * 64, 1024, (bf16_t*)(p.ws + OFF_WOUT) + (size_t)(nt * 64) * L.WIDTH + kt * 64, L.WIDTH, lds);
  }
}

__device__ __forceinline__ void mod_item(const Params& p, int it, unsigned char* lds) {
  float* ssilu = (float*)lds;
  float* red = ssilu + 9 * 1024;
  const int tid = HTID;
  const int l = it / 48, col0 = (it % 48) * 64;
  for (int i = tid; i < 9 * 1024; i += 256) {
    const int v = i >> 10, k = i & 1023;
    const float x = (v == 0) ? p.in[7][k] : p.in[6][(v - 1) * 1024 + k];
    ssilu[i] = silu_f(x);
  }
  __syncthreads();
  const int col = tid & 63, kq = tid >> 6;
  const float* w = p.in[8] + (size_t)l * 1024 * 3072 + col0 + col;
  float acc[9];
#pragma unroll
  for (int v = 0; v < 9; ++v) acc[v] = 0.f;
  for (int k = kq * 256; k < kq * 256 + 256; ++k) {
    const float wv = w[(size_t)k * 3072];
#pragma unroll
    for (int v = 0; v < 9; ++v) acc[v] += ssilu[v * 1024 + k] * wv;
  }
#pragma unroll
  for (int v = 0; v < 9; ++v) red[(kq * 9 + v) * 64 + col] = acc[v];
  __syncthreads();
  float* mod = (float*)(p.ws + OFF_MISC);
  for (int i = tid; i < 9 * 64; i += 256) {
    const int v = i >> 6, cc = i & 63;
    const float s = red[(0 * 9 + v) * 64 + cc] + red[(1 * 9 + v) * 64 + cc] + red[(2 * 9 + v) * 64 + cc] + red[(3 * 9 + v) * 64 + cc];
    mod[(size_t)(l * 9 + v) * 3072 + col0 + cc] = s + p.in[9][l * 3072 + col0 + cc];
  }
  __syncthreads();
}

__device__ __forceinline__ void rope_item(const Params& p, int it) {
  const int idx = it * 256 + HTID;
  const int t = idx >> 5, pp = idx & 31;
  const int pos = pp < 16 ? (t >> 6) : (t & 63);
  const float inv = exp2f(-(float)(pp & 15) * (13.287712379549449f / 16.f));
  const float ang = (float)pos * inv;
  const double a = (double)ang;
  const double r = a - 6.283185307179586 * rint(a * 0.15915494309189535);
  const float rf = (float)r;
  float2* tab = (float2*)(p.ws + OFF_MISC + MISC_ROPE);
  tab[idx] = make_float2(__cosf(rf), __sinf(rf));
  if (it < 8) {
    const int e = it * 256 + HTID;
    const float* lbp = p.in[21] + (e >> 10) * 4096 + (e & 1023);
    const float x0 = lbp[0], x1 = lbp[1024], x2 = lbp[2048], x3 = lbp[3072];
    const float m = fmaxf(fmaxf(x0, x1), fmaxf(x2, x3));
    const float e0 = expf(x0 - m), e1 = expf(x1 - m), e2 = expf(x2 - m), e3 = expf(x3 - m);
    ((float*)(p.ws + OFF_MISC + MISC_LB))[e] = (e1 + e2) / (e0 + e1 + e2 + e3);
  }
}

__device__ __forceinline__ void phase0(const Params& p, unsigned char* lds) {
  const int nw = conv_weights_count(p, 0);
  const int total = 192 + 256 + nw;
  for (int it = VBID; it < total; it += VGDIM) {
    if (it < 192) mod_item(p, it, lds);
    else if (it < 448) rope_item(p, it - 192);
    else conv_weights_item(p, 0, it - 448, lds);
  }
}

__device__ __forceinline__ void post_phase(const Params& p, int lprev, int lnext, unsigned char* lds, const bool dry) {
  const int tid = HTID, lane = tid & 63, w = tid >> 6;
  const float* mod = (const float*)(p.ws + OFF_MISC);
  const bf16_t* Y = nullptr;
  if (lprev >= 0) {
    const int kind = layer_info(p, lprev).kind;
    Y = (const bf16_t*)(p.ws + (kind == 1 ? 96 * MIB : 0));
  }
  bf16_t* hp = (bf16_t*)(p.ws + OFF_HP);
  bf16_t* hs = lnext < 4 ? hs_ptr(p, lnext) : nullptr;
  for (int row = VBID * 4 + w; row < 24576; row += VGDIM * 4) {
    const int mv = row < 8192 ? 0 : 1 + ((row - 8192) >> 11);
    const float* xs = (lprev <= 0) ? (row < 8192 ? p.in[0] + (size_t)row * 1024 : p.in[1] + (size_t)(row - 8192) * 1024) : p.out + (size_t)row * 1024;
    float4 x[4];
#pragma unroll
    for (int j = 0; j < 4; ++j) x[j] = *(const float4*)(xs + lane * 4 + 256 * j);
    if (lprev >= 0) {
      float4 y[4];
      float ss = 0.f;
#pragma unroll
      for (int j = 0; j < 4; ++j) { const uint2 yw = *(const uint2*)(Y + (size_t)row * 1024 + lane * 4 + 256 * j); y[j] = make_float4(lo_f(yw.x), hi_f(yw.x), lo_f(yw.y), hi_f(yw.y)); ss += y[j].x * y[j].x + y[j].y * y[j].y + y[j].z * y[j].z + y[j].w * y[j].w; }
      ss = wave_sum(ss);
      const float rstd = rsqrtf(ss * (1.f / 1024.f) + 1e-6f);
      const float* ga = mod + (size_t)(lprev * 9 + mv) * 3072 + 2048;
      const float* gp = p.in[11] + lprev * 1024;
#pragma unroll
      for (int j = 0; j < 4; ++j) {
        const int c = lane * 4 + 256 * j;
        const float4 g4 = *(const float4*)(ga + c), p4 = *(const float4*)(gp + c);
        x[j].x += g4.x * (y[j].x * rstd * p4.x); x[j].y += g4.y * (y[j].y * rstd * p4.y);
        x[j].z += g4.z * (y[j].z * rstd * p4.z); x[j].w += g4.w * (y[j].w * rstd * p4.w);
        if (!dry) *(float4*)(p.out + (size_t)row * 1024 + c) = x[j];
      }
    }
    if (lnext < 4) {
      float ss = 0.f;
#pragma unroll
      for (int j = 0; j < 4; ++j) ss += x[j].x * x[j].x + x[j].y * x[j].y + x[j].z * x[j].z + x[j].w * x[j].w;
      ss = wave_sum(ss);
      const float rstd = rsqrtf(ss * (1.f / 1024.f) + 1e-6f);
      const float* sh = mod + (size_t)(lnext * 9 + mv) * 3072;
      const float* sc = sh + 1024;
      const float* gp = p.in[10] + lnext * 1024;
      bf16_t* hd = row < 8192 ? hp + (size_t)row * 1024 : hs + (size_t)(row - 8192) * 1024;
#pragma unroll
      for (int j = 0; j < 4; ++j) {
        const int c = lane * 4 + 256 * j;
        const float4 s4 = *(const float4*)(sh + c), c4 = *(const float4*)(sc + c), p4 = *(const float4*)(gp + c);
        const float h0 = x[j].x * rstd * p4.x * (1.f + c4.x) + s4.x, h1 = x[j].y * rstd * p4.y * (1.f + c4.y) + s4.y;
        const float h2 = x[j].z * rstd * p4.z * (1.f + c4.z) + s4.z, h3 = x[j].w * rstd * p4.w * (1.f + c4.w) + s4.w;
        *(uint2*)(hd + c) = make_uint2(pack2(h0, h1), pack2(h2, h3));
      }
    }
  }
  if (lprev >= 0 && lnext < 4) {
    const int nw = conv_weights_count(p, lnext);
    for (int it = VBID; it < nw; it += VGDIM) conv_weights_item(p, lnext, it, lds);
  }
}


__device__ __forceinline__ unsigned xcc_id() { return (unsigned)__builtin_amdgcn_s_getreg((3 << 11) | 20) & 7u; }
#define LAS __attribute__((address_space(3)))
template <bool SWAP>
__device__ __forceinline__ void gemm_tile_compute(const bf16_t* __restrict__ Ag, const bf16_t* __restrict__ Bg, int K, unsigned char* lds, f32x4 (&acc)[8][4],
                                                  const bool pre, const bf16_t* __restrict__ An, const bf16_t* __restrict__ Bn, const bool hasn) {
  const int tid = threadIdx.x, lane = tid & 63, wid = __builtin_amdgcn_readfirstlane(tid >> 6), wm = wid >> 2, wn = wid & 3;
  const int lr = lane & 15, lg = lane >> 4;
  LAS unsigned char* l3 = (LAS unsigned char*)lds;
  const int prow = lane >> 3;
  const int pgo0 = prow * K + (((lane & 7) ^ ((prow >> 1) & 7)) << 3);
  const int pgo1 = prow * K + (((lane & 7) ^ ((4 + (prow >> 1)) & 7)) << 3);
  const bf16_t* asrc = Ag + (size_t)(wid * 32) * K;
  const bf16_t* bsrc = Bg + (size_t)(wid * 32) * K;
  const size_t pstep = (size_t)8 * K;
#pragma unroll
  for (int mi = 0; mi < 8; ++mi)
#pragma unroll
    for (int ni = 0; ni < 4; ++ni) acc[mi][ni] = (f32x4){0.f, 0.f, 0.f, 0.f};
#define GEMM_STAGE_P(ap_, bp_, s, k0)                                                                                                      \
  {                                                                                                                                        \
    _Pragma("unroll") for (int j = 0; j < 4; ++j) {                                                                                        \
      __builtin_amdgcn_global_load_lds((const unsigned*)((ap_) + j * pstep + ((j & 1) ? pgo1 : pgo0) + (k0)), (LAS unsigned*)(l3 + (s) * 65536 + (wid * 4 + j) * 1024), 16, 0, 0);          \
      __builtin_amdgcn_global_load_lds((const unsigned*)((bp_) + j * pstep + ((j & 1) ? pgo1 : pgo0) + (k0)), (LAS unsigned*)(l3 + (s) * 65536 + 32768 + (wid * 4 + j) * 1024), 16, 0, 0);  \
    }                                                                                                                                      \
  }
#define GEMM_STAGE(s, k0) GEMM_STAGE_P(asrc, bsrc, s, k0)
  const int nk = K >> 6;
  if (!pre) GEMM_STAGE(0, 0);
  asm volatile("s_waitcnt vmcnt(0)" ::: "memory");
  __syncthreads();
  const int x0 = lg ^ ((lr >> 1) & 7);
  const int aoff0 = (wm * 128 + lr) * 128 + x0 * 16, aoff1 = (wm * 128 + lr) * 128 + (x0 ^ 4) * 16;
  const int boff0 = 32768 + (wn * 64 + lr) * 128 + x0 * 16, boff1 = 32768 + (wn * 64 + lr) * 128 + (x0 ^ 4) * 16;
  for (int kt = 0; kt < nk; ++kt) {
    if (kt + 1 < nk) GEMM_STAGE((kt + 1) & 1, (kt + 1) * 64);
    const unsigned char* st = lds + (kt & 1) * 65536;
#pragma unroll
    for (int kk = 0; kk < 2; ++kk) {
      bf16x8 af[8], bfr[4];
#pragma unroll
      for (int ni = 0; ni < 4; ++ni) bfr[ni] = *(const bf16x8*)(st + (kk ? boff1 : boff0) + ni * 2048);
#pragma unroll
      for (int mi = 0; mi < 8; ++mi) af[mi] = *(const bf16x8*)(st + (kk ? aoff1 : aoff0) + mi * 2048);
#pragma unroll
      for (int mi = 0; mi < 8; ++mi)
#pragma unroll
        for (int ni = 0; ni < 4; ++ni)
          acc[mi][ni] = SWAP ? MFMA(bfr[ni], af[mi], acc[mi][ni]) : MFMA(af[mi], bfr[ni], acc[mi][ni]);
    }
    asm volatile("s_waitcnt vmcnt(0)" ::: "memory");
    __syncthreads();
  }
  if (hasn) { const bf16_t* an_ = An + (size_t)(wid * 32) * K; const bf16_t* bn_ = Bn + (size_t)(wid * 32) * K; GEMM_STAGE_P(an_, bn_, 0, 0); }
#undef GEMM_STAGE
#undef GEMM_STAGE_P
}

enum { GM_IN_DA = 0, GM_IN_RET_QKV = 1, GM_IN_RET_G = 2, GM_IN_HG = 3, GM_OUT = 4 };

__device__ __forceinline__ void epi_swapped(const Params& p, int mode, int slot, int ykind, int m, int n, f32x4 v) {
  bf16_t* R0 = (bf16_t*)p.ws;
  if (mode == GM_OUT) {
    bf16_t* Y = (bf16_t*)(p.ws + (ykind == 1 ? 96 * MIB : 0));
    *(uint2*)(Y + (size_t)m * 1024 + n) = make_uint2(pack2(v[0], v[1]), pack2(v[2], v[3]));
  } else if (mode == GM_IN_DA) {
    const bool smp = m >= 8192;
    const int ms = m - 8192;
    const int b = smp ? (ms >> 11) : (m >> 8), t = smp ? (ms & 2047) : (m & 255);
    if (n < 2048) {
      if (smp) {
        const float4 cs = *(const float4*)((const float*)(p.ws + OFF_MISC + MISC_ROPE) + (size_t)(t * 32 + ((n & 63) >> 1)) * 2);
        const float a0 = v[0] * cs.x - v[1] * cs.y, a1 = v[0] * cs.y + v[1] * cs.x;
        const float a2 = v[2] * cs.z - v[3] * cs.w, a3 = v[2] * cs.w + v[3] * cs.z;
        v = (f32x4){a0, a1, a2, a3};
      }
      if (n < 1024) {
        *(uint2*)(R0 + (size_t)m * 1024 + n) = make_uint2(pack2(v[0] * QSCALE, v[1] * QSCALE), pack2(v[2] * QSCALE, v[3] * QSCALE));
      } else {
        const int c = n - 1024;
        const uint2 pk = make_uint2(pack2(v[0], v[1]), pack2(v[2], v[3]));
        if (smp) {
          *(uint2*)(R0 + 64 * MIB / 2 + ((size_t)b * 2560 + t) * 1024 + c) = pk;
        } else {
          *(f32x4*)(p.out + OUT_CK + ((size_t)((b * 2 + slot) * 256 + t)) * 1024 + c) = v;
          *(uint2*)(R0 + 48 * MIB / 2 + (size_t)m * 1024 + c) = pk;
        }
      }
    } else {
      *(uint2*)(R0 + 160 * MIB / 2 + (size_t)m * 1024 + (n - 3072)) = make_uint2(pack2(silu_f(v[0]), silu_f(v[1])), pack2(silu_f(v[2]), silu_f(v[3])));
    }
  } else if (mode == GM_IN_RET_QKV) {
    if (n < 1024) *(uint2*)(R0 + (size_t)m * 1024 + n) = make_uint2(pack2(v[0], v[1]), pack2(v[2], v[3]));
    else if (n < 2048) { const float s = 0.08838834764831845f; *(uint2*)(R0 + PLANE_E + (size_t)m * 1024 + (n - 1024)) = make_uint2(pack2(v[0] * s, v[1] * s), pack2(v[2] * s, v[3] * s)); }
    else *(uint2*)(R0 + 2 * PLANE_E + (size_t)m * 2048 + (n - 2048)) = make_uint2(pack2(v[0], v[1]), pack2(v[2], v[3]));
  } else if (mode == GM_IN_RET_G) {
    *(uint2*)(R0 + (size_t)m * 2048 + n) = make_uint2(pack2(silu_f(v[0]), silu_f(v[1])), pack2(silu_f(v[2]), silu_f(v[3])));
  } else {
    if (n < 1024 || n >= 4096) v = (f32x4){silu_f(v[0]), silu_f(v[1]), silu_f(v[2]), silu_f(v[3])};
    else if (n < 3072) {
      const float4 lb = *(const float4*)((const float*)(p.ws + OFF_MISC + MISC_LB) + (n - 1024));
      v = (f32x4){__log2f(lb.x + (1.f - lb.x) / (1.f + __expf(-v[0]))), __log2f(lb.y + (1.f - lb.y) / (1.f + __expf(-v[1]))),
                  __log2f(lb.z + (1.f - lb.z) / (1.f + __expf(-v[2]))), __log2f(lb.w + (1.f - lb.w) / (1.f + __expf(-v[3])))};
    }
    *(uint2*)(R0 + (size_t)(n >> 10) * PLANE_E + (size_t)m * 1024 + (n & 1023)) = make_uint2(pack2(v[0], v[1]), pack2(v[2], v[3]));
  }
}

__device__ __forceinline__ void epi_da_v(const Params& p, int slot, int m, int n, f32x4 v) {
  bf16_t* R0 = (bf16_t*)p.ws;
  const int c = n - 2048, hh = c >> 7, e = c & 127;
  const uint2 pk = make_uint2(pack2(v[0], v[1]), pack2(v[2], v[3]));
  if (m >= 8192) {
    const int ms = m - 8192, b = ms >> 11, t = ms & 2047;
    *(uint2*)(R0 + 120 * MIB / 2 + ((size_t)((b * 8 + hh) * 128 + e)) * 2560 + t) = pk;
  } else {
    const int b = m >> 8, t = m & 255;
    float* o = p.out + OUT_CV + ((size_t)((b * 2 + slot) * 256 + t)) * 1024 + c;
    o[0] = v[0]; o[1024] = v[1]; o[2048] = v[2]; o[3072] = v[3];
    *(uint2*)(R0 + 104 * MIB / 2 + ((size_t)((b * 8 + hh) * 128 + e)) * 256 + t) = pk;
  }
}

__device__ __forceinline__ void gemm_phase(const Params& p, int l, int mode, unsigned char* lds, int phid) {
  const LayerInfo L = layer_info(p, l);
  bf16_t* R0 = (bf16_t*)p.ws;
  const bf16_t *Ap, *As, *Bt;
  int K, N;
  if (mode == GM_OUT) {
    K = L.WIDTH; N = 1024; Bt = (const bf16_t*)(p.ws + OFF_WOUT);
    const bf16_t* base = R0 + (L.kind == 0 ? 160 * MIB / 2 : (L.kind == 1 ? 4 * PLANE_E : 5 * PLANE_E));
    Ap = base; As = base + (size_t)8192 * K;
  } else {
    K = 1024; Ap = (const bf16_t*)(p.ws + OFF_HP); As = hs_ptr(p, l);
    Bt = (const bf16_t*)(p.ws + OFF_WIN) + (mode == GM_IN_RET_G ? (size_t)4096 * 1024 : 0);
    N = (mode == GM_IN_DA || mode == GM_IN_RET_QKV) ? 4096 : (mode == GM_IN_RET_G ? 2048 : 5120);
  }
  const int ntn = N >> 8, ntiles = 96 * ntn;
  const int extra = (mode == GM_IN_DA) ? 3072 : 0;
  const int tid = threadIdx.x, lane = tid & 63, wid = tid >> 6, wm = wid >> 2, wn = wid & 3, lr = lane & 15, lg = lane >> 4;
  const int G = gridDim.x;
  const bool swz = (G & 7) == 0;
  const int xcd = blockIdx.x & 7, snn = ntn >> 2, nst = 12 * snn;
  const int q0 = swz ? (int)(blockIdx.x >> 3) : (int)blockIdx.x, qstep = swz ? (G >> 3) : G;
  const int qlen = swz ? 32 * ((nst - xcd + 7) >> 3) : ntiles;
#define GEMM_TILE_OF(qq, m0_, n0_)                                                   \
  {                                                                                    \
    int it_ = (qq);                                                                    \
    if (swz) {                                                                         \
      const int st_ = xcd + 8 * ((qq) >> 5), tin_ = (qq) & 31;                         \
      const int smt_ = st_ / snn, snt_ = st_ - smt_ * snn;                             \
      it_ = (smt_ * 8 + (tin_ >> 2)) * ntn + snt_ * 4 + (tin_ & 3);                    \
    }                                                                                  \
    const int mt_ = it_ / ntn;                                                         \
    m0_ = mt_ * 256; n0_ = (it_ - mt_ * ntn) * 256;                                    \
  }
  bool pre = false;
  for (int q = q0; q < qlen; q += qstep) {
    int m0, n0;
    GEMM_TILE_OF(q, m0, n0)
    const bf16_t* A = m0 < 8192 ? Ap + (size_t)m0 * K : As + (size_t)(m0 - 8192) * K;
    const bf16_t* B = Bt + (size_t)n0 * K;
    const bool hasn = q + qstep < qlen;
    const bf16_t *An = A, *Bn = B;
    if (hasn) {
      int m1, n1;
      GEMM_TILE_OF(q + qstep, m1, n1)
      An = m1 < 8192 ? Ap + (size_t)m1 * K : As + (size_t)(m1 - 8192) * K;
      Bn = Bt + (size_t)n1 * K;
    }
    {
      f32x4 acc[8][4];
      if (mode == GM_IN_DA && n0 >= 2048 && n0 < 3072) {
        gemm_tile_compute<false>(A, B, K, lds, acc, pre, An, Bn, hasn);
#pragma unroll
        for (int mi = 0; mi < 8; ++mi)
#pragma unroll
          for (int ni = 0; ni < 4; ++ni)
            epi_da_v(p, L.slot, m0 + wm * 128 + mi * 16 + 4 * lg, n0 + wn * 64 + ni * 16 + lr, acc[mi][ni]);
      } else {
        gemm_tile_compute<true>(A, B, K, lds, acc, pre, An, Bn, hasn);
#pragma unroll
        for (int mi = 0; mi < 8; ++mi)
#pragma unroll
          for (int ni = 0; ni < 4; ++ni)
            epi_swapped(p, mode, L.slot, L.kind, m0 + wm * 128 + mi * 16 + lr, n0 + wn * 64 + ni * 16 + 4 * lg, acc[mi][ni]);
      }
    }
    pre = hasn;
  }
#undef GEMM_TILE_OF
  if (extra) { asm volatile("s_waitcnt vmcnt(0)" ::: "memory"); __syncthreads(); }
  for (int ci = VBID; ci < extra; ci += VGDIM) {
    {
      if (ci < 2048) {
        const int idx = (ci * 256 + HTID) * 8;
        const int b = idx >> 19, rem = idx & 524287, tp = rem >> 10, c = rem & 1023;
        const float* src = p.in[2] + ((size_t)((b * 2 + L.slot) * 512 + tp)) * 1024 + c;
        const float4 u0 = *(const float4*)src, u1 = *(const float4*)(src + 4);
        *(uint4*)(R0 + 64 * MIB / 2 + ((size_t)b * 2560 + 2048 + tp) * 1024 + c) = make_uint4(pack2(u0.x, u0.y), pack2(u0.z, u0.w), pack2(u1.x, u1.y), pack2(u1.z, u1.w));
      } else {
        const int i2 = ci - 2048;
        const int b = i2 >> 7, hh = (i2 >> 4) & 7, tt = (i2 >> 1) & 7, et = i2 & 1;
        convT_tile(p.in[3] + ((size_t)((b * 2 + L.slot) * 512 + tt * 64)) * 1024 + hh * 128 + et * 64, 1024,
                   R0 + 120 * MIB / 2 + ((size_t)((b * 8 + hh) * 128 + et * 64)) * 2560 + 2048 + tt * 64, 2560, lds + HALFID * HALF_LDS);
      }
    }
  }
}

__device__ __forceinline__ void attn_phase(const Params& p, int l, unsigned char* lds, const bool dry, int phid) {
  const int slot = l == 3 ? 1 : 0;
  const float lam_init = 0.8f - 0.6f * expf(-0.3f * (float)l);
  const int tid = threadIdx.x, lane = tid & 63, w = tid >> 6, lr = lane & 15, lg = lane >> 4;
  float lam;
  {
    const float* lf = p.in[14] + slot * 256;
    const float a = wave_sum(lf[lane] * lf[64 + lane]);
    const float b2 = wave_sum(lf[128 + lane] * lf[192 + lane]);
    lam = expf(a) - expf(b2) + lam_init;
  }
  bf16_t* R0 = (bf16_t*)p.ws;
  const float* subg = p.in[15] + slot * 128;
  for (int item = blockIdx.x; item < 1536; item += gridDim.x) {
    int grp, b, h, qt;
    if (item < 1024) { grp = 1; b = item >> 7; h = (item >> 4) & 7; qt = item & 15; }
    else { const int i2 = item - 1024; grp = 0; b = i2 >> 4; h = (i2 >> 1) & 7; qt = i2 & 1; }
    const int nkeys = grp ? 2560 : 256, ntile = nkeys >> 7;
    const int mq = (grp ? 8192 + b * 2048 : b * 256) + qt * 128 + w * 16 + lr;
    const bf16_t* Kg = grp ? R0 + 64 * MIB / 2 + (size_t)b * 2560 * 1024 + h * 128 : R0 + 48 * MIB / 2 + (size_t)b * 256 * 1024 + h * 128;
    const bf16_t* Vg = grp ? R0 + 120 * MIB / 2 + (size_t)(b * 8 + h) * 128 * 2560 : R0 + 104 * MIB / 2 + (size_t)(b * 8 + h) * 128 * 256;
    bf16x8 qf[2][2];
#pragma unroll
    for (int sub = 0; sub < 2; ++sub)
#pragma unroll
      for (int ks = 0; ks < 2; ++ks) qf[sub][ks] = *(const bf16x8*)(R0 + (size_t)mq * 1024 + h * 128 + sub * 64 + ks * 32 + lg * 8);
    LAS unsigned char* l3 = (LAS unsigned char*)lds;
    const int wu = __builtin_amdgcn_readfirstlane(w);
    int koff[4], voff[4];
#pragma unroll
    for (int j = 0; j < 4; ++j) {
      const int kr = (wu * 4 + j) * 4 + (lane >> 4);
      koff[j] = kr * 1024 + (((lane & 15) ^ (kr & 15)) << 3);
      voff[j] = kr * nkeys + (((lane & 15) ^ (kr & 15)) << 3);
    }
#define ATT_STAGE_K(s, key0)                                                                                  \
  {                                                                                                           \
    _Pragma("unroll") for (int j = 0; j < 4; ++j)                                                             \
      __builtin_amdgcn_global_load_lds((const unsigned*)(Kg + (size_t)(key0) * 1024 + koff[j]), (LAS unsigned*)(l3 + (s) * 65536 + (wu * 4 + j) * 1024), 16, 0, 0); \
  }
#define ATT_STAGE_V(s, key0)                                                                                  \
  {                                                                                                           \
    _Pragma("unroll") for (int j = 0; j < 4; ++j)                                                             \
      __builtin_amdgcn_global_load_lds((const unsigned*)(Vg + (key0) + voff[j]), (LAS unsigned*)(l3 + (s) * 65536 + 32768 + (wu * 4 + j) * 1024), 16, 0, 0); \
  }
    const int xl = lg ^ lr;
    const int vsw = (lr >> 1) & 7;
    const int vlo = lr * 256 + ((((lg >> 1)) ^ lr) << 4) + (lg & 1) * 8;
    float mx[2] = {-1e30f, -1e30f}, ls[2] = {0.f, 0.f};
    f32x4 o0[8], o1[8];
#pragma unroll
    for (int et = 0; et < 8; ++et) { o0[et] = (f32x4){0.f, 0.f, 0.f, 0.f}; o1[et] = (f32x4){0.f, 0.f, 0.f, 0.f}; }
    ATT_STAGE_K(0, 0);
    ATT_STAGE_V(0, 0);
    asm volatile("s_waitcnt vmcnt(0)" ::: "memory");
    __syncthreads();
    for (int kt = 0; kt < ntile; ++kt) {
      if (kt + 1 < ntile) { ATT_STAGE_K((kt + 1) & 1, (kt + 1) * 128); ATT_STAGE_V((kt + 1) & 1, (kt + 1) * 128); }
      const unsigned char* ks_ = lds + (kt & 1) * 65536 + lr * 256;
      const unsigned char* vs_ = lds + (kt & 1) * 65536 + 32768;
#pragma unroll
      for (int k2 = 0; k2 < 4; ++k2) {
        bf16x8 kfr[8];
        uint2 vlo_[8], vhi_[8];
#pragma unroll
        for (int sub = 0; sub < 2; ++sub)
#pragma unroll
          for (int nn = 0; nn < 2; ++nn)
#pragma unroll
            for (int ks = 0; ks < 2; ++ks)
              kfr[sub * 4 + nn * 2 + ks] = *(const bf16x8*)(ks_ + (2 * k2 + nn) * 4096 + ((xl ^ (sub * 8 + ks * 4)) << 4));
#pragma unroll
        for (int et = 0; et < 8; ++et) {
          vlo_[et] = *(const uint2*)(vs_ + et * 4096 + (vlo ^ (k2 << 6)));
          vhi_[et] = *(const uint2*)(vs_ + et * 4096 + (vlo ^ (k2 << 6) ^ 32));
        }
        SB;
        f32x4 s[2][2];
#pragma unroll
        for (int sub = 0; sub < 2; ++sub)
#pragma unroll
          for (int nn = 0; nn < 2; ++nn) {
            s[sub][nn] = MFMA(kfr[sub * 4 + nn * 2], qf[sub][0], ((f32x4){0.f, 0.f, 0.f, 0.f}));
            s[sub][nn] = MFMA(kfr[sub * 4 + nn * 2 + 1], qf[sub][1], s[sub][nn]);
          }
        SB;
        bf16x8 pf[2];
        float tmx[2];
#pragma unroll
        for (int sub = 0; sub < 2; ++sub) {
          float tm = fmaxf(fmaxf(fmaxf(s[sub][0][0], s[sub][0][1]), fmaxf(s[sub][0][2], s[sub][0][3])), fmaxf(fmaxf(s[sub][1][0], s[sub][1][1]), fmaxf(s[sub][1][2], s[sub][1][3])));
          tmx[sub] = tm;
        }
        if (__any((tmx[0] > mx[0] + 8.f) || (tmx[1] > mx[1] + 8.f))) {
#pragma unroll
          for (int sub = 0; sub < 2; ++sub) {
            float tm = tmx[sub];
            tm = fmaxf(tm, __shfl_xor(tm, 16));
            tm = fmaxf(tm, __shfl_xor(tm, 32));
            const float mn = (tm > mx[sub] + 8.f) ? tm : mx[sub];
            const float sc = __builtin_amdgcn_exp2f(mx[sub] - mn);
            mx[sub] = mn;
            ls[sub] *= sc;
#pragma unroll
            for (int et = 0; et < 8; ++et) {
              if (sub == 0) { o0[et][0] *= sc; o0[et][1] *= sc; o0[et][2] *= sc; o0[et][3] *= sc; }
              else { o1[et][0] *= sc; o1[et][1] *= sc; o1[et][2] *= sc; o1[et][3] *= sc; }
            }
          }
        }
#pragma unroll
        for (int sub = 0; sub < 2; ++sub) {
          unsigned pw[4];
          float acc = 0.f;
#pragma unroll
          for (int nn = 0; nn < 2; ++nn) {
            float a[4];
#pragma unroll
            for (int r = 0; r < 4; ++r) { a[r] = __builtin_amdgcn_exp2f(s[sub][nn][r] - mx[sub]); acc += a[r]; }
            pw[nn * 2] = pack2(a[0], a[1]);
            pw[nn * 2 + 1] = pack2(a[2], a[3]);
          }
          ls[sub] += acc;
          union { unsigned u[4]; bf16x8 v; } cp;
          cp.u[0] = pw[0]; cp.u[1] = pw[1]; cp.u[2] = pw[2]; cp.u[3] = pw[3];
          pf[sub] = cp.v;
        }
        SB;
#pragma unroll
        for (int et = 0; et < 8; ++et) {
          union { unsigned u[4]; bf16x8 v; } cv;
          cv.u[0] = vlo_[et].x; cv.u[1] = vlo_[et].y; cv.u[2] = vhi_[et].x; cv.u[3] = vhi_[et].y;
          o0[et] = MFMA(cv.v, pf[0], o0[et]);
          o1[et] = MFMA(cv.v, pf[1], o1[et]);
        }
        SB;
      }
      asm volatile("s_waitcnt vmcnt(0)" ::: "memory");
      __syncthreads();
    }
    f32x4 o[8];
    {
      float t0 = ls[0], t1 = ls[1];
      t0 += __shfl_xor(t0, 16); t0 += __shfl_xor(t0, 32);
      t1 += __shfl_xor(t1, 16); t1 += __shfl_xor(t1, 32);
      const float c1 = 1.f / t0, c2 = lam / t1;
#pragma unroll
      for (int et = 0; et < 8; ++et)
#pragma unroll
        for (int r = 0; r < 4; ++r) o[et][r] = o0[et][r] * c1 - o1[et][r] * c2;
    }
#undef ATT_STAGE_K
#undef ATT_STAGE_V
    float ss = 0.f;
#pragma unroll
    for (int et = 0; et < 8; ++et)
#pragma unroll
      for (int r = 0; r < 4; ++r) ss += o[et][r] * o[et][r];
    ss += __shfl_xor(ss, 16);
    ss += __shfl_xor(ss, 32);
    const float rs = rsqrtf(ss * (1.f / 128.f) + 1e-6f) * (1.f - lam_init);
    bf16_t* gp = R0 + 160 * MIB / 2 + (size_t)mq * 1024 + h * 128;
#pragma unroll
    for (int et = 0; et < 8; ++et) {
      const int e0 = 16 * et + 4 * lg;
      const uint2 g = *(const uint2*)(gp + e0);
      const float4 sg = *(const float4*)(subg + e0);
      const float v0 = o[et][0] * rs * sg.x * lo_f(g.x), v1 = o[et][1] * rs * sg.y * hi_f(g.x);
      const float v2 = o[et][2] * rs * sg.z * lo_f(g.y), v3 = o[et][3] * rs * sg.w * hi_f(g.y);
      if (!dry) *(uint2*)(gp + e0) = make_uint2(pack2(v0, v1), pack2(v2, v3));
    }
  }
}

__device__ __forceinline__ bf16_t* hg_ob_row(const Params& p, int m) {
  const int c = m >> 9;
  float* base = c < 32 ? p.out + OUT_CK + (size_t)(c * 2 + 1) * 262144 : p.out + OUT_CV + (size_t)((c - 32) * 2 + 1) * 262144;
  return (bf16_t*)base + (size_t)(m & 511) * 1024;
}

__device__ __forceinline__ bf16_t* ret_ob_row(const Params& p, int ms) {
  const int c = ms >> 8;
  float* base = c < 32 ? p.out + OUT_CK + (size_t)(c * 2 + 1) * 262144 : p.out + OUT_CV + (size_t)((c - 32) * 2 + 1) * 262144;
  return (bf16_t*)base + (size_t)(ms & 255) * 2048;
}

template <int KIND, int DIR>
__device__ __forceinline__ void scan_item(const Params& p, int item, unsigned char* lds, const bool dry) {
  constexpr int DV = KIND == 1 ? 256 : 128, NSL = DV / 64, LDV = KIND == 1 ? 2048 : 1024;
  const int tid = HTID, lane = tid & 63, w = tid >> 6, lr = lane & 15, lg = lane >> 4;
  int grp, b, h, sl;
  {
    int it = item;
    if (it < 64 * NSL) grp = 1; else { grp = 0; it -= 64 * NSL; }
    sl = it % NSL; h = (it / NSL) & 7; b = it / (NSL * 8);
  }
  const int T = grp ? 2048 : 256, nch = T >> 6;
  const size_t mbase = grp ? (size_t)8192 + (size_t)b * 2048 : (size_t)b * 256;
  bf16_t* R0 = (bf16_t*)p.ws;
  const bf16_t* Qg = R0 + mbase * 1024 + h * 128;
  const bf16_t* Kg = R0 + (KIND == 1 ? PLANE_E : (DIR ? 2 * PLANE_E : PLANE_E)) + mbase * 1024 + h * 128;
  const bf16_t* Vg = R0 + (KIND == 1 ? 2 * PLANE_E : 3 * PLANE_E) + mbase * LDV + h * DV + sl * 64;
  bf16_t* Og = R0 + (KIND == 1 ? 4 * PLANE_E : 5 * PLANE_E) + mbase * LDV + h * DV + sl * 64;
  unsigned char* Qs = lds;
  unsigned char* X = lds + 17408;
  unsigned char* Vt = lds + 35840;
  unsigned char* StS = lds + 45056;
  unsigned char* Pm = lds + 62464;
  float* xch = (float*)(lds + 71680);
  float* blA = xch + 512;
  float* erA = xch + 640;
  const int dp = tid & 63, tq = tid >> 6, r0 = tq * 16, d0 = dp * 2;
  float cst0, cst1;
  if (KIND == 1) { cst0 = cst1 = log1pf(-expf(p.in[18][DIR * 8 + h])) * 1.4426950408889634f; }
  else {
    const float* lbp = p.in[21] + DIR * 4096 + h * 128 + d0;
    {
      const float x0 = lbp[0], x1 = lbp[1024], x2 = lbp[2048], x3 = lbp[3072];
      const float m = fmaxf(fmaxf(x0, x1), fmaxf(x2, x3));
      const float e0 = expf(x0 - m), e1 = expf(x1 - m), e2 = expf(x2 - m), e3 = expf(x3 - m);
      cst0 = (e1 + e2) / (e0 + e1 + e2 + e3);
    }
    {
      const float x0 = lbp[1], x1 = lbp[1025], x2 = lbp[2049], x3 = lbp[3073];
      const float m = fmaxf(fmaxf(x0, x1), fmaxf(x2, x3));
      const float e0 = expf(x0 - m), e1 = expf(x1 - m), e2 = expf(x2 - m), e3 = expf(x3 - m);
      cst1 = (e1 + e2) / (e0 + e1 + e2 + e3);
    }
  }
  f32x4 S[8];
  if (grp) {
    const float* s0 = (KIND == 1 ? p.in[4] : p.in[5]) + ((size_t)((b * 2 + DIR) * 8 + h) * 128) * DV + sl * 64 + 16 * w + lr + (size_t)(4 * lg) * DV;
    asm volatile("" : "+v"(s0));
#pragma unroll
    for (int dt = 0; dt < 8; ++dt)
#pragma unroll
      for (int r = 0; r < 4; ++r) S[dt][r] = s0[(16 * dt + r) * DV];
  } else {
#pragma unroll
    for (int dt = 0; dt < 8; ++dt) S[dt] = (f32x4){0.f, 0.f, 0.f, 0.f};
  }
  unsigned qv[16], kv[16], vv[8];
  const int ve2 = tid & 31, vq = tid >> 5;
  const int qoff = r0 * 512 + dp;
  const int voff = (8 * vq) * (LDV / 2) + ve2;
  const unsigned* Qg32 = (const unsigned*)Qg;
  const unsigned* Kg32 = (const unsigned*)Kg;
  const unsigned* Vg32 = (const unsigned*)Vg;
#define SCAN_ISSUE(c)                                                                                   \
  {                                                                                                     \
    const unsigned* q_ = Qg32 + (size_t)(c) * (64 * 512) + qoff;                                        \
    const unsigned* k_ = Kg32 + (size_t)(c) * (64 * 512) + qoff;                                        \
    const unsigned* v_ = Vg32 + (size_t)(c) * (64 * (LDV / 2)) + voff;                                  \
    asm volatile("" : "+v"(q_), "+v"(k_), "+v"(v_));                                                    \
    _Pragma("unroll") for (int i = 0; i < 16; ++i) { qv[i] = q_[i * 512]; kv[i] = k_[i * 512]; }        \
    _Pragma("unroll") for (int i = 0; i < 8; ++i) vv[i] = v_[i * (LDV / 2)];                            \
  }
  if (KIND == 1) {
    if (tid < 64) {
      const float ex = (DIR ? (float)(32 - tid) : (float)(tid - 31)) * cst0;
      *(float2*)(xch + 2 * tid) = make_float2(__builtin_amdgcn_exp2f(ex), __builtin_amdgcn_exp2f(-ex));
    }
    if (tid < 128) { blA[tid] = __builtin_amdgcn_exp2f(64.f * cst0); erA[tid] = __builtin_amdgcn_exp2f(32.f * cst0); }
    __syncthreads();
  }
  SCAN_ISSUE(DIR ? nch - 1 : 0);
  for (int ci = 0; ci < nch; ++ci) {
    const int c = DIR ? nch - 1 - ci : ci;
    unsigned ktp0[8], ktp1[8];
    if (KIND == 1) {
      const float cbr = __builtin_amdgcn_exp2f(32.f * cst0);
#pragma unroll
      for (int j = 0; j < 8; ++j) {
        float ka[2], kb[2];
#pragma unroll
        for (int hh = 0; hh < 2; ++hh) {
          const int i = 2 * j + hh;
          const float2 e = *(const float2*)(xch + 2 * (r0 + i));
          *(unsigned*)(Qs + (r0 + i) * 272 + d0 * 2) = pack2(lo_f(qv[i]) * e.x, hi_f(qv[i]) * e.x);
          const float kh0 = lo_f(kv[i]) * e.y, kh1 = hi_f(kv[i]) * e.y;
          *(unsigned*)(X + (r0 + i) * 272 + d0 * 2) = pack2(kh0, kh1);
          ka[hh] = kh0 * cbr;
          kb[hh] = kh1 * cbr;
        }
        ktp0[j] = pack2(ka[0], ka[1]);
        ktp1[j] = pack2(kb[0], kb[1]);
      }
    } else {
    float tot0 = 0.f, tot1 = 0.f;
#pragma unroll
    for (int i = 0; i < 16; ++i) { tot0 += lo_f(kv[i]); tot1 += hi_f(kv[i]); }
    *(float2*)(xch + tq * 128 + d0) = make_float2(tot0, tot1);
    __syncthreads();
    const float2 t0 = *(const float2*)(xch + d0), t1 = *(const float2*)(xch + 128 + d0), t2 = *(const float2*)(xch + 256 + d0), t3 = *(const float2*)(xch + 384 + d0);
    const float blast0 = (t0.x + t1.x) + (t2.x + t3.x), blast1 = (t0.y + t1.y) + (t2.y + t3.y);
    float ref0, ref1, run0, run1;
    if (DIR == 0) {
      ref0 = t0.x + t1.x; ref1 = t0.y + t1.y;
      run0 = (tq > 0 ? t0.x : 0.f) + (tq > 1 ? t1.x : 0.f) + (tq > 2 ? t2.x : 0.f);
      run1 = (tq > 0 ? t0.y : 0.f) + (tq > 1 ? t1.y : 0.f) + (tq > 2 ? t2.y : 0.f);
    } else {
      ref0 = t2.x + t3.x; ref1 = t2.y + t3.y;
      run0 = (tq < 3 ? t3.x : 0.f) + (tq < 2 ? t2.x : 0.f) + (tq < 1 ? t1.x : 0.f);
      run1 = (tq < 3 ? t3.y : 0.f) + (tq < 2 ? t2.y : 0.f) + (tq < 1 ? t1.y : 0.f);
    }
    const float cbr0 = __builtin_amdgcn_exp2f(blast0 - ref0), cbr1 = __builtin_amdgcn_exp2f(blast1 - ref1);
#pragma unroll
    for (int jj = 0; jj < 8; ++jj) {
      const int j = DIR ? 7 - jj : jj;
      float ka[2], kb[2];
#pragma unroll
      for (int hh = 0; hh < 2; ++hh) {
        const int i = 2 * j + (DIR ? 1 - hh : hh);
        const float g0 = lo_f(kv[i]), g1 = hi_f(kv[i]);
        const float k0 = 1.f - __builtin_amdgcn_exp2f(g0), k1 = 1.f - __builtin_amdgcn_exp2f(g1);
        run0 += g0; run1 += g1;
        *(unsigned*)(Qs + (r0 + i) * 272 + d0 * 2) = pack2(lo_f(qv[i]) * __builtin_amdgcn_exp2f(run0 - ref0), hi_f(qv[i]) * __builtin_amdgcn_exp2f(run1 - ref1));
        const float kh0 = k0 * __builtin_amdgcn_exp2f(ref0 - run0), kh1 = k1 * __builtin_amdgcn_exp2f(ref1 - run1);
        *(unsigned*)(X + (r0 + i) * 272 + d0 * 2) = pack2(kh0, kh1);
        ka[i & 1] = kh0 * cbr0;
        kb[i & 1] = kh1 * cbr1;
      }
      ktp0[j] = pack2(ka[0], ka[1]);
      ktp1[j] = pack2(kb[0], kb[1]);
    }
    if (tq == 0) { *(float2*)(blA + d0) = make_float2(__builtin_amdgcn_exp2f(blast0), __builtin_amdgcn_exp2f(blast1)); *(float2*)(erA + d0) = make_float2(__builtin_amdgcn_exp2f(ref0), __builtin_amdgcn_exp2f(ref1)); }
    }
    {
      const unsigned a0 = (vv[0] & 0xffffu) | (vv[1] << 16), a1 = (vv[2] & 0xffffu) | (vv[3] << 16), a2 = (vv[4] & 0xffffu) | (vv[5] << 16), a3 = (vv[6] & 0xffffu) | (vv[7] << 16);
      const unsigned b0 = (vv[0] >> 16) | (vv[1] & 0xffff0000u), b1 = (vv[2] >> 16) | (vv[3] & 0xffff0000u), b2 = (vv[4] >> 16) | (vv[5] & 0xffff0000u), b3 = (vv[6] >> 16) | (vv[7] & 0xffff0000u);
      *(uint4*)(Vt + (2 * ve2) * 144 + vq * 16) = make_uint4(a0, a1, a2, a3);
      *(uint4*)(Vt + (2 * ve2 + 1) * 144 + vq * 16) = make_uint4(b0, b1, b2, b3);
    }
    if (ci + 1 < nch) { SCAN_ISSUE(DIR ? c - 1 : c + 1); }
    __syncthreads();
#pragma unroll
    for (int dt = 0; dt < 8; ++dt) {
      const float4 er4 = *(const float4*)(erA + 16 * dt + 4 * lg);
      *(uint2*)(StS + (16 * w + lr) * 272 + (16 * dt + 4 * lg) * 2) = make_uint2(pack2(S[dt][0] * er4.x, S[dt][1] * er4.y), pack2(S[dt][2] * er4.z, S[dt][3] * er4.w));
    }
    bf16x8 qf[4];
#pragma unroll
    for (int ks = 0; ks < 4; ++ks) qf[ks] = *(const bf16x8*)(Qs + (16 * w + lr) * 272 + ks * 64 + lg * 16);
    uint2 pv[4];
    {
      const int t = 16 * w + lr;
#pragma unroll
      for (int st = 0; st < 4; ++st) {
        f32x4 s = (f32x4){0.f, 0.f, 0.f, 0.f};
#pragma unroll
        for (int ks = 0; ks < 4; ++ks) {
          const bf16x8 kf = *(const bf16x8*)(X + (16 * st + lr) * 272 + ks * 64 + lg * 16);
          s = MFMA(kf, qf[ks], s);
        }
        float v[4];
#pragma unroll
        for (int r = 0; r < 4; ++r) {
          const int si = 16 * st + 4 * lg + r;
          const bool keep = DIR ? (t <= si) : (t >= si);
          v[r] = keep ? s[r] : 0.f;
        }
        pv[st] = make_uint2(pack2(v[0], v[1]), pack2(v[2], v[3]));
      }
    }
    __syncthreads();
#pragma unroll
    for (int st = 0; st < 4; ++st) *(uint2*)(Pm + (16 * w + lr) * 144 + (16 * st + 4 * lg) * 2) = pv[st];
    *(uint4*)(X + d0 * 144 + r0 * 2) = make_uint4(ktp0[0], ktp0[1], ktp0[2], ktp0[3]);
    *(uint4*)(X + d0 * 144 + r0 * 2 + 16) = make_uint4(ktp0[4], ktp0[5], ktp0[6], ktp0[7]);
    *(uint4*)(X + (d0 + 1) * 144 + r0 * 2) = make_uint4(ktp1[0], ktp1[1], ktp1[2], ktp1[3]);
    *(uint4*)(X + (d0 + 1) * 144 + r0 * 2 + 16) = make_uint4(ktp1[4], ktp1[5], ktp1[6], ktp1[7]);
    __syncthreads();
    {
      bf16x8 pf[2];
#pragma unroll
      for (int ks = 0; ks < 2; ++ks) pf[ks] = *(const bf16x8*)(Pm + (16 * w + lr) * 144 + ks * 64 + lg * 16);
      const bool sep = DIR && (KIND == 2 || grp);
      bf16_t* orow = (KIND == 2 && DIR) ? hg_ob_row(p, (int)mbase + c * 64 + 16 * w + lr) + h * DV + sl * 64 + 4 * lg
                   : (KIND == 1 && DIR && grp) ? ret_ob_row(p, b * 2048 + c * 64 + 16 * w + lr) + h * DV + sl * 64 + 4 * lg
                                               : Og + (size_t)(c * 64 + 16 * w + lr) * LDV + 4 * lg;
#pragma unroll
      for (int et = 0; et < 4; ++et) {
        f32x4 o = (f32x4){0.f, 0.f, 0.f, 0.f};
#pragma unroll
        for (int ks = 0; ks < 2; ++ks) {
          const bf16x8 vf = *(const bf16x8*)(Vt + (16 * et + lr) * 144 + ks * 64 + lg * 16);
          o = MFMA(vf, pf[ks], o);
        }
#pragma unroll
        for (int ks = 0; ks < 4; ++ks) {
          const bf16x8 sf = *(const bf16x8*)(StS + (16 * et + lr) * 272 + ks * 64 + lg * 16);
          o = MFMA(sf, qf[ks], o);
        }
        bf16_t* op = orow + 16 * et;
        if (DIR && !sep) {
          const uint2 old = *(const uint2*)op;
          o[0] += lo_f(old.x); o[1] += hi_f(old.x); o[2] += lo_f(old.y); o[3] += hi_f(old.y);
        }
        if (!(DIR && !sep && dry)) *(uint2*)op = make_uint2(pack2(o[0], o[1]), pack2(o[2], o[3]));
      }
    }
    {
      bf16x8 vtf[2];
#pragma unroll
      for (int ks = 0; ks < 2; ++ks) vtf[ks] = *(const bf16x8*)(Vt + (16 * w + lr) * 144 + ks * 64 + lg * 16);
#pragma unroll
      for (int dt = 0; dt < 8; ++dt) {
        const float4 bl4 = *(const float4*)(blA + 16 * dt + 4 * lg);
        S[dt][0] *= bl4.x; S[dt][1] *= bl4.y; S[dt][2] *= bl4.z; S[dt][3] *= bl4.w;
#pragma unroll
        for (int ks = 0; ks < 2; ++ks) {
          const bf16x8 kf = *(const bf16x8*)(X + (16 * dt + lr) * 144 + ks * 64 + lg * 16);
          S[dt] = MFMA(kf, vtf[ks], S[dt]);
        }
      }
    }
    __syncthreads();
  }
#undef SCAN_ISSUE
  if (!grp) {
    float* so = p.out + (KIND == 1 ? OUT_SR : OUT_SH) + ((size_t)((b * 2 + DIR) * 8 + h) * 128) * DV + sl * 64 + 16 * w + lr + (size_t)(4 * lg) * DV;
    asm volatile("" : "+v"(so));
#pragma unroll
    for (int dt = 0; dt < 8; ++dt)
#pragma unroll
      for (int r = 0; r < 4; ++r) so[(16 * dt + r) * DV] = S[dt][r];
  }
}

template <int KIND, int DIR>
__device__ __forceinline__ void scan_phase(const Params& p, unsigned char* lds, const bool dry) {
  constexpr int NSL = (KIND == 1 ? 256 : 128) / 64;
  const int ns = 64 * NSL, npr = 256 * NSL;
  const int G = VGDIM, bid = VBID;
  int it, step, end = ns + npr;
  if (G > ns) {
    if (bid < ns) { it = bid; step = end; }
    else { it = ns + (bid - ns); step = G - ns; }
  } else { it = bid; step = G; }
  for (; it < end; it += step) scan_item<KIND, DIR>(p, it, lds, dry);
}

__device__ __forceinline__ void scan_phase_ret_sample(const Params& p, unsigned char* lds, const bool dry) {
  const int G = VGDIM >> 1, bid = VBID;
  const int role = bid >= G;
  const int rb = role ? bid - G : bid;
  if (role == 0) { for (int it = rb; it < 256; it += G) scan_item<1, 0>(p, it, lds, dry); }
  else           { for (int it = rb; it < 256; it += G) scan_item<1, 1>(p, it, lds, dry); }
}
template <int DIR>
__device__ __forceinline__ void scan_phase_ret_prompt(const Params& p, unsigned char* lds, const bool dry) {
  for (int it = VBID; it < 1024; it += VGDIM) scan_item<1, DIR>(p, 256 + it, lds, dry);
}

__device__ __forceinline__ void scan_phase_hg_both(const Params& p, unsigned char* lds, const bool dry) {
  if (gridDim.x == 256) {
    const int bid = blockIdx.x, half = HALFID;
    const int role = bid >= 128, rb = role ? bid - 128 : bid;
    const int n_it = half ? 4 : 1, first = half ? 128 + rb * 4 : rb;
    if (role == 0) { for (int k = 0; k < n_it; ++k) scan_item<2, 0>(p, first + k, lds, dry); }
    else           { for (int k = 0; k < n_it; ++k) scan_item<2, 1>(p, first + k, lds, dry); }
    if (half) { for (int i = 0; i < 80; ++i) __syncthreads(); }
    return;
  }
  const int G = VGDIM >> 1, bid = VBID;
  const int role = bid >= G;
  const int rb = role ? bid - G : bid;
  int it, step;
  if (G > 128) {
    if (rb < 128) { it = rb; step = 1 << 20; } else { it = rb; step = G - 128; }
  } else { it = rb; step = G; }
  if (role == 0) { for (; it < 640; it += step) scan_item<2, 0>(p, it, lds, dry); }
  else           { for (; it < 640; it += step) scan_item<2, 1>(p, it, lds, dry); }
}

template <int KIND>
__device__ __forceinline__ void normgate_phase(const Params& p, const bool dry) {
  constexpr int NCH = KIND == 1 ? 4 : 2, DV = KIND == 1 ? 256 : 128, LD = KIND == 1 ? 2048 : 1024;
  const int tid = HTID, lane = tid & 63, w = tid >> 6;
  const int hh = lane >> 3, sub = lane & 7;
  bf16_t* R0 = (bf16_t*)p.ws;
  bf16_t* Ob = R0 + (KIND == 1 ? 4 * PLANE_E : 5 * PLANE_E) + hh * DV + sub * 8;
  const bf16_t* Gb = R0 + (KIND == 1 ? 0 : 4 * PLANE_E) + hh * DV + sub * 8;
  float gn[NCH][8];
#pragma unroll
  for (int j = 0; j < NCH; ++j)
#pragma unroll
    for (int i = 0; i < 8; ++i) gn[j][i] = (KIND == 1) ? 1.f : p.in[22][j * 64 + sub * 8 + i];
  for (int row = VBID * 4 + w; row < 24576; row += VGDIM * 4) {
    bf16_t* op = Ob + (size_t)row * LD;
    const bf16_t* gp = Gb + (size_t)row * LD;
    uint4 ov[NCH], gv[NCH];
#pragma unroll
    for (int j = 0; j < NCH; ++j) { ov[j] = *(const uint4*)(op + j * 64); gv[j] = *(const uint4*)(gp + j * 64); }
    if (KIND == 2 || row >= 8192) {
      const bf16_t* bp = (KIND == 2 ? hg_ob_row(p, row) : ret_ob_row(p, row - 8192)) + hh * DV + sub * 8;
#pragma unroll
      for (int j = 0; j < NCH; ++j) {
        const uint4 bv = *(const uint4*)(bp + j * 64);
        ov[j].x = pack2(lo_f(ov[j].x) + lo_f(bv.x), hi_f(ov[j].x) + hi_f(bv.x));
        ov[j].y = pack2(lo_f(ov[j].y) + lo_f(bv.y), hi_f(ov[j].y) + hi_f(bv.y));
        ov[j].z = pack2(lo_f(ov[j].z) + lo_f(bv.z), hi_f(ov[j].z) + hi_f(bv.z));
        ov[j].w = pack2(lo_f(ov[j].w) + lo_f(bv.w), hi_f(ov[j].w) + hi_f(bv.w));
      }
    }
    float ss = 0.f;
#pragma unroll
    for (int j = 0; j < NCH; ++j) {
      const unsigned wv[4] = {ov[j].x, ov[j].y, ov[j].z, ov[j].w};
#pragma unroll
      for (int i = 0; i < 4; ++i) { const float a = lo_f(wv[i]), b2 = hi_f(wv[i]); ss += a * a + b2 * b2; }
    }
    ss += __shfl_xor(ss, 1);
    ss += __shfl_xor(ss, 2);
    ss += __shfl_xor(ss, 4);
    const float rs = rsqrtf(ss * (1.f / (float)DV) + 1e-6f);
#pragma unroll
    for (int j = 0; j < NCH; ++j) {
      const unsigned wv[4] = {ov[j].x, ov[j].y, ov[j].z, ov[j].w};
      const unsigned gw[4] = {gv[j].x, gv[j].y, gv[j].z, gv[j].w};
      unsigned r[4];
#pragma unroll
      for (int i = 0; i < 4; ++i)
        r[i] = pack2(lo_f(wv[i]) * rs * gn[j][2 * i] * lo_f(gw[i]), hi_f(wv[i]) * rs * gn[j][2 * i + 1] * hi_f(gw[i]));
      if (!dry) *(uint4*)(op + j * 64) = make_uint4(r[0], r[1], r[2], r[3]);
    }
  }
}

__device__ __forceinline__ void opaque_params(Params& q) {
  asm volatile("" : "+s"(q.out), "+s"(q.ws));
#pragma unroll
  for (int i = 0; i < 23; ++i) asm volatile("" : "+s"(q.in[i]));
}

struct BarState { unsigned* base; unsigned xcd, mycnt, nact, esub, etop; };
__device__ __forceinline__ void grid_barrier(BarState& b) {
  asm volatile("s_waitcnt vmcnt(0) lgkmcnt(0)" ::: "memory");
  __syncthreads();
  if (threadIdx.x == 0) {
    b.esub += b.mycnt; b.etop += b.nact;
    const unsigned old = __hip_atomic_fetch_add(b.base + 64 * b.xcd, 1u, __ATOMIC_RELAXED, __HIP_MEMORY_SCOPE_AGENT);
    if (old + 1u == b.esub) {
      __builtin_amdgcn_fence(__ATOMIC_RELEASE, "agent");
      __hip_atomic_fetch_add(b.base + 512, 1u, __ATOMIC_RELAXED, __HIP_MEMORY_SCOPE_AGENT);
    }
    while (__hip_atomic_load(b.base + 512, __ATOMIC_RELAXED, __HIP_MEMORY_SCOPE_AGENT) < b.etop) __builtin_amdgcn_s_sleep(1);
    __builtin_amdgcn_fence(__ATOMIC_ACQUIRE, "agent");
  }
  __syncthreads();
}
__device__ __forceinline__ void bar_census_post(BarState& b) {
  if (threadIdx.x == 0) __hip_atomic_fetch_add(b.base + 1024 + 64 * b.xcd, 1u, __ATOMIC_RELAXED, __HIP_MEMORY_SCOPE_AGENT);
}
__device__ __forceinline__ void bar_census_read(BarState& b) {
  if (threadIdx.x == 0) {
    unsigned n = 0;
    for (unsigned j = 0; j < 8; ++j) {
      const unsigned c = __hip_atomic_load(b.base + 1024 + 64 * j, __ATOMIC_RELAXED, __HIP_MEMORY_SCOPE_AGENT);
      n += (c != 0u);
      if (j == b.xcd) b.mycnt = c;
    }
    b.nact = n;
  }
}
#define GSYNC(n) { if ((n) == 0) { grid.sync(); bar_census_read(bst); } else grid_barrier(bst); }

#if defined(PH_ONLY)
#define PHASE(n, call) if (n == PH_ONLY) { const bool dry = false; call; }
#elif defined(REP_N)
#define PHASE(n, call) if (lo <= n && n < hi) { for (int rep = (n == REP_N ? 0 : 1); rep < 2; ++rep) { const bool dry = (rep == 0); call; if (!(fin && n + 1 == hi && rep == 1)) GSYNC(n) } }
#else
#define PHASE(n, call) if (lo <= n && n < hi) { const bool dry = false; call; if (!(fin && n + 1 == hi)) GSYNC(n) }
#endif

__device__ __forceinline__ void run_range(const Params& q, int lo, int hi, bool fin, cg::grid_group& grid, unsigned char* lds) {
  unsigned char* ldh = lds + HALFID * HALF_LDS;
  BarState bst; bst.base = (unsigned*)(q.ws + OFF_MISC + MISC_CTR); bst.xcd = xcc_id(); bst.mycnt = 0; bst.nact = 0; bst.esub = 0; bst.etop = 0;
  if (lo == 0) bar_census_post(bst);
  PHASE(0, phase0(q, ldh))
  PHASE(1, post_phase(q, -1, 0, ldh, dry))
  PHASE(2, gemm_phase(q, 0, GM_IN_DA, lds, 2))
  PHASE(3, attn_phase(q, 0, lds, dry, 3))
  PHASE(4, gemm_phase(q, 0, GM_OUT, lds, 4))
  PHASE(5, post_phase(q, 0, 1, ldh, dry))
  PHASE(6, gemm_phase(q, 1, GM_IN_RET_QKV, lds, 6))
  PHASE(7, scan_phase_ret_sample(q, ldh, dry))
  PHASE(8, scan_phase_ret_prompt<0>(q, ldh, dry))
  PHASE(8, scan_phase_ret_prompt<1>(q, ldh, dry))
  PHASE(9, gemm_phase(q, 1, GM_IN_RET_G, lds, 9))
  PHASE(10, normgate_phase<1>(q, dry))
  PHASE(11, gemm_phase(q, 1, GM_OUT, lds, 11))
  PHASE(12, post_phase(q, 1, 2, ldh, dry))
  PHASE(13, gemm_phase(q, 2, GM_IN_HG, lds, 13))
  PHASE(14, scan_phase_hg_both(q, ldh, dry))
  PHASE(16, normgate_phase<2>(q, dry))
  PHASE(17, gemm_phase(q, 2, GM_OUT, lds, 17))
  PHASE(18, post_phase(q, 2, 3, ldh, dry))
  PHASE(19, gemm_phase(q, 3, GM_IN_DA, lds, 19))
  PHASE(20, attn_phase(q, 3, lds, dry, 20))
  PHASE(21, gemm_phase(q, 3, GM_OUT, lds, 21))
  PHASE(22, post_phase(q, 3, 4, ldh, dry))
}

__global__ void __launch_bounds__(NTHR, 2) mega_fwd(Params p) {
  extern __shared__ __attribute__((aligned(16))) unsigned char lds[];
  cg::grid_group grid = cg::this_grid();
  run_range(p, p.ph_lo, p.ph_hi, true, grid, lds);
}

extern "C" void kernel_launch(void* const* d_in, const int* in_sizes, int n_in, void* d_out, int out_size, void* d_ws, size_t ws_size, hipStream_t stream) {
  static int grid_blocks = 0;
  if (grid_blocks == 0) {
    int dev = 0, cus = 0, per_cu = 0;
    hipGetDevice(&dev);
    hipDeviceGetAttribute(&cus, hipDeviceAttributeMultiprocessorCount, dev);
    hipFuncSetAttribute((const void*)mega_fwd, hipFuncAttributeMaxDynamicSharedMemorySize, LDS_BYTES);
    hipOccupancyMaxActiveBlocksPerMultiprocessor(&per_cu, (const void*)mega_fwd, NTHR, LDS_BYTES);
    if (per_cu < 1) per_cu = 1;
    if (per_cu > 1) per_cu = 1;
    if (cus < 1) cus = 256;
    grid_blocks = cus * per_cu;
    (void)hipGetLastError();
    if (n_in != 23 || ws_size < WS_NEED) { fprintf(stderr, "kernel_launch: unexpected n_in %d / ws_size %zu (need %zu)\n", n_in, ws_size, (size_t)WS_NEED); }
  }
  hipMemsetAsync((unsigned char*)d_ws + OFF_MISC + MISC_CTR, 0, 8192, stream);
  Params p{};
  for (int i = 0; i < 23; ++i) p.in[i] = (const float*)d_in[i];
  p.out = (float*)d_out;
  p.ws = (unsigned char*)d_ws;
#if ONE_LAUNCH
  p.ph_lo = 0; p.ph_hi = NPH;
  void* args[] = {&p};
  hipError_t e = hipLaunchCooperativeKernel((const void*)mega_fwd, dim3(grid_blocks), dim3(NTHR), args, LDS_BYTES, stream);
  if (e != hipSuccess) fprintf(stderr, "cooperative launch failed: %s (grid %d)\n", hipGetErrorString(e), grid_blocks);
#else
  for (int ph = 0; ph < NPH; ++ph) {
    p.ph_lo = ph; p.ph_hi = ph + 1;
    hipLaunchKernelGGL(mega_fwd, dim3(grid_blocks), dim3(NTHR), LDS_BYTES, stream, p);
  }
#endif
}
```

```cpp
#include <hip/hip_runtime.h>
#include <hip/hip_cooperative_groups.h>
#include <cstdint>
#include <cstdio>
namespace cg = cooperative_groups;

#ifndef ONE_LAUNCH
#define ONE_LAUNCH 1
#endif

typedef unsigned short bf16_t;
typedef short bf16x8 __attribute__((ext_vector_type(8)));
typedef float f32x4 __attribute__((ext_vector_type(4)));

#define NTHR 512
#define HTID ((int)(threadIdx.x & 255))
#define HALFID ((int)(threadIdx.x >> 8))
#define VBID ((int)(blockIdx.x * 2 + (threadIdx.x >> 8)))
#define VGDIM ((int)(gridDim.x * 2))
#define HALF_LDS 74816
#define MIB ((size_t)1 << 20)
#define NPH 23
#define LDS_BYTES (2 * HALF_LDS)
#define LDS_SLOT 74752
#define MISC_LB (MISC_ROPE + 524288 + 16384)
#define MISC_CTR (MISC_ROPE + 524288)

#define OFF_WIN  (288 * MIB)
#define OFF_WOUT (300 * MIB)
#define OFF_HP   (304 * MIB)
#define OFF_MISC (320 * MIB)
#define MISC_ROPE 524288
#define WS_NEED  (322 * MIB)
#define PLANE_E  ((size_t)25165824)
#define OUT_YP 0
#define OUT_YS 8388608
#define OUT_CK 25165824
#define OUT_CV 41943040
#define OUT_SR 58720256
#define OUT_SH 75497472

struct Params {
  const float* in[23];
  float* out;
  unsigned char* ws;
  int ph_lo, ph_hi;
};

struct LayerInfo { int kind, slot, IN, WIDTH; const float* w_in; const float* w_out; };

__device__ __forceinline__ LayerInfo layer_info(const Params& p, int l) {
  LayerInfo L;
  if (l == 0)      { L.kind = 0; L.slot = 0; L.IN = 4096; L.WIDTH = 1024; L.w_in = p.in[12]; L.w_out = p.in[13]; }
  else if (l == 1) { L.kind = 1; L.slot = 0; L.IN = 6144; L.WIDTH = 2048; L.w_in = p.in[16]; L.w_out = p.in[17]; }
  else if (l == 2) { L.kind = 2; L.slot = 0; L.IN = 5120; L.WIDTH = 1024; L.w_in = p.in[19]; L.w_out = p.in[20]; }
  else             { L.kind = 0; L.slot = 1; L.IN = 4096; L.WIDTH = 1024; L.w_in = p.in[12] + (size_t)1024 * 4096; L.w_out = p.in[13] + (size_t)1024 * 1024; }
  return L;
}
__device__ __forceinline__ bf16_t* hs_ptr(const Params& p, int l) {
  return l < 3 ? (bf16_t*)(p.out + OUT_SH) : (bf16_t*)(p.ws + 240 * MIB);
}

typedef __bf16 nbf16x2 __attribute__((ext_vector_type(2)));
typedef float f32x2 __attribute__((ext_vector_type(2)));
__device__ __forceinline__ float bf2f(unsigned h) { return __uint_as_float(h << 16); }
__device__ __forceinline__ unsigned pack2(float a, float b) { const f32x2 f = {a, b}; return __builtin_bit_cast(unsigned, __builtin_convertvector(f, nbf16x2)); }
__device__ __forceinline__ float lo_f(unsigned w) { return __uint_as_float(w << 16); }
__device__ __forceinline__ float hi_f(unsigned w) { return __uint_as_float(w & 0xffff0000u); }
__device__ __forceinline__ float silu_f(float x) { return x / (1.f + __expf(-x)); }
__device__ __forceinline__ float wave_sum(float v) {
#pragma unroll
  for (int o = 32; o > 0; o >>= 1) v += __shfl_xor(v, o);
  return v;
}
#define QSCALE 0.18033688011112042f
#define SB __builtin_amdgcn_sched_barrier(0)
#define MFMA(a, b, c) __builtin_amdgcn_mfma_f32_16x16x32_bf16((a), (b), (c), 0, 0, 0)

__device__ __forceinline__ void convT_tile(const float* __restrict__ src, int src_ld, bf16_t* __restrict__ dst, int dst_ld, unsigned char* lds) {
  float* t = (float*)lds;
  const int tid = HTID;
  const int kr = tid >> 4, nc = (tid & 15) * 4;
#pragma unroll
  for (int j = 0; j < 4; ++j) {
    const float4 v = *(const float4*)(src + (size_t)(kr + 16 * j) * src_ld + nc);
    float* tp = t + (kr + 16 * j) * 65 + nc;
    tp[0] = v.x; tp[1] = v.y; tp[2] = v.z; tp[3] = v.w;
  }
  __syncthreads();
  const int n = tid >> 2, kc = (tid & 3) * 16;
  unsigned w[8];
#pragma unroll
  for (int i = 0; i < 8; ++i) w[i] = pack2(t[(kc + 2 * i) * 65 + n], t[(kc + 2 * i + 1) * 65 + n]);
  uint4* d = (uint4*)(dst + (size_t)n * dst_ld + kc);
  d[0] = make_uint4(w[0], w[1], w[2], w[3]);
  d[1] = make_uint4(w[4], w[5], w[6], w[7]);
  __syncthreads();
}

__device__ __forceinline__ int conv_weights_count(const Params& p, int l) {
  const LayerInfo L = layer_info(p, l);
  return (L.IN / 64) * 16 + (L.WIDTH / 64) * 16;
}
__device__ __forceinline__ void conv_weights_item(const Params& p, int l, int it, unsigned char* lds) {
  const LayerInfo L = layer_info(p, l);
  const int nin = (L.IN / 64) * 16;
  if (it < nin) {
    const int kt = it & 15, nt = it >> 4;
    convT_tile(L.w_in + (size_t)(kt * 64) * L.IN + nt * 64, L.IN, (bf16_t*)(p.ws + OFF_WIN) + (size_t)(nt * 64) * 1024 + kt * 64, 1024, lds);
  } else {
    const int it2 = it - nin, nkt = L.WIDTH / 64;
    const int kt = it2 % nkt, nt = it2 / nkt;
    convT_tile(L.w_out + (size_t)(kt * 64) * 1024 + nt * 64, 1024, (bf16_t*)(p.ws + OFF_WOUT) + (size_t)(nt * 64) * L.WIDTH + kt * 64, L.WIDTH, lds);
  }
}

__device__ __forceinline__ void mod_item(const Params& p, int it, unsigned char* lds) {
  float* ssilu = (float*)lds;
  float* red = ssilu + 9 * 1024;
  const int tid = HTID;
  const int l = it / 48, col0 = (it % 48) * 64;
  for (int i = tid; i < 9 * 1024; i += 256) {
    const int v = i >> 10, k = i & 1023;
    const float x = (v == 0) ? p.in[7][k] : p.in[6][(v - 1) * 1024 + k];
    ssilu[i] = silu_f(x);
  }
  __syncthreads();
  const int col = tid & 63, kq = tid >> 6;
  const float* w = p.in[8] + (size_t)l * 1024 * 3072 + col0 + col;
  float acc[9];
#pragma unroll
  for (int v = 0; v < 9; ++v) acc[v] = 0.f;
  for (int k = kq * 256; k < kq * 256 + 256; ++k) {
    const float wv = w[(size_t)k * 3072];
#pragma unroll
    for (int v = 0; v < 9; ++v) acc[v] += ssilu[v * 1024 + k] * wv;
  }
#pragma unroll
  for (int v = 0; v < 9; ++v) red[(kq * 9 + v) * 64 + col] = acc[v];
  __syncthreads();
  float* mod = (float*)(p.ws + OFF_MISC);
  for (int i = tid; i < 9 * 64; i += 256) {
    const int v = i >> 6, cc = i & 63;
    const float s = red[(0 * 9 + v) * 64 + cc] + red[(1 * 9 + v) * 64 + cc] + red[(2 * 9 + v) * 64 + cc] + red[(3 * 9 + v) * 64 + cc];
    mod[(size_t)(l * 9 + v) * 3072 + col0 + cc] = s + p.in[9][l * 3072 + col0 + cc];
  }
  __syncthreads();
}

__device__ __forceinline__ void rope_item(const Params& p, int it) {
  const int idx = it * 256 + HTID;
  const int t = idx >> 5, pp = idx & 31;
  const int pos = pp < 16 ? (t >> 6) : (t & 63);
  const float inv = exp2f(-(float)(pp & 15) * (13.287712379549449f / 16.f));
  const float ang = (float)pos * inv;
  const double a = (double)ang;
  const double r = a - 6.283185307179586 * rint(a * 0.15915494309189535);
  const float rf = (float)r;
  float2* tab = (float2*)(p.ws + OFF_MISC + MISC_ROPE);
  tab[idx] = make_float2(__cosf(rf), __sinf(rf));
  if (it < 8) {
    const int e = it * 256 + HTID;
    const float* lbp = p.in[21] + (e >> 10) * 4096 + (e & 1023);
    const float x0 = lbp[0], x1 = lbp[1024], x2 = lbp[2048], x3 = lbp[3072];
    const float m = fmaxf(fmaxf(x0, x1), fmaxf(x2, x3));
    const float e0 = expf(x0 - m), e1 = expf(x1 - m), e2 = expf(x2 - m), e3 = expf(x3 - m);
    ((float*)(p.ws + OFF_MISC + MISC_LB))[e] = (e1 + e2) / (e0 + e1 + e2 + e3);
  }
}

__device__ __forceinline__ void phase0(const Params& p, unsigned char* lds) {
  const int nw = conv_weights_count(p, 0);
  const int total = 192 + 256 + nw;
  for (int it = VBID; it < total; it += VGDIM) {
    if (it < 192) mod_item(p, it, lds);
    else if (it < 448) rope_item(p, it - 192);
    else conv_weights_item(p, 0, it - 448, lds);
  }
}

__device__ __forceinline__ void post_phase(const Params& p, int lprev, int lnext, unsigned char* lds, const bool dry) {
  const int tid = HTID, lane = tid & 63, w = tid >> 6;
  const float* mod = (const float*)(p.ws + OFF_MISC);
  const bf16_t* Y = nullptr;
  if (lprev >= 0) {
    const int kind = layer_info(p, lprev).kind;
    Y = (const bf16_t*)(p.ws + (kind == 1 ? 96 * MIB : 0));
  }
  bf16_t* hp = (bf16_t*)(p.ws + OFF_HP);
  bf16_t* hs = lnext < 4 ? hs_ptr(p, lnext) : nullptr;
  for (int row = VBID * 4 + w; row < 24576; row += VGDIM * 4) {
    const int mv = row < 8192 ? 0 : 1 + ((row - 8192) >> 11);
    const float* xs = (lprev <= 0) ? (row < 8192 ? p.in[0] + (size_t)row * 1024 : p.in[1] + (size_t)(row - 8192) * 1024) : p.out + (size_t)row * 1024;
    float4 x[4];
#pragma unroll
    for (int j = 0; j < 4; ++j) x[j] = *(const float4*)(xs + lane * 4 + 256 * j);
    if (lprev >= 0) {
      float4 y[4];
      float ss = 0.f;
#pragma unroll
      for (int j = 0; j < 4; ++j) { const uint2 yw = *(const uint2*)(Y + (size_t)row * 1024 + lane * 4 + 256 * j); y[j] = make_float4(lo_f(yw.x), hi_f(yw.x), lo_f(yw.y), hi_f(yw.y)); ss += y[j].x * y[j].x + y[j].y * y[j].y + y[j].z * y[j].z + y[j].w * y[j].w; }
      ss = wave_sum(ss);
      const float rstd = rsqrtf(ss * (1.f / 1024.f) + 1e-6f);
      const float* ga = mod + (size_t)(lprev * 9 + mv) * 3072 + 2048;
      const float* gp = p.in[11] + lprev * 1024;
#pragma unroll
      for (int j = 0; j < 4; ++j) {
        const int c = lane * 4 + 256 * j;
        const float4 g4 = *(const float4*)(ga + c), p4 = *(const float4*)(gp + c);
        x[j].x += g4.x * (y[j].x * rstd * p4.x); x[j].y += g4.y * (y[j].y * rstd * p4.y);
        x[j].z += g4.z * (y[j].z * rstd * p4.z); x[j].w += g4.w * (y[j].w * rstd * p4.w);
        if (!dry) *(float4*)(p.out + (size_t)row * 1024 + c) = x[j];
      }
    }
    if (lnext < 4) {
      float ss = 0.f;
#pragma unroll
      for (int j = 0; j < 4; ++j) ss += x[j].x * x[j].x + x[j].y * x[j].y + x[j].z * x[j].z + x[j].w * x[j].w;
      ss = wave_sum(ss);
      const float rstd = rsqrtf(ss * (1.f / 1024.f) + 1e-6f);
      const float* sh = mod + (size_t)(lnext * 9 + mv) * 3072;
      const float* sc = sh + 1024;
      const float* gp = p.in[10] + lnext * 1024;
      bf16_t* hd = row < 8192 ? hp + (size_t)row * 1024 : hs + (size_t)(row - 8192) * 1024;
#pragma unroll
      for (int j = 0; j < 4; ++j) {
        const int c = lane * 4 + 256 * j;
        const float4 s4 = *(const float4*)(sh + c), c4 = *(const float4*)(sc + c), p4 = *(const float4*)(gp + c);
        const float h0 = x[j].x * rstd * p4.x * (1.f + c4.x) + s4.x, h1 = x[j].y * rstd * p4.y * (1.f + c4.y) + s4.y;
        const float h2 = x[j].z * rstd * p4.z * (1.f + c4.z) + s4.z, h3 = x[j].w * rstd * p4.w * (1.f + c4.w) + s4.w;
        *(uint2*)(hd + c) = make_uint2(pack2(h0, h1), pack2(h2, h3));
      }
    }
  }
  if (lprev >= 0 && lnext < 4) {
    const int nw = conv_weights_count(p, lnext);
    for (int it = VBID; it < nw; it += VGDIM) conv_weights_item(p, lnext, it, lds);
  }
}


__device__ __forceinline__ unsigned xcc_id() { return (unsigned)__builtin_amdgcn_s_getreg((3 << 11) | 20) & 7u; }
#define LAS __attribute__((address_space(3)))
template <bool SWAP>
__device__ __forceinline__ void gemm_tile_compute(const bf16_t* __restrict__ Ag, const bf16_t* __restrict__ Bg, int K, unsigned char* lds, f32x4 (&acc)[8][4],
                                                  const bool pre, const bf16_t* __restrict__ An, const bf16_t* __restrict__ Bn, const bool hasn) {
  const int tid = threadIdx.x, lane = tid & 63, wid = __builtin_amdgcn_readfirstlane(tid >> 6), wm = wid >> 2, wn = wid & 3;
  const int lr = lane & 15, lg = lane >> 4;
  LAS unsigned char* l3 = (LAS unsigned char*)lds;
  const int prow = lane >> 3;
  const int pgo0 = prow * K + (((lane & 7) ^ ((prow >> 1) & 7)) << 3);
  const int pgo1 = prow * K + (((lane & 7) ^ ((4 + (prow >> 1)) & 7)) << 3);
  const bf16_t* asrc = Ag + (size_t)(wid * 32) * K;
  const bf16_t* bsrc = Bg + (size_t)(wid * 32) * K;
  const size_t pstep = (size_t)8 * K;
#pragma unroll
  for (int mi = 0; mi < 8; ++mi)
#pragma unroll
    for (int ni = 0; ni < 4; ++ni) acc[mi][ni] = (f32x4){0.f, 0.f, 0.f, 0.f};
#define GEMM_STAGE_P(ap_, bp_, s, k0)                                                                                                      \
  {                                                                                                                                        \
    _Pragma("unroll") for (int j = 0; j < 4; ++j) {                                                                                        \
      __builtin_amdgcn_global_load_lds((const unsigned*)((ap_) + j * pstep + ((j & 1) ? pgo1 : pgo0) + (k0)), (LAS unsigned*)(l3 + (s) * 65536 + (wid * 4 + j) * 1024), 16, 0, 0);          \
      __builtin_amdgcn_global_load_lds((const unsigned*)((bp_) + j * pstep + ((j & 1) ? pgo1 : pgo0) + (k0)), (LAS unsigned*)(l3 + (s) * 65536 + 32768 + (wid * 4 + j) * 1024), 16, 0, 0);  \
    }                                                                                                                                      \
  }
#define GEMM_STAGE(s, k0) GEMM_STAGE_P(asrc, bsrc, s, k0)
  const int nk = K >> 6;
  if (!pre) GEMM_STAGE(0, 0);
  asm volatile("s_waitcnt vmcnt(0)" ::: "memory");
  __syncthreads();
  const int x0 = lg ^ ((lr >> 1) & 7);
  const int aoff0 = (wm * 128 + lr) * 128 + x0 * 16, aoff1 = (wm * 128 + lr) * 128 + (x0 ^ 4) * 16;
  const int boff0 = 32768 + (wn * 64 + lr) * 128 + x0 * 16, boff1 = 32768 + (wn * 64 + lr) * 128 + (x0 ^ 4) * 16;
  for (int kt = 0; kt < nk; ++kt) {
    if (kt + 1 < nk) GEMM_STAGE((kt + 1) & 1, (kt + 1) * 64);
    const unsigned char* st = lds + (kt & 1) * 65536;
#pragma unroll
    for (int kk = 0; kk < 2; ++kk) {
      bf16x8 af[8], bfr[4];
#pragma unroll
      for (int ni = 0; ni < 4; ++ni) bfr[ni] = *(const bf16x8*)(st + (kk ? boff1 : boff0) + ni * 2048);
#pragma unroll
      for (int mi = 0; mi < 8; ++mi) af[mi] = *(const bf16x8*)(st + (kk ? aoff1 : aoff0) + mi * 2048);
#pragma unroll
      for (int mi = 0; mi < 8; ++mi)
#pragma unroll
        for (int ni = 0; ni < 4; ++ni)
          acc[mi][ni] = SWAP ? MFMA(bfr[ni], af[mi], acc[mi][ni]) : MFMA(af[mi], bfr[ni], acc[mi][ni]);
    }
    asm volatile("s_waitcnt vmcnt(0)" ::: "memory");
    __syncthreads();
  }
  if (hasn) { const bf16_t* an_ = An + (size_t)(wid * 32) * K; const bf16_t* bn_ = Bn + (size_t)(wid * 32) * K; GEMM_STAGE_P(an_, bn_, 0, 0); }
#undef GEMM_STAGE
#undef GEMM_STAGE_P
}

enum { GM_IN_DA = 0, GM_IN_RET_QKV = 1, GM_IN_RET_G = 2, GM_IN_HG = 3, GM_OUT = 4 };

__device__ __forceinline__ void epi_swapped(const Params& p, int mode, int slot, int ykind, int m, int n, f32x4 v) {
  bf16_t* R0 = (bf16_t*)p.ws;
  if (mode == GM_OUT) {
    bf16_t* Y = (bf16_t*)(p.ws + (ykind == 1 ? 96 * MIB : 0));
    *(uint2*)(Y + (size_t)m * 1024 + n) = make_uint2(pack2(v[0], v[1]), pack2(v[2], v[3]));
  } else if (mode == GM_IN_DA) {
    const bool smp = m >= 8192;
    const int ms = m - 8192;
    const int b = smp ? (ms >> 11) : (m >> 8), t = smp ? (ms & 2047) : (m & 255);
    if (n < 2048) {
      if (smp) {
        const float4 cs = *(const float4*)((const float*)(p.ws + OFF_MISC + MISC_ROPE) + (size_t)(t * 32 + ((n & 63) >> 1)) * 2);
        const float a0 = v[0] * cs.x - v[1] * cs.y, a1 = v[0] * cs.y + v[1] * cs.x;
        const float a2 = v[2] * cs.z - v[3] * cs.w, a3 = v[2] * cs.w + v[3] * cs.z;
        v = (f32x4){a0, a1, a2, a3};
      }
      if (n < 1024) {
        *(uint2*)(R0 + (size_t)m * 1024 + n) = make_uint2(pack2(v[0] * QSCALE, v[1] * QSCALE), pack2(v[2] * QSCALE, v[3] * QSCALE));
      } else {
        const int c = n - 1024;
        const uint2 pk = make_uint2(pack2(v[0], v[1]), pack2(v[2], v[3]));
        if (smp) {
          *(uint2*)(R0 + 64 * MIB / 2 + ((size_t)b * 2560 + t) * 1024 + c) = pk;
        } else {
          *(f32x4*)(p.out + OUT_CK + ((size_t)((b * 2 + slot) * 256 + t)) * 1024 + c) = v;
          *(uint2*)(R0 + 48 * MIB / 2 + (size_t)m * 1024 + c) = pk;
        }
      }
    } else {
      *(uint2*)(R0 + 160 * MIB / 2 + (size_t)m * 1024 + (n - 3072)) = make_uint2(pack2(silu_f(v[0]), silu_f(v[1])), pack2(silu_f(v[2]), silu_f(v[3])));
    }
  } else if (mode == GM_IN_RET_QKV) {
    if (n < 1024) *(uint2*)(R0 + (size_t)m * 1024 + n) = make_uint2(pack2(v[0], v[1]), pack2(v[2], v[3]));
    else if (n < 2048) { const float s = 0.08838834764831845f; *(uint2*)(R0 + PLANE_E + (size_t)m * 1024 + (n - 1024)) = make_uint2(pack2(v[0] * s, v[1] * s), pack2(v[2] * s, v[3] * s)); }
    else *(uint2*)(R0 + 2 * PLANE_E + (size_t)m * 2048 + (n - 2048)) = make_uint2(pack2(v[0], v[1]), pack2(v[2], v[3]));
  } else if (mode == GM_IN_RET_G) {
    *(uint2*)(R0 + (size_t)m * 2048 + n) = make_uint2(pack2(silu_f(v[0]), silu_f(v[1])), pack2(silu_f(v[2]), silu_f(v[3])));
  } else {
    if (n < 1024 || n >= 4096) v = (f32x4){silu_f(v[0]), silu_f(v[1]), silu_f(v[2]), silu_f(v[3])};
    else if (n < 3072) {
      const float4 lb = *(const float4*)((const float*)(p.ws + OFF_MISC + MISC_LB) + (n - 1024));
      v = (f32x4){__log2f(lb.x + (1.f - lb.x) / (1.f + __expf(-v[0]))), __log2f(lb.y + (1.f - lb.y) / (1.f + __expf(-v[1]))),
                  __log2f(lb.z + (1.f - lb.z) / (1.f + __expf(-v[2]))), __log2f(lb.w + (1.f - lb.w) / (1.f + __expf(-v[3])))};
    }
    *(uint2*)(R0 + (size_t)(n >> 10) * PLANE_E + (size_t)m * 1024 + (n & 1023)) = make_uint2(pack2(v[0], v[1]), pack2(v[2], v[3]));
  }
}

__device__ __forceinline__ void epi_da_v(const Params& p, int slot, int m, int n, f32x4 v) {
  bf16_t* R0 = (bf16_t*)p.ws;
  const int c = n - 2048, hh = c >> 7, e = c & 127;
  const uint2 pk = make_uint2(pack2(v[0], v[1]), pack2(v[2], v[3]));
  if (m >= 8192) {
    const int ms = m - 8192, b = ms >> 11, t = ms & 2047;
    *(uint2*)(R0 + 120 * MIB / 2 + ((size_t)((b * 8 + hh) * 128 + e)) * 2560 + t) = pk;
  } else {
    const int b = m >> 8, t = m & 255;
    float* o = p.out + OUT_CV + ((size_t)((b * 2 + slot) * 256 + t)) * 1024 + c;
    o[0] = v[0]; o[1024] = v[1]; o[2048] = v[2]; o[3072] = v[3];
    *(uint2*)(R0 + 104 * MIB / 2 + ((size_t)((b * 8 + hh) * 128 + e)) * 256 + t) = pk;
  }
}

__device__ __forceinline__ void gemm_phase(const Params& p, int l, int mode, unsigned char* lds, int phid) {
  const LayerInfo L = layer_info(p, l);
  bf16_t* R0 = (bf16_t*)p.ws;
  const bf16_t *Ap, *As, *Bt;
  int K, N;
  if (mode == GM_OUT) {
    K = L.WIDTH; N = 1024; Bt = (const bf16_t*)(p.ws + OFF_WOUT);
    const bf16_t* base = R0 + (L.kind == 0 ? 160 * MIB / 2 : (L.kind == 1 ? 4 * PLANE_E : 5 * PLANE_E));
    Ap = base; As = base + (size_t)8192 * K;
  } else {
    K = 1024; Ap = (const bf16_t*)(p.ws + OFF_HP); As = hs_ptr(p, l);
    Bt = (const bf16_t*)(p.ws + OFF_WIN) + (mode == GM_IN_RET_G ? (size_t)4096 * 1024 : 0);
    N = (mode == GM_IN_DA || mode == GM_IN_RET_QKV) ? 4096 : (mode == GM_IN_RET_G ? 2048 : 5120);
  }
  const int ntn = N >> 8, ntiles = 96 * ntn;
  const int extra = (mode == GM_IN_DA) ? 3072 : 0;
  const int tid = threadIdx.x, lane = tid & 63, wid = tid >> 6, wm = wid >> 2, wn = wid & 3, lr = lane & 15, lg = lane >> 4;
  const int G = gridDim.x;
  const bool swz = (G & 7) == 0;
  const int xcd = blockIdx.x & 7, snn = ntn >> 2, nst = 12 * snn;
  const int q0 = swz ? (int)(blockIdx.x >> 3) : (int)blockIdx.x, qstep = swz ? (G >> 3) : G;
  const int qlen = swz ? 32 * ((nst - xcd + 7) >> 3) : ntiles;
#define GEMM_TILE_OF(qq, m0_, n0_)                                                   \
  {                                                                                    \
    int it_ = (qq);                                                                    \
    if (swz) {                                                                         \
      const int st_ = xcd + 8 * ((qq) >> 5), tin_ = (qq) & 31;                         \
      const int smt_ = st_ / snn, snt_ = st_ - smt_ * snn;                             \
      it_ = (smt_ * 8 + (tin_ >> 2)) * ntn + snt_ * 4 + (tin_ & 3);                    \
    }                                                                                  \
    const int mt_ = it_ / ntn;                                                         \
    m0_ = mt_ * 256; n0_ = (it_ - mt_ * ntn) * 256;                                    \
  }
  bool pre = false;
  for (int q = q0; q < qlen; q += qstep) {
    int m0, n0;
    GEMM_TILE_OF(q, m0, n0)
    const bf16_t* A = m0 < 8192 ? Ap + (size_t)m0 * K : As + (size_t)(m0 - 8192) * K;
    const bf16_t* B = Bt + (size_t)n0 * K;
    const bool hasn = q + qstep < qlen;
    const bf16_t *An = A, *Bn = B;
    if (hasn) {
      int m1, n1;
      GEMM_TILE_OF(q + qstep, m1, n1)
      An = m1 < 8192 ? Ap + (size_t)m1 * K : As + (size_t)(m1 - 8192) * K;
      Bn = Bt + (size_t)n1 * K;
    }
    {
      f32x4 acc[8][4];
      if (mode == GM_IN_DA && n0 >= 2048 && n0 < 3072) {
        gemm_tile_compute<false>(A, B, K, lds, acc, pre, An, Bn, hasn);
#pragma unroll
        for (int mi = 0; mi < 8; ++mi)
#pragma unroll
          for (int ni = 0; ni < 4; ++ni)
            epi_da_v(p, L.slot, m0 + wm * 128 + mi * 16 + 4 * lg, n0 + wn * 64 + ni * 16 + lr, acc[mi][ni]);
      } else {
        gemm_tile_compute<true>(A, B, K, lds, acc, pre, An, Bn, hasn);
#pragma unroll
        for (int mi = 0; mi < 8; ++mi)
#pragma unroll
          for (int ni = 0; ni < 4; ++ni)
            epi_swapped(p, mode, L.slot, L.kind, m0 + wm * 128 + mi * 16 + lr, n0 + wn * 64 + ni * 16 + 4 * lg, acc[mi][ni]);
      }
    }
    pre = hasn;
  }
#undef GEMM_TILE_OF
  if (extra) { asm volatile("s_waitcnt vmcnt(0)" ::: "memory"); __syncthreads(); }
  for (int ci = VBID; ci < extra; ci += VGDIM) {
    {
      if (ci < 2048) {
        const int idx = (ci * 256 + HTID) * 8;
        const int b = idx >> 19, rem = idx & 524287, tp = rem >> 10, c = rem & 1023;
        const float* src = p.in[2] + ((size_t)((b * 2 + L.slot) * 512 + tp)) * 1024 + c;
        const float4 u0 = *(const float4*)src, u1 = *(const float4*)(src + 4);
        *(uint4*)(R0 + 64 * MIB / 2 + ((size_t)b * 2560 + 2048 + tp) * 1024 + c) = make_uint4(pack2(u0.x, u0.y), pack2(u0.z, u0.w), pack2(u1.x, u1.y), pack2(u1.z, u1.w));
      } else {
        const int i2 = ci - 2048;
        const int b = i2 >> 7, hh = (i2 >> 4) & 7, tt = (i2 >> 1) & 7, et = i2 & 1;
        convT_tile(p.in[3] + ((size_t)((b * 2 + L.slot) * 512 + tt * 64)) * 1024 + hh * 128 + et * 64, 1024,
                   R0 + 120 * MIB / 2 + ((size_t)((b * 8 + hh) * 128 + et * 64)) * 2560 + 2048 + tt * 64, 2560, lds + HALFID * HALF_LDS);
      }
    }
  }
}

__device__ __forceinline__ void attn_phase(const Params& p, int l, unsigned char* lds, const bool dry, int phid) {
  const int slot = l == 3 ? 1 : 0;
  const float lam_init = 0.8f - 0.6f * expf(-0.3f * (float)l);
  const int tid = threadIdx.x, lane = tid & 63, w = tid >> 6, lr = lane & 15, lg = lane >> 4;
  float lam;
  {
    const float* lf = p.in[14] + slot * 256;
    const float a = wave_sum(lf[lane] * lf[64 + lane]);
    const float b2 = wave_sum(lf[128 + lane] * lf[192 + lane]);
    lam = expf(a) - expf(b2) + lam_init;
  }
  bf16_t* R0 = (bf16_t*)p.ws;
  const float* subg = p.in[15] + slot * 128;
  for (int item = blockIdx.x; item < 1536; item += gridDim.x) {
    int grp, b, h, qt;
    if (item < 1024) { grp = 1; b = item >> 7; h = (item >> 4) & 7; qt = item & 15; }
    else { const int i2 = item - 1024; grp = 0; b = i2 >> 4; h = (i2 >> 1) & 7; qt = i2 & 1; }
    const int nkeys = grp ? 2560 : 256, ntile = nkeys >> 7;
    const int mq = (grp ? 8192 + b * 2048 : b * 256) + qt * 128 + w * 16 + lr;
    const bf16_t* Kg = grp ? R0 + 64 * MIB / 2 + (size_t)b * 2560 * 1024 + h * 128 : R0 + 48 * MIB / 2 + (size_t)b * 256 * 1024 + h * 128;
    const bf16_t* Vg = grp ? R0 + 120 * MIB / 2 + (size_t)(b * 8 + h) * 128 * 2560 : R0 + 104 * MIB / 2 + (size_t)(b * 8 + h) * 128 * 256;
    bf16x8 qf[2][2];
#pragma unroll
    for (int sub = 0; sub < 2; ++sub)
#pragma unroll
      for (int ks = 0; ks < 2; ++ks) qf[sub][ks] = *(const bf16x8*)(R0 + (size_t)mq * 1024 + h * 128 + sub * 64 + ks * 32 + lg * 8);
    LAS unsigned char* l3 = (LAS unsigned char*)lds;
    const int wu = __builtin_amdgcn_readfirstlane(w);
    int koff[4], voff[4];
#pragma unroll
    for (int j = 0; j < 4; ++j) {
      const int kr = (wu * 4 + j) * 4 + (lane >> 4);
      koff[j] = kr * 1024 + (((lane & 15) ^ (kr & 15)) << 3);
      voff[j] = kr * nkeys + (((lane & 15) ^ (kr & 15)) << 3);
    }
#define ATT_STAGE_K(s, key0)                                                                                  \
  {                                                                                                           \
    _Pragma("unroll") for (int j = 0; j < 4; ++j)                                                             \
      __builtin_amdgcn_global_load_lds((const unsigned*)(Kg + (size_t)(key0) * 1024 + koff[j]), (LAS unsigned*)(l3 + (s) * 65536 + (wu * 4 + j) * 1024), 16, 0, 0); \
  }
#define ATT_STAGE_V(s, key0)                                                                                  \
  {                                                                                                           \
    _Pragma("unroll") for (int j = 0; j < 4; ++j)                                                             \
      __builtin_amdgcn_global_load_lds((const unsigned*)(Vg + (key0) + voff[j]), (LAS unsigned*)(l3 + (s) * 65536 + 32768 + (wu * 4 + j) * 1024), 16, 0, 0); \
  }
    const int xl = lg ^ lr;
    const int vsw = (lr >> 1) & 7;
    const int vlo = lr * 256 + ((((lg >> 1)) ^ lr) << 4) + (lg & 1) * 8;
    float mx[2] = {-1e30f, -1e30f}, ls[2] = {0.f, 0.f};
    f32x4 o0[8], o1[8];
#pragma unroll
    for (int et = 0; et < 8; ++et) { o0[et] = (f32x4){0.f, 0.f, 0.f, 0.f}; o1[et] = (f32x4){0.f, 0.f, 0.f, 0.f}; }
    ATT_STAGE_K(0, 0);
    ATT_STAGE_V(0, 0);
    asm volatile("s_waitcnt vmcnt(0)" ::: "memory");
    __syncthreads();
    for (int kt = 0; kt < ntile; ++kt) {
      if (kt + 1 < ntile) { ATT_STAGE_K((kt + 1) & 1, (kt + 1) * 128); ATT_STAGE_V((kt + 1) & 1, (kt + 1) * 128); }
      const unsigned char* ks_ = lds + (kt & 1) * 65536 + lr * 256;
      const unsigned char* vs_ = lds + (kt & 1) * 65536 + 32768;
#pragma unroll
      for (int k2 = 0; k2 < 4; ++k2) {
        bf16x8 kfr[8];
        uint2 vlo_[8], vhi_[8];
#pragma unroll
        for (int sub = 0; sub < 2; ++sub)
#pragma unroll
          for (int nn = 0; nn < 2; ++nn)
#pragma unroll
            for (int ks = 0; ks < 2; ++ks)
              kfr[sub * 4 + nn * 2 + ks] = *(const bf16x8*)(ks_ + (2 * k2 + nn) * 4096 + ((xl ^ (sub * 8 + ks * 4)) << 4));
#pragma unroll
        for (int et = 0; et < 8; ++et) {
          vlo_[et] = *(const uint2*)(vs_ + et * 4096 + (vlo ^ (k2 << 6)));
          vhi_[et] = *(const uint2*)(vs_ + et * 4096 + (vlo ^ (k2 << 6) ^ 32));
        }
        SB;
        f32x4 s[2][2];
#pragma unroll
        for (int sub = 0; sub < 2; ++sub)
#pragma unroll
          for (int nn = 0; nn < 2; ++nn) {
            s[sub][nn] = MFMA(kfr[sub * 4 + nn * 2], qf[sub][0], ((f32x4){0.f, 0.f, 0.f, 0.f}));
            s[sub][nn] = MFMA(kfr[sub * 4 + nn * 2 + 1], qf[sub][1], s[sub][nn]);
          }
        SB;
        bf16x8 pf[2];
        float tmx[2];
#pragma unroll
        for (int sub = 0; sub < 2; ++sub) {
          float tm = fmaxf(fmaxf(fmaxf(s[sub][0][0], s[sub][0][1]), fmaxf(s[sub][0][2], s[sub][0][3])), fmaxf(fmaxf(s[sub][1][0], s[sub][1][1]), fmaxf(s[sub][1][2], s[sub][1][3])));
          tmx[sub] = tm;
        }
        if (__any((tmx[0] > mx[0] + 8.f) || (tmx[1] > mx[1] + 8.f))) {
#pragma unroll
          for (int sub = 0; sub < 2; ++sub) {
            float tm = tmx[sub];
            tm = fmaxf(tm, __shfl_xor(tm, 16));
            tm = fmaxf(tm, __shfl_xor(tm, 32));
            const float mn = (tm > mx[sub] + 8.f) ? tm : mx[sub];
            const float sc = __builtin_amdgcn_exp2f(mx[sub] - mn);
            mx[sub] = mn;
            ls[sub] *= sc;
#pragma unroll
            for (int et = 0; et < 8; ++et) {
              if (sub == 0) { o0[et][0] *= sc; o0[et][1] *= sc; o0[et][2] *= sc; o0[et][3] *= sc; }
              else { o1[et][0] *= sc; o1[et][1] *= sc; o1[et][2] *= sc; o1[et][3] *= sc; }
            }
          }
        }
#pragma unroll
        for (int sub = 0; sub < 2; ++sub) {
          unsigned pw[4];
          float acc = 0.f;
#pragma unroll
          for (int nn = 0; nn < 2; ++nn) {
            float a[4];
#pragma unroll
            for (int r = 0; r < 4; ++r) { a[r] = __builtin_amdgcn_exp2f(s[sub][nn][r] - mx[sub]); acc += a[r]; }
            pw[nn * 2] = pack2(a[0], a[1]);
            pw[nn * 2 + 1] = pack2(a[2], a[3]);
          }
          ls[sub] += acc;
          union { unsigned u[4]; bf16x8 v; } cp;
          cp.u[0] = pw[0]; cp.u[1] = pw[1]; cp.u[2] = pw[2]; cp.u[3] = pw[3];
          pf[sub] = cp.v;
        }
        SB;
#pragma unroll
        for (int et = 0; et < 8; ++et) {
          union { unsigned u[4]; bf16x8 v; } cv;
          cv.u[0] = vlo_[et].x; cv.u[1] = vlo_[et].y; cv.u[2] = vhi_[et].x; cv.u[3] = vhi_[et].y;
          o0[et] = MFMA(cv.v, pf[0], o0[et]);
          o1[et] = MFMA(cv.v, pf[1], o1[et]);
        }
        SB;
      }
      asm volatile("s_waitcnt vmcnt(0)" ::: "memory");
      __syncthreads();
    }
    f32x4 o[8];
    {
      float t0 = ls[0], t1 = ls[1];
      t0 += __shfl_xor(t0, 16); t0 += __shfl_xor(t0, 32);
      t1 += __shfl_xor(t1, 16); t1 += __shfl_xor(t1, 32);
      const float c1 = 1.f / t0, c2 = lam / t1;
#pragma unroll
      for (int et = 0; et < 8; ++et)
#pragma unroll
        for (int r = 0; r < 4; ++r) o[et][r] = o0[et][r] * c1 - o1[et][r] * c2;
    }
#undef ATT_STAGE_K
#undef ATT_STAGE_V
    float ss = 0.f;
#pragma unroll
    for (int et = 0; et < 8; ++et)
#pragma unroll
      for (int r = 0; r < 4; ++r) ss += o[et][r] * o[et][r];
    ss += __shfl_xor(ss, 16);
    ss += __shfl_xor(ss, 32);
    const float rs = rsqrtf(ss * (1.f / 128.f) + 1e-6f) * (1.f - lam_init);
    bf16_t* gp = R0 + 160 * MIB / 2 + (size_t)mq * 1024 + h * 128;
#pragma unroll
    for (int et = 0; et < 8; ++et) {
      const int e0 = 16 * et + 4 * lg;
      const uint2 g = *(const uint2*)(gp + e0);
      const float4 sg = *(const float4*)(subg + e0);
      const float v0 = o[et][0] * rs * sg.x * lo_f(g.x), v1 = o[et][1] * rs * sg.y * hi_f(g.x);
      const float v2 = o[et][2] * rs * sg.z * lo_f(g.y), v3 = o[et][3] * rs * sg.w * hi_f(g.y);
      if (!dry) *(uint2*)(gp + e0) = make_uint2(pack2(v0, v1), pack2(v2, v3));
    }
  }
}

__device__ __forceinline__ bf16_t* hg_ob_row(const Params& p, int m) {
  const int c = m >> 9;
  float* base = c < 32 ? p.out + OUT_CK + (size_t)(c * 2 + 1) * 262144 : p.out + OUT_CV + (size_t)((c - 32) * 2 + 1) * 262144;
  return (bf16_t*)base + (size_t)(m & 511) * 1024;
}

__device__ __forceinline__ bf16_t* ret_ob_row(const Params& p, int ms) {
  const int c = ms >> 8;
  float* base = c < 32 ? p.out + OUT_CK + (size_t)(c * 2 + 1) * 262144 : p.out + OUT_CV + (size_t)((c - 32) * 2 + 1) * 262144;
  return (bf16_t*)base + (size_t)(ms & 255) * 2048;
}

template <int KIND, int DIR>
__device__ __forceinline__ void scan_item(const Params& p, int item, unsigned char* lds, const bool dry) {
  constexpr int DV = KIND == 1 ? 256 : 128, NSL = DV / 64, LDV = KIND == 1 ? 2048 : 1024;
  const int tid = HTID, lane = tid & 63, w = tid >> 6, lr = lane & 15, lg = lane >> 4;
  int grp, b, h, sl;
  {
    int it = item;
    if (it < 64 * NSL) grp = 1; else { grp = 0; it -= 64 * NSL; }
    sl = it % NSL; h = (it / NSL) & 7; b = it / (NSL * 8);
  }
  const int T = grp ? 2048 : 256, nch = T >> 6;
  const size_t mbase = grp ? (size_t)8192 + (size_t)b * 2048 : (size_t)b * 256;
  bf16_t* R0 = (bf16_t*)p.ws;
  const bf16_t* Qg = R0 + mbase * 1024 + h * 128;
  const bf16_t* Kg = R0 + (KIND == 1 ? PLANE_E : (DIR ? 2 * PLANE_E : PLANE_E)) + mbase * 1024 + h * 128;
  const bf16_t* Vg = R0 + (KIND == 1 ? 2 * PLANE_E : 3 * PLANE_E) + mbase * LDV + h * DV + sl * 64;
  bf16_t* Og = R0 + (KIND == 1 ? 4 * PLANE_E : 5 * PLANE_E) + mbase * LDV + h * DV + sl * 64;
  unsigned char* Qs = lds;
  unsigned char* X = lds + 17408;
  unsigned char* Vt = lds + 35840;
  unsigned char* StS = lds + 45056;
  unsigned char* Pm = lds + 62464;
  float* xch = (float*)(lds + 71680);
  float* blA = xch + 512;
  float* erA = xch + 640;
  const int dp = tid & 63, tq = tid >> 6, r0 = tq * 16, d0 = dp * 2;
  float cst0, cst1;
  if (KIND == 1) { cst0 = cst1 = log1pf(-expf(p.in[18][DIR * 8 + h])) * 1.4426950408889634f; }
  else {
    const float* lbp = p.in[21] + DIR * 4096 + h * 128 + d0;
    {
      const float x0 = lbp[0], x1 = lbp[1024], x2 = lbp[2048], x3 = lbp[3072];
      const float m = fmaxf(fmaxf(x0, x1), fmaxf(x2, x3));
      const float e0 = expf(x0 - m), e1 = expf(x1 - m), e2 = expf(x2 - m), e3 = expf(x3 - m);
      cst0 = (e1 + e2) / (e0 + e1 + e2 + e3);
    }
    {
      const float x0 = lbp[1], x1 = lbp[1025], x2 = lbp[2049], x3 = lbp[3073];
      const float m = fmaxf(fmaxf(x0, x1), fmaxf(x2, x3));
      const float e0 = expf(x0 - m), e1 = expf(x1 - m), e2 = expf(x2 - m), e3 = expf(x3 - m);
      cst1 = (e1 + e2) / (e0 + e1 + e2 + e3);
    }
  }
  f32x4 S[8];
  if (grp) {
    const float* s0 = (KIND == 1 ? p.in[4] : p.in[5]) + ((size_t)((b * 2 + DIR) * 8 + h) * 128) * DV + sl * 64 + 16 * w + lr + (size_t)(4 * lg) * DV;
    asm volatile("" : "+v"(s0));
#pragma unroll
    for (int dt = 0; dt < 8; ++dt)
#pragma unroll
      for (int r = 0; r < 4; ++r) S[dt][r] = s0[(16 * dt + r) * DV];
  } else {
#pragma unroll
    for (int dt = 0; dt < 8; ++dt) S[dt] = (f32x4){0.f, 0.f, 0.f, 0.f};
  }
  unsigned qv[16], kv[16], vv[8];
  const int ve2 = tid & 31, vq = tid >> 5;
  const int qoff = r0 * 512 + dp;
  const int voff = (8 * vq) * (LDV / 2) + ve2;
  const unsigned* Qg32 = (const unsigned*)Qg;
  const unsigned* Kg32 = (const unsigned*)Kg;
  const unsigned* Vg32 = (const unsigned*)Vg;
#define SCAN_ISSUE(c)                                                                                   \
  {                                                                                                     \
    const unsigned* q_ = Qg32 + (size_t)(c) * (64 * 512) + qoff;                                        \
    const unsigned* k_ = Kg32 + (size_t)(c) * (64 * 512) + qoff;                                        \
    const unsigned* v_ = Vg32 + (size_t)(c) * (64 * (LDV / 2)) + voff;                                  \
    asm volatile("" : "+v"(q_), "+v"(k_), "+v"(v_));                                                    \
    _Pragma("unroll") for (int i = 0; i < 16; ++i) { qv[i] = q_[i * 512]; kv[i] = k_[i * 512]; }        \
    _Pragma("unroll") for (int i = 0; i < 8; ++i) vv[i] = v_[i * (LDV / 2)];                            \
  }
  if (KIND == 1) {
    if (tid < 64) {
      const float ex = (DIR ? (float)(32 - tid) : (float)(tid - 31)) * cst0;
      *(float2*)(xch + 2 * tid) = make_float2(__builtin_amdgcn_exp2f(ex), __builtin_amdgcn_exp2f(-ex));
    }
    if (tid < 128) { blA[tid] = __builtin_amdgcn_exp2f(64.f * cst0); erA[tid] = __builtin_amdgcn_exp2f(32.f * cst0); }
    __syncthreads();
  }
  SCAN_ISSUE(DIR ? nch - 1 : 0);
  for (int ci = 0; ci < nch; ++ci) {
    const int c = DIR ? nch - 1 - ci : ci;
    unsigned ktp0[8], ktp1[8];
    if (KIND == 1) {
      const float cbr = __builtin_amdgcn_exp2f(32.f * cst0);
#pragma unroll
      for (int j = 0; j < 8; ++j) {
        float ka[2], kb[2];
#pragma unroll
        for (int hh = 0; hh < 2; ++hh) {
          const int i = 2 * j + hh;
          const float2 e = *(const float2*)(xch + 2 * (r0 + i));
          *(unsigned*)(Qs + (r0 + i) * 272 + d0 * 2) = pack2(lo_f(qv[i]) * e.x, hi_f(qv[i]) * e.x);
          const float kh0 = lo_f(kv[i]) * e.y, kh1 = hi_f(kv[i]) * e.y;
          *(unsigned*)(X + (r0 + i) * 272 + d0 * 2) = pack2(kh0, kh1);
          ka[hh] = kh0 * cbr;
          kb[hh] = kh1 * cbr;
        }
        ktp0[j] = pack2(ka[0], ka[1]);
        ktp1[j] = pack2(kb[0], kb[1]);
      }
    } else {
    float tot0 = 0.f, tot1 = 0.f;
#pragma unroll
    for (int i = 0; i < 16; ++i) { tot0 += lo_f(kv[i]); tot1 += hi_f(kv[i]); }
    *(float2*)(xch + tq * 128 + d0) = make_float2(tot0, tot1);
    __syncthreads();
    const float2 t0 = *(const float2*)(xch + d0), t1 = *(const float2*)(xch + 128 + d0), t2 = *(const float2*)(xch + 256 + d0), t3 = *(const float2*)(xch + 384 + d0);
    const float blast0 = (t0.x + t1.x) + (t2.x + t3.x), blast1 = (t0.y + t1.y) + (t2.y + t3.y);
    float ref0, ref1, run0, run1;
    if (DIR == 0) {
      ref0 = t0.x + t1.x; ref1 = t0.y + t1.y;
      run0 = (tq > 0 ? t0.x : 0.f) + (tq > 1 ? t1.x : 0.f) + (tq > 2 ? t2.x : 0.f);
      run1 = (tq > 0 ? t0.y : 0.f) + (tq > 1 ? t1.y : 0.f) + (tq > 2 ? t2.y : 0.f);
    } else {
      ref0 = t2.x + t3.x; ref1 = t2.y + t3.y;
      run0 = (tq < 3 ? t3.x : 0.f) + (tq < 2 ? t2.x : 0.f) + (tq < 1 ? t1.x : 0.f);
      run1 = (tq < 3 ? t3.y : 0.f) + (tq < 2 ? t2.y : 0.f) + (tq < 1 ? t1.y : 0.f);
    }
    const float cbr0 = __builtin_amdgcn_exp2f(blast0 - ref0), cbr1 = __builtin_amdgcn_exp2f(blast1 - ref1);
#pragma unroll
    for (int jj = 0; jj < 8; ++jj) {
      const int j = DIR ? 7 - jj : jj;
      float ka[2], kb[2];
#pragma unroll
      for (int hh = 0; hh < 2; ++hh) {
        const int i = 2 * j + (DIR ? 1 - hh : hh);
        const float g0 = lo_f(kv[i]), g1 = hi_f(kv[i]);
        const float k0 = 1.f - __builtin_amdgcn_exp2f(g0), k1 = 1.f - __builtin_amdgcn_exp2f(g1);
        run0 += g0; run1 += g1;
        *(unsigned*)(Qs + (r0 + i) * 272 + d0 * 2) = pack2(lo_f(qv[i]) * __builtin_amdgcn_exp2f(run0 - ref0), hi_f(qv[i]) * __builtin_amdgcn_exp2f(run1 - ref1));
        const float kh0 = k0 * __builtin_amdgcn_exp2f(ref0 - run0), kh1 = k1 * __builtin_amdgcn_exp2f(ref1 - run1);
        *(unsigned*)(X + (r0 + i) * 272 + d0 * 2) = pack2(kh0, kh1);
        ka[i & 1] = kh0 * cbr0;
        kb[i & 1] = kh1 * cbr1;
      }
      ktp0[j] = pack2(ka[0], ka[1]);
      ktp1[j] = pack2(kb[0], kb[1]);
    }
    if (tq == 0) { *(float2*)(blA + d0) = make_float2(__builtin_amdgcn_exp2f(blast0), __builtin_amdgcn_exp2f(blast1)); *(float2*)(erA + d0) = make_float2(__builtin_amdgcn_exp2f(ref0), __builtin_amdgcn_exp2f(ref1)); }
    }
    {
      const unsigned a0 = (vv[0] & 0xffffu) | (vv[1] << 16), a1 = (vv[2] & 0xffffu) | (vv[3] << 16), a2 = (vv[4] & 0xffffu) | (vv[5] << 16), a3 = (vv[6] & 0xffffu) | (vv[7] << 16);
      const unsigned b0 = (vv[0] >> 16) | (vv[1] & 0xffff0000u), b1 = (vv[2] >> 16) | (vv[3] & 0xffff0000u), b2 = (vv[4] >> 16) | (vv[5] & 0xffff0000u), b3 = (vv[6] >> 16) | (vv[7] & 0xffff0000u);
      *(uint4*)(Vt + (2 * ve2) * 144 + vq * 16) = make_uint4(a0, a1, a2, a3);
      *(uint4*)(Vt + (2 * ve2 + 1) * 144 + vq * 16) = make_uint4(b0, b1, b2, b3);
    }
    if (ci + 1 < nch) { SCAN_ISSUE(DIR ? c - 1 : c + 1); }
    __syncthreads();
#pragma unroll
    for (int dt = 0; dt < 8; ++dt) {
      const float4 er4 = *(const float4*)(erA + 16 * dt + 4 * lg);
      *(uint2*)(StS + (16 * w + lr) * 272 + (16 * dt + 4 * lg) * 2) = make_uint2(pack2(S[dt][0] * er4.x, S[dt][1] * er4.y), pack2(S[dt][2] * er4.z, S[dt][3] * er4.w));
    }
    bf16x8 qf[4];
#pragma unroll
    for (int ks = 0; ks < 4; ++ks) qf[ks] = *(const bf16x8*)(Qs + (16 * w + lr) * 272 + ks * 64 + lg * 16);
    uint2 pv[4];
    {
      const int t = 16 * w + lr;
#pragma unroll
      for (int st = 0; st < 4; ++st) {
        f32x4 s = (f32x4){0.f, 0.f, 0.f, 0.f};
#pragma unroll
        for (int ks = 0; ks < 4; ++ks) {
          const bf16x8 kf = *(const bf16x8*)(X + (16 * st + lr) * 272 + ks * 64 + lg * 16);
          s = MFMA(kf, qf[ks], s);
        }
        float v[4];
#pragma unroll
        for (int r = 0; r < 4; ++r) {
          const int si = 16 * st + 4 * lg + r;
          const bool keep = DIR ? (t <= si) : (t >= si);
          v[r] = keep ? s[r] : 0.f;
        }
        pv[st] = make_uint2(pack2(v[0], v[1]), pack2(v[2], v[3]));
      }
    }
    __syncthreads();
#pragma unroll
    for (int st = 0; st < 4; ++st) *(uint2*)(Pm + (16 * w + lr) * 144 + (16 * st + 4 * lg) * 2) = pv[st];
    *(uint4*)(X + d0 * 144 + r0 * 2) = make_uint4(ktp0[0], ktp0[1], ktp0[2], ktp0[3]);
    *(uint4*)(X + d0 * 144 + r0 * 2 + 16) = make_uint4(ktp0[4], ktp0[5], ktp0[6], ktp0[7]);
    *(uint4*)(X + (d0 + 1) * 144 + r0 * 2) = make_uint4(ktp1[0], ktp1[1], ktp1[2], ktp1[3]);
    *(uint4*)(X + (d0 + 1) * 144 + r0 * 2 + 16) = make_uint4(ktp1[4], ktp1[5], ktp1[6], ktp1[7]);
    __syncthreads();
    {
      bf16x8 pf[2];
#pragma unroll
      for (int ks = 0; ks < 2; ++ks) pf[ks] = *(const bf16x8*)(Pm + (16 * w + lr) * 144 + ks * 64 + lg * 16);
      const bool sep = DIR && (KIND == 2 || grp);
      bf16_t* orow = (KIND == 2 && DIR) ? hg_ob_row(p, (int)mbase + c * 64 + 16 * w + lr) + h * DV + sl * 64 + 4 * lg
                   : (KIND == 1 && DIR && grp) ? ret_ob_row(p, b * 2048 + c * 64 + 16 * w + lr) + h * DV + sl * 64 + 4 * lg
                                               : Og + (size_t)(c * 64 + 16 * w + lr) * LDV + 4 * lg;
#pragma unroll
      for (int et = 0; et < 4; ++et) {
        f32x4 o = (f32x4){0.f, 0.f, 0.f, 0.f};
#pragma unroll
        for (int ks = 0; ks < 2; ++ks) {
          const bf16x8 vf = *(const bf16x8*)(Vt + (16 * et + lr) * 144 + ks * 64 + lg * 16);
          o = MFMA(vf, pf[ks], o);
        }
#pragma unroll
        for (int ks = 0; ks < 4; ++ks) {
          const bf16x8 sf = *(const bf16x8*)(StS + (16 * et + lr) * 272 + ks * 64 + lg * 16);
          o = MFMA(sf, qf[ks], o);
        }
        bf16_t* op = orow + 16 * et;
        if (DIR && !sep) {
          const uint2 old = *(const uint2*)op;
          o[0] += lo_f(old.x); o[1] += hi_f(old.x); o[2] += lo_f(old.y); o[3] += hi_f(old.y);
        }
        if (!(DIR && !sep && dry)) *(uint2*)op = make_uint2(pack2(o[0], o[1]), pack2(o[2], o[3]));
      }
    }
    {
      bf16x8 vtf[2];
#pragma unroll
      for (int ks = 0; ks < 2; ++ks) vtf[ks] = *(const bf16x8*)(Vt + (16 * w + lr) * 144 + ks * 64 + lg * 16);
#pragma unroll
      for (int dt = 0; dt < 8; ++dt) {
        const float4 bl4 = *(const float4*)(blA + 16 * dt + 4 * lg);
        S[dt][0] *= bl4.x; S[dt][1] *= bl4.y; S[dt][2] *= bl4.z; S[dt][3] *= bl4.w;
#pragma unroll
        for (int ks = 0; ks < 2; ++ks) {
          const bf16x8 kf = *(const bf16x8*)(X + (16 * dt + lr) * 144 + ks * 64 + lg * 16);
          S[dt] = MFMA(kf, vtf[ks], S[dt]);
        }
      }
    }
    __syncthreads();
  }
#undef SCAN_ISSUE
  if (!grp) {
    float* so = p.out + (KIND == 1 ? OUT_SR : OUT_SH) + ((size_t)((b * 2 + DIR) * 8 + h) * 128) * DV + sl * 64 + 16 * w + lr + (size_t)(4 * lg) * DV;
    asm volatile("" : "+v"(so));
#pragma unroll
    for (int dt = 0; dt < 8; ++dt)
#pragma unroll
      for (int r = 0; r < 4; ++r) so[(16 * dt + r) * DV] = S[dt][r];
  }
}

template <int KIND, int DIR>
__device__ __forceinline__ void scan_phase(const Params& p, unsigned char* lds, const bool dry) {
  constexpr int NSL = (KIND == 1 ? 256 : 128) / 64;
  const int ns = 64 * NSL, npr = 256 * NSL;
  const int G = VGDIM, bid = VBID;
  int it, step, end = ns + npr;
  if (G > ns) {
    if (bid < ns) { it = bid; step = end; }
    else { it = ns + (bid - ns); step = G - ns; }
  } else { it = bid; step = G; }
  for (; it < end; it += step) scan_item<KIND, DIR>(p, it, lds, dry);
}

__device__ __forceinline__ void scan_phase_ret_sample(const Params& p, unsigned char* lds, const bool dry) {
  const int G = VGDIM >> 1, bid = VBID;
  const int role = bid >= G;
  const int rb = role ? bid - G : bid;
  if (role == 0) { for (int it = rb; it < 256; it += G) scan_item<1, 0>(p, it, lds, dry); }
  else           { for (int it = rb; it < 256; it += G) scan_item<1, 1>(p, it, lds, dry); }
}
__device__ __forceinline__ void scan_phase_ret_prompt(const Params& p, unsigned char* lds, const bool dry) {
  for (int it = VBID; it < 1024; it += VGDIM) {
    scan_item<1, 0>(p, 256 + it, lds, dry);
    scan_item<1, 1>(p, 256 + it, lds, dry);
  }
}

__device__ __forceinline__ void scan_phase_hg_both(const Params& p, unsigned char* lds, const bool dry) {
  if (gridDim.x == 256) {
    const int bid = blockIdx.x, half = HALFID;
    const int role = bid >= 128, rb = role ? bid - 128 : bid;
    const int n_it = half ? 4 : 1, first = half ? 128 + rb * 4 : rb;
    if (role == 0) { for (int k = 0; k < n_it; ++k) scan_item<2, 0>(p, first + k, lds, dry); }
    else           { for (int k = 0; k < n_it; ++k) scan_item<2, 1>(p, first + k, lds, dry); }
    if (half) { for (int i = 0; i < 80; ++i) __syncthreads(); }
    return;
  }
  const int G = VGDIM >> 1, bid = VBID;
  const int role = bid >= G;
  const int rb = role ? bid - G : bid;
  int it, step;
  if (G > 128) {
    if (rb < 128) { it = rb; step = 1 << 20; } else { it = rb; step = G - 128; }
  } else { it = rb; step = G; }
  if (role == 0) { for (; it < 640; it += step) scan_item<2, 0>(p, it, lds, dry); }
  else           { for (; it < 640; it += step) scan_item<2, 1>(p, it, lds, dry); }
}

template <int KIND>
__device__ __forceinline__ void normgate_phase(const Params& p, const bool dry) {
  constexpr int NCH = KIND == 1 ? 4 : 2, DV = KIND == 1 ? 256 : 128, LD = KIND == 1 ? 2048 : 1024;
  const int tid = HTID, lane = tid & 63, w = tid >> 6;
  const int hh = lane >> 3, sub = lane & 7;
  bf16_t* R0 = (bf16_t*)p.ws;
  bf16_t* Ob = R0 + (KIND == 1 ? 4 * PLANE_E : 5 * PLANE_E) + hh * DV + sub * 8;
  const bf16_t* Gb = R0 + (KIND == 1 ? 0 : 4 * PLANE_E) + hh * DV + sub * 8;
  float gn[NCH][8];
#pragma unroll
  for (int j = 0; j < NCH; ++j)
#pragma unroll
    for (int i = 0; i < 8; ++i) gn[j][i] = (KIND == 1) ? 1.f : p.in[22][j * 64 + sub * 8 + i];
  for (int row = VBID * 4 + w; row < 24576; row += VGDIM * 4) {
    bf16_t* op = Ob + (size_t)row * LD;
    const bf16_t* gp = Gb + (size_t)row * LD;
    uint4 ov[NCH], gv[NCH];
#pragma unroll
    for (int j = 0; j < NCH; ++j) { ov[j] = *(const uint4*)(op + j * 64); gv[j] = *(const uint4*)(gp + j * 64); }
    if (KIND == 2 || row >= 8192) {
      const bf16_t* bp = (KIND == 2 ? hg_ob_row(p, row) : ret_ob_row(p, row - 8192)) + hh * DV + sub * 8;
#pragma unroll
      for (int j = 0; j < NCH; ++j) {
        const uint4 bv = *(const uint4*)(bp + j * 64);
        ov[j].x = pack2(lo_f(ov[j].x) + lo_f(bv.x), hi_f(ov[j].x) + hi_f(bv.x));
        ov[j].y = pack2(lo_f(ov[j].y) + lo_f(bv.y), hi_f(ov[j].y) + hi_f(bv.y));
        ov[j].z = pack2(lo_f(ov[j].z) + lo_f(bv.z), hi_f(ov[j].z) + hi_f(bv.z));
        ov[j].w = pack2(lo_f(ov[j].w) + lo_f(bv.w), hi_f(ov[j].w) + hi_f(bv.w));
      }
    }
    float ss = 0.f;
#pragma unroll
    for (int j = 0; j < NCH; ++j) {
      const unsigned wv[4] = {ov[j].x, ov[j].y, ov[j].z, ov[j].w};
#pragma unroll
      for (int i = 0; i < 4; ++i) { const float a = lo_f(wv[i]), b2 = hi_f(wv[i]); ss += a * a + b2 * b2; }
    }
    ss += __shfl_xor(ss, 1);
    ss += __shfl_xor(ss, 2);
    ss += __shfl_xor(ss, 4);
    const float rs = rsqrtf(ss * (1.f / (float)DV) + 1e-6f);
#pragma unroll
    for (int j = 0; j < NCH; ++j) {
      const unsigned wv[4] = {ov[j].x, ov[j].y, ov[j].z, ov[j].w};
      const unsigned gw[4] = {gv[j].x, gv[j].y, gv[j].z, gv[j].w};
      unsigned r[4];
#pragma unroll
      for (int i = 0; i < 4; ++i)
        r[i] = pack2(lo_f(wv[i]) * rs * gn[j][2 * i] * lo_f(gw[i]), hi_f(wv[i]) * rs * gn[j][2 * i + 1] * hi_f(gw[i]));
      if (!dry) *(uint4*)(op + j * 64) = make_uint4(r[0], r[1], r[2], r[3]);
    }
  }
}

__device__ __forceinline__ void opaque_params(Params& q) {
  asm volatile("" : "+s"(q.out), "+s"(q.ws));
#pragma unroll
  for (int i = 0; i < 23; ++i) asm volatile("" : "+s"(q.in[i]));
}

struct BarState { unsigned* base; unsigned xcd, mycnt, nact, esub, etop; };
__device__ __forceinline__ void grid_barrier(BarState& b) {
  asm volatile("s_waitcnt vmcnt(0) lgkmcnt(0)" ::: "memory");
  __syncthreads();
  if (threadIdx.x == 0) {
    b.esub += b.mycnt; b.etop += b.nact;
    const unsigned old = __hip_atomic_fetch_add(b.base + 64 * b.xcd, 1u, __ATOMIC_RELAXED, __HIP_MEMORY_SCOPE_AGENT);
    if (old + 1u == b.esub) {
      __builtin_amdgcn_fence(__ATOMIC_RELEASE, "agent");
      __hip_atomic_fetch_add(b.base + 512, 1u, __ATOMIC_RELAXED, __HIP_MEMORY_SCOPE_AGENT);
    }
    while (__hip_atomic_load(b.base + 512, __ATOMIC_RELAXED, __HIP_MEMORY_SCOPE_AGENT) < b.etop) __builtin_amdgcn_s_sleep(1);
    __builtin_amdgcn_fence(__ATOMIC_ACQUIRE, "agent");
  }
  __syncthreads();
}
__device__ __forceinline__ void bar_census_post(BarState& b) {
  if (threadIdx.x == 0) __hip_atomic_fetch_add(b.base + 1024 + 64 * b.xcd, 1u, __ATOMIC_RELAXED, __HIP_MEMORY_SCOPE_AGENT);
}
__device__ __forceinline__ void bar_census_read(BarState& b) {
  if (threadIdx.x == 0) {
    unsigned n = 0;
    for (unsigned j = 0; j < 8; ++j) {
      const unsigned c = __hip_atomic_load(b.base + 1024 + 64 * j, __ATOMIC_RELAXED, __HIP_MEMORY_SCOPE_AGENT);
      n += (c != 0u);
      if (j == b.xcd) b.mycnt = c;
    }
    b.nact = n;
  }
}
#define GSYNC(n) { if ((n) == 0) { grid.sync(); bar_census_read(bst); } else grid_barrier(bst); }

#if defined(PH_ONLY)
#define PHASE(n, call) if (n == PH_ONLY) { const bool dry = false; call; }
#elif defined(REP_N)
#define PHASE(n, call) if (lo <= n && n < hi) { for (int rep = (n == REP_N ? 0 : 1); rep < 2; ++rep) { const bool dry = (rep == 0); call; if (!(fin && n + 1 == hi && rep == 1)) GSYNC(n) } }
#else
#define PHASE(n, call) if (lo <= n && n < hi) { const bool dry = false; call; if (!(fin && n + 1 == hi)) GSYNC(n) }
#endif

__device__ __forceinline__ void run_range(const Params& q, int lo, int hi, bool fin, cg::grid_group& grid, unsigned char* lds) {
  unsigned char* ldh = lds + HALFID * HALF_LDS;
  BarState bst; bst.base = (unsigned*)(q.ws + OFF_MISC + MISC_CTR); bst.xcd = xcc_id(); bst.mycnt = 0; bst.nact = 0; bst.esub = 0; bst.etop = 0;
  if (lo == 0) bar_census_post(bst);
  PHASE(0, phase0(q, ldh))
  PHASE(1, post_phase(q, -1, 0, ldh, dry))
  PHASE(2, gemm_phase(q, 0, GM_IN_DA, lds, 2))
  PHASE(3, attn_phase(q, 0, lds, dry, 3))
  PHASE(4, gemm_phase(q, 0, GM_OUT, lds, 4))
  PHASE(5, post_phase(q, 0, 1, ldh, dry))
  PHASE(6, gemm_phase(q, 1, GM_IN_RET_QKV, lds, 6))
  PHASE(7, scan_phase_ret_sample(q, ldh, dry))
  PHASE(8, scan_phase_ret_prompt(q, ldh, dry))
  PHASE(9, gemm_phase(q, 1, GM_IN_RET_G, lds, 9))
  PHASE(10, normgate_phase<1>(q, dry))
  PHASE(11, gemm_phase(q, 1, GM_OUT, lds, 11))
  PHASE(12, post_phase(q, 1, 2, ldh, dry))
  PHASE(13, gemm_phase(q, 2, GM_IN_HG, lds, 13))
  PHASE(14, scan_phase_hg_both(q, ldh, dry))
  PHASE(16, normgate_phase<2>(q, dry))
  PHASE(17, gemm_phase(q, 2, GM_OUT, lds, 17))
  PHASE(18, post_phase(q, 2, 3, ldh, dry))
  PHASE(19, gemm_phase(q, 3, GM_IN_DA, lds, 19))
  PHASE(20, attn_phase(q, 3, lds, dry, 20))
  PHASE(21, gemm_phase(q, 3, GM_OUT, lds, 21))
  PHASE(22, post_phase(q, 3, 4, ldh, dry))
}

__global__ void __launch_bounds__(NTHR, 2) mega_fwd(Params p) {
  extern __shared__ __attribute__((aligned(16))) unsigned char lds[];
  cg::grid_group grid = cg::this_grid();
  run_range(p, p.ph_lo, p.ph_hi, true, grid, lds);
}

extern "C" void kernel_launch(void* const* d_in, const int* in_sizes, int n_in, void* d_out, int out_size, void* d_ws, size_t ws_size, hipStream_t stream) {
  static int grid_blocks = 0;
  if (grid_blocks == 0) {
    int dev = 0, cus = 0, per_cu = 0;
    hipGetDevice(&dev);
    hipDeviceGetAttribute(&cus, hipDeviceAttributeMultiprocessorCount, dev);
    hipFuncSetAttribute((const void*)mega_fwd, hipFuncAttributeMaxDynamicSharedMemorySize, LDS_BYTES);
    hipOccupancyMaxActiveBlocksPerMultiprocessor(&per_cu, (const void*)mega_fwd, NTHR, LDS_BYTES);
    if (per_cu < 1) per_cu = 1;
    if (per_cu > 1) per_cu = 1;
    if (cus < 1) cus = 256;
    grid_blocks = cus * per_cu;
    (void)hipGetLastError();
    if (n_in != 23 || ws_size < WS_NEED) { fprintf(stderr, "kernel_launch: unexpected n_in %d / ws_size %zu (need %zu)\n", n_in, ws_size, (size_t)WS_NEED); }
  }
  hipMemsetAsync((unsigned char*)d_ws + OFF_MISC + MISC_CTR, 0, 8192, stream);
  Params p{};
  for (int i = 0; i < 23; ++i) p.in[i] = (const float*)d_in[i];
  p.out = (float*)d_out;
  p.ws = (unsigned char*)d_ws;
#if ONE_LAUNCH
  p.ph_lo = 0; p.ph_hi = NPH;
  void* args[] = {&p};
  hipError_t e = hipLaunchCooperativeKernel((const void*)mega_fwd, dim3(grid_blocks), dim3(NTHR), args, LDS_BYTES, stream);
  if (e != hipSuccess) fprintf(stderr, "cooperative launch failed: %s (grid %d)\n", hipGetErrorString(e), grid_blocks);
#else
  for (int ph = 0; ph < NPH; ++ph) {
    p.ph_lo = ph; p.ph_hi = ph + 1;
    hipLaunchKernelGGL(mega_fwd, dim3(grid_blocks), dim3(NTHR), LDS_BYTES, stream, p);
  }
#endif
}
```
